# Optimizing an MI355X kernel written in HIP

```python
import math
import jax, jax.numpy as jnp
from jax import lax
import numpy as np

D_MODEL = 1024
BATCH = 4
SEQ = 4096
DEPTH = 2

N_BRANCH = 4
MIX_WIDTH = D_MODEL // N_BRANCH
EPS = 1e-6
Q_BLOCK = 128

A_HEAD_DIM = 64
A_HEADS = MIX_WIDTH // A_HEAD_DIM
IDX_HEADS = 8
IDX_DIM = 32
TOPK_MAX = 256

POOL_WINDOWS = (2, 4, 8, 16)
POOL_GROUPS = len(POOL_WINDOWS)
POOL_GROUP_DIM = MIX_WIDTH // POOL_GROUPS

GMLP_CHUNK = 128
GMLP_GROUPS = 4
GMLP_GROUP_DIM = MIX_WIDTH // GMLP_GROUPS

SB_HEAD_DIM = 64
SB_HEADS = MIX_WIDTH // SB_HEAD_DIM

D_FF = ((8 * D_MODEL + 3 * 256 - 1) // (3 * 256)) * 256

SPLIT_SIZES = (
    MIX_WIDTH, MIX_WIDTH, MIX_WIDTH,
    IDX_HEADS * IDX_DIM,
    IDX_DIM,
    IDX_HEADS,
    MIX_WIDTH,
    MIX_WIDTH, MIX_WIDTH,
    MIX_WIDTH, MIX_WIDTH, MIX_WIDTH,
    N_BRANCH * D_MODEL,
)
D_IN = sum(SPLIT_SIZES)

kernel_name = "hybrid_gated_dsa_pool_gmlp_stickbreak"


def _split_points():
    return [int(c) for c in np.cumsum(np.array(SPLIT_SIZES))[:-1]]


def rms_norm(x, g):
    xf = x.astype(jnp.float32)
    y = xf * lax.rsqrt(jnp.mean(xf * xf, axis=-1, keepdims=True) + EPS)
    return (y * g.astype(jnp.float32)).astype(x.dtype)


def layer_norm(x, g):
    xf = x.astype(jnp.float32)
    mu = jnp.mean(xf, axis=-1, keepdims=True)
    xc = xf - mu
    y = xc * lax.rsqrt(jnp.mean(xc * xc, axis=-1, keepdims=True) + EPS)
    return (y * g.astype(jnp.float32)).astype(x.dtype)


def sparse_indexed_attention(q, k, v, q_idx, k_idx, w_idx, q_norm, k_norm):
    B, S, H, Dh = q.shape
    topk = min(TOPK_MAX, S // 4)
    q = rms_norm(q, q_norm)
    k = rms_norm(k, k_norm)
    scale = Dh ** -0.5
    n_blocks = S // Q_BLOCK
    s_pos = jnp.arange(S)
    k_idx_f = k_idx.astype(jnp.float32)

    def block(i):
        start = i * Q_BLOCK
        qb = lax.dynamic_slice_in_dim(q, start, Q_BLOCK, axis=1)
        qib = lax.dynamic_slice_in_dim(q_idx, start, Q_BLOCK, axis=1).astype(jnp.float32)
        wb = lax.dynamic_slice_in_dim(w_idx, start, Q_BLOCK, axis=1).astype(jnp.float32)
        t_pos = start + jnp.arange(Q_BLOCK)
        head_scores = jax.nn.relu(jnp.einsum('bthd,bsd->bths', qib, k_idx_f))
        idx_score = jnp.einsum('bth,bths->bts', wb, head_scores)
        causal = s_pos[None, :] <= t_pos[:, None]
        idx_score = jnp.where(causal[None], idx_score, -jnp.inf)
        _, sel = lax.top_k(idx_score, topk)
        valid = sel <= t_pos[None, :, None]
        k_sel = jax.vmap(lambda kk, ii: kk[ii])(k, sel)
        v_sel = jax.vmap(lambda vv, ii: vv[ii])(v, sel)
        logits = jnp.einsum('bthd,btkhd->bhtk', qb, k_sel).astype(jnp.float32) * scale
        logits = jnp.where(valid[:, None], logits, -jnp.inf)
        p = jax.nn.softmax(logits, axis=-1).astype(v.dtype)
        return jnp.einsum('bhtk,btkhd->bthd', p, v_sel)

    out = lax.map(block, jnp.arange(n_blocks))
    return out.transpose(1, 0, 2, 3, 4).reshape(B, S, H * Dh)


def multiscale_pool(p, w_grp, scale):
    B, S, _ = p.shape
    pg = p.reshape(B, S, POOL_GROUPS, POOL_GROUP_DIM).astype(jnp.float32)
    csum = jnp.pad(jnp.cumsum(pg, axis=1), ((0, 0), (1, 0), (0, 0), (0, 0)))
    pos = jnp.arange(S)
    means = []
    for g, w in enumerate(POOL_WINDOWS):
        lo_idx = jnp.maximum(pos + 1 - w, 0)
        cnt = jnp.minimum(pos + 1, w).astype(jnp.float32)
        means.append((csum[:, 1:, g] - csum[:, lo_idx, g]) / cnt[None, :, None])
    pooled = jnp.stack(means, axis=2) - pg
    y = jnp.einsum('bsgc,gcd->bsgd', pooled, w_grp.astype(jnp.float32))
    return (y.reshape(B, S, MIX_WIDTH) * scale.astype(jnp.float32)).astype(p.dtype)


def chunked_spatial_gating(u, v, ln_g, w_s, b_s):
    B, S, _ = v.shape
    v = layer_norm(v, ln_g)
    vg = v.reshape(B, S // GMLP_CHUNK, GMLP_CHUNK, GMLP_GROUPS, GMLP_GROUP_DIM)
    mask = jnp.tril(jnp.ones((GMLP_CHUNK, GMLP_CHUNK), dtype=w_s.dtype))
    mixed = jnp.einsum('gts,bnsgd->bntgd', w_s * mask[None], vg)
    mixed = mixed + b_s.T[None, None, :, :, None]
    return u * mixed.reshape(B, S, MIX_WIDTH)


def stick_breaking_attention(q, k, v):
    B, S, H, Dh = q.shape
    scale = Dh ** -0.5
    n_blocks = S // Q_BLOCK
    s_pos = jnp.arange(S)

    def block(i):
        start = i * Q_BLOCK
        qb = lax.dynamic_slice_in_dim(q, start, Q_BLOCK, axis=1)
        t_pos = start + jnp.arange(Q_BLOCK)
        z = jnp.einsum('bthd,bshd->bhts', qb, k).astype(jnp.float32) * scale
        strict = (s_pos[None, :] < t_pos[:, None])[None, None]
        log_1m = jnp.where(strict, jax.nn.log_sigmoid(-z), 0.0)
        tail = lax.cumsum(log_1m, axis=3, reverse=True) - log_1m
        a = jnp.where(strict, jnp.exp(jax.nn.log_sigmoid(z) + tail), 0.0)
        return jnp.einsum('bhts,bshd->bthd', a.astype(v.dtype), v)

    out = lax.map(block, jnp.arange(n_blocks))
    return out.transpose(1, 0, 2, 3, 4).reshape(B, S, H * Dh)


def hybrid_mixer(h, w_in, q_norm, k_norm, pool_w, pool_scale,
                 gm_norm, gm_ws, gm_b, w_branch, w_out):
    B, S, _ = h.shape
    z = h @ w_in
    (aq, ak, av, iq, ik, iw, pin, gu, gv, sq, sk, sv, gl) = jnp.split(z, _split_points(), axis=-1)
    o_a = sparse_indexed_attention(
        aq.reshape(B, S, A_HEADS, A_HEAD_DIM), ak.reshape(B, S, A_HEADS, A_HEAD_DIM),
        av.reshape(B, S, A_HEADS, A_HEAD_DIM), iq.reshape(B, S, IDX_HEADS, IDX_DIM),
        ik, iw, q_norm, k_norm)
    o_b = multiscale_pool(pin, pool_w, pool_scale)
    o_c = chunked_spatial_gating(jax.nn.gelu(gu), jax.nn.gelu(gv), gm_norm, gm_ws, gm_b)
    o_d = stick_breaking_attention(
        sq.reshape(B, S, SB_HEADS, SB_HEAD_DIM), sk.reshape(B, S, SB_HEADS, SB_HEAD_DIM),
        sv.reshape(B, S, SB_HEADS, SB_HEAD_DIM))
    o = jnp.stack([o_a, o_b, o_c, o_d], axis=2)
    proj = jnp.einsum('bsnw,nwd->bsnd', o, w_branch)
    gate = jax.nn.sigmoid(gl.astype(jnp.float32)).reshape(B, S, N_BRANCH, D_MODEL)
    merged = jnp.sum(gate.astype(proj.dtype) * proj, axis=2)
    return merged @ w_out


def swiglu_ffn(h, w_gate, w_up, w_down):
    return (jax.nn.silu(h @ w_gate) * (h @ w_up)) @ w_down


def setup_inputs(seed: int = 0) -> dict:
    key = jax.random.key(seed)
    ks = jax.random.split(key, 17)
    f32 = jnp.float32

    def nrm(k, shape, s):
        return jax.random.normal(k, shape, f32) * s

    return {
        "x": nrm(ks[0], (BATCH, SEQ, D_MODEL), 1.0),
        "mix_norm": 1.0 + nrm(ks[1], (DEPTH, D_MODEL), 0.05),
        "w_in": nrm(ks[2], (DEPTH, D_MODEL, D_IN), D_MODEL ** -0.5),
        "attn_q_norm": 1.0 + nrm(ks[3], (DEPTH, A_HEAD_DIM), 0.05),
        "attn_k_norm": 1.0 + nrm(ks[4], (DEPTH, A_HEAD_DIM), 0.05),
        "pool_w": nrm(ks[5], (DEPTH, POOL_GROUPS, POOL_GROUP_DIM, POOL_GROUP_DIM), POOL_GROUP_DIM ** -0.5),
        "pool_scale": 1.0 + nrm(ks[6], (DEPTH, MIX_WIDTH), 0.05),
        "gmlp_norm": 1.0 + nrm(ks[7], (DEPTH, MIX_WIDTH), 0.05),
        "gmlp_w_s": nrm(ks[8], (DEPTH, GMLP_GROUPS, GMLP_CHUNK, GMLP_CHUNK), GMLP_CHUNK ** -0.5),
        "gmlp_b": 1.0 + nrm(ks[9], (DEPTH, GMLP_GROUPS, GMLP_CHUNK), 0.1),
        "w_branch": nrm(ks[10], (DEPTH, N_BRANCH, MIX_WIDTH, D_MODEL), MIX_WIDTH ** -0.5),
        "w_out": nrm(ks[11], (DEPTH, D_MODEL, D_MODEL), D_MODEL ** -0.5),
        "ffn_norm": 1.0 + nrm(ks[12], (DEPTH, D_MODEL), 0.05),
        "w_ffn_gate": nrm(ks[13], (DEPTH, D_MODEL, D_FF), D_MODEL ** -0.5),
        "w_ffn_up": nrm(ks[14], (DEPTH, D_MODEL, D_FF), D_MODEL ** -0.5),
        "w_ffn_down": nrm(ks[15], (DEPTH, D_FF, D_MODEL), D_FF ** -0.5),
    }


def reference(x, mix_norm, w_in, attn_q_norm, attn_k_norm, pool_w, pool_scale,
              gmlp_norm, gmlp_w_s, gmlp_b, w_branch, w_out, ffn_norm,
              w_ffn_gate, w_ffn_up, w_ffn_down):
    for l in range(DEPTH):
        h = rms_norm(x, mix_norm[l])
        x = x + hybrid_mixer(h, w_in[l], attn_q_norm[l], attn_k_norm[l], pool_w[l],
                             pool_scale[l], gmlp_norm[l], gmlp_w_s[l], gmlp_b[l],
                             w_branch[l], w_out[l])
        h = rms_norm(x, ffn_norm[l])
        x = x + swiglu_ffn(h, w_ffn_gate[l], w_ffn_up[l], w_ffn_down[l])
    return x
```

```cpp
#include <hip/hip_runtime.h>
#include <hip/hip_cooperative_groups.h>
#include <cstdio>
#include <cstdint>
namespace pg8 {
#define PG8_LAS __attribute__((address_space(3)))
typedef unsigned short bf16_t;
typedef short bf16x8 __attribute__((ext_vector_type(8)));
typedef float f32x4 __attribute__((ext_vector_type(4)));
typedef unsigned u32x4 __attribute__((ext_vector_type(4)));
constexpr int BM = 256, BK = 64, HALF = 128, HTB = HALF * BK * 2  , STAGE_BYTES = 8 * HTB, NXCD = 8, WGM = 8;

__host__ __device__ __forceinline__ int lds_byte(int r, int c) { const int st = (r >> 4) * 2 + (c >> 5), rr = r & 15, cc = c & 31, ob = rr * 64 + cc * 2; return st * 1024 + (ob ^ (((ob >> 9) & 1) << 5)); }
__host__ __device__ __forceinline__ void stage_rc(int b, int& R, int& C) { const int st = b / 1024, sb = b % 1024, swz = sb ^ (((sb >> 9) & 1) << 5); R = (st >> 1) * 16 + swz / 64; C = (st & 1) * 32 + (swz % 64) / 2; }
__host__ __device__ __forceinline__ int perm32(int rho) { const int n = rho >> 4, i = rho & 15; return 8 * (i >> 2) + 4 * n + (i & 3); }

struct Unit { int pm, pn; };
struct Gemm { const bf16_t* A; const bf16_t* Bt; int M, N, K; };

struct StaticOrder {
    int nM, nN, nwg, G, c;
    __host__ __device__ void init(int M, int N, int G_, int c_) { nM = M / BM; nN = N / BM; nwg = nM * nN; G = G_; c = c_; }
    __host__ __device__ bool next(int i, Unit& u) const {
        const long L = (long)i * G + c; if (L >= nwg) return false;
        int wgid = (int)L; { const int q = nwg / NXCD, r = nwg % NXCD, xcd = wgid % NXCD, off = wgid / NXCD; wgid = (xcd < r ? xcd * (q + 1) : r * (q + 1) + (xcd - r) * q) + off; }
        const int nig = WGM * nN, gid = wgid / nig, fm = gid * WGM, gsz = (nM - fm) < WGM ? (nM - fm) : WGM;
        u.pm = fm + ((wgid % nig) % gsz); u.pn = (wgid % nig) / gsz; return true;
    }
    __device__ __forceinline__ void a_ready(const Unit&) const {}
    __device__ __forceinline__ void done(const Unit&) const {}
};

__device__ __forceinline__ unsigned cvt_pk_bf16(float lo, float hi) { unsigned r; asm volatile("v_cvt_pk_bf16_f32 %0, %1, %2" : "=v"(r) : "v"(lo), "v"(hi)); return r; }
template <class Epi, class Sched, bool ALIGN_EPI = false, bool SP2 = false>
__device__ __forceinline__ void gemm_phase(PG8_LAS unsigned char* lds, const Gemm g, const Sched& S, const Epi& E) {
    int tid_ = threadIdx.x; asm volatile("" : "+v"(tid_)); const int tid = tid_, wid = __builtin_amdgcn_readfirstlane(tid >> 6), lane = tid & 63, wr = wid >> 2, wc = wid & 3, fr = lane & 15, fq = lane >> 4;
    const int K = g.K, nt = K / BK;
    unsigned voffA[2], voffB[2];
#pragma unroll
    for (int i = 0; i < 2; ++i) { int R, C; stage_rc(tid * 16 + i * 8192, R, C); const int Rb = Epi::PERM ? ((R & ~31) + perm32(R & 31)) : R;
        voffA[i] = (unsigned)(R * K + C) * 2u; voffB[i] = (unsigned)(Rb * K + C) * 2u; }
    const size_t kstep = (size_t)(BK * 2);
    const size_t hstep = (size_t)HALF * K * 2;
    const size_t tstep = 2 * hstep;
    const unsigned ldsw = (unsigned)wid * 1024u;
    const int aoff = lds_byte(wr * 64 + fr, fq * 8), boff = lds_byte(wc * 32 + fr, fq * 8);
#define PG8_SA(b, h) (((b) * 2 + (h)) * HTB)
#define PG8_SB(b, h) ((4 + (b) * 2 + (h)) * HTB)
#define PG8_STAGE(bufoff, gbase, voff) do { _Pragma("unroll") for (int _i = 0; _i < 2; ++_i) \
        __builtin_amdgcn_global_load_lds((const unsigned*)((const char*)(gbase) + (voff)[_i]), (PG8_LAS unsigned*)(lds + (bufoff) + ldsw + _i * 8192), 16, 0, 0); } while (0)
#define PG8_LDA(dst, b, h) do { _Pragma("unroll") for (int m = 0; m < 4; ++m) _Pragma("unroll") for (int k = 0; k < 2; ++k) dst[m][k] = *(const PG8_LAS bf16x8*)(lds + PG8_SA(b, h) + aoff + m * 2048 + k * 1024); } while (0)
#define PG8_LDB(dst, b, h) do { _Pragma("unroll") for (int n = 0; n < 2; ++n) _Pragma("unroll") for (int k = 0; k < 2; ++k) dst[n][k] = *(const PG8_LAS bf16x8*)(lds + PG8_SB(b, h) + boff + n * 2048 + k * 1024); } while (0)
#define PG8_MMA(ai, bj, At, Bt) do { __builtin_amdgcn_s_setprio(1); _Pragma("unroll") for (int m = 0; m < 4; ++m) _Pragma("unroll") for (int n = 0; n < 2; ++n) _Pragma("unroll") for (int k = 0; k < 2; ++k) \
        acc[ai][bj][m][n] = __builtin_amdgcn_mfma_f32_16x16x32_bf16(Bt[n][k], At[m][k], acc[ai][bj][m][n], 0, 0, 0); __builtin_amdgcn_s_setprio(0); } while (0)
#define PG8_WAIT_V(n) asm volatile("s_waitcnt vmcnt(" #n ")" ::: "memory")
#define PG8_WAIT_L(n) asm volatile("s_waitcnt lgkmcnt(" #n ")" ::: "memory")
#define PG8_BAR __builtin_amdgcn_s_barrier()
#define PG8_SCHED __builtin_amdgcn_sched_barrier(0)
    Unit cur, nxt; int ui = 0;
    if (!S.next(0, cur)) return;
    f32x4 acc[2][2][4][2];
#pragma unroll
    for (int a = 0; a < 2; ++a)
#pragma unroll
        for (int b = 0; b < 2; ++b)
#pragma unroll
            for (int m = 0; m < 4; ++m)
#pragma unroll
                for (int n = 0; n < 2; ++n) acc[a][b][m][n] = (f32x4){0.f, 0.f, 0.f, 0.f};
    bf16x8 At[4][2], B0[2][2], B1[2][2];
    const char* cA = (const char*)g.A + (size_t)cur.pm * tstep; const char* cB = (const char*)g.Bt + (size_t)cur.pn * tstep;
    S.a_ready(cur);
    if constexpr (SP2) {
        PG8_STAGE(PG8_SB(0, 0), cB, voffB); PG8_STAGE(PG8_SB(0, 1), cB + hstep, voffB); PG8_STAGE(PG8_SA(0, 0), cA, voffA); PG8_STAGE(PG8_SA(0, 1), cA + hstep, voffA);
        if (wr == 1) PG8_BAR;
        PG8_WAIT_V(2); PG8_BAR;
        PG8_STAGE(PG8_SB(1, 0), cB + kstep, voffB); PG8_STAGE(PG8_SA(1, 0), cA + kstep, voffA); PG8_STAGE(PG8_SB(1, 1), cB + hstep + kstep, voffB);
        PG8_WAIT_V(6); PG8_BAR;
    } else {
        PG8_STAGE(PG8_SB(0, 0), cB, voffB); PG8_STAGE(PG8_SA(0, 0), cA, voffA); PG8_STAGE(PG8_SB(0, 1), cB + hstep, voffB); PG8_STAGE(PG8_SA(0, 1), cA + hstep, voffA);
        if (wr == 1) PG8_BAR;
        PG8_WAIT_V(4); PG8_BAR;
        PG8_STAGE(PG8_SB(1, 0), cB + kstep, voffB); PG8_STAGE(PG8_SA(1, 0), cA + kstep, voffA); PG8_STAGE(PG8_SB(1, 1), cB + hstep + kstep, voffB);
        PG8_WAIT_V(6); PG8_BAR;
    }
    for (;;) {
        const bool has_next = S.next(ui + 1, nxt);
        const char* nA = has_next ? (const char*)g.A + (size_t)nxt.pm * tstep : cA; const char* nB = has_next ? (const char*)g.Bt + (size_t)nxt.pn * tstep : cB;
        for (int t = 0; t < nt; t += 2) {
            const bool last = (t == nt - 2);
            const char* a1 = cA + (size_t)(t + 1) * kstep;
            const char* a2 = last ? nA : cA + (size_t)(t + 2) * kstep; const char* b2 = last ? nB : cB + (size_t)(t + 2) * kstep;
            const char* a3 = a2 + kstep; const char* b3 = b2 + kstep;
            if (last && has_next) S.a_ready(nxt);
            if constexpr (SP2) {
            PG8_LDB(B0, 0, 0); PG8_LDB(B1, 0, 1); PG8_SCHED; PG8_LDA(At, 0, 0); PG8_STAGE(PG8_SA(1, 1), a1 + hstep, voffA);
            PG8_WAIT_V(8); PG8_WAIT_L(0); PG8_BAR; PG8_MMA(0, 0, At, B0); PG8_MMA(0, 1, At, B1); PG8_BAR; PG8_SCHED;
            PG8_LDA(At, 0, 1); PG8_STAGE(PG8_SB(0, 0), b2, voffB); PG8_STAGE(PG8_SB(0, 1), b2 + hstep, voffB); PG8_STAGE(PG8_SA(0, 0), a2, voffA);
            PG8_WAIT_V(8); PG8_WAIT_L(0); PG8_BAR; PG8_MMA(1, 0, At, B0); PG8_MMA(1, 1, At, B1); PG8_BAR; PG8_SCHED;
            PG8_LDB(B0, 1, 0); PG8_LDB(B1, 1, 1); PG8_SCHED; PG8_LDA(At, 1, 0); PG8_STAGE(PG8_SA(0, 1), a2 + hstep, voffA);
            PG8_WAIT_V(8); PG8_WAIT_L(0); PG8_BAR; PG8_MMA(0, 0, At, B0); PG8_MMA(0, 1, At, B1); PG8_BAR; PG8_SCHED;
            PG8_LDA(At, 1, 1); PG8_STAGE(PG8_SB(1, 0), b3, voffB); PG8_STAGE(PG8_SB(1, 1), b3 + hstep, voffB); PG8_STAGE(PG8_SA(1, 0), a3, voffA);
            PG8_WAIT_V(8); PG8_WAIT_L(0); PG8_BAR; PG8_MMA(1, 0, At, B0); PG8_MMA(1, 1, At, B1); PG8_BAR; PG8_SCHED;
            } else {
            PG8_LDB(B0, 0, 0); PG8_SCHED; PG8_LDA(At, 0, 0); PG8_STAGE(PG8_SA(1, 1), a1 + hstep, voffA);
            PG8_WAIT_L(8); PG8_BAR; PG8_WAIT_L(0); PG8_MMA(0, 0, At, B0); PG8_BAR; PG8_SCHED;
            PG8_LDB(B1, 0, 1); PG8_STAGE(PG8_SB(0, 0), b2, voffB);
            PG8_BAR; PG8_WAIT_L(0); PG8_MMA(0, 1, At, B1); PG8_BAR;
            PG8_LDA(At, 0, 1); PG8_STAGE(PG8_SA(0, 0), a2, voffA);
            PG8_BAR; PG8_WAIT_L(0); PG8_MMA(1, 0, At, B0); PG8_BAR; PG8_SCHED;
            PG8_STAGE(PG8_SB(0, 1), b2 + hstep, voffB);
            PG8_WAIT_V(6); PG8_BAR; PG8_MMA(1, 1, At, B1); PG8_BAR;
            PG8_LDB(B0, 1, 0); PG8_SCHED; PG8_LDA(At, 1, 0); PG8_STAGE(PG8_SA(0, 1), a2 + hstep, voffA);
            PG8_WAIT_L(8); PG8_BAR; PG8_WAIT_L(0); PG8_MMA(0, 0, At, B0); PG8_BAR; PG8_SCHED;
            PG8_LDB(B1, 1, 1); PG8_STAGE(PG8_SB(1, 0), b3, voffB);
            PG8_BAR; PG8_WAIT_L(0); PG8_MMA(0, 1, At, B1); PG8_BAR;
            PG8_LDA(At, 1, 1); PG8_STAGE(PG8_SA(1, 0), a3, voffA);
            PG8_BAR; PG8_WAIT_L(0); PG8_MMA(1, 0, At, B0); PG8_BAR; PG8_SCHED;
            PG8_STAGE(PG8_SB(1, 1), b3 + hstep, voffB);
            PG8_WAIT_V(6); PG8_BAR; PG8_MMA(1, 1, At, B1); PG8_BAR;
            }
        }
        if constexpr (ALIGN_EPI) { if (wr == 0) PG8_BAR; }
        if constexpr (!Epi::AFTER_DRAIN) { E(acc, cur, wr, wc, fr, fq); S.done(cur); }
        if (!has_next) break;
#pragma unroll
        for (int a = 0; a < 2; ++a)
#pragma unroll
            for (int b = 0; b < 2; ++b)
#pragma unroll
                for (int m = 0; m < 4; ++m)
#pragma unroll
                    for (int n = 0; n < 2; ++n) acc[a][b][m][n] = (f32x4){0.f, 0.f, 0.f, 0.f};
        cur = nxt; cA = nA; cB = nB; ++ui;
        if constexpr (ALIGN_EPI) { if (wr == 1) PG8_BAR; }
    }
    PG8_WAIT_V(0);
    if constexpr (!ALIGN_EPI) { if (wr == 0) PG8_BAR; }
    PG8_BAR;
    if constexpr (Epi::AFTER_DRAIN) { E.fused(acc, cur, wr, wc, fr, fq, lds, wid, lane); S.done(cur); }
#undef PG8_SA
#undef PG8_SB
#undef PG8_STAGE
#undef PG8_LDA
#undef PG8_LDB
#undef PG8_MMA
#undef PG8_WAIT_V
#undef PG8_WAIT_L
#undef PG8_BAR
#undef PG8_SCHED
}
}
namespace cg = cooperative_groups;
using pg8::bf16_t; using pg8::bf16x8; using pg8::f32x4; using pg8::u32x4; using pg8::Unit; using pg8::cvt_pk_bf16;
typedef unsigned u32x2 __attribute__((ext_vector_type(2)));
#define LAS __attribute__((address_space(3)))
#define LDS_WAIT() asm volatile("s_waitcnt lgkmcnt(0)" ::: "memory")

constexpr int M_ = 16384, DM = 1024, SEQ = 4096, DFF = 2816, DIN = 6696, NINP = 6912;
constexpr float EPSN = 1e-6f;
constexpr float LOG2E = 1.4426950408889634f, LN2 = 0.6931471805599453f;
constexpr float C2 = 0.125f * LOG2E;

constexpr size_t MiB = (size_t)1 << 20;
constexpr size_t WS_WIN = 1 * MiB;
constexpr size_t WS_WB = WS_WIN + (size_t)NINP * 1024 * 2;
constexpr size_t WS_WOUT = WS_WB + 2 * MiB;
constexpr size_t WS_WGU = WS_WOUT + 2 * MiB;
constexpr size_t WS_WD = WS_WGU + 11 * MiB;
constexpr size_t WS_WP = WS_WD + (size_t)1024 * 2816 * 2;
constexpr size_t WS_WS = WS_WP + 32768;
static_assert(WS_WS + 131072 <= 36 * MiB, "weights region");
constexpr size_t WS_XN = 36 * MiB;
constexpr size_t WS_R1 = 68 * MiB;
constexpr size_t WS_G = WS_R1, WS_KA = WS_R1 + 64 * MiB, WS_VTA = WS_KA + 8 * MiB, WS_IQ = WS_VTA + 8 * MiB;
constexpr size_t WS_S = 156 * MiB;
constexpr size_t WS_PIN = WS_S, WS_GU = WS_S + 8 * MiB, WS_GV = WS_S + 16 * MiB, WS_SQ = WS_S + 24 * MiB, WS_SK = WS_S + 32 * MiB,
                 WS_VTS = WS_S + 40 * MiB, WS_QA = WS_S + 48 * MiB, WS_OB = WS_S + 56 * MiB, WS_MASK = 220 * MiB, WS_IK = 228 * MiB, WS_IW = 229 * MiB, WS_END = 230 * MiB;

__device__ __forceinline__ float bf2f(unsigned short v) { return __uint_as_float((unsigned)v << 16); }
__device__ __forceinline__ float bflo(unsigned v) { return __uint_as_float(v << 16); }
__device__ __forceinline__ float bfhi(unsigned v) { return __uint_as_float(v & 0xffff0000u); }
__device__ __forceinline__ unsigned short f2bf(float f) { return (unsigned short)(cvt_pk_bf16(f, 0.f) & 0xffffu); }
__device__ __forceinline__ float sigmoidf_(float x) { return __builtin_amdgcn_rcpf(1.f + __builtin_amdgcn_exp2f(-x * LOG2E)); }
__device__ __forceinline__ float gelu_tanh(float x) { const float u = 0.7978845608028654f * (x + 0.044715f * x * x * x); return x * __builtin_amdgcn_rcpf(1.f + __builtin_amdgcn_exp2f(-2.f * LOG2E * u)); }
__device__ __forceinline__ f32x4 mfma16(bf16x8 a, bf16x8 b, f32x4 c) { return __builtin_amdgcn_mfma_f32_16x16x32_bf16(a, b, c, 0, 0, 0); }
__device__ __forceinline__ bf16x8 mk8(unsigned a, unsigned b, unsigned c, unsigned d) { u32x4 v = {a, b, c, d}; return __builtin_bit_cast(bf16x8, v); }

struct EpiIn {
    static constexpr bool PERM = true, AFTER_DRAIN = false;
    unsigned char* ws; const float *qn, *kn;
    __device__ __forceinline__ void operator()(const f32x4 (&acc)[2][2][4][2], const Unit& u, int wr, int wc, int fr, int fq) const {
        bf16_t* const QA = (bf16_t*)(ws + WS_QA); bf16_t* const KA = (bf16_t*)(ws + WS_KA); bf16_t* const VTA = (bf16_t*)(ws + WS_VTA); bf16_t* const IQ = (bf16_t*)(ws + WS_IQ);
        bf16_t* const PIN = (bf16_t*)(ws + WS_PIN); bf16_t* const GU = (bf16_t*)(ws + WS_GU); bf16_t* const GV = (bf16_t*)(ws + WS_GV); bf16_t* const SQ = (bf16_t*)(ws + WS_SQ);
        bf16_t* const SK = (bf16_t*)(ws + WS_SK); bf16_t* const VTS = (bf16_t*)(ws + WS_VTS); bf16_t* const IK = (bf16_t*)(ws + WS_IK); float* const IW = (float*)(ws + WS_IW); unsigned char* const G = ws + WS_G;
        const int pn = u.pn; const int row0 = u.pm * 256 + wr * 64 + fr; const int cl = wc * 32 + 8 * fq;
        if (pn >= 11) {
            unsigned char* gp = G + (size_t)row0 * 4096 + (pn - 11) * 256 + cl;
#pragma unroll
            for (int ai = 0; ai < 2; ++ai)
#pragma unroll
                for (int m = 0; m < 4; ++m)
#pragma unroll
                    for (int bj = 0; bj < 2; ++bj) {
                        unsigned w2[2];
#pragma unroll
                        for (int n = 0; n < 2; ++n) { const f32x4 v = acc[ai][bj][m][n]; unsigned pk = 0;
#pragma unroll
                            for (int i = 0; i < 4; ++i) { const unsigned qv = (unsigned)(sigmoidf_(v[i]) * 255.f + 0.5f); pk |= qv << (8 * i); }
                            w2[n] = pk; }
                        *(u32x2*)(gp + (size_t)(ai * 128 + m * 16) * 4096 + bj * 128) = (u32x2){w2[0], w2[1]};
                    }
            return;
        }
        if (pn <= 1) {
            const float* gw = pn == 0 ? qn : kn; const float sc = pn == 0 ? C2 : 1.f; bf16_t* T = pn == 0 ? QA : KA;
            f32x4 gv[2][2];
#pragma unroll
            for (int bj = 0; bj < 2; ++bj)
#pragma unroll
                for (int n = 0; n < 2; ++n) gv[bj][n] = *(const f32x4*)(gw + bj * 32 + 8 * fq + 4 * n);
#pragma unroll
            for (int ai = 0; ai < 2; ++ai)
#pragma unroll
                for (int m = 0; m < 4; ++m) {
                    float ss = 0.f;
#pragma unroll
                    for (int bj = 0; bj < 2; ++bj)
#pragma unroll
                        for (int n = 0; n < 2; ++n) { const f32x4 v = acc[ai][bj][m][n]; ss += (v[0] * v[0] + v[1] * v[1]) + (v[2] * v[2] + v[3] * v[3]); }
                    ss += __shfl_xor(ss, 16); ss += __shfl_xor(ss, 32);
                    const float rinv = __builtin_amdgcn_rsqf(ss * (1.f / 64.f) + EPSN) * sc;
                    bf16_t* rp = T + (size_t)(row0 + ai * 128 + m * 16) * 256 + wc * 64 + 8 * fq;
#pragma unroll
                    for (int bj = 0; bj < 2; ++bj) { const f32x4 v0 = acc[ai][bj][m][0] * gv[bj][0] * rinv, v1 = acc[ai][bj][m][1] * gv[bj][1] * rinv;
                        u32x4 w; w.x = cvt_pk_bf16(v0[0], v0[1]); w.y = cvt_pk_bf16(v0[2], v0[3]); w.z = cvt_pk_bf16(v1[0], v1[1]); w.w = cvt_pk_bf16(v1[2], v1[3]);
                        *(u32x4*)(rp + bj * 32) = w; }
                }
            return;
        }
        if (pn == 2 || pn == 9) {
            bf16_t* T = pn == 2 ? VTA : VTS;
#pragma unroll
            for (int ai = 0; ai < 2; ++ai)
#pragma unroll
                for (int m = 0; m < 4; ++m) { const int row = row0 + ai * 128 + m * 16; const int b = row >> 12, t = row & 4095;
#pragma unroll
                    for (int bj = 0; bj < 2; ++bj)
#pragma unroll
                        for (int n = 0; n < 2; ++n) { const f32x4 v = acc[ai][bj][m][n];
#pragma unroll
                            for (int i = 0; i < 4; ++i) T[((size_t)b * 256 + bj * 128 + cl + 4 * n + i) * 4096 + t] = f2bf(v[i]); }
                }
            return;
        }
        if (pn == 10) {
            if (wc == 0) {
#pragma unroll
                for (int ai = 0; ai < 2; ++ai)
#pragma unroll
                    for (int m = 0; m < 4; ++m) { const f32x4 v0 = acc[ai][0][m][0], v1 = acc[ai][0][m][1];
                        u32x4 w; w.x = cvt_pk_bf16(v0[0], v0[1]); w.y = cvt_pk_bf16(v0[2], v0[3]); w.z = cvt_pk_bf16(v1[0], v1[1]); w.w = cvt_pk_bf16(v1[2], v1[3]);
                        *(u32x4*)(IK + (size_t)(row0 + ai * 128 + m * 16) * 32 + 8 * fq) = w; }
            } else if (wc == 1 && fq == 0) {
#pragma unroll
                for (int ai = 0; ai < 2; ++ai)
#pragma unroll
                    for (int m = 0; m < 4; ++m) { float* p = IW + (size_t)(row0 + ai * 128 + m * 16) * 8; *(f32x4*)p = acc[ai][0][m][0]; *(f32x4*)(p + 4) = acc[ai][0][m][1]; }
            }
            return;
        }
        {
            bf16_t* T = pn == 3 ? IQ : pn == 4 ? PIN : pn == 5 ? GU : pn == 6 ? GV : pn == 7 ? SQ : SK;
            const bool act = (pn == 5 || pn == 6); const float sc = pn == 7 ? 0.125f : 1.f;
#pragma unroll
            for (int ai = 0; ai < 2; ++ai)
#pragma unroll
                for (int m = 0; m < 4; ++m) { bf16_t* rp = T + (size_t)(row0 + ai * 128 + m * 16) * 256 + cl;
#pragma unroll
                    for (int bj = 0; bj < 2; ++bj) { f32x4 v0 = acc[ai][bj][m][0] * sc, v1 = acc[ai][bj][m][1] * sc;
                        if (act) {
#pragma unroll
                            for (int i = 0; i < 4; ++i) { v0[i] = gelu_tanh(v0[i]); v1[i] = gelu_tanh(v1[i]); } }
                        u32x4 w; w.x = cvt_pk_bf16(v0[0], v0[1]); w.y = cvt_pk_bf16(v0[2], v0[3]); w.z = cvt_pk_bf16(v1[0], v1[1]); w.w = cvt_pk_bf16(v1[2], v1[3]);
                        *(u32x4*)(rp + bj * 128) = w; }
                }
        }
    }
};

struct EpiMerge {
    static constexpr bool PERM = true, AFTER_DRAIN = false;
    const unsigned char* G; bf16_t* MG; int nb;
    __device__ __forceinline__ void operator()(const f32x4 (&acc)[2][2][4][2], const Unit& u, int wr, int wc, int fr, int fq) const {
        const int row0 = u.pm * 256 + wr * 64 + fr; const int col0 = u.pn * 256 + wc * 32 + 8 * fq;
        const unsigned char* gp0 = G + (size_t)row0 * 4096 + nb * 1024 + col0; bf16_t* mp0 = MG + (size_t)row0 * 1024 + col0;
#pragma unroll
        for (int ai = 0; ai < 2; ++ai)
#pragma unroll
            for (int m = 0; m < 4; ++m) {
#pragma unroll
                for (int bj = 0; bj < 2; ++bj)
#pragma unroll
                    for (int n = 0; n < 2; ++n) {
                        const size_t ro = (size_t)(ai * 128 + m * 16);
                        const unsigned gb = *(const unsigned*)(gp0 + ro * 4096 + bj * 128 + 4 * n);
                        f32x4 v = acc[ai][bj][m][n];
#pragma unroll
                        for (int i = 0; i < 4; ++i) v[i] *= (float)((gb >> (8 * i)) & 255u) * (1.f / 255.f);
                        bf16_t* mp = mp0 + ro * 1024 + bj * 128 + 4 * n;
                        if (nb > 0) { const u32x2 o = *(const u32x2*)mp; v[0] += bflo(o.x); v[1] += bfhi(o.x); v[2] += bflo(o.y); v[3] += bfhi(o.y); }
                        *(u32x2*)mp = (u32x2){cvt_pk_bf16(v[0], v[1]), cvt_pk_bf16(v[2], v[3])};
                    }
                asm volatile("" ::: "memory"); }
    }
};

struct EpiResid {
    static constexpr bool PERM = true, AFTER_DRAIN = false;
    const float* base; float* out;
    __device__ __forceinline__ void operator()(const f32x4 (&acc)[2][2][4][2], const Unit& u, int wr, int wc, int fr, int fq) const {
        const int row0 = u.pm * 256 + wr * 64 + fr; const int col0 = u.pn * 256 + wc * 32 + 8 * fq;
#pragma unroll
        for (int ai = 0; ai < 2; ++ai)
#pragma unroll
            for (int m = 0; m < 4; ++m) { const size_t off = (size_t)(row0 + ai * 128 + m * 16) * 1024 + col0;
#pragma unroll
                for (int bj = 0; bj < 2; ++bj) { const f32x4 b0 = *(const f32x4*)(base + off + bj * 128), b1 = *(const f32x4*)(base + off + bj * 128 + 4);
                    *(f32x4*)(out + off + bj * 128) = b0 + acc[ai][bj][m][0]; *(f32x4*)(out + off + bj * 128 + 4) = b1 + acc[ai][bj][m][1]; }
                asm volatile("" ::: "memory"); }
    }
};

struct EpiSwiGLU {
    static constexpr bool PERM = true, AFTER_DRAIN = false;
    bf16_t* ACT;
    __device__ __forceinline__ void operator()(const f32x4 (&acc)[2][2][4][2], const Unit& u, int wr, int wc, int fr, int fq) const {
        const int row0 = u.pm * 256 + wr * 64 + fr; const int f0 = u.pn * 128 + wc * 32 + 8 * fq;
#pragma unroll
        for (int ai = 0; ai < 2; ++ai)
#pragma unroll
            for (int m = 0; m < 4; ++m) { f32x4 r[2];
#pragma unroll
                for (int n = 0; n < 2; ++n) { const f32x4 g = acc[ai][0][m][n], up = acc[ai][1][m][n];
#pragma unroll
                    for (int i = 0; i < 4; ++i) r[n][i] = g[i] * sigmoidf_(g[i]) * up[i]; }
                u32x4 w; w.x = cvt_pk_bf16(r[0][0], r[0][1]); w.y = cvt_pk_bf16(r[0][2], r[0][3]); w.z = cvt_pk_bf16(r[1][0], r[1][1]); w.w = cvt_pk_bf16(r[1][2], r[1][3]);
                *(u32x4*)(ACT + (size_t)(row0 + ai * 128 + m * 16) * DFF + f0) = w; }
    }
};

__device__ __forceinline__ void cvt_item(const float* src, int ld, int col0, int nvalid, int K, bf16_t* WT, int dst_row0, int kb, LAS float* scr, int lane) {
    const int k0 = 64 * kb, c = lane & 31;
#pragma unroll 8
    for (int i = 0; i < 32; ++i) { const int kk = 2 * i + (lane >> 5); float v = 0.f; if (c < nvalid) v = src[(size_t)(k0 + kk) * ld + col0 + c]; scr[kk * 33 + c] = v; }
    LDS_WAIT();
    const int c8 = lane & 7;
#pragma unroll
    for (int j = 0; j < 4; ++j) { const int n = (lane >> 3) + 8 * j; const LAS float* s = scr + (8 * c8) * 33 + n;
        u32x4 o; o.x = cvt_pk_bf16(s[0 * 33], s[1 * 33]); o.y = cvt_pk_bf16(s[2 * 33], s[3 * 33]); o.z = cvt_pk_bf16(s[4 * 33], s[5 * 33]); o.w = cvt_pk_bf16(s[6 * 33], s[7 * 33]);
        *(u32x4*)(WT + (size_t)(dst_row0 + n) * K + k0 + 8 * c8) = o; }
    LDS_WAIT();
}
__device__ __forceinline__ float wave_sum(float v) {
#pragma unroll
    for (int o = 1; o < 64; o <<= 1) v += __shfl_xor(v, o);
    return v;
}
__device__ __forceinline__ float wave_max(float v) {
#pragma unroll
    for (int o = 1; o < 64; o <<= 1) v = fmaxf(v, __shfl_xor(v, o));
    return v;
}
__device__ __forceinline__ void rmsnorm_rows(const float* xs, const float* gamma, bf16_t* XN, int gw, int ngw, int lane) {
    f32x4 gm[4];
#pragma unroll
    for (int j = 0; j < 4; ++j) gm[j] = *(const f32x4*)(gamma + 4 * lane + 256 * j);
    for (int m = gw; m < M_; m += ngw) {
        const f32x4* xr = (const f32x4*)(xs + (size_t)m * DM) + lane; f32x4 v[4]; float s = 0.f;
#pragma unroll
        for (int j = 0; j < 4; ++j) { v[j] = xr[64 * j]; s += (v[j].x * v[j].x + v[j].y * v[j].y) + (v[j].z * v[j].z + v[j].w * v[j].w); }
        const float r = __builtin_amdgcn_rsqf(wave_sum(s) * (1.f / DM) + EPSN);
        u32x2* o8 = (u32x2*)(XN + (size_t)m * DM) + lane;
#pragma unroll
        for (int j = 0; j < 4; ++j) { const f32x4 y = v[j] * r * gm[j]; o8[64 * j] = (u32x2){cvt_pk_bf16(y.x, y.y), cvt_pk_bf16(y.z, y.w)}; }
    }
}

struct Ptrs {
    const float *w_in, *qn, *kn, *pool_w, *pool_scale, *gm_norm, *gm_ws, *gm_b, *w_branch, *w_out, *w_gate, *w_up, *w_down;
};

__device__ __forceinline__ void convert_weights(const Ptrs& P, unsigned char* ws, LAS float* scr, int gw, int ngw, int lane, int gtid, int ngt) {
    bf16_t* WinT = (bf16_t*)(ws + WS_WIN); bf16_t* WbT = (bf16_t*)(ws + WS_WB); bf16_t* WoutT = (bf16_t*)(ws + WS_WOUT); bf16_t* WguT = (bf16_t*)(ws + WS_WGU);
    bf16_t* WdT = (bf16_t*)(ws + WS_WD); bf16_t* WpT = (bf16_t*)(ws + WS_WP); bf16_t* Wtril = (bf16_t*)(ws + WS_WS);
    constexpr int I_A = 216 * 16, I_B = 512, I_C = 512, I_D = 176 * 16, I_E = 32 * 44, I_F = 8, NIT = I_A + I_B + I_C + I_D + I_E + I_F;
    for (int it = gw; it < NIT; it += ngw) {
        int r = it;
        if (r < I_A) { const int rb = r >> 4, kb = r & 15, tile = rb >> 3, sub = rb & 7; int col0, nv = 32;
            if (tile <= 1) col0 = tile * 256 + (sub & 3) * 64 + (sub >> 2) * 32;
            else if (tile == 2) col0 = 512 + sub * 32;
            else if (tile == 3) col0 = 768 + sub * 32;
            else if (tile <= 9) col0 = 1064 + (tile - 4) * 256 + sub * 32;
            else if (tile == 10) { col0 = sub == 0 ? 1024 : 1056; nv = sub == 0 ? 32 : (sub == 1 ? 8 : 0); }
            else col0 = 2600 + (tile - 11) * 256 + sub * 32;
            cvt_item(P.w_in, DIN, col0, nv, 1024, WinT, rb * 32, kb, scr, lane); continue; }
        r -= I_A;
        if (r < I_B) { const int n = r >> 7, q = r & 127, rb = q >> 2, kb = q & 3;
            cvt_item(P.w_branch + (size_t)n * 256 * 1024, 1024, rb * 32, 32, 256, WbT + (size_t)n * 1024 * 256, rb * 32, kb, scr, lane); continue; }
        r -= I_B;
        if (r < I_C) { const int rb = r >> 4, kb = r & 15; cvt_item(P.w_out, 1024, rb * 32, 32, 1024, WoutT, rb * 32, kb, scr, lane); continue; }
        r -= I_C;
        if (r < I_D) { const int rb = r >> 4, kb = r & 15, tile = rb >> 3, sub = rb & 7;
            cvt_item((sub >> 2) ? P.w_up : P.w_gate, DFF, tile * 128 + (sub & 3) * 32, 32, 1024, WguT, rb * 32, kb, scr, lane); continue; }
        r -= I_D;
        if (r < I_E) { const int rb = r / 44, kb = r % 44; cvt_item(P.w_down, 1024, rb * 32, 32, DFF, WdT, rb * 32, kb, scr, lane); continue; }
        r -= I_E;
        { const int gp = r >> 1, rb = r & 1; cvt_item(P.pool_w + gp * 4096, 64, rb * 32, 32, 64, WpT + gp * 4096, rb * 32, 0, scr, lane); }
    }
    for (int e = gtid; e < 4 * 128 * 128; e += ngt) { const int s = e & 127, t = (e >> 7) & 127; Wtril[e] = (s <= t) ? f2bf(P.gm_ws[e]) : (unsigned short)0; }
}

__device__ __forceinline__ unsigned mono_key(float s) { const unsigned b = __float_as_uint(s); return b ^ ((unsigned)((int)b >> 31) | 0x80000000u); }

__device__ __forceinline__ void phase_a1(unsigned char* lds, const bf16_t* IQ, const bf16_t* IK, const float* IW, unsigned short* MASK, int tid, int bid, int G) {
    const int lane = tid & 63, w = __builtin_amdgcn_readfirstlane(tid >> 6), q = lane & 15, g = lane >> 4;
    unsigned* red = (unsigned*)lds;
    for (int L = bid; L < 1024; L += G) {
        const int b = L >> 8, c = L & 255, qg = (b & 1) ? 255 - c : c;
        const int row0 = b * SEQ + qg * 16;
        unsigned short* mrow = MASK + (size_t)(row0 + q) * 256;
        if (qg <= 15) {
#pragma unroll
            for (int i = 0; i < 2; ++i) { const int kt = 8 * i + w; if (kt <= qg && g == 0) mrow[kt] = (kt < qg) ? (unsigned short)0xFFFFu : (unsigned short)((2u << q) - 1u); }
            continue;
        }
        bf16x8 iqf[8]; float wv[8];
#pragma unroll
        for (int h = 0; h < 8; ++h) iqf[h] = *(const bf16x8*)(IQ + (size_t)(row0 + q) * 256 + h * 32 + 8 * g);
        { const f32x4 a = *(const f32x4*)(IW + (size_t)(row0 + q) * 8), bq = *(const f32x4*)(IW + (size_t)(row0 + q) * 8 + 4);
          wv[0] = a[0]; wv[1] = a[1]; wv[2] = a[2]; wv[3] = a[3]; wv[4] = bq[0]; wv[5] = bq[1]; wv[6] = bq[2]; wv[7] = bq[3]; }
        unsigned u[128];
#pragma unroll
        for (int i = 0; i < 32; ++i) {
            const int kt = 8 * i + w;
            if (kt <= qg) {
                const bf16x8 kf = *(const bf16x8*)(IK + (size_t)(b * SEQ + kt * 16 + q) * 32 + 8 * g);
                f32x4 s = {0.f, 0.f, 0.f, 0.f};
#pragma unroll
                for (int h = 0; h < 8; ++h) { const f32x4 a = mfma16(kf, iqf[h], (f32x4){0.f, 0.f, 0.f, 0.f});
#pragma unroll
                    for (int j = 0; j < 4; ++j) s[j] = __builtin_fmaf(wv[h], fmaxf(a[j], 0.f), s[j]); }
#pragma unroll
                for (int j = 0; j < 4; ++j) { unsigned uu = mono_key(s[j]); if (kt == qg && (4 * g + j) > q) uu = 0u; u[4 * i + j] = uu; }
            } else {
#pragma unroll
                for (int j = 0; j < 4; ++j) u[4 * i + j] = 0u;
            }
        }
        const int nact = (qg >= w) ? ((qg - w) >> 3) + 1 : 0;
        unsigned prefix = 0u;
#pragma unroll 1
        for (int bit = 31; bit >= 0; --bit) {
            const unsigned cand = prefix | (1u << bit);
            unsigned cnt = 0u;
#pragma unroll
            for (int blk = 0; blk < 4; ++blk) {
                if (nact > blk * 8) {
#pragma unroll
                    for (int r = 0; r < 32; ++r) cnt += (u[blk * 32 + r] >= cand) ? 1u : 0u;
                }
            }
            cnt += __shfl_xor(cnt, 16); cnt += __shfl_xor(cnt, 32);
            unsigned* rs = red + (bit & 1) * 128;
            if (g == 0) rs[w * 16 + q] = cnt;
            __syncthreads();
            unsigned tot = 0u;
#pragma unroll
            for (int ww = 0; ww < 8; ++ww) tot += rs[ww * 16 + q];
            if (tot >= 256u) prefix = cand;
        }
        const unsigned thr = prefix > 1u ? prefix : 1u;
#pragma unroll
        for (int i = 0; i < 32; ++i) {
            const int kt = 8 * i + w;
            if (kt <= qg) {
                unsigned nib = 0u;
#pragma unroll
                for (int j = 0; j < 4; ++j) nib |= (u[4 * i + j] >= thr ? 1u : 0u) << j;
                unsigned wd = nib << (4 * g); wd |= __shfl_xor(wd, 16); wd |= __shfl_xor(wd, 32);
                if (g == 0) mrow[kt] = (unsigned short)wd;
            }
        }
    }
}

__device__ __forceinline__ void phase_a2(unsigned char* lds, bf16_t* QA  , const bf16_t* KA, const bf16_t* VTA, const unsigned short* MASK,
                                         const float* qn, const float* kn, int tid, int bid, int G) {
    const int lane = tid & 63, w = __builtin_amdgcn_readfirstlane(tid >> 6), q = lane & 15, g = lane >> 4;
    bf16_t* Kt = (bf16_t*)lds;
    bf16_t* Vt = (bf16_t*)(lds + 2 * 64 * 72 * 2);
    const float msh = LOG2E * 8.f * wave_max(fabsf(qn[lane])) * wave_max(fabsf(kn[lane])) * 1.02f + 0.25f;
    const int srow = tid >> 3, sch = tid & 7;
    for (int L = bid; L < 512; L += G) {
        const int jj = L >> 8, c = L & 255, bh = c >> 4, qb = jj ? 31 - (c & 15) : (c & 15);
        const int b = bh >> 2, h = bh & 3;
        const int qgw = qb * 8 + w;
        const int row0 = b * SEQ + qb * 128 + 16 * w;
        bf16x8 qf[2];
#pragma unroll
        for (int hf = 0; hf < 2; ++hf) qf[hf] = *(const bf16x8*)(QA + (size_t)(row0 + q) * 256 + h * 64 + hf * 32 + 8 * g);
        const unsigned short* mrow = MASK + (size_t)(row0 + q) * 256;
        const int nsteps = 2 * qb + 2;
        const bf16_t* ksrc = KA + (size_t)(b * SEQ + srow) * 256 + h * 64 + sch * 8;
        const bf16_t* vsrc = VTA + (size_t)(b * 256 + h * 64 + srow) * SEQ + sch * 8;
        u32x4 kreg = *(const u32x4*)ksrc, vreg = *(const u32x4*)vsrc;
        *(u32x4*)(Kt + srow * 72 + sch * 8) = kreg; *(u32x4*)(Vt + srow * 72 + sch * 8) = vreg;
        u32x2 mcur = *(const u32x2*)mrow, mnext = mcur;
        f32x4 o[4]; float lsum = 0.f;
#pragma unroll
        for (int d = 0; d < 4; ++d) o[d] = (f32x4){0.f, 0.f, 0.f, 0.f};
        __syncthreads();
        for (int st = 0; st < nsteps; ++st) {
            const int buf = st & 1; const bool more = st + 1 < nsteps;
            if (more) { kreg = *(const u32x4*)(ksrc + (size_t)(st + 1) * 64 * 256); vreg = *(const u32x4*)(vsrc + (st + 1) * 64); mnext = *(const u32x2*)(mrow + (st + 1) * 4); }
            const bf16_t* kb_ = Kt + buf * 64 * 72; const bf16_t* vb_ = Vt + buf * 64 * 72;
#pragma unroll
            for (int p = 0; p < 2; ++p) {
                const int kt0 = st * 4 + 2 * p;
                if (kt0 <= qgw) {
                    const unsigned mw = p ? mcur.y : mcur.x;
                    const unsigned nib0 = (mw >> (4 * g)) & 15u, nib1 = (kt0 + 1 <= qgw) ? ((mw >> (16 + 4 * g)) & 15u) : 0u;
                    const bf16_t* kr0 = kb_ + (p * 32 + q) * 72 + 8 * g; const bf16_t* kr1 = kr0 + 16 * 72;
                    f32x4 a0 = mfma16(*(const bf16x8*)kr0, qf[0], (f32x4){0.f, 0.f, 0.f, 0.f}); a0 = mfma16(*(const bf16x8*)(kr0 + 32), qf[1], a0);
                    f32x4 a1 = mfma16(*(const bf16x8*)kr1, qf[0], (f32x4){0.f, 0.f, 0.f, 0.f}); a1 = mfma16(*(const bf16x8*)(kr1 + 32), qf[1], a1);
                    float p0[4], p1[4];
#pragma unroll
                    for (int j = 0; j < 4; ++j) { p0[j] = ((nib0 >> j) & 1u) ? __builtin_amdgcn_exp2f(a0[j] - msh) : 0.f; p1[j] = ((nib1 >> j) & 1u) ? __builtin_amdgcn_exp2f(a1[j] - msh) : 0.f; }
                    lsum += ((p0[0] + p0[1]) + (p0[2] + p0[3])) + ((p1[0] + p1[1]) + (p1[2] + p1[3]));
                    const bf16x8 pf = mk8(cvt_pk_bf16(p0[0], p0[1]), cvt_pk_bf16(p0[2], p0[3]), cvt_pk_bf16(p1[0], p1[1]), cvt_pk_bf16(p1[2], p1[3]));
#pragma unroll
                    for (int d = 0; d < 4; ++d) { const bf16_t* vr = vb_ + (d * 16 + q) * 72 + p * 32 + 4 * g;
                        const u32x2 lo = *(const u32x2*)vr, hi = *(const u32x2*)(vr + 16);
                        o[d] = mfma16(mk8(lo.x, lo.y, hi.x, hi.y), pf, o[d]); }
                }
            }
            if (more) { *(u32x4*)(Kt + (buf ^ 1) * 64 * 72 + srow * 72 + sch * 8) = kreg; *(u32x4*)(Vt + (buf ^ 1) * 64 * 72 + srow * 72 + sch * 8) = vreg; }
            __syncthreads();
            mcur = mnext;
        }
        lsum += __shfl_xor(lsum, 16); lsum += __shfl_xor(lsum, 32);
        const float inv = 1.f / lsum;
#pragma unroll
        for (int d = 0; d < 4; ++d) { const f32x4 v = o[d] * inv;
            *(u32x2*)(QA + (size_t)(row0 + q) * 256 + h * 64 + d * 16 + 4 * g) = (u32x2){cvt_pk_bf16(v[0], v[1]), cvt_pk_bf16(v[2], v[3])}; }
    }
}

__device__ __forceinline__ void phase_b(const bf16_t* PIN, const bf16_t* WpT, const float* pscale, bf16_t* OB, int gw, int ngw, int lane) {
    const int q = lane & 15, g4 = lane >> 4;
    for (int L = gw; L < 4096; L += ngw) {
        const int gp = L & 3, tg = L >> 2; const int row = tg * 16 + q; const int t = row & (SEQ - 1);
        const int win = 2 << gp; const int cnt = (t + 1 < win) ? t + 1 : win; const float inv = 1.f / (float)cnt;
        f32x4 acc[4];
#pragma unroll
        for (int d = 0; d < 4; ++d) acc[d] = (f32x4){0.f, 0.f, 0.f, 0.f};
#pragma unroll
        for (int ch = 0; ch < 2; ++ch) {
            const bf16_t* p = PIN + (size_t)row * 256 + gp * 64 + ch * 32 + 8 * g4;
            const u32x4 ov = *(const u32x4*)p;
            float own[8], sum[8];
            own[0] = bflo(ov.x); own[1] = bfhi(ov.x); own[2] = bflo(ov.y); own[3] = bfhi(ov.y); own[4] = bflo(ov.z); own[5] = bfhi(ov.z); own[6] = bflo(ov.w); own[7] = bfhi(ov.w);
#pragma unroll
            for (int k = 0; k < 8; ++k) sum[k] = own[k];
            for (int i = 1; i < win; ++i) {
                if (i <= t) { const u32x4 v = *(const u32x4*)(p - (size_t)i * 256);
                    sum[0] += bflo(v.x); sum[1] += bfhi(v.x); sum[2] += bflo(v.y); sum[3] += bfhi(v.y); sum[4] += bflo(v.z); sum[5] += bfhi(v.z); sum[6] += bflo(v.w); sum[7] += bfhi(v.w); }
            }
            float pl[8];
#pragma unroll
            for (int k = 0; k < 8; ++k) pl[k] = sum[k] * inv - own[k];
            const bf16x8 bfr = mk8(cvt_pk_bf16(pl[0], pl[1]), cvt_pk_bf16(pl[2], pl[3]), cvt_pk_bf16(pl[4], pl[5]), cvt_pk_bf16(pl[6], pl[7]));
#pragma unroll
            for (int d = 0; d < 4; ++d) { const bf16x8 afr = *(const bf16x8*)(WpT + gp * 4096 + (d * 16 + q) * 64 + ch * 32 + 8 * g4); acc[d] = mfma16(afr, bfr, acc[d]); }
        }
#pragma unroll
        for (int d = 0; d < 4; ++d) { const int d0 = d * 16 + 4 * g4; const f32x4 sc = *(const f32x4*)(pscale + gp * 64 + d0); const f32x4 v = acc[d] * sc;
            *(u32x2*)(OB + (size_t)row * 256 + gp * 64 + d0) = (u32x2){cvt_pk_bf16(v[0], v[1]), cvt_pk_bf16(v[2], v[3])}; }
    }
}

__device__ __forceinline__ void phase_c(unsigned char* lds, const bf16_t* GV, bf16_t* GU, const float* gamma, const bf16_t* Wtril, const float* gbias, int tid, int bid, int G) {
    bf16_t* LT = (bf16_t*)lds;
    const int lane = tid & 63, w = __builtin_amdgcn_readfirstlane(tid >> 6), q = lane & 15, g4 = lane >> 4;
    for (int L = bid; L < 512; L += G) {
        const int gp = L & 3, chk = L >> 2; const int R0 = chk * 128;
        {
            const int row = tid >> 2, part = tid & 3;
            const bf16_t* src = GV + (size_t)(R0 + row) * 256 + part * 64;
            float x[64];
#pragma unroll
            for (int k8 = 0; k8 < 8; ++k8) { const u32x4 v = *(const u32x4*)(src + 8 * k8);
                x[8 * k8 + 0] = bflo(v.x); x[8 * k8 + 1] = bfhi(v.x); x[8 * k8 + 2] = bflo(v.y); x[8 * k8 + 3] = bfhi(v.y); x[8 * k8 + 4] = bflo(v.z); x[8 * k8 + 5] = bfhi(v.z); x[8 * k8 + 6] = bflo(v.w); x[8 * k8 + 7] = bfhi(v.w); }
            float s = 0.f;
#pragma unroll
            for (int k = 0; k < 64; ++k) s += x[k];
            s += __shfl_xor(s, 1); s += __shfl_xor(s, 2);
            const float mean = s * (1.f / 256.f); float ss = 0.f;
#pragma unroll
            for (int k = 0; k < 64; ++k) { const float dd = x[k] - mean; ss += dd * dd; }
            ss += __shfl_xor(ss, 1); ss += __shfl_xor(ss, 2);
            const float rstd = __builtin_amdgcn_rsqf(ss * (1.f / 256.f) + EPSN);
            if (part == gp) {
#pragma unroll
                for (int k4 = 0; k4 < 16; ++k4) { const f32x4 gm = *(const f32x4*)(gamma + gp * 64 + 4 * k4);
#pragma unroll
                    for (int i = 0; i < 4; ++i) LT[(4 * k4 + i) * 136 + row] = f2bf((x[4 * k4 + i] - mean) * rstd * gm[i]); }
            }
        }
        __syncthreads();
        {
            f32x4 acc[4];
#pragma unroll
            for (int d = 0; d < 4; ++d) acc[d] = (f32x4){0.f, 0.f, 0.f, 0.f};
            const int t = 16 * w + q; const int nsb = ((16 * w + 15) >> 5) + 1;
            for (int sb = 0; sb < nsb; ++sb) {
                const bf16x8 bfr = *(const bf16x8*)(Wtril + ((size_t)gp * 128 + t) * 128 + sb * 32 + 8 * g4);
#pragma unroll
                for (int d = 0; d < 4; ++d) { const bf16x8 afr = *(const bf16x8*)(LT + (d * 16 + q) * 136 + sb * 32 + 8 * g4); acc[d] = mfma16(afr, bfr, acc[d]); }
            }
            const float bias = gbias[gp * 128 + t];
#pragma unroll
            for (int d = 0; d < 4; ++d) { bf16_t* up = GU + (size_t)(R0 + t) * 256 + gp * 64 + d * 16 + 4 * g4; const u32x2 uu = *(const u32x2*)up;
                const float r0 = bflo(uu.x) * (acc[d][0] + bias), r1 = bfhi(uu.x) * (acc[d][1] + bias), r2 = bflo(uu.y) * (acc[d][2] + bias), r3 = bfhi(uu.y) * (acc[d][3] + bias);
                *(u32x2*)up = (u32x2){cvt_pk_bf16(r0, r1), cvt_pk_bf16(r2, r3)}; }
        }
        __syncthreads();
    }
}

__device__ __forceinline__ void sb_tile(const f32x4 z, int kbase, int tq, int g, float& carry, float (&a)[4]) {
    float lm[4]; bool msk[4];
#pragma unroll
    for (int j = 0; j < 4; ++j) { msk[j] = (kbase + 4 * g + j) >= tq;
        const float e = __builtin_amdgcn_exp2f(-fabsf(z[j]) * LOG2E); const float sp = fmaxf(z[j], 0.f) + __builtin_amdgcn_logf(1.f + e) * LN2;
        lm[j] = msk[j] ? 0.f : -sp; }
    const float suf2 = lm[3], suf1 = lm[3] + lm[2], suf0 = suf1 + lm[1]; const float T = suf0 + lm[0];
    const float x16 = __shfl_xor(T, 16); const float Pp = T + x16; const float Qq = __shfl_xor(Pp, 32);
    const float Sg = ((g & 1) ? 0.f : x16) + ((g & 2) ? 0.f : Qq);
    const float base = carry + Sg;
    const float tl[4] = {base + suf0, base + suf1, base + suf2, base};
#pragma unroll
    for (int j = 0; j < 4; ++j) a[j] = msk[j] ? 0.f : __builtin_amdgcn_exp2f((z[j] + lm[j] + tl[j]) * LOG2E);
    carry += Pp + Qq;
}
__device__ __forceinline__ void phase_d(bf16_t* SQ, const bf16_t* SK, const bf16_t* VTS, int gw, int ngw, int lane) {
    const int q = lane & 15, g = lane >> 4;
    for (int L = gw; L < 4096; L += ngw) {
        const int qg = L & 255, bh = L >> 8, b = bh >> 2, h = bh & 3;
        const int row0 = b * SEQ + qg * 16; const int tq = qg * 16 + q;
        bf16x8 qf[2];
#pragma unroll
        for (int hf = 0; hf < 2; ++hf) qf[hf] = *(const bf16x8*)(SQ + (size_t)(row0 + q) * 256 + h * 64 + hf * 32 + 8 * g);
        f32x4 o[4];
#pragma unroll
        for (int d = 0; d < 4; ++d) o[d] = (f32x4){0.f, 0.f, 0.f, 0.f};
        float carry = 0.f;
        for (int pp = qg >> 1; pp >= 0; --pp) {
            const int kt0 = 2 * pp, kt1 = kt0 + 1;
            float a0[4], a1[4];
            if (kt1 <= qg) {
                const bf16_t* kr = SK + (size_t)(b * SEQ + kt1 * 16 + q) * 256 + h * 64 + 8 * g;
                f32x4 z = mfma16(*(const bf16x8*)kr, qf[0], (f32x4){0.f, 0.f, 0.f, 0.f}); z = mfma16(*(const bf16x8*)(kr + 32), qf[1], z);
                sb_tile(z, kt1 * 16, tq, g, carry, a1);
            } else {
#pragma unroll
                for (int j = 0; j < 4; ++j) a1[j] = 0.f;
            }
            {
                const bf16_t* kr = SK + (size_t)(b * SEQ + kt0 * 16 + q) * 256 + h * 64 + 8 * g;
                f32x4 z = mfma16(*(const bf16x8*)kr, qf[0], (f32x4){0.f, 0.f, 0.f, 0.f}); z = mfma16(*(const bf16x8*)(kr + 32), qf[1], z);
                sb_tile(z, kt0 * 16, tq, g, carry, a0);
            }
            const bf16x8 pf = mk8(cvt_pk_bf16(a0[0], a0[1]), cvt_pk_bf16(a0[2], a0[3]), cvt_pk_bf16(a1[0], a1[1]), cvt_pk_bf16(a1[2], a1[3]));
#pragma unroll
            for (int d = 0; d < 4; ++d) { const bf16_t* vr = VTS + (size_t)(b * 256 + h * 64 + d * 16 + q) * SEQ + kt0 * 16 + 4 * g;
                const u32x2 lo = *(const u32x2*)vr, hi = *(const u32x2*)(vr + 16);
                o[d] = mfma16(mk8(lo.x, lo.y, hi.x, hi.y), pf, o[d]); }
            if (__all(carry < -104.f)) break;
        }
#pragma unroll
        for (int d = 0; d < 4; ++d) *(u32x2*)(SQ + (size_t)(row0 + q) * 256 + h * 64 + d * 16 + 4 * g) = (u32x2){cvt_pk_bf16(o[d][0], o[d][1]), cvt_pk_bf16(o[d][2], o[d][3])};
    }
}

struct Args { const float* in[16]; float* out; unsigned char* ws; };
constexpr int LDS_BYTES = 147456;
__device__ __forceinline__ unsigned char* opq(unsigned char* p) { asm volatile("" : "+s"(p)); return p; }
__device__ __forceinline__ int opq_tid() { int t = threadIdx.x; asm volatile("" : "+v"(t)); return t; }
#define WSB(T, off) ((T*)(ws + (off)))
constexpr int PTAB_OFF = 131072 + 4096;
__device__ __forceinline__ void* ldp(PG8_LAS unsigned char* ldsl, int i) {
    unsigned off = PTAB_OFF + 8 * i; asm volatile("" : "+v"(off));
    const unsigned long long v = *(volatile LAS unsigned long long*)(ldsl + off);
    const unsigned lo = __builtin_amdgcn_readfirstlane((unsigned)v), hi = __builtin_amdgcn_readfirstlane((unsigned)(v >> 32));
    return (void*)(((unsigned long long)hi << 32) | lo);
}

__global__ void __launch_bounds__(512, 2) fwd_kernel(Args a) {
    extern __shared__ __attribute__((aligned(16))) unsigned char lds[];
    cg::grid_group grid = cg::this_grid();
    PG8_LAS unsigned char* ldsl = (PG8_LAS unsigned char*)lds;
    if (threadIdx.x == 0) { LAS unsigned long long* tb = (LAS unsigned long long*)(ldsl + PTAB_OFF);
#pragma unroll
        for (int i = 0; i < 16; ++i) tb[i] = (unsigned long long)a.in[i];
        tb[16] = (unsigned long long)a.out; tb[17] = (unsigned long long)a.ws; }
    __syncthreads();
#define INP(i) ((const float*)ldp(ldsl, (i)))
#define OUTP ((float*)ldp(ldsl, 16))
#define WSP ((unsigned char*)ldp(ldsl, 17))

#define PHASE_VARS unsigned char* ws = WSP; int bid = blockIdx.x; asm volatile("" : "+s"(bid)); int G = gridDim.x; asm volatile("" : "+s"(G)); \
    const int tid = opq_tid(), lane = tid & 63, wave = __builtin_amdgcn_readfirstlane(tid >> 6); const int gw = bid * 8 + wave, ngw = G * 8; (void)ws; (void)lane; (void)gw; (void)ngw;
#pragma unroll 1
    for (int l = 0; l < 2; ++l) {
        {
            PHASE_VARS
#ifndef NO_CVT
            Ptrs P;
            P.w_in = INP(2) + (size_t)l * DM * DIN; P.qn = INP(3) + l * 64; P.kn = INP(4) + l * 64; P.pool_w = INP(5) + l * 4 * 64 * 64; P.pool_scale = INP(6) + l * 256;
            P.gm_norm = INP(7) + l * 256; P.gm_ws = INP(8) + l * 4 * 128 * 128; P.gm_b = INP(9) + l * 4 * 128; P.w_branch = INP(10) + (size_t)l * 4 * 256 * 1024;
            P.w_out = INP(11) + (size_t)l * 1024 * 1024; P.w_gate = INP(13) + (size_t)l * DM * DFF; P.w_up = INP(14) + (size_t)l * DM * DFF; P.w_down = INP(15) + (size_t)l * DFF * DM;
            convert_weights(P, ws, (LAS float*)(ldsl + wave * 8448), gw, ngw, lane, bid * 512 + tid, G * 512);
#endif
            rmsnorm_rows(l == 0 ? INP(0) : OUTP, INP(1) + l * DM, WSB(bf16_t, WS_XN), gw, ngw, lane);
        }
        grid.sync();
        {
            PHASE_VARS
            pg8::Gemm g{WSB(bf16_t, WS_XN), WSB(bf16_t, WS_WIN), M_, NINP, DM}; pg8::StaticOrder S; S.init(M_, NINP, G, bid);
            EpiIn E{ws, INP(3) + l * 64, INP(4) + l * 64};
#ifndef NO_G1
            pg8::gemm_phase<EpiIn, pg8::StaticOrder, true, true>(ldsl, g, S, E);
#endif
        }
        grid.sync();
        {
            PHASE_VARS
#ifndef NO_A1
            phase_a1(lds, WSB(bf16_t, WS_IQ), WSB(bf16_t, WS_IK), WSB(float, WS_IW), WSB(unsigned short, WS_MASK), tid, bid, G);
#endif
            __syncthreads();
        }
        {
            PHASE_VARS
#ifndef NO_C
            phase_c(lds, WSB(bf16_t, WS_GV), WSB(bf16_t, WS_GU), INP(7) + l * 256, WSB(bf16_t, WS_WS), INP(9) + l * 4 * 128, tid, bid, G);
#endif
        }
        {
            PHASE_VARS
#ifndef NO_B
            phase_b(WSB(bf16_t, WS_PIN), WSB(bf16_t, WS_WP), INP(6) + l * 256, WSB(bf16_t, WS_OB), gw, ngw, lane);
#endif
        }
        {
            PHASE_VARS
#ifndef NO_D
            phase_d(WSB(bf16_t, WS_SQ), WSB(bf16_t, WS_SK), WSB(bf16_t, WS_VTS), gw, ngw, lane);
#endif
        }
        grid.sync();
        {
            PHASE_VARS
#ifndef NO_A2
            phase_a2(lds, WSB(bf16_t, WS_QA), WSB(bf16_t, WS_KA), WSB(bf16_t, WS_VTA), WSB(unsigned short, WS_MASK), INP(3) + l * 64, INP(4) + l * 64, tid, bid, G);
#endif
        }
        grid.sync();
#pragma unroll 1
        for (int nb = 0; nb < 4; ++nb) {
            PHASE_VARS
            const bf16_t* A = WSB(bf16_t, nb == 0 ? WS_QA : nb == 1 ? WS_OB : nb == 2 ? WS_GU : WS_SQ);
            int Kv = 256; asm volatile("" : "+s"(Kv));
            pg8::Gemm g{A, WSB(bf16_t, WS_WB) + (size_t)nb * 1024 * 256, M_, DM, Kv}; pg8::StaticOrder S; S.init(M_, DM, G, bid);
            EpiMerge E{ws + WS_G, WSB(bf16_t, WS_XN), nb};
#ifndef NO_G2
            pg8::gemm_phase<EpiMerge, pg8::StaticOrder, true, true>(ldsl, g, S, E);
#endif
            __syncthreads();
        }
        grid.sync();
        {
            PHASE_VARS
            pg8::Gemm g{WSB(bf16_t, WS_XN), WSB(bf16_t, WS_WOUT), M_, DM, DM}; pg8::StaticOrder S; S.init(M_, DM, G, bid);
            EpiResid E{l == 0 ? INP(0) : OUTP, OUTP};
#ifndef NO_G3
            pg8::gemm_phase<EpiResid, pg8::StaticOrder, true, true>(ldsl, g, S, E);
#endif
        }
        grid.sync();
        {
            PHASE_VARS
            rmsnorm_rows(OUTP, INP(12) + l * DM, WSB(bf16_t, WS_XN), gw, ngw, lane);
        }
        grid.sync();
        {
            PHASE_VARS
            pg8::Gemm g{WSB(bf16_t, WS_XN), WSB(bf16_t, WS_WGU), M_, 2 * DFF, DM}; pg8::StaticOrder S; S.init(M_, 2 * DFF, G, bid);
            EpiSwiGLU E{WSB(bf16_t, WS_R1)};
#ifndef NO_G4
            pg8::gemm_phase<EpiSwiGLU, pg8::StaticOrder, true, true>(ldsl, g, S, E);
#endif
        }
        grid.sync();
        {
            PHASE_VARS
            pg8::Gemm g{WSB(bf16_t, WS_R1), WSB(bf16_t, WS_WD), M_, DM, DFF}; pg8::StaticOrder S; S.init(M_, DM, G, bid);
            float* o = OUTP; EpiResid E{o, o};
#ifndef NO_G3
            pg8::gemm_phase<EpiResid, pg8::StaticOrder, true, true>(ldsl, g, S, E);
#endif
        }
        if (l == 0) grid.sync();
    }
}

extern "C" void kernel_launch(void* const* d_in, const int* in_sizes, int n_in, void* d_out, int out_size, void* d_ws, size_t ws_size, hipStream_t stream) {
    static int grid_blocks = 0;
    if (grid_blocks == 0) {
        if (n_in != 16 || out_size != M_ * DM || ws_size < WS_END) { fprintf(stderr, "kernel_launch: unexpected shapes (n_in %d out %d ws %zu)\n", n_in, out_size, ws_size); grid_blocks = -1; return; }
        int dev = 0, cus = 0, per_cu = 0;
        hipGetDevice(&dev);
        hipDeviceGetAttribute(&cus, hipDeviceAttributeMultiprocessorCount, dev);
        hipFuncSetAttribute((const void*)fwd_kernel, hipFuncAttributeMaxDynamicSharedMemorySize, LDS_BYTES);
        if (hipOccupancyMaxActiveBlocksPerMultiprocessor(&per_cu, (const void*)fwd_kernel, 512, LDS_BYTES) != hipSuccess || per_cu < 1) per_cu = 1;
        (void)hipGetLastError();
        grid_blocks = cus;
    }
    if (grid_blocks < 0) return;
    Args a{};
    for (int i = 0; i < 16; ++i) a.in[i] = (const float*)d_in[i];
    a.out = (float*)d_out; a.ws = (unsigned char*)d_ws;
    void* args[] = {&a};
    hipError_t e = hipLaunchCooperativeKernel((const void*)fwd_kernel, dim3(grid_blocks), dim3(512), args, LDS_BYTES, stream);
    if (e != hipSuccess) fprintf(stderr, "cooperative launch failed: %s (grid %d)\n", hipGetErrorString(e), grid_blocks);
}
```

```cpp
#include <hip/hip_runtime.h>
#include <hip/hip_cooperative_groups.h>
#include <cstdio>
#include <cstdint>
namespace pg8 {
#define PG8_LAS __attribute__((address_space(3)))
typedef unsigned short bf16_t;
typedef short bf16x8 __attribute__((ext_vector_type(8)));
typedef float f32x4 __attribute__((ext_vector_type(4)));
typedef unsigned u32x4 __attribute__((ext_vector_type(4)));
constexpr int BM = 256, BK = 64, HALF = 128, HTB = HALF * BK * 2  , STAGE_BYTES = 8 * HTB, NXCD = 8, WGM = 8;

__host__ __device__ __forceinline__ int lds_byte(int r, int c) { const int st = (r >> 4) * 2 + (c >> 5), rr = r & 15, cc = c & 31, ob = rr * 64 + cc * 2; return st * 1024 + (ob ^ (((ob >> 9) & 1) << 5)); }
__host__ __device__ __forceinline__ void stage_rc(int b, int& R, int& C) { const int st = b / 1024, sb = b % 1024, swz = sb ^ (((sb >> 9) & 1) << 5); R = (st >> 1) * 16 + swz / 64; C = (st & 1) * 32 + (swz % 64) / 2; }
__host__ __device__ __forceinline__ int perm32(int rho) { const int n = rho >> 4, i = rho & 15; return 8 * (i >> 2) + 4 * n + (i & 3); }

struct Unit { int pm, pn; };
struct Gemm { const bf16_t* A; const bf16_t* Bt; int M, N, K; };

struct StaticOrder {
    int nM, nN, nwg, G, c;
    __host__ __device__ void init(int M, int N, int G_, int c_) { nM = M / BM; nN = N / BM; nwg = nM * nN; G = G_; c = c_; }
    __host__ __device__ bool next(int i, Unit& u) const {
        const long L = (long)i * G + c; if (L >= nwg) return false;
        int wgid = (int)L; { const int q = nwg / NXCD, r = nwg % NXCD, xcd = wgid % NXCD, off = wgid / NXCD; wgid = (xcd < r ? xcd * (q + 1) : r * (q + 1) + (xcd - r) * q) + off; }
        const int nig = WGM * nN, gid = wgid / nig, fm = gid * WGM, gsz = (nM - fm) < WGM ? (nM - fm) : WGM;
        u.pm = fm + ((wgid % nig) % gsz); u.pn = (wgid % nig) / gsz; return true;
    }
    __device__ __forceinline__ void a_ready(const Unit&) const {}
    __device__ __forceinline__ void done(const Unit&) const {}
};

__device__ __forceinline__ unsigned cvt_pk_bf16(float lo, float hi) { unsigned r; asm volatile("v_cvt_pk_bf16_f32 %0, %1, %2" : "=v"(r) : "v"(lo), "v"(hi)); return r; }
template <class Epi, class Sched, bool ALIGN_EPI = false, bool SP2 = false>
__device__ __forceinline__ void gemm_phase(PG8_LAS unsigned char* lds, const Gemm g, const Sched& S, const Epi& E) {
    int tid_ = threadIdx.x; asm volatile("" : "+v"(tid_)); const int tid = tid_, wid = __builtin_amdgcn_readfirstlane(tid >> 6), lane = tid & 63, wr = wid >> 2, wc = wid & 3, fr = lane & 15, fq = lane >> 4;
    const int K = g.K, nt = K / BK;
    unsigned voffA[2], voffB[2];
#pragma unroll
    for (int i = 0; i < 2; ++i) { int R, C; stage_rc(tid * 16 + i * 8192, R, C); const int Rb = Epi::PERM ? ((R & ~31) + perm32(R & 31)) : R;
        voffA[i] = (unsigned)(R * K + C) * 2u; voffB[i] = (unsigned)(Rb * K + C) * 2u; }
    const size_t kstep = (size_t)(BK * 2);
    const size_t hstep = (size_t)HALF * K * 2;
    const size_t tstep = 2 * hstep;
    const unsigned ldsw = (unsigned)wid * 1024u;
    const int aoff = lds_byte(wr * 64 + fr, fq * 8), boff = lds_byte(wc * 32 + fr, fq * 8);
#define PG8_SA(b, h) (((b) * 2 + (h)) * HTB)
#define PG8_SB(b, h) ((4 + (b) * 2 + (h)) * HTB)
#define PG8_STAGE(bufoff, gbase, voff) do { _Pragma("unroll") for (int _i = 0; _i < 2; ++_i) \
        __builtin_amdgcn_global_load_lds((const unsigned*)((const char*)(gbase) + (voff)[_i]), (PG8_LAS unsigned*)(lds + (bufoff) + ldsw + _i * 8192), 16, 0, 0); } while (0)
#define PG8_LDA(dst, b, h) do { _Pragma("unroll") for (int m = 0; m < 4; ++m) _Pragma("unroll") for (int k = 0; k < 2; ++k) dst[m][k] = *(const PG8_LAS bf16x8*)(lds + PG8_SA(b, h) + aoff + m * 2048 + k * 1024); } while (0)
#define PG8_LDB(dst, b, h) do { _Pragma("unroll") for (int n = 0; n < 2; ++n) _Pragma("unroll") for (int k = 0; k < 2; ++k) dst[n][k] = *(const PG8_LAS bf16x8*)(lds + PG8_SB(b, h) + boff + n * 2048 + k * 1024); } while (0)
#define PG8_MMA(ai, bj, At, Bt) do { __builtin_amdgcn_s_setprio(1); _Pragma("unroll") for (int m = 0; m < 4; ++m) _Pragma("unroll") for (int n = 0; n < 2; ++n) _Pragma("unroll") for (int k = 0; k < 2; ++k) \
        acc[ai][bj][m][n] = __builtin_amdgcn_mfma_f32_16x16x32_bf16(Bt[n][k], At[m][k], acc[ai][bj][m][n], 0, 0, 0); __builtin_amdgcn_s_setprio(0); } while (0)
#define PG8_WAIT_V(n) asm volatile("s_waitcnt vmcnt(" #n ")" ::: "memory")
#define PG8_WAIT_L(n) asm volatile("s_waitcnt lgkmcnt(" #n ")" ::: "memory")
#define PG8_BAR __builtin_amdgcn_s_barrier()
#define PG8_SCHED __builtin_amdgcn_sched_barrier(0)
    Unit cur, nxt; int ui = 0;
    if (!S.next(0, cur)) return;
    f32x4 acc[2][2][4][2];
#pragma unroll
    for (int a = 0; a < 2; ++a)
#pragma unroll
        for (int b = 0; b < 2; ++b)
#pragma unroll
            for (int m = 0; m < 4; ++m)
#pragma unroll
                for (int n = 0; n < 2; ++n) acc[a][b][m][n] = (f32x4){0.f, 0.f, 0.f, 0.f};
    bf16x8 At[4][2], B0[2][2], B1[2][2];
    const char* cA = (const char*)g.A + (size_t)cur.pm * tstep; const char* cB = (const char*)g.Bt + (size_t)cur.pn * tstep;
    S.a_ready(cur);
    if constexpr (SP2) {
        PG8_STAGE(PG8_SB(0, 0), cB, voffB); PG8_STAGE(PG8_SB(0, 1), cB + hstep, voffB); PG8_STAGE(PG8_SA(0, 0), cA, voffA); PG8_STAGE(PG8_SA(0, 1), cA + hstep, voffA);
        if (wr == 1) PG8_BAR;
        PG8_WAIT_V(2); PG8_BAR;
        PG8_STAGE(PG8_SB(1, 0), cB + kstep, voffB); PG8_STAGE(PG8_SA(1, 0), cA + kstep, voffA); PG8_STAGE(PG8_SB(1, 1), cB + hstep + kstep, voffB);
        PG8_WAIT_V(6); PG8_BAR;
    } else {
        PG8_STAGE(PG8_SB(0, 0), cB, voffB); PG8_STAGE(PG8_SA(0, 0), cA, voffA); PG8_STAGE(PG8_SB(0, 1), cB + hstep, voffB); PG8_STAGE(PG8_SA(0, 1), cA + hstep, voffA);
        if (wr == 1) PG8_BAR;
        PG8_WAIT_V(4); PG8_BAR;
        PG8_STAGE(PG8_SB(1, 0), cB + kstep, voffB); PG8_STAGE(PG8_SA(1, 0), cA + kstep, voffA); PG8_STAGE(PG8_SB(1, 1), cB + hstep + kstep, voffB);
        PG8_WAIT_V(6); PG8_BAR;
    }
    for (;;) {
        const bool has_next = S.next(ui + 1, nxt);
        const char* nA = has_next ? (const char*)g.A + (size_t)nxt.pm * tstep : cA; const char* nB = has_next ? (const char*)g.Bt + (size_t)nxt.pn * tstep : cB;
        for (int t = 0; t < nt; t += 2) {
            const bool last = (t == nt - 2);
            const char* a1 = cA + (size_t)(t + 1) * kstep;
            const char* a2 = last ? nA : cA + (size_t)(t + 2) * kstep; const char* b2 = last ? nB : cB + (size_t)(t + 2) * kstep;
            const char* a3 = a2 + kstep; const char* b3 = b2 + kstep;
            if (last && has_next) S.a_ready(nxt);
            if constexpr (SP2) {
            PG8_LDB(B0, 0, 0); PG8_LDB(B1, 0, 1); PG8_SCHED; PG8_LDA(At, 0, 0); PG8_STAGE(PG8_SA(1, 1), a1 + hstep, voffA);
            PG8_WAIT_V(8); PG8_WAIT_L(0); PG8_BAR; PG8_MMA(0, 0, At, B0); PG8_MMA(0, 1, At, B1); PG8_BAR; PG8_SCHED;
            PG8_LDA(At, 0, 1); PG8_STAGE(PG8_SB(0, 0), b2, voffB); PG8_STAGE(PG8_SB(0, 1), b2 + hstep, voffB); PG8_STAGE(PG8_SA(0, 0), a2, voffA);
            PG8_WAIT_V(8); PG8_WAIT_L(0); PG8_BAR; PG8_MMA(1, 0, At, B0); PG8_MMA(1, 1, At, B1); PG8_BAR; PG8_SCHED;
            PG8_LDB(B0, 1, 0); PG8_LDB(B1, 1, 1); PG8_SCHED; PG8_LDA(At, 1, 0); PG8_STAGE(PG8_SA(0, 1), a2 + hstep, voffA);
            PG8_WAIT_V(8); PG8_WAIT_L(0); PG8_BAR; PG8_MMA(0, 0, At, B0); PG8_MMA(0, 1, At, B1); PG8_BAR; PG8_SCHED;
            PG8_LDA(At, 1, 1); PG8_STAGE(PG8_SB(1, 0), b3, voffB); PG8_STAGE(PG8_SB(1, 1), b3 + hstep, voffB); PG8_STAGE(PG8_SA(1, 0), a3, voffA);
            PG8_WAIT_V(8); PG8_WAIT_L(0); PG8_BAR; PG8_MMA(1, 0, At, B0); PG8_MMA(1, 1, At, B1); PG8_BAR; PG8_SCHED;
            } else {
            PG8_LDB(B0, 0, 0); PG8_SCHED; PG8_LDA(At, 0, 0); PG8_STAGE(PG8_SA(1, 1), a1 + hstep, voffA);
            PG8_WAIT_L(8); PG8_BAR; PG8_WAIT_L(0); PG8_MMA(0, 0, At, B0); PG8_BAR; PG8_SCHED;
            PG8_LDB(B1, 0, 1); PG8_STAGE(PG8_SB(0, 0), b2, voffB);
            PG8_BAR; PG8_WAIT_L(0); PG8_MMA(0, 1, At, B1); PG8_BAR;
            PG8_LDA(At, 0, 1); PG8_STAGE(PG8_SA(0, 0), a2, voffA);
            PG8_BAR; PG8_WAIT_L(0); PG8_MMA(1, 0, At, B0); PG8_BAR; PG8_SCHED;
            PG8_STAGE(PG8_SB(0, 1), b2 + hstep, voffB);
            PG8_WAIT_V(6); PG8_BAR; PG8_MMA(1, 1, At, B1); PG8_BAR;
            PG8_LDB(B0, 1, 0); PG8_SCHED; PG8_LDA(At, 1, 0); PG8_STAGE(PG8_SA(0, 1), a2 + hstep, voffA);
            PG8_WAIT_L(8); PG8_BAR; PG8_WAIT_L(0); PG8_MMA(0, 0, At, B0); PG8_BAR; PG8_SCHED;
            PG8_LDB(B1, 1, 1); PG8_STAGE(PG8_SB(1, 0), b3, voffB);
            PG8_BAR; PG8_WAIT_L(0); PG8_MMA(0, 1, At, B1); PG8_BAR;
            PG8_LDA(At, 1, 1); PG8_STAGE(PG8_SA(1, 0), a3, voffA);
            PG8_BAR; PG8_WAIT_L(0); PG8_MMA(1, 0, At, B0); PG8_BAR; PG8_SCHED;
            PG8_STAGE(PG8_SB(1, 1), b3 + hstep, voffB);
            PG8_WAIT_V(6); PG8_BAR; PG8_MMA(1, 1, At, B1); PG8_BAR;
            }
        }
        if constexpr (ALIGN_EPI) { if (wr == 0) PG8_BAR; }
        if constexpr (!Epi::AFTER_DRAIN) { E(acc, cur, wr, wc, fr, fq); S.done(cur); }
        if (!has_next) break;
#pragma unroll
        for (int a = 0; a < 2; ++a)
#pragma unroll
            for (int b = 0; b < 2; ++b)
#pragma unroll
                for (int m = 0; m < 4; ++m)
#pragma unroll
                    for (int n = 0; n < 2; ++n) acc[a][b][m][n] = (f32x4){0.f, 0.f, 0.f, 0.f};
        cur = nxt; cA = nA; cB = nB; ++ui;
        if constexpr (ALIGN_EPI) { if (wr == 1) PG8_BAR; }
    }
    PG8_WAIT_V(0);
    if constexpr (!ALIGN_EPI) { if (wr == 0) PG8_BAR; }
    PG8_BAR;
    if constexpr (Epi::AFTER_DRAIN) { E.fused(acc, cur, wr, wc, fr, fq, lds, wid, lane); S.done(cur); }
#undef PG8_SA
#undef PG8_SB
#undef PG8_STAGE
#undef PG8_LDA
#undef PG8_LDB
#undef PG8_MMA
#undef PG8_WAIT_V
#undef PG8_WAIT_L
#undef PG8_BAR
#undef PG8_SCHED
}
}
namespace cg = cooperative_groups;
using pg8::bf16_t; using pg8::bf16x8; using pg8::f32x4; using pg8::u32x4; using pg8::Unit; using pg8::cvt_pk_bf16;
typedef unsigned u32x2 __attribute__((ext_vector_type(2)));
#define LAS __attribute__((address_space(3)))
#define LDS_WAIT() asm volatile("s_waitcnt lgkmcnt(0)" ::: "memory")

constexpr int M_ = 16384, DM = 1024, SEQ = 4096, DFF = 2816, DIN = 6696, NINP = 6912;
constexpr float EPSN = 1e-6f;
constexpr float LOG2E = 1.4426950408889634f, LN2 = 0.6931471805599453f;
constexpr float C2 = 0.125f * LOG2E;

constexpr size_t MiB = (size_t)1 << 20;
constexpr size_t WS_WIN = 1 * MiB;
constexpr size_t WS_WB = WS_WIN + (size_t)NINP * 1024 * 2;
constexpr size_t WS_WOUT = WS_WB + 2 * MiB;
constexpr size_t WS_WGU = WS_WOUT + 2 * MiB;
constexpr size_t WS_WD = WS_WGU + 11 * MiB;
constexpr size_t WS_WP = WS_WD + (size_t)1024 * 2816 * 2;
constexpr size_t WS_WS = WS_WP + 32768;
static_assert(WS_WS + 131072 <= 36 * MiB, "weights region");
constexpr size_t WS_XN = 36 * MiB;
constexpr size_t WS_R1 = 68 * MiB;
constexpr size_t WS_G = WS_R1, WS_KA = WS_R1 + 64 * MiB, WS_VTA = WS_KA + 8 * MiB, WS_IQ = WS_VTA + 8 * MiB;
constexpr size_t WS_S = 156 * MiB;
constexpr size_t WS_PIN = WS_S, WS_GU = WS_S + 8 * MiB, WS_GV = WS_S + 16 * MiB, WS_SQ = WS_S + 24 * MiB, WS_SK = WS_S + 32 * MiB,
                 WS_VTS = WS_S + 40 * MiB, WS_QA = WS_S + 48 * MiB, WS_OB = WS_S + 56 * MiB, WS_MASK = 220 * MiB, WS_IK = 228 * MiB, WS_IW = 229 * MiB, WS_OA = 230 * MiB, WS_OC = 238 * MiB, WS_OD = 246 * MiB, WS_END = 254 * MiB;

__device__ __forceinline__ float bf2f(unsigned short v) { return __uint_as_float((unsigned)v << 16); }
__device__ __forceinline__ float bflo(unsigned v) { return __uint_as_float(v << 16); }
__device__ __forceinline__ float bfhi(unsigned v) { return __uint_as_float(v & 0xffff0000u); }
__device__ __forceinline__ unsigned short f2bf(float f) { return (unsigned short)(cvt_pk_bf16(f, 0.f) & 0xffffu); }
__device__ __forceinline__ float sigmoidf_(float x) { return __builtin_amdgcn_rcpf(1.f + __builtin_amdgcn_exp2f(-x * LOG2E)); }
__device__ __forceinline__ float gelu_tanh(float x) { const float u = 0.7978845608028654f * (x + 0.044715f * x * x * x); return x * __builtin_amdgcn_rcpf(1.f + __builtin_amdgcn_exp2f(-2.f * LOG2E * u)); }
__device__ __forceinline__ f32x4 mfma16(bf16x8 a, bf16x8 b, f32x4 c) { return __builtin_amdgcn_mfma_f32_16x16x32_bf16(a, b, c, 0, 0, 0); }
__device__ __forceinline__ bf16x8 mk8(unsigned a, unsigned b, unsigned c, unsigned d) { u32x4 v = {a, b, c, d}; return __builtin_bit_cast(bf16x8, v); }

struct EpiIn {
    static constexpr bool PERM = true, AFTER_DRAIN = false;
    unsigned char* ws; const float *qn, *kn;
    __device__ __forceinline__ void operator()(const f32x4 (&acc)[2][2][4][2], const Unit& u, int wr, int wc, int fr, int fq) const {
        bf16_t* const QA = (bf16_t*)(ws + WS_QA); bf16_t* const KA = (bf16_t*)(ws + WS_KA); bf16_t* const VTA = (bf16_t*)(ws + WS_VTA); bf16_t* const IQ = (bf16_t*)(ws + WS_IQ);
        bf16_t* const PIN = (bf16_t*)(ws + WS_PIN); bf16_t* const GU = (bf16_t*)(ws + WS_GU); bf16_t* const GV = (bf16_t*)(ws + WS_GV); bf16_t* const SQ = (bf16_t*)(ws + WS_SQ);
        bf16_t* const SK = (bf16_t*)(ws + WS_SK); bf16_t* const VTS = (bf16_t*)(ws + WS_VTS); bf16_t* const IK = (bf16_t*)(ws + WS_IK); float* const IW = (float*)(ws + WS_IW); unsigned char* const G = ws + WS_G;
        const int pn = u.pn; const int row0 = u.pm * 256 + wr * 64 + fr; const int cl = wc * 32 + 8 * fq;
        if (pn >= 11) {
            unsigned char* gp = G + (size_t)row0 * 4096 + (pn - 11) * 256 + cl;
#pragma unroll
            for (int ai = 0; ai < 2; ++ai)
#pragma unroll
                for (int m = 0; m < 4; ++m)
#pragma unroll
                    for (int bj = 0; bj < 2; ++bj) {
                        unsigned w2[2];
#pragma unroll
                        for (int n = 0; n < 2; ++n) { const f32x4 v = acc[ai][bj][m][n]; unsigned pk = 0;
#pragma unroll
                            for (int i = 0; i < 4; ++i) { const unsigned qv = (unsigned)(sigmoidf_(v[i]) * 255.f + 0.5f); pk |= qv << (8 * i); }
                            w2[n] = pk; }
                        *(u32x2*)(gp + (size_t)(ai * 128 + m * 16) * 4096 + bj * 128) = (u32x2){w2[0], w2[1]};
                    }
            return;
        }
        if (pn <= 1) {
            const float* gw = pn == 0 ? qn : kn; const float sc = pn == 0 ? C2 : 1.f; bf16_t* T = pn == 0 ? QA : KA;
            f32x4 gv[2][2];
#pragma unroll
            for (int bj = 0; bj < 2; ++bj)
#pragma unroll
                for (int n = 0; n < 2; ++n) gv[bj][n] = *(const f32x4*)(gw + bj * 32 + 8 * fq + 4 * n);
#pragma unroll
            for (int ai = 0; ai < 2; ++ai)
#pragma unroll
                for (int m = 0; m < 4; ++m) {
                    float ss = 0.f;
#pragma unroll
                    for (int bj = 0; bj < 2; ++bj)
#pragma unroll
                        for (int n = 0; n < 2; ++n) { const f32x4 v = acc[ai][bj][m][n]; ss += (v[0] * v[0] + v[1] * v[1]) + (v[2] * v[2] + v[3] * v[3]); }
                    ss += __shfl_xor(ss, 16); ss += __shfl_xor(ss, 32);
                    const float rinv = __builtin_amdgcn_rsqf(ss * (1.f / 64.f) + EPSN) * sc;
                    bf16_t* rp = T + (size_t)(row0 + ai * 128 + m * 16) * 256 + wc * 64 + 8 * fq;
#pragma unroll
                    for (int bj = 0; bj < 2; ++bj) { const f32x4 v0 = acc[ai][bj][m][0] * gv[bj][0] * rinv, v1 = acc[ai][bj][m][1] * gv[bj][1] * rinv;
                        u32x4 w; w.x = cvt_pk_bf16(v0[0], v0[1]); w.y = cvt_pk_bf16(v0[2], v0[3]); w.z = cvt_pk_bf16(v1[0], v1[1]); w.w = cvt_pk_bf16(v1[2], v1[3]);
                        *(u32x4*)(rp + bj * 32) = w; }
                }
            return;
        }
        if (pn == 2 || pn == 9) {
            bf16_t* T = pn == 2 ? VTA : VTS;
#pragma unroll
            for (int ai = 0; ai < 2; ++ai)
#pragma unroll
                for (int m = 0; m < 4; ++m) { const int row = row0 + ai * 128 + m * 16; const int b = row >> 12, t = row & 4095;
#pragma unroll
                    for (int bj = 0; bj < 2; ++bj)
#pragma unroll
                        for (int n = 0; n < 2; ++n) { const f32x4 v = acc[ai][bj][m][n];
#pragma unroll
                            for (int i = 0; i < 4; ++i) T[((size_t)b * 256 + bj * 128 + cl + 4 * n + i) * 4096 + t] = f2bf(v[i]); }
                }
            return;
        }
        if (pn == 10) {
            if (wc == 0) {
#pragma unroll
                for (int ai = 0; ai < 2; ++ai)
#pragma unroll
                    for (int m = 0; m < 4; ++m) { const f32x4 v0 = acc[ai][0][m][0], v1 = acc[ai][0][m][1];
                        u32x4 w; w.x = cvt_pk_bf16(v0[0], v0[1]); w.y = cvt_pk_bf16(v0[2], v0[3]); w.z = cvt_pk_bf16(v1[0], v1[1]); w.w = cvt_pk_bf16(v1[2], v1[3]);
                        *(u32x4*)(IK + (size_t)(row0 + ai * 128 + m * 16) * 32 + 8 * fq) = w; }
            } else if (wc == 1 && fq == 0) {
#pragma unroll
                for (int ai = 0; ai < 2; ++ai)
#pragma unroll
                    for (int m = 0; m < 4; ++m) { float* p = IW + (size_t)(row0 + ai * 128 + m * 16) * 8; *(f32x4*)p = acc[ai][0][m][0]; *(f32x4*)(p + 4) = acc[ai][0][m][1]; }
            }
            return;
        }
        {
            bf16_t* T = pn == 3 ? IQ : pn == 4 ? PIN : pn == 5 ? GU : pn == 6 ? GV : pn == 7 ? SQ : SK;
            const bool act = (pn == 5 || pn == 6); const float sc = pn == 7 ? 0.125f : 1.f;
#pragma unroll
            for (int ai = 0; ai < 2; ++ai)
#pragma unroll
                for (int m = 0; m < 4; ++m) { bf16_t* rp = T + (size_t)(row0 + ai * 128 + m * 16) * 256 + cl;
#pragma unroll
                    for (int bj = 0; bj < 2; ++bj) { f32x4 v0 = acc[ai][bj][m][0] * sc, v1 = acc[ai][bj][m][1] * sc;
                        if (act) {
#pragma unroll
                            for (int i = 0; i < 4; ++i) { v0[i] = gelu_tanh(v0[i]); v1[i] = gelu_tanh(v1[i]); } }
                        u32x4 w; w.x = cvt_pk_bf16(v0[0], v0[1]); w.y = cvt_pk_bf16(v0[2], v0[3]); w.z = cvt_pk_bf16(v1[0], v1[1]); w.w = cvt_pk_bf16(v1[2], v1[3]);
                        *(u32x4*)(rp + bj * 128) = w; }
                }
        }
    }
};

struct EpiMerge {
    static constexpr bool PERM = true, AFTER_DRAIN = false;
    const unsigned char* G; bf16_t* MG; int nb;
    __device__ __forceinline__ void operator()(const f32x4 (&acc)[2][2][4][2], const Unit& u, int wr, int wc, int fr, int fq) const {
        const int row0 = u.pm * 256 + wr * 64 + fr; const int col0 = u.pn * 256 + wc * 32 + 8 * fq;
        const unsigned char* gp0 = G + (size_t)row0 * 4096 + nb * 1024 + col0; bf16_t* mp0 = MG + (size_t)row0 * 1024 + col0;
#pragma unroll
        for (int ai = 0; ai < 2; ++ai)
#pragma unroll
            for (int m = 0; m < 4; ++m) {
#pragma unroll
                for (int bj = 0; bj < 2; ++bj)
#pragma unroll
                    for (int n = 0; n < 2; ++n) {
                        const size_t ro = (size_t)(ai * 128 + m * 16);
                        const unsigned gb = *(const unsigned*)(gp0 + ro * 4096 + bj * 128 + 4 * n);
                        f32x4 v = acc[ai][bj][m][n];
#pragma unroll
                        for (int i = 0; i < 4; ++i) v[i] *= (float)((gb >> (8 * i)) & 255u) * (1.f / 255.f);
                        bf16_t* mp = mp0 + ro * 1024 + bj * 128 + 4 * n;
                        if (nb > 0) { const u32x2 o = *(const u32x2*)mp; v[0] += bflo(o.x); v[1] += bfhi(o.x); v[2] += bflo(o.y); v[3] += bfhi(o.y); }
                        *(u32x2*)mp = (u32x2){cvt_pk_bf16(v[0], v[1]), cvt_pk_bf16(v[2], v[3])};
                    }
                asm volatile("" ::: "memory"); }
    }
};

struct EpiResid {
    static constexpr bool PERM = true, AFTER_DRAIN = false;
    const float* base; float* out;
    __device__ __forceinline__ void operator()(const f32x4 (&acc)[2][2][4][2], const Unit& u, int wr, int wc, int fr, int fq) const {
        const int row0 = u.pm * 256 + wr * 64 + fr; const int col0 = u.pn * 256 + wc * 32 + 8 * fq;
#pragma unroll
        for (int ai = 0; ai < 2; ++ai)
#pragma unroll
            for (int m = 0; m < 4; ++m) { const size_t off = (size_t)(row0 + ai * 128 + m * 16) * 1024 + col0;
#pragma unroll
                for (int bj = 0; bj < 2; ++bj) { const f32x4 b0 = *(const f32x4*)(base + off + bj * 128), b1 = *(const f32x4*)(base + off + bj * 128 + 4);
                    *(f32x4*)(out + off + bj * 128) = b0 + acc[ai][bj][m][0]; *(f32x4*)(out + off + bj * 128 + 4) = b1 + acc[ai][bj][m][1]; }
                asm volatile("" ::: "memory"); }
    }
};

struct EpiSwiGLU {
    static constexpr bool PERM = true, AFTER_DRAIN = false;
    bf16_t* ACT;
    __device__ __forceinline__ void operator()(const f32x4 (&acc)[2][2][4][2], const Unit& u, int wr, int wc, int fr, int fq) const {
        const int row0 = u.pm * 256 + wr * 64 + fr; const int f0 = u.pn * 128 + wc * 32 + 8 * fq;
#pragma unroll
        for (int ai = 0; ai < 2; ++ai)
#pragma unroll
            for (int m = 0; m < 4; ++m) { f32x4 r[2];
#pragma unroll
                for (int n = 0; n < 2; ++n) { const f32x4 g = acc[ai][0][m][n], up = acc[ai][1][m][n];
#pragma unroll
                    for (int i = 0; i < 4; ++i) r[n][i] = g[i] * sigmoidf_(g[i]) * up[i]; }
                u32x4 w; w.x = cvt_pk_bf16(r[0][0], r[0][1]); w.y = cvt_pk_bf16(r[0][2], r[0][3]); w.z = cvt_pk_bf16(r[1][0], r[1][1]); w.w = cvt_pk_bf16(r[1][2], r[1][3]);
                *(u32x4*)(ACT + (size_t)(row0 + ai * 128 + m * 16) * DFF + f0) = w; }
    }
};

__device__ __forceinline__ void cvt_item(const float* src, int ld, int col0, int nvalid, int K, bf16_t* WT, int dst_row0, int kb, LAS float* scr, int lane) {
    const int k0 = 64 * kb, c = lane & 31;
#pragma unroll 8
    for (int i = 0; i < 32; ++i) { const int kk = 2 * i + (lane >> 5); float v = 0.f; if (c < nvalid) v = src[(size_t)(k0 + kk) * ld + col0 + c]; scr[kk * 33 + c] = v; }
    LDS_WAIT();
    const int c8 = lane & 7;
#pragma unroll
    for (int j = 0; j < 4; ++j) { const int n = (lane >> 3) + 8 * j; const LAS float* s = scr + (8 * c8) * 33 + n;
        u32x4 o; o.x = cvt_pk_bf16(s[0 * 33], s[1 * 33]); o.y = cvt_pk_bf16(s[2 * 33], s[3 * 33]); o.z = cvt_pk_bf16(s[4 * 33], s[5 * 33]); o.w = cvt_pk_bf16(s[6 * 33], s[7 * 33]);
        *(u32x4*)(WT + (size_t)(dst_row0 + n) * K + k0 + 8 * c8) = o; }
    LDS_WAIT();
}
__device__ __forceinline__ float wave_sum(float v) {
#pragma unroll
    for (int o = 1; o < 64; o <<= 1) v += __shfl_xor(v, o);
    return v;
}
__device__ __forceinline__ float wave_max(float v) {
#pragma unroll
    for (int o = 1; o < 64; o <<= 1) v = fmaxf(v, __shfl_xor(v, o));
    return v;
}
__device__ __forceinline__ void rmsnorm_rows(const float* xs, const float* gamma, bf16_t* XN, int gw, int ngw, int lane) {
    f32x4 gm[4];
#pragma unroll
    for (int j = 0; j < 4; ++j) gm[j] = *(const f32x4*)(gamma + 4 * lane + 256 * j);
    for (int m = gw; m < M_; m += ngw) {
        const f32x4* xr = (const f32x4*)(xs + (size_t)m * DM) + lane; f32x4 v[4]; float s = 0.f;
#pragma unroll
        for (int j = 0; j < 4; ++j) { v[j] = xr[64 * j]; s += (v[j].x * v[j].x + v[j].y * v[j].y) + (v[j].z * v[j].z + v[j].w * v[j].w); }
        const float r = __builtin_amdgcn_rsqf(wave_sum(s) * (1.f / DM) + EPSN);
        u32x2* o8 = (u32x2*)(XN + (size_t)m * DM) + lane;
#pragma unroll
        for (int j = 0; j < 4; ++j) { const f32x4 y = v[j] * r * gm[j]; o8[64 * j] = (u32x2){cvt_pk_bf16(y.x, y.y), cvt_pk_bf16(y.z, y.w)}; }
    }
}

struct Ptrs {
    const float *w_in, *qn, *kn, *pool_w, *pool_scale, *gm_norm, *gm_ws, *gm_b, *w_branch, *w_out, *w_gate, *w_up, *w_down;
};

__device__ __forceinline__ void convert_weights(const Ptrs& P, unsigned char* ws, LAS float* scr, int gw, int ngw, int lane, int gtid, int ngt) {
    bf16_t* WinT = (bf16_t*)(ws + WS_WIN); bf16_t* WbT = (bf16_t*)(ws + WS_WB); bf16_t* WoutT = (bf16_t*)(ws + WS_WOUT); bf16_t* WguT = (bf16_t*)(ws + WS_WGU);
    bf16_t* WdT = (bf16_t*)(ws + WS_WD); bf16_t* WpT = (bf16_t*)(ws + WS_WP); bf16_t* Wtril = (bf16_t*)(ws + WS_WS);
    constexpr int I_A = 216 * 16, I_B = 512, I_C = 512, I_D = 176 * 16, I_E = 32 * 44, I_F = 8, NIT = I_A + I_B + I_C + I_D + I_E + I_F;
    for (int it = gw; it < NIT; it += ngw) {
        int r = it;
        if (r < I_A) { const int rb = r >> 4, kb = r & 15, tile = rb >> 3, sub = rb & 7; int col0, nv = 32;
            if (tile <= 1) col0 = tile * 256 + (sub & 3) * 64 + (sub >> 2) * 32;
            else if (tile == 2) col0 = 512 + sub * 32;
            else if (tile == 3) col0 = 768 + sub * 32;
            else if (tile <= 9) col0 = 1064 + (tile - 4) * 256 + sub * 32;
            else if (tile == 10) { col0 = sub == 0 ? 1024 : 1056; nv = sub == 0 ? 32 : (sub == 1 ? 8 : 0); }
            else col0 = 2600 + (tile - 11) * 256 + sub * 32;
            cvt_item(P.w_in, DIN, col0, nv, 1024, WinT, rb * 32, kb, scr, lane); continue; }
        r -= I_A;
        if (r < I_B) { const int n = r >> 7, q = r & 127, rb = q >> 2, kb = q & 3;
            cvt_item(P.w_branch + (size_t)n * 256 * 1024, 1024, rb * 32, 32, 256, WbT + (size_t)n * 1024 * 256, rb * 32, kb, scr, lane); continue; }
        r -= I_B;
        if (r < I_C) { const int rb = r >> 4, kb = r & 15; cvt_item(P.w_out, 1024, rb * 32, 32, 1024, WoutT, rb * 32, kb, scr, lane); continue; }
        r -= I_C;
        if (r < I_D) { const int rb = r >> 4, kb = r & 15, tile = rb >> 3, sub = rb & 7;
            cvt_item((sub >> 2) ? P.w_up : P.w_gate, DFF, tile * 128 + (sub & 3) * 32, 32, 1024, WguT, rb * 32, kb, scr, lane); continue; }
        r -= I_D;
        if (r < I_E) { const int rb = r / 44, kb = r % 44; cvt_item(P.w_down, 1024, rb * 32, 32, DFF, WdT, rb * 32, kb, scr, lane); continue; }
        r -= I_E;
        { const int gp = r >> 1, rb = r & 1; cvt_item(P.pool_w + gp * 4096, 64, rb * 32, 32, 64, WpT + gp * 4096, rb * 32, 0, scr, lane); }
    }
    for (int e = gtid; e < 4 * 128 * 128; e += ngt) { const int s = e & 127, t = (e >> 7) & 127; Wtril[e] = (s <= t) ? f2bf(P.gm_ws[e]) : (unsigned short)0; }
}

__device__ __forceinline__ unsigned mono_key(float s) { const unsigned b = __float_as_uint(s); return b ^ ((unsigned)((int)b >> 31) | 0x80000000u); }

__device__ __forceinline__ void phase_a1(unsigned char* lds, const bf16_t* IQ, const bf16_t* IK, const float* IW, unsigned short* MASK, int tid, int bid, int G) {
    const int lane = tid & 63, w = __builtin_amdgcn_readfirstlane(tid >> 6), q = lane & 15, g = lane >> 4;
    unsigned* red = (unsigned*)lds;
    for (int L = bid; L < 1024; L += G) {
        const int b = L >> 8, c = L & 255, qg = (b & 1) ? 255 - c : c;
        const int row0 = b * SEQ + qg * 16;
        unsigned short* mrow = MASK + (size_t)(row0 + q) * 256;
        if (qg <= 15) {
#pragma unroll
            for (int i = 0; i < 2; ++i) { const int kt = 8 * i + w; if (kt <= qg && g == 0) mrow[kt] = (kt < qg) ? (unsigned short)0xFFFFu : (unsigned short)((2u << q) - 1u); }
            continue;
        }
        bf16x8 iqf[8]; float wv[8];
#pragma unroll
        for (int h = 0; h < 8; ++h) iqf[h] = *(const bf16x8*)(IQ + (size_t)(row0 + q) * 256 + h * 32 + 8 * g);
        { const f32x4 a = *(const f32x4*)(IW + (size_t)(row0 + q) * 8), bq = *(const f32x4*)(IW + (size_t)(row0 + q) * 8 + 4);
          wv[0] = a[0]; wv[1] = a[1]; wv[2] = a[2]; wv[3] = a[3]; wv[4] = bq[0]; wv[5] = bq[1]; wv[6] = bq[2]; wv[7] = bq[3]; }
        unsigned u[128];
#pragma unroll
        for (int i = 0; i < 32; ++i) {
            const int kt = 8 * i + w;
            if (kt <= qg) {
                const bf16x8 kf = *(const bf16x8*)(IK + (size_t)(b * SEQ + kt * 16 + q) * 32 + 8 * g);
                f32x4 s = {0.f, 0.f, 0.f, 0.f};
#pragma unroll
                for (int h = 0; h < 8; ++h) { const f32x4 a = mfma16(kf, iqf[h], (f32x4){0.f, 0.f, 0.f, 0.f});
#pragma unroll
                    for (int j = 0; j < 4; ++j) s[j] = __builtin_fmaf(wv[h], fmaxf(a[j], 0.f), s[j]); }
#pragma unroll
                for (int j = 0; j < 4; ++j) { unsigned uu = mono_key(s[j]); if (kt == qg && (4 * g + j) > q) uu = 0u; u[4 * i + j] = uu; }
            } else {
#pragma unroll
                for (int j = 0; j < 4; ++j) u[4 * i + j] = 0u;
            }
        }
        const int nact = (qg >= w) ? ((qg - w) >> 3) + 1 : 0;
        unsigned prefix = 0u;
#pragma unroll 1
        for (int bit = 31; bit >= 0; --bit) {
            const unsigned cand = prefix | (1u << bit);
            unsigned cnt = 0u;
#pragma unroll
            for (int blk = 0; blk < 4; ++blk) {
                if (nact > blk * 8) {
#pragma unroll
                    for (int r = 0; r < 32; ++r) cnt += (u[blk * 32 + r] >= cand) ? 1u : 0u;
                }
            }
            cnt += __shfl_xor(cnt, 16); cnt += __shfl_xor(cnt, 32);
            unsigned* rs = red + (bit & 1) * 128;
            if (g == 0) rs[w * 16 + q] = cnt;
            __syncthreads();
            unsigned tot = 0u;
#pragma unroll
            for (int ww = 0; ww < 8; ++ww) tot += rs[ww * 16 + q];
            if (tot >= 256u) prefix = cand;
        }
        const unsigned thr = prefix > 1u ? prefix : 1u;
#pragma unroll
        for (int i = 0; i < 32; ++i) {
            const int kt = 8 * i + w;
            if (kt <= qg) {
                unsigned nib = 0u;
#pragma unroll
                for (int j = 0; j < 4; ++j) nib |= (u[4 * i + j] >= thr ? 1u : 0u) << j;
                unsigned wd = nib << (4 * g); wd |= __shfl_xor(wd, 16); wd |= __shfl_xor(wd, 32);
                if (g == 0) mrow[kt] = (unsigned short)wd;
            }
        }
    }
}

__device__ __forceinline__ void phase_a2(unsigned char* lds, const bf16_t* QA, bf16_t* OA, const bf16_t* KA, const bf16_t* VTA, const unsigned short* MASK,
                                         const float* qn, const float* kn, int tid, int bid, int G) {
    const int lane = tid & 63, w = __builtin_amdgcn_readfirstlane(tid >> 6), q = lane & 15, g = lane >> 4;
    bf16_t* Kt = (bf16_t*)lds;
    bf16_t* Vt = (bf16_t*)(lds + 2 * 64 * 72 * 2);
    const float msh = LOG2E * 8.f * wave_max(fabsf(qn[lane])) * wave_max(fabsf(kn[lane])) * 1.02f + 0.25f;
    const int srow = tid >> 3, sch = tid & 7;
    for (int L = bid; L < 512; L += G) {
        const int jj = L >> 8, c = L & 255, bh = c >> 4, qb = jj ? 31 - (c & 15) : (c & 15);
        const int b = bh >> 2, h = bh & 3;
        const int qgw = qb * 8 + w;
        const int row0 = b * SEQ + qb * 128 + 16 * w;
        bf16x8 qf[2];
#pragma unroll
        for (int hf = 0; hf < 2; ++hf) qf[hf] = *(const bf16x8*)(QA + (size_t)(row0 + q) * 256 + h * 64 + hf * 32 + 8 * g);
        const unsigned short* mrow = MASK + (size_t)(row0 + q) * 256;
        const int nsteps = 2 * qb + 2;
        const bf16_t* ksrc = KA + (size_t)(b * SEQ + srow) * 256 + h * 64 + sch * 8;
        const bf16_t* vsrc = VTA + (size_t)(b * 256 + h * 64 + srow) * SEQ + sch * 8;
        u32x4 kreg = *(const u32x4*)ksrc, vreg = *(const u32x4*)vsrc;
        *(u32x4*)(Kt + srow * 72 + sch * 8) = kreg; *(u32x4*)(Vt + srow * 72 + sch * 8) = vreg;
        u32x2 mcur = *(const u32x2*)mrow, mnext = mcur;
        f32x4 o[4]; float lsum = 0.f;
#pragma unroll
        for (int d = 0; d < 4; ++d) o[d] = (f32x4){0.f, 0.f, 0.f, 0.f};
        __syncthreads();
        for (int st = 0; st < nsteps; ++st) {
            const int buf = st & 1; const bool more = st + 1 < nsteps;
            if (more) { kreg = *(const u32x4*)(ksrc + (size_t)(st + 1) * 64 * 256); vreg = *(const u32x4*)(vsrc + (st + 1) * 64); mnext = *(const u32x2*)(mrow + (st + 1) * 4); }
            const bf16_t* kb_ = Kt + buf * 64 * 72; const bf16_t* vb_ = Vt + buf * 64 * 72;
#pragma unroll
            for (int p = 0; p < 2; ++p) {
                const int kt0 = st * 4 + 2 * p;
                if (kt0 <= qgw) {
                    const unsigned mw = p ? mcur.y : mcur.x;
                    const unsigned nib0 = (mw >> (4 * g)) & 15u, nib1 = (kt0 + 1 <= qgw) ? ((mw >> (16 + 4 * g)) & 15u) : 0u;
                    const bf16_t* kr0 = kb_ + (p * 32 + q) * 72 + 8 * g; const bf16_t* kr1 = kr0 + 16 * 72;
                    f32x4 a0 = mfma16(*(const bf16x8*)kr0, qf[0], (f32x4){0.f, 0.f, 0.f, 0.f}); a0 = mfma16(*(const bf16x8*)(kr0 + 32), qf[1], a0);
                    f32x4 a1 = mfma16(*(const bf16x8*)kr1, qf[0], (f32x4){0.f, 0.f, 0.f, 0.f}); a1 = mfma16(*(const bf16x8*)(kr1 + 32), qf[1], a1);
                    float p0[4], p1[4];
#pragma unroll
                    for (int j = 0; j < 4; ++j) { p0[j] = ((nib0 >> j) & 1u) ? __builtin_amdgcn_exp2f(a0[j] - msh) : 0.f; p1[j] = ((nib1 >> j) & 1u) ? __builtin_amdgcn_exp2f(a1[j] - msh) : 0.f; }
                    lsum += ((p0[0] + p0[1]) + (p0[2] + p0[3])) + ((p1[0] + p1[1]) + (p1[2] + p1[3]));
                    const bf16x8 pf = mk8(cvt_pk_bf16(p0[0], p0[1]), cvt_pk_bf16(p0[2], p0[3]), cvt_pk_bf16(p1[0], p1[1]), cvt_pk_bf16(p1[2], p1[3]));
#pragma unroll
                    for (int d = 0; d < 4; ++d) { const bf16_t* vr = vb_ + (d * 16 + q) * 72 + p * 32 + 4 * g;
                        const u32x2 lo = *(const u32x2*)vr, hi = *(const u32x2*)(vr + 16);
                        o[d] = mfma16(mk8(lo.x, lo.y, hi.x, hi.y), pf, o[d]); }
                }
            }
            if (more) { *(u32x4*)(Kt + (buf ^ 1) * 64 * 72 + srow * 72 + sch * 8) = kreg; *(u32x4*)(Vt + (buf ^ 1) * 64 * 72 + srow * 72 + sch * 8) = vreg; }
            __syncthreads();
            mcur = mnext;
        }
        lsum += __shfl_xor(lsum, 16); lsum += __shfl_xor(lsum, 32);
        const float inv = 1.f / lsum;
#pragma unroll
        for (int d = 0; d < 4; ++d) { const f32x4 v = o[d] * inv;
            *(u32x2*)(OA + (size_t)(row0 + q) * 256 + h * 64 + d * 16 + 4 * g) = (u32x2){cvt_pk_bf16(v[0], v[1]), cvt_pk_bf16(v[2], v[3])}; }
    }
}

__device__ __forceinline__ void phase_b(const bf16_t* PIN, const bf16_t* WpT, const float* pscale, bf16_t* OB, int gw, int ngw, int lane) {
    const int q = lane & 15, g4 = lane >> 4;
    for (int L = gw; L < 4096; L += ngw) {
        const int gp = L & 3, tg = L >> 2; const int row = tg * 16 + q; const int t = row & (SEQ - 1);
        const int win = 2 << gp; const int cnt = (t + 1 < win) ? t + 1 : win; const float inv = 1.f / (float)cnt;
        f32x4 acc[4];
#pragma unroll
        for (int d = 0; d < 4; ++d) acc[d] = (f32x4){0.f, 0.f, 0.f, 0.f};
#pragma unroll
        for (int ch = 0; ch < 2; ++ch) {
            const bf16_t* p = PIN + (size_t)row * 256 + gp * 64 + ch * 32 + 8 * g4;
            const u32x4 ov = *(const u32x4*)p;
            float own[8], sum[8];
            own[0] = bflo(ov.x); own[1] = bfhi(ov.x); own[2] = bflo(ov.y); own[3] = bfhi(ov.y); own[4] = bflo(ov.z); own[5] = bfhi(ov.z); own[6] = bflo(ov.w); own[7] = bfhi(ov.w);
#pragma unroll
            for (int k = 0; k < 8; ++k) sum[k] = own[k];
            for (int i = 1; i < win; ++i) {
                if (i <= t) { const u32x4 v = *(const u32x4*)(p - (size_t)i * 256);
                    sum[0] += bflo(v.x); sum[1] += bfhi(v.x); sum[2] += bflo(v.y); sum[3] += bfhi(v.y); sum[4] += bflo(v.z); sum[5] += bfhi(v.z); sum[6] += bflo(v.w); sum[7] += bfhi(v.w); }
            }
            float pl[8];
#pragma unroll
            for (int k = 0; k < 8; ++k) pl[k] = sum[k] * inv - own[k];
            const bf16x8 bfr = mk8(cvt_pk_bf16(pl[0], pl[1]), cvt_pk_bf16(pl[2], pl[3]), cvt_pk_bf16(pl[4], pl[5]), cvt_pk_bf16(pl[6], pl[7]));
#pragma unroll
            for (int d = 0; d < 4; ++d) { const bf16x8 afr = *(const bf16x8*)(WpT + gp * 4096 + (d * 16 + q) * 64 + ch * 32 + 8 * g4); acc[d] = mfma16(afr, bfr, acc[d]); }
        }
#pragma unroll
        for (int d = 0; d < 4; ++d) { const int d0 = d * 16 + 4 * g4; const f32x4 sc = *(const f32x4*)(pscale + gp * 64 + d0); const f32x4 v = acc[d] * sc;
            *(u32x2*)(OB + (size_t)row * 256 + gp * 64 + d0) = (u32x2){cvt_pk_bf16(v[0], v[1]), cvt_pk_bf16(v[2], v[3])}; }
    }
}

__device__ __forceinline__ void phase_c(unsigned char* lds, const bf16_t* GV, const bf16_t* GU, bf16_t* OC, const float* gamma, const bf16_t* Wtril, const float* gbias, int tid, int bid, int G) {
    bf16_t* LT = (bf16_t*)lds;
    const int lane = tid & 63, w = __builtin_amdgcn_readfirstlane(tid >> 6), q = lane & 15, g4 = lane >> 4;
    for (int L = bid; L < 512; L += G) {
        const int gp = L & 3, chk = L >> 2; const int R0 = chk * 128;
        {
            const int row = tid >> 2, part = tid & 3;
            const bf16_t* src = GV + (size_t)(R0 + row) * 256 + part * 64;
            float x[64];
#pragma unroll
            for (int k8 = 0; k8 < 8; ++k8) { const u32x4 v = *(const u32x4*)(src + 8 * k8);
                x[8 * k8 + 0] = bflo(v.x); x[8 * k8 + 1] = bfhi(v.x); x[8 * k8 + 2] = bflo(v.y); x[8 * k8 + 3] = bfhi(v.y); x[8 * k8 + 4] = bflo(v.z); x[8 * k8 + 5] = bfhi(v.z); x[8 * k8 + 6] = bflo(v.w); x[8 * k8 + 7] = bfhi(v.w); }
            float s = 0.f;
#pragma unroll
            for (int k = 0; k < 64; ++k) s += x[k];
            s += __shfl_xor(s, 1); s += __shfl_xor(s, 2);
            const float mean = s * (1.f / 256.f); float ss = 0.f;
#pragma unroll
            for (int k = 0; k < 64; ++k) { const float dd = x[k] - mean; ss += dd * dd; }
            ss += __shfl_xor(ss, 1); ss += __shfl_xor(ss, 2);
            const float rstd = __builtin_amdgcn_rsqf(ss * (1.f / 256.f) + EPSN);
            if (part == gp) {
#pragma unroll
                for (int k4 = 0; k4 < 16; ++k4) { const f32x4 gm = *(const f32x4*)(gamma + gp * 64 + 4 * k4);
#pragma unroll
                    for (int i = 0; i < 4; ++i) LT[(4 * k4 + i) * 136 + row] = f2bf((x[4 * k4 + i] - mean) * rstd * gm[i]); }
            }
        }
        __syncthreads();
        {
            f32x4 acc[4];
#pragma unroll
            for (int d = 0; d < 4; ++d) acc[d] = (f32x4){0.f, 0.f, 0.f, 0.f};
            const int t = 16 * w + q; const int nsb = ((16 * w + 15) >> 5) + 1;
            for (int sb = 0; sb < nsb; ++sb) {
                const bf16x8 bfr = *(const bf16x8*)(Wtril + ((size_t)gp * 128 + t) * 128 + sb * 32 + 8 * g4);
#pragma unroll
                for (int d = 0; d < 4; ++d) { const bf16x8 afr = *(const bf16x8*)(LT + (d * 16 + q) * 136 + sb * 32 + 8 * g4); acc[d] = mfma16(afr, bfr, acc[d]); }
            }
            const float bias = gbias[gp * 128 + t];
#pragma unroll
            for (int d = 0; d < 4; ++d) { const size_t eo = (size_t)(R0 + t) * 256 + gp * 64 + d * 16 + 4 * g4; const u32x2 uu = *(const u32x2*)(GU + eo);
                const float r0 = bflo(uu.x) * (acc[d][0] + bias), r1 = bfhi(uu.x) * (acc[d][1] + bias), r2 = bflo(uu.y) * (acc[d][2] + bias), r3 = bfhi(uu.y) * (acc[d][3] + bias);
                *(u32x2*)(OC + eo) = (u32x2){cvt_pk_bf16(r0, r1), cvt_pk_bf16(r2, r3)}; }
        }
        __syncthreads();
    }
}

__device__ __forceinline__ void sb_tile(const f32x4 z, int kbase, int tq, int g, float& carry, float (&a)[4]) {
    float lm[4]; bool msk[4];
#pragma unroll
    for (int j = 0; j < 4; ++j) { msk[j] = (kbase + 4 * g + j) >= tq;
        const float e = __builtin_amdgcn_exp2f(-fabsf(z[j]) * LOG2E); const float sp = fmaxf(z[j], 0.f) + __builtin_amdgcn_logf(1.f + e) * LN2;
        lm[j] = msk[j] ? 0.f : -sp; }
    const float suf2 = lm[3], suf1 = lm[3] + lm[2], suf0 = suf1 + lm[1]; const float T = suf0 + lm[0];
    const float x16 = __shfl_xor(T, 16); const float Pp = T + x16; const float Qq = __shfl_xor(Pp, 32);
    const float Sg = ((g & 1) ? 0.f : x16) + ((g & 2) ? 0.f : Qq);
    const float base = carry + Sg;
    const float tl[4] = {base + suf0, base + suf1, base + suf2, base};
#pragma unroll
    for (int j = 0; j < 4; ++j) a[j] = msk[j] ? 0.f : __builtin_amdgcn_exp2f((z[j] + lm[j] + tl[j]) * LOG2E);
    carry += Pp + Qq;
}
__device__ __forceinline__ void phase_d(const bf16_t* SQ, bf16_t* OD, const bf16_t* SK, const bf16_t* VTS, int gw, int ngw, int lane) {
    const int q = lane & 15, g = lane >> 4;
    for (int L = gw; L < 4096; L += ngw) {
        const int qg = L & 255, bh = L >> 8, b = bh >> 2, h = bh & 3;
        const int row0 = b * SEQ + qg * 16; const int tq = qg * 16 + q;
        bf16x8 qf[2];
#pragma unroll
        for (int hf = 0; hf < 2; ++hf) qf[hf] = *(const bf16x8*)(SQ + (size_t)(row0 + q) * 256 + h * 64 + hf * 32 + 8 * g);
        f32x4 o[4];
#pragma unroll
        for (int d = 0; d < 4; ++d) o[d] = (f32x4){0.f, 0.f, 0.f, 0.f};
        float carry = 0.f;
        for (int pp = qg >> 1; pp >= 0; --pp) {
            const int kt0 = 2 * pp, kt1 = kt0 + 1;
            float a0[4], a1[4];
            if (kt1 <= qg) {
                const bf16_t* kr = SK + (size_t)(b * SEQ + kt1 * 16 + q) * 256 + h * 64 + 8 * g;
                f32x4 z = mfma16(*(const bf16x8*)kr, qf[0], (f32x4){0.f, 0.f, 0.f, 0.f}); z = mfma16(*(const bf16x8*)(kr + 32), qf[1], z);
                sb_tile(z, kt1 * 16, tq, g, carry, a1);
            } else {
#pragma unroll
                for (int j = 0; j < 4; ++j) a1[j] = 0.f;
            }
            {
                const bf16_t* kr = SK + (size_t)(b * SEQ + kt0 * 16 + q) * 256 + h * 64 + 8 * g;
                f32x4 z = mfma16(*(const bf16x8*)kr, qf[0], (f32x4){0.f, 0.f, 0.f, 0.f}); z = mfma16(*(const bf16x8*)(kr + 32), qf[1], z);
                sb_tile(z, kt0 * 16, tq, g, carry, a0);
            }
            const bf16x8 pf = mk8(cvt_pk_bf16(a0[0], a0[1]), cvt_pk_bf16(a0[2], a0[3]), cvt_pk_bf16(a1[0], a1[1]), cvt_pk_bf16(a1[2], a1[3]));
#pragma unroll
            for (int d = 0; d < 4; ++d) { const bf16_t* vr = VTS + (size_t)(b * 256 + h * 64 + d * 16 + q) * SEQ + kt0 * 16 + 4 * g;
                const u32x2 lo = *(const u32x2*)vr, hi = *(const u32x2*)(vr + 16);
                o[d] = mfma16(mk8(lo.x, lo.y, hi.x, hi.y), pf, o[d]); }
            if (__all(carry < -104.f)) break;
        }
#pragma unroll
        for (int d = 0; d < 4; ++d) *(u32x2*)(OD + (size_t)(row0 + q) * 256 + h * 64 + d * 16 + 4 * g) = (u32x2){cvt_pk_bf16(o[d][0], o[d][1]), cvt_pk_bf16(o[d][2], o[d][3])};
    }
}

#define XB_TMO      128
#define XB_XCNT(j)  (256  + 64 * (j))
#define XB_XSUB(j)  (1280 + 64 * (j))
#define XB_XGEN(j)  (2304 + 64 * (j))
#define XB_TOP      3328
#define XB_TOPGEN   3392
#define XCD_BAR_WORDS 3456
#define XB_SPIN_CAP (1u << 18)

__device__ __forceinline__ unsigned xb_ld(unsigned* p)              { return __hip_atomic_load(p, __ATOMIC_RELAXED, __HIP_MEMORY_SCOPE_AGENT); }
__device__ __forceinline__ unsigned xb_add(unsigned* p, unsigned v) { return __hip_atomic_fetch_add(p, v, __ATOMIC_RELAXED, __HIP_MEMORY_SCOPE_AGENT); }
__device__ __forceinline__ unsigned xb_xcc_id() { return (unsigned)__builtin_amdgcn_s_getreg((3 << 11) | 20) & 0xFu; }
#define XB_SPIN(cond, bar) do { unsigned _sp = 0; while (cond) { __builtin_amdgcn_s_sleep(1); \
    if ((++_sp & 255u) == 0u) { if (xb_ld(&(bar)[XB_TMO])) break; if (_sp > XB_SPIN_CAP) { atomicAdd(&(bar)[XB_TMO], 1u); break; } } } } while (0)

struct XcdBarrier {
    unsigned* bar; unsigned x;
    volatile LAS unsigned* st;
};

__device__ __forceinline__ XcdBarrier xcd_barrier_post(unsigned* bar, volatile LAS unsigned* st) {
    XcdBarrier b; b.bar = bar; b.x = xb_xcc_id(); b.st = st;
    if (threadIdx.x == 0) (void)xb_add(&bar[XB_XCNT(b.x)], 1u);
    return b;
}
__device__ __forceinline__ void xcd_barrier_complete(unsigned* bar, unsigned x, unsigned& nloc, unsigned& nx) {
    const unsigned G = gridDim.x * gridDim.y * gridDim.z;
    unsigned sum, cnt, mine, sp = 0u;
    for (;;) {
        sum = 0u; cnt = 0u; mine = 0u;
#pragma unroll
        for (unsigned j = 0; j < 16; ++j) { const unsigned c = xb_ld(&bar[XB_XCNT(j)]); sum += c; cnt += (c > 0u) ? 1u : 0u; mine = (j == x) ? c : mine; }
        if (sum == G) break;
        __builtin_amdgcn_s_sleep(1);
        if ((++sp & 255u) == 0u) { if (xb_ld(&bar[XB_TMO])) break; if (sp > XB_SPIN_CAP) { atomicAdd(&bar[XB_TMO], 1u); break; } }
    }
    nloc = mine > 0u ? mine : 1u; nx = cnt > 0u ? cnt : 1u;
}

__device__ __forceinline__ void xcd_barrier(const XcdBarrier& b) {
    asm volatile("s_waitcnt vmcnt(0)" ::: "memory");
    __syncthreads();
    if (threadIdx.x == 0) {
        unsigned* bar = b.bar;
        __builtin_amdgcn_s_waitcnt(0);
        unsigned nloc = b.st[0], nx = b.st[1];
        if (nloc == 0u) { xcd_barrier_complete(bar, b.x, nloc, nx); b.st[0] = nloc; b.st[1] = nx; }
        const unsigned old = xb_add(&bar[XB_XSUB(b.x)], 1u);
        const unsigned gen = old / nloc;
        if (old + 1u == (gen + 1u) * nloc) {
            __builtin_amdgcn_fence(__ATOMIC_RELEASE, "agent");
            asm volatile("s_waitcnt vmcnt(0)" ::: "memory");
            const unsigned og = xb_add(&bar[XB_TOP], 1u);
            const unsigned tg = og / nx;
            if (og + 1u == (tg + 1u) * nx) xb_add(&bar[XB_TOPGEN], 1u);
            else XB_SPIN(xb_ld(&bar[XB_TOPGEN]) == tg, bar);
            __builtin_amdgcn_fence(__ATOMIC_ACQUIRE, "agent");
            xb_add(&bar[XB_XGEN(b.x)], 1u);
            asm volatile("s_waitcnt vmcnt(0)" ::: "memory");
        } else {
            XB_SPIN(xb_ld(&bar[XB_XGEN(b.x)]) == gen, bar);
            __builtin_amdgcn_fence(__ATOMIC_ACQUIRE, "agent");
            asm volatile("s_waitcnt vmcnt(0)" ::: "memory");
        }
    }
    __syncthreads();
}

#ifndef REP_P0
#define REP_P0 1
#endif
#ifndef REP_P1
#define REP_P1 1
#endif
#ifndef REP_A1
#define REP_A1 1
#endif
#ifndef REP_BCD
#define REP_BCD 1
#endif
#ifndef REP_A2
#define REP_A2 1
#endif
#ifndef REP_MG
#define REP_MG 1
#endif
#ifndef REP_UP
#define REP_UP 1
#endif
#ifndef REP_WO
#define REP_WO 1
#endif
#ifndef REP_N2
#define REP_N2 1
#endif
#ifndef REP_DN
#define REP_DN 1
#endif
#ifndef REP_SYNC
#define REP_SYNC 1
#endif
#define GSYNC() do { _Pragma("unroll 1") for (int r_ = 0; r_ < REP_SYNC; ++r_) xcd_barrier(bar); } while (0)
#define REPEAT(n) _Pragma("unroll 1") for (int rep_ = 0; rep_ < (n); ++rep_)
struct Args { const float* in[16]; float* out; unsigned char* ws; };
constexpr int LDS_BYTES = 147456;
__device__ __forceinline__ unsigned char* opq(unsigned char* p) { asm volatile("" : "+s"(p)); return p; }
__device__ __forceinline__ int opq_tid() { int t = threadIdx.x; asm volatile("" : "+v"(t)); return t; }
#define WSB(T, off) ((T*)(ws + (off)))
constexpr int PTAB_OFF = 147456 - 512, BST_OFF = 147456 - 64;
__device__ __forceinline__ void* ldp(PG8_LAS unsigned char* ldsl, int i) {
    unsigned off = PTAB_OFF + 8 * i; asm volatile("" : "+v"(off));
    const unsigned long long v = *(volatile LAS unsigned long long*)(ldsl + off);
    const unsigned lo = __builtin_amdgcn_readfirstlane((unsigned)v), hi = __builtin_amdgcn_readfirstlane((unsigned)(v >> 32));
    return (void*)(((unsigned long long)hi << 32) | lo);
}

__global__ void __launch_bounds__(512, 2) fwd_kernel(Args a) {
    extern __shared__ __attribute__((aligned(16))) unsigned char lds[];
    cg::grid_group grid = cg::this_grid();
    PG8_LAS unsigned char* ldsl = (PG8_LAS unsigned char*)lds;
    if (a.ws == nullptr) grid.sync();
    if (threadIdx.x == 0) { ((volatile LAS unsigned*)(ldsl + BST_OFF))[0] = 0u; ((volatile LAS unsigned*)(ldsl + BST_OFF))[1] = 0u; }
    if (threadIdx.x == 0) { LAS unsigned long long* tb = (LAS unsigned long long*)(ldsl + PTAB_OFF);
#pragma unroll
        for (int i = 0; i < 16; ++i) tb[i] = (unsigned long long)a.in[i];
        tb[16] = (unsigned long long)a.out; tb[17] = (unsigned long long)a.ws; }
    __syncthreads();
    XcdBarrier bar = xcd_barrier_post((unsigned*)a.ws + 1024, (volatile LAS unsigned*)(ldsl + BST_OFF));
#define INP(i) ((const float*)ldp(ldsl, (i)))
#define OUTP ((float*)ldp(ldsl, 16))
#define WSP ((unsigned char*)ldp(ldsl, 17))

#define PHASE_VARS unsigned char* ws = WSP; int bid = blockIdx.x; asm volatile("" : "+s"(bid)); int G = gridDim.x; asm volatile("" : "+s"(G)); \
    const int tid = opq_tid(), lane = tid & 63, wave = __builtin_amdgcn_readfirstlane(tid >> 6); const int gw = bid * 8 + wave, ngw = G * 8; (void)ws; (void)lane; (void)gw; (void)ngw;
#pragma unroll 1
    for (int l = 0; l < 2; ++l) {
        REPEAT(REP_P0) {
            PHASE_VARS
#ifndef NO_CVT
            Ptrs P;
            P.w_in = INP(2) + (size_t)l * DM * DIN; P.qn = INP(3) + l * 64; P.kn = INP(4) + l * 64; P.pool_w = INP(5) + l * 4 * 64 * 64; P.pool_scale = INP(6) + l * 256;
            P.gm_norm = INP(7) + l * 256; P.gm_ws = INP(8) + l * 4 * 128 * 128; P.gm_b = INP(9) + l * 4 * 128; P.w_branch = INP(10) + (size_t)l * 4 * 256 * 1024;
            P.w_out = INP(11) + (size_t)l * 1024 * 1024; P.w_gate = INP(13) + (size_t)l * DM * DFF; P.w_up = INP(14) + (size_t)l * DM * DFF; P.w_down = INP(15) + (size_t)l * DFF * DM;
            convert_weights(P, ws, (LAS float*)(ldsl + wave * 8448), gw, ngw, lane, bid * 512 + tid, G * 512);
#endif
            rmsnorm_rows(l == 0 ? INP(0) : OUTP, INP(1) + l * DM, WSB(bf16_t, WS_XN), gw, ngw, lane);
        }
        GSYNC();
        REPEAT(REP_P1) {
            PHASE_VARS
            pg8::Gemm g{WSB(bf16_t, WS_XN), WSB(bf16_t, WS_WIN), M_, NINP, DM}; pg8::StaticOrder S; S.init(M_, NINP, G, bid);
            EpiIn E{ws, INP(3) + l * 64, INP(4) + l * 64};
#ifndef NO_G1
            pg8::gemm_phase<EpiIn, pg8::StaticOrder, true, true>(ldsl, g, S, E);
#endif
        }
        GSYNC();
        REPEAT(REP_A1) {
            PHASE_VARS
#ifndef NO_A1
            phase_a1(lds, WSB(bf16_t, WS_IQ), WSB(bf16_t, WS_IK), WSB(float, WS_IW), WSB(unsigned short, WS_MASK), tid, bid, G);
#endif
            __syncthreads();
        }
        REPEAT(REP_BCD) {
        {
            PHASE_VARS
#ifndef NO_C
            phase_c(lds, WSB(bf16_t, WS_GV), WSB(bf16_t, WS_GU), WSB(bf16_t, WS_OC), INP(7) + l * 256, WSB(bf16_t, WS_WS), INP(9) + l * 4 * 128, tid, bid, G);
#endif
        }
        {
            PHASE_VARS
#ifndef NO_B
            phase_b(WSB(bf16_t, WS_PIN), WSB(bf16_t, WS_WP), INP(6) + l * 256, WSB(bf16_t, WS_OB), gw, ngw, lane);
#endif
        }
        {
            PHASE_VARS
#ifndef NO_D
            phase_d(WSB(bf16_t, WS_SQ), WSB(bf16_t, WS_OD), WSB(bf16_t, WS_SK), WSB(bf16_t, WS_VTS), gw, ngw, lane);
#endif
        }
        }
        GSYNC();
        REPEAT(REP_A2) {
            PHASE_VARS
#ifndef NO_A2
            phase_a2(lds, WSB(bf16_t, WS_QA), WSB(bf16_t, WS_OA), WSB(bf16_t, WS_KA), WSB(bf16_t, WS_VTA), WSB(unsigned short, WS_MASK), INP(3) + l * 64, INP(4) + l * 64, tid, bid, G);
#endif
        }
        GSYNC();
        REPEAT(REP_MG)
#pragma unroll 1
        for (int nb = 0; nb < 4; ++nb) {
            PHASE_VARS
            const bf16_t* A = WSB(bf16_t, nb == 0 ? WS_OA : nb == 1 ? WS_OB : nb == 2 ? WS_OC : WS_OD);
            int Kv = 256; asm volatile("" : "+s"(Kv));
            pg8::Gemm g{A, WSB(bf16_t, WS_WB) + (size_t)nb * 1024 * 256, M_, DM, Kv}; pg8::StaticOrder S; S.init(M_, DM, G, bid);
            EpiMerge E{ws + WS_G, WSB(bf16_t, WS_XN), nb};
#ifndef NO_G2
            pg8::gemm_phase<EpiMerge, pg8::StaticOrder, true, true>(ldsl, g, S, E);
#endif
            __syncthreads();
        }
        GSYNC();
        REPEAT(REP_WO) {
            PHASE_VARS
            pg8::Gemm g{WSB(bf16_t, WS_XN), WSB(bf16_t, WS_WOUT), M_, DM, DM}; pg8::StaticOrder S; S.init(M_, DM, G, bid);
            EpiResid E{l == 0 ? INP(0) : OUTP, rep_ == REP_WO - 1 ? OUTP : WSB(float, WS_S)};
#ifndef NO_G3
            pg8::gemm_phase<EpiResid, pg8::StaticOrder, true, true>(ldsl, g, S, E);
#endif
        }
        GSYNC();
        REPEAT(REP_N2) {
            PHASE_VARS
            rmsnorm_rows(OUTP, INP(12) + l * DM, WSB(bf16_t, WS_XN), gw, ngw, lane);
        }
        GSYNC();
        REPEAT(REP_UP) {
            PHASE_VARS
            pg8::Gemm g{WSB(bf16_t, WS_XN), WSB(bf16_t, WS_WGU), M_, 2 * DFF, DM}; pg8::StaticOrder S; S.init(M_, 2 * DFF, G, bid);
            EpiSwiGLU E{WSB(bf16_t, WS_R1)};
#ifndef NO_G4
            pg8::gemm_phase<EpiSwiGLU, pg8::StaticOrder, true, true>(ldsl, g, S, E);
#endif
        }
        GSYNC();
        REPEAT(REP_DN) {
            PHASE_VARS
            pg8::Gemm g{WSB(bf16_t, WS_R1), WSB(bf16_t, WS_WD), M_, DM, DFF}; pg8::StaticOrder S; S.init(M_, DM, G, bid);
            float* o = OUTP; EpiResid E{o, rep_ == REP_DN - 1 ? o : WSB(float, WS_S)};
#ifndef NO_G3
            pg8::gemm_phase<EpiResid, pg8::StaticOrder, true, true>(ldsl, g, S, E);
#endif
        }
        if (l == 0) GSYNC();
    }
}

extern "C" void kernel_launch(void* const* d_in, const int* in_sizes, int n_in, void* d_out, int out_size, void* d_ws, size_t ws_size, hipStream_t stream) {
    static int grid_blocks = 0;
    if (grid_blocks == 0) {
        if (n_in != 16 || out_size != M_ * DM || ws_size < WS_END) { fprintf(stderr, "kernel_launch: unexpected shapes (n_in %d out %d ws %zu)\n", n_in, out_size, ws_size); grid_blocks = -1; return; }
        int dev = 0, cus = 0, per_cu = 0;
        hipGetDevice(&dev);
        hipDeviceGetAttribute(&cus, hipDeviceAttributeMultiprocessorCount, dev);
        hipFuncSetAttribute((const void*)fwd_kernel, hipFuncAttributeMaxDynamicSharedMemorySize, LDS_BYTES);
        if (hipOccupancyMaxActiveBlocksPerMultiprocessor(&per_cu, (const void*)fwd_kernel, 512, LDS_BYTES) != hipSuccess || per_cu < 1) per_cu = 1;
        (void)hipGetLastError();
        grid_blocks = cus;
    }
    if (grid_blocks < 0) return;
    Args a{};
    for (int i = 0; i < 16; ++i) a.in[i] = (const float*)d_in[i];
    a.out = (float*)d_out; a.ws = (unsigned char*)d_ws;
    if (hipMemsetAsync(d_ws, 0, 65536, stream) != hipSuccess) { fprintf(stderr, "kernel_launch: memset failed\n"); return; }
    void* args[] = {&a};
    hipError_t e = hipLaunchCooperativeKernel((const void*)fwd_kernel, dim3(grid_blocks), dim3(512), args, LDS_BYTES, stream);
    if (e != hipSuccess) fprintf(stderr, "cooperative launch failed: %s (grid %d)\n", hipGetErrorString(e), grid_blocks);
}
```

```cpp
#include <hip/hip_runtime.h>
#include <hip/hip_cooperative_groups.h>
#include <cstdio>
#include <cstdint>
namespace pg8 {
#define PG8_LAS __attribute__((address_space(3)))
typedef unsigned short bf16_t;
typedef short bf16x8 __attribute__((ext_vector_type(8)));
typedef float f32x4 __attribute__((ext_vector_type(4)));
typedef unsigned u32x4 __attribute__((ext_vector_type(4)));
constexpr int BM = 256, BK = 64, HALF = 128, HTB = HALF * BK * 2  , STAGE_BYTES = 8 * HTB, NXCD = 8, WGM = 8;

__host__ __device__ __forceinline__ int lds_byte(int r, int c) { const int st = (r >> 4) * 2 + (c >> 5), rr = r & 15, cc = c & 31, ob = rr * 64 + cc * 2; return st * 1024 + (ob ^ (((ob >> 9) & 1) << 5)); }
__host__ __device__ __forceinline__ void stage_rc(int b, int& R, int& C) { const int st = b / 1024, sb = b % 1024, swz = sb ^ (((sb >> 9) & 1) << 5); R = (st >> 1) * 16 + swz / 64; C = (st & 1) * 32 + (swz % 64) / 2; }
__host__ __device__ __forceinline__ int perm32(int rho) { const int n = rho >> 4, i = rho & 15; return 8 * (i >> 2) + 4 * n + (i & 3); }

struct Unit { int pm, pn; };
struct Gemm { const bf16_t* A; const bf16_t* Bt; int M, N, K; };

struct StaticOrder {
    int nM, nN, nwg, G, c;
    __host__ __device__ void init(int M, int N, int G_, int c_) { nM = M / BM; nN = N / BM; nwg = nM * nN; G = G_; c = c_; }
    __host__ __device__ bool next(int i, Unit& u) const {
        const long L = (long)i * G + c; if (L >= nwg) return false;
        int wgid = (int)L; { const int q = nwg / NXCD, r = nwg % NXCD, xcd = wgid % NXCD, off = wgid / NXCD; wgid = (xcd < r ? xcd * (q + 1) : r * (q + 1) + (xcd - r) * q) + off; }
        const int nig = WGM * nN, gid = wgid / nig, fm = gid * WGM, gsz = (nM - fm) < WGM ? (nM - fm) : WGM;
        u.pm = fm + ((wgid % nig) % gsz); u.pn = (wgid % nig) / gsz; return true;
    }
    __device__ __forceinline__ void a_ready(const Unit&) const {}
    __device__ __forceinline__ void done(const Unit&) const {}
};

__device__ __forceinline__ unsigned cvt_pk_bf16(float lo, float hi) { unsigned r; asm volatile("v_cvt_pk_bf16_f32 %0, %1, %2" : "=v"(r) : "v"(lo), "v"(hi)); return r; }
template <class Epi, class Sched, bool ALIGN_EPI = false, bool SP2 = false>
__device__ __forceinline__ void gemm_phase(PG8_LAS unsigned char* lds, const Gemm g, const Sched& S, const Epi& E) {
    int tid_ = threadIdx.x; asm volatile("" : "+v"(tid_)); const int tid = tid_, wid = __builtin_amdgcn_readfirstlane(tid >> 6), lane = tid & 63, wr = wid >> 2, wc = wid & 3, fr = lane & 15, fq = lane >> 4;
    const int K = g.K, nt = K / BK;
    unsigned voffA[2], voffB[2];
#pragma unroll
    for (int i = 0; i < 2; ++i) { int R, C; stage_rc(tid * 16 + i * 8192, R, C); const int Rb = Epi::PERM ? ((R & ~31) + perm32(R & 31)) : R;
        voffA[i] = (unsigned)(R * K + C) * 2u; voffB[i] = (unsigned)(Rb * K + C) * 2u; }
    const size_t kstep = (size_t)(BK * 2);
    const size_t hstep = (size_t)HALF * K * 2;
    const size_t tstep = 2 * hstep;
    const unsigned ldsw = (unsigned)wid * 1024u;
    const int aoff = lds_byte(wr * 64 + fr, fq * 8), boff = lds_byte(wc * 32 + fr, fq * 8);
#define PG8_SA(b, h) (((b) * 2 + (h)) * HTB)
#define PG8_SB(b, h) ((4 + (b) * 2 + (h)) * HTB)
#define PG8_STAGE(bufoff, gbase, voff) do { _Pragma("unroll") for (int _i = 0; _i < 2; ++_i) \
        __builtin_amdgcn_global_load_lds((const unsigned*)((const char*)(gbase) + (voff)[_i]), (PG8_LAS unsigned*)(lds + (bufoff) + ldsw + _i * 8192), 16, 0, 0); } while (0)
#define PG8_LDA(dst, b, h) do { _Pragma("unroll") for (int m = 0; m < 4; ++m) _Pragma("unroll") for (int k = 0; k < 2; ++k) dst[m][k] = *(const PG8_LAS bf16x8*)(lds + PG8_SA(b, h) + aoff + m * 2048 + k * 1024); } while (0)
#define PG8_LDB(dst, b, h) do { _Pragma("unroll") for (int n = 0; n < 2; ++n) _Pragma("unroll") for (int k = 0; k < 2; ++k) dst[n][k] = *(const PG8_LAS bf16x8*)(lds + PG8_SB(b, h) + boff + n * 2048 + k * 1024); } while (0)
#define PG8_MMA(ai, bj, At, Bt) do { __builtin_amdgcn_s_setprio(1); _Pragma("unroll") for (int m = 0; m < 4; ++m) _Pragma("unroll") for (int n = 0; n < 2; ++n) _Pragma("unroll") for (int k = 0; k < 2; ++k) \
        acc[ai][bj][m][n] = __builtin_amdgcn_mfma_f32_16x16x32_bf16(Bt[n][k], At[m][k], acc[ai][bj][m][n], 0, 0, 0); __builtin_amdgcn_s_setprio(0); } while (0)
#define PG8_WAIT_V(n) asm volatile("s_waitcnt vmcnt(" #n ")" ::: "memory")
#define PG8_WAIT_L(n) asm volatile("s_waitcnt lgkmcnt(" #n ")" ::: "memory")
#define PG8_BAR __builtin_amdgcn_s_barrier()
#define PG8_SCHED __builtin_amdgcn_sched_barrier(0)
    Unit cur, nxt; int ui = 0;
    if (!S.next(0, cur)) return;
    f32x4 acc[2][2][4][2];
#pragma unroll
    for (int a = 0; a < 2; ++a)
#pragma unroll
        for (int b = 0; b < 2; ++b)
#pragma unroll
            for (int m = 0; m < 4; ++m)
#pragma unroll
                for (int n = 0; n < 2; ++n) acc[a][b][m][n] = (f32x4){0.f, 0.f, 0.f, 0.f};
    bf16x8 At[4][2], B0[2][2], B1[2][2];
    const char* cA = (const char*)g.A + (size_t)cur.pm * tstep; const char* cB = (const char*)g.Bt + (size_t)cur.pn * tstep;
    S.a_ready(cur);
    if constexpr (SP2) {
        PG8_STAGE(PG8_SB(0, 0), cB, voffB); PG8_STAGE(PG8_SB(0, 1), cB + hstep, voffB); PG8_STAGE(PG8_SA(0, 0), cA, voffA); PG8_STAGE(PG8_SA(0, 1), cA + hstep, voffA);
        if (wr == 1) PG8_BAR;
        PG8_WAIT_V(2); PG8_BAR;
        PG8_STAGE(PG8_SB(1, 0), cB + kstep, voffB); PG8_STAGE(PG8_SA(1, 0), cA + kstep, voffA); PG8_STAGE(PG8_SB(1, 1), cB + hstep + kstep, voffB);
        PG8_WAIT_V(6); PG8_BAR;
    } else {
        PG8_STAGE(PG8_SB(0, 0), cB, voffB); PG8_STAGE(PG8_SA(0, 0), cA, voffA); PG8_STAGE(PG8_SB(0, 1), cB + hstep, voffB); PG8_STAGE(PG8_SA(0, 1), cA + hstep, voffA);
        if (wr == 1) PG8_BAR;
        PG8_WAIT_V(4); PG8_BAR;
        PG8_STAGE(PG8_SB(1, 0), cB + kstep, voffB); PG8_STAGE(PG8_SA(1, 0), cA + kstep, voffA); PG8_STAGE(PG8_SB(1, 1), cB + hstep + kstep, voffB);
        PG8_WAIT_V(6); PG8_BAR;
    }
    for (;;) {
        const bool has_next = S.next(ui + 1, nxt);
        const char* nA = has_next ? (const char*)g.A + (size_t)nxt.pm * tstep : cA; const char* nB = has_next ? (const char*)g.Bt + (size_t)nxt.pn * tstep : cB;
        for (int t = 0; t < nt; t += 2) {
            const bool last = (t == nt - 2);
            const char* a1 = cA + (size_t)(t + 1) * kstep;
            const char* a2 = last ? nA : cA + (size_t)(t + 2) * kstep; const char* b2 = last ? nB : cB + (size_t)(t + 2) * kstep;
            const char* a3 = a2 + kstep; const char* b3 = b2 + kstep;
            if (last && has_next) S.a_ready(nxt);
            if constexpr (SP2) {
            PG8_LDB(B0, 0, 0); PG8_LDB(B1, 0, 1); PG8_SCHED; PG8_LDA(At, 0, 0); PG8_STAGE(PG8_SA(1, 1), a1 + hstep, voffA);
            PG8_WAIT_V(8); PG8_WAIT_L(0); PG8_BAR; PG8_MMA(0, 0, At, B0); PG8_MMA(0, 1, At, B1); PG8_BAR; PG8_SCHED;
            PG8_LDA(At, 0, 1); PG8_STAGE(PG8_SB(0, 0), b2, voffB); PG8_STAGE(PG8_SB(0, 1), b2 + hstep, voffB); PG8_STAGE(PG8_SA(0, 0), a2, voffA);
            PG8_WAIT_V(8); PG8_WAIT_L(0); PG8_BAR; PG8_MMA(1, 0, At, B0); PG8_MMA(1, 1, At, B1); PG8_BAR; PG8_SCHED;
            PG8_LDB(B0, 1, 0); PG8_LDB(B1, 1, 1); PG8_SCHED; PG8_LDA(At, 1, 0); PG8_STAGE(PG8_SA(0, 1), a2 + hstep, voffA);
            PG8_WAIT_V(8); PG8_WAIT_L(0); PG8_BAR; PG8_MMA(0, 0, At, B0); PG8_MMA(0, 1, At, B1); PG8_BAR; PG8_SCHED;
            PG8_LDA(At, 1, 1); PG8_STAGE(PG8_SB(1, 0), b3, voffB); PG8_STAGE(PG8_SB(1, 1), b3 + hstep, voffB); PG8_STAGE(PG8_SA(1, 0), a3, voffA);
            PG8_WAIT_V(8); PG8_WAIT_L(0); PG8_BAR; PG8_MMA(1, 0, At, B0); PG8_MMA(1, 1, At, B1); PG8_BAR; PG8_SCHED;
            } else {
            PG8_LDB(B0, 0, 0); PG8_SCHED; PG8_LDA(At, 0, 0); PG8_STAGE(PG8_SA(1, 1), a1 + hstep, voffA);
            PG8_WAIT_L(8); PG8_BAR; PG8_WAIT_L(0); PG8_MMA(0, 0, At, B0); PG8_BAR; PG8_SCHED;
            PG8_LDB(B1, 0, 1); PG8_STAGE(PG8_SB(0, 0), b2, voffB);
            PG8_BAR; PG8_WAIT_L(0); PG8_MMA(0, 1, At, B1); PG8_BAR;
            PG8_LDA(At, 0, 1); PG8_STAGE(PG8_SA(0, 0), a2, voffA);
            PG8_BAR; PG8_WAIT_L(0); PG8_MMA(1, 0, At, B0); PG8_BAR; PG8_SCHED;
            PG8_STAGE(PG8_SB(0, 1), b2 + hstep, voffB);
            PG8_WAIT_V(6); PG8_BAR; PG8_MMA(1, 1, At, B1); PG8_BAR;
            PG8_LDB(B0, 1, 0); PG8_SCHED; PG8_LDA(At, 1, 0); PG8_STAGE(PG8_SA(0, 1), a2 + hstep, voffA);
            PG8_WAIT_L(8); PG8_BAR; PG8_WAIT_L(0); PG8_MMA(0, 0, At, B0); PG8_BAR; PG8_SCHED;
            PG8_LDB(B1, 1, 1); PG8_STAGE(PG8_SB(1, 0), b3, voffB);
            PG8_BAR; PG8_WAIT_L(0); PG8_MMA(0, 1, At, B1); PG8_BAR;
            PG8_LDA(At, 1, 1); PG8_STAGE(PG8_SA(1, 0), a3, voffA);
            PG8_BAR; PG8_WAIT_L(0); PG8_MMA(1, 0, At, B0); PG8_BAR; PG8_SCHED;
            PG8_STAGE(PG8_SB(1, 1), b3 + hstep, voffB);
            PG8_WAIT_V(6); PG8_BAR; PG8_MMA(1, 1, At, B1); PG8_BAR;
            }
        }
        if constexpr (ALIGN_EPI) { if (wr == 0) PG8_BAR; }
        if constexpr (!Epi::AFTER_DRAIN) { E(acc, cur, wr, wc, fr, fq); S.done(cur); }
        if (!has_next) break;
#pragma unroll
        for (int a = 0; a < 2; ++a)
#pragma unroll
            for (int b = 0; b < 2; ++b)
#pragma unroll
                for (int m = 0; m < 4; ++m)
#pragma unroll
                    for (int n = 0; n < 2; ++n) acc[a][b][m][n] = (f32x4){0.f, 0.f, 0.f, 0.f};
        cur = nxt; cA = nA; cB = nB; ++ui;
        if constexpr (ALIGN_EPI) { if (wr == 1) PG8_BAR; }
    }
    PG8_WAIT_V(0);
    if constexpr (!ALIGN_EPI) { if (wr == 0) PG8_BAR; }
    PG8_BAR;
    if constexpr (Epi::AFTER_DRAIN) { E.fused(acc, cur, wr, wc, fr, fq, lds, wid, lane); S.done(cur); }
#undef PG8_SA
#undef PG8_SB
#undef PG8_STAGE
#undef PG8_LDA
#undef PG8_LDB
#undef PG8_MMA
#undef PG8_WAIT_V
#undef PG8_WAIT_L
#undef PG8_BAR
#undef PG8_SCHED
}
}
namespace cg = cooperative_groups;
using pg8::bf16_t; using pg8::bf16x8; using pg8::f32x4; using pg8::u32x4; using pg8::Unit; using pg8::cvt_pk_bf16;
typedef unsigned u32x2 __attribute__((ext_vector_type(2)));
#define LAS __attribute__((address_space(3)))
#define LDS_WAIT() asm volatile("s_waitcnt lgkmcnt(0)" ::: "memory")

constexpr int M_ = 16384, DM = 1024, SEQ = 4096, DFF = 2816, DIN = 6696, NINP = 6912;
constexpr float EPSN = 1e-6f;
constexpr float LOG2E = 1.4426950408889634f, LN2 = 0.6931471805599453f;
constexpr float C2 = 0.125f * LOG2E;

constexpr size_t MiB = (size_t)1 << 20;
constexpr size_t WS_WIN = 1 * MiB;
constexpr size_t WS_WB = WS_WIN + (size_t)NINP * 1024 * 2;
constexpr size_t WS_WOUT = WS_WB + 2 * MiB;
constexpr size_t WS_WGU = WS_WOUT + 2 * MiB;
constexpr size_t WS_WD = WS_WGU + 11 * MiB;
constexpr size_t WS_WP = WS_WD + (size_t)1024 * 2816 * 2;
constexpr size_t WS_WS = WS_WP + 32768;
static_assert(WS_WS + 131072 <= 36 * MiB, "weights region");
constexpr size_t WS_XN = 36 * MiB;
constexpr size_t WS_R1 = 68 * MiB;
constexpr size_t WS_G = WS_R1, WS_KA = WS_R1 + 64 * MiB, WS_VTA = WS_KA + 8 * MiB, WS_IQ = WS_VTA + 8 * MiB;
constexpr size_t WS_S = 156 * MiB;
constexpr size_t WS_PIN = WS_S, WS_GU = WS_S + 8 * MiB, WS_GV = WS_S + 16 * MiB, WS_SQ = WS_S + 24 * MiB, WS_SK = WS_S + 32 * MiB,
                 WS_VTS = WS_S + 40 * MiB, WS_QA = WS_S + 48 * MiB, WS_OB = WS_S + 56 * MiB, WS_MASK = 220 * MiB, WS_IK = 228 * MiB, WS_IW = 229 * MiB, WS_OA = 230 * MiB, WS_OC = 238 * MiB, WS_OD = 246 * MiB, WS_END = 254 * MiB;

__device__ __forceinline__ float bf2f(unsigned short v) { return __uint_as_float((unsigned)v << 16); }
__device__ __forceinline__ float bflo(unsigned v) { return __uint_as_float(v << 16); }
__device__ __forceinline__ float bfhi(unsigned v) { return __uint_as_float(v & 0xffff0000u); }
__device__ __forceinline__ unsigned short f2bf(float f) { return (unsigned short)(cvt_pk_bf16(f, 0.f) & 0xffffu); }
__device__ __forceinline__ float sigmoidf_(float x) { return __builtin_amdgcn_rcpf(1.f + __builtin_amdgcn_exp2f(-x * LOG2E)); }
__device__ __forceinline__ float gelu_tanh(float x) { const float u = 0.7978845608028654f * (x + 0.044715f * x * x * x); return x * __builtin_amdgcn_rcpf(1.f + __builtin_amdgcn_exp2f(-2.f * LOG2E * u)); }
__device__ __forceinline__ f32x4 mfma16(bf16x8 a, bf16x8 b, f32x4 c) { return __builtin_amdgcn_mfma_f32_16x16x32_bf16(a, b, c, 0, 0, 0); }
__device__ __forceinline__ bf16x8 mk8(unsigned a, unsigned b, unsigned c, unsigned d) { u32x4 v = {a, b, c, d}; return __builtin_bit_cast(bf16x8, v); }

struct EpiIn {
    static constexpr bool PERM = true, AFTER_DRAIN = false;
    unsigned char* ws; const float *qn, *kn;
    __device__ __forceinline__ void operator()(const f32x4 (&acc)[2][2][4][2], const Unit& u, int wr, int wc, int fr, int fq) const {
        bf16_t* const QA = (bf16_t*)(ws + WS_QA); bf16_t* const KA = (bf16_t*)(ws + WS_KA); bf16_t* const VTA = (bf16_t*)(ws + WS_VTA); bf16_t* const IQ = (bf16_t*)(ws + WS_IQ);
        bf16_t* const PIN = (bf16_t*)(ws + WS_PIN); bf16_t* const GU = (bf16_t*)(ws + WS_GU); bf16_t* const GV = (bf16_t*)(ws + WS_GV); bf16_t* const SQ = (bf16_t*)(ws + WS_SQ);
        bf16_t* const SK = (bf16_t*)(ws + WS_SK); bf16_t* const VTS = (bf16_t*)(ws + WS_VTS); bf16_t* const IK = (bf16_t*)(ws + WS_IK); float* const IW = (float*)(ws + WS_IW); unsigned char* const G = ws + WS_G;
        const int pn = u.pn; const int row0 = u.pm * 256 + wr * 64 + fr; const int cl = wc * 32 + 8 * fq;
        if (pn >= 11) {
            unsigned char* gp = G + (size_t)row0 * 4096 + (pn - 11) * 256 + cl;
#pragma unroll
            for (int ai = 0; ai < 2; ++ai)
#pragma unroll
                for (int m = 0; m < 4; ++m)
#pragma unroll
                    for (int bj = 0; bj < 2; ++bj) {
                        unsigned w2[2];
#pragma unroll
                        for (int n = 0; n < 2; ++n) { const f32x4 v = acc[ai][bj][m][n]; unsigned pk = 0;
#pragma unroll
                            for (int i = 0; i < 4; ++i) { const unsigned qv = (unsigned)(sigmoidf_(v[i]) * 255.f + 0.5f); pk |= qv << (8 * i); }
                            w2[n] = pk; }
                        *(u32x2*)(gp + (size_t)(ai * 128 + m * 16) * 4096 + bj * 128) = (u32x2){w2[0], w2[1]};
                    }
            return;
        }
        if (pn <= 1) {
            const float* gw = pn == 0 ? qn : kn; const float sc = pn == 0 ? C2 : 1.f; bf16_t* T = pn == 0 ? QA : KA;
            f32x4 gv[2][2];
#pragma unroll
            for (int bj = 0; bj < 2; ++bj)
#pragma unroll
                for (int n = 0; n < 2; ++n) gv[bj][n] = *(const f32x4*)(gw + bj * 32 + 8 * fq + 4 * n);
#pragma unroll
            for (int ai = 0; ai < 2; ++ai)
#pragma unroll
                for (int m = 0; m < 4; ++m) {
                    float ss = 0.f;
#pragma unroll
                    for (int bj = 0; bj < 2; ++bj)
#pragma unroll
                        for (int n = 0; n < 2; ++n) { const f32x4 v = acc[ai][bj][m][n]; ss += (v[0] * v[0] + v[1] * v[1]) + (v[2] * v[2] + v[3] * v[3]); }
                    ss += __shfl_xor(ss, 16); ss += __shfl_xor(ss, 32);
                    const float rinv = __builtin_amdgcn_rsqf(ss * (1.f / 64.f) + EPSN) * sc;
                    bf16_t* rp = T + (size_t)(row0 + ai * 128 + m * 16) * 256 + wc * 64 + 8 * fq;
#pragma unroll
                    for (int bj = 0; bj < 2; ++bj) { const f32x4 v0 = acc[ai][bj][m][0] * gv[bj][0] * rinv, v1 = acc[ai][bj][m][1] * gv[bj][1] * rinv;
                        u32x4 w; w.x = cvt_pk_bf16(v0[0], v0[1]); w.y = cvt_pk_bf16(v0[2], v0[3]); w.z = cvt_pk_bf16(v1[0], v1[1]); w.w = cvt_pk_bf16(v1[2], v1[3]);
                        *(u32x4*)(rp + bj * 32) = w; }
                }
            return;
        }
        if (pn == 2 || pn == 9) {
            bf16_t* T = pn == 2 ? VTA : VTS;
#pragma unroll
            for (int ai = 0; ai < 2; ++ai)
#pragma unroll
                for (int m = 0; m < 4; ++m) { const int row = row0 + ai * 128 + m * 16; const int b = row >> 12, t = row & 4095;
#pragma unroll
                    for (int bj = 0; bj < 2; ++bj)
#pragma unroll
                        for (int n = 0; n < 2; ++n) { const f32x4 v = acc[ai][bj][m][n];
#pragma unroll
                            for (int i = 0; i < 4; ++i) T[((size_t)b * 256 + bj * 128 + cl + 4 * n + i) * 4096 + t] = f2bf(v[i]); }
                }
            return;
        }
        if (pn == 10) {
            if (wc == 0) {
#pragma unroll
                for (int ai = 0; ai < 2; ++ai)
#pragma unroll
                    for (int m = 0; m < 4; ++m) { const f32x4 v0 = acc[ai][0][m][0], v1 = acc[ai][0][m][1];
                        u32x4 w; w.x = cvt_pk_bf16(v0[0], v0[1]); w.y = cvt_pk_bf16(v0[2], v0[3]); w.z = cvt_pk_bf16(v1[0], v1[1]); w.w = cvt_pk_bf16(v1[2], v1[3]);
                        *(u32x4*)(IK + (size_t)(row0 + ai * 128 + m * 16) * 32 + 8 * fq) = w; }
            } else if (wc == 1 && fq == 0) {
#pragma unroll
                for (int ai = 0; ai < 2; ++ai)
#pragma unroll
                    for (int m = 0; m < 4; ++m) { float* p = IW + (size_t)(row0 + ai * 128 + m * 16) * 8; *(f32x4*)p = acc[ai][0][m][0]; *(f32x4*)(p + 4) = acc[ai][0][m][1]; }
            }
            return;
        }
        {
            bf16_t* T = pn == 3 ? IQ : pn == 4 ? PIN : pn == 5 ? GU : pn == 6 ? GV : pn == 7 ? SQ : SK;
            const bool act = (pn == 5 || pn == 6); const float sc = pn == 7 ? 0.125f : 1.f;
#pragma unroll
            for (int ai = 0; ai < 2; ++ai)
#pragma unroll
                for (int m = 0; m < 4; ++m) { bf16_t* rp = T + (size_t)(row0 + ai * 128 + m * 16) * 256 + cl;
#pragma unroll
                    for (int bj = 0; bj < 2; ++bj) { f32x4 v0 = acc[ai][bj][m][0] * sc, v1 = acc[ai][bj][m][1] * sc;
                        if (act) {
#pragma unroll
                            for (int i = 0; i < 4; ++i) { v0[i] = gelu_tanh(v0[i]); v1[i] = gelu_tanh(v1[i]); } }
                        u32x4 w; w.x = cvt_pk_bf16(v0[0], v0[1]); w.y = cvt_pk_bf16(v0[2], v0[3]); w.z = cvt_pk_bf16(v1[0], v1[1]); w.w = cvt_pk_bf16(v1[2], v1[3]);
                        *(u32x4*)(rp + bj * 128) = w; }
                }
        }
    }
};

struct EpiMerge {
    static constexpr bool PERM = true, AFTER_DRAIN = false;
    const unsigned char* G; bf16_t* MG; int nb;
    __device__ __forceinline__ void operator()(const f32x4 (&acc)[2][2][4][2], const Unit& u, int wr, int wc, int fr, int fq) const {
        const int row0 = u.pm * 256 + wr * 64 + fr; const int col0 = u.pn * 256 + wc * 32 + 8 * fq;
        const unsigned char* gp0 = G + (size_t)row0 * 4096 + nb * 1024 + col0; bf16_t* mp0 = MG + (size_t)row0 * 1024 + col0;
#pragma unroll
        for (int ai = 0; ai < 2; ++ai)
#pragma unroll
            for (int m = 0; m < 4; ++m) {
#pragma unroll
                for (int bj = 0; bj < 2; ++bj)
#pragma unroll
                    for (int n = 0; n < 2; ++n) {
                        const size_t ro = (size_t)(ai * 128 + m * 16);
                        const unsigned gb = *(const unsigned*)(gp0 + ro * 4096 + bj * 128 + 4 * n);
                        f32x4 v = acc[ai][bj][m][n];
#pragma unroll
                        for (int i = 0; i < 4; ++i) v[i] *= (float)((gb >> (8 * i)) & 255u) * (1.f / 255.f);
                        bf16_t* mp = mp0 + ro * 1024 + bj * 128 + 4 * n;
                        if (nb > 0) { const u32x2 o = *(const u32x2*)mp; v[0] += bflo(o.x); v[1] += bfhi(o.x); v[2] += bflo(o.y); v[3] += bfhi(o.y); }
                        *(u32x2*)mp = (u32x2){cvt_pk_bf16(v[0], v[1]), cvt_pk_bf16(v[2], v[3])};
                    }
                asm volatile("" ::: "memory"); }
    }
};

struct EpiResid {
    static constexpr bool PERM = true, AFTER_DRAIN = false;
    const float* base; float* out;
    __device__ __forceinline__ void operator()(const f32x4 (&acc)[2][2][4][2], const Unit& u, int wr, int wc, int fr, int fq) const {
        const int row0 = u.pm * 256 + wr * 64 + fr; const int col0 = u.pn * 256 + wc * 32 + 8 * fq;
#pragma unroll
        for (int ai = 0; ai < 2; ++ai)
#pragma unroll
            for (int m = 0; m < 4; ++m) { const size_t off = (size_t)(row0 + ai * 128 + m * 16) * 1024 + col0;
#pragma unroll
                for (int bj = 0; bj < 2; ++bj) { const f32x4 b0 = *(const f32x4*)(base + off + bj * 128), b1 = *(const f32x4*)(base + off + bj * 128 + 4);
                    *(f32x4*)(out + off + bj * 128) = b0 + acc[ai][bj][m][0]; *(f32x4*)(out + off + bj * 128 + 4) = b1 + acc[ai][bj][m][1]; }
                asm volatile("" ::: "memory"); }
    }
};

struct EpiSwiGLU {
    static constexpr bool PERM = true, AFTER_DRAIN = false;
    bf16_t* ACT;
    __device__ __forceinline__ void operator()(const f32x4 (&acc)[2][2][4][2], const Unit& u, int wr, int wc, int fr, int fq) const {
        const int row0 = u.pm * 256 + wr * 64 + fr; const int f0 = u.pn * 128 + wc * 32 + 8 * fq;
#pragma unroll
        for (int ai = 0; ai < 2; ++ai)
#pragma unroll
            for (int m = 0; m < 4; ++m) { f32x4 r[2];
#pragma unroll
                for (int n = 0; n < 2; ++n) { const f32x4 g = acc[ai][0][m][n], up = acc[ai][1][m][n];
#pragma unroll
                    for (int i = 0; i < 4; ++i) r[n][i] = g[i] * sigmoidf_(g[i]) * up[i]; }
                u32x4 w; w.x = cvt_pk_bf16(r[0][0], r[0][1]); w.y = cvt_pk_bf16(r[0][2], r[0][3]); w.z = cvt_pk_bf16(r[1][0], r[1][1]); w.w = cvt_pk_bf16(r[1][2], r[1][3]);
                *(u32x4*)(ACT + (size_t)(row0 + ai * 128 + m * 16) * DFF + f0) = w; }
    }
};

__device__ __forceinline__ void cvt_item(const float* src, int ld, int col0, int nvalid, int K, bf16_t* WT, int dst_row0, int kb, LAS float* scr, int lane) {
    const int k0 = 64 * kb, c = lane & 31;
#pragma unroll 8
    for (int i = 0; i < 32; ++i) { const int kk = 2 * i + (lane >> 5); float v = 0.f; if (c < nvalid) v = src[(size_t)(k0 + kk) * ld + col0 + c]; scr[kk * 33 + c] = v; }
    LDS_WAIT();
    const int c8 = lane & 7;
#pragma unroll
    for (int j = 0; j < 4; ++j) { const int n = (lane >> 3) + 8 * j; const LAS float* s = scr + (8 * c8) * 33 + n;
        u32x4 o; o.x = cvt_pk_bf16(s[0 * 33], s[1 * 33]); o.y = cvt_pk_bf16(s[2 * 33], s[3 * 33]); o.z = cvt_pk_bf16(s[4 * 33], s[5 * 33]); o.w = cvt_pk_bf16(s[6 * 33], s[7 * 33]);
        *(u32x4*)(WT + (size_t)(dst_row0 + n) * K + k0 + 8 * c8) = o; }
    LDS_WAIT();
}
__device__ __forceinline__ float wave_sum(float v) {
#pragma unroll
    for (int o = 1; o < 64; o <<= 1) v += __shfl_xor(v, o);
    return v;
}
__device__ __forceinline__ float wave_max(float v) {
#pragma unroll
    for (int o = 1; o < 64; o <<= 1) v = fmaxf(v, __shfl_xor(v, o));
    return v;
}
__device__ __forceinline__ void rmsnorm_rows(const float* xs, const float* gamma, bf16_t* XN, int gw, int ngw, int lane) {
    f32x4 gm[4];
#pragma unroll
    for (int j = 0; j < 4; ++j) gm[j] = *(const f32x4*)(gamma + 4 * lane + 256 * j);
    for (int m = gw; m < M_; m += ngw) {
        const f32x4* xr = (const f32x4*)(xs + (size_t)m * DM) + lane; f32x4 v[4]; float s = 0.f;
#pragma unroll
        for (int j = 0; j < 4; ++j) { v[j] = xr[64 * j]; s += (v[j].x * v[j].x + v[j].y * v[j].y) + (v[j].z * v[j].z + v[j].w * v[j].w); }
        const float r = __builtin_amdgcn_rsqf(wave_sum(s) * (1.f / DM) + EPSN);
        u32x2* o8 = (u32x2*)(XN + (size_t)m * DM) + lane;
#pragma unroll
        for (int j = 0; j < 4; ++j) { const f32x4 y = v[j] * r * gm[j]; o8[64 * j] = (u32x2){cvt_pk_bf16(y.x, y.y), cvt_pk_bf16(y.z, y.w)}; }
    }
}

struct Ptrs {
    const float *w_in, *qn, *kn, *pool_w, *pool_scale, *gm_norm, *gm_ws, *gm_b, *w_branch, *w_out, *w_gate, *w_up, *w_down;
};

__device__ __forceinline__ void convert_weights(const Ptrs& P, unsigned char* ws, LAS float* scr, int gw, int ngw, int lane, int gtid, int ngt) {
    bf16_t* WinT = (bf16_t*)(ws + WS_WIN); bf16_t* WbT = (bf16_t*)(ws + WS_WB); bf16_t* WoutT = (bf16_t*)(ws + WS_WOUT); bf16_t* WguT = (bf16_t*)(ws + WS_WGU);
    bf16_t* WdT = (bf16_t*)(ws + WS_WD); bf16_t* WpT = (bf16_t*)(ws + WS_WP); bf16_t* Wtril = (bf16_t*)(ws + WS_WS);
    constexpr int I_A = 216 * 16, I_B = 512, I_C = 512, I_D = 176 * 16, I_E = 32 * 44, I_F = 8, NIT = I_A + I_B + I_C + I_D + I_E + I_F;
    for (int it = gw; it < NIT; it += ngw) {
        int r = it;
        if (r < I_A) { const int rb = r >> 4, kb = r & 15, tile = rb >> 3, sub = rb & 7; int col0, nv = 32;
            if (tile <= 1) col0 = tile * 256 + (sub & 3) * 64 + (sub >> 2) * 32;
            else if (tile == 2) col0 = 512 + sub * 32;
            else if (tile == 3) col0 = 768 + sub * 32;
            else if (tile <= 9) col0 = 1064 + (tile - 4) * 256 + sub * 32;
            else if (tile == 10) { col0 = sub == 0 ? 1024 : 1056; nv = sub == 0 ? 32 : (sub == 1 ? 8 : 0); }
            else col0 = 2600 + (tile - 11) * 256 + sub * 32;
            cvt_item(P.w_in, DIN, col0, nv, 1024, WinT, rb * 32, kb, scr, lane); continue; }
        r -= I_A;
        if (r < I_B) { const int n = r >> 7, q = r & 127, rb = q >> 2, kb = q & 3;
            cvt_item(P.w_branch + (size_t)n * 256 * 1024, 1024, rb * 32, 32, 256, WbT + (size_t)n * 1024 * 256, rb * 32, kb, scr, lane); continue; }
        r -= I_B;
        if (r < I_C) { const int rb = r >> 4, kb = r & 15; cvt_item(P.w_out, 1024, rb * 32, 32, 1024, WoutT, rb * 32, kb, scr, lane); continue; }
        r -= I_C;
        if (r < I_D) { const int rb = r >> 4, kb = r & 15, tile = rb >> 3, sub = rb & 7;
            cvt_item((sub >> 2) ? P.w_up : P.w_gate, DFF, tile * 128 + (sub & 3) * 32, 32, 1024, WguT, rb * 32, kb, scr, lane); continue; }
        r -= I_D;
        if (r < I_E) { const int rb = r / 44, kb = r % 44; cvt_item(P.w_down, 1024, rb * 32, 32, DFF, WdT, rb * 32, kb, scr, lane); continue; }
        r -= I_E;
        { const int gp = r >> 1, rb = r & 1; cvt_item(P.pool_w + gp * 4096, 64, rb * 32, 32, 64, WpT + gp * 4096, rb * 32, 0, scr, lane); }
    }
    for (int e = gtid; e < 4 * 128 * 128; e += ngt) { const int s = e & 127, t = (e >> 7) & 127; Wtril[e] = (s <= t) ? f2bf(P.gm_ws[e]) : (unsigned short)0; }
}

__device__ __forceinline__ unsigned mono_key(float s) { const unsigned b = __float_as_uint(s); return b ^ ((unsigned)((int)b >> 31) | 0x80000000u); }

#define wr_lane(dst, sval, ln) asm volatile("s_nop 4\n\tv_writelane_b32 %0, %1, %2\n\ts_nop 1" : "+v"(dst) : "s"(sval), "n"(ln))
template <int NBLK> __device__ __forceinline__ unsigned a1_bisect(const unsigned (&v)[64]) {
    unsigned prefix = 0u;
#pragma unroll 1
    for (int bit = 31; bit >= 0; --bit) {
        const unsigned cand = prefix | (1u << bit);
        int cnt = 0;
#pragma unroll
        for (int blk = 0; blk < NBLK; ++blk) {
            unsigned long long bl[8];
#pragma unroll
            for (int k = 0; k < 8; ++k) bl[k] = __ballot(v[blk * 8 + k] >= cand);
            __builtin_amdgcn_sched_barrier(0);
#pragma unroll
            for (int k = 0; k < 8; ++k) cnt += __builtin_popcountll(bl[k]);
            __builtin_amdgcn_sched_barrier(0);
        }
        if (cnt >= 256) { prefix = cand; if (cnt == 256) break; }
    }
    return prefix;
}
constexpr int A1_ROWF = 4100;
__device__ __forceinline__ void phase_a1(unsigned char* lds, const bf16_t* IQ, const bf16_t* IK, const float* IW, unsigned short* MASK, int tid, int bid, int G) {
    const int lane = tid & 63, w = __builtin_amdgcn_readfirstlane(tid >> 6), q = lane & 15, g = lane >> 4;
    unsigned* keys = (unsigned*)lds;
#ifndef REP_A1X
#define REP_A1X 1
#endif
    for (int L2 = bid; L2 < 1024 * REP_A1X; L2 += G) {
        const int L = L2 & 1023;
        const int b = L >> 8, c = L & 255, qg = (b & 1) ? 255 - c : c;
        const int row0 = b * SEQ + qg * 16;
        const int nreg = (qg >> 2) + 1;
        if (qg <= 15) {
#pragma unroll
            for (int half = 0; half < 2; ++half) { const int qq = half * 8 + w; const int t = qg * 16 + qq; unsigned mlo = 0u, mhi = 0u;
#pragma unroll
                for (int r = 0; r < 4; ++r) { const unsigned long long bal = __ballot(64 * r + lane <= t);
                    wr_lane(mlo, (unsigned)bal, r); wr_lane(mhi, (unsigned)(bal >> 32), r); }
                if (lane < nreg) *(u32x2*)(MASK + (size_t)(row0 + qq) * 256 + 4 * lane) = (u32x2){mlo, mhi}; }
            continue;
        }
        unsigned u[128];
        {
            bf16x8 iqf[8]; float wv[8];
#pragma unroll
            for (int h = 0; h < 8; ++h) iqf[h] = *(const bf16x8*)(IQ + (size_t)(row0 + q) * 256 + h * 32 + 8 * g);
            { const f32x4 a = *(const f32x4*)(IW + (size_t)(row0 + q) * 8), bq = *(const f32x4*)(IW + (size_t)(row0 + q) * 8 + 4);
              wv[0] = a[0]; wv[1] = a[1]; wv[2] = a[2]; wv[3] = a[3]; wv[4] = bq[0]; wv[5] = bq[1]; wv[6] = bq[2]; wv[7] = bq[3]; }
#ifndef REP_SC
#define REP_SC 1
#endif
#pragma unroll 1
            for (int rs_ = 0; rs_ < REP_SC; ++rs_)
#pragma unroll
            for (int blk = 0; blk < 8; ++blk) {
                if (32 * blk + w <= qg) {
                    bf16x8 kf[4];
#pragma unroll
                    for (int ii = 0; ii < 4; ++ii) { const int kt = 8 * (4 * blk + ii) + w; kf[ii] = *(const bf16x8*)(IK + (size_t)(b * SEQ + kt * 16 + q) * 32 + 8 * g); }
#pragma unroll
                    for (int ii = 0; ii < 4; ++ii) { const int i = 4 * blk + ii; const int kt = 8 * i + w;
                        f32x4 s = {0.f, 0.f, 0.f, 0.f};
#pragma unroll
                        for (int h = 0; h < 8; ++h) { const f32x4 a = mfma16(kf[ii], iqf[h], (f32x4){0.f, 0.f, 0.f, 0.f});
#pragma unroll
                            for (int j = 0; j < 4; ++j) s[j] = __builtin_fmaf(wv[h], fmaxf(a[j], 0.f), s[j]); }
#pragma unroll
                        for (int j = 0; j < 4; ++j) { unsigned uu = mono_key(s[j]); if (kt > qg || (kt == qg && (4 * g + j) > q)) uu = 0u; u[4 * i + j] = uu; }
                    }
                } else {
#pragma unroll
                    for (int r = 0; r < 16; ++r) u[16 * blk + r] = 0u;
                }
            }
        }
#pragma unroll 1
        for (int half = 0; half < 2; ++half) {
            if ((q >> 3) == half) {
                unsigned* krow = keys + (q & 7) * A1_ROWF + 4 * g;
#pragma unroll
                for (int i = 0; i < 32; ++i) { const int kt = 8 * i + w; if (kt <= qg) *(u32x4*)(krow + kt * 16) = (u32x4){u[4 * i], u[4 * i + 1], u[4 * i + 2], u[4 * i + 3]}; }
            }
            __syncthreads();
            {
                const int qq = half * 8 + w; const unsigned* krow = keys + w * A1_ROWF + lane; const int nkeys = (qg + 1) * 16;
                unsigned v[64];
#pragma unroll
                for (int blk = 0; blk < 8; ++blk) {
                    if (nreg > blk * 8) {
#pragma unroll
                        for (int r = blk * 8; r < blk * 8 + 8; ++r) { const unsigned x = krow[64 * r]; v[r] = (64 * r + lane < nkeys) ? x : 0u; }
                    } else {
#pragma unroll
                        for (int r = blk * 8; r < blk * 8 + 8; ++r) v[r] = 0u;
                    }
                }
                unsigned prefix;
                switch ((nreg + 7) >> 3) {
                    case 1: prefix = a1_bisect<1>(v); break; case 2: prefix = a1_bisect<2>(v); break; case 3: prefix = a1_bisect<3>(v); break; case 4: prefix = a1_bisect<4>(v); break;
                    case 5: prefix = a1_bisect<5>(v); break; case 6: prefix = a1_bisect<6>(v); break; case 7: prefix = a1_bisect<7>(v); break; default: prefix = a1_bisect<8>(v); break;
                }
                const unsigned thr = prefix > 1u ? prefix : 1u;
                unsigned mlo = 0u, mhi = 0u;
#pragma unroll
                for (int r = 0; r < 64; ++r) { const unsigned long long bal = __ballot(v[r] >= thr);
                    wr_lane(mlo, (unsigned)bal, r); wr_lane(mhi, (unsigned)(bal >> 32), r); }
                if (lane < nreg) *(u32x2*)(MASK + (size_t)(row0 + qq) * 256 + 4 * lane) = (u32x2){mlo, mhi};
            }
            __syncthreads();
        }
    }
}

__device__ __forceinline__ void phase_a2(unsigned char* lds, const bf16_t* QA, bf16_t* OA, const bf16_t* KA, const bf16_t* VTA, const unsigned short* MASK,
                                         const float* qn, const float* kn, int tid, int bid, int G) {
    const int lane = tid & 63, w = __builtin_amdgcn_readfirstlane(tid >> 6), q = lane & 15, g = lane >> 4;
    bf16_t* Kt = (bf16_t*)lds;
    bf16_t* Vt = (bf16_t*)(lds + 2 * 64 * 72 * 2);
    const float msh = LOG2E * 8.f * wave_max(fabsf(qn[lane])) * wave_max(fabsf(kn[lane])) * 1.02f + 0.25f;
    const int srow = tid >> 3, sch = tid & 7;
    for (int L = bid; L < 512; L += G) {
        const int jj = L >> 8, c = L & 255, bh = c >> 4, qb = jj ? 31 - (c & 15) : (c & 15);
        const int b = bh >> 2, h = bh & 3;
        const int qgw = qb * 8 + w;
        const int row0 = b * SEQ + qb * 128 + 16 * w;
        bf16x8 qf[2];
#pragma unroll
        for (int hf = 0; hf < 2; ++hf) qf[hf] = *(const bf16x8*)(QA + (size_t)(row0 + q) * 256 + h * 64 + hf * 32 + 8 * g);
        const unsigned short* mrow = MASK + (size_t)(row0 + q) * 256;
        const int nsteps = 2 * qb + 2;
        const bf16_t* ksrc = KA + (size_t)(b * SEQ + srow) * 256 + h * 64 + sch * 8;
        const bf16_t* vsrc = VTA + (size_t)(b * 256 + h * 64 + srow) * SEQ + sch * 8;
        u32x4 kreg = *(const u32x4*)ksrc, vreg = *(const u32x4*)vsrc;
        *(u32x4*)(Kt + srow * 72 + sch * 8) = kreg; *(u32x4*)(Vt + srow * 72 + sch * 8) = vreg;
        u32x2 mcur = *(const u32x2*)mrow, mnext = mcur;
        f32x4 o[4]; float lsum = 0.f;
#pragma unroll
        for (int d = 0; d < 4; ++d) o[d] = (f32x4){0.f, 0.f, 0.f, 0.f};
        __syncthreads();
        for (int st = 0; st < nsteps; ++st) {
            const int buf = st & 1; const bool more = st + 1 < nsteps;
            if (more) { kreg = *(const u32x4*)(ksrc + (size_t)(st + 1) * 64 * 256); vreg = *(const u32x4*)(vsrc + (st + 1) * 64); mnext = *(const u32x2*)(mrow + (st + 1) * 4); }
            const bf16_t* kb_ = Kt + buf * 64 * 72; const bf16_t* vb_ = Vt + buf * 64 * 72;
#pragma unroll
            for (int p = 0; p < 2; ++p) {
                const int kt0 = st * 4 + 2 * p;
                if (kt0 <= qgw) {
                    const unsigned mw = p ? mcur.y : mcur.x;
                    const unsigned nib0 = (mw >> (4 * g)) & 15u, nib1 = (kt0 + 1 <= qgw) ? ((mw >> (16 + 4 * g)) & 15u) : 0u;
                    const bf16_t* kr0 = kb_ + (p * 32 + q) * 72 + 8 * g; const bf16_t* kr1 = kr0 + 16 * 72;
                    f32x4 a0 = mfma16(*(const bf16x8*)kr0, qf[0], (f32x4){0.f, 0.f, 0.f, 0.f}); a0 = mfma16(*(const bf16x8*)(kr0 + 32), qf[1], a0);
                    f32x4 a1 = mfma16(*(const bf16x8*)kr1, qf[0], (f32x4){0.f, 0.f, 0.f, 0.f}); a1 = mfma16(*(const bf16x8*)(kr1 + 32), qf[1], a1);
                    float p0[4], p1[4];
#pragma unroll
                    for (int j = 0; j < 4; ++j) { p0[j] = ((nib0 >> j) & 1u) ? __builtin_amdgcn_exp2f(a0[j] - msh) : 0.f; p1[j] = ((nib1 >> j) & 1u) ? __builtin_amdgcn_exp2f(a1[j] - msh) : 0.f; }
                    lsum += ((p0[0] + p0[1]) + (p0[2] + p0[3])) + ((p1[0] + p1[1]) + (p1[2] + p1[3]));
                    const bf16x8 pf = mk8(cvt_pk_bf16(p0[0], p0[1]), cvt_pk_bf16(p0[2], p0[3]), cvt_pk_bf16(p1[0], p1[1]), cvt_pk_bf16(p1[2], p1[3]));
#pragma unroll
                    for (int d = 0; d < 4; ++d) { const bf16_t* vr = vb_ + (d * 16 + q) * 72 + p * 32 + 4 * g;
                        const u32x2 lo = *(const u32x2*)vr, hi = *(const u32x2*)(vr + 16);
                        o[d] = mfma16(mk8(lo.x, lo.y, hi.x, hi.y), pf, o[d]); }
                }
            }
            if (more) { *(u32x4*)(Kt + (buf ^ 1) * 64 * 72 + srow * 72 + sch * 8) = kreg; *(u32x4*)(Vt + (buf ^ 1) * 64 * 72 + srow * 72 + sch * 8) = vreg; }
            __syncthreads();
            mcur = mnext;
        }
        lsum += __shfl_xor(lsum, 16); lsum += __shfl_xor(lsum, 32);
        const float inv = 1.f / lsum;
#pragma unroll
        for (int d = 0; d < 4; ++d) { const f32x4 v = o[d] * inv;
            *(u32x2*)(OA + (size_t)(row0 + q) * 256 + h * 64 + d * 16 + 4 * g) = (u32x2){cvt_pk_bf16(v[0], v[1]), cvt_pk_bf16(v[2], v[3])}; }
    }
}

__device__ __forceinline__ void phase_b(const bf16_t* PIN, const bf16_t* WpT, const float* pscale, bf16_t* OB, int gw, int ngw, int lane) {
    const int q = lane & 15, g4 = lane >> 4;
    for (int L = gw; L < 4096; L += ngw) {
        const int gp = L & 3, tg = L >> 2; const int row = tg * 16 + q; const int t = row & (SEQ - 1);
        const int win = 2 << gp; const int cnt = (t + 1 < win) ? t + 1 : win; const float inv = 1.f / (float)cnt;
        f32x4 acc[4];
#pragma unroll
        for (int d = 0; d < 4; ++d) acc[d] = (f32x4){0.f, 0.f, 0.f, 0.f};
#pragma unroll
        for (int ch = 0; ch < 2; ++ch) {
            const bf16_t* p = PIN + (size_t)row * 256 + gp * 64 + ch * 32 + 8 * g4;
            const u32x4 ov = *(const u32x4*)p;
            float own[8], sum[8];
            own[0] = bflo(ov.x); own[1] = bfhi(ov.x); own[2] = bflo(ov.y); own[3] = bfhi(ov.y); own[4] = bflo(ov.z); own[5] = bfhi(ov.z); own[6] = bflo(ov.w); own[7] = bfhi(ov.w);
#pragma unroll
            for (int k = 0; k < 8; ++k) sum[k] = own[k];
            for (int i = 1; i < win; ++i) {
                if (i <= t) { const u32x4 v = *(const u32x4*)(p - (size_t)i * 256);
                    sum[0] += bflo(v.x); sum[1] += bfhi(v.x); sum[2] += bflo(v.y); sum[3] += bfhi(v.y); sum[4] += bflo(v.z); sum[5] += bfhi(v.z); sum[6] += bflo(v.w); sum[7] += bfhi(v.w); }
            }
            float pl[8];
#pragma unroll
            for (int k = 0; k < 8; ++k) pl[k] = sum[k] * inv - own[k];
            const bf16x8 bfr = mk8(cvt_pk_bf16(pl[0], pl[1]), cvt_pk_bf16(pl[2], pl[3]), cvt_pk_bf16(pl[4], pl[5]), cvt_pk_bf16(pl[6], pl[7]));
#pragma unroll
            for (int d = 0; d < 4; ++d) { const bf16x8 afr = *(const bf16x8*)(WpT + gp * 4096 + (d * 16 + q) * 64 + ch * 32 + 8 * g4); acc[d] = mfma16(afr, bfr, acc[d]); }
        }
#pragma unroll
        for (int d = 0; d < 4; ++d) { const int d0 = d * 16 + 4 * g4; const f32x4 sc = *(const f32x4*)(pscale + gp * 64 + d0); const f32x4 v = acc[d] * sc;
            *(u32x2*)(OB + (size_t)row * 256 + gp * 64 + d0) = (u32x2){cvt_pk_bf16(v[0], v[1]), cvt_pk_bf16(v[2], v[3])}; }
    }
}

__device__ __forceinline__ void phase_c(unsigned char* lds, const bf16_t* GV, const bf16_t* GU, bf16_t* OC, const float* gamma, const bf16_t* Wtril, const float* gbias, int tid, int bid, int G) {
    bf16_t* LT = (bf16_t*)lds;
    const int lane = tid & 63, w = __builtin_amdgcn_readfirstlane(tid >> 6), q = lane & 15, g4 = lane >> 4;
    for (int L = bid; L < 512; L += G) {
        const int gp = L & 3, chk = L >> 2; const int R0 = chk * 128;
        {
            const int row = tid >> 2, part = tid & 3;
            const bf16_t* src = GV + (size_t)(R0 + row) * 256 + part * 64;
            float x[64];
#pragma unroll
            for (int k8 = 0; k8 < 8; ++k8) { const u32x4 v = *(const u32x4*)(src + 8 * k8);
                x[8 * k8 + 0] = bflo(v.x); x[8 * k8 + 1] = bfhi(v.x); x[8 * k8 + 2] = bflo(v.y); x[8 * k8 + 3] = bfhi(v.y); x[8 * k8 + 4] = bflo(v.z); x[8 * k8 + 5] = bfhi(v.z); x[8 * k8 + 6] = bflo(v.w); x[8 * k8 + 7] = bfhi(v.w); }
            float s = 0.f;
#pragma unroll
            for (int k = 0; k < 64; ++k) s += x[k];
            s += __shfl_xor(s, 1); s += __shfl_xor(s, 2);
            const float mean = s * (1.f / 256.f); float ss = 0.f;
#pragma unroll
            for (int k = 0; k < 64; ++k) { const float dd = x[k] - mean; ss += dd * dd; }
            ss += __shfl_xor(ss, 1); ss += __shfl_xor(ss, 2);
            const float rstd = __builtin_amdgcn_rsqf(ss * (1.f / 256.f) + EPSN);
            if (part == gp) {
#pragma unroll
                for (int k4 = 0; k4 < 16; ++k4) { const f32x4 gm = *(const f32x4*)(gamma + gp * 64 + 4 * k4);
#pragma unroll
                    for (int i = 0; i < 4; ++i) LT[(4 * k4 + i) * 136 + row] = f2bf((x[4 * k4 + i] - mean) * rstd * gm[i]); }
            }
        }
        __syncthreads();
        {
            f32x4 acc[4];
#pragma unroll
            for (int d = 0; d < 4; ++d) acc[d] = (f32x4){0.f, 0.f, 0.f, 0.f};
            const int t = 16 * w + q; const int nsb = ((16 * w + 15) >> 5) + 1;
            for (int sb = 0; sb < nsb; ++sb) {
                const bf16x8 bfr = *(const bf16x8*)(Wtril + ((size_t)gp * 128 + t) * 128 + sb * 32 + 8 * g4);
#pragma unroll
                for (int d = 0; d < 4; ++d) { const bf16x8 afr = *(const bf16x8*)(LT + (d * 16 + q) * 136 + sb * 32 + 8 * g4); acc[d] = mfma16(afr, bfr, acc[d]); }
            }
            const float bias = gbias[gp * 128 + t];
#pragma unroll
            for (int d = 0; d < 4; ++d) { const size_t eo = (size_t)(R0 + t) * 256 + gp * 64 + d * 16 + 4 * g4; const u32x2 uu = *(const u32x2*)(GU + eo);
                const float r0 = bflo(uu.x) * (acc[d][0] + bias), r1 = bfhi(uu.x) * (acc[d][1] + bias), r2 = bflo(uu.y) * (acc[d][2] + bias), r3 = bfhi(uu.y) * (acc[d][3] + bias);
                *(u32x2*)(OC + eo) = (u32x2){cvt_pk_bf16(r0, r1), cvt_pk_bf16(r2, r3)}; }
        }
        __syncthreads();
    }
}

__device__ __forceinline__ void sb_tile(const f32x4 z, int kbase, int tq, int g, float& carry, float (&a)[4]) {
    float lm[4]; bool msk[4];
#pragma unroll
    for (int j = 0; j < 4; ++j) { msk[j] = (kbase + 4 * g + j) >= tq;
        const float e = __builtin_amdgcn_exp2f(-fabsf(z[j]) * LOG2E); const float sp = fmaxf(z[j], 0.f) + __builtin_amdgcn_logf(1.f + e) * LN2;
        lm[j] = msk[j] ? 0.f : -sp; }
    const float suf2 = lm[3], suf1 = lm[3] + lm[2], suf0 = suf1 + lm[1]; const float T = suf0 + lm[0];
    const float x16 = __shfl_xor(T, 16); const float Pp = T + x16; const float Qq = __shfl_xor(Pp, 32);
    const float Sg = ((g & 1) ? 0.f : x16) + ((g & 2) ? 0.f : Qq);
    const float base = carry + Sg;
    const float tl[4] = {base + suf0, base + suf1, base + suf2, base};
#pragma unroll
    for (int j = 0; j < 4; ++j) a[j] = msk[j] ? 0.f : __builtin_amdgcn_exp2f((z[j] + lm[j] + tl[j]) * LOG2E);
    carry += Pp + Qq;
}
__device__ __forceinline__ void phase_d(const bf16_t* SQ, bf16_t* OD, const bf16_t* SK, const bf16_t* VTS, int gw, int ngw, int lane) {
    const int q = lane & 15, g = lane >> 4;
    for (int L = gw; L < 4096; L += ngw) {
        const int qg = L & 255, bh = L >> 8, b = bh >> 2, h = bh & 3;
        const int row0 = b * SEQ + qg * 16; const int tq = qg * 16 + q;
        bf16x8 qf[2];
#pragma unroll
        for (int hf = 0; hf < 2; ++hf) qf[hf] = *(const bf16x8*)(SQ + (size_t)(row0 + q) * 256 + h * 64 + hf * 32 + 8 * g);
        f32x4 o[4];
#pragma unroll
        for (int d = 0; d < 4; ++d) o[d] = (f32x4){0.f, 0.f, 0.f, 0.f};
        float carry = 0.f;
        for (int pp = qg >> 1; pp >= 0; --pp) {
            const int kt0 = 2 * pp, kt1 = kt0 + 1;
            float a0[4], a1[4];
            if (kt1 <= qg) {
                const bf16_t* kr = SK + (size_t)(b * SEQ + kt1 * 16 + q) * 256 + h * 64 + 8 * g;
                f32x4 z = mfma16(*(const bf16x8*)kr, qf[0], (f32x4){0.f, 0.f, 0.f, 0.f}); z = mfma16(*(const bf16x8*)(kr + 32), qf[1], z);
                sb_tile(z, kt1 * 16, tq, g, carry, a1);
            } else {
#pragma unroll
                for (int j = 0; j < 4; ++j) a1[j] = 0.f;
            }
            {
                const bf16_t* kr = SK + (size_t)(b * SEQ + kt0 * 16 + q) * 256 + h * 64 + 8 * g;
                f32x4 z = mfma16(*(const bf16x8*)kr, qf[0], (f32x4){0.f, 0.f, 0.f, 0.f}); z = mfma16(*(const bf16x8*)(kr + 32), qf[1], z);
                sb_tile(z, kt0 * 16, tq, g, carry, a0);
            }
            const bf16x8 pf = mk8(cvt_pk_bf16(a0[0], a0[1]), cvt_pk_bf16(a0[2], a0[3]), cvt_pk_bf16(a1[0], a1[1]), cvt_pk_bf16(a1[2], a1[3]));
#pragma unroll
            for (int d = 0; d < 4; ++d) { const bf16_t* vr = VTS + (size_t)(b * 256 + h * 64 + d * 16 + q) * SEQ + kt0 * 16 + 4 * g;
                const u32x2 lo = *(const u32x2*)vr, hi = *(const u32x2*)(vr + 16);
                o[d] = mfma16(mk8(lo.x, lo.y, hi.x, hi.y), pf, o[d]); }
            if (__all(carry < -104.f)) break;
        }
#pragma unroll
        for (int d = 0; d < 4; ++d) *(u32x2*)(OD + (size_t)(row0 + q) * 256 + h * 64 + d * 16 + 4 * g) = (u32x2){cvt_pk_bf16(o[d][0], o[d][1]), cvt_pk_bf16(o[d][2], o[d][3])};
    }
}

#define XB_TMO      128
#define XB_XCNT(j)  (256  + 64 * (j))
#define XB_XSUB(j)  (1280 + 64 * (j))
#define XB_XGEN(j)  (2304 + 64 * (j))
#define XB_TOP      3328
#define XB_TOPGEN   3392
#define XCD_BAR_WORDS 3456
#define XB_SPIN_CAP (1u << 18)

__device__ __forceinline__ unsigned xb_ld(unsigned* p)              { return __hip_atomic_load(p, __ATOMIC_RELAXED, __HIP_MEMORY_SCOPE_AGENT); }
__device__ __forceinline__ unsigned xb_add(unsigned* p, unsigned v) { return __hip_atomic_fetch_add(p, v, __ATOMIC_RELAXED, __HIP_MEMORY_SCOPE_AGENT); }
__device__ __forceinline__ unsigned xb_xcc_id() { return (unsigned)__builtin_amdgcn_s_getreg((3 << 11) | 20) & 0xFu; }
#define XB_SPIN(cond, bar) do { unsigned _sp = 0; while (cond) { __builtin_amdgcn_s_sleep(1); \
    if ((++_sp & 255u) == 0u) { if (xb_ld(&(bar)[XB_TMO])) break; if (_sp > XB_SPIN_CAP) { atomicAdd(&(bar)[XB_TMO], 1u); break; } } } } while (0)

struct XcdBarrier {
    unsigned* bar; unsigned x;
    volatile LAS unsigned* st;
};

__device__ __forceinline__ XcdBarrier xcd_barrier_post(unsigned* bar, volatile LAS unsigned* st) {
    XcdBarrier b; b.bar = bar; b.x = xb_xcc_id(); b.st = st;
    if (threadIdx.x == 0) (void)xb_add(&bar[XB_XCNT(b.x)], 1u);
    return b;
}
__device__ __forceinline__ void xcd_barrier_complete(unsigned* bar, unsigned x, unsigned& nloc, unsigned& nx) {
    const unsigned G = gridDim.x * gridDim.y * gridDim.z;
    unsigned sum, cnt, mine, sp = 0u;
    for (;;) {
        sum = 0u; cnt = 0u; mine = 0u;
#pragma unroll
        for (unsigned j = 0; j < 16; ++j) { const unsigned c = xb_ld(&bar[XB_XCNT(j)]); sum += c; cnt += (c > 0u) ? 1u : 0u; mine = (j == x) ? c : mine; }
        if (sum == G) break;
        __builtin_amdgcn_s_sleep(1);
        if ((++sp & 255u) == 0u) { if (xb_ld(&bar[XB_TMO])) break; if (sp > XB_SPIN_CAP) { atomicAdd(&bar[XB_TMO], 1u); break; } }
    }
    nloc = mine > 0u ? mine : 1u; nx = cnt > 0u ? cnt : 1u;
}

__device__ __forceinline__ void xcd_barrier(const XcdBarrier& b) {
    asm volatile("s_waitcnt vmcnt(0)" ::: "memory");
    __syncthreads();
    if (threadIdx.x == 0) {
        unsigned* bar = b.bar;
        __builtin_amdgcn_s_waitcnt(0);
        unsigned nloc = b.st[0], nx = b.st[1];
        if (nloc == 0u) { xcd_barrier_complete(bar, b.x, nloc, nx); b.st[0] = nloc; b.st[1] = nx; }
        const unsigned old = xb_add(&bar[XB_XSUB(b.x)], 1u);
        const unsigned gen = old / nloc;
        if (old + 1u == (gen + 1u) * nloc) {
            __builtin_amdgcn_fence(__ATOMIC_RELEASE, "agent");
            asm volatile("s_waitcnt vmcnt(0)" ::: "memory");
            const unsigned og = xb_add(&bar[XB_TOP], 1u);
            const unsigned tg = og / nx;
            if (og + 1u == (tg + 1u) * nx) xb_add(&bar[XB_TOPGEN], 1u);
            else XB_SPIN(xb_ld(&bar[XB_TOPGEN]) == tg, bar);
            __builtin_amdgcn_fence(__ATOMIC_ACQUIRE, "agent");
            xb_add(&bar[XB_XGEN(b.x)], 1u);
            asm volatile("s_waitcnt vmcnt(0)" ::: "memory");
        } else {
            XB_SPIN(xb_ld(&bar[XB_XGEN(b.x)]) == gen, bar);
            __builtin_amdgcn_fence(__ATOMIC_ACQUIRE, "agent");
            asm volatile("s_waitcnt vmcnt(0)" ::: "memory");
        }
    }
    __syncthreads();
}

#ifndef REP_P0
#define REP_P0 1
#endif
#ifndef REP_P1
#define REP_P1 1
#endif
#ifndef REP_A1
#define REP_A1 1
#endif
#ifndef REP_BCD
#define REP_BCD 1
#endif
#ifndef REP_A2
#define REP_A2 1
#endif
#ifndef REP_MG
#define REP_MG 1
#endif
#ifndef REP_UP
#define REP_UP 1
#endif
#ifndef REP_WO
#define REP_WO 1
#endif
#ifndef REP_N2
#define REP_N2 1
#endif
#ifndef REP_DN
#define REP_DN 1
#endif
#ifndef REP_SYNC
#define REP_SYNC 1
#endif
#define GSYNC() do { _Pragma("unroll 1") for (int r_ = 0; r_ < REP_SYNC; ++r_) xcd_barrier(bar); } while (0)
#define REPEAT(n) _Pragma("unroll 1") for (int rep_ = 0; rep_ < (n); ++rep_)
struct Args { const float* in[16]; float* out; unsigned char* ws; };
constexpr int LDS_BYTES = 147456;
__device__ __forceinline__ unsigned char* opq(unsigned char* p) { asm volatile("" : "+s"(p)); return p; }
__device__ __forceinline__ int opq_tid() { int t = threadIdx.x; asm volatile("" : "+v"(t)); return t; }
#define WSB(T, off) ((T*)(ws + (off)))
constexpr int PTAB_OFF = 147456 - 512, BST_OFF = 147456 - 64;
__device__ __forceinline__ void* ldp(PG8_LAS unsigned char* ldsl, int i) {
    unsigned off = PTAB_OFF + 8 * i; asm volatile("" : "+v"(off));
    const unsigned long long v = *(volatile LAS unsigned long long*)(ldsl + off);
    const unsigned lo = __builtin_amdgcn_readfirstlane((unsigned)v), hi = __builtin_amdgcn_readfirstlane((unsigned)(v >> 32));
    return (void*)(((unsigned long long)hi << 32) | lo);
}

__global__ void __launch_bounds__(512, 2) fwd_kernel(Args a) {
    extern __shared__ __attribute__((aligned(16))) unsigned char lds[];
    cg::grid_group grid = cg::this_grid();
    PG8_LAS unsigned char* ldsl = (PG8_LAS unsigned char*)lds;
    if (a.ws == nullptr) grid.sync();
    if (threadIdx.x == 0) { ((volatile LAS unsigned*)(ldsl + BST_OFF))[0] = 0u; ((volatile LAS unsigned*)(ldsl + BST_OFF))[1] = 0u; }
    if (threadIdx.x == 0) { LAS unsigned long long* tb = (LAS unsigned long long*)(ldsl + PTAB_OFF);
#pragma unroll
        for (int i = 0; i < 16; ++i) tb[i] = (unsigned long long)a.in[i];
        tb[16] = (unsigned long long)a.out; tb[17] = (unsigned long long)a.ws; }
    __syncthreads();
    XcdBarrier bar = xcd_barrier_post((unsigned*)a.ws + 1024, (volatile LAS unsigned*)(ldsl + BST_OFF));
#define INP(i) ((const float*)ldp(ldsl, (i)))
#define OUTP ((float*)ldp(ldsl, 16))
#define WSP ((unsigned char*)ldp(ldsl, 17))

#define PHASE_VARS unsigned char* ws = WSP; int bid = blockIdx.x; asm volatile("" : "+s"(bid)); int G = gridDim.x; asm volatile("" : "+s"(G)); \
    const int tid = opq_tid(), lane = tid & 63, wave = __builtin_amdgcn_readfirstlane(tid >> 6); const int gw = bid * 8 + wave, ngw = G * 8; (void)ws; (void)lane; (void)gw; (void)ngw;
#pragma unroll 1
    for (int l = 0; l < 2; ++l) {
        REPEAT(REP_P0) {
            PHASE_VARS
#ifndef NO_CVT
            Ptrs P;
            P.w_in = INP(2) + (size_t)l * DM * DIN; P.qn = INP(3) + l * 64; P.kn = INP(4) + l * 64; P.pool_w = INP(5) + l * 4 * 64 * 64; P.pool_scale = INP(6) + l * 256;
            P.gm_norm = INP(7) + l * 256; P.gm_ws = INP(8) + l * 4 * 128 * 128; P.gm_b = INP(9) + l * 4 * 128; P.w_branch = INP(10) + (size_t)l * 4 * 256 * 1024;
            P.w_out = INP(11) + (size_t)l * 1024 * 1024; P.w_gate = INP(13) + (size_t)l * DM * DFF; P.w_up = INP(14) + (size_t)l * DM * DFF; P.w_down = INP(15) + (size_t)l * DFF * DM;
            convert_weights(P, ws, (LAS float*)(ldsl + wave * 8448), gw, ngw, lane, bid * 512 + tid, G * 512);
#endif
            rmsnorm_rows(l == 0 ? INP(0) : OUTP, INP(1) + l * DM, WSB(bf16_t, WS_XN), gw, ngw, lane);
        }
        GSYNC();
        REPEAT(REP_P1) {
            PHASE_VARS
            pg8::Gemm g{WSB(bf16_t, WS_XN), WSB(bf16_t, WS_WIN), M_, NINP, DM}; pg8::StaticOrder S; S.init(M_, NINP, G, bid);
            EpiIn E{ws, INP(3) + l * 64, INP(4) + l * 64};
#ifndef NO_G1
            pg8::gemm_phase<EpiIn, pg8::StaticOrder, true, true>(ldsl, g, S, E);
#endif
        }
        GSYNC();
        REPEAT(REP_A1) {
            PHASE_VARS
#ifndef NO_A1
            phase_a1(lds, WSB(bf16_t, WS_IQ), WSB(bf16_t, WS_IK), WSB(float, WS_IW), WSB(unsigned short, WS_MASK), tid, bid, G);
#endif
            __syncthreads();
        }
        REPEAT(REP_BCD) {
        {
            PHASE_VARS
#ifndef NO_C
            phase_c(lds, WSB(bf16_t, WS_GV), WSB(bf16_t, WS_GU), WSB(bf16_t, WS_OC), INP(7) + l * 256, WSB(bf16_t, WS_WS), INP(9) + l * 4 * 128, tid, bid, G);
#endif
        }
        {
            PHASE_VARS
#ifndef NO_B
            phase_b(WSB(bf16_t, WS_PIN), WSB(bf16_t, WS_WP), INP(6) + l * 256, WSB(bf16_t, WS_OB), gw, ngw, lane);
#endif
        }
        {
            PHASE_VARS
#ifndef NO_D
            phase_d(WSB(bf16_t, WS_SQ), WSB(bf16_t, WS_OD), WSB(bf16_t, WS_SK), WSB(bf16_t, WS_VTS), gw, ngw, lane);
#endif
        }
        }
        GSYNC();
        REPEAT(REP_A2) {
            PHASE_VARS
#ifndef NO_A2
            phase_a2(lds, WSB(bf16_t, WS_QA), WSB(bf16_t, WS_OA), WSB(bf16_t, WS_KA), WSB(bf16_t, WS_VTA), WSB(unsigned short, WS_MASK), INP(3) + l * 64, INP(4) + l * 64, tid, bid, G);
#endif
        }
        GSYNC();
        REPEAT(REP_MG)
#pragma unroll 1
        for (int nb = 0; nb < 4; ++nb) {
            PHASE_VARS
            const bf16_t* A = WSB(bf16_t, nb == 0 ? WS_OA : nb == 1 ? WS_OB : nb == 2 ? WS_OC : WS_OD);
            int Kv = 256; asm volatile("" : "+s"(Kv));
            pg8::Gemm g{A, WSB(bf16_t, WS_WB) + (size_t)nb * 1024 * 256, M_, DM, Kv}; pg8::StaticOrder S; S.init(M_, DM, G, bid);
            EpiMerge E{ws + WS_G, WSB(bf16_t, WS_XN), nb};
#ifndef NO_G2
            pg8::gemm_phase<EpiMerge, pg8::StaticOrder, true, true>(ldsl, g, S, E);
#endif
            __syncthreads();
        }
        GSYNC();
        REPEAT(REP_WO) {
            PHASE_VARS
            pg8::Gemm g{WSB(bf16_t, WS_XN), WSB(bf16_t, WS_WOUT), M_, DM, DM}; pg8::StaticOrder S; S.init(M_, DM, G, bid);
            EpiResid E{l == 0 ? INP(0) : OUTP, rep_ == REP_WO - 1 ? OUTP : WSB(float, WS_S)};
#ifndef NO_G3
            pg8::gemm_phase<EpiResid, pg8::StaticOrder, true, true>(ldsl, g, S, E);
#endif
        }
        GSYNC();
        REPEAT(REP_N2) {
            PHASE_VARS
            rmsnorm_rows(OUTP, INP(12) + l * DM, WSB(bf16_t, WS_XN), gw, ngw, lane);
        }
        GSYNC();
        REPEAT(REP_UP) {
            PHASE_VARS
            pg8::Gemm g{WSB(bf16_t, WS_XN), WSB(bf16_t, WS_WGU), M_, 2 * DFF, DM}; pg8::StaticOrder S; S.init(M_, 2 * DFF, G, bid);
            EpiSwiGLU E{WSB(bf16_t, WS_R1)};
#ifndef NO_G4
            pg8::gemm_phase<EpiSwiGLU, pg8::StaticOrder, true, true>(ldsl, g, S, E);
#endif
        }
        GSYNC();
        REPEAT(REP_DN) {
            PHASE_VARS
            pg8::Gemm g{WSB(bf16_t, WS_R1), WSB(bf16_t, WS_WD), M_, DM, DFF}; pg8::StaticOrder S; S.init(M_, DM, G, bid);
            float* o = OUTP; EpiResid E{o, rep_ == REP_DN - 1 ? o : WSB(float, WS_S)};
#ifndef NO_G3
            pg8::gemm_phase<EpiResid, pg8::StaticOrder, true, true>(ldsl, g, S, E);
#endif
        }
        if (l == 0) GSYNC();
    }
}

extern "C" void kernel_launch(void* const* d_in, const int* in_sizes, int n_in, void* d_out, int out_size, void* d_ws, size_t ws_size, hipStream_t stream) {
    static int grid_blocks = 0;
    if (grid_blocks == 0) {
        if (n_in != 16 || out_size != M_ * DM || ws_size < WS_END) { fprintf(stderr, "kernel_launch: unexpected shapes (n_in %d out %d ws %zu)\n", n_in, out_size, ws_size); grid_blocks = -1; return; }
        int dev = 0, cus = 0, per_cu = 0;
        hipGetDevice(&dev);
        hipDeviceGetAttribute(&cus, hipDeviceAttributeMultiprocessorCount, dev);
        hipFuncSetAttribute((const void*)fwd_kernel, hipFuncAttributeMaxDynamicSharedMemorySize, LDS_BYTES);
        if (hipOccupancyMaxActiveBlocksPerMultiprocessor(&per_cu, (const void*)fwd_kernel, 512, LDS_BYTES) != hipSuccess || per_cu < 1) per_cu = 1;
        (void)hipGetLastError();
        grid_blocks = cus;
    }
    if (grid_blocks < 0) return;
    Args a{};
    for (int i = 0; i < 16; ++i) a.in[i] = (const float*)d_in[i];
    a.out = (float*)d_out; a.ws = (unsigned char*)d_ws;
    if (hipMemsetAsync(d_ws, 0, 65536, stream) != hipSuccess) { fprintf(stderr, "kernel_launch: memset failed\n"); return; }
    void* args[] = {&a};
    hipError_t e = hipLaunchCooperativeKernel((const void*)fwd_kernel, dim3(grid_blocks), dim3(512), args, LDS_BYTES, stream);
    if (e != hipSuccess) fprintf(stderr, "cooperative launch failed: %s (grid %d)\n", hipGetErrorString(e), grid_blocks);
}
```

```cpp
#include <hip/hip_runtime.h>
#include <hip/hip_cooperative_groups.h>
#include <cstdio>
#include <cstdint>
namespace pg8 {
#define PG8_LAS __attribute__((address_space(3)))
typedef unsigned short bf16_t;
typedef short bf16x8 __attribute__((ext_vector_type(8)));
typedef float f32x4 __attribute__((ext_vector_type(4)));
typedef unsigned u32x4 __attribute__((ext_vector_type(4)));
constexpr int BM = 256, BK = 64, HALF = 128, HTB = HALF * BK * 2  , STAGE_BYTES = 8 * HTB, NXCD = 8, WGM = 8;

__host__ __device__ __forceinline__ int lds_byte(int r, int c) { const int st = (r >> 4) * 2 + (c >> 5), rr = r & 15, cc = c & 31, ob = rr * 64 + cc * 2; return st * 1024 + (ob ^ (((ob >> 9) & 1) << 5)); }
__host__ __device__ __forceinline__ void stage_rc(int b, int& R, int& C) { const int st = b / 1024, sb = b % 1024, swz = sb ^ (((sb >> 9) & 1) << 5); R = (st >> 1) * 16 + swz / 64; C = (st & 1) * 32 + (swz % 64) / 2; }
__host__ __device__ __forceinline__ int perm32(int rho) { const int n = rho >> 4, i = rho & 15; return 8 * (i >> 2) + 4 * n + (i & 3); }

struct Unit { int pm, pn; };
struct Gemm { const bf16_t* A; const bf16_t* Bt; int M, N, K; };

struct StaticOrder {
    int nM, nN, nwg, G, c;
    __host__ __device__ void init(int M, int N, int G_, int c_) { nM = M / BM; nN = N / BM; nwg = nM * nN; G = G_; c = c_; }
    __host__ __device__ bool next(int i, Unit& u) const {
        const long L = (long)i * G + c; if (L >= nwg) return false;
        int wgid = (int)L; { const int q = nwg / NXCD, r = nwg % NXCD, xcd = wgid % NXCD, off = wgid / NXCD; wgid = (xcd < r ? xcd * (q + 1) : r * (q + 1) + (xcd - r) * q) + off; }
        const int nig = WGM * nN, gid = wgid / nig, fm = gid * WGM, gsz = (nM - fm) < WGM ? (nM - fm) : WGM;
        u.pm = fm + ((wgid % nig) % gsz); u.pn = (wgid % nig) / gsz; return true;
    }
    __device__ __forceinline__ void a_ready(const Unit&) const {}
    __device__ __forceinline__ void done(const Unit&) const {}
};

__device__ __forceinline__ unsigned cvt_pk_bf16(float lo, float hi) { unsigned r; asm volatile("v_cvt_pk_bf16_f32 %0, %1, %2" : "=v"(r) : "v"(lo), "v"(hi)); return r; }
template <class Epi, class Sched, bool ALIGN_EPI = false, bool SP2 = false>
__device__ __forceinline__ void gemm_phase(PG8_LAS unsigned char* lds, const Gemm g, const Sched& S, const Epi& E) {
    int tid_ = threadIdx.x; asm volatile("" : "+v"(tid_)); const int tid = tid_, wid = __builtin_amdgcn_readfirstlane(tid >> 6), lane = tid & 63, wr = wid >> 2, wc = wid & 3, fr = lane & 15, fq = lane >> 4;
    const int K = g.K, nt = K / BK;
    unsigned voffA[2], voffB[2];
#pragma unroll
    for (int i = 0; i < 2; ++i) { int R, C; stage_rc(tid * 16 + i * 8192, R, C); const int Rb = Epi::PERM ? ((R & ~31) + perm32(R & 31)) : R;
        voffA[i] = (unsigned)(R * K + C) * 2u; voffB[i] = (unsigned)(Rb * K + C) * 2u; }
    const size_t kstep = (size_t)(BK * 2);
    const size_t hstep = (size_t)HALF * K * 2;
    const size_t tstep = 2 * hstep;
    const unsigned ldsw = (unsigned)wid * 1024u;
    const int aoff = lds_byte(wr * 64 + fr, fq * 8), boff = lds_byte(wc * 32 + fr, fq * 8);
#define PG8_SA(b, h) (((b) * 2 + (h)) * HTB)
#define PG8_SB(b, h) ((4 + (b) * 2 + (h)) * HTB)
#define PG8_STAGE(bufoff, gbase, voff) do { _Pragma("unroll") for (int _i = 0; _i < 2; ++_i) \
        __builtin_amdgcn_global_load_lds((const unsigned*)((const char*)(gbase) + (voff)[_i]), (PG8_LAS unsigned*)(lds + (bufoff) + ldsw + _i * 8192), 16, 0, 0); } while (0)
#define PG8_LDA(dst, b, h) do { _Pragma("unroll") for (int m = 0; m < 4; ++m) _Pragma("unroll") for (int k = 0; k < 2; ++k) dst[m][k] = *(const PG8_LAS bf16x8*)(lds + PG8_SA(b, h) + aoff + m * 2048 + k * 1024); } while (0)
#define PG8_LDB(dst, b, h) do { _Pragma("unroll") for (int n = 0; n < 2; ++n) _Pragma("unroll") for (int k = 0; k < 2; ++k) dst[n][k] = *(const PG8_LAS bf16x8*)(lds + PG8_SB(b, h) + boff + n * 2048 + k * 1024); } while (0)
#define PG8_MMA(ai, bj, At, Bt) do { __builtin_amdgcn_s_setprio(1); _Pragma("unroll") for (int m = 0; m < 4; ++m) _Pragma("unroll") for (int n = 0; n < 2; ++n) _Pragma("unroll") for (int k = 0; k < 2; ++k) \
        acc[ai][bj][m][n] = __builtin_amdgcn_mfma_f32_16x16x32_bf16(Bt[n][k], At[m][k], acc[ai][bj][m][n], 0, 0, 0); __builtin_amdgcn_s_setprio(0); } while (0)
#define PG8_WAIT_V(n) asm volatile("s_waitcnt vmcnt(" #n ")" ::: "memory")
#define PG8_WAIT_L(n) asm volatile("s_waitcnt lgkmcnt(" #n ")" ::: "memory")
#define PG8_BAR __builtin_amdgcn_s_barrier()
#define PG8_SCHED __builtin_amdgcn_sched_barrier(0)
    Unit cur, nxt; int ui = 0;
    if (!S.next(0, cur)) return;
    f32x4 acc[2][2][4][2];
#pragma unroll
    for (int a = 0; a < 2; ++a)
#pragma unroll
        for (int b = 0; b < 2; ++b)
#pragma unroll
            for (int m = 0; m < 4; ++m)
#pragma unroll
                for (int n = 0; n < 2; ++n) acc[a][b][m][n] = (f32x4){0.f, 0.f, 0.f, 0.f};
    bf16x8 At[4][2], B0[2][2], B1[2][2];
    const char* cA = (const char*)g.A + (size_t)cur.pm * tstep; const char* cB = (const char*)g.Bt + (size_t)cur.pn * tstep;
    S.a_ready(cur);
    if constexpr (SP2) {
        PG8_STAGE(PG8_SB(0, 0), cB, voffB); PG8_STAGE(PG8_SB(0, 1), cB + hstep, voffB); PG8_STAGE(PG8_SA(0, 0), cA, voffA); PG8_STAGE(PG8_SA(0, 1), cA + hstep, voffA);
        if (wr == 1) PG8_BAR;
        PG8_WAIT_V(2); PG8_BAR;
        PG8_STAGE(PG8_SB(1, 0), cB + kstep, voffB); PG8_STAGE(PG8_SA(1, 0), cA + kstep, voffA); PG8_STAGE(PG8_SB(1, 1), cB + hstep + kstep, voffB);
        PG8_WAIT_V(6); PG8_BAR;
    } else {
        PG8_STAGE(PG8_SB(0, 0), cB, voffB); PG8_STAGE(PG8_SA(0, 0), cA, voffA); PG8_STAGE(PG8_SB(0, 1), cB + hstep, voffB); PG8_STAGE(PG8_SA(0, 1), cA + hstep, voffA);
        if (wr == 1) PG8_BAR;
        PG8_WAIT_V(4); PG8_BAR;
        PG8_STAGE(PG8_SB(1, 0), cB + kstep, voffB); PG8_STAGE(PG8_SA(1, 0), cA + kstep, voffA); PG8_STAGE(PG8_SB(1, 1), cB + hstep + kstep, voffB);
        PG8_WAIT_V(6); PG8_BAR;
    }
    for (;;) {
        const bool has_next = S.next(ui + 1, nxt);
        const char* nA = has_next ? (const char*)g.A + (size_t)nxt.pm * tstep : cA; const char* nB = has_next ? (const char*)g.Bt + (size_t)nxt.pn * tstep : cB;
        for (int t = 0; t < nt; t += 2) {
            if constexpr (Epi::HOOK) { if (t != 0 && (t & 3) == 0) E.hook(acc, cur, (t >> 2) - 1, wr, wc, fr, fq); }
            const bool last = (t == nt - 2);
            const char* a1 = cA + (size_t)(t + 1) * kstep;
            const char* a2 = last ? nA : cA + (size_t)(t + 2) * kstep; const char* b2 = last ? nB : cB + (size_t)(t + 2) * kstep;
            const char* a3 = a2 + kstep; const char* b3 = b2 + kstep;
            if (last && has_next) S.a_ready(nxt);
            if constexpr (SP2) {
            PG8_LDB(B0, 0, 0); PG8_LDB(B1, 0, 1); PG8_SCHED; PG8_LDA(At, 0, 0); PG8_STAGE(PG8_SA(1, 1), a1 + hstep, voffA);
            PG8_WAIT_V(8); PG8_WAIT_L(0); PG8_BAR; PG8_MMA(0, 0, At, B0); PG8_MMA(0, 1, At, B1); PG8_BAR; PG8_SCHED;
            PG8_LDA(At, 0, 1); PG8_STAGE(PG8_SB(0, 0), b2, voffB); PG8_STAGE(PG8_SB(0, 1), b2 + hstep, voffB); PG8_STAGE(PG8_SA(0, 0), a2, voffA);
            PG8_WAIT_V(8); PG8_WAIT_L(0); PG8_BAR; PG8_MMA(1, 0, At, B0); PG8_MMA(1, 1, At, B1); PG8_BAR; PG8_SCHED;
            PG8_LDB(B0, 1, 0); PG8_LDB(B1, 1, 1); PG8_SCHED; PG8_LDA(At, 1, 0); PG8_STAGE(PG8_SA(0, 1), a2 + hstep, voffA);
            PG8_WAIT_V(8); PG8_WAIT_L(0); PG8_BAR; PG8_MMA(0, 0, At, B0); PG8_MMA(0, 1, At, B1); PG8_BAR; PG8_SCHED;
            PG8_LDA(At, 1, 1); PG8_STAGE(PG8_SB(1, 0), b3, voffB); PG8_STAGE(PG8_SB(1, 1), b3 + hstep, voffB); PG8_STAGE(PG8_SA(1, 0), a3, voffA);
            PG8_WAIT_V(8); PG8_WAIT_L(0); PG8_BAR; PG8_MMA(1, 0, At, B0); PG8_MMA(1, 1, At, B1); PG8_BAR; PG8_SCHED;
            } else {
            PG8_LDB(B0, 0, 0); PG8_SCHED; PG8_LDA(At, 0, 0); PG8_STAGE(PG8_SA(1, 1), a1 + hstep, voffA);
            PG8_WAIT_L(8); PG8_BAR; PG8_WAIT_L(0); PG8_MMA(0, 0, At, B0); PG8_BAR; PG8_SCHED;
            PG8_LDB(B1, 0, 1); PG8_STAGE(PG8_SB(0, 0), b2, voffB);
            PG8_BAR; PG8_WAIT_L(0); PG8_MMA(0, 1, At, B1); PG8_BAR;
            PG8_LDA(At, 0, 1); PG8_STAGE(PG8_SA(0, 0), a2, voffA);
            PG8_BAR; PG8_WAIT_L(0); PG8_MMA(1, 0, At, B0); PG8_BAR; PG8_SCHED;
            PG8_STAGE(PG8_SB(0, 1), b2 + hstep, voffB);
            PG8_WAIT_V(6); PG8_BAR; PG8_MMA(1, 1, At, B1); PG8_BAR;
            PG8_LDB(B0, 1, 0); PG8_SCHED; PG8_LDA(At, 1, 0); PG8_STAGE(PG8_SA(0, 1), a2 + hstep, voffA);
            PG8_WAIT_L(8); PG8_BAR; PG8_WAIT_L(0); PG8_MMA(0, 0, At, B0); PG8_BAR; PG8_SCHED;
            PG8_LDB(B1, 1, 1); PG8_STAGE(PG8_SB(1, 0), b3, voffB);
            PG8_BAR; PG8_WAIT_L(0); PG8_MMA(0, 1, At, B1); PG8_BAR;
            PG8_LDA(At, 1, 1); PG8_STAGE(PG8_SA(1, 0), a3, voffA);
            PG8_BAR; PG8_WAIT_L(0); PG8_MMA(1, 0, At, B0); PG8_BAR; PG8_SCHED;
            PG8_STAGE(PG8_SB(1, 1), b3 + hstep, voffB);
            PG8_WAIT_V(6); PG8_BAR; PG8_MMA(1, 1, At, B1); PG8_BAR;
            }
        }
        if constexpr (ALIGN_EPI) { if (wr == 0) PG8_BAR; }
        if constexpr (!Epi::AFTER_DRAIN) { E(acc, cur, wr, wc, fr, fq); S.done(cur); }
        if (!has_next) break;
#pragma unroll
        for (int a = 0; a < 2; ++a)
#pragma unroll
            for (int b = 0; b < 2; ++b)
#pragma unroll
                for (int m = 0; m < 4; ++m)
#pragma unroll
                    for (int n = 0; n < 2; ++n) acc[a][b][m][n] = (f32x4){0.f, 0.f, 0.f, 0.f};
        cur = nxt; cA = nA; cB = nB; ++ui;
        if constexpr (ALIGN_EPI) { if (wr == 1) PG8_BAR; }
    }
    PG8_WAIT_V(0);
    if constexpr (!ALIGN_EPI) { if (wr == 0) PG8_BAR; }
    PG8_BAR;
    if constexpr (Epi::AFTER_DRAIN) { E.fused(acc, cur, wr, wc, fr, fq, lds, wid, lane); S.done(cur); }
#undef PG8_SA
#undef PG8_SB
#undef PG8_STAGE
#undef PG8_LDA
#undef PG8_LDB
#undef PG8_MMA
#undef PG8_WAIT_V
#undef PG8_WAIT_L
#undef PG8_BAR
#undef PG8_SCHED
}
}
namespace cg = cooperative_groups;
using pg8::bf16_t; using pg8::bf16x8; using pg8::f32x4; using pg8::u32x4; using pg8::Unit; using pg8::cvt_pk_bf16;
typedef unsigned u32x2 __attribute__((ext_vector_type(2)));
#define LAS __attribute__((address_space(3)))
#define LDS_WAIT() asm volatile("s_waitcnt lgkmcnt(0)" ::: "memory")

constexpr int M_ = 16384, DM = 1024, SEQ = 4096, DFF = 2816, DIN = 6696, NINP = 6912;
constexpr float EPSN = 1e-6f;
constexpr float LOG2E = 1.4426950408889634f, LN2 = 0.6931471805599453f;
constexpr float C2 = 0.125f * LOG2E;

constexpr size_t MiB = (size_t)1 << 20;
constexpr size_t WS_WIN = 1 * MiB;
constexpr size_t WS_WB = WS_WIN + (size_t)NINP * 1024 * 2;
constexpr size_t WS_WOUT = WS_WB + 2 * MiB;
constexpr size_t WS_WGU = WS_WOUT + 2 * MiB;
constexpr size_t WS_WD = WS_WGU + 11 * MiB;
constexpr size_t WS_WP = WS_WD + (size_t)1024 * 2816 * 2;
constexpr size_t WS_WS = WS_WP + 32768;
static_assert(WS_WS + 131072 <= 36 * MiB, "weights region");
constexpr size_t WS_XN = 36 * MiB;
constexpr size_t WS_R1 = 68 * MiB;
constexpr size_t WS_G = WS_R1, WS_KA = WS_R1 + 64 * MiB, WS_VTA = WS_KA + 8 * MiB, WS_IQ = WS_VTA + 8 * MiB;
constexpr size_t WS_S = 156 * MiB;
constexpr size_t WS_PIN = WS_S, WS_GU = WS_S + 8 * MiB, WS_GV = WS_S + 16 * MiB, WS_SQ = WS_S + 24 * MiB, WS_SK = WS_S + 32 * MiB,
                 WS_VTS = WS_S + 40 * MiB, WS_QA = WS_S + 48 * MiB, WS_MASK = WS_S + 56 * MiB, WS_IK = 220 * MiB, WS_IW = 221 * MiB, WS_OCAT = 222 * MiB  , WS_END = 254 * MiB;

__device__ __forceinline__ float bf2f(unsigned short v) { return __uint_as_float((unsigned)v << 16); }
__device__ __forceinline__ float bflo(unsigned v) { return __uint_as_float(v << 16); }
__device__ __forceinline__ float bfhi(unsigned v) { return __uint_as_float(v & 0xffff0000u); }
__device__ __forceinline__ unsigned short f2bf(float f) { return (unsigned short)(cvt_pk_bf16(f, 0.f) & 0xffffu); }
__device__ __forceinline__ float sigmoidf_(float x) { return __builtin_amdgcn_rcpf(1.f + __builtin_amdgcn_exp2f(-x * LOG2E)); }
__device__ __forceinline__ float gelu_tanh(float x) { const float u = 0.7978845608028654f * (x + 0.044715f * x * x * x); return x * __builtin_amdgcn_rcpf(1.f + __builtin_amdgcn_exp2f(-2.f * LOG2E * u)); }
__device__ __forceinline__ f32x4 mfma16(bf16x8 a, bf16x8 b, f32x4 c) { return __builtin_amdgcn_mfma_f32_16x16x32_bf16(a, b, c, 0, 0, 0); }
__device__ __forceinline__ bf16x8 mk8(unsigned a, unsigned b, unsigned c, unsigned d) { u32x4 v = {a, b, c, d}; return __builtin_bit_cast(bf16x8, v); }

struct EpiIn {
    static constexpr bool PERM = true, AFTER_DRAIN = false, HOOK = false;
    unsigned char* ws; const float *qn, *kn;
    __device__ __forceinline__ void operator()(const f32x4 (&acc)[2][2][4][2], const Unit& u, int wr, int wc, int fr, int fq) const {
        bf16_t* const QA = (bf16_t*)(ws + WS_QA); bf16_t* const KA = (bf16_t*)(ws + WS_KA); bf16_t* const VTA = (bf16_t*)(ws + WS_VTA); bf16_t* const IQ = (bf16_t*)(ws + WS_IQ);
        bf16_t* const PIN = (bf16_t*)(ws + WS_PIN); bf16_t* const GU = (bf16_t*)(ws + WS_GU); bf16_t* const GV = (bf16_t*)(ws + WS_GV); bf16_t* const SQ = (bf16_t*)(ws + WS_SQ);
        bf16_t* const SK = (bf16_t*)(ws + WS_SK); bf16_t* const VTS = (bf16_t*)(ws + WS_VTS); bf16_t* const IK = (bf16_t*)(ws + WS_IK); float* const IW = (float*)(ws + WS_IW); unsigned char* const G = ws + WS_G;
        const int pn = u.pn; const int row0 = u.pm * 256 + wr * 64 + fr; const int cl = wc * 32 + 8 * fq;
        if (pn >= 11) {
            unsigned char* gp = G + (size_t)row0 * 4096 + (pn - 11) * 256 + cl;
#pragma unroll
            for (int ai = 0; ai < 2; ++ai)
#pragma unroll
                for (int m = 0; m < 4; ++m)
#pragma unroll
                    for (int bj = 0; bj < 2; ++bj) {
                        unsigned w2[2];
#pragma unroll
                        for (int n = 0; n < 2; ++n) { const f32x4 v = acc[ai][bj][m][n]; unsigned pk = 0;
#pragma unroll
                            for (int i = 0; i < 4; ++i) { const unsigned qv = (unsigned)(sigmoidf_(v[i]) * 255.f + 0.5f); pk |= qv << (8 * i); }
                            w2[n] = pk; }
                        *(u32x2*)(gp + (size_t)(ai * 128 + m * 16) * 4096 + bj * 128) = (u32x2){w2[0], w2[1]};
                    }
            return;
        }
        if (pn <= 1) {
            const float* gw = pn == 0 ? qn : kn; const float sc = pn == 0 ? C2 : 1.f; bf16_t* T = pn == 0 ? QA : KA;
            f32x4 gv[2][2];
#pragma unroll
            for (int bj = 0; bj < 2; ++bj)
#pragma unroll
                for (int n = 0; n < 2; ++n) gv[bj][n] = *(const f32x4*)(gw + bj * 32 + 8 * fq + 4 * n);
#pragma unroll
            for (int ai = 0; ai < 2; ++ai)
#pragma unroll
                for (int m = 0; m < 4; ++m) {
                    float ss = 0.f;
#pragma unroll
                    for (int bj = 0; bj < 2; ++bj)
#pragma unroll
                        for (int n = 0; n < 2; ++n) { const f32x4 v = acc[ai][bj][m][n]; ss += (v[0] * v[0] + v[1] * v[1]) + (v[2] * v[2] + v[3] * v[3]); }
                    ss += __shfl_xor(ss, 16); ss += __shfl_xor(ss, 32);
                    const float rinv = __builtin_amdgcn_rsqf(ss * (1.f / 64.f) + EPSN) * sc;
                    bf16_t* rp = T + (size_t)(row0 + ai * 128 + m * 16) * 256 + wc * 64 + 8 * fq;
#pragma unroll
                    for (int bj = 0; bj < 2; ++bj) { const f32x4 v0 = acc[ai][bj][m][0] * gv[bj][0] * rinv, v1 = acc[ai][bj][m][1] * gv[bj][1] * rinv;
                        u32x4 w; w.x = cvt_pk_bf16(v0[0], v0[1]); w.y = cvt_pk_bf16(v0[2], v0[3]); w.z = cvt_pk_bf16(v1[0], v1[1]); w.w = cvt_pk_bf16(v1[2], v1[3]);
                        *(u32x4*)(rp + bj * 32) = w; }
                }
            return;
        }
        if (pn == 2 || pn == 9) {
            bf16_t* T = pn == 2 ? VTA : VTS;
#pragma unroll
            for (int ai = 0; ai < 2; ++ai)
#pragma unroll
                for (int m = 0; m < 4; ++m) { const int row = row0 + ai * 128 + m * 16; const int b = row >> 12, t = row & 4095;
#pragma unroll
                    for (int bj = 0; bj < 2; ++bj)
#pragma unroll
                        for (int n = 0; n < 2; ++n) { const f32x4 v = acc[ai][bj][m][n];
#pragma unroll
                            for (int i = 0; i < 4; ++i) T[((size_t)b * 256 + bj * 128 + cl + 4 * n + i) * 4096 + t] = f2bf(v[i]); }
                }
            return;
        }
        if (pn == 10) {
            if (wc == 0) {
#pragma unroll
                for (int ai = 0; ai < 2; ++ai)
#pragma unroll
                    for (int m = 0; m < 4; ++m) { const f32x4 v0 = acc[ai][0][m][0], v1 = acc[ai][0][m][1];
                        u32x4 w; w.x = cvt_pk_bf16(v0[0], v0[1]); w.y = cvt_pk_bf16(v0[2], v0[3]); w.z = cvt_pk_bf16(v1[0], v1[1]); w.w = cvt_pk_bf16(v1[2], v1[3]);
                        *(u32x4*)(IK + (size_t)(row0 + ai * 128 + m * 16) * 32 + 8 * fq) = w; }
            } else if (wc == 1 && fq == 0) {
#pragma unroll
                for (int ai = 0; ai < 2; ++ai)
#pragma unroll
                    for (int m = 0; m < 4; ++m) { float* p = IW + (size_t)(row0 + ai * 128 + m * 16) * 8; *(f32x4*)p = acc[ai][0][m][0]; *(f32x4*)(p + 4) = acc[ai][0][m][1]; }
            }
            return;
        }
        {
            bf16_t* T = pn == 3 ? IQ : pn == 4 ? PIN : pn == 5 ? GU : pn == 6 ? GV : pn == 7 ? SQ : SK;
            const bool act = (pn == 5 || pn == 6); const float sc = pn == 7 ? 0.125f : 1.f;
#pragma unroll
            for (int ai = 0; ai < 2; ++ai)
#pragma unroll
                for (int m = 0; m < 4; ++m) { bf16_t* rp = T + (size_t)(row0 + ai * 128 + m * 16) * 256 + cl;
#pragma unroll
                    for (int bj = 0; bj < 2; ++bj) { f32x4 v0 = acc[ai][bj][m][0] * sc, v1 = acc[ai][bj][m][1] * sc;
                        if (act) {
#pragma unroll
                            for (int i = 0; i < 4; ++i) { v0[i] = gelu_tanh(v0[i]); v1[i] = gelu_tanh(v1[i]); } }
                        u32x4 w; w.x = cvt_pk_bf16(v0[0], v0[1]); w.y = cvt_pk_bf16(v0[2], v0[3]); w.z = cvt_pk_bf16(v1[0], v1[1]); w.w = cvt_pk_bf16(v1[2], v1[3]);
                        *(u32x4*)(rp + bj * 128) = w; }
                }
        }
    }
};

struct EpiMerge {
    static constexpr bool PERM = true, AFTER_DRAIN = false, HOOK = true;
    const unsigned char* G; bf16_t* MG;
    __device__ __forceinline__ void hook(f32x4 (&acc)[2][2][4][2], const Unit& u, int s, int wr, int wc, int fr, int fq) const {
        const int row0 = u.pm * 256 + wr * 64 + fr; const int col0 = u.pn * 256 + wc * 32 + 8 * fq;
        const unsigned char* gp0 = G + (size_t)row0 * 4096 + s * 1024 + col0;
#pragma unroll
        for (int ai = 0; ai < 2; ++ai)
#pragma unroll
            for (int m = 0; m < 4; ++m) {
#pragma unroll
                for (int bj = 0; bj < 2; ++bj) { const unsigned char* gp = gp0 + (size_t)(ai * 128 + m * 16) * 4096 + bj * 128;
                    const u32x2 ga = *(const u32x2*)gp, gb = *(const u32x2*)(gp + 1024);
#pragma unroll
                    for (int i = 0; i < 4; ++i) {
                        const float a0 = fmaxf((float)((ga.x >> (8 * i)) & 255u), 1.f), b0 = fmaxf((float)((gb.x >> (8 * i)) & 255u), 1.f);
                        const float a1 = fmaxf((float)((ga.y >> (8 * i)) & 255u), 1.f), b1 = fmaxf((float)((gb.y >> (8 * i)) & 255u), 1.f);
                        acc[ai][bj][m][0][i] *= a0 * __builtin_amdgcn_rcpf(b0); acc[ai][bj][m][1][i] *= a1 * __builtin_amdgcn_rcpf(b1); }
                }
                asm volatile("" ::: "memory"); }
    }
    __device__ __forceinline__ void operator()(const f32x4 (&acc)[2][2][4][2], const Unit& u, int wr, int wc, int fr, int fq) const {
        const int row0 = u.pm * 256 + wr * 64 + fr; const int col0 = u.pn * 256 + wc * 32 + 8 * fq;
        const unsigned char* gp0 = G + (size_t)row0 * 4096 + 3 * 1024 + col0; bf16_t* mp0 = MG + (size_t)row0 * 1024 + col0;
#pragma unroll
        for (int ai = 0; ai < 2; ++ai)
#pragma unroll
            for (int m = 0; m < 4; ++m) {
#pragma unroll
                for (int bj = 0; bj < 2; ++bj) { const size_t ro = (size_t)(ai * 128 + m * 16);
                    const u32x2 gb = *(const u32x2*)(gp0 + ro * 4096 + bj * 128);
                    f32x4 v0 = acc[ai][bj][m][0], v1 = acc[ai][bj][m][1];
#pragma unroll
                    for (int i = 0; i < 4; ++i) { v0[i] *= fmaxf((float)((gb.x >> (8 * i)) & 255u), 1.f) * (1.f / 255.f); v1[i] *= fmaxf((float)((gb.y >> (8 * i)) & 255u), 1.f) * (1.f / 255.f); }
                    u32x4 w; w.x = cvt_pk_bf16(v0[0], v0[1]); w.y = cvt_pk_bf16(v0[2], v0[3]); w.z = cvt_pk_bf16(v1[0], v1[1]); w.w = cvt_pk_bf16(v1[2], v1[3]);
                    *(u32x4*)(mp0 + ro * 1024 + bj * 128) = w; }
                asm volatile("" ::: "memory"); }
    }
};

struct EpiResid {
    static constexpr bool PERM = true, AFTER_DRAIN = false, HOOK = false;
    const float* base; float* out;
    __device__ __forceinline__ void operator()(const f32x4 (&acc)[2][2][4][2], const Unit& u, int wr, int wc, int fr, int fq) const {
        const int row0 = u.pm * 256 + wr * 64 + fr; const int col0 = u.pn * 256 + wc * 32 + 8 * fq;
#pragma unroll
        for (int ai = 0; ai < 2; ++ai)
#pragma unroll
            for (int m = 0; m < 4; ++m) { const size_t off = (size_t)(row0 + ai * 128 + m * 16) * 1024 + col0;
#pragma unroll
                for (int bj = 0; bj < 2; ++bj) { const f32x4 b0 = *(const f32x4*)(base + off + bj * 128), b1 = *(const f32x4*)(base + off + bj * 128 + 4);
                    *(f32x4*)(out + off + bj * 128) = b0 + acc[ai][bj][m][0]; *(f32x4*)(out + off + bj * 128 + 4) = b1 + acc[ai][bj][m][1]; }
                asm volatile("" ::: "memory"); }
    }
};

struct EpiSwiGLU {
    static constexpr bool PERM = true, AFTER_DRAIN = false, HOOK = false;
    bf16_t* ACT;
    __device__ __forceinline__ void operator()(const f32x4 (&acc)[2][2][4][2], const Unit& u, int wr, int wc, int fr, int fq) const {
        const int row0 = u.pm * 256 + wr * 64 + fr; const int f0 = u.pn * 128 + wc * 32 + 8 * fq;
#pragma unroll
        for (int ai = 0; ai < 2; ++ai)
#pragma unroll
            for (int m = 0; m < 4; ++m) { f32x4 r[2];
#pragma unroll
                for (int n = 0; n < 2; ++n) { const f32x4 g = acc[ai][0][m][n], up = acc[ai][1][m][n];
#pragma unroll
                    for (int i = 0; i < 4; ++i) r[n][i] = g[i] * sigmoidf_(g[i]) * up[i]; }
                u32x4 w; w.x = cvt_pk_bf16(r[0][0], r[0][1]); w.y = cvt_pk_bf16(r[0][2], r[0][3]); w.z = cvt_pk_bf16(r[1][0], r[1][1]); w.w = cvt_pk_bf16(r[1][2], r[1][3]);
                *(u32x4*)(ACT + (size_t)(row0 + ai * 128 + m * 16) * DFF + f0) = w; }
    }
};

__device__ __forceinline__ void cvt_item(const float* src, int ld, int col0, int nvalid, int K, bf16_t* WT, int dst_row0, int kb, LAS float* scr, int lane) {
    const int k0 = 64 * kb, c = lane & 31;
#pragma unroll 8
    for (int i = 0; i < 32; ++i) { const int kk = 2 * i + (lane >> 5); float v = 0.f; if (c < nvalid) v = src[(size_t)(k0 + kk) * ld + col0 + c]; scr[kk * 33 + c] = v; }
    LDS_WAIT();
    const int c8 = lane & 7;
#pragma unroll
    for (int j = 0; j < 4; ++j) { const int n = (lane >> 3) + 8 * j; const LAS float* s = scr + (8 * c8) * 33 + n;
        u32x4 o; o.x = cvt_pk_bf16(s[0 * 33], s[1 * 33]); o.y = cvt_pk_bf16(s[2 * 33], s[3 * 33]); o.z = cvt_pk_bf16(s[4 * 33], s[5 * 33]); o.w = cvt_pk_bf16(s[6 * 33], s[7 * 33]);
        *(u32x4*)(WT + (size_t)(dst_row0 + n) * K + k0 + 8 * c8) = o; }
    LDS_WAIT();
}
__device__ __forceinline__ float wave_sum(float v) {
#pragma unroll
    for (int o = 1; o < 64; o <<= 1) v += __shfl_xor(v, o);
    return v;
}
__device__ __forceinline__ float wave_max(float v) {
#pragma unroll
    for (int o = 1; o < 64; o <<= 1) v = fmaxf(v, __shfl_xor(v, o));
    return v;
}
__device__ __forceinline__ void rmsnorm_rows(const float* xs, const float* gamma, bf16_t* XN, int gw, int ngw, int lane) {
    f32x4 gm[4];
#pragma unroll
    for (int j = 0; j < 4; ++j) gm[j] = *(const f32x4*)(gamma + 4 * lane + 256 * j);
    for (int m = gw; m < M_; m += ngw) {
        const f32x4* xr = (const f32x4*)(xs + (size_t)m * DM) + lane; f32x4 v[4]; float s = 0.f;
#pragma unroll
        for (int j = 0; j < 4; ++j) { v[j] = xr[64 * j]; s += (v[j].x * v[j].x + v[j].y * v[j].y) + (v[j].z * v[j].z + v[j].w * v[j].w); }
        const float r = __builtin_amdgcn_rsqf(wave_sum(s) * (1.f / DM) + EPSN);
        u32x2* o8 = (u32x2*)(XN + (size_t)m * DM) + lane;
#pragma unroll
        for (int j = 0; j < 4; ++j) { const f32x4 y = v[j] * r * gm[j]; o8[64 * j] = (u32x2){cvt_pk_bf16(y.x, y.y), cvt_pk_bf16(y.z, y.w)}; }
    }
}

struct Ptrs {
    const float *w_in, *qn, *kn, *pool_w, *pool_scale, *gm_norm, *gm_ws, *gm_b, *w_branch, *w_out, *w_gate, *w_up, *w_down;
};

__device__ __forceinline__ void convert_weights(const Ptrs& P, unsigned char* ws, LAS float* scr, int gw, int ngw, int lane, int gtid, int ngt) {
    bf16_t* WinT = (bf16_t*)(ws + WS_WIN); bf16_t* WbT = (bf16_t*)(ws + WS_WB); bf16_t* WoutT = (bf16_t*)(ws + WS_WOUT); bf16_t* WguT = (bf16_t*)(ws + WS_WGU);
    bf16_t* WdT = (bf16_t*)(ws + WS_WD); bf16_t* WpT = (bf16_t*)(ws + WS_WP); bf16_t* Wtril = (bf16_t*)(ws + WS_WS);
    constexpr int I_A = 216 * 16, I_B = 512, I_C = 512, I_D = 176 * 16, I_E = 32 * 44, I_F = 8, NIT = I_A + I_B + I_C + I_D + I_E + I_F;
    for (int it = gw; it < NIT; it += ngw) {
        int r = it;
        if (r < I_A) { const int rb = r >> 4, kb = r & 15, tile = rb >> 3, sub = rb & 7; int col0, nv = 32;
            if (tile <= 1) col0 = tile * 256 + (sub & 3) * 64 + (sub >> 2) * 32;
            else if (tile == 2) col0 = 512 + sub * 32;
            else if (tile == 3) col0 = 768 + sub * 32;
            else if (tile <= 9) col0 = 1064 + (tile - 4) * 256 + sub * 32;
            else if (tile == 10) { col0 = sub == 0 ? 1024 : 1056; nv = sub == 0 ? 32 : (sub == 1 ? 8 : 0); }
            else col0 = 2600 + (tile - 11) * 256 + sub * 32;
            cvt_item(P.w_in, DIN, col0, nv, 1024, WinT, rb * 32, kb, scr, lane); continue; }
        r -= I_A;
        if (r < I_B) { const int rb = r >> 4, kb = r & 15; cvt_item(P.w_branch, 1024, rb * 32, 32, 1024, WbT, rb * 32, kb, scr, lane); continue; }
        r -= I_B;
        if (r < I_C) { const int rb = r >> 4, kb = r & 15; cvt_item(P.w_out, 1024, rb * 32, 32, 1024, WoutT, rb * 32, kb, scr, lane); continue; }
        r -= I_C;
        if (r < I_D) { const int rb = r >> 4, kb = r & 15, tile = rb >> 3, sub = rb & 7;
            cvt_item((sub >> 2) ? P.w_up : P.w_gate, DFF, tile * 128 + (sub & 3) * 32, 32, 1024, WguT, rb * 32, kb, scr, lane); continue; }
        r -= I_D;
        if (r < I_E) { const int rb = r / 44, kb = r % 44; cvt_item(P.w_down, 1024, rb * 32, 32, DFF, WdT, rb * 32, kb, scr, lane); continue; }
        r -= I_E;
        { const int gp = r >> 1, rb = r & 1; cvt_item(P.pool_w + gp * 4096, 64, rb * 32, 32, 64, WpT + gp * 4096, rb * 32, 0, scr, lane); }
    }
    for (int e = gtid; e < 4 * 128 * 128; e += ngt) { const int s = e & 127, t = (e >> 7) & 127; Wtril[e] = (s <= t) ? f2bf(P.gm_ws[e]) : (unsigned short)0; }
}

__device__ __forceinline__ unsigned mono_key(float s) { const unsigned b = __float_as_uint(s); return b ^ ((unsigned)((int)b >> 31) | 0x80000000u); }

#define wr_lane(dst, sval, ln) asm volatile("s_nop 4\n\tv_writelane_b32 %0, %1, %2\n\ts_nop 1" : "+v"(dst) : "s"(sval), "n"(ln))
template <int NBLK> __device__ __forceinline__ unsigned a1_bisect(const unsigned (&v)[64]) {
    unsigned prefix = 0u;
#pragma unroll 1
    for (int bit = 31; bit >= 0; --bit) {
        const unsigned cand = prefix | (1u << bit);
        int cnt = 0;
#pragma unroll
        for (int blk = 0; blk < NBLK; ++blk) {
            unsigned long long bl[8];
#pragma unroll
            for (int k = 0; k < 8; ++k) bl[k] = __ballot(v[blk * 8 + k] >= cand);
            __builtin_amdgcn_sched_barrier(0);
#pragma unroll
            for (int k = 0; k < 8; ++k) cnt += __builtin_popcountll(bl[k]);
            __builtin_amdgcn_sched_barrier(0);
        }
        if (cnt >= 256) { prefix = cand; if (cnt == 256) break; }
    }
    return prefix;
}
constexpr int A1_ROWF = 4100;
__device__ __forceinline__ void phase_a1(unsigned char* lds, const bf16_t* IQ, const bf16_t* IK, const float* IW, unsigned short* MASK, int tid, int bid, int G) {
    const int lane = tid & 63, w = __builtin_amdgcn_readfirstlane(tid >> 6), q = lane & 15, g = lane >> 4;
    unsigned* keys = (unsigned*)lds;
#ifndef REP_A1X
#define REP_A1X 1
#endif
    for (int L2 = bid; L2 < 1024 * REP_A1X; L2 += G) {
        const int L = L2 & 1023;
        const int b = L >> 8, c = L & 255, qg = (b & 1) ? 255 - c : c;
        const int row0 = b * SEQ + qg * 16;
        const int nreg = (qg >> 2) + 1;
        if (qg <= 15) {
#pragma unroll
            for (int half = 0; half < 2; ++half) { const int qq = half * 8 + w; const int t = qg * 16 + qq; unsigned mlo = 0u, mhi = 0u;
#pragma unroll
                for (int r = 0; r < 4; ++r) { const unsigned long long bal = __ballot(64 * r + lane <= t);
                    wr_lane(mlo, (unsigned)bal, r); wr_lane(mhi, (unsigned)(bal >> 32), r); }
                if (lane < nreg) *(u32x2*)(MASK + (size_t)(row0 + qq) * 256 + 4 * lane) = (u32x2){mlo, mhi}; }
            continue;
        }
        unsigned u[128];
        {
            bf16x8 iqf[8]; float wv[8];
#pragma unroll
            for (int h = 0; h < 8; ++h) iqf[h] = *(const bf16x8*)(IQ + (size_t)(row0 + q) * 256 + h * 32 + 8 * g);
            { const f32x4 a = *(const f32x4*)(IW + (size_t)(row0 + q) * 8), bq = *(const f32x4*)(IW + (size_t)(row0 + q) * 8 + 4);
              wv[0] = a[0]; wv[1] = a[1]; wv[2] = a[2]; wv[3] = a[3]; wv[4] = bq[0]; wv[5] = bq[1]; wv[6] = bq[2]; wv[7] = bq[3]; }
#ifndef REP_SC
#define REP_SC 1
#endif
#pragma unroll 1
            for (int rs_ = 0; rs_ < REP_SC; ++rs_)
#pragma unroll
            for (int blk = 0; blk < 8; ++blk) {
                if (32 * blk + w <= qg) {
                    bf16x8 kf[4];
#pragma unroll
                    for (int ii = 0; ii < 4; ++ii) { const int kt = 8 * (4 * blk + ii) + w; kf[ii] = *(const bf16x8*)(IK + (size_t)(b * SEQ + kt * 16 + q) * 32 + 8 * g); }
#pragma unroll
                    for (int ii = 0; ii < 4; ++ii) { const int i = 4 * blk + ii; const int kt = 8 * i + w;
                        f32x4 s = {0.f, 0.f, 0.f, 0.f};
#pragma unroll
                        for (int h = 0; h < 8; ++h) { const f32x4 a = mfma16(kf[ii], iqf[h], (f32x4){0.f, 0.f, 0.f, 0.f});
#pragma unroll
                            for (int j = 0; j < 4; ++j) s[j] = __builtin_fmaf(wv[h], fmaxf(a[j], 0.f), s[j]); }
#pragma unroll
                        for (int j = 0; j < 4; ++j) { unsigned uu = mono_key(s[j]); if (kt > qg || (kt == qg && (4 * g + j) > q)) uu = 0u; u[4 * i + j] = uu; }
                    }
                } else {
#pragma unroll
                    for (int r = 0; r < 16; ++r) u[16 * blk + r] = 0u;
                }
            }
        }
#pragma unroll 1
        for (int half = 0; half < 2; ++half) {
            if ((q >> 3) == half) {
                unsigned* krow = keys + (q & 7) * A1_ROWF + 4 * g;
#pragma unroll
                for (int i = 0; i < 32; ++i) { const int kt = 8 * i + w; if (kt <= qg) *(u32x4*)(krow + kt * 16) = (u32x4){u[4 * i], u[4 * i + 1], u[4 * i + 2], u[4 * i + 3]}; }
            }
            __syncthreads();
            {
                const int qq = half * 8 + w; const unsigned* krow = keys + w * A1_ROWF + lane; const int nkeys = (qg + 1) * 16;
                unsigned v[64];
#pragma unroll
                for (int blk = 0; blk < 8; ++blk) {
                    if (nreg > blk * 8) {
#pragma unroll
                        for (int r = blk * 8; r < blk * 8 + 8; ++r) { const unsigned x = krow[64 * r]; v[r] = (64 * r + lane < nkeys) ? x : 0u; }
                    } else {
#pragma unroll
                        for (int r = blk * 8; r < blk * 8 + 8; ++r) v[r] = 0u;
                    }
                }
                unsigned prefix;
                switch ((nreg + 7) >> 3) {
                    case 1: prefix = a1_bisect<1>(v); break; case 2: prefix = a1_bisect<2>(v); break; case 3: prefix = a1_bisect<3>(v); break; case 4: prefix = a1_bisect<4>(v); break;
                    case 5: prefix = a1_bisect<5>(v); break; case 6: prefix = a1_bisect<6>(v); break; case 7: prefix = a1_bisect<7>(v); break; default: prefix = a1_bisect<8>(v); break;
                }
                const unsigned thr = prefix > 1u ? prefix : 1u;
                unsigned mlo = 0u, mhi = 0u;
#pragma unroll
                for (int r = 0; r < 64; ++r) { const unsigned long long bal = __ballot(v[r] >= thr);
                    wr_lane(mlo, (unsigned)bal, r); wr_lane(mhi, (unsigned)(bal >> 32), r); }
                if (lane < nreg) *(u32x2*)(MASK + (size_t)(row0 + qq) * 256 + 4 * lane) = (u32x2){mlo, mhi};
            }
            __syncthreads();
        }
    }
}

__device__ __forceinline__ void phase_a2(unsigned char* lds, const bf16_t* QA, bf16_t* OA, const bf16_t* KA, const bf16_t* VTA, const unsigned short* MASK,
                                         const float* qn, const float* kn, int tid, int bid, int G) {
    const int lane = tid & 63, w = __builtin_amdgcn_readfirstlane(tid >> 6), q = lane & 15, g = lane >> 4;
    bf16_t* Kt = (bf16_t*)lds;
    bf16_t* Vt = (bf16_t*)(lds + 2 * 64 * 72 * 2);
    const float msh = LOG2E * 8.f * wave_max(fabsf(qn[lane])) * wave_max(fabsf(kn[lane])) * 1.02f + 0.25f;
    const int srow = tid >> 3, sch = tid & 7;
    for (int L = bid; L < 512; L += G) {
        const int jj = L >> 8, c = L & 255, bh = c >> 4, qb = jj ? 31 - (c & 15) : (c & 15);
        const int b = bh >> 2, h = bh & 3;
        const int qgw = qb * 8 + w;
        const int row0 = b * SEQ + qb * 128 + 16 * w;
        bf16x8 qf[2];
#pragma unroll
        for (int hf = 0; hf < 2; ++hf) qf[hf] = *(const bf16x8*)(QA + (size_t)(row0 + q) * 256 + h * 64 + hf * 32 + 8 * g);
        const unsigned short* mrow = MASK + (size_t)(row0 + q) * 256;
        const int nsteps = 2 * qb + 2;
        const bf16_t* ksrc = KA + (size_t)(b * SEQ + srow) * 256 + h * 64 + sch * 8;
        const bf16_t* vsrc = VTA + (size_t)(b * 256 + h * 64 + srow) * SEQ + sch * 8;
        u32x4 kreg = *(const u32x4*)ksrc, vreg = *(const u32x4*)vsrc;
        *(u32x4*)(Kt + srow * 72 + sch * 8) = kreg; *(u32x4*)(Vt + srow * 72 + sch * 8) = vreg;
        u32x2 mcur = *(const u32x2*)mrow, mnext = mcur;
        f32x4 o[4]; float lsum = 0.f;
#pragma unroll
        for (int d = 0; d < 4; ++d) o[d] = (f32x4){0.f, 0.f, 0.f, 0.f};
        __syncthreads();
        for (int st = 0; st < nsteps; ++st) {
            const int buf = st & 1; const bool more = st + 1 < nsteps;
            if (more) { kreg = *(const u32x4*)(ksrc + (size_t)(st + 1) * 64 * 256); vreg = *(const u32x4*)(vsrc + (st + 1) * 64); mnext = *(const u32x2*)(mrow + (st + 1) * 4); }
            const bf16_t* kb_ = Kt + buf * 64 * 72; const bf16_t* vb_ = Vt + buf * 64 * 72;
#pragma unroll
            for (int p = 0; p < 2; ++p) {
                const int kt0 = st * 4 + 2 * p;
                if (kt0 <= qgw) {
                    const unsigned mw = p ? mcur.y : mcur.x;
                    const unsigned nib0 = (mw >> (4 * g)) & 15u, nib1 = (kt0 + 1 <= qgw) ? ((mw >> (16 + 4 * g)) & 15u) : 0u;
                    const bf16_t* kr0 = kb_ + (p * 32 + q) * 72 + 8 * g; const bf16_t* kr1 = kr0 + 16 * 72;
                    f32x4 a0 = mfma16(*(const bf16x8*)kr0, qf[0], (f32x4){0.f, 0.f, 0.f, 0.f}); a0 = mfma16(*(const bf16x8*)(kr0 + 32), qf[1], a0);
                    f32x4 a1 = mfma16(*(const bf16x8*)kr1, qf[0], (f32x4){0.f, 0.f, 0.f, 0.f}); a1 = mfma16(*(const bf16x8*)(kr1 + 32), qf[1], a1);
                    float p0[4], p1[4];
#pragma unroll
                    for (int j = 0; j < 4; ++j) { p0[j] = ((nib0 >> j) & 1u) ? __builtin_amdgcn_exp2f(a0[j] - msh) : 0.f; p1[j] = ((nib1 >> j) & 1u) ? __builtin_amdgcn_exp2f(a1[j] - msh) : 0.f; }
                    lsum += ((p0[0] + p0[1]) + (p0[2] + p0[3])) + ((p1[0] + p1[1]) + (p1[2] + p1[3]));
                    const bf16x8 pf = mk8(cvt_pk_bf16(p0[0], p0[1]), cvt_pk_bf16(p0[2], p0[3]), cvt_pk_bf16(p1[0], p1[1]), cvt_pk_bf16(p1[2], p1[3]));
#pragma unroll
                    for (int d = 0; d < 4; ++d) { const bf16_t* vr = vb_ + (d * 16 + q) * 72 + p * 32 + 4 * g;
                        const u32x2 lo = *(const u32x2*)vr, hi = *(const u32x2*)(vr + 16);
                        o[d] = mfma16(mk8(lo.x, lo.y, hi.x, hi.y), pf, o[d]); }
                }
            }
            if (more) { *(u32x4*)(Kt + (buf ^ 1) * 64 * 72 + srow * 72 + sch * 8) = kreg; *(u32x4*)(Vt + (buf ^ 1) * 64 * 72 + srow * 72 + sch * 8) = vreg; }
            __syncthreads();
            mcur = mnext;
        }
        lsum += __shfl_xor(lsum, 16); lsum += __shfl_xor(lsum, 32);
        const float inv = 1.f / lsum;
#pragma unroll
        for (int d = 0; d < 4; ++d) { const f32x4 v = o[d] * inv;
            *(u32x2*)(OA + (size_t)(row0 + q) * 1024 + h * 64 + d * 16 + 4 * g) = (u32x2){cvt_pk_bf16(v[0], v[1]), cvt_pk_bf16(v[2], v[3])}; }
    }
}

__device__ __forceinline__ void phase_b(const bf16_t* PIN, const bf16_t* WpT, const float* pscale, bf16_t* OB, int gw, int ngw, int lane) {
    const int q = lane & 15, g4 = lane >> 4;
    for (int L = gw; L < 4096; L += ngw) {
        const int gp = L >> 10, tg = L & 1023; const int row = tg * 16 + q; const int t = row & (SEQ - 1);
        const int win = 2 << gp; const int cnt = (t + 1 < win) ? t + 1 : win; const float inv = 1.f / (float)cnt;
        f32x4 acc[4];
#pragma unroll
        for (int d = 0; d < 4; ++d) acc[d] = (f32x4){0.f, 0.f, 0.f, 0.f};
#pragma unroll
        for (int ch = 0; ch < 2; ++ch) {
            const bf16_t* p = PIN + (size_t)row * 256 + gp * 64 + ch * 32 + 8 * g4;
            u32x4 wv[16];
#pragma unroll
            for (int i = 0; i < 16; ++i) { wv[i] = (u32x4){0u, 0u, 0u, 0u}; if (i < win && i <= t) wv[i] = *(const u32x4*)(p - (size_t)i * 256); }
            float own[8], sum[8];
            own[0] = bflo(wv[0].x); own[1] = bfhi(wv[0].x); own[2] = bflo(wv[0].y); own[3] = bfhi(wv[0].y); own[4] = bflo(wv[0].z); own[5] = bfhi(wv[0].z); own[6] = bflo(wv[0].w); own[7] = bfhi(wv[0].w);
#pragma unroll
            for (int k = 0; k < 8; ++k) sum[k] = own[k];
#pragma unroll
            for (int i = 1; i < 16; ++i) { const u32x4 v = wv[i];
                sum[0] += bflo(v.x); sum[1] += bfhi(v.x); sum[2] += bflo(v.y); sum[3] += bfhi(v.y); sum[4] += bflo(v.z); sum[5] += bfhi(v.z); sum[6] += bflo(v.w); sum[7] += bfhi(v.w); }
            float pl[8];
#pragma unroll
            for (int k = 0; k < 8; ++k) pl[k] = sum[k] * inv - own[k];
            const bf16x8 bfr = mk8(cvt_pk_bf16(pl[0], pl[1]), cvt_pk_bf16(pl[2], pl[3]), cvt_pk_bf16(pl[4], pl[5]), cvt_pk_bf16(pl[6], pl[7]));
#pragma unroll
            for (int d = 0; d < 4; ++d) { const bf16x8 afr = *(const bf16x8*)(WpT + gp * 4096 + (d * 16 + q) * 64 + ch * 32 + 8 * g4); acc[d] = mfma16(afr, bfr, acc[d]); }
        }
#pragma unroll
        for (int d = 0; d < 4; ++d) { const int d0 = d * 16 + 4 * g4; const f32x4 sc = *(const f32x4*)(pscale + gp * 64 + d0); const f32x4 v = acc[d] * sc;
            *(u32x2*)(OB + (size_t)row * 1024 + gp * 64 + d0) = (u32x2){cvt_pk_bf16(v[0], v[1]), cvt_pk_bf16(v[2], v[3])}; }
    }
}

__device__ __forceinline__ void phase_c(unsigned char* lds, const bf16_t* GV, const bf16_t* GU, bf16_t* OC, const float* gamma, const bf16_t* Wtril, const float* gbias, int tid, int bid, int G) {
    bf16_t* LT = (bf16_t*)lds;
    const int lane = tid & 63, w = __builtin_amdgcn_readfirstlane(tid >> 6), q = lane & 15, g4 = lane >> 4;
    for (int L = bid; L < 512; L += G) {
        const int gp = L & 3, chk = L >> 2; const int R0 = chk * 128;
        {
            const int row = tid >> 2, part = tid & 3;
            const bf16_t* src = GV + (size_t)(R0 + row) * 256 + part * 64;
            float x[64];
#pragma unroll
            for (int k8 = 0; k8 < 8; ++k8) { const u32x4 v = *(const u32x4*)(src + 8 * k8);
                x[8 * k8 + 0] = bflo(v.x); x[8 * k8 + 1] = bfhi(v.x); x[8 * k8 + 2] = bflo(v.y); x[8 * k8 + 3] = bfhi(v.y); x[8 * k8 + 4] = bflo(v.z); x[8 * k8 + 5] = bfhi(v.z); x[8 * k8 + 6] = bflo(v.w); x[8 * k8 + 7] = bfhi(v.w); }
            float s = 0.f;
#pragma unroll
            for (int k = 0; k < 64; ++k) s += x[k];
            s += __shfl_xor(s, 1); s += __shfl_xor(s, 2);
            const float mean = s * (1.f / 256.f); float ss = 0.f;
#pragma unroll
            for (int k = 0; k < 64; ++k) { const float dd = x[k] - mean; ss += dd * dd; }
            ss += __shfl_xor(ss, 1); ss += __shfl_xor(ss, 2);
            const float rstd = __builtin_amdgcn_rsqf(ss * (1.f / 256.f) + EPSN);
            if (part == gp) {
#pragma unroll
                for (int k4 = 0; k4 < 16; ++k4) { const f32x4 gm = *(const f32x4*)(gamma + gp * 64 + 4 * k4);
#pragma unroll
                    for (int i = 0; i < 4; ++i) LT[(4 * k4 + i) * 136 + row] = f2bf((x[4 * k4 + i] - mean) * rstd * gm[i]); }
            }
        }
        __syncthreads();
        {
            f32x4 acc[4];
#pragma unroll
            for (int d = 0; d < 4; ++d) acc[d] = (f32x4){0.f, 0.f, 0.f, 0.f};
            const int t = 16 * w + q; const int nsb = ((16 * w + 15) >> 5) + 1;
            for (int sb = 0; sb < nsb; ++sb) {
                const bf16x8 bfr = *(const bf16x8*)(Wtril + ((size_t)gp * 128 + t) * 128 + sb * 32 + 8 * g4);
#pragma unroll
                for (int d = 0; d < 4; ++d) { const bf16x8 afr = *(const bf16x8*)(LT + (d * 16 + q) * 136 + sb * 32 + 8 * g4); acc[d] = mfma16(afr, bfr, acc[d]); }
            }
            const float bias = gbias[gp * 128 + t];
#pragma unroll
            for (int d = 0; d < 4; ++d) { const size_t eo = (size_t)(R0 + t) * 256 + gp * 64 + d * 16 + 4 * g4; const u32x2 uu = *(const u32x2*)(GU + eo);
                const float r0 = bflo(uu.x) * (acc[d][0] + bias), r1 = bfhi(uu.x) * (acc[d][1] + bias), r2 = bflo(uu.y) * (acc[d][2] + bias), r3 = bfhi(uu.y) * (acc[d][3] + bias);
                *(u32x2*)(OC + (size_t)(R0 + t) * 1024 + gp * 64 + d * 16 + 4 * g4) = (u32x2){cvt_pk_bf16(r0, r1), cvt_pk_bf16(r2, r3)}; }
        }
        __syncthreads();
    }
}

__device__ __forceinline__ void sb_tile(const f32x4 z, int kbase, int tq, int g, float& carry, float (&a)[4]) {
    float lm[4]; bool msk[4];
#pragma unroll
    for (int j = 0; j < 4; ++j) { msk[j] = (kbase + 4 * g + j) >= tq;
        const float e = __builtin_amdgcn_exp2f(-fabsf(z[j]) * LOG2E); const float sp = fmaxf(z[j], 0.f) + __builtin_amdgcn_logf(1.f + e) * LN2;
        lm[j] = msk[j] ? 0.f : -sp; }
    const float suf2 = lm[3], suf1 = lm[3] + lm[2], suf0 = suf1 + lm[1]; const float T = suf0 + lm[0];
    const float x16 = __shfl_xor(T, 16); const float Pp = T + x16; const float Qq = __shfl_xor(Pp, 32);
    const float Sg = ((g & 1) ? 0.f : x16) + ((g & 2) ? 0.f : Qq);
    const float base = carry + Sg;
    const float tl[4] = {base + suf0, base + suf1, base + suf2, base};
#pragma unroll
    for (int j = 0; j < 4; ++j) a[j] = msk[j] ? 0.f : __builtin_amdgcn_exp2f((z[j] + lm[j] + tl[j]) * LOG2E);
    carry += Pp + Qq;
}
__device__ __forceinline__ void phase_d(const bf16_t* SQ, bf16_t* OD, const bf16_t* SK, const bf16_t* VTS, int gw, int ngw, int lane) {
    const int q = lane & 15, g = lane >> 4;
    for (int L = gw; L < 4096; L += ngw) {
        const int qg = L & 255, bh = L >> 8, b = bh >> 2, h = bh & 3;
        const int row0 = b * SEQ + qg * 16; const int tq = qg * 16 + q;
        bf16x8 qf[2];
#pragma unroll
        for (int hf = 0; hf < 2; ++hf) qf[hf] = *(const bf16x8*)(SQ + (size_t)(row0 + q) * 256 + h * 64 + hf * 32 + 8 * g);
        f32x4 o[4];
#pragma unroll
        for (int d = 0; d < 4; ++d) o[d] = (f32x4){0.f, 0.f, 0.f, 0.f};
        float carry = 0.f;
        for (int pp = qg >> 1; pp >= 0; --pp) {
            const int kt0 = 2 * pp, kt1 = kt0 + 1;
            float a0[4], a1[4];
            if (kt1 <= qg) {
                const bf16_t* kr = SK + (size_t)(b * SEQ + kt1 * 16 + q) * 256 + h * 64 + 8 * g;
                f32x4 z = mfma16(*(const bf16x8*)kr, qf[0], (f32x4){0.f, 0.f, 0.f, 0.f}); z = mfma16(*(const bf16x8*)(kr + 32), qf[1], z);
                sb_tile(z, kt1 * 16, tq, g, carry, a1);
            } else {
#pragma unroll
                for (int j = 0; j < 4; ++j) a1[j] = 0.f;
            }
            {
                const bf16_t* kr = SK + (size_t)(b * SEQ + kt0 * 16 + q) * 256 + h * 64 + 8 * g;
                f32x4 z = mfma16(*(const bf16x8*)kr, qf[0], (f32x4){0.f, 0.f, 0.f, 0.f}); z = mfma16(*(const bf16x8*)(kr + 32), qf[1], z);
                sb_tile(z, kt0 * 16, tq, g, carry, a0);
            }
            const bf16x8 pf = mk8(cvt_pk_bf16(a0[0], a0[1]), cvt_pk_bf16(a0[2], a0[3]), cvt_pk_bf16(a1[0], a1[1]), cvt_pk_bf16(a1[2], a1[3]));
#pragma unroll
            for (int d = 0; d < 4; ++d) { const bf16_t* vr = VTS + (size_t)(b * 256 + h * 64 + d * 16 + q) * SEQ + kt0 * 16 + 4 * g;
                const u32x2 lo = *(const u32x2*)vr, hi = *(const u32x2*)(vr + 16);
                o[d] = mfma16(mk8(lo.x, lo.y, hi.x, hi.y), pf, o[d]); }
            if (__all(carry < -104.f)) break;
        }
#pragma unroll
        for (int d = 0; d < 4; ++d) *(u32x2*)(OD + (size_t)(row0 + q) * 1024 + h * 64 + d * 16 + 4 * g) = (u32x2){cvt_pk_bf16(o[d][0], o[d][1]), cvt_pk_bf16(o[d][2], o[d][3])};
    }
}

#define XB_TMO      128
#define XB_XCNT(j)  (256  + 64 * (j))
#define XB_XSUB(j)  (1280 + 64 * (j))
#define XB_XGEN(j)  (2304 + 64 * (j))
#define XB_TOP      3328
#define XB_TOPGEN   3392
#define XCD_BAR_WORDS 3456
#define XB_SPIN_CAP (1u << 18)

__device__ __forceinline__ unsigned xb_ld(unsigned* p)              { return __hip_atomic_load(p, __ATOMIC_RELAXED, __HIP_MEMORY_SCOPE_AGENT); }
__device__ __forceinline__ unsigned xb_add(unsigned* p, unsigned v) { return __hip_atomic_fetch_add(p, v, __ATOMIC_RELAXED, __HIP_MEMORY_SCOPE_AGENT); }
__device__ __forceinline__ unsigned xb_xcc_id() { return (unsigned)__builtin_amdgcn_s_getreg((3 << 11) | 20) & 0xFu; }
#define XB_SPIN(cond, bar) do { unsigned _sp = 0; while (cond) { __builtin_amdgcn_s_sleep(1); \
    if ((++_sp & 255u) == 0u) { if (xb_ld(&(bar)[XB_TMO])) break; if (_sp > XB_SPIN_CAP) { atomicAdd(&(bar)[XB_TMO], 1u); break; } } } } while (0)

struct XcdBarrier {
    unsigned* bar; unsigned x;
    volatile LAS unsigned* st;
};

__device__ __forceinline__ XcdBarrier xcd_barrier_post(unsigned* bar, volatile LAS unsigned* st) {
    XcdBarrier b; b.bar = bar; b.x = xb_xcc_id(); b.st = st;
    if (threadIdx.x == 0) (void)xb_add(&bar[XB_XCNT(b.x)], 1u);
    return b;
}
__device__ __forceinline__ void xcd_barrier_complete(unsigned* bar, unsigned x, unsigned& nloc, unsigned& nx) {
    const unsigned G = gridDim.x * gridDim.y * gridDim.z;
    unsigned sum, cnt, mine, sp = 0u;
    for (;;) {
        sum = 0u; cnt = 0u; mine = 0u;
#pragma unroll
        for (unsigned j = 0; j < 16; ++j) { const unsigned c = xb_ld(&bar[XB_XCNT(j)]); sum += c; cnt += (c > 0u) ? 1u : 0u; mine = (j == x) ? c : mine; }
        if (sum == G) break;
        __builtin_amdgcn_s_sleep(1);
        if ((++sp & 255u) == 0u) { if (xb_ld(&bar[XB_TMO])) break; if (sp > XB_SPIN_CAP) { atomicAdd(&bar[XB_TMO], 1u); break; } }
    }
    nloc = mine > 0u ? mine : 1u; nx = cnt > 0u ? cnt : 1u;
}

__device__ __forceinline__ void xcd_barrier(const XcdBarrier& b) {
    asm volatile("s_waitcnt vmcnt(0)" ::: "memory");
    __syncthreads();
    if (threadIdx.x == 0) {
        unsigned* bar = b.bar;
        __builtin_amdgcn_s_waitcnt(0);
        unsigned nloc = b.st[0], nx = b.st[1];
        if (nloc == 0u) { xcd_barrier_complete(bar, b.x, nloc, nx); b.st[0] = nloc; b.st[1] = nx; }
        const unsigned old = xb_add(&bar[XB_XSUB(b.x)], 1u);
        const unsigned gen = old / nloc;
        if (old + 1u == (gen + 1u) * nloc) {
            __builtin_amdgcn_fence(__ATOMIC_RELEASE, "agent");
            asm volatile("s_waitcnt vmcnt(0)" ::: "memory");
            const unsigned og = xb_add(&bar[XB_TOP], 1u);
            const unsigned tg = og / nx;
            if (og + 1u == (tg + 1u) * nx) xb_add(&bar[XB_TOPGEN], 1u);
            else XB_SPIN(xb_ld(&bar[XB_TOPGEN]) == tg, bar);
            __builtin_amdgcn_fence(__ATOMIC_ACQUIRE, "agent");
            xb_add(&bar[XB_XGEN(b.x)], 1u);
            asm volatile("s_waitcnt vmcnt(0)" ::: "memory");
        } else {
            XB_SPIN(xb_ld(&bar[XB_XGEN(b.x)]) == gen, bar);
            __builtin_amdgcn_fence(__ATOMIC_ACQUIRE, "agent");
            asm volatile("s_waitcnt vmcnt(0)" ::: "memory");
        }
    }
    __syncthreads();
}

#ifndef REP_P0
#define REP_P0 1
#endif
#ifndef REP_P1
#define REP_P1 1
#endif
#ifndef REP_A1
#define REP_A1 1
#endif
#ifndef REP_BCD
#define REP_BCD 1
#endif
#ifndef REP_A2
#define REP_A2 1
#endif
#ifndef REP_MG
#define REP_MG 1
#endif
#ifndef REP_UP
#define REP_UP 1
#endif
#ifndef REP_WO
#define REP_WO 1
#endif
#ifndef REP_N2
#define REP_N2 1
#endif
#ifndef REP_DN
#define REP_DN 1
#endif
#ifndef REP_B
#define REP_B 1
#endif
#ifndef REP_C
#define REP_C 1
#endif
#ifndef REP_D
#define REP_D 1
#endif
#ifndef REP_SYNC
#define REP_SYNC 1
#endif
#define GSYNC() do { _Pragma("unroll 1") for (int r_ = 0; r_ < REP_SYNC; ++r_) xcd_barrier(bar); } while (0)
#define REPEAT(n) _Pragma("unroll 1") for (int rep_ = 0; rep_ < (n); ++rep_)
struct Args { const float* in[16]; float* out; unsigned char* ws; };
constexpr int LDS_BYTES = 147456;
__device__ __forceinline__ unsigned char* opq(unsigned char* p) { asm volatile("" : "+s"(p)); return p; }
__device__ __forceinline__ int opq_tid() { int t = threadIdx.x; asm volatile("" : "+v"(t)); return t; }
#define WSB(T, off) ((T*)(ws + (off)))
constexpr int PTAB_OFF = 147456 - 512, BST_OFF = 147456 - 64;
__device__ __forceinline__ void* ldp(PG8_LAS unsigned char* ldsl, int i) {
    unsigned off = PTAB_OFF + 8 * i; asm volatile("" : "+v"(off));
    const unsigned long long v = *(volatile LAS unsigned long long*)(ldsl + off);
    const unsigned lo = __builtin_amdgcn_readfirstlane((unsigned)v), hi = __builtin_amdgcn_readfirstlane((unsigned)(v >> 32));
    return (void*)(((unsigned long long)hi << 32) | lo);
}

__global__ void __launch_bounds__(512, 2) fwd_kernel(Args a) {
    extern __shared__ __attribute__((aligned(16))) unsigned char lds[];
    cg::grid_group grid = cg::this_grid();
    PG8_LAS unsigned char* ldsl = (PG8_LAS unsigned char*)lds;
    if (a.ws == nullptr) grid.sync();
    if (threadIdx.x == 0) { ((volatile LAS unsigned*)(ldsl + BST_OFF))[0] = 0u; ((volatile LAS unsigned*)(ldsl + BST_OFF))[1] = 0u; }
    if (threadIdx.x == 0) { LAS unsigned long long* tb = (LAS unsigned long long*)(ldsl + PTAB_OFF);
#pragma unroll
        for (int i = 0; i < 16; ++i) tb[i] = (unsigned long long)a.in[i];
        tb[16] = (unsigned long long)a.out; tb[17] = (unsigned long long)a.ws; }
    __syncthreads();
    XcdBarrier bar = xcd_barrier_post((unsigned*)a.ws + 1024, (volatile LAS unsigned*)(ldsl + BST_OFF));
#define INP(i) ((const float*)ldp(ldsl, (i)))
#define OUTP ((float*)ldp(ldsl, 16))
#define WSP ((unsigned char*)ldp(ldsl, 17))

#define PHASE_VARS unsigned char* ws = WSP; int bid = blockIdx.x; asm volatile("" : "+s"(bid)); int G = gridDim.x; asm volatile("" : "+s"(G)); \
    const int tid = opq_tid(), lane = tid & 63, wave = __builtin_amdgcn_readfirstlane(tid >> 6); const int gw = bid * 8 + wave, ngw = G * 8; (void)ws; (void)lane; (void)gw; (void)ngw;
#pragma unroll 1
    for (int l = 0; l < 2; ++l) {
        REPEAT(REP_P0) {
            PHASE_VARS
#ifndef NO_CVT
            Ptrs P;
            P.w_in = INP(2) + (size_t)l * DM * DIN; P.qn = INP(3) + l * 64; P.kn = INP(4) + l * 64; P.pool_w = INP(5) + l * 4 * 64 * 64; P.pool_scale = INP(6) + l * 256;
            P.gm_norm = INP(7) + l * 256; P.gm_ws = INP(8) + l * 4 * 128 * 128; P.gm_b = INP(9) + l * 4 * 128; P.w_branch = INP(10) + (size_t)l * 4 * 256 * 1024;
            P.w_out = INP(11) + (size_t)l * 1024 * 1024; P.w_gate = INP(13) + (size_t)l * DM * DFF; P.w_up = INP(14) + (size_t)l * DM * DFF; P.w_down = INP(15) + (size_t)l * DFF * DM;
            convert_weights(P, ws, (LAS float*)(ldsl + wave * 8448), gw, ngw, lane, bid * 512 + tid, G * 512);
#endif
            rmsnorm_rows(l == 0 ? INP(0) : OUTP, INP(1) + l * DM, WSB(bf16_t, WS_XN), gw, ngw, lane);
        }
        GSYNC();
        REPEAT(REP_P1) {
            PHASE_VARS
            pg8::Gemm g{WSB(bf16_t, WS_XN), WSB(bf16_t, WS_WIN), M_, NINP, DM}; pg8::StaticOrder S; S.init(M_, NINP, G, bid);
            EpiIn E{ws, INP(3) + l * 64, INP(4) + l * 64};
#ifndef NO_G1
            pg8::gemm_phase<EpiIn, pg8::StaticOrder, true, true>(ldsl, g, S, E);
#endif
        }
        GSYNC();
        REPEAT(REP_A1) {
            PHASE_VARS
#ifndef NO_A1
            phase_a1(lds, WSB(bf16_t, WS_IQ), WSB(bf16_t, WS_IK), WSB(float, WS_IW), WSB(unsigned short, WS_MASK), tid, bid, G);
#endif
            __syncthreads();
        }
        REPEAT(REP_BCD) {
        REPEAT(REP_C) {
            PHASE_VARS
#ifndef NO_C
            phase_c(lds, WSB(bf16_t, WS_GV), WSB(bf16_t, WS_GU), WSB(bf16_t, WS_OCAT) + 512, INP(7) + l * 256, WSB(bf16_t, WS_WS), INP(9) + l * 4 * 128, tid, bid, G);
#endif
        }
        REPEAT(REP_B) {
            PHASE_VARS
#ifndef NO_B
            phase_b(WSB(bf16_t, WS_PIN), WSB(bf16_t, WS_WP), INP(6) + l * 256, WSB(bf16_t, WS_OCAT) + 256, gw, ngw, lane);
#endif
        }
        REPEAT(REP_D) {
            PHASE_VARS
#ifndef NO_D
            phase_d(WSB(bf16_t, WS_SQ), WSB(bf16_t, WS_OCAT) + 768, WSB(bf16_t, WS_SK), WSB(bf16_t, WS_VTS), gw, ngw, lane);
#endif
        }
        }
        GSYNC();
        REPEAT(REP_A2) {
            PHASE_VARS
#ifndef NO_A2
            phase_a2(lds, WSB(bf16_t, WS_QA), WSB(bf16_t, WS_OCAT), WSB(bf16_t, WS_KA), WSB(bf16_t, WS_VTA), WSB(unsigned short, WS_MASK), INP(3) + l * 64, INP(4) + l * 64, tid, bid, G);
#endif
        }
        GSYNC();
        REPEAT(REP_MG) {
            PHASE_VARS
            pg8::Gemm g{WSB(bf16_t, WS_OCAT), WSB(bf16_t, WS_WB), M_, DM, DM}; pg8::StaticOrder S; S.init(M_, DM, G, bid);
            EpiMerge E{ws + WS_G, WSB(bf16_t, WS_XN)};
#ifndef NO_G2
            pg8::gemm_phase<EpiMerge, pg8::StaticOrder, true, true>(ldsl, g, S, E);
#endif
        }
        GSYNC();
        REPEAT(REP_WO) {
            PHASE_VARS
            pg8::Gemm g{WSB(bf16_t, WS_XN), WSB(bf16_t, WS_WOUT), M_, DM, DM}; pg8::StaticOrder S; S.init(M_, DM, G, bid);
            EpiResid E{l == 0 ? INP(0) : OUTP, rep_ == REP_WO - 1 ? OUTP : WSB(float, WS_S)};
#ifndef NO_G3
            pg8::gemm_phase<EpiResid, pg8::StaticOrder, true, true>(ldsl, g, S, E);
#endif
        }
        GSYNC();
        REPEAT(REP_N2) {
            PHASE_VARS
            rmsnorm_rows(OUTP, INP(12) + l * DM, WSB(bf16_t, WS_XN), gw, ngw, lane);
        }
        GSYNC();
        REPEAT(REP_UP) {
            PHASE_VARS
            pg8::Gemm g{WSB(bf16_t, WS_XN), WSB(bf16_t, WS_WGU), M_, 2 * DFF, DM}; pg8::StaticOrder S; S.init(M_, 2 * DFF, G, bid);
            EpiSwiGLU E{WSB(bf16_t, WS_R1)};
#ifndef NO_G4
            pg8::gemm_phase<EpiSwiGLU, pg8::StaticOrder, true, true>(ldsl, g, S, E);
#endif
        }
        GSYNC();
        REPEAT(REP_DN) {
            PHASE_VARS
            pg8::Gemm g{WSB(bf16_t, WS_R1), WSB(bf16_t, WS_WD), M_, DM, DFF}; pg8::StaticOrder S; S.init(M_, DM, G, bid);
            float* o = OUTP; EpiResid E{o, rep_ == REP_DN - 1 ? o : WSB(float, WS_S)};
#ifndef NO_G3
            pg8::gemm_phase<EpiResid, pg8::StaticOrder, true, true>(ldsl, g, S, E);
#endif
        }
        if (l == 0) GSYNC();
    }
}

extern "C" void kernel_launch(void* const* d_in, const int* in_sizes, int n_in, void* d_out, int out_size, void* d_ws, size_t ws_size, hipStream_t stream) {
    static int grid_blocks = 0;
    if (grid_blocks == 0) {
        if (n_in != 16 || out_size != M_ * DM || ws_size < WS_END) { fprintf(stderr, "kernel_launch: unexpected shapes (n_in %d out %d ws %zu)\n", n_in, out_size, ws_size); grid_blocks = -1; return; }
        int dev = 0, cus = 0, per_cu = 0;
        hipGetDevice(&dev);
        hipDeviceGetAttribute(&cus, hipDeviceAttributeMultiprocessorCount, dev);
        hipFuncSetAttribute((const void*)fwd_kernel, hipFuncAttributeMaxDynamicSharedMemorySize, LDS_BYTES);
        if (hipOccupancyMaxActiveBlocksPerMultiprocessor(&per_cu, (const void*)fwd_kernel, 512, LDS_BYTES) != hipSuccess || per_cu < 1) per_cu = 1;
        (void)hipGetLastError();
        grid_blocks = cus;
    }
    if (grid_blocks < 0) return;
    Args a{};
    for (int i = 0; i < 16; ++i) a.in[i] = (const float*)d_in[i];
    a.out = (float*)d_out; a.ws = (unsigned char*)d_ws;
    if (hipMemsetAsync(d_ws, 0, 65536, stream) != hipSuccess) { fprintf(stderr, "kernel_launch: memset failed\n"); return; }
    void* args[] = {&a};
    hipError_t e = hipLaunchCooperativeKernel((const void*)fwd_kernel, dim3(grid_blocks), dim3(512), args, LDS_BYTES, stream);
    if (e != hipSuccess) fprintf(stderr, "cooperative launch failed: %s (grid %d)\n", hipGetErrorString(e), grid_blocks);
}
```

```cpp
#include <hip/hip_runtime.h>
#include <hip/hip_cooperative_groups.h>
#include <cstdio>
#include <cstdint>
namespace pg8 {
#define PG8_LAS __attribute__((address_space(3)))
typedef unsigned short bf16_t;
typedef short bf16x8 __attribute__((ext_vector_type(8)));
typedef float f32x4 __attribute__((ext_vector_type(4)));
typedef unsigned u32x4 __attribute__((ext_vector_type(4)));
constexpr int BM = 256, BK = 64, HALF = 128, HTB = HALF * BK * 2  , STAGE_BYTES = 8 * HTB, NXCD = 8, WGM = 8;

__host__ __device__ __forceinline__ int lds_byte(int r, int c) { const int st = (r >> 4) * 2 + (c >> 5), rr = r & 15, cc = c & 31, ob = rr * 64 + cc * 2; return st * 1024 + (ob ^ (((ob >> 9) & 1) << 5)); }
__host__ __device__ __forceinline__ void stage_rc(int b, int& R, int& C) { const int st = b / 1024, sb = b % 1024, swz = sb ^ (((sb >> 9) & 1) << 5); R = (st >> 1) * 16 + swz / 64; C = (st & 1) * 32 + (swz % 64) / 2; }
__host__ __device__ __forceinline__ int perm32(int rho) { const int n = rho >> 4, i = rho & 15; return 8 * (i >> 2) + 4 * n + (i & 3); }

struct Unit { int pm, pn; };
struct Gemm { const bf16_t* A; const bf16_t* Bt; int M, N, K; };

struct StaticOrder {
    int nM, nN, nwg, G, c;
    __host__ __device__ void init(int M, int N, int G_, int c_) { nM = M / BM; nN = N / BM; nwg = nM * nN; G = G_; c = c_; }
    __host__ __device__ bool next(int i, Unit& u) const {
        const long L = (long)i * G + c; if (L >= nwg) return false;
        int wgid = (int)L; { const int q = nwg / NXCD, r = nwg % NXCD, xcd = wgid % NXCD, off = wgid / NXCD; wgid = (xcd < r ? xcd * (q + 1) : r * (q + 1) + (xcd - r) * q) + off; }
        const int nig = WGM * nN, gid = wgid / nig, fm = gid * WGM, gsz = (nM - fm) < WGM ? (nM - fm) : WGM;
        u.pm = fm + ((wgid % nig) % gsz); u.pn = (wgid % nig) / gsz; return true;
    }
    __device__ __forceinline__ void a_ready(const Unit&) const {}
    __device__ __forceinline__ void done(const Unit&) const {}
};

__device__ __forceinline__ unsigned cvt_pk_bf16(float lo, float hi) { unsigned r; asm volatile("v_cvt_pk_bf16_f32 %0, %1, %2" : "=v"(r) : "v"(lo), "v"(hi)); return r; }
template <class Epi, class Sched, bool ALIGN_EPI = false, bool SP2 = false>
__device__ __forceinline__ void gemm_phase(PG8_LAS unsigned char* lds, const Gemm g, const Sched& S, const Epi& E) {
    int tid_ = threadIdx.x; asm volatile("" : "+v"(tid_)); const int tid = tid_, wid = __builtin_amdgcn_readfirstlane(tid >> 6), lane = tid & 63, wr = wid >> 2, wc = wid & 3, fr = lane & 15, fq = lane >> 4;
    const int K = g.K, nt = K / BK;
    unsigned voffA[2], voffB[2];
#pragma unroll
    for (int i = 0; i < 2; ++i) { int R, C; stage_rc(tid * 16 + i * 8192, R, C); const int Rb = Epi::PERM ? ((R & ~31) + perm32(R & 31)) : R;
        voffA[i] = (unsigned)(R * K + C) * 2u; voffB[i] = (unsigned)(Rb * K + C) * 2u; }
    const size_t kstep = (size_t)(BK * 2);
    const size_t hstep = (size_t)HALF * K * 2;
    const size_t tstep = 2 * hstep;
    const unsigned ldsw = (unsigned)wid * 1024u;
    const int aoff = lds_byte(wr * 64 + fr, fq * 8), boff = lds_byte(wc * 32 + fr, fq * 8);
#define PG8_SA(b, h) (((b) * 2 + (h)) * HTB)
#define PG8_SB(b, h) ((4 + (b) * 2 + (h)) * HTB)
#define PG8_STAGE(bufoff, gbase, voff) do { _Pragma("unroll") for (int _i = 0; _i < 2; ++_i) \
        __builtin_amdgcn_global_load_lds((const unsigned*)((const char*)(gbase) + (voff)[_i]), (PG8_LAS unsigned*)(lds + (bufoff) + ldsw + _i * 8192), 16, 0, 0); } while (0)
#define PG8_LDA(dst, b, h) do { _Pragma("unroll") for (int m = 0; m < 4; ++m) _Pragma("unroll") for (int k = 0; k < 2; ++k) dst[m][k] = *(const PG8_LAS bf16x8*)(lds + PG8_SA(b, h) + aoff + m * 2048 + k * 1024); } while (0)
#define PG8_LDB(dst, b, h) do { _Pragma("unroll") for (int n = 0; n < 2; ++n) _Pragma("unroll") for (int k = 0; k < 2; ++k) dst[n][k] = *(const PG8_LAS bf16x8*)(lds + PG8_SB(b, h) + boff + n * 2048 + k * 1024); } while (0)
#define PG8_MMA(ai, bj, At, Bt) do { __builtin_amdgcn_s_setprio(1); _Pragma("unroll") for (int m = 0; m < 4; ++m) _Pragma("unroll") for (int n = 0; n < 2; ++n) _Pragma("unroll") for (int k = 0; k < 2; ++k) \
        acc[ai][bj][m][n] = __builtin_amdgcn_mfma_f32_16x16x32_bf16(Bt[n][k], At[m][k], acc[ai][bj][m][n], 0, 0, 0); __builtin_amdgcn_s_setprio(0); } while (0)
#define PG8_WAIT_V(n) asm volatile("s_waitcnt vmcnt(" #n ")" ::: "memory")
#define PG8_WAIT_L(n) asm volatile("s_waitcnt lgkmcnt(" #n ")" ::: "memory")
#define PG8_BAR __builtin_amdgcn_s_barrier()
#define PG8_SCHED __builtin_amdgcn_sched_barrier(0)
    Unit cur, nxt; int ui = 0;
    if (!S.next(0, cur)) return;
    f32x4 acc[2][2][4][2];
#pragma unroll
    for (int a = 0; a < 2; ++a)
#pragma unroll
        for (int b = 0; b < 2; ++b)
#pragma unroll
            for (int m = 0; m < 4; ++m)
#pragma unroll
                for (int n = 0; n < 2; ++n) acc[a][b][m][n] = (f32x4){0.f, 0.f, 0.f, 0.f};
    bf16x8 At[4][2], B0[2][2], B1[2][2];
    const char* cA = (const char*)g.A + (size_t)cur.pm * tstep; const char* cB = (const char*)g.Bt + (size_t)cur.pn * tstep;
    S.a_ready(cur);
    if constexpr (SP2) {
        PG8_STAGE(PG8_SB(0, 0), cB, voffB); PG8_STAGE(PG8_SB(0, 1), cB + hstep, voffB); PG8_STAGE(PG8_SA(0, 0), cA, voffA); PG8_STAGE(PG8_SA(0, 1), cA + hstep, voffA);
        if (wr == 1) PG8_BAR;
        PG8_WAIT_V(2); PG8_BAR;
        PG8_STAGE(PG8_SB(1, 0), cB + kstep, voffB); PG8_STAGE(PG8_SA(1, 0), cA + kstep, voffA); PG8_STAGE(PG8_SB(1, 1), cB + hstep + kstep, voffB);
        PG8_WAIT_V(6); PG8_BAR;
    } else {
        PG8_STAGE(PG8_SB(0, 0), cB, voffB); PG8_STAGE(PG8_SA(0, 0), cA, voffA); PG8_STAGE(PG8_SB(0, 1), cB + hstep, voffB); PG8_STAGE(PG8_SA(0, 1), cA + hstep, voffA);
        if (wr == 1) PG8_BAR;
        PG8_WAIT_V(4); PG8_BAR;
        PG8_STAGE(PG8_SB(1, 0), cB + kstep, voffB); PG8_STAGE(PG8_SA(1, 0), cA + kstep, voffA); PG8_STAGE(PG8_SB(1, 1), cB + hstep + kstep, voffB);
        PG8_WAIT_V(6); PG8_BAR;
    }
    for (;;) {
        const bool has_next = S.next(ui + 1, nxt);
        const char* nA = has_next ? (const char*)g.A + (size_t)nxt.pm * tstep : cA; const char* nB = has_next ? (const char*)g.Bt + (size_t)nxt.pn * tstep : cB;
        for (int t = 0; t < nt; t += 2) {
            if constexpr (Epi::HOOK) { if (t != 0 && (t & 3) == 0) E.hook(acc, cur, (t >> 2) - 1, wr, wc, fr, fq); }
            const bool last = (t == nt - 2);
            const char* a1 = cA + (size_t)(t + 1) * kstep;
            const char* a2 = last ? nA : cA + (size_t)(t + 2) * kstep; const char* b2 = last ? nB : cB + (size_t)(t + 2) * kstep;
            const char* a3 = a2 + kstep; const char* b3 = b2 + kstep;
            if (last && has_next) S.a_ready(nxt);
            if constexpr (SP2) {
            PG8_LDB(B0, 0, 0); PG8_LDB(B1, 0, 1); PG8_SCHED; PG8_LDA(At, 0, 0); PG8_STAGE(PG8_SA(1, 1), a1 + hstep, voffA);
            PG8_WAIT_V(8); PG8_WAIT_L(0); PG8_BAR; PG8_MMA(0, 0, At, B0); PG8_MMA(0, 1, At, B1); PG8_BAR; PG8_SCHED;
            PG8_LDA(At, 0, 1); PG8_STAGE(PG8_SB(0, 0), b2, voffB); PG8_STAGE(PG8_SB(0, 1), b2 + hstep, voffB); PG8_STAGE(PG8_SA(0, 0), a2, voffA);
            PG8_WAIT_V(8); PG8_WAIT_L(0); PG8_BAR; PG8_MMA(1, 0, At, B0); PG8_MMA(1, 1, At, B1); PG8_BAR; PG8_SCHED;
            PG8_LDB(B0, 1, 0); PG8_LDB(B1, 1, 1); PG8_SCHED; PG8_LDA(At, 1, 0); PG8_STAGE(PG8_SA(0, 1), a2 + hstep, voffA);
            PG8_WAIT_V(8); PG8_WAIT_L(0); PG8_BAR; PG8_MMA(0, 0, At, B0); PG8_MMA(0, 1, At, B1); PG8_BAR; PG8_SCHED;
            PG8_LDA(At, 1, 1); PG8_STAGE(PG8_SB(1, 0), b3, voffB); PG8_STAGE(PG8_SB(1, 1), b3 + hstep, voffB); PG8_STAGE(PG8_SA(1, 0), a3, voffA);
            PG8_WAIT_V(8); PG8_WAIT_L(0); PG8_BAR; PG8_MMA(1, 0, At, B0); PG8_MMA(1, 1, At, B1); PG8_BAR; PG8_SCHED;
            } else {
            PG8_LDB(B0, 0, 0); PG8_SCHED; PG8_LDA(At, 0, 0); PG8_STAGE(PG8_SA(1, 1), a1 + hstep, voffA);
            PG8_WAIT_L(8); PG8_BAR; PG8_WAIT_L(0); PG8_MMA(0, 0, At, B0); PG8_BAR; PG8_SCHED;
            PG8_LDB(B1, 0, 1); PG8_STAGE(PG8_SB(0, 0), b2, voffB);
            PG8_BAR; PG8_WAIT_L(0); PG8_MMA(0, 1, At, B1); PG8_BAR;
            PG8_LDA(At, 0, 1); PG8_STAGE(PG8_SA(0, 0), a2, voffA);
            PG8_BAR; PG8_WAIT_L(0); PG8_MMA(1, 0, At, B0); PG8_BAR; PG8_SCHED;
            PG8_STAGE(PG8_SB(0, 1), b2 + hstep, voffB);
            PG8_WAIT_V(6); PG8_BAR; PG8_MMA(1, 1, At, B1); PG8_BAR;
            PG8_LDB(B0, 1, 0); PG8_SCHED; PG8_LDA(At, 1, 0); PG8_STAGE(PG8_SA(0, 1), a2 + hstep, voffA);
            PG8_WAIT_L(8); PG8_BAR; PG8_WAIT_L(0); PG8_MMA(0, 0, At, B0); PG8_BAR; PG8_SCHED;
            PG8_LDB(B1, 1, 1); PG8_STAGE(PG8_SB(1, 0), b3, voffB);
            PG8_BAR; PG8_WAIT_L(0); PG8_MMA(0, 1, At, B1); PG8_BAR;
            PG8_LDA(At, 1, 1); PG8_STAGE(PG8_SA(1, 0), a3, voffA);
            PG8_BAR; PG8_WAIT_L(0); PG8_MMA(1, 0, At, B0); PG8_BAR; PG8_SCHED;
            PG8_STAGE(PG8_SB(1, 1), b3 + hstep, voffB);
            PG8_WAIT_V(6); PG8_BAR; PG8_MMA(1, 1, At, B1); PG8_BAR;
            }
        }
        if constexpr (ALIGN_EPI) { if (wr == 0) PG8_BAR; }
        if constexpr (!Epi::AFTER_DRAIN) { E(acc, cur, wr, wc, fr, fq); S.done(cur); }
        if (!has_next) break;
#pragma unroll
        for (int a = 0; a < 2; ++a)
#pragma unroll
            for (int b = 0; b < 2; ++b)
#pragma unroll
                for (int m = 0; m < 4; ++m)
#pragma unroll
                    for (int n = 0; n < 2; ++n) acc[a][b][m][n] = (f32x4){0.f, 0.f, 0.f, 0.f};
        cur = nxt; cA = nA; cB = nB; ++ui;
        if constexpr (ALIGN_EPI) { if (wr == 1) PG8_BAR; }
    }
    PG8_WAIT_V(0);
    if constexpr (!ALIGN_EPI) { if (wr == 0) PG8_BAR; }
    PG8_BAR;
    if constexpr (Epi::AFTER_DRAIN) { E.fused(acc, cur, wr, wc, fr, fq, lds, wid, lane); S.done(cur); }
#undef PG8_SA
#undef PG8_SB
#undef PG8_STAGE
#undef PG8_LDA
#undef PG8_LDB
#undef PG8_MMA
#undef PG8_WAIT_V
#undef PG8_WAIT_L
#undef PG8_BAR
#undef PG8_SCHED
}
}
namespace cg = cooperative_groups;
using pg8::bf16_t; using pg8::bf16x8; using pg8::f32x4; using pg8::u32x4; using pg8::Unit; using pg8::cvt_pk_bf16;
typedef unsigned u32x2 __attribute__((ext_vector_type(2)));
#define LAS __attribute__((address_space(3)))
#define LDS_WAIT() asm volatile("s_waitcnt lgkmcnt(0)" ::: "memory")

constexpr int M_ = 16384, DM = 1024, SEQ = 4096, DFF = 2816, DIN = 6696, NINP = 6912;
constexpr float EPSN = 1e-6f;
constexpr float LOG2E = 1.4426950408889634f, LN2 = 0.6931471805599453f;
constexpr float C2 = 0.125f * LOG2E;

constexpr size_t MiB = (size_t)1 << 20;
constexpr size_t WS_SS0 = 128 * 1024, WS_SS1 = 256 * 1024;
constexpr size_t WS_WIN = 1 * MiB;
constexpr size_t WS_WB = WS_WIN + (size_t)NINP * 1024 * 2;
constexpr size_t WS_WOUT = WS_WB + 2 * MiB;
constexpr size_t WS_WGU = WS_WOUT + 2 * MiB;
constexpr size_t WS_WD = WS_WGU + 11 * MiB;
constexpr size_t WS_WP = WS_WD + (size_t)1024 * 2816 * 2;
constexpr size_t WS_WS = WS_WP + 32768;
static_assert(WS_WS + 131072 <= 36 * MiB, "weights region");
constexpr size_t WS_XN = 36 * MiB;
constexpr size_t WS_R1 = 68 * MiB;
constexpr size_t WS_G = WS_R1, WS_KA = WS_R1 + 64 * MiB, WS_VTA = WS_KA + 8 * MiB, WS_IQ = WS_VTA + 8 * MiB;
constexpr size_t WS_S = 156 * MiB;
constexpr size_t WS_PIN = WS_S, WS_GU = WS_S + 8 * MiB, WS_GV = WS_S + 16 * MiB, WS_SQ = WS_S + 24 * MiB, WS_SK = WS_S + 32 * MiB,
                 WS_VTS = WS_S + 40 * MiB, WS_QA = WS_S + 48 * MiB, WS_MASK = WS_S + 56 * MiB, WS_IK = 220 * MiB, WS_IW = 221 * MiB, WS_OCAT = 222 * MiB  , WS_END = 254 * MiB;

__device__ __forceinline__ float bf2f(unsigned short v) { return __uint_as_float((unsigned)v << 16); }
__device__ __forceinline__ float bflo(unsigned v) { return __uint_as_float(v << 16); }
__device__ __forceinline__ float bfhi(unsigned v) { return __uint_as_float(v & 0xffff0000u); }
__device__ __forceinline__ unsigned short f2bf(float f) { return (unsigned short)(cvt_pk_bf16(f, 0.f) & 0xffffu); }
__device__ __forceinline__ float sigmoidf_(float x) { return __builtin_amdgcn_rcpf(1.f + __builtin_amdgcn_exp2f(-x * LOG2E)); }
__device__ __forceinline__ float gelu_tanh(float x) { const float u = 0.7978845608028654f * (x + 0.044715f * x * x * x); return x * __builtin_amdgcn_rcpf(1.f + __builtin_amdgcn_exp2f(-2.f * LOG2E * u)); }
__device__ __forceinline__ f32x4 mfma16(bf16x8 a, bf16x8 b, f32x4 c) { return __builtin_amdgcn_mfma_f32_16x16x32_bf16(a, b, c, 0, 0, 0); }
__device__ __forceinline__ bf16x8 mk8(unsigned a, unsigned b, unsigned c, unsigned d) { u32x4 v = {a, b, c, d}; return __builtin_bit_cast(bf16x8, v); }

struct EpiIn {
    static constexpr bool PERM = true, AFTER_DRAIN = false, HOOK = false;
    unsigned char* ws; const float *qn, *kn; const float* SS;
    __device__ __forceinline__ void operator()(const f32x4 (&acc)[2][2][4][2], const Unit& u, int wr, int wc, int fr, int fq) const {
        bf16_t* const QA = (bf16_t*)(ws + WS_QA); bf16_t* const KA = (bf16_t*)(ws + WS_KA); bf16_t* const VTA = (bf16_t*)(ws + WS_VTA); bf16_t* const IQ = (bf16_t*)(ws + WS_IQ);
        bf16_t* const PIN = (bf16_t*)(ws + WS_PIN); bf16_t* const GU = (bf16_t*)(ws + WS_GU); bf16_t* const GV = (bf16_t*)(ws + WS_GV); bf16_t* const SQ = (bf16_t*)(ws + WS_SQ);
        bf16_t* const SK = (bf16_t*)(ws + WS_SK); bf16_t* const VTS = (bf16_t*)(ws + WS_VTS); bf16_t* const IK = (bf16_t*)(ws + WS_IK); float* const IW = (float*)(ws + WS_IW); unsigned char* const G = ws + WS_G;
        const int pn = u.pn; const int row0 = u.pm * 256 + wr * 64 + fr; const int cl = wc * 32 + 8 * fq;
        float rr[2][4];
#pragma unroll
        for (int ai = 0; ai < 2; ++ai)
#pragma unroll
            for (int m = 0; m < 4; ++m) rr[ai][m] = __builtin_amdgcn_rsqf(SS[row0 + ai * 128 + m * 16] * (1.f / 1024.f) + EPSN);
        if (pn >= 11) {
            unsigned char* gp = G + (size_t)row0 * 4096 + (pn - 11) * 256 + cl;
#pragma unroll
            for (int ai = 0; ai < 2; ++ai)
#pragma unroll
                for (int m = 0; m < 4; ++m)
#pragma unroll
                    for (int bj = 0; bj < 2; ++bj) {
                        unsigned w2[2];
#pragma unroll
                        for (int n = 0; n < 2; ++n) { const f32x4 v = (acc[ai][bj][m][n] * rr[ai][m]); unsigned pk = 0;
#pragma unroll
                            for (int i = 0; i < 4; ++i) { const unsigned qv = (unsigned)(sigmoidf_(v[i]) * 255.f + 0.5f); pk |= qv << (8 * i); }
                            w2[n] = pk; }
                        *(u32x2*)(gp + (size_t)(ai * 128 + m * 16) * 4096 + bj * 128) = (u32x2){w2[0], w2[1]};
                    }
            return;
        }
        if (pn <= 1) {
            const float* gw = pn == 0 ? qn : kn; const float sc = pn == 0 ? C2 : 1.f; bf16_t* T = pn == 0 ? QA : KA;
            f32x4 gv[2][2];
#pragma unroll
            for (int bj = 0; bj < 2; ++bj)
#pragma unroll
                for (int n = 0; n < 2; ++n) gv[bj][n] = *(const f32x4*)(gw + bj * 32 + 8 * fq + 4 * n);
#pragma unroll
            for (int ai = 0; ai < 2; ++ai)
#pragma unroll
                for (int m = 0; m < 4; ++m) {
                    float ss = 0.f;
#pragma unroll
                    for (int bj = 0; bj < 2; ++bj)
#pragma unroll
                        for (int n = 0; n < 2; ++n) { const f32x4 v = (acc[ai][bj][m][n] * rr[ai][m]); ss += (v[0] * v[0] + v[1] * v[1]) + (v[2] * v[2] + v[3] * v[3]); }
                    ss += __shfl_xor(ss, 16); ss += __shfl_xor(ss, 32);
                    const float rinv = __builtin_amdgcn_rsqf(ss * (1.f / 64.f) + EPSN) * sc;
                    bf16_t* rp = T + (size_t)(row0 + ai * 128 + m * 16) * 256 + wc * 64 + 8 * fq;
#pragma unroll
                    for (int bj = 0; bj < 2; ++bj) { const f32x4 v0 = (acc[ai][bj][m][0] * rr[ai][m]) * gv[bj][0] * rinv, v1 = (acc[ai][bj][m][1] * rr[ai][m]) * gv[bj][1] * rinv;
                        u32x4 w; w.x = cvt_pk_bf16(v0[0], v0[1]); w.y = cvt_pk_bf16(v0[2], v0[3]); w.z = cvt_pk_bf16(v1[0], v1[1]); w.w = cvt_pk_bf16(v1[2], v1[3]);
                        *(u32x4*)(rp + bj * 32) = w; }
                }
            return;
        }
        if (pn == 2 || pn == 9) {
            bf16_t* T = pn == 2 ? VTA : VTS;
#pragma unroll
            for (int ai = 0; ai < 2; ++ai)
#pragma unroll
                for (int m = 0; m < 4; ++m) { const int row = row0 + ai * 128 + m * 16; const int b = row >> 12, t = row & 4095;
#pragma unroll
                    for (int bj = 0; bj < 2; ++bj)
#pragma unroll
                        for (int n = 0; n < 2; ++n) { const f32x4 v = (acc[ai][bj][m][n] * rr[ai][m]);
#pragma unroll
                            for (int i = 0; i < 4; ++i) T[((size_t)b * 256 + bj * 128 + cl + 4 * n + i) * 4096 + t] = f2bf(v[i]); }
                }
            return;
        }
        if (pn == 10) {
            if (wc == 0) {
#pragma unroll
                for (int ai = 0; ai < 2; ++ai)
#pragma unroll
                    for (int m = 0; m < 4; ++m) { const f32x4 v0 = (acc[ai][0][m][0] * rr[ai][m]), v1 = (acc[ai][0][m][1] * rr[ai][m]);
                        u32x4 w; w.x = cvt_pk_bf16(v0[0], v0[1]); w.y = cvt_pk_bf16(v0[2], v0[3]); w.z = cvt_pk_bf16(v1[0], v1[1]); w.w = cvt_pk_bf16(v1[2], v1[3]);
                        *(u32x4*)(IK + (size_t)(row0 + ai * 128 + m * 16) * 32 + 8 * fq) = w; }
            } else if (wc == 1 && fq == 0) {
#pragma unroll
                for (int ai = 0; ai < 2; ++ai)
#pragma unroll
                    for (int m = 0; m < 4; ++m) { float* p = IW + (size_t)(row0 + ai * 128 + m * 16) * 8; *(f32x4*)p = (acc[ai][0][m][0] * rr[ai][m]); *(f32x4*)(p + 4) = (acc[ai][0][m][1] * rr[ai][m]); }
            }
            return;
        }
        {
            bf16_t* T = pn == 3 ? IQ : pn == 4 ? PIN : pn == 5 ? GU : pn == 6 ? GV : pn == 7 ? SQ : SK;
            const bool act = (pn == 5 || pn == 6); const float sc = pn == 7 ? 0.125f : 1.f;
#pragma unroll
            for (int ai = 0; ai < 2; ++ai)
#pragma unroll
                for (int m = 0; m < 4; ++m) { bf16_t* rp = T + (size_t)(row0 + ai * 128 + m * 16) * 256 + cl;
#pragma unroll
                    for (int bj = 0; bj < 2; ++bj) { f32x4 v0 = (acc[ai][bj][m][0] * rr[ai][m]) * sc, v1 = (acc[ai][bj][m][1] * rr[ai][m]) * sc;
                        if (act) {
#pragma unroll
                            for (int i = 0; i < 4; ++i) { v0[i] = gelu_tanh(v0[i]); v1[i] = gelu_tanh(v1[i]); } }
                        u32x4 w; w.x = cvt_pk_bf16(v0[0], v0[1]); w.y = cvt_pk_bf16(v0[2], v0[3]); w.z = cvt_pk_bf16(v1[0], v1[1]); w.w = cvt_pk_bf16(v1[2], v1[3]);
                        *(u32x4*)(rp + bj * 128) = w; }
                }
        }
    }
};

struct EpiMerge {
    static constexpr bool PERM = true, AFTER_DRAIN = false, HOOK = true;
    const unsigned char* G; bf16_t* MG;
    __device__ __forceinline__ void hook(f32x4 (&acc)[2][2][4][2], const Unit& u, int s, int wr, int wc, int fr, int fq) const {
        const int row0 = u.pm * 256 + wr * 64 + fr; const int col0 = u.pn * 256 + wc * 32 + 8 * fq;
        const unsigned char* gp0 = G + (size_t)row0 * 4096 + s * 1024 + col0;
#pragma unroll
        for (int ai = 0; ai < 2; ++ai)
#pragma unroll
            for (int m = 0; m < 4; ++m) {
#pragma unroll
                for (int bj = 0; bj < 2; ++bj) { const unsigned char* gp = gp0 + (size_t)(ai * 128 + m * 16) * 4096 + bj * 128;
                    const u32x2 ga = *(const u32x2*)gp, gb = *(const u32x2*)(gp + 1024);
#pragma unroll
                    for (int i = 0; i < 4; ++i) {
                        const float a0 = fmaxf((float)((ga.x >> (8 * i)) & 255u), 1.f), b0 = fmaxf((float)((gb.x >> (8 * i)) & 255u), 1.f);
                        const float a1 = fmaxf((float)((ga.y >> (8 * i)) & 255u), 1.f), b1 = fmaxf((float)((gb.y >> (8 * i)) & 255u), 1.f);
                        acc[ai][bj][m][0][i] *= a0 * __builtin_amdgcn_rcpf(b0); acc[ai][bj][m][1][i] *= a1 * __builtin_amdgcn_rcpf(b1); }
                }
                asm volatile("" ::: "memory"); }
    }
    __device__ __forceinline__ void operator()(const f32x4 (&acc)[2][2][4][2], const Unit& u, int wr, int wc, int fr, int fq) const {
        const int row0 = u.pm * 256 + wr * 64 + fr; const int col0 = u.pn * 256 + wc * 32 + 8 * fq;
        const unsigned char* gp0 = G + (size_t)row0 * 4096 + 3 * 1024 + col0; bf16_t* mp0 = MG + (size_t)row0 * 1024 + col0;
#pragma unroll
        for (int ai = 0; ai < 2; ++ai)
#pragma unroll
            for (int m = 0; m < 4; ++m) {
#pragma unroll
                for (int bj = 0; bj < 2; ++bj) { const size_t ro = (size_t)(ai * 128 + m * 16);
                    const u32x2 gb = *(const u32x2*)(gp0 + ro * 4096 + bj * 128);
                    f32x4 v0 = acc[ai][bj][m][0], v1 = acc[ai][bj][m][1];
#pragma unroll
                    for (int i = 0; i < 4; ++i) { v0[i] *= fmaxf((float)((gb.x >> (8 * i)) & 255u), 1.f) * (1.f / 255.f); v1[i] *= fmaxf((float)((gb.y >> (8 * i)) & 255u), 1.f) * (1.f / 255.f); }
                    u32x4 w; w.x = cvt_pk_bf16(v0[0], v0[1]); w.y = cvt_pk_bf16(v0[2], v0[3]); w.z = cvt_pk_bf16(v1[0], v1[1]); w.w = cvt_pk_bf16(v1[2], v1[3]);
                    *(u32x4*)(mp0 + ro * 1024 + bj * 128) = w; }
                asm volatile("" ::: "memory"); }
    }
};

struct EpiResid {
    static constexpr bool PERM = true, AFTER_DRAIN = false, HOOK = false;
    const float* base; float* out; bf16_t* XB; float* SS; int stat;
    __device__ __forceinline__ void operator()(const f32x4 (&acc)[2][2][4][2], const Unit& u, int wr, int wc, int fr, int fq) const {
        const int row0 = u.pm * 256 + wr * 64 + fr; const int col0 = u.pn * 256 + wc * 32 + 8 * fq;
#pragma unroll
        for (int ai = 0; ai < 2; ++ai)
#pragma unroll
            for (int m = 0; m < 4; ++m) { const int row = row0 + ai * 128 + m * 16; const size_t off = (size_t)row * 1024 + col0; float ssum = 0.f;
#pragma unroll
                for (int bj = 0; bj < 2; ++bj) { const f32x4 b0 = *(const f32x4*)(base + off + bj * 128), b1 = *(const f32x4*)(base + off + bj * 128 + 4);
                    const f32x4 o0 = b0 + acc[ai][bj][m][0], o1 = b1 + acc[ai][bj][m][1];
                    *(f32x4*)(out + off + bj * 128) = o0; *(f32x4*)(out + off + bj * 128 + 4) = o1;
                    if (stat) { u32x4 w; w.x = cvt_pk_bf16(o0[0], o0[1]); w.y = cvt_pk_bf16(o0[2], o0[3]); w.z = cvt_pk_bf16(o1[0], o1[1]); w.w = cvt_pk_bf16(o1[2], o1[3]);
                        *(u32x4*)(XB + off + bj * 128) = w;
                        ssum += ((o0[0] * o0[0] + o0[1] * o0[1]) + (o0[2] * o0[2] + o0[3] * o0[3])) + ((o1[0] * o1[0] + o1[1] * o1[1]) + (o1[2] * o1[2] + o1[3] * o1[3])); } }
                if (stat) { ssum += __shfl_xor(ssum, 16); ssum += __shfl_xor(ssum, 32); if (fq == 0) atomicAdd(SS + row, ssum); }
                asm volatile("" ::: "memory"); }
    }
};

struct EpiSwiGLU {
    static constexpr bool PERM = true, AFTER_DRAIN = false, HOOK = false;
    bf16_t* ACT; const float* SS;
    __device__ __forceinline__ void operator()(const f32x4 (&acc)[2][2][4][2], const Unit& u, int wr, int wc, int fr, int fq) const {
        const int row0 = u.pm * 256 + wr * 64 + fr; const int f0 = u.pn * 128 + wc * 32 + 8 * fq;
#pragma unroll
        for (int ai = 0; ai < 2; ++ai)
#pragma unroll
            for (int m = 0; m < 4; ++m) { f32x4 r[2]; const float rs = __builtin_amdgcn_rsqf(SS[row0 + ai * 128 + m * 16] * (1.f / 1024.f) + EPSN);
#pragma unroll
                for (int n = 0; n < 2; ++n) { const f32x4 g = acc[ai][0][m][n] * rs, up = acc[ai][1][m][n] * rs;
#pragma unroll
                    for (int i = 0; i < 4; ++i) r[n][i] = g[i] * sigmoidf_(g[i]) * up[i]; }
                u32x4 w; w.x = cvt_pk_bf16(r[0][0], r[0][1]); w.y = cvt_pk_bf16(r[0][2], r[0][3]); w.z = cvt_pk_bf16(r[1][0], r[1][1]); w.w = cvt_pk_bf16(r[1][2], r[1][3]);
                *(u32x4*)(ACT + (size_t)(row0 + ai * 128 + m * 16) * DFF + f0) = w; }
    }
};

__device__ __forceinline__ void cvt_item(const float* src, int ld, int col0, int nvalid, int K, bf16_t* WT, int dst_row0, int kb, LAS float* scr, int lane, const float* rs = nullptr) {
    const int k0 = 64 * kb, c = lane & 31;
#pragma unroll 8
    for (int i = 0; i < 32; ++i) { const int kk = 2 * i + (lane >> 5); float v = 0.f; if (c < nvalid) v = src[(size_t)(k0 + kk) * ld + col0 + c]; if (rs) v *= rs[k0 + kk]; scr[kk * 33 + c] = v; }
    LDS_WAIT();
    const int c8 = lane & 7;
#pragma unroll
    for (int j = 0; j < 4; ++j) { const int n = (lane >> 3) + 8 * j; const LAS float* s = scr + (8 * c8) * 33 + n;
        u32x4 o; o.x = cvt_pk_bf16(s[0 * 33], s[1 * 33]); o.y = cvt_pk_bf16(s[2 * 33], s[3 * 33]); o.z = cvt_pk_bf16(s[4 * 33], s[5 * 33]); o.w = cvt_pk_bf16(s[6 * 33], s[7 * 33]);
        *(u32x4*)(WT + (size_t)(dst_row0 + n) * K + k0 + 8 * c8) = o; }
    LDS_WAIT();
}
__device__ __forceinline__ float wave_sum(float v) {
#pragma unroll
    for (int o = 1; o < 64; o <<= 1) v += __shfl_xor(v, o);
    return v;
}
__device__ __forceinline__ float wave_max(float v) {
#pragma unroll
    for (int o = 1; o < 64; o <<= 1) v = fmaxf(v, __shfl_xor(v, o));
    return v;
}
__device__ __forceinline__ void rmsnorm_rows(const float* xs, const float* gamma, bf16_t* XN, int gw, int ngw, int lane) {
    f32x4 gm[4];
#pragma unroll
    for (int j = 0; j < 4; ++j) gm[j] = *(const f32x4*)(gamma + 4 * lane + 256 * j);
    for (int m = gw; m < M_; m += ngw) {
        const f32x4* xr = (const f32x4*)(xs + (size_t)m * DM) + lane; f32x4 v[4]; float s = 0.f;
#pragma unroll
        for (int j = 0; j < 4; ++j) { v[j] = xr[64 * j]; s += (v[j].x * v[j].x + v[j].y * v[j].y) + (v[j].z * v[j].z + v[j].w * v[j].w); }
        const float r = __builtin_amdgcn_rsqf(wave_sum(s) * (1.f / DM) + EPSN);
        u32x2* o8 = (u32x2*)(XN + (size_t)m * DM) + lane;
#pragma unroll
        for (int j = 0; j < 4; ++j) { const f32x4 y = v[j] * r * gm[j]; o8[64 * j] = (u32x2){cvt_pk_bf16(y.x, y.y), cvt_pk_bf16(y.z, y.w)}; }
    }
}

__device__ __forceinline__ void x_to_bf16_ss(const float* xs, bf16_t* XN, float* SS, int gw, int ngw, int lane) {
    for (int m = gw; m < M_; m += ngw) {
        const f32x4* xr = (const f32x4*)(xs + (size_t)m * DM) + lane; f32x4 v[4]; float s = 0.f;
#pragma unroll
        for (int j = 0; j < 4; ++j) { v[j] = xr[64 * j]; s += (v[j].x * v[j].x + v[j].y * v[j].y) + (v[j].z * v[j].z + v[j].w * v[j].w); }
        s = wave_sum(s);
        u32x2* o8 = (u32x2*)(XN + (size_t)m * DM) + lane;
#pragma unroll
        for (int j = 0; j < 4; ++j) o8[64 * j] = (u32x2){cvt_pk_bf16(v[j].x, v[j].y), cvt_pk_bf16(v[j].z, v[j].w)};
        if (lane == 0) SS[m] = s;
    }
}
struct Ptrs {
    const float *mix_g, *ffn_g, *w_in, *qn, *kn, *pool_w, *pool_scale, *gm_norm, *gm_ws, *gm_b, *w_branch, *w_out, *w_gate, *w_up, *w_down;
};

__device__ __forceinline__ void convert_weights(const Ptrs& P, unsigned char* ws, LAS float* scr, int gw, int ngw, int lane, int gtid, int ngt) {
    bf16_t* WinT = (bf16_t*)(ws + WS_WIN); bf16_t* WbT = (bf16_t*)(ws + WS_WB); bf16_t* WoutT = (bf16_t*)(ws + WS_WOUT); bf16_t* WguT = (bf16_t*)(ws + WS_WGU);
    bf16_t* WdT = (bf16_t*)(ws + WS_WD); bf16_t* WpT = (bf16_t*)(ws + WS_WP); bf16_t* Wtril = (bf16_t*)(ws + WS_WS);
    constexpr int I_A = 216 * 16, I_B = 512, I_C = 512, I_D = 176 * 16, I_E = 32 * 44, I_F = 8, NIT = I_A + I_B + I_C + I_D + I_E + I_F;
    for (int it = gw; it < NIT; it += ngw) {
        int r = it;
        if (r < I_A) { const int rb = r >> 4, kb = r & 15, tile = rb >> 3, sub = rb & 7; int col0, nv = 32;
            if (tile <= 1) col0 = tile * 256 + (sub & 3) * 64 + (sub >> 2) * 32;
            else if (tile == 2) col0 = 512 + sub * 32;
            else if (tile == 3) col0 = 768 + sub * 32;
            else if (tile <= 9) col0 = 1064 + (tile - 4) * 256 + sub * 32;
            else if (tile == 10) { col0 = sub == 0 ? 1024 : 1056; nv = sub == 0 ? 32 : (sub == 1 ? 8 : 0); }
            else col0 = 2600 + (tile - 11) * 256 + sub * 32;
            cvt_item(P.w_in, DIN, col0, nv, 1024, WinT, rb * 32, kb, scr, lane, P.mix_g); continue; }
        r -= I_A;
        if (r < I_B) { const int rb = r >> 4, kb = r & 15; cvt_item(P.w_branch, 1024, rb * 32, 32, 1024, WbT, rb * 32, kb, scr, lane); continue; }
        r -= I_B;
        if (r < I_C) { const int rb = r >> 4, kb = r & 15; cvt_item(P.w_out, 1024, rb * 32, 32, 1024, WoutT, rb * 32, kb, scr, lane); continue; }
        r -= I_C;
        if (r < I_D) { const int rb = r >> 4, kb = r & 15, tile = rb >> 3, sub = rb & 7;
            cvt_item((sub >> 2) ? P.w_up : P.w_gate, DFF, tile * 128 + (sub & 3) * 32, 32, 1024, WguT, rb * 32, kb, scr, lane, P.ffn_g); continue; }
        r -= I_D;
        if (r < I_E) { const int rb = r / 44, kb = r % 44; cvt_item(P.w_down, 1024, rb * 32, 32, DFF, WdT, rb * 32, kb, scr, lane); continue; }
        r -= I_E;
        { const int gp = r >> 1, rb = r & 1; cvt_item(P.pool_w + gp * 4096, 64, rb * 32, 32, 64, WpT + gp * 4096, rb * 32, 0, scr, lane); }
    }
    for (int e = gtid; e < 4 * 128 * 128; e += ngt) { const int s = e & 127, t = (e >> 7) & 127; Wtril[e] = (s <= t) ? f2bf(P.gm_ws[e]) : (unsigned short)0; }
}

__device__ __forceinline__ unsigned mono_key(float s) { const unsigned b = __float_as_uint(s); return b ^ ((unsigned)((int)b >> 31) | 0x80000000u); }

#define wr_lane(dst, sval, ln) asm volatile("s_nop 4\n\tv_writelane_b32 %0, %1, %2\n\ts_nop 1" : "+v"(dst) : "s"(sval), "n"(ln))
template <int NBLK> __device__ __forceinline__ unsigned a1_bisect(const unsigned (&v)[64], int& cpre) {
    unsigned prefix = 0u; cpre = 0;
#pragma unroll 1
    for (int bit = 31; bit >= 0; --bit) {
        const unsigned cand = prefix | (1u << bit);
        int cnt = 0;
#pragma unroll
        for (int blk = 0; blk < NBLK; ++blk) {
            unsigned long long bl[8];
#pragma unroll
            for (int k = 0; k < 8; ++k) bl[k] = __ballot(v[blk * 8 + k] >= cand);
            __builtin_amdgcn_sched_barrier(0);
#pragma unroll
            for (int k = 0; k < 8; ++k) cnt += __builtin_popcountll(bl[k]);
            __builtin_amdgcn_sched_barrier(0);
        }
        if (cnt >= 256) { prefix = cand; cpre = cnt; if (cnt == 256) break; }
    }
    return prefix;
}
constexpr int A1_ROWF = 4100;
__device__ __forceinline__ void phase_a1(unsigned char* lds, const bf16_t* IQ, const bf16_t* IK, const float* IW, unsigned short* MASK, int tid, int bid, int G) {
    const int lane = tid & 63, w = __builtin_amdgcn_readfirstlane(tid >> 6), q = lane & 15, g = lane >> 4;
    unsigned* keys = (unsigned*)lds;
#ifndef REP_A1X
#define REP_A1X 1
#endif
    for (int L2 = bid; L2 < 1024 * REP_A1X; L2 += G) {
        const int L = L2 & 1023;
        const int b = L >> 8, c = L & 255, qg = (b & 1) ? 255 - c : c;
        const int row0 = b * SEQ + qg * 16;
        const int nreg = (qg >> 2) + 1;
        if (qg <= 15) {
#pragma unroll
            for (int half = 0; half < 2; ++half) { const int qq = half * 8 + w; const int t = qg * 16 + qq; unsigned mlo = 0u, mhi = 0u;
#pragma unroll
                for (int r = 0; r < 4; ++r) { const unsigned long long bal = __ballot(64 * r + lane <= t);
                    wr_lane(mlo, (unsigned)bal, r); wr_lane(mhi, (unsigned)(bal >> 32), r); }
                if (lane < nreg) *(u32x2*)(MASK + (size_t)(row0 + qq) * 256 + 4 * lane) = (u32x2){mlo, mhi}; }
            continue;
        }
        unsigned u[128];
        {
            bf16x8 iqf[8]; float wv[8];
#pragma unroll
            for (int h = 0; h < 8; ++h) iqf[h] = *(const bf16x8*)(IQ + (size_t)(row0 + q) * 256 + h * 32 + 8 * g);
            { const f32x4 a = *(const f32x4*)(IW + (size_t)(row0 + q) * 8), bq = *(const f32x4*)(IW + (size_t)(row0 + q) * 8 + 4);
              wv[0] = a[0]; wv[1] = a[1]; wv[2] = a[2]; wv[3] = a[3]; wv[4] = bq[0]; wv[5] = bq[1]; wv[6] = bq[2]; wv[7] = bq[3]; }
#pragma unroll
            for (int blk = 0; blk < 4; ++blk) {
                if (64 * blk + w <= qg) {
                    bf16x8 kf[8];
#pragma unroll
                    for (int ii = 0; ii < 8; ++ii) { const int kt = 8 * (8 * blk + ii) + w; kf[ii] = *(const bf16x8*)(IK + (size_t)(b * SEQ + kt * 16 + q) * 32 + 8 * g); }
#pragma unroll
                    for (int ii = 0; ii < 8; ++ii) { const int i = 8 * blk + ii; const int kt = 8 * i + w;
                        f32x4 s = {0.f, 0.f, 0.f, 0.f};
#pragma unroll
                        for (int h = 0; h < 8; ++h) { const f32x4 a = mfma16(kf[ii], iqf[h], (f32x4){0.f, 0.f, 0.f, 0.f});
#pragma unroll
                            for (int j = 0; j < 4; ++j) s[j] = __builtin_fmaf(wv[h], fmaxf(a[j], 0.f), s[j]); }
#pragma unroll
                        for (int j = 0; j < 4; ++j) { unsigned uu = mono_key(s[j]); if (kt > qg || (kt == qg && (4 * g + j) > q)) uu = 0u; u[4 * i + j] = uu; }
                    }
                } else {
#pragma unroll
                    for (int r = 0; r < 32; ++r) u[32 * blk + r] = 0u;
                }
            }
        }
#pragma unroll 1
        for (int half = 0; half < 2; ++half) {
            if ((q >> 3) == half) {
                unsigned* krow = keys + (q & 7) * A1_ROWF + 4 * g;
#pragma unroll
                for (int i = 0; i < 32; ++i) { const int kt = 8 * i + w; *(u32x4*)(krow + kt * 16) = (u32x4){u[4 * i], u[4 * i + 1], u[4 * i + 2], u[4 * i + 3]}; }
            }
            __syncthreads();
            {
                const int qq = half * 8 + w; const unsigned* krow = keys + w * A1_ROWF + lane;
                unsigned v[64];
#pragma unroll
                for (int blk = 0; blk < 8; ++blk) {
                    if (nreg > blk * 8) {
#pragma unroll
                        for (int r = blk * 8; r < blk * 8 + 8; ++r) v[r] = krow[64 * r];
                    } else {
#pragma unroll
                        for (int r = blk * 8; r < blk * 8 + 8; ++r) v[r] = 0u;
                    }
                }
#ifndef REP_BIS
#define REP_BIS 1
#endif
                unsigned prefix; int cpre = 0;
#pragma unroll 1
                for (int rb_ = 0; rb_ < REP_BIS; ++rb_)
                switch ((nreg + 7) >> 3) {
                    case 1: prefix = a1_bisect<1>(v, cpre); break; case 2: prefix = a1_bisect<2>(v, cpre); break; case 3: prefix = a1_bisect<3>(v, cpre); break; case 4: prefix = a1_bisect<4>(v, cpre); break;
                    case 5: prefix = a1_bisect<5>(v, cpre); break; case 6: prefix = a1_bisect<6>(v, cpre); break; case 7: prefix = a1_bisect<7>(v, cpre); break; default: prefix = a1_bisect<8>(v, cpre); break;
                }
                const unsigned thr = prefix > 1u ? prefix : 1u;
                unsigned mlo = 0u, mhi = 0u;
                if (cpre == 256) {
#pragma unroll
                    for (int r = 0; r < 64; ++r) { const unsigned long long bal = __ballot(v[r] >= thr); wr_lane(mlo, (unsigned)bal, r); wr_lane(mhi, (unsigned)(bal >> 32), r); }
                } else {
                    int rem = 256;
#pragma unroll
                    for (int r = 0; r < 64; ++r) rem -= __builtin_popcountll(__ballot(v[r] > thr));
#pragma unroll
                    for (int r = 0; r < 64; ++r) { unsigned long long bal = __ballot(v[r] > thr); unsigned long long eq = __ballot(v[r] == thr);
                        const int ne = __builtin_popcountll(eq);
                        if (ne <= rem) { bal |= eq; rem -= ne; }
                        else { while (rem > 0) { const unsigned long long low = eq & (0ull - eq); bal |= low; eq ^= low; --rem; } }
                        wr_lane(mlo, (unsigned)bal, r); wr_lane(mhi, (unsigned)(bal >> 32), r); }
                }
                if (lane < nreg) *(u32x2*)(MASK + (size_t)(row0 + qq) * 256 + 4 * lane) = (u32x2){mlo, mhi};
            }
            __syncthreads();
        }
    }
}

__device__ __forceinline__ void phase_a2(unsigned char* lds, const bf16_t* QA, bf16_t* OA, const bf16_t* KA, const bf16_t* VTA, const unsigned short* MASK,
                                         const float* qn, const float* kn, int tid, int bid, int G) {
    const int lane = tid & 63, w = __builtin_amdgcn_readfirstlane(tid >> 6), q = lane & 15, g = lane >> 4;
    bf16_t* Kt = (bf16_t*)lds;
    bf16_t* Vt = (bf16_t*)(lds + 2 * 64 * 72 * 2);
    const float msh = LOG2E * 8.f * wave_max(fabsf(qn[lane])) * wave_max(fabsf(kn[lane])) * 1.02f + 0.25f;
    const int srow = tid >> 3, sch = tid & 7;
    for (int L = bid; L < 512; L += G) {
        const int jj = L >> 8, c = L & 255, bh = c >> 4, qb = jj ? 31 - (c & 15) : (c & 15);
        const int b = bh >> 2, h = bh & 3;
        const int qgw = qb * 8 + w;
        const int row0 = b * SEQ + qb * 128 + 16 * w;
        bf16x8 qf[2];
#pragma unroll
        for (int hf = 0; hf < 2; ++hf) qf[hf] = *(const bf16x8*)(QA + (size_t)(row0 + q) * 256 + h * 64 + hf * 32 + 8 * g);
        const unsigned short* mrow = MASK + (size_t)(row0 + q) * 256;
        const int nsteps = 2 * qb + 2;
        const bf16_t* ksrc = KA + (size_t)(b * SEQ + srow) * 256 + h * 64 + sch * 8;
        const bf16_t* vsrc = VTA + (size_t)(b * 256 + h * 64 + srow) * SEQ + sch * 8;
        u32x4 kreg = *(const u32x4*)ksrc, vreg = *(const u32x4*)vsrc;
        *(u32x4*)(Kt + srow * 72 + sch * 8) = kreg; *(u32x4*)(Vt + srow * 72 + sch * 8) = vreg;
        u32x2 mcur = *(const u32x2*)mrow, mnext = mcur;
        f32x4 o[4]; float lsum = 0.f; const f32x4 negm = {-msh, -msh, -msh, -msh};
#pragma unroll
        for (int d = 0; d < 4; ++d) o[d] = (f32x4){0.f, 0.f, 0.f, 0.f};
        __syncthreads();
        for (int st = 0; st < nsteps; ++st) {
            const int buf = st & 1; const bool more = st + 1 < nsteps;
            if (more) { kreg = *(const u32x4*)(ksrc + (size_t)(st + 1) * 64 * 256); vreg = *(const u32x4*)(vsrc + (st + 1) * 64); mnext = *(const u32x2*)(mrow + (st + 1) * 4); }
            const bf16_t* kb_ = Kt + buf * 64 * 72; const bf16_t* vb_ = Vt + buf * 64 * 72;
#pragma unroll
            for (int p = 0; p < 2; ++p) {
                const int kt0 = st * 4 + 2 * p;
                if (kt0 <= qgw) {
                    const unsigned mw = p ? mcur.y : mcur.x;
                    const unsigned nib0 = (mw >> (4 * g)) & 15u, nib1 = (kt0 + 1 <= qgw) ? ((mw >> (16 + 4 * g)) & 15u) : 0u;
                    const bf16_t* kr0 = kb_ + (p * 32 + q) * 72 + 8 * g; const bf16_t* kr1 = kr0 + 16 * 72;
                    f32x4 a0 = mfma16(*(const bf16x8*)kr0, qf[0], negm); a0 = mfma16(*(const bf16x8*)(kr0 + 32), qf[1], a0);
                    f32x4 a1 = mfma16(*(const bf16x8*)kr1, qf[0], negm); a1 = mfma16(*(const bf16x8*)(kr1 + 32), qf[1], a1);
                    float p0[4], p1[4];
#pragma unroll
                    for (int j = 0; j < 4; ++j) { p0[j] = ((nib0 >> j) & 1u) ? __builtin_amdgcn_exp2f(a0[j]) : 0.f; p1[j] = ((nib1 >> j) & 1u) ? __builtin_amdgcn_exp2f(a1[j]) : 0.f; }
                    lsum += ((p0[0] + p0[1]) + (p0[2] + p0[3])) + ((p1[0] + p1[1]) + (p1[2] + p1[3]));
                    const bf16x8 pf = mk8(cvt_pk_bf16(p0[0], p0[1]), cvt_pk_bf16(p0[2], p0[3]), cvt_pk_bf16(p1[0], p1[1]), cvt_pk_bf16(p1[2], p1[3]));
#pragma unroll
                    for (int d = 0; d < 4; ++d) { const bf16_t* vr = vb_ + (d * 16 + q) * 72 + p * 32 + 4 * g;
                        const u32x2 lo = *(const u32x2*)vr, hi = *(const u32x2*)(vr + 16);
                        o[d] = mfma16(mk8(lo.x, lo.y, hi.x, hi.y), pf, o[d]); }
                }
            }
            if (more) { *(u32x4*)(Kt + (buf ^ 1) * 64 * 72 + srow * 72 + sch * 8) = kreg; *(u32x4*)(Vt + (buf ^ 1) * 64 * 72 + srow * 72 + sch * 8) = vreg; }
            __syncthreads();
            mcur = mnext;
        }
        lsum += __shfl_xor(lsum, 16); lsum += __shfl_xor(lsum, 32);
        const float inv = 1.f / lsum;
#pragma unroll
        for (int d = 0; d < 4; ++d) { const f32x4 v = o[d] * inv;
            *(u32x2*)(OA + (size_t)(row0 + q) * 1024 + h * 64 + d * 16 + 4 * g) = (u32x2){cvt_pk_bf16(v[0], v[1]), cvt_pk_bf16(v[2], v[3])}; }
    }
}

__device__ __forceinline__ void phase_b(const bf16_t* PIN, const bf16_t* WpT, const float* pscale, bf16_t* OB, int gw, int ngw, int lane) {
    const int q = lane & 15, g4 = lane >> 4;
    for (int L = gw; L < 4096; L += ngw) {
        const int gp = L >> 10, tg = L & 1023; const int row = tg * 16 + q; const int t = row & (SEQ - 1);
        const int win = 2 << gp; const int cnt = (t + 1 < win) ? t + 1 : win; const float inv = 1.f / (float)cnt;
        f32x4 acc[4];
#pragma unroll
        for (int d = 0; d < 4; ++d) acc[d] = (f32x4){0.f, 0.f, 0.f, 0.f};
#pragma unroll
        for (int ch = 0; ch < 2; ++ch) {
            const bf16_t* p = PIN + (size_t)row * 256 + gp * 64 + ch * 32 + 8 * g4;
            u32x4 wv[16];
#pragma unroll
            for (int i = 0; i < 16; ++i) { wv[i] = (u32x4){0u, 0u, 0u, 0u}; if (i < win && i <= t) wv[i] = *(const u32x4*)(p - (size_t)i * 256); }
            float own[8], sum[8];
            own[0] = bflo(wv[0].x); own[1] = bfhi(wv[0].x); own[2] = bflo(wv[0].y); own[3] = bfhi(wv[0].y); own[4] = bflo(wv[0].z); own[5] = bfhi(wv[0].z); own[6] = bflo(wv[0].w); own[7] = bfhi(wv[0].w);
#pragma unroll
            for (int k = 0; k < 8; ++k) sum[k] = own[k];
#pragma unroll
            for (int i = 1; i < 16; ++i) { const u32x4 v = wv[i];
                sum[0] += bflo(v.x); sum[1] += bfhi(v.x); sum[2] += bflo(v.y); sum[3] += bfhi(v.y); sum[4] += bflo(v.z); sum[5] += bfhi(v.z); sum[6] += bflo(v.w); sum[7] += bfhi(v.w); }
            float pl[8];
#pragma unroll
            for (int k = 0; k < 8; ++k) pl[k] = sum[k] * inv - own[k];
            const bf16x8 bfr = mk8(cvt_pk_bf16(pl[0], pl[1]), cvt_pk_bf16(pl[2], pl[3]), cvt_pk_bf16(pl[4], pl[5]), cvt_pk_bf16(pl[6], pl[7]));
#pragma unroll
            for (int d = 0; d < 4; ++d) { const bf16x8 afr = *(const bf16x8*)(WpT + gp * 4096 + (d * 16 + q) * 64 + ch * 32 + 8 * g4); acc[d] = mfma16(afr, bfr, acc[d]); }
        }
#pragma unroll
        for (int d = 0; d < 4; ++d) { const int d0 = d * 16 + 4 * g4; const f32x4 sc = *(const f32x4*)(pscale + gp * 64 + d0); const f32x4 v = acc[d] * sc;
            *(u32x2*)(OB + (size_t)row * 1024 + gp * 64 + d0) = (u32x2){cvt_pk_bf16(v[0], v[1]), cvt_pk_bf16(v[2], v[3])}; }
    }
}

__device__ __forceinline__ void phase_c(unsigned char* lds, const bf16_t* GV, const bf16_t* GU, bf16_t* OC, const float* gamma, const bf16_t* Wtril, const float* gbias, int tid, int bid, int G) {
    bf16_t* LT = (bf16_t*)lds;
    const int lane = tid & 63, w = __builtin_amdgcn_readfirstlane(tid >> 6), q = lane & 15, g4 = lane >> 4;
    for (int L = bid; L < 512; L += G) {
        const int gp = L & 3, chk = L >> 2; const int R0 = chk * 128;
        {
            const int row = tid >> 2, part = tid & 3;
            const bf16_t* src = GV + (size_t)(R0 + row) * 256 + part * 64;
            float x[64];
#pragma unroll
            for (int k8 = 0; k8 < 8; ++k8) { const u32x4 v = *(const u32x4*)(src + 8 * k8);
                x[8 * k8 + 0] = bflo(v.x); x[8 * k8 + 1] = bfhi(v.x); x[8 * k8 + 2] = bflo(v.y); x[8 * k8 + 3] = bfhi(v.y); x[8 * k8 + 4] = bflo(v.z); x[8 * k8 + 5] = bfhi(v.z); x[8 * k8 + 6] = bflo(v.w); x[8 * k8 + 7] = bfhi(v.w); }
            float s = 0.f;
#pragma unroll
            for (int k = 0; k < 64; ++k) s += x[k];
            s += __shfl_xor(s, 1); s += __shfl_xor(s, 2);
            const float mean = s * (1.f / 256.f); float ss = 0.f;
#pragma unroll
            for (int k = 0; k < 64; ++k) { const float dd = x[k] - mean; ss += dd * dd; }
            ss += __shfl_xor(ss, 1); ss += __shfl_xor(ss, 2);
            const float rstd = __builtin_amdgcn_rsqf(ss * (1.f / 256.f) + EPSN);
            if (part == gp) {
#pragma unroll
                for (int k4 = 0; k4 < 16; ++k4) { const f32x4 gm = *(const f32x4*)(gamma + gp * 64 + 4 * k4);
#pragma unroll
                    for (int i = 0; i < 4; ++i) LT[(4 * k4 + i) * 136 + row] = f2bf((x[4 * k4 + i] - mean) * rstd * gm[i]); }
            }
        }
        __syncthreads();
        {
            f32x4 acc[4];
#pragma unroll
            for (int d = 0; d < 4; ++d) acc[d] = (f32x4){0.f, 0.f, 0.f, 0.f};
            const int t = 16 * w + q; const int nsb = ((16 * w + 15) >> 5) + 1;
            for (int sb = 0; sb < nsb; ++sb) {
                const bf16x8 bfr = *(const bf16x8*)(Wtril + ((size_t)gp * 128 + t) * 128 + sb * 32 + 8 * g4);
#pragma unroll
                for (int d = 0; d < 4; ++d) { const bf16x8 afr = *(const bf16x8*)(LT + (d * 16 + q) * 136 + sb * 32 + 8 * g4); acc[d] = mfma16(afr, bfr, acc[d]); }
            }
            const float bias = gbias[gp * 128 + t];
#pragma unroll
            for (int d = 0; d < 4; ++d) { const size_t eo = (size_t)(R0 + t) * 256 + gp * 64 + d * 16 + 4 * g4; const u32x2 uu = *(const u32x2*)(GU + eo);
                const float r0 = bflo(uu.x) * (acc[d][0] + bias), r1 = bfhi(uu.x) * (acc[d][1] + bias), r2 = bflo(uu.y) * (acc[d][2] + bias), r3 = bfhi(uu.y) * (acc[d][3] + bias);
                *(u32x2*)(OC + (size_t)(R0 + t) * 1024 + gp * 64 + d * 16 + 4 * g4) = (u32x2){cvt_pk_bf16(r0, r1), cvt_pk_bf16(r2, r3)}; }
        }
        __syncthreads();
    }
}

__device__ __forceinline__ void sb_tile(const f32x4 z, int kbase, int tq, int g, float& carry, float (&a)[4]) {
    float lm[4]; bool msk[4];
#pragma unroll
    for (int j = 0; j < 4; ++j) { msk[j] = (kbase + 4 * g + j) >= tq;
        const float e = __builtin_amdgcn_exp2f(-fabsf(z[j]) * LOG2E); const float sp = fmaxf(z[j], 0.f) + __builtin_amdgcn_logf(1.f + e) * LN2;
        lm[j] = msk[j] ? 0.f : -sp; }
    const float suf2 = lm[3], suf1 = lm[3] + lm[2], suf0 = suf1 + lm[1]; const float T = suf0 + lm[0];
    const float x16 = __shfl_xor(T, 16); const float Pp = T + x16; const float Qq = __shfl_xor(Pp, 32);
    const float Sg = ((g & 1) ? 0.f : x16) + ((g & 2) ? 0.f : Qq);
    const float base = carry + Sg;
    const float tl[4] = {base + suf0, base + suf1, base + suf2, base};
#pragma unroll
    for (int j = 0; j < 4; ++j) a[j] = msk[j] ? 0.f : __builtin_amdgcn_exp2f((z[j] + lm[j] + tl[j]) * LOG2E);
    carry += Pp + Qq;
}
__device__ __forceinline__ void phase_d(const bf16_t* SQ, bf16_t* OD, const bf16_t* SK, const bf16_t* VTS, int gw, int ngw, int lane) {
    const int q = lane & 15, g = lane >> 4;
    for (int L = gw; L < 4096; L += ngw) {
        const int qg = L & 255, bh = L >> 8, b = bh >> 2, h = bh & 3;
        const int row0 = b * SEQ + qg * 16; const int tq = qg * 16 + q;
        bf16x8 qf[2];
#pragma unroll
        for (int hf = 0; hf < 2; ++hf) qf[hf] = *(const bf16x8*)(SQ + (size_t)(row0 + q) * 256 + h * 64 + hf * 32 + 8 * g);
        f32x4 o[4];
#pragma unroll
        for (int d = 0; d < 4; ++d) o[d] = (f32x4){0.f, 0.f, 0.f, 0.f};
        float carry = 0.f;
        for (int pp = qg >> 1; pp >= 0; --pp) {
            const int kt0 = 2 * pp, kt1 = kt0 + 1;
            float a0[4], a1[4];
            if (kt1 <= qg) {
                const bf16_t* kr = SK + (size_t)(b * SEQ + kt1 * 16 + q) * 256 + h * 64 + 8 * g;
                f32x4 z = mfma16(*(const bf16x8*)kr, qf[0], (f32x4){0.f, 0.f, 0.f, 0.f}); z = mfma16(*(const bf16x8*)(kr + 32), qf[1], z);
                sb_tile(z, kt1 * 16, tq, g, carry, a1);
            } else {
#pragma unroll
                for (int j = 0; j < 4; ++j) a1[j] = 0.f;
            }
            {
                const bf16_t* kr = SK + (size_t)(b * SEQ + kt0 * 16 + q) * 256 + h * 64 + 8 * g;
                f32x4 z = mfma16(*(const bf16x8*)kr, qf[0], (f32x4){0.f, 0.f, 0.f, 0.f}); z = mfma16(*(const bf16x8*)(kr + 32), qf[1], z);
                sb_tile(z, kt0 * 16, tq, g, carry, a0);
            }
            const bf16x8 pf = mk8(cvt_pk_bf16(a0[0], a0[1]), cvt_pk_bf16(a0[2], a0[3]), cvt_pk_bf16(a1[0], a1[1]), cvt_pk_bf16(a1[2], a1[3]));
#pragma unroll
            for (int d = 0; d < 4; ++d) { const bf16_t* vr = VTS + (size_t)(b * 256 + h * 64 + d * 16 + q) * SEQ + kt0 * 16 + 4 * g;
                const u32x2 lo = *(const u32x2*)vr, hi = *(const u32x2*)(vr + 16);
                o[d] = mfma16(mk8(lo.x, lo.y, hi.x, hi.y), pf, o[d]); }
            if (__all(carry < -104.f)) break;
        }
#pragma unroll
        for (int d = 0; d < 4; ++d) *(u32x2*)(OD + (size_t)(row0 + q) * 1024 + h * 64 + d * 16 + 4 * g) = (u32x2){cvt_pk_bf16(o[d][0], o[d][1]), cvt_pk_bf16(o[d][2], o[d][3])};
    }
}

#define XB_TMO      128
#define XB_XCNT(j)  (256  + 64 * (j))
#define XB_XSUB(j)  (1280 + 64 * (j))
#define XB_XGEN(j)  (2304 + 64 * (j))
#define XB_TOP      3328
#define XB_TOPGEN   3392
#define XCD_BAR_WORDS 3456
#define XB_SPIN_CAP (1u << 18)

__device__ __forceinline__ unsigned xb_ld(unsigned* p)              { return __hip_atomic_load(p, __ATOMIC_RELAXED, __HIP_MEMORY_SCOPE_AGENT); }
__device__ __forceinline__ unsigned xb_add(unsigned* p, unsigned v) { return __hip_atomic_fetch_add(p, v, __ATOMIC_RELAXED, __HIP_MEMORY_SCOPE_AGENT); }
__device__ __forceinline__ unsigned xb_xcc_id() { return (unsigned)__builtin_amdgcn_s_getreg((3 << 11) | 20) & 0xFu; }
#define XB_SPIN(cond, bar) do { unsigned _sp = 0; while (cond) { __builtin_amdgcn_s_sleep(1); \
    if ((++_sp & 255u) == 0u) { if (xb_ld(&(bar)[XB_TMO])) break; if (_sp > XB_SPIN_CAP) { atomicAdd(&(bar)[XB_TMO], 1u); break; } } } } while (0)

struct XcdBarrier {
    unsigned* bar; unsigned x;
    volatile LAS unsigned* st;
};

__device__ __forceinline__ XcdBarrier xcd_barrier_post(unsigned* bar, volatile LAS unsigned* st) {
    XcdBarrier b; b.bar = bar; b.x = xb_xcc_id(); b.st = st;
    if (threadIdx.x == 0) (void)xb_add(&bar[XB_XCNT(b.x)], 1u);
    return b;
}
__device__ __forceinline__ void xcd_barrier_complete(unsigned* bar, unsigned x, unsigned& nloc, unsigned& nx) {
    const unsigned G = gridDim.x * gridDim.y * gridDim.z;
    unsigned sum, cnt, mine, sp = 0u;
    for (;;) {
        sum = 0u; cnt = 0u; mine = 0u;
#pragma unroll
        for (unsigned j = 0; j < 16; ++j) { const unsigned c = xb_ld(&bar[XB_XCNT(j)]); sum += c; cnt += (c > 0u) ? 1u : 0u; mine = (j == x) ? c : mine; }
        if (sum == G) break;
        __builtin_amdgcn_s_sleep(1);
        if ((++sp & 255u) == 0u) { if (xb_ld(&bar[XB_TMO])) break; if (sp > XB_SPIN_CAP) { atomicAdd(&bar[XB_TMO], 1u); break; } }
    }
    nloc = mine > 0u ? mine : 1u; nx = cnt > 0u ? cnt : 1u;
}

__device__ __forceinline__ void xcd_barrier(const XcdBarrier& b) {
    asm volatile("s_waitcnt vmcnt(0)" ::: "memory");
    __syncthreads();
    if (threadIdx.x == 0) {
        unsigned* bar = b.bar;
        __builtin_amdgcn_s_waitcnt(0);
        unsigned nloc = b.st[0], nx = b.st[1];
        if (nloc == 0u) { xcd_barrier_complete(bar, b.x, nloc, nx); b.st[0] = nloc; b.st[1] = nx; }
        const unsigned old = xb_add(&bar[XB_XSUB(b.x)], 1u);
        const unsigned gen = old / nloc;
        if (old + 1u == (gen + 1u) * nloc) {
            __builtin_amdgcn_fence(__ATOMIC_RELEASE, "agent");
            asm volatile("s_waitcnt vmcnt(0)" ::: "memory");
            const unsigned og = xb_add(&bar[XB_TOP], 1u);
            const unsigned tg = og / nx;
            if (og + 1u == (tg + 1u) * nx) xb_add(&bar[XB_TOPGEN], 1u);
            else XB_SPIN(xb_ld(&bar[XB_TOPGEN]) == tg, bar);
            __builtin_amdgcn_fence(__ATOMIC_ACQUIRE, "agent");
            xb_add(&bar[XB_XGEN(b.x)], 1u);
            asm volatile("s_waitcnt vmcnt(0)" ::: "memory");
        } else {
            XB_SPIN(xb_ld(&bar[XB_XGEN(b.x)]) == gen, bar);
            __builtin_amdgcn_fence(__ATOMIC_ACQUIRE, "agent");
            asm volatile("s_waitcnt vmcnt(0)" ::: "memory");
        }
    }
    __syncthreads();
}

#ifndef REP_P0
#define REP_P0 1
#endif
#ifndef REP_P1
#define REP_P1 1
#endif
#ifndef REP_A1
#define REP_A1 1
#endif
#ifndef REP_BCD
#define REP_BCD 1
#endif
#ifndef REP_A2
#define REP_A2 1
#endif
#ifndef REP_MG
#define REP_MG 1
#endif
#ifndef REP_UP
#define REP_UP 1
#endif
#ifndef REP_WO
#define REP_WO 1
#endif
#ifndef REP_N2
#define REP_N2 1
#endif
#ifndef REP_DN
#define REP_DN 1
#endif
#ifndef REP_B
#define REP_B 1
#endif
#ifndef REP_C
#define REP_C 1
#endif
#ifndef REP_D
#define REP_D 1
#endif
#ifndef REP_SYNC
#define REP_SYNC 1
#endif
#define GSYNC() do { _Pragma("unroll 1") for (int r_ = 0; r_ < REP_SYNC; ++r_) xcd_barrier(bar); } while (0)
#define REPEAT(n) _Pragma("unroll 1") for (int rep_ = 0; rep_ < (n); ++rep_)
struct Args { const float* in[16]; float* out; unsigned char* ws; };
constexpr int LDS_BYTES = 147456;
__device__ __forceinline__ unsigned char* opq(unsigned char* p) { asm volatile("" : "+s"(p)); return p; }
__device__ __forceinline__ int opq_tid() { int t = threadIdx.x; asm volatile("" : "+v"(t)); return t; }
#define WSB(T, off) ((T*)(ws + (off)))
constexpr int PTAB_OFF = 147456 - 512, BST_OFF = 147456 - 64;
__device__ __forceinline__ void* ldp(PG8_LAS unsigned char* ldsl, int i) {
    unsigned off = PTAB_OFF + 8 * i; asm volatile("" : "+v"(off));
    const unsigned long long v = *(volatile LAS unsigned long long*)(ldsl + off);
    const unsigned lo = __builtin_amdgcn_readfirstlane((unsigned)v), hi = __builtin_amdgcn_readfirstlane((unsigned)(v >> 32));
    return (void*)(((unsigned long long)hi << 32) | lo);
}

__global__ void __launch_bounds__(512, 2) fwd_kernel(Args a) {
    extern __shared__ __attribute__((aligned(16))) unsigned char lds[];
    cg::grid_group grid = cg::this_grid();
    PG8_LAS unsigned char* ldsl = (PG8_LAS unsigned char*)lds;
    if (a.ws == nullptr) grid.sync();
    if (threadIdx.x == 0) { ((volatile LAS unsigned*)(ldsl + BST_OFF))[0] = 0u; ((volatile LAS unsigned*)(ldsl + BST_OFF))[1] = 0u; }
    if (threadIdx.x == 0) { LAS unsigned long long* tb = (LAS unsigned long long*)(ldsl + PTAB_OFF);
#pragma unroll
        for (int i = 0; i < 16; ++i) tb[i] = (unsigned long long)a.in[i];
        tb[16] = (unsigned long long)a.out; tb[17] = (unsigned long long)a.ws; }
    __syncthreads();
    XcdBarrier bar = xcd_barrier_post((unsigned*)a.ws + 1024, (volatile LAS unsigned*)(ldsl + BST_OFF));
#define INP(i) ((const float*)ldp(ldsl, (i)))
#define OUTP ((float*)ldp(ldsl, 16))
#define WSP ((unsigned char*)ldp(ldsl, 17))

#define PHASE_VARS unsigned char* ws = WSP; int bid = blockIdx.x; asm volatile("" : "+s"(bid)); int G = gridDim.x; asm volatile("" : "+s"(G)); \
    const int tid = opq_tid(), lane = tid & 63, wave = __builtin_amdgcn_readfirstlane(tid >> 6); const int gw = bid * 8 + wave, ngw = G * 8; (void)ws; (void)lane; (void)gw; (void)ngw;
#ifndef REP_ALL
#define REP_ALL 1
#endif
#pragma unroll 1
    for (int ll = 0; ll < 2 * REP_ALL; ++ll) {
        const int l = ll & 1;
        REPEAT(REP_P0) {
            PHASE_VARS
#ifndef NO_CVT
            Ptrs P; P.mix_g = INP(1) + l * DM; P.ffn_g = INP(12) + l * DM;
            P.w_in = INP(2) + (size_t)l * DM * DIN; P.qn = INP(3) + l * 64; P.kn = INP(4) + l * 64; P.pool_w = INP(5) + l * 4 * 64 * 64; P.pool_scale = INP(6) + l * 256;
            P.gm_norm = INP(7) + l * 256; P.gm_ws = INP(8) + l * 4 * 128 * 128; P.gm_b = INP(9) + l * 4 * 128; P.w_branch = INP(10) + (size_t)l * 4 * 256 * 1024;
            P.w_out = INP(11) + (size_t)l * 1024 * 1024; P.w_gate = INP(13) + (size_t)l * DM * DFF; P.w_up = INP(14) + (size_t)l * DM * DFF; P.w_down = INP(15) + (size_t)l * DFF * DM;
            convert_weights(P, ws, (LAS float*)(ldsl + wave * 8448), gw, ngw, lane, bid * 512 + tid, G * 512);
#endif
            if (l == 0) x_to_bf16_ss(INP(0), WSB(bf16_t, WS_XN), WSB(float, WS_SS0), gw, ngw, lane);
        }
        GSYNC();
        REPEAT(REP_P1) {
            PHASE_VARS
            pg8::Gemm g{WSB(bf16_t, WS_XN), WSB(bf16_t, WS_WIN), M_, NINP, DM}; pg8::StaticOrder S; S.init(M_, NINP, G, bid);
            EpiIn E{ws, INP(3) + l * 64, INP(4) + l * 64, WSB(float, WS_SS0)};
#ifndef NO_G1
            pg8::gemm_phase<EpiIn, pg8::StaticOrder, true, true>(ldsl, g, S, E);
#endif
        }
        GSYNC();
        REPEAT(REP_A1) {
            PHASE_VARS
            for (int i = bid * 512 + tid; i < M_; i += G * 512) { WSB(float, WS_SS0)[i] = 0.f; WSB(float, WS_SS1)[i] = 0.f; }
#ifndef NO_A1
            phase_a1(lds, WSB(bf16_t, WS_IQ), WSB(bf16_t, WS_IK), WSB(float, WS_IW), WSB(unsigned short, WS_MASK), tid, bid, G);
#endif
            __syncthreads();
        }
        REPEAT(REP_BCD) {
        REPEAT(REP_C) {
            PHASE_VARS
#ifndef NO_C
            phase_c(lds, WSB(bf16_t, WS_GV), WSB(bf16_t, WS_GU), WSB(bf16_t, WS_OCAT) + 512, INP(7) + l * 256, WSB(bf16_t, WS_WS), INP(9) + l * 4 * 128, tid, bid, G);
#endif
        }
        REPEAT(REP_B) {
            PHASE_VARS
#ifndef NO_B
            phase_b(WSB(bf16_t, WS_PIN), WSB(bf16_t, WS_WP), INP(6) + l * 256, WSB(bf16_t, WS_OCAT) + 256, gw, ngw, lane);
#endif
        }
        REPEAT(REP_D) {
            PHASE_VARS
#ifndef NO_D
            phase_d(WSB(bf16_t, WS_SQ), WSB(bf16_t, WS_OCAT) + 768, WSB(bf16_t, WS_SK), WSB(bf16_t, WS_VTS), gw, ngw, lane);
#endif
        }
        }
        GSYNC();
        REPEAT(REP_A2) {
            PHASE_VARS
#ifndef NO_A2
            phase_a2(lds, WSB(bf16_t, WS_QA), WSB(bf16_t, WS_OCAT), WSB(bf16_t, WS_KA), WSB(bf16_t, WS_VTA), WSB(unsigned short, WS_MASK), INP(3) + l * 64, INP(4) + l * 64, tid, bid, G);
#endif
        }
        GSYNC();
        REPEAT(REP_MG) {
            PHASE_VARS
            pg8::Gemm g{WSB(bf16_t, WS_OCAT), WSB(bf16_t, WS_WB), M_, DM, DM}; pg8::StaticOrder S; S.init(M_, DM, G, bid);
            EpiMerge E{ws + WS_G, WSB(bf16_t, WS_XN)};
#ifndef NO_G2
            pg8::gemm_phase<EpiMerge, pg8::StaticOrder, true, true>(ldsl, g, S, E);
#endif
        }
        GSYNC();
        REPEAT(REP_WO) {
            PHASE_VARS
            pg8::Gemm g{WSB(bf16_t, WS_XN), WSB(bf16_t, WS_WOUT), M_, DM, DM}; pg8::StaticOrder S; S.init(M_, DM, G, bid);
            EpiResid E{l == 0 ? INP(0) : OUTP, OUTP, WSB(bf16_t, WS_S), WSB(float, WS_SS1), 1};
#ifndef NO_G3
            pg8::gemm_phase<EpiResid, pg8::StaticOrder, true, true>(ldsl, g, S, E);
#endif
        }
        GSYNC();
        REPEAT(REP_UP) {
            PHASE_VARS
            pg8::Gemm g{WSB(bf16_t, WS_S), WSB(bf16_t, WS_WGU), M_, 2 * DFF, DM}; pg8::StaticOrder S; S.init(M_, 2 * DFF, G, bid);
            EpiSwiGLU E{WSB(bf16_t, WS_R1), WSB(float, WS_SS1)};
#ifndef NO_G4
            pg8::gemm_phase<EpiSwiGLU, pg8::StaticOrder, true, true>(ldsl, g, S, E);
#endif
        }
        GSYNC();
        REPEAT(REP_DN) {
            PHASE_VARS
            pg8::Gemm g{WSB(bf16_t, WS_R1), WSB(bf16_t, WS_WD), M_, DM, DFF}; pg8::StaticOrder S; S.init(M_, DM, G, bid);
            float* o = OUTP; EpiResid E{o, o, WSB(bf16_t, WS_XN), WSB(float, WS_SS0), l == 0 ? 1 : 0};
#ifndef NO_G3
            pg8::gemm_phase<EpiResid, pg8::StaticOrder, true, true>(ldsl, g, S, E);
#endif
        }
        if (ll + 1 < 2 * REP_ALL) GSYNC();
    }
}

extern "C" void kernel_launch(void* const* d_in, const int* in_sizes, int n_in, void* d_out, int out_size, void* d_ws, size_t ws_size, hipStream_t stream) {
    static int grid_blocks = 0;
    if (grid_blocks == 0) {
        if (n_in != 16 || out_size != M_ * DM || ws_size < WS_END) { fprintf(stderr, "kernel_launch: unexpected shapes (n_in %d out %d ws %zu)\n", n_in, out_size, ws_size); grid_blocks = -1; return; }
        int dev = 0, cus = 0, per_cu = 0;
        hipGetDevice(&dev);
        hipDeviceGetAttribute(&cus, hipDeviceAttributeMultiprocessorCount, dev);
        hipFuncSetAttribute((const void*)fwd_kernel, hipFuncAttributeMaxDynamicSharedMemorySize, LDS_BYTES);
        if (hipOccupancyMaxActiveBlocksPerMultiprocessor(&per_cu, (const void*)fwd_kernel, 512, LDS_BYTES) != hipSuccess || per_cu < 1) per_cu = 1;
        (void)hipGetLastError();
        grid_blocks = cus;
    }
    if (grid_blocks < 0) return;
    Args a{};
    for (int i = 0; i < 16; ++i) a.in[i] = (const float*)d_in[i];
    a.out = (float*)d_out; a.ws = (unsigned char*)d_ws;
    if (hipMemsetAsync(d_ws, 0, 65536, stream) != hipSuccess) { fprintf(stderr, "kernel_launch: memset failed\n"); return; }
    void* args[] = {&a};
    hipError_t e = hipLaunchCooperativeKernel((const void*)fwd_kernel, dim3(grid_blocks), dim3(512), args, LDS_BYTES, stream);
    if (e != hipSuccess) fprintf(stderr, "cooperative launch failed: %s (grid %d)\n", hipGetErrorString(e), grid_blocks);
}
```

```cpp
#include <hip/hip_runtime.h>
#include <hip/hip_cooperative_groups.h>
#include <cstdio>
#include <cstdint>
namespace pg8 {
#define PG8_LAS __attribute__((address_space(3)))
typedef unsigned short bf16_t;
typedef short bf16x8 __attribute__((ext_vector_type(8)));
typedef float f32x4 __attribute__((ext_vector_type(4)));
typedef unsigned u32x4 __attribute__((ext_vector_type(4)));
constexpr int BM = 256, BK = 64, HALF = 128, HTB = HALF * BK * 2  , STAGE_BYTES = 8 * HTB, NXCD = 8, WGM = 8;

__host__ __device__ __forceinline__ int lds_byte(int r, int c) { const int st = (r >> 4) * 2 + (c >> 5), rr = r & 15, cc = c & 31, ob = rr * 64 + cc * 2; return st * 1024 + (ob ^ (((ob >> 9) & 1) << 5)); }
__host__ __device__ __forceinline__ void stage_rc(int b, int& R, int& C) { const int st = b / 1024, sb = b % 1024, swz = sb ^ (((sb >> 9) & 1) << 5); R = (st >> 1) * 16 + swz / 64; C = (st & 1) * 32 + (swz % 64) / 2; }
__host__ __device__ __forceinline__ int perm32(int rho) { const int n = rho >> 4, i = rho & 15; return 8 * (i >> 2) + 4 * n + (i & 3); }

struct Unit { int pm, pn; };
struct Gemm { const bf16_t* A; const bf16_t* Bt; int M, N, K; };

struct StaticOrder {
    int nM, nN, nwg, G, c;
    __host__ __device__ void init(int M, int N, int G_, int c_) { nM = M / BM; nN = N / BM; nwg = nM * nN; G = G_; c = c_; }
    __host__ __device__ bool next(int i, Unit& u) const {
        const long L = (long)i * G + c; if (L >= nwg) return false;
        int wgid = (int)L; { const int q = nwg / NXCD, r = nwg % NXCD, xcd = wgid % NXCD, off = wgid / NXCD; wgid = (xcd < r ? xcd * (q + 1) : r * (q + 1) + (xcd - r) * q) + off; }
        const int nig = WGM * nN, gid = wgid / nig, fm = gid * WGM, gsz = (nM - fm) < WGM ? (nM - fm) : WGM;
        u.pm = fm + ((wgid % nig) % gsz); u.pn = (wgid % nig) / gsz; return true;
    }
    __device__ __forceinline__ void a_ready(const Unit&) const {}
    __device__ __forceinline__ void done(const Unit&) const {}
};

__device__ __forceinline__ unsigned cvt_pk_bf16(float lo, float hi) { unsigned r; asm volatile("v_cvt_pk_bf16_f32 %0, %1, %2" : "=v"(r) : "v"(lo), "v"(hi)); return r; }
template <class Epi, class Sched, bool ALIGN_EPI = false, bool SP2 = false>
__device__ __forceinline__ void gemm_phase(PG8_LAS unsigned char* lds, const Gemm g, const Sched& S, const Epi& E) {
    int tid_ = threadIdx.x; asm volatile("" : "+v"(tid_)); const int tid = tid_, wid = __builtin_amdgcn_readfirstlane(tid >> 6), lane = tid & 63, wr = wid >> 2, wc = wid & 3, fr = lane & 15, fq = lane >> 4;
    const int K = g.K, nt = K / BK;
    unsigned voffA[2], voffB[2];
#pragma unroll
    for (int i = 0; i < 2; ++i) { int R, C; stage_rc(tid * 16 + i * 8192, R, C); const int Rb = Epi::PERM ? ((R & ~31) + perm32(R & 31)) : R;
        voffA[i] = (unsigned)(R * K + C) * 2u; voffB[i] = (unsigned)(Rb * K + C) * 2u; }
    const size_t kstep = (size_t)(BK * 2);
    const size_t hstep = (size_t)HALF * K * 2;
    const size_t tstep = 2 * hstep;
    const unsigned ldsw = (unsigned)wid * 1024u;
    const int aoff = lds_byte(wr * 64 + fr, fq * 8), boff = lds_byte(wc * 32 + fr, fq * 8);
#define PG8_SA(b, h) (((b) * 2 + (h)) * HTB)
#define PG8_SB(b, h) ((4 + (b) * 2 + (h)) * HTB)
#define PG8_STAGE(bufoff, gbase, voff) do { _Pragma("unroll") for (int _i = 0; _i < 2; ++_i) \
        __builtin_amdgcn_global_load_lds((const unsigned*)((const char*)(gbase) + (voff)[_i]), (PG8_LAS unsigned*)(lds + (bufoff) + ldsw + _i * 8192), 16, 0, 0); } while (0)
#define PG8_LDA(dst, b, h) do { _Pragma("unroll") for (int m = 0; m < 4; ++m) _Pragma("unroll") for (int k = 0; k < 2; ++k) dst[m][k] = *(const PG8_LAS bf16x8*)(lds + PG8_SA(b, h) + aoff + m * 2048 + k * 1024); } while (0)
#define PG8_LDB(dst, b, h) do { _Pragma("unroll") for (int n = 0; n < 2; ++n) _Pragma("unroll") for (int k = 0; k < 2; ++k) dst[n][k] = *(const PG8_LAS bf16x8*)(lds + PG8_SB(b, h) + boff + n * 2048 + k * 1024); } while (0)
#define PG8_MMA(ai, bj, At, Bt) do { __builtin_amdgcn_s_setprio(1); _Pragma("unroll") for (int m = 0; m < 4; ++m) _Pragma("unroll") for (int n = 0; n < 2; ++n) _Pragma("unroll") for (int k = 0; k < 2; ++k) \
        acc[ai][bj][m][n] = __builtin_amdgcn_mfma_f32_16x16x32_bf16(Bt[n][k], At[m][k], acc[ai][bj][m][n], 0, 0, 0); __builtin_amdgcn_s_setprio(0); } while (0)
#define PG8_WAIT_V(n) asm volatile("s_waitcnt vmcnt(" #n ")" ::: "memory")
#define PG8_WAIT_L(n) asm volatile("s_waitcnt lgkmcnt(" #n ")" ::: "memory")
#define PG8_BAR __builtin_amdgcn_s_barrier()
#define PG8_SCHED __builtin_amdgcn_sched_barrier(0)
    Unit cur, nxt; int ui = 0;
    if (!S.next(0, cur)) return;
    f32x4 acc[2][2][4][2];
#pragma unroll
    for (int a = 0; a < 2; ++a)
#pragma unroll
        for (int b = 0; b < 2; ++b)
#pragma unroll
            for (int m = 0; m < 4; ++m)
#pragma unroll
                for (int n = 0; n < 2; ++n) acc[a][b][m][n] = (f32x4){0.f, 0.f, 0.f, 0.f};
    bf16x8 At[4][2], B0[2][2], B1[2][2];
    const char* cA = (const char*)g.A + (size_t)cur.pm * tstep; const char* cB = (const char*)g.Bt + (size_t)cur.pn * tstep;
    S.a_ready(cur);
    if constexpr (SP2) {
        PG8_STAGE(PG8_SB(0, 0), cB, voffB); PG8_STAGE(PG8_SB(0, 1), cB + hstep, voffB); PG8_STAGE(PG8_SA(0, 0), cA, voffA); PG8_STAGE(PG8_SA(0, 1), cA + hstep, voffA);
        if (wr == 1) PG8_BAR;
        PG8_WAIT_V(2); PG8_BAR;
        PG8_STAGE(PG8_SB(1, 0), cB + kstep, voffB); PG8_STAGE(PG8_SA(1, 0), cA + kstep, voffA); PG8_STAGE(PG8_SB(1, 1), cB + hstep + kstep, voffB);
        PG8_WAIT_V(6); PG8_BAR;
    } else {
        PG8_STAGE(PG8_SB(0, 0), cB, voffB); PG8_STAGE(PG8_SA(0, 0), cA, voffA); PG8_STAGE(PG8_SB(0, 1), cB + hstep, voffB); PG8_STAGE(PG8_SA(0, 1), cA + hstep, voffA);
        if (wr == 1) PG8_BAR;
        PG8_WAIT_V(4); PG8_BAR;
        PG8_STAGE(PG8_SB(1, 0), cB + kstep, voffB); PG8_STAGE(PG8_SA(1, 0), cA + kstep, voffA); PG8_STAGE(PG8_SB(1, 1), cB + hstep + kstep, voffB);
        PG8_WAIT_V(6); PG8_BAR;
    }
    for (;;) {
        const bool has_next = S.next(ui + 1, nxt);
        const char* nA = has_next ? (const char*)g.A + (size_t)nxt.pm * tstep : cA; const char* nB = has_next ? (const char*)g.Bt + (size_t)nxt.pn * tstep : cB;
        for (int t = 0; t < nt; t += 2) {
            if constexpr (Epi::HOOK) { if (t != 0 && (t & 3) == 0) E.hook(acc, cur, (t >> 2) - 1, wr, wc, fr, fq); }
            const bool last = (t == nt - 2);
            const char* a1 = cA + (size_t)(t + 1) * kstep;
            const char* a2 = last ? nA : cA + (size_t)(t + 2) * kstep; const char* b2 = last ? nB : cB + (size_t)(t + 2) * kstep;
            const char* a3 = a2 + kstep; const char* b3 = b2 + kstep;
            if (last && has_next) S.a_ready(nxt);
            if constexpr (SP2) {
            PG8_LDB(B0, 0, 0); PG8_LDB(B1, 0, 1); PG8_SCHED; PG8_LDA(At, 0, 0); PG8_STAGE(PG8_SA(1, 1), a1 + hstep, voffA);
            PG8_WAIT_V(8); PG8_WAIT_L(0); PG8_BAR; PG8_MMA(0, 0, At, B0); PG8_MMA(0, 1, At, B1); PG8_BAR; PG8_SCHED;
            PG8_LDA(At, 0, 1); PG8_STAGE(PG8_SB(0, 0), b2, voffB); PG8_STAGE(PG8_SB(0, 1), b2 + hstep, voffB); PG8_STAGE(PG8_SA(0, 0), a2, voffA);
            PG8_WAIT_V(8); PG8_WAIT_L(0); PG8_BAR; PG8_MMA(1, 0, At, B0); PG8_MMA(1, 1, At, B1); PG8_BAR; PG8_SCHED;
            PG8_LDB(B0, 1, 0); PG8_LDB(B1, 1, 1); PG8_SCHED; PG8_LDA(At, 1, 0); PG8_STAGE(PG8_SA(0, 1), a2 + hstep, voffA);
            PG8_WAIT_V(8); PG8_WAIT_L(0); PG8_BAR; PG8_MMA(0, 0, At, B0); PG8_MMA(0, 1, At, B1); PG8_BAR; PG8_SCHED;
            PG8_LDA(At, 1, 1); PG8_STAGE(PG8_SB(1, 0), b3, voffB); PG8_STAGE(PG8_SB(1, 1), b3 + hstep, voffB); PG8_STAGE(PG8_SA(1, 0), a3, voffA);
            PG8_WAIT_V(8); PG8_WAIT_L(0); PG8_BAR; PG8_MMA(1, 0, At, B0); PG8_MMA(1, 1, At, B1); PG8_BAR; PG8_SCHED;
            } else {
            PG8_LDB(B0, 0, 0); PG8_SCHED; PG8_LDA(At, 0, 0); PG8_STAGE(PG8_SA(1, 1), a1 + hstep, voffA);
            PG8_WAIT_L(8); PG8_BAR; PG8_WAIT_L(0); PG8_MMA(0, 0, At, B0); PG8_BAR; PG8_SCHED;
            PG8_LDB(B1, 0, 1); PG8_STAGE(PG8_SB(0, 0), b2, voffB);
            PG8_BAR; PG8_WAIT_L(0); PG8_MMA(0, 1, At, B1); PG8_BAR;
            PG8_LDA(At, 0, 1); PG8_STAGE(PG8_SA(0, 0), a2, voffA);
            PG8_BAR; PG8_WAIT_L(0); PG8_MMA(1, 0, At, B0); PG8_BAR; PG8_SCHED;
            PG8_STAGE(PG8_SB(0, 1), b2 + hstep, voffB);
            PG8_WAIT_V(6); PG8_BAR; PG8_MMA(1, 1, At, B1); PG8_BAR;
            PG8_LDB(B0, 1, 0); PG8_SCHED; PG8_LDA(At, 1, 0); PG8_STAGE(PG8_SA(0, 1), a2 + hstep, voffA);
            PG8_WAIT_L(8); PG8_BAR; PG8_WAIT_L(0); PG8_MMA(0, 0, At, B0); PG8_BAR; PG8_SCHED;
            PG8_LDB(B1, 1, 1); PG8_STAGE(PG8_SB(1, 0), b3, voffB);
            PG8_BAR; PG8_WAIT_L(0); PG8_MMA(0, 1, At, B1); PG8_BAR;
            PG8_LDA(At, 1, 1); PG8_STAGE(PG8_SA(1, 0), a3, voffA);
            PG8_BAR; PG8_WAIT_L(0); PG8_MMA(1, 0, At, B0); PG8_BAR; PG8_SCHED;
            PG8_STAGE(PG8_SB(1, 1), b3 + hstep, voffB);
            PG8_WAIT_V(6); PG8_BAR; PG8_MMA(1, 1, At, B1); PG8_BAR;
            }
        }
        if constexpr (ALIGN_EPI) { if (wr == 0) PG8_BAR; }
        if constexpr (!Epi::AFTER_DRAIN) { E(acc, cur, wr, wc, fr, fq); S.done(cur); }
        if (!has_next) break;
#pragma unroll
        for (int a = 0; a < 2; ++a)
#pragma unroll
            for (int b = 0; b < 2; ++b)
#pragma unroll
                for (int m = 0; m < 4; ++m)
#pragma unroll
                    for (int n = 0; n < 2; ++n) acc[a][b][m][n] = (f32x4){0.f, 0.f, 0.f, 0.f};
        cur = nxt; cA = nA; cB = nB; ++ui;
        if constexpr (ALIGN_EPI) { if (wr == 1) PG8_BAR; }
    }
    PG8_WAIT_V(0);
    if constexpr (!ALIGN_EPI) { if (wr == 0) PG8_BAR; }
    PG8_BAR;
    if constexpr (Epi::AFTER_DRAIN) { E.fused(acc, cur, wr, wc, fr, fq, lds, wid, lane); S.done(cur); }
#undef PG8_SA
#undef PG8_SB
#undef PG8_STAGE
#undef PG8_LDA
#undef PG8_LDB
#undef PG8_MMA
#undef PG8_WAIT_V
#undef PG8_WAIT_L
#undef PG8_BAR
#undef PG8_SCHED
}
}
namespace cg = cooperative_groups;
using pg8::bf16_t; using pg8::bf16x8; using pg8::f32x4; using pg8::u32x4; using pg8::Unit; using pg8::cvt_pk_bf16;
typedef unsigned u32x2 __attribute__((ext_vector_type(2)));
#define LAS __attribute__((address_space(3)))
#define LDS_WAIT() asm volatile("s_waitcnt lgkmcnt(0)" ::: "memory")

constexpr int M_ = 16384, DM = 1024, SEQ = 4096, DFF = 2816, DIN = 6696, NINP = 6912;
constexpr float EPSN = 1e-6f;
constexpr float LOG2E = 1.4426950408889634f, LN2 = 0.6931471805599453f;
constexpr float C2 = 0.125f * LOG2E;

constexpr size_t MiB = (size_t)1 << 20;
constexpr size_t WS_SS0 = 128 * 1024, WS_SS1 = 256 * 1024;
constexpr size_t WS_WIN = 1 * MiB;
constexpr size_t WS_WB = WS_WIN + (size_t)NINP * 1024 * 2;
constexpr size_t WS_WOUT = WS_WB + 2 * MiB;
constexpr size_t WS_WGU = WS_WOUT + 2 * MiB;
constexpr size_t WS_WD = WS_WGU + 11 * MiB;
constexpr size_t WS_WP = WS_WD + (size_t)1024 * 2816 * 2;
constexpr size_t WS_WS = WS_WP + 32768;
static_assert(WS_WS + 131072 <= 36 * MiB, "weights region");
constexpr size_t WS_XN = 36 * MiB;
constexpr size_t WS_R1 = 68 * MiB;
constexpr size_t WS_G = WS_R1, WS_KA = WS_R1 + 64 * MiB, WS_VTA = WS_KA + 8 * MiB, WS_IQ = WS_VTA + 8 * MiB;
constexpr size_t WS_S = 156 * MiB;
constexpr size_t WS_PIN = WS_S, WS_GU = WS_S + 8 * MiB, WS_GV = WS_S + 16 * MiB, WS_SQ = WS_S + 24 * MiB, WS_SK = WS_S + 32 * MiB,
                 WS_VTS = WS_S + 40 * MiB, WS_QA = WS_S + 48 * MiB, WS_MASK = WS_S + 56 * MiB, WS_IK = 220 * MiB, WS_IW = 221 * MiB, WS_OCAT = 222 * MiB  , WS_END = 254 * MiB;

__device__ __forceinline__ float bf2f(unsigned short v) { return __uint_as_float((unsigned)v << 16); }
__device__ __forceinline__ float bflo(unsigned v) { return __uint_as_float(v << 16); }
__device__ __forceinline__ float bfhi(unsigned v) { return __uint_as_float(v & 0xffff0000u); }
__device__ __forceinline__ unsigned short f2bf(float f) { return (unsigned short)(cvt_pk_bf16(f, 0.f) & 0xffffu); }
__device__ __forceinline__ float sigmoidf_(float x) { return __builtin_amdgcn_rcpf(1.f + __builtin_amdgcn_exp2f(-x * LOG2E)); }
__device__ __forceinline__ float gelu_tanh(float x) { const float u = 0.7978845608028654f * (x + 0.044715f * x * x * x); return x * __builtin_amdgcn_rcpf(1.f + __builtin_amdgcn_exp2f(-2.f * LOG2E * u)); }
__device__ __forceinline__ f32x4 mfma16(bf16x8 a, bf16x8 b, f32x4 c) { return __builtin_amdgcn_mfma_f32_16x16x32_bf16(a, b, c, 0, 0, 0); }
__device__ __forceinline__ bf16x8 mk8(unsigned a, unsigned b, unsigned c, unsigned d) { u32x4 v = {a, b, c, d}; return __builtin_bit_cast(bf16x8, v); }

struct EpiIn {
    static constexpr bool PERM = true, AFTER_DRAIN = false, HOOK = false;
    unsigned char* ws; const float *qn, *kn; const float* SS;
    __device__ __forceinline__ void operator()(const f32x4 (&acc)[2][2][4][2], const Unit& u, int wr, int wc, int fr, int fq) const {
        bf16_t* const QA = (bf16_t*)(ws + WS_QA); bf16_t* const KA = (bf16_t*)(ws + WS_KA); bf16_t* const VTA = (bf16_t*)(ws + WS_VTA); bf16_t* const IQ = (bf16_t*)(ws + WS_IQ);
        bf16_t* const PIN = (bf16_t*)(ws + WS_PIN); bf16_t* const GU = (bf16_t*)(ws + WS_GU); bf16_t* const GV = (bf16_t*)(ws + WS_GV); bf16_t* const SQ = (bf16_t*)(ws + WS_SQ);
        bf16_t* const SK = (bf16_t*)(ws + WS_SK); bf16_t* const VTS = (bf16_t*)(ws + WS_VTS); bf16_t* const IK = (bf16_t*)(ws + WS_IK); float* const IW = (float*)(ws + WS_IW); unsigned char* const G = ws + WS_G;
        const int pn = u.pn; const int row0 = u.pm * 256 + wr * 64 + fr; const int cl = wc * 32 + 8 * fq;
        float rr[2][4];
#pragma unroll
        for (int ai = 0; ai < 2; ++ai)
#pragma unroll
            for (int m = 0; m < 4; ++m) rr[ai][m] = __builtin_amdgcn_rsqf(SS[row0 + ai * 128 + m * 16] * (1.f / 1024.f) + EPSN);
        if (pn >= 11) {
            unsigned char* gp = G + (size_t)row0 * 4096 + (pn - 11) * 256 + cl;
#pragma unroll
            for (int ai = 0; ai < 2; ++ai)
#pragma unroll
                for (int m = 0; m < 4; ++m)
#pragma unroll
                    for (int bj = 0; bj < 2; ++bj) {
                        unsigned w2[2];
#pragma unroll
                        for (int n = 0; n < 2; ++n) { const f32x4 v = (acc[ai][bj][m][n] * rr[ai][m]); unsigned pk = 0;
#pragma unroll
                            for (int i = 0; i < 4; ++i) { const unsigned qv = (unsigned)(sigmoidf_(v[i]) * 255.f + 0.5f); pk |= qv << (8 * i); }
                            w2[n] = pk; }
                        *(u32x2*)(gp + (size_t)(ai * 128 + m * 16) * 4096 + bj * 128) = (u32x2){w2[0], w2[1]};
                    }
            return;
        }
        if (pn <= 1) {
            const float* gw = pn == 0 ? qn : kn; const float sc = pn == 0 ? C2 : 1.f; bf16_t* T = pn == 0 ? QA : KA;
            f32x4 gv[2][2];
#pragma unroll
            for (int bj = 0; bj < 2; ++bj)
#pragma unroll
                for (int n = 0; n < 2; ++n) gv[bj][n] = *(const f32x4*)(gw + bj * 32 + 8 * fq + 4 * n);
#pragma unroll
            for (int ai = 0; ai < 2; ++ai)
#pragma unroll
                for (int m = 0; m < 4; ++m) {
                    float ss = 0.f;
#pragma unroll
                    for (int bj = 0; bj < 2; ++bj)
#pragma unroll
                        for (int n = 0; n < 2; ++n) { const f32x4 v = (acc[ai][bj][m][n] * rr[ai][m]); ss += (v[0] * v[0] + v[1] * v[1]) + (v[2] * v[2] + v[3] * v[3]); }
                    ss += __shfl_xor(ss, 16); ss += __shfl_xor(ss, 32);
                    const float rinv = __builtin_amdgcn_rsqf(ss * (1.f / 64.f) + EPSN) * sc;
                    bf16_t* rp = T + (size_t)(row0 + ai * 128 + m * 16) * 256 + wc * 64 + 8 * fq;
#pragma unroll
                    for (int bj = 0; bj < 2; ++bj) { const f32x4 v0 = (acc[ai][bj][m][0] * rr[ai][m]) * gv[bj][0] * rinv, v1 = (acc[ai][bj][m][1] * rr[ai][m]) * gv[bj][1] * rinv;
                        u32x4 w; w.x = cvt_pk_bf16(v0[0], v0[1]); w.y = cvt_pk_bf16(v0[2], v0[3]); w.z = cvt_pk_bf16(v1[0], v1[1]); w.w = cvt_pk_bf16(v1[2], v1[3]);
                        *(u32x4*)(rp + bj * 32) = w; }
                }
            return;
        }
        if (pn == 2 || pn == 9) {
            bf16_t* T = pn == 2 ? VTA : VTS;
#pragma unroll
            for (int ai = 0; ai < 2; ++ai)
#pragma unroll
                for (int m = 0; m < 4; ++m) { const int row = row0 + ai * 128 + m * 16; const int b = row >> 12, t = row & 4095;
#pragma unroll
                    for (int bj = 0; bj < 2; ++bj)
#pragma unroll
                        for (int n = 0; n < 2; ++n) { const f32x4 v = (acc[ai][bj][m][n] * rr[ai][m]);
#pragma unroll
                            for (int i = 0; i < 4; ++i) T[((size_t)b * 256 + bj * 128 + cl + 4 * n + i) * 4096 + t] = f2bf(v[i]); }
                }
            return;
        }
        if (pn == 10) {
            if (wc == 0) {
#pragma unroll
                for (int ai = 0; ai < 2; ++ai)
#pragma unroll
                    for (int m = 0; m < 4; ++m) { const f32x4 v0 = (acc[ai][0][m][0] * rr[ai][m]), v1 = (acc[ai][0][m][1] * rr[ai][m]);
                        u32x4 w; w.x = cvt_pk_bf16(v0[0], v0[1]); w.y = cvt_pk_bf16(v0[2], v0[3]); w.z = cvt_pk_bf16(v1[0], v1[1]); w.w = cvt_pk_bf16(v1[2], v1[3]);
                        *(u32x4*)(IK + (size_t)(row0 + ai * 128 + m * 16) * 32 + 8 * fq) = w; }
            } else if (wc == 1 && fq == 0) {
#pragma unroll
                for (int ai = 0; ai < 2; ++ai)
#pragma unroll
                    for (int m = 0; m < 4; ++m) { float* p = IW + (size_t)(row0 + ai * 128 + m * 16) * 8; *(f32x4*)p = (acc[ai][0][m][0] * rr[ai][m]); *(f32x4*)(p + 4) = (acc[ai][0][m][1] * rr[ai][m]); }
            }
            return;
        }
        {
            bf16_t* T = pn == 3 ? IQ : pn == 4 ? PIN : pn == 5 ? GU : pn == 6 ? GV : pn == 7 ? SQ : SK;
            const bool act = (pn == 5 || pn == 6); const float sc = pn == 7 ? 0.125f : 1.f;
#pragma unroll
            for (int ai = 0; ai < 2; ++ai)
#pragma unroll
                for (int m = 0; m < 4; ++m) { bf16_t* rp = T + (size_t)(row0 + ai * 128 + m * 16) * 256 + cl;
#pragma unroll
                    for (int bj = 0; bj < 2; ++bj) { f32x4 v0 = (acc[ai][bj][m][0] * rr[ai][m]) * sc, v1 = (acc[ai][bj][m][1] * rr[ai][m]) * sc;
                        if (act) {
#pragma unroll
                            for (int i = 0; i < 4; ++i) { v0[i] = gelu_tanh(v0[i]); v1[i] = gelu_tanh(v1[i]); } }
                        u32x4 w; w.x = cvt_pk_bf16(v0[0], v0[1]); w.y = cvt_pk_bf16(v0[2], v0[3]); w.z = cvt_pk_bf16(v1[0], v1[1]); w.w = cvt_pk_bf16(v1[2], v1[3]);
                        *(u32x4*)(rp + bj * 128) = w; }
                }
        }
    }
};

struct EpiMerge {
    static constexpr bool PERM = true, AFTER_DRAIN = false, HOOK = true;
    const unsigned char* G; bf16_t* MG;
    __device__ __forceinline__ void hook(f32x4 (&acc)[2][2][4][2], const Unit& u, int s, int wr, int wc, int fr, int fq) const {
        const int row0 = u.pm * 256 + wr * 64 + fr; const int col0 = u.pn * 256 + wc * 32 + 8 * fq;
        const unsigned char* gp0 = G + (size_t)row0 * 4096 + s * 1024 + col0;
#pragma unroll
        for (int ai = 0; ai < 2; ++ai)
#pragma unroll
            for (int m = 0; m < 4; ++m) {
#pragma unroll
                for (int bj = 0; bj < 2; ++bj) { const unsigned char* gp = gp0 + (size_t)(ai * 128 + m * 16) * 4096 + bj * 128;
                    const u32x2 ga = *(const u32x2*)gp, gb = *(const u32x2*)(gp + 1024);
#pragma unroll
                    for (int i = 0; i < 4; ++i) {
                        const float a0 = fmaxf((float)((ga.x >> (8 * i)) & 255u), 1.f), b0 = fmaxf((float)((gb.x >> (8 * i)) & 255u), 1.f);
                        const float a1 = fmaxf((float)((ga.y >> (8 * i)) & 255u), 1.f), b1 = fmaxf((float)((gb.y >> (8 * i)) & 255u), 1.f);
                        acc[ai][bj][m][0][i] *= a0 * __builtin_amdgcn_rcpf(b0); acc[ai][bj][m][1][i] *= a1 * __builtin_amdgcn_rcpf(b1); }
                }
                asm volatile("" ::: "memory"); }
    }
    __device__ __forceinline__ void operator()(const f32x4 (&acc)[2][2][4][2], const Unit& u, int wr, int wc, int fr, int fq) const {
        const int row0 = u.pm * 256 + wr * 64 + fr; const int col0 = u.pn * 256 + wc * 32 + 8 * fq;
        const unsigned char* gp0 = G + (size_t)row0 * 4096 + 3 * 1024 + col0; bf16_t* mp0 = MG + (size_t)row0 * 1024 + col0;
#pragma unroll
        for (int ai = 0; ai < 2; ++ai)
#pragma unroll
            for (int m = 0; m < 4; ++m) {
#pragma unroll
                for (int bj = 0; bj < 2; ++bj) { const size_t ro = (size_t)(ai * 128 + m * 16);
                    const u32x2 gb = *(const u32x2*)(gp0 + ro * 4096 + bj * 128);
                    f32x4 v0 = acc[ai][bj][m][0], v1 = acc[ai][bj][m][1];
#pragma unroll
                    for (int i = 0; i < 4; ++i) { v0[i] *= fmaxf((float)((gb.x >> (8 * i)) & 255u), 1.f) * (1.f / 255.f); v1[i] *= fmaxf((float)((gb.y >> (8 * i)) & 255u), 1.f) * (1.f / 255.f); }
                    u32x4 w; w.x = cvt_pk_bf16(v0[0], v0[1]); w.y = cvt_pk_bf16(v0[2], v0[3]); w.z = cvt_pk_bf16(v1[0], v1[1]); w.w = cvt_pk_bf16(v1[2], v1[3]);
                    *(u32x4*)(mp0 + ro * 1024 + bj * 128) = w; }
                asm volatile("" ::: "memory"); }
    }
};

struct EpiResid {
    static constexpr bool PERM = true, AFTER_DRAIN = false, HOOK = false;
    const float* base; float* out; bf16_t* XB; float* SS; int stat;
    __device__ __forceinline__ void operator()(const f32x4 (&acc)[2][2][4][2], const Unit& u, int wr, int wc, int fr, int fq) const {
        const int row0 = u.pm * 256 + wr * 64 + fr; const int col0 = u.pn * 256 + wc * 32 + 8 * fq;
#pragma unroll
        for (int ai = 0; ai < 2; ++ai)
#pragma unroll
            for (int m = 0; m < 4; ++m) { const int row = row0 + ai * 128 + m * 16; const size_t off = (size_t)row * 1024 + col0; float ssum = 0.f;
#pragma unroll
                for (int bj = 0; bj < 2; ++bj) { const f32x4 b0 = *(const f32x4*)(base + off + bj * 128), b1 = *(const f32x4*)(base + off + bj * 128 + 4);
                    const f32x4 o0 = b0 + acc[ai][bj][m][0], o1 = b1 + acc[ai][bj][m][1];
                    *(f32x4*)(out + off + bj * 128) = o0; *(f32x4*)(out + off + bj * 128 + 4) = o1;
                    if (stat) { u32x4 w; w.x = cvt_pk_bf16(o0[0], o0[1]); w.y = cvt_pk_bf16(o0[2], o0[3]); w.z = cvt_pk_bf16(o1[0], o1[1]); w.w = cvt_pk_bf16(o1[2], o1[3]);
                        *(u32x4*)(XB + off + bj * 128) = w;
                        ssum += ((o0[0] * o0[0] + o0[1] * o0[1]) + (o0[2] * o0[2] + o0[3] * o0[3])) + ((o1[0] * o1[0] + o1[1] * o1[1]) + (o1[2] * o1[2] + o1[3] * o1[3])); } }
                if (stat) { ssum += __shfl_xor(ssum, 16); ssum += __shfl_xor(ssum, 32); if (fq == 0) atomicAdd(SS + row, ssum); }
                asm volatile("" ::: "memory"); }
    }
};

struct EpiSwiGLU {
    static constexpr bool PERM = true, AFTER_DRAIN = false, HOOK = false;
    bf16_t* ACT; const float* SS;
    __device__ __forceinline__ void operator()(const f32x4 (&acc)[2][2][4][2], const Unit& u, int wr, int wc, int fr, int fq) const {
        const int row0 = u.pm * 256 + wr * 64 + fr; const int f0 = u.pn * 128 + wc * 32 + 8 * fq;
#pragma unroll
        for (int ai = 0; ai < 2; ++ai)
#pragma unroll
            for (int m = 0; m < 4; ++m) { f32x4 r[2]; const float rs = __builtin_amdgcn_rsqf(SS[row0 + ai * 128 + m * 16] * (1.f / 1024.f) + EPSN);
#pragma unroll
                for (int n = 0; n < 2; ++n) { const f32x4 g = acc[ai][0][m][n] * rs, up = acc[ai][1][m][n] * rs;
#pragma unroll
                    for (int i = 0; i < 4; ++i) r[n][i] = g[i] * sigmoidf_(g[i]) * up[i]; }
                u32x4 w; w.x = cvt_pk_bf16(r[0][0], r[0][1]); w.y = cvt_pk_bf16(r[0][2], r[0][3]); w.z = cvt_pk_bf16(r[1][0], r[1][1]); w.w = cvt_pk_bf16(r[1][2], r[1][3]);
                *(u32x4*)(ACT + (size_t)(row0 + ai * 128 + m * 16) * DFF + f0) = w; }
    }
};

__device__ __forceinline__ void cvt_item(const float* src, int ld, int col0, int nvalid, int K, bf16_t* WT, int dst_row0, int kb, LAS float* scr, int lane, const float* rs = nullptr) {
    const int k0 = 64 * kb, c = lane & 31;
#pragma unroll 8
    for (int i = 0; i < 32; ++i) { const int kk = 2 * i + (lane >> 5); float v = 0.f; if (c < nvalid) v = src[(size_t)(k0 + kk) * ld + col0 + c]; if (rs) v *= rs[k0 + kk]; scr[kk * 33 + c] = v; }
    LDS_WAIT();
    const int c8 = lane & 7;
#pragma unroll
    for (int j = 0; j < 4; ++j) { const int n = (lane >> 3) + 8 * j; const LAS float* s = scr + (8 * c8) * 33 + n;
        u32x4 o; o.x = cvt_pk_bf16(s[0 * 33], s[1 * 33]); o.y = cvt_pk_bf16(s[2 * 33], s[3 * 33]); o.z = cvt_pk_bf16(s[4 * 33], s[5 * 33]); o.w = cvt_pk_bf16(s[6 * 33], s[7 * 33]);
        *(u32x4*)(WT + (size_t)(dst_row0 + n) * K + k0 + 8 * c8) = o; }
    LDS_WAIT();
}
__device__ __forceinline__ float wave_sum(float v) {
#pragma unroll
    for (int o = 1; o < 64; o <<= 1) v += __shfl_xor(v, o);
    return v;
}
__device__ __forceinline__ float wave_max(float v) {
#pragma unroll
    for (int o = 1; o < 64; o <<= 1) v = fmaxf(v, __shfl_xor(v, o));
    return v;
}
__device__ __forceinline__ void rmsnorm_rows(const float* xs, const float* gamma, bf16_t* XN, int gw, int ngw, int lane) {
    f32x4 gm[4];
#pragma unroll
    for (int j = 0; j < 4; ++j) gm[j] = *(const f32x4*)(gamma + 4 * lane + 256 * j);
    for (int m = gw; m < M_; m += ngw) {
        const f32x4* xr = (const f32x4*)(xs + (size_t)m * DM) + lane; f32x4 v[4]; float s = 0.f;
#pragma unroll
        for (int j = 0; j < 4; ++j) { v[j] = xr[64 * j]; s += (v[j].x * v[j].x + v[j].y * v[j].y) + (v[j].z * v[j].z + v[j].w * v[j].w); }
        const float r = __builtin_amdgcn_rsqf(wave_sum(s) * (1.f / DM) + EPSN);
        u32x2* o8 = (u32x2*)(XN + (size_t)m * DM) + lane;
#pragma unroll
        for (int j = 0; j < 4; ++j) { const f32x4 y = v[j] * r * gm[j]; o8[64 * j] = (u32x2){cvt_pk_bf16(y.x, y.y), cvt_pk_bf16(y.z, y.w)}; }
    }
}

__device__ __forceinline__ void x_to_bf16_ss(const float* xs, bf16_t* XN, float* SS, int gw, int ngw, int lane) {
    for (int m = gw; m < M_; m += ngw) {
        const f32x4* xr = (const f32x4*)(xs + (size_t)m * DM) + lane; f32x4 v[4]; float s = 0.f;
#pragma unroll
        for (int j = 0; j < 4; ++j) { v[j] = xr[64 * j]; s += (v[j].x * v[j].x + v[j].y * v[j].y) + (v[j].z * v[j].z + v[j].w * v[j].w); }
        s = wave_sum(s);
        u32x2* o8 = (u32x2*)(XN + (size_t)m * DM) + lane;
#pragma unroll
        for (int j = 0; j < 4; ++j) o8[64 * j] = (u32x2){cvt_pk_bf16(v[j].x, v[j].y), cvt_pk_bf16(v[j].z, v[j].w)};
        if (lane == 0) SS[m] = s;
    }
}
struct Ptrs {
    const float *mix_g, *ffn_g, *w_in, *qn, *kn, *pool_w, *pool_scale, *gm_norm, *gm_ws, *gm_b, *w_branch, *w_out, *w_gate, *w_up, *w_down;
};

__device__ __forceinline__ void convert_weights(const Ptrs& P, unsigned char* ws, LAS float* scr, int gw, int ngw, int lane, int gtid, int ngt) {
    bf16_t* WinT = (bf16_t*)(ws + WS_WIN); bf16_t* WbT = (bf16_t*)(ws + WS_WB); bf16_t* WoutT = (bf16_t*)(ws + WS_WOUT); bf16_t* WguT = (bf16_t*)(ws + WS_WGU);
    bf16_t* WdT = (bf16_t*)(ws + WS_WD); bf16_t* WpT = (bf16_t*)(ws + WS_WP); bf16_t* Wtril = (bf16_t*)(ws + WS_WS);
    constexpr int I_A = 216 * 16, I_B = 512, I_C = 512, I_D = 176 * 16, I_E = 32 * 44, I_F = 8, NIT = I_A + I_B + I_C + I_D + I_E + I_F;
    for (int it = gw; it < NIT; it += ngw) {
        int r = it;
        if (r < I_A) { const int rb = r >> 4, kb = r & 15, tile = rb >> 3, sub = rb & 7; int col0, nv = 32;
            if (tile <= 1) col0 = tile * 256 + (sub & 3) * 64 + (sub >> 2) * 32;
            else if (tile == 2) col0 = 512 + sub * 32;
            else if (tile == 3) col0 = 768 + sub * 32;
            else if (tile <= 9) col0 = 1064 + (tile - 4) * 256 + sub * 32;
            else if (tile == 10) { col0 = sub == 0 ? 1024 : 1056; nv = sub == 0 ? 32 : (sub == 1 ? 8 : 0); }
            else col0 = 2600 + (tile - 11) * 256 + sub * 32;
            cvt_item(P.w_in, DIN, col0, nv, 1024, WinT, rb * 32, kb, scr, lane, P.mix_g); continue; }
        r -= I_A;
        if (r < I_B) { const int rb = r >> 4, kb = r & 15; cvt_item(P.w_branch, 1024, rb * 32, 32, 1024, WbT, rb * 32, kb, scr, lane); continue; }
        r -= I_B;
        if (r < I_C) { const int rb = r >> 4, kb = r & 15; cvt_item(P.w_out, 1024, rb * 32, 32, 1024, WoutT, rb * 32, kb, scr, lane); continue; }
        r -= I_C;
        if (r < I_D) { const int rb = r >> 4, kb = r & 15, tile = rb >> 3, sub = rb & 7;
            cvt_item((sub >> 2) ? P.w_up : P.w_gate, DFF, tile * 128 + (sub & 3) * 32, 32, 1024, WguT, rb * 32, kb, scr, lane, P.ffn_g); continue; }
        r -= I_D;
        if (r < I_E) { const int rb = r / 44, kb = r % 44; cvt_item(P.w_down, 1024, rb * 32, 32, DFF, WdT, rb * 32, kb, scr, lane); continue; }
        r -= I_E;
        { const int gp = r >> 1, rb = r & 1; cvt_item(P.pool_w + gp * 4096, 64, rb * 32, 32, 64, WpT + gp * 4096, rb * 32, 0, scr, lane); }
    }
    for (int e = gtid; e < 4 * 128 * 128; e += ngt) { const int s = e & 127, t = (e >> 7) & 127; Wtril[e] = (s <= t) ? f2bf(P.gm_ws[e]) : (unsigned short)0; }
}

__device__ __forceinline__ unsigned mono_key(float s) { const unsigned b = __float_as_uint(s); return b ^ ((unsigned)((int)b >> 31) | 0x80000000u); }

#define wr_lane(dst, sval, ln) asm volatile("s_nop 4\n\tv_writelane_b32 %0, %1, %2\n\ts_nop 1" : "+v"(dst) : "s"(sval), "n"(ln))
template <int NBLK> __device__ __forceinline__ unsigned a1_bisect(const unsigned (&v)[64], int& cpre) {
    unsigned prefix = 0u; cpre = 0;
#pragma unroll 1
    for (int bit = 31; bit >= 0; --bit) {
        const unsigned cand = prefix | (1u << bit);
        int cnt = 0;
#pragma unroll
        for (int blk = 0; blk < NBLK; ++blk) {
            unsigned long long bl[8];
#pragma unroll
            for (int k = 0; k < 8; ++k) bl[k] = __ballot(v[blk * 8 + k] >= cand);
            __builtin_amdgcn_sched_barrier(0);
#pragma unroll
            for (int k = 0; k < 8; ++k) cnt += __builtin_popcountll(bl[k]);
            __builtin_amdgcn_sched_barrier(0);
        }
        if (cnt >= 256) { prefix = cand; cpre = cnt; if (cnt == 256) break; }
    }
    return prefix;
}
constexpr int A1_ROWF = 4100;
__device__ __forceinline__ void phase_a1(unsigned char* lds, const bf16_t* IQ, const bf16_t* IK, const float* IW, unsigned short* MASK, int tid, int bid, int G) {
    const int lane = tid & 63, w = __builtin_amdgcn_readfirstlane(tid >> 6), q = lane & 15, g = lane >> 4;
    unsigned* keys = (unsigned*)lds;
#ifndef REP_A1X
#define REP_A1X 1
#endif
    for (int L2 = bid; L2 < 1024 * REP_A1X; L2 += G) {
        const int L = L2 & 1023;
        const int b = L >> 8, c = L & 255, qg = (b & 1) ? 255 - c : c;
        const int row0 = b * SEQ + qg * 16;
        const int nreg = (qg >> 2) + 1;
        if (qg <= 15) {
#pragma unroll
            for (int half = 0; half < 2; ++half) { const int qq = half * 8 + w; const int t = qg * 16 + qq; unsigned mlo = 0u, mhi = 0u;
#pragma unroll
                for (int r = 0; r < 4; ++r) { const unsigned long long bal = __ballot(64 * r + lane <= t);
                    wr_lane(mlo, (unsigned)bal, r); wr_lane(mhi, (unsigned)(bal >> 32), r); }
                if (lane < nreg) *(u32x2*)(MASK + (size_t)(row0 + qq) * 256 + 4 * lane) = (u32x2){mlo, mhi}; }
            continue;
        }
        unsigned u[128];
        {
            bf16x8 iqf[8]; float wv[8];
#pragma unroll
            for (int h = 0; h < 8; ++h) iqf[h] = *(const bf16x8*)(IQ + (size_t)(row0 + q) * 256 + h * 32 + 8 * g);
            { const f32x4 a = *(const f32x4*)(IW + (size_t)(row0 + q) * 8), bq = *(const f32x4*)(IW + (size_t)(row0 + q) * 8 + 4);
              wv[0] = a[0]; wv[1] = a[1]; wv[2] = a[2]; wv[3] = a[3]; wv[4] = bq[0]; wv[5] = bq[1]; wv[6] = bq[2]; wv[7] = bq[3]; }
#pragma unroll
            for (int blk = 0; blk < 4; ++blk) {
                if (64 * blk + w <= qg) {
                    bf16x8 kf[8];
#pragma unroll
                    for (int ii = 0; ii < 8; ++ii) { const int kt = 8 * (8 * blk + ii) + w; kf[ii] = *(const bf16x8*)(IK + (size_t)(b * SEQ + kt * 16 + q) * 32 + 8 * g); }
#pragma unroll
                    for (int ii = 0; ii < 8; ++ii) { const int i = 8 * blk + ii; const int kt = 8 * i + w;
                        f32x4 s = {0.f, 0.f, 0.f, 0.f};
#pragma unroll
                        for (int h = 0; h < 8; ++h) { const f32x4 a = mfma16(kf[ii], iqf[h], (f32x4){0.f, 0.f, 0.f, 0.f});
#pragma unroll
                            for (int j = 0; j < 4; ++j) s[j] = __builtin_fmaf(wv[h], fmaxf(a[j], 0.f), s[j]); }
#pragma unroll
                        for (int j = 0; j < 4; ++j) { unsigned uu = mono_key(s[j]); if (kt > qg || (kt == qg && (4 * g + j) > q)) uu = 0u; u[4 * i + j] = uu; }
                    }
                } else {
#pragma unroll
                    for (int r = 0; r < 32; ++r) u[32 * blk + r] = 0u;
                }
            }
        }
#pragma unroll 1
        for (int half = 0; half < 2; ++half) {
            if ((q >> 3) == half) {
                unsigned* krow = keys + (q & 7) * A1_ROWF + 4 * g;
#pragma unroll
                for (int i = 0; i < 32; ++i) { const int kt = 8 * i + w; *(u32x4*)(krow + kt * 16) = (u32x4){u[4 * i], u[4 * i + 1], u[4 * i + 2], u[4 * i + 3]}; }
            }
            __syncthreads();
            {
                const int qq = half * 8 + w; const unsigned* krow = keys + w * A1_ROWF + lane;
                unsigned v[64];
#pragma unroll
                for (int blk = 0; blk < 8; ++blk) {
                    if (nreg > blk * 8) {
#pragma unroll
                        for (int r = blk * 8; r < blk * 8 + 8; ++r) v[r] = krow[64 * r];
                    } else {
#pragma unroll
                        for (int r = blk * 8; r < blk * 8 + 8; ++r) v[r] = 0u;
                    }
                }
#ifndef REP_BIS
#define REP_BIS 1
#endif
                unsigned prefix; int cpre = 0;
#pragma unroll 1
                for (int rb_ = 0; rb_ < REP_BIS; ++rb_)
                switch ((nreg + 7) >> 3) {
                    case 1: prefix = a1_bisect<1>(v, cpre); break; case 2: prefix = a1_bisect<2>(v, cpre); break; case 3: prefix = a1_bisect<3>(v, cpre); break; case 4: prefix = a1_bisect<4>(v, cpre); break;
                    case 5: prefix = a1_bisect<5>(v, cpre); break; case 6: prefix = a1_bisect<6>(v, cpre); break; case 7: prefix = a1_bisect<7>(v, cpre); break; default: prefix = a1_bisect<8>(v, cpre); break;
                }
                const unsigned thr = prefix > 1u ? prefix : 1u;
                unsigned mlo = 0u, mhi = 0u;
                if (cpre == 256) {
#pragma unroll
                    for (int r = 0; r < 64; ++r) { const unsigned long long bal = __ballot(v[r] >= thr); wr_lane(mlo, (unsigned)bal, r); wr_lane(mhi, (unsigned)(bal >> 32), r); }
                } else {
                    int rem = 256;
#pragma unroll
                    for (int r = 0; r < 64; ++r) rem -= __builtin_popcountll(__ballot(v[r] > thr));
#pragma unroll
                    for (int r = 0; r < 64; ++r) { unsigned long long bal = __ballot(v[r] > thr); unsigned long long eq = __ballot(v[r] == thr);
                        const int ne = __builtin_popcountll(eq);
                        if (ne <= rem) { bal |= eq; rem -= ne; }
                        else { while (rem > 0) { const unsigned long long low = eq & (0ull - eq); bal |= low; eq ^= low; --rem; } }
                        wr_lane(mlo, (unsigned)bal, r); wr_lane(mhi, (unsigned)(bal >> 32), r); }
                }
                if (lane < nreg) *(u32x2*)(MASK + (size_t)(row0 + qq) * 256 + 4 * lane) = (u32x2){mlo, mhi};
            }
            __syncthreads();
        }
    }
}

__device__ __forceinline__ void phase_a2(unsigned char* lds, const bf16_t* QA, bf16_t* OA, const bf16_t* KA, const bf16_t* VTA, const unsigned short* MASK,
                                         const float* qn, const float* kn, int tid, int bid, int G) {
    const int lane = tid & 63, w = __builtin_amdgcn_readfirstlane(tid >> 6), q = lane & 15, g = lane >> 4;
    bf16_t* Kt = (bf16_t*)lds;
    bf16_t* Vt = (bf16_t*)(lds + 2 * 64 * 72 * 2);
    const float msh = LOG2E * 8.f * wave_max(fabsf(qn[lane])) * wave_max(fabsf(kn[lane])) * 1.02f + 0.25f;
    const int srow = tid >> 3, sch = tid & 7;
    for (int L = bid; L < 512; L += G) {
        const int jj = L >> 8, c = L & 255, bh = c >> 4, qb = jj ? 31 - (c & 15) : (c & 15);
        const int b = bh >> 2, h = bh & 3;
        const int qgw = qb * 8 + w;
        const int row0 = b * SEQ + qb * 128 + 16 * w;
        bf16x8 qf[2];
#pragma unroll
        for (int hf = 0; hf < 2; ++hf) qf[hf] = *(const bf16x8*)(QA + (size_t)(row0 + q) * 256 + h * 64 + hf * 32 + 8 * g);
        const unsigned short* mrow = MASK + (size_t)(row0 + q) * 256;
        const int nsteps = 2 * qb + 2;
        const bf16_t* ksrc = KA + (size_t)(b * SEQ + srow) * 256 + h * 64 + sch * 8;
        const bf16_t* vsrc = VTA + (size_t)(b * 256 + h * 64 + srow) * SEQ + sch * 8;
        u32x4 kA = *(const u32x4*)ksrc, vA = *(const u32x4*)vsrc, kB = kA, vB = vA;
        u32x2 mE = *(const u32x2*)mrow, mO = mE;
        *(u32x4*)(Kt + srow * 72 + sch * 8) = kA; *(u32x4*)(Vt + srow * 72 + sch * 8) = vA;
        if (nsteps > 1) { kB = *(const u32x4*)(ksrc + (size_t)64 * 256); vB = *(const u32x4*)(vsrc + 64); mO = *(const u32x2*)(mrow + 4); }
        f32x4 o[4]; float lsum = 0.f; const f32x4 negm = {-msh, -msh, -msh, -msh};
#pragma unroll
        for (int d = 0; d < 4; ++d) o[d] = (f32x4){0.f, 0.f, 0.f, 0.f};
        __syncthreads();
#define A2_COMPUTE(st, buf, mcur) do { \
            const bf16_t* kb_ = Kt + (buf) * 64 * 72; const bf16_t* vb_ = Vt + (buf) * 64 * 72; \
            _Pragma("unroll") for (int p = 0; p < 2; ++p) { \
                const int kt0 = (st) * 4 + 2 * p; \
                if (kt0 <= qgw) { \
                    const unsigned mw = p ? (mcur).y : (mcur).x; \
                    const unsigned nib0 = (mw >> (4 * g)) & 15u, nib1 = (kt0 + 1 <= qgw) ? ((mw >> (16 + 4 * g)) & 15u) : 0u; \
                    const bf16_t* kr0 = kb_ + (p * 32 + q) * 72 + 8 * g; const bf16_t* kr1 = kr0 + 16 * 72; \
                    f32x4 a0 = mfma16(*(const bf16x8*)kr0, qf[0], negm); a0 = mfma16(*(const bf16x8*)(kr0 + 32), qf[1], a0); \
                    f32x4 a1 = mfma16(*(const bf16x8*)kr1, qf[0], negm); a1 = mfma16(*(const bf16x8*)(kr1 + 32), qf[1], a1); \
                    float p0[4], p1[4]; \
                    _Pragma("unroll") for (int j = 0; j < 4; ++j) { p0[j] = ((nib0 >> j) & 1u) ? __builtin_amdgcn_exp2f(a0[j]) : 0.f; p1[j] = ((nib1 >> j) & 1u) ? __builtin_amdgcn_exp2f(a1[j]) : 0.f; } \
                    lsum += ((p0[0] + p0[1]) + (p0[2] + p0[3])) + ((p1[0] + p1[1]) + (p1[2] + p1[3])); \
                    const bf16x8 pf = mk8(cvt_pk_bf16(p0[0], p0[1]), cvt_pk_bf16(p0[2], p0[3]), cvt_pk_bf16(p1[0], p1[1]), cvt_pk_bf16(p1[2], p1[3])); \
                    _Pragma("unroll") for (int d = 0; d < 4; ++d) { const bf16_t* vr = vb_ + (d * 16 + q) * 72 + p * 32 + 4 * g; \
                        const u32x2 lo = *(const u32x2*)vr, hi = *(const u32x2*)(vr + 16); \
                        o[d] = mfma16(mk8(lo.x, lo.y, hi.x, hi.y), pf, o[d]); } \
                } } } while (0)
        for (int st = 0; st < nsteps; st += 2) {
            {
                const bool more2 = st + 2 < nsteps; u32x2 mEn = mE;
                if (more2) { kA = *(const u32x4*)(ksrc + (size_t)(st + 2) * 64 * 256); vA = *(const u32x4*)(vsrc + (st + 2) * 64); mEn = *(const u32x2*)(mrow + (st + 2) * 4); }
                A2_COMPUTE(st, 0, mE);
                *(u32x4*)(Kt + 64 * 72 + srow * 72 + sch * 8) = kB; *(u32x4*)(Vt + 64 * 72 + srow * 72 + sch * 8) = vB;
                __syncthreads();
                mE = mEn;
            }
            {
                const int s1 = st + 1; const bool more2 = s1 + 2 < nsteps; u32x2 mOn = mO;
                if (more2) { kB = *(const u32x4*)(ksrc + (size_t)(s1 + 2) * 64 * 256); vB = *(const u32x4*)(vsrc + (s1 + 2) * 64); mOn = *(const u32x2*)(mrow + (s1 + 2) * 4); }
                A2_COMPUTE(s1, 1, mO);
                if (s1 + 1 < nsteps) { *(u32x4*)(Kt + srow * 72 + sch * 8) = kA; *(u32x4*)(Vt + srow * 72 + sch * 8) = vA; }
                __syncthreads();
                mO = mOn;
            }
        }
#undef A2_COMPUTE
        lsum += __shfl_xor(lsum, 16); lsum += __shfl_xor(lsum, 32);
        const float inv = 1.f / lsum;
#pragma unroll
        for (int d = 0; d < 4; ++d) { const f32x4 v = o[d] * inv;
            *(u32x2*)(OA + (size_t)(row0 + q) * 1024 + h * 64 + d * 16 + 4 * g) = (u32x2){cvt_pk_bf16(v[0], v[1]), cvt_pk_bf16(v[2], v[3])}; }
    }
}

__device__ __forceinline__ void phase_b(const bf16_t* PIN, const bf16_t* WpT, const float* pscale, bf16_t* OB, int gw, int ngw, int lane) {
    const int q = lane & 15, g4 = lane >> 4;
    for (int L = gw; L < 4096; L += ngw) {
        const int gp = L >> 10, tg = L & 1023; const int row = tg * 16 + q; const int t = row & (SEQ - 1);
        const int win = 2 << gp; const int cnt = (t + 1 < win) ? t + 1 : win; const float inv = 1.f / (float)cnt;
        f32x4 acc[4];
#pragma unroll
        for (int d = 0; d < 4; ++d) acc[d] = (f32x4){0.f, 0.f, 0.f, 0.f};
#pragma unroll
        for (int ch = 0; ch < 2; ++ch) {
            const bf16_t* p = PIN + (size_t)row * 256 + gp * 64 + ch * 32 + 8 * g4;
            u32x4 wv[16];
#pragma unroll
            for (int i = 0; i < 16; ++i) { wv[i] = (u32x4){0u, 0u, 0u, 0u}; if (i < win && i <= t) wv[i] = *(const u32x4*)(p - (size_t)i * 256); }
            float own[8], sum[8];
            own[0] = bflo(wv[0].x); own[1] = bfhi(wv[0].x); own[2] = bflo(wv[0].y); own[3] = bfhi(wv[0].y); own[4] = bflo(wv[0].z); own[5] = bfhi(wv[0].z); own[6] = bflo(wv[0].w); own[7] = bfhi(wv[0].w);
#pragma unroll
            for (int k = 0; k < 8; ++k) sum[k] = own[k];
#pragma unroll
            for (int i = 1; i < 16; ++i) { const u32x4 v = wv[i];
                sum[0] += bflo(v.x); sum[1] += bfhi(v.x); sum[2] += bflo(v.y); sum[3] += bfhi(v.y); sum[4] += bflo(v.z); sum[5] += bfhi(v.z); sum[6] += bflo(v.w); sum[7] += bfhi(v.w); }
            float pl[8];
#pragma unroll
            for (int k = 0; k < 8; ++k) pl[k] = sum[k] * inv - own[k];
            const bf16x8 bfr = mk8(cvt_pk_bf16(pl[0], pl[1]), cvt_pk_bf16(pl[2], pl[3]), cvt_pk_bf16(pl[4], pl[5]), cvt_pk_bf16(pl[6], pl[7]));
#pragma unroll
            for (int d = 0; d < 4; ++d) { const bf16x8 afr = *(const bf16x8*)(WpT + gp * 4096 + (d * 16 + q) * 64 + ch * 32 + 8 * g4); acc[d] = mfma16(afr, bfr, acc[d]); }
        }
#pragma unroll
        for (int d = 0; d < 4; ++d) { const int d0 = d * 16 + 4 * g4; const f32x4 sc = *(const f32x4*)(pscale + gp * 64 + d0); const f32x4 v = acc[d] * sc;
            *(u32x2*)(OB + (size_t)row * 1024 + gp * 64 + d0) = (u32x2){cvt_pk_bf16(v[0], v[1]), cvt_pk_bf16(v[2], v[3])}; }
    }
}

__device__ __forceinline__ void phase_c(unsigned char* lds, const bf16_t* GV, const bf16_t* GU, bf16_t* OC, const float* gamma, const bf16_t* Wtril, const float* gbias, int tid, int bid, int G) {
    bf16_t* LT = (bf16_t*)lds;
    const int lane = tid & 63, w = __builtin_amdgcn_readfirstlane(tid >> 6), q = lane & 15, g4 = lane >> 4;
    for (int L = bid; L < 512; L += G) {
        const int gp = L & 3, chk = L >> 2; const int R0 = chk * 128;
        {
            const int row = tid >> 2, part = tid & 3;
            const bf16_t* src = GV + (size_t)(R0 + row) * 256 + part * 64;
            float x[64];
#pragma unroll
            for (int k8 = 0; k8 < 8; ++k8) { const u32x4 v = *(const u32x4*)(src + 8 * k8);
                x[8 * k8 + 0] = bflo(v.x); x[8 * k8 + 1] = bfhi(v.x); x[8 * k8 + 2] = bflo(v.y); x[8 * k8 + 3] = bfhi(v.y); x[8 * k8 + 4] = bflo(v.z); x[8 * k8 + 5] = bfhi(v.z); x[8 * k8 + 6] = bflo(v.w); x[8 * k8 + 7] = bfhi(v.w); }
            float s = 0.f;
#pragma unroll
            for (int k = 0; k < 64; ++k) s += x[k];
            s += __shfl_xor(s, 1); s += __shfl_xor(s, 2);
            const float mean = s * (1.f / 256.f); float ss = 0.f;
#pragma unroll
            for (int k = 0; k < 64; ++k) { const float dd = x[k] - mean; ss += dd * dd; }
            ss += __shfl_xor(ss, 1); ss += __shfl_xor(ss, 2);
            const float rstd = __builtin_amdgcn_rsqf(ss * (1.f / 256.f) + EPSN);
            if (part == gp) {
#pragma unroll
                for (int k4 = 0; k4 < 16; ++k4) { const f32x4 gm = *(const f32x4*)(gamma + gp * 64 + 4 * k4);
#pragma unroll
                    for (int i = 0; i < 4; ++i) LT[(4 * k4 + i) * 136 + row] = f2bf((x[4 * k4 + i] - mean) * rstd * gm[i]); }
            }
        }
        __syncthreads();
        {
            f32x4 acc[4];
#pragma unroll
            for (int d = 0; d < 4; ++d) acc[d] = (f32x4){0.f, 0.f, 0.f, 0.f};
            const int t = 16 * w + q; const int nsb = ((16 * w + 15) >> 5) + 1;
            for (int sb = 0; sb < nsb; ++sb) {
                const bf16x8 bfr = *(const bf16x8*)(Wtril + ((size_t)gp * 128 + t) * 128 + sb * 32 + 8 * g4);
#pragma unroll
                for (int d = 0; d < 4; ++d) { const bf16x8 afr = *(const bf16x8*)(LT + (d * 16 + q) * 136 + sb * 32 + 8 * g4); acc[d] = mfma16(afr, bfr, acc[d]); }
            }
            const float bias = gbias[gp * 128 + t];
#pragma unroll
            for (int d = 0; d < 4; ++d) { const size_t eo = (size_t)(R0 + t) * 256 + gp * 64 + d * 16 + 4 * g4; const u32x2 uu = *(const u32x2*)(GU + eo);
                const float r0 = bflo(uu.x) * (acc[d][0] + bias), r1 = bfhi(uu.x) * (acc[d][1] + bias), r2 = bflo(uu.y) * (acc[d][2] + bias), r3 = bfhi(uu.y) * (acc[d][3] + bias);
                *(u32x2*)(OC + (size_t)(R0 + t) * 1024 + gp * 64 + d * 16 + 4 * g4) = (u32x2){cvt_pk_bf16(r0, r1), cvt_pk_bf16(r2, r3)}; }
        }
        __syncthreads();
    }
}

__device__ __forceinline__ void sb_tile(const f32x4 z, int kbase, int tq, int g, float& carry, float (&a)[4]) {
    float lm[4]; bool msk[4];
#pragma unroll
    for (int j = 0; j < 4; ++j) { msk[j] = (kbase + 4 * g + j) >= tq;
        const float e = __builtin_amdgcn_exp2f(-fabsf(z[j]) * LOG2E); const float sp = fmaxf(z[j], 0.f) + __builtin_amdgcn_logf(1.f + e) * LN2;
        lm[j] = msk[j] ? 0.f : -sp; }
    const float suf2 = lm[3], suf1 = lm[3] + lm[2], suf0 = suf1 + lm[1]; const float T = suf0 + lm[0];
    const float x16 = __shfl_xor(T, 16); const float Pp = T + x16; const float Qq = __shfl_xor(Pp, 32);
    const float Sg = ((g & 1) ? 0.f : x16) + ((g & 2) ? 0.f : Qq);
    const float base = carry + Sg;
    const float tl[4] = {base + suf0, base + suf1, base + suf2, base};
#pragma unroll
    for (int j = 0; j < 4; ++j) a[j] = msk[j] ? 0.f : __builtin_amdgcn_exp2f((z[j] + lm[j] + tl[j]) * LOG2E);
    carry += Pp + Qq;
}
__device__ __forceinline__ void phase_d(const bf16_t* SQ, bf16_t* OD, const bf16_t* SK, const bf16_t* VTS, int gw, int ngw, int lane) {
    const int q = lane & 15, g = lane >> 4;
    for (int L = gw; L < 4096; L += ngw) {
        const int qg = L & 255, bh = L >> 8, b = bh >> 2, h = bh & 3;
        const int row0 = b * SEQ + qg * 16; const int tq = qg * 16 + q;
        bf16x8 qf[2];
#pragma unroll
        for (int hf = 0; hf < 2; ++hf) qf[hf] = *(const bf16x8*)(SQ + (size_t)(row0 + q) * 256 + h * 64 + hf * 32 + 8 * g);
        f32x4 o[4];
#pragma unroll
        for (int d = 0; d < 4; ++d) o[d] = (f32x4){0.f, 0.f, 0.f, 0.f};
        float carry = 0.f;
        for (int pp = qg >> 1; pp >= 0; --pp) {
            const int kt0 = 2 * pp, kt1 = kt0 + 1;
            float a0[4], a1[4];
            if (kt1 <= qg) {
                const bf16_t* kr = SK + (size_t)(b * SEQ + kt1 * 16 + q) * 256 + h * 64 + 8 * g;
                f32x4 z = mfma16(*(const bf16x8*)kr, qf[0], (f32x4){0.f, 0.f, 0.f, 0.f}); z = mfma16(*(const bf16x8*)(kr + 32), qf[1], z);
                sb_tile(z, kt1 * 16, tq, g, carry, a1);
            } else {
#pragma unroll
                for (int j = 0; j < 4; ++j) a1[j] = 0.f;
            }
            {
                const bf16_t* kr = SK + (size_t)(b * SEQ + kt0 * 16 + q) * 256 + h * 64 + 8 * g;
                f32x4 z = mfma16(*(const bf16x8*)kr, qf[0], (f32x4){0.f, 0.f, 0.f, 0.f}); z = mfma16(*(const bf16x8*)(kr + 32), qf[1], z);
                sb_tile(z, kt0 * 16, tq, g, carry, a0);
            }
            const bf16x8 pf = mk8(cvt_pk_bf16(a0[0], a0[1]), cvt_pk_bf16(a0[2], a0[3]), cvt_pk_bf16(a1[0], a1[1]), cvt_pk_bf16(a1[2], a1[3]));
#pragma unroll
            for (int d = 0; d < 4; ++d) { const bf16_t* vr = VTS + (size_t)(b * 256 + h * 64 + d * 16 + q) * SEQ + kt0 * 16 + 4 * g;
                const u32x2 lo = *(const u32x2*)vr, hi = *(const u32x2*)(vr + 16);
                o[d] = mfma16(mk8(lo.x, lo.y, hi.x, hi.y), pf, o[d]); }
            if (__all(carry < -104.f)) break;
        }
#pragma unroll
        for (int d = 0; d < 4; ++d) *(u32x2*)(OD + (size_t)(row0 + q) * 1024 + h * 64 + d * 16 + 4 * g) = (u32x2){cvt_pk_bf16(o[d][0], o[d][1]), cvt_pk_bf16(o[d][2], o[d][3])};
    }
}

#define XB_TMO      128
#define XB_XCNT(j)  (256  + 64 * (j))
#define XB_XSUB(j)  (1280 + 64 * (j))
#define XB_XGEN(j)  (2304 + 64 * (j))
#define XB_TOP      3328
#define XB_TOPGEN   3392
#define XCD_BAR_WORDS 3456
#define XB_SPIN_CAP (1u << 18)

__device__ __forceinline__ unsigned xb_ld(unsigned* p)              { return __hip_atomic_load(p, __ATOMIC_RELAXED, __HIP_MEMORY_SCOPE_AGENT); }
__device__ __forceinline__ unsigned xb_add(unsigned* p, unsigned v) { return __hip_atomic_fetch_add(p, v, __ATOMIC_RELAXED, __HIP_MEMORY_SCOPE_AGENT); }
__device__ __forceinline__ unsigned xb_xcc_id() { return (unsigned)__builtin_amdgcn_s_getreg((3 << 11) | 20) & 0xFu; }
#define XB_SPIN(cond, bar) do { unsigned _sp = 0; while (cond) { __builtin_amdgcn_s_sleep(1); \
    if ((++_sp & 255u) == 0u) { if (xb_ld(&(bar)[XB_TMO])) break; if (_sp > XB_SPIN_CAP) { atomicAdd(&(bar)[XB_TMO], 1u); break; } } } } while (0)

struct XcdBarrier {
    unsigned* bar; unsigned x;
    volatile LAS unsigned* st;
};

__device__ __forceinline__ XcdBarrier xcd_barrier_post(unsigned* bar, volatile LAS unsigned* st) {
    XcdBarrier b; b.bar = bar; b.x = xb_xcc_id(); b.st = st;
    if (threadIdx.x == 0) (void)xb_add(&bar[XB_XCNT(b.x)], 1u);
    return b;
}
__device__ __forceinline__ void xcd_barrier_complete(unsigned* bar, unsigned x, unsigned& nloc, unsigned& nx) {
    const unsigned G = gridDim.x * gridDim.y * gridDim.z;
    unsigned sum, cnt, mine, sp = 0u;
    for (;;) {
        sum = 0u; cnt = 0u; mine = 0u;
#pragma unroll
        for (unsigned j = 0; j < 16; ++j) { const unsigned c = xb_ld(&bar[XB_XCNT(j)]); sum += c; cnt += (c > 0u) ? 1u : 0u; mine = (j == x) ? c : mine; }
        if (sum == G) break;
        __builtin_amdgcn_s_sleep(1);
        if ((++sp & 255u) == 0u) { if (xb_ld(&bar[XB_TMO])) break; if (sp > XB_SPIN_CAP) { atomicAdd(&bar[XB_TMO], 1u); break; } }
    }
    nloc = mine > 0u ? mine : 1u; nx = cnt > 0u ? cnt : 1u;
}

__device__ __forceinline__ void xcd_barrier(const XcdBarrier& b) {
    asm volatile("s_waitcnt vmcnt(0)" ::: "memory");
    __syncthreads();
    if (threadIdx.x == 0) {
        unsigned* bar = b.bar;
        __builtin_amdgcn_s_waitcnt(0);
        unsigned nloc = b.st[0], nx = b.st[1];
        if (nloc == 0u) { xcd_barrier_complete(bar, b.x, nloc, nx); b.st[0] = nloc; b.st[1] = nx; }
        const unsigned old = xb_add(&bar[XB_XSUB(b.x)], 1u);
        const unsigned gen = old / nloc;
        if (old + 1u == (gen + 1u) * nloc) {
            __builtin_amdgcn_fence(__ATOMIC_RELEASE, "agent");
            asm volatile("s_waitcnt vmcnt(0)" ::: "memory");
            const unsigned og = xb_add(&bar[XB_TOP], 1u);
            const unsigned tg = og / nx;
            if (og + 1u == (tg + 1u) * nx) xb_add(&bar[XB_TOPGEN], 1u);
            else XB_SPIN(xb_ld(&bar[XB_TOPGEN]) == tg, bar);
            __builtin_amdgcn_fence(__ATOMIC_ACQUIRE, "agent");
            xb_add(&bar[XB_XGEN(b.x)], 1u);
            asm volatile("s_waitcnt vmcnt(0)" ::: "memory");
        } else {
            XB_SPIN(xb_ld(&bar[XB_XGEN(b.x)]) == gen, bar);
            __builtin_amdgcn_fence(__ATOMIC_ACQUIRE, "agent");
            asm volatile("s_waitcnt vmcnt(0)" ::: "memory");
        }
    }
    __syncthreads();
}

#ifndef REP_P0
#define REP_P0 1
#endif
#ifndef REP_P1
#define REP_P1 1
#endif
#ifndef REP_A1
#define REP_A1 1
#endif
#ifndef REP_BCD
#define REP_BCD 1
#endif
#ifndef REP_A2
#define REP_A2 1
#endif
#ifndef REP_MG
#define REP_MG 1
#endif
#ifndef REP_UP
#define REP_UP 1
#endif
#ifndef REP_WO
#define REP_WO 1
#endif
#ifndef REP_N2
#define REP_N2 1
#endif
#ifndef REP_DN
#define REP_DN 1
#endif
#ifndef REP_B
#define REP_B 1
#endif
#ifndef REP_C
#define REP_C 1
#endif
#ifndef REP_D
#define REP_D 1
#endif
#ifndef REP_SYNC
#define REP_SYNC 1
#endif
#define GSYNC() do { _Pragma("unroll 1") for (int r_ = 0; r_ < REP_SYNC; ++r_) xcd_barrier(bar); } while (0)
#define REPEAT(n) _Pragma("unroll 1") for (int rep_ = 0; rep_ < (n); ++rep_)
struct Args { const float* in[16]; float* out; unsigned char* ws; };
constexpr int LDS_BYTES = 147456;
__device__ __forceinline__ unsigned char* opq(unsigned char* p) { asm volatile("" : "+s"(p)); return p; }
__device__ __forceinline__ int opq_tid() { int t = threadIdx.x; asm volatile("" : "+v"(t)); return t; }
#define WSB(T, off) ((T*)(ws + (off)))
constexpr int PTAB_OFF = 147456 - 512, BST_OFF = 147456 - 64;
__device__ __forceinline__ void* ldp(PG8_LAS unsigned char* ldsl, int i) {
    unsigned off = PTAB_OFF + 8 * i; asm volatile("" : "+v"(off));
    const unsigned long long v = *(volatile LAS unsigned long long*)(ldsl + off);
    const unsigned lo = __builtin_amdgcn_readfirstlane((unsigned)v), hi = __builtin_amdgcn_readfirstlane((unsigned)(v >> 32));
    return (void*)(((unsigned long long)hi << 32) | lo);
}

__global__ void __launch_bounds__(512, 2) fwd_kernel(Args a) {
    extern __shared__ __attribute__((aligned(16))) unsigned char lds[];
    cg::grid_group grid = cg::this_grid();
    PG8_LAS unsigned char* ldsl = (PG8_LAS unsigned char*)lds;
    if (a.ws == nullptr) grid.sync();
    if (threadIdx.x == 0) { ((volatile LAS unsigned*)(ldsl + BST_OFF))[0] = 0u; ((volatile LAS unsigned*)(ldsl + BST_OFF))[1] = 0u; }
    if (threadIdx.x == 0) { LAS unsigned long long* tb = (LAS unsigned long long*)(ldsl + PTAB_OFF);
#pragma unroll
        for (int i = 0; i < 16; ++i) tb[i] = (unsigned long long)a.in[i];
        tb[16] = (unsigned long long)a.out; tb[17] = (unsigned long long)a.ws; }
    __syncthreads();
    XcdBarrier bar = xcd_barrier_post((unsigned*)a.ws + 1024, (volatile LAS unsigned*)(ldsl + BST_OFF));
#define INP(i) ((const float*)ldp(ldsl, (i)))
#define OUTP ((float*)ldp(ldsl, 16))
#define WSP ((unsigned char*)ldp(ldsl, 17))

#define PHASE_VARS unsigned char* ws = WSP; int bid = blockIdx.x; asm volatile("" : "+s"(bid)); int G = gridDim.x; asm volatile("" : "+s"(G)); \
    const int tid = opq_tid(), lane = tid & 63, wave = __builtin_amdgcn_readfirstlane(tid >> 6); const int gw = bid * 8 + wave, ngw = G * 8; (void)ws; (void)lane; (void)gw; (void)ngw;
#ifndef REP_ALL
#define REP_ALL 1
#endif
#pragma unroll 1
    for (int ll = 0; ll < 2 * REP_ALL; ++ll) {
        const int l = ll & 1;
        REPEAT(REP_P0) {
            PHASE_VARS
#ifndef NO_CVT
            Ptrs P; P.mix_g = INP(1) + l * DM; P.ffn_g = INP(12) + l * DM;
            P.w_in = INP(2) + (size_t)l * DM * DIN; P.qn = INP(3) + l * 64; P.kn = INP(4) + l * 64; P.pool_w = INP(5) + l * 4 * 64 * 64; P.pool_scale = INP(6) + l * 256;
            P.gm_norm = INP(7) + l * 256; P.gm_ws = INP(8) + l * 4 * 128 * 128; P.gm_b = INP(9) + l * 4 * 128; P.w_branch = INP(10) + (size_t)l * 4 * 256 * 1024;
            P.w_out = INP(11) + (size_t)l * 1024 * 1024; P.w_gate = INP(13) + (size_t)l * DM * DFF; P.w_up = INP(14) + (size_t)l * DM * DFF; P.w_down = INP(15) + (size_t)l * DFF * DM;
            convert_weights(P, ws, (LAS float*)(ldsl + wave * 8448), gw, ngw, lane, bid * 512 + tid, G * 512);
#endif
            if (l == 0) x_to_bf16_ss(INP(0), WSB(bf16_t, WS_XN), WSB(float, WS_SS0), gw, ngw, lane);
        }
        GSYNC();
        REPEAT(REP_P1) {
            PHASE_VARS
            pg8::Gemm g{WSB(bf16_t, WS_XN), WSB(bf16_t, WS_WIN), M_, NINP, DM}; pg8::StaticOrder S; S.init(M_, NINP, G, bid);
            EpiIn E{ws, INP(3) + l * 64, INP(4) + l * 64, WSB(float, WS_SS0)};
#ifndef NO_G1
            pg8::gemm_phase<EpiIn, pg8::StaticOrder, true, true>(ldsl, g, S, E);
#endif
        }
        GSYNC();
        REPEAT(REP_A1) {
            PHASE_VARS
            for (int i = bid * 512 + tid; i < M_; i += G * 512) { WSB(float, WS_SS0)[i] = 0.f; WSB(float, WS_SS1)[i] = 0.f; }
#ifndef NO_A1
            phase_a1(lds, WSB(bf16_t, WS_IQ), WSB(bf16_t, WS_IK), WSB(float, WS_IW), WSB(unsigned short, WS_MASK), tid, bid, G);
#endif
            __syncthreads();
        }
        REPEAT(REP_BCD) {
        REPEAT(REP_C) {
            PHASE_VARS
#ifndef NO_C
            phase_c(lds, WSB(bf16_t, WS_GV), WSB(bf16_t, WS_GU), WSB(bf16_t, WS_OCAT) + 512, INP(7) + l * 256, WSB(bf16_t, WS_WS), INP(9) + l * 4 * 128, tid, bid, G);
#endif
        }
        REPEAT(REP_B) {
            PHASE_VARS
#ifndef NO_B
            phase_b(WSB(bf16_t, WS_PIN), WSB(bf16_t, WS_WP), INP(6) + l * 256, WSB(bf16_t, WS_OCAT) + 256, gw, ngw, lane);
#endif
        }
        REPEAT(REP_D) {
            PHASE_VARS
#ifndef NO_D
            phase_d(WSB(bf16_t, WS_SQ), WSB(bf16_t, WS_OCAT) + 768, WSB(bf16_t, WS_SK), WSB(bf16_t, WS_VTS), gw, ngw, lane);
#endif
        }
        }
        GSYNC();
        REPEAT(REP_A2) {
            PHASE_VARS
#ifndef NO_A2
            phase_a2(lds, WSB(bf16_t, WS_QA), WSB(bf16_t, WS_OCAT), WSB(bf16_t, WS_KA), WSB(bf16_t, WS_VTA), WSB(unsigned short, WS_MASK), INP(3) + l * 64, INP(4) + l * 64, tid, bid, G);
#endif
        }
        GSYNC();
        REPEAT(REP_MG) {
            PHASE_VARS
            pg8::Gemm g{WSB(bf16_t, WS_OCAT), WSB(bf16_t, WS_WB), M_, DM, DM}; pg8::StaticOrder S; S.init(M_, DM, G, bid);
            EpiMerge E{ws + WS_G, WSB(bf16_t, WS_XN)};
#ifndef NO_G2
            pg8::gemm_phase<EpiMerge, pg8::StaticOrder, true, true>(ldsl, g, S, E);
#endif
        }
        GSYNC();
        REPEAT(REP_WO) {
            PHASE_VARS
            pg8::Gemm g{WSB(bf16_t, WS_XN), WSB(bf16_t, WS_WOUT), M_, DM, DM}; pg8::StaticOrder S; S.init(M_, DM, G, bid);
            EpiResid E{l == 0 ? INP(0) : OUTP, OUTP, WSB(bf16_t, WS_S), WSB(float, WS_SS1), 1};
#ifndef NO_G3
            pg8::gemm_phase<EpiResid, pg8::StaticOrder, true, true>(ldsl, g, S, E);
#endif
        }
        GSYNC();
        REPEAT(REP_UP) {
            PHASE_VARS
            pg8::Gemm g{WSB(bf16_t, WS_S), WSB(bf16_t, WS_WGU), M_, 2 * DFF, DM}; pg8::StaticOrder S; S.init(M_, 2 * DFF, G, bid);
            EpiSwiGLU E{WSB(bf16_t, WS_R1), WSB(float, WS_SS1)};
#ifndef NO_G4
            pg8::gemm_phase<EpiSwiGLU, pg8::StaticOrder, true, true>(ldsl, g, S, E);
#endif
        }
        GSYNC();
        REPEAT(REP_DN) {
            PHASE_VARS
            pg8::Gemm g{WSB(bf16_t, WS_R1), WSB(bf16_t, WS_WD), M_, DM, DFF}; pg8::StaticOrder S; S.init(M_, DM, G, bid);
            float* o = OUTP; EpiResid E{o, o, WSB(bf16_t, WS_XN), WSB(float, WS_SS0), l == 0 ? 1 : 0};
#ifndef NO_G3
            pg8::gemm_phase<EpiResid, pg8::StaticOrder, true, true>(ldsl, g, S, E);
#endif
        }
        if (ll + 1 < 2 * REP_ALL) GSYNC();
    }
}

extern "C" void kernel_launch(void* const* d_in, const int* in_sizes, int n_in, void* d_out, int out_size, void* d_ws, size_t ws_size, hipStream_t stream) {
    static int grid_blocks = 0;
    if (grid_blocks == 0) {
        if (n_in != 16 || out_size != M_ * DM || ws_size < WS_END) { fprintf(stderr, "kernel_launch: unexpected shapes (n_in %d out %d ws %zu)\n", n_in, out_size, ws_size); grid_blocks = -1; return; }
        int dev = 0, cus = 0, per_cu = 0;
        hipGetDevice(&dev);
        hipDeviceGetAttribute(&cus, hipDeviceAttributeMultiprocessorCount, dev);
        hipFuncSetAttribute((const void*)fwd_kernel, hipFuncAttributeMaxDynamicSharedMemorySize, LDS_BYTES);
        if (hipOccupancyMaxActiveBlocksPerMultiprocessor(&per_cu, (const void*)fwd_kernel, 512, LDS_BYTES) != hipSuccess || per_cu < 1) per_cu = 1;
        (void)hipGetLastError();
        grid_blocks = cus;
    }
    if (grid_blocks < 0) return;
    Args a{};
    for (int i = 0; i < 16; ++i) a.in[i] = (const float*)d_in[i];
    a.out = (float*)d_out; a.ws = (unsigned char*)d_ws;
    if (hipMemsetAsync(d_ws, 0, 65536, stream) != hipSuccess) { fprintf(stderr, "kernel_launch: memset failed\n"); return; }
    void* args[] = {&a};
    hipError_t e = hipLaunchCooperativeKernel((const void*)fwd_kernel, dim3(grid_blocks), dim3(512), args, LDS_BYTES, stream);
    if (e != hipSuccess) fprintf(stderr, "cooperative launch failed: %s (grid %d)\n", hipGetErrorString(e), grid_blocks);
}
```

```cpp
#include <hip/hip_runtime.h>
#include <hip/hip_cooperative_groups.h>
#include <cstdio>
#include <cstdint>
namespace pg8 {
#define PG8_LAS __attribute__((address_space(3)))
typedef unsigned short bf16_t;
typedef short bf16x8 __attribute__((ext_vector_type(8)));
typedef float f32x4 __attribute__((ext_vector_type(4)));
typedef unsigned u32x4 __attribute__((ext_vector_type(4)));
constexpr int BM = 256, BK = 64, HALF = 128, HTB = HALF * BK * 2  , STAGE_BYTES = 8 * HTB, NXCD = 8, WGM = 8;

__host__ __device__ __forceinline__ int lds_byte(int r, int c) { const int st = (r >> 4) * 2 + (c >> 5), rr = r & 15, cc = c & 31, ob = rr * 64 + cc * 2; return st * 1024 + (ob ^ (((ob >> 9) & 1) << 5)); }
__host__ __device__ __forceinline__ void stage_rc(int b, int& R, int& C) { const int st = b / 1024, sb = b % 1024, swz = sb ^ (((sb >> 9) & 1) << 5); R = (st >> 1) * 16 + swz / 64; C = (st & 1) * 32 + (swz % 64) / 2; }
__host__ __device__ __forceinline__ int perm32(int rho) { const int n = rho >> 4, i = rho & 15; return 8 * (i >> 2) + 4 * n + (i & 3); }

struct Unit { int pm, pn; };
struct Gemm { const bf16_t* A; const bf16_t* Bt; int M, N, K; };

struct StaticOrder {
    int nM, nN, nwg, G, c;
    __host__ __device__ void init(int M, int N, int G_, int c_) { nM = M / BM; nN = N / BM; nwg = nM * nN; G = G_; c = c_; }
    __host__ __device__ bool next(int i, Unit& u) const {
        const long L = (long)i * G + c; if (L >= nwg) return false;
        int wgid = (int)L; { const int q = nwg / NXCD, r = nwg % NXCD, xcd = wgid % NXCD, off = wgid / NXCD; wgid = (xcd < r ? xcd * (q + 1) : r * (q + 1) + (xcd - r) * q) + off; }
        const int nig = WGM * nN, gid = wgid / nig, fm = gid * WGM, gsz = (nM - fm) < WGM ? (nM - fm) : WGM;
        u.pm = fm + ((wgid % nig) % gsz); u.pn = (wgid % nig) / gsz; return true;
    }
    __device__ __forceinline__ void a_ready(const Unit&) const {}
    __device__ __forceinline__ void done(const Unit&) const {}
};

__device__ __forceinline__ unsigned cvt_pk_bf16(float lo, float hi) { unsigned r; asm volatile("v_cvt_pk_bf16_f32 %0, %1, %2" : "=v"(r) : "v"(lo), "v"(hi)); return r; }
template <class Epi, class Sched, bool ALIGN_EPI = false, bool SP2 = false>
__device__ __forceinline__ void gemm_phase(PG8_LAS unsigned char* lds, const Gemm g, const Sched& S, const Epi& E) {
    int tid_ = threadIdx.x; asm volatile("" : "+v"(tid_)); const int tid = tid_, wid = __builtin_amdgcn_readfirstlane(tid >> 6), lane = tid & 63, wr = wid >> 2, wc = wid & 3, fr = lane & 15, fq = lane >> 4;
    const int K = g.K, nt = K / BK;
    unsigned voffA[2], voffB[2];
#pragma unroll
    for (int i = 0; i < 2; ++i) { int R, C; stage_rc(tid * 16 + i * 8192, R, C); const int Rb = Epi::PERM ? ((R & ~31) + perm32(R & 31)) : R;
        voffA[i] = (unsigned)(R * K + C) * 2u; voffB[i] = (unsigned)(Rb * K + C) * 2u; }
    const size_t kstep = (size_t)(BK * 2);
    const size_t hstep = (size_t)HALF * K * 2;
    const size_t tstep = 2 * hstep;
    const unsigned ldsw = (unsigned)wid * 1024u;
    const int aoff = lds_byte(wr * 64 + fr, fq * 8), boff = lds_byte(wc * 32 + fr, fq * 8);
#define PG8_SA(b, h) (((b) * 2 + (h)) * HTB)
#define PG8_SB(b, h) ((4 + (b) * 2 + (h)) * HTB)
#define PG8_STAGE(bufoff, gbase, voff) do { _Pragma("unroll") for (int _i = 0; _i < 2; ++_i) \
        __builtin_amdgcn_global_load_lds((const unsigned*)((const char*)(gbase) + (voff)[_i]), (PG8_LAS unsigned*)(lds + (bufoff) + ldsw + _i * 8192), 16, 0, 0); } while (0)
#define PG8_LDA(dst, b, h) do { _Pragma("unroll") for (int m = 0; m < 4; ++m) _Pragma("unroll") for (int k = 0; k < 2; ++k) dst[m][k] = *(const PG8_LAS bf16x8*)(lds + PG8_SA(b, h) + aoff + m * 2048 + k * 1024); } while (0)
#define PG8_LDB(dst, b, h) do { _Pragma("unroll") for (int n = 0; n < 2; ++n) _Pragma("unroll") for (int k = 0; k < 2; ++k) dst[n][k] = *(const PG8_LAS bf16x8*)(lds + PG8_SB(b, h) + boff + n * 2048 + k * 1024); } while (0)
#define PG8_MMA(ai, bj, At, Bt) do { __builtin_amdgcn_s_setprio(1); _Pragma("unroll") for (int m = 0; m < 4; ++m) _Pragma("unroll") for (int n = 0; n < 2; ++n) _Pragma("unroll") for (int k = 0; k < 2; ++k) \
        acc[ai][bj][m][n] = __builtin_amdgcn_mfma_f32_16x16x32_bf16(Bt[n][k], At[m][k], acc[ai][bj][m][n], 0, 0, 0); __builtin_amdgcn_s_setprio(0); } while (0)
#define PG8_WAIT_V(n) asm volatile("s_waitcnt vmcnt(" #n ")" ::: "memory")
#define PG8_WAIT_L(n) asm volatile("s_waitcnt lgkmcnt(" #n ")" ::: "memory")
#define PG8_BAR __builtin_amdgcn_s_barrier()
#define PG8_SCHED __builtin_amdgcn_sched_barrier(0)
    Unit cur, nxt; int ui = 0;
    if (!S.next(0, cur)) return;
    f32x4 acc[2][2][4][2];
#pragma unroll
    for (int a = 0; a < 2; ++a)
#pragma unroll
        for (int b = 0; b < 2; ++b)
#pragma unroll
            for (int m = 0; m < 4; ++m)
#pragma unroll
                for (int n = 0; n < 2; ++n) acc[a][b][m][n] = (f32x4){0.f, 0.f, 0.f, 0.f};
    bf16x8 At[4][2], B0[2][2], B1[2][2];
    const char* cA = (const char*)g.A + (size_t)cur.pm * tstep; const char* cB = (const char*)g.Bt + (size_t)cur.pn * tstep;
    S.a_ready(cur);
    if constexpr (SP2) {
        PG8_STAGE(PG8_SB(0, 0), cB, voffB); PG8_STAGE(PG8_SB(0, 1), cB + hstep, voffB); PG8_STAGE(PG8_SA(0, 0), cA, voffA); PG8_STAGE(PG8_SA(0, 1), cA + hstep, voffA);
        if (wr == 1) PG8_BAR;
        PG8_WAIT_V(2); PG8_BAR;
        PG8_STAGE(PG8_SB(1, 0), cB + kstep, voffB); PG8_STAGE(PG8_SA(1, 0), cA + kstep, voffA); PG8_STAGE(PG8_SB(1, 1), cB + hstep + kstep, voffB);
        PG8_WAIT_V(6); PG8_BAR;
    } else {
        PG8_STAGE(PG8_SB(0, 0), cB, voffB); PG8_STAGE(PG8_SA(0, 0), cA, voffA); PG8_STAGE(PG8_SB(0, 1), cB + hstep, voffB); PG8_STAGE(PG8_SA(0, 1), cA + hstep, voffA);
        if (wr == 1) PG8_BAR;
        PG8_WAIT_V(4); PG8_BAR;
        PG8_STAGE(PG8_SB(1, 0), cB + kstep, voffB); PG8_STAGE(PG8_SA(1, 0), cA + kstep, voffA); PG8_STAGE(PG8_SB(1, 1), cB + hstep + kstep, voffB);
        PG8_WAIT_V(6); PG8_BAR;
    }
    for (;;) {
        const bool has_next = S.next(ui + 1, nxt);
        const char* nA = has_next ? (const char*)g.A + (size_t)nxt.pm * tstep : cA; const char* nB = has_next ? (const char*)g.Bt + (size_t)nxt.pn * tstep : cB;
        for (int t = 0; t < nt; t += 2) {
            if constexpr (Epi::HOOK) { if (t != 0 && (t & 3) == 0) E.hook(acc, cur, (t >> 2) - 1, wr, wc, fr, fq); }
            const bool last = (t == nt - 2);
            const char* a1 = cA + (size_t)(t + 1) * kstep;
            const char* a2 = last ? nA : cA + (size_t)(t + 2) * kstep; const char* b2 = last ? nB : cB + (size_t)(t + 2) * kstep;
            const char* a3 = a2 + kstep; const char* b3 = b2 + kstep;
            if (last && has_next) S.a_ready(nxt);
            if constexpr (SP2) {
            PG8_LDB(B0, 0, 0); PG8_LDB(B1, 0, 1); PG8_SCHED; PG8_LDA(At, 0, 0); PG8_STAGE(PG8_SA(1, 1), a1 + hstep, voffA);
            PG8_WAIT_V(8); PG8_WAIT_L(0); PG8_BAR; PG8_MMA(0, 0, At, B0); PG8_MMA(0, 1, At, B1); PG8_BAR; PG8_SCHED;
            PG8_LDA(At, 0, 1); PG8_STAGE(PG8_SB(0, 0), b2, voffB); PG8_STAGE(PG8_SB(0, 1), b2 + hstep, voffB); PG8_STAGE(PG8_SA(0, 0), a2, voffA);
            PG8_WAIT_V(8); PG8_WAIT_L(0); PG8_BAR; PG8_MMA(1, 0, At, B0); PG8_MMA(1, 1, At, B1); PG8_BAR; PG8_SCHED;
            PG8_LDB(B0, 1, 0); PG8_LDB(B1, 1, 1); PG8_SCHED; PG8_LDA(At, 1, 0); PG8_STAGE(PG8_SA(0, 1), a2 + hstep, voffA);
            PG8_WAIT_V(8); PG8_WAIT_L(0); PG8_BAR; PG8_MMA(0, 0, At, B0); PG8_MMA(0, 1, At, B1); PG8_BAR; PG8_SCHED;
            PG8_LDA(At, 1, 1); PG8_STAGE(PG8_SB(1, 0), b3, voffB); PG8_STAGE(PG8_SB(1, 1), b3 + hstep, voffB); PG8_STAGE(PG8_SA(1, 0), a3, voffA);
            PG8_WAIT_V(8); PG8_WAIT_L(0); PG8_BAR; PG8_MMA(1, 0, At, B0); PG8_MMA(1, 1, At, B1); PG8_BAR; PG8_SCHED;
            } else {
            PG8_LDB(B0, 0, 0); PG8_SCHED; PG8_LDA(At, 0, 0); PG8_STAGE(PG8_SA(1, 1), a1 + hstep, voffA);
            PG8_WAIT_L(8); PG8_BAR; PG8_WAIT_L(0); PG8_MMA(0, 0, At, B0); PG8_BAR; PG8_SCHED;
            PG8_LDB(B1, 0, 1); PG8_STAGE(PG8_SB(0, 0), b2, voffB);
            PG8_BAR; PG8_WAIT_L(0); PG8_MMA(0, 1, At, B1); PG8_BAR;
            PG8_LDA(At, 0, 1); PG8_STAGE(PG8_SA(0, 0), a2, voffA);
            PG8_BAR; PG8_WAIT_L(0); PG8_MMA(1, 0, At, B0); PG8_BAR; PG8_SCHED;
            PG8_STAGE(PG8_SB(0, 1), b2 + hstep, voffB);
            PG8_WAIT_V(6); PG8_BAR; PG8_MMA(1, 1, At, B1); PG8_BAR;
            PG8_LDB(B0, 1, 0); PG8_SCHED; PG8_LDA(At, 1, 0); PG8_STAGE(PG8_SA(0, 1), a2 + hstep, voffA);
            PG8_WAIT_L(8); PG8_BAR; PG8_WAIT_L(0); PG8_MMA(0, 0, At, B0); PG8_BAR; PG8_SCHED;
            PG8_LDB(B1, 1, 1); PG8_STAGE(PG8_SB(1, 0), b3, voffB);
            PG8_BAR; PG8_WAIT_L(0); PG8_MMA(0, 1, At, B1); PG8_BAR;
            PG8_LDA(At, 1, 1); PG8_STAGE(PG8_SA(1, 0), a3, voffA);
            PG8_BAR; PG8_WAIT_L(0); PG8_MMA(1, 0, At, B0); PG8_BAR; PG8_SCHED;
            PG8_STAGE(PG8_SB(1, 1), b3 + hstep, voffB);
            PG8_WAIT_V(6); PG8_BAR; PG8_MMA(1, 1, At, B1); PG8_BAR;
            }
        }
        if constexpr (ALIGN_EPI) { if (wr == 0) PG8_BAR; }
        if constexpr (!Epi::AFTER_DRAIN) { E(acc, cur, wr, wc, fr, fq); S.done(cur); }
        if (!has_next) break;
#pragma unroll
        for (int a = 0; a < 2; ++a)
#pragma unroll
            for (int b = 0; b < 2; ++b)
#pragma unroll
                for (int m = 0; m < 4; ++m)
#pragma unroll
                    for (int n = 0; n < 2; ++n) acc[a][b][m][n] = (f32x4){0.f, 0.f, 0.f, 0.f};
        cur = nxt; cA = nA; cB = nB; ++ui;
        if constexpr (ALIGN_EPI) { if (wr == 1) PG8_BAR; }
    }
    PG8_WAIT_V(0);
    if constexpr (!ALIGN_EPI) { if (wr == 0) PG8_BAR; }
    PG8_BAR;
    if constexpr (Epi::AFTER_DRAIN) { E.fused(acc, cur, wr, wc, fr, fq, lds, wid, lane); S.done(cur); }
#undef PG8_SA
#undef PG8_SB
#undef PG8_STAGE
#undef PG8_LDA
#undef PG8_LDB
#undef PG8_MMA
#undef PG8_WAIT_V
#undef PG8_WAIT_L
#undef PG8_BAR
#undef PG8_SCHED
}
}
namespace cg = cooperative_groups;
using pg8::bf16_t; using pg8::bf16x8; using pg8::f32x4; using pg8::u32x4; using pg8::Unit; using pg8::cvt_pk_bf16;
typedef unsigned u32x2 __attribute__((ext_vector_type(2)));
#define LAS __attribute__((address_space(3)))
#define LDS_WAIT() asm volatile("s_waitcnt lgkmcnt(0)" ::: "memory")

constexpr int M_ = 16384, DM = 1024, SEQ = 4096, DFF = 2816, DIN = 6696, NINP = 6912;
constexpr float EPSN = 1e-6f;
constexpr float LOG2E = 1.4426950408889634f, LN2 = 0.6931471805599453f;
constexpr float C2 = 0.125f * LOG2E;

constexpr size_t MiB = (size_t)1 << 20;
constexpr size_t WS_SS0 = 128 * 1024, WS_SS1 = 256 * 1024;
constexpr size_t WS_WIN = 1 * MiB;
constexpr size_t WS_WB = WS_WIN + (size_t)NINP * 1024 * 2;
constexpr size_t WS_WOUT = WS_WB + 2 * MiB;
constexpr size_t WS_WGU = WS_WOUT + 2 * MiB;
constexpr size_t WS_WD = WS_WGU + 11 * MiB;
constexpr size_t WS_WP = WS_WD + (size_t)1024 * 2816 * 2;
constexpr size_t WS_WS = WS_WP + 32768;
static_assert(WS_WS + 131072 <= 36 * MiB, "weights region");
constexpr size_t WS_XN = 36 * MiB;
constexpr size_t WS_R1 = 68 * MiB;
constexpr size_t WS_G = WS_R1, WS_KA = WS_R1 + 64 * MiB, WS_VTA = WS_KA + 8 * MiB, WS_IQ = WS_VTA + 8 * MiB;
constexpr size_t WS_S = 156 * MiB;
constexpr size_t WS_PIN = WS_S, WS_GU = WS_S + 8 * MiB, WS_GV = WS_S + 16 * MiB, WS_SQ = WS_S + 24 * MiB, WS_SK = WS_S + 32 * MiB,
                 WS_VTS = WS_S + 40 * MiB, WS_QA = WS_S + 48 * MiB, WS_MASK = WS_S + 56 * MiB, WS_IK = 220 * MiB, WS_IW = 221 * MiB, WS_OCAT = 222 * MiB  , WS_END = 254 * MiB;

__device__ __forceinline__ float bf2f(unsigned short v) { return __uint_as_float((unsigned)v << 16); }
__device__ __forceinline__ float bflo(unsigned v) { return __uint_as_float(v << 16); }
__device__ __forceinline__ float bfhi(unsigned v) { return __uint_as_float(v & 0xffff0000u); }
__device__ __forceinline__ unsigned short f2bf(float f) { return (unsigned short)(cvt_pk_bf16(f, 0.f) & 0xffffu); }
__device__ __forceinline__ float sigmoidf_(float x) { return __builtin_amdgcn_rcpf(1.f + __builtin_amdgcn_exp2f(-x * LOG2E)); }
__device__ __forceinline__ float gelu_tanh(float x) { const float u = 0.7978845608028654f * (x + 0.044715f * x * x * x); return x * __builtin_amdgcn_rcpf(1.f + __builtin_amdgcn_exp2f(-2.f * LOG2E * u)); }
__device__ __forceinline__ f32x4 mfma16(bf16x8 a, bf16x8 b, f32x4 c) { return __builtin_amdgcn_mfma_f32_16x16x32_bf16(a, b, c, 0, 0, 0); }
__device__ __forceinline__ bf16x8 mk8(unsigned a, unsigned b, unsigned c, unsigned d) { u32x4 v = {a, b, c, d}; return __builtin_bit_cast(bf16x8, v); }

struct EpiIn {
    static constexpr bool PERM = true, AFTER_DRAIN = false, HOOK = false;
    unsigned char* ws; const float *qn, *kn; const float* SS;
    __device__ __forceinline__ void operator()(const f32x4 (&acc)[2][2][4][2], const Unit& u, int wr, int wc, int fr, int fq) const {
        bf16_t* const QA = (bf16_t*)(ws + WS_QA); bf16_t* const KA = (bf16_t*)(ws + WS_KA); bf16_t* const VTA = (bf16_t*)(ws + WS_VTA); bf16_t* const IQ = (bf16_t*)(ws + WS_IQ);
        bf16_t* const PIN = (bf16_t*)(ws + WS_PIN); bf16_t* const GU = (bf16_t*)(ws + WS_GU); bf16_t* const GV = (bf16_t*)(ws + WS_GV); bf16_t* const SQ = (bf16_t*)(ws + WS_SQ);
        bf16_t* const SK = (bf16_t*)(ws + WS_SK); bf16_t* const VTS = (bf16_t*)(ws + WS_VTS); bf16_t* const IK = (bf16_t*)(ws + WS_IK); float* const IW = (float*)(ws + WS_IW); unsigned char* const G = ws + WS_G;
        const int pn = u.pn; const int row0 = u.pm * 256 + wr * 64 + fr; const int cl = wc * 32 + 8 * fq;
        float rr[2][4];
#pragma unroll
        for (int ai = 0; ai < 2; ++ai)
#pragma unroll
            for (int m = 0; m < 4; ++m) rr[ai][m] = __builtin_amdgcn_rsqf(SS[row0 + ai * 128 + m * 16] * (1.f / 1024.f) + EPSN);
        if (pn >= 11) {
            unsigned char* gp = G + (size_t)row0 * 4096 + (pn - 11) * 256 + cl;
#pragma unroll
            for (int ai = 0; ai < 2; ++ai)
#pragma unroll
                for (int m = 0; m < 4; ++m)
#pragma unroll
                    for (int bj = 0; bj < 2; ++bj) {
                        unsigned w2[2];
#pragma unroll
                        for (int n = 0; n < 2; ++n) { const f32x4 v = (acc[ai][bj][m][n] * rr[ai][m]); unsigned pk = 0;
#pragma unroll
                            for (int i = 0; i < 4; ++i) { const unsigned qv = (unsigned)(sigmoidf_(v[i]) * 255.f + 0.5f); pk |= qv << (8 * i); }
                            w2[n] = pk; }
                        *(u32x2*)(gp + (size_t)(ai * 128 + m * 16) * 4096 + bj * 128) = (u32x2){w2[0], w2[1]};
                    }
            return;
        }
        if (pn <= 1) {
            const float* gw = pn == 0 ? qn : kn; const float sc = pn == 0 ? C2 : 1.f; bf16_t* T = pn == 0 ? QA : KA;
            f32x4 gv[2][2];
#pragma unroll
            for (int bj = 0; bj < 2; ++bj)
#pragma unroll
                for (int n = 0; n < 2; ++n) gv[bj][n] = *(const f32x4*)(gw + bj * 32 + 8 * fq + 4 * n);
#pragma unroll
            for (int ai = 0; ai < 2; ++ai)
#pragma unroll
                for (int m = 0; m < 4; ++m) {
                    float ss = 0.f;
#pragma unroll
                    for (int bj = 0; bj < 2; ++bj)
#pragma unroll
                        for (int n = 0; n < 2; ++n) { const f32x4 v = (acc[ai][bj][m][n] * rr[ai][m]); ss += (v[0] * v[0] + v[1] * v[1]) + (v[2] * v[2] + v[3] * v[3]); }
                    ss += __shfl_xor(ss, 16); ss += __shfl_xor(ss, 32);
                    const float rinv = __builtin_amdgcn_rsqf(ss * (1.f / 64.f) + EPSN) * sc;
                    bf16_t* rp = T + (size_t)(row0 + ai * 128 + m * 16) * 256 + wc * 64 + 8 * fq;
#pragma unroll
                    for (int bj = 0; bj < 2; ++bj) { const f32x4 v0 = (acc[ai][bj][m][0] * rr[ai][m]) * gv[bj][0] * rinv, v1 = (acc[ai][bj][m][1] * rr[ai][m]) * gv[bj][1] * rinv;
                        u32x4 w; w.x = cvt_pk_bf16(v0[0], v0[1]); w.y = cvt_pk_bf16(v0[2], v0[3]); w.z = cvt_pk_bf16(v1[0], v1[1]); w.w = cvt_pk_bf16(v1[2], v1[3]);
                        *(u32x4*)(rp + bj * 32) = w; }
                }
            return;
        }
        if (pn == 2 || pn == 9) {
            bf16_t* T = pn == 2 ? VTA : VTS;
#pragma unroll
            for (int ai = 0; ai < 2; ++ai)
#pragma unroll
                for (int m = 0; m < 4; ++m) { const int row = row0 + ai * 128 + m * 16; const int b = row >> 12, t = row & 4095;
#pragma unroll
                    for (int bj = 0; bj < 2; ++bj)
#pragma unroll
                        for (int n = 0; n < 2; ++n) { const f32x4 v = (acc[ai][bj][m][n] * rr[ai][m]);
#pragma unroll
                            for (int i = 0; i < 4; ++i) T[((size_t)b * 256 + bj * 128 + cl + 4 * n + i) * 4096 + t] = f2bf(v[i]); }
                }
            return;
        }
        if (pn == 10) {
            if (wc == 0) {
#pragma unroll
                for (int ai = 0; ai < 2; ++ai)
#pragma unroll
                    for (int m = 0; m < 4; ++m) { const f32x4 v0 = (acc[ai][0][m][0] * rr[ai][m]), v1 = (acc[ai][0][m][1] * rr[ai][m]);
                        u32x4 w; w.x = cvt_pk_bf16(v0[0], v0[1]); w.y = cvt_pk_bf16(v0[2], v0[3]); w.z = cvt_pk_bf16(v1[0], v1[1]); w.w = cvt_pk_bf16(v1[2], v1[3]);
                        *(u32x4*)(IK + (size_t)(row0 + ai * 128 + m * 16) * 32 + 8 * fq) = w; }
            } else if (wc == 1 && fq == 0) {
#pragma unroll
                for (int ai = 0; ai < 2; ++ai)
#pragma unroll
                    for (int m = 0; m < 4; ++m) { float* p = IW + (size_t)(row0 + ai * 128 + m * 16) * 8; *(f32x4*)p = (acc[ai][0][m][0] * rr[ai][m]); *(f32x4*)(p + 4) = (acc[ai][0][m][1] * rr[ai][m]); }
            }
            return;
        }
        {
            bf16_t* T = pn == 3 ? IQ : pn == 4 ? PIN : pn == 5 ? GU : pn == 6 ? GV : pn == 7 ? SQ : SK;
            const bool act = (pn == 5 || pn == 6); const float sc = pn == 7 ? 0.125f : 1.f;
#pragma unroll
            for (int ai = 0; ai < 2; ++ai)
#pragma unroll
                for (int m = 0; m < 4; ++m) { bf16_t* rp = T + (size_t)(row0 + ai * 128 + m * 16) * 256 + cl;
#pragma unroll
                    for (int bj = 0; bj < 2; ++bj) { f32x4 v0 = (acc[ai][bj][m][0] * rr[ai][m]) * sc, v1 = (acc[ai][bj][m][1] * rr[ai][m]) * sc;
                        if (act) {
#pragma unroll
                            for (int i = 0; i < 4; ++i) { v0[i] = gelu_tanh(v0[i]); v1[i] = gelu_tanh(v1[i]); } }
                        u32x4 w; w.x = cvt_pk_bf16(v0[0], v0[1]); w.y = cvt_pk_bf16(v0[2], v0[3]); w.z = cvt_pk_bf16(v1[0], v1[1]); w.w = cvt_pk_bf16(v1[2], v1[3]);
                        *(u32x4*)(rp + bj * 128) = w; }
                }
        }
    }
};

struct EpiMerge {
    static constexpr bool PERM = true, AFTER_DRAIN = false, HOOK = true;
    const unsigned char* G; bf16_t* MG;
    __device__ __forceinline__ void hook(f32x4 (&acc)[2][2][4][2], const Unit& u, int s, int wr, int wc, int fr, int fq) const {
        const int row0 = u.pm * 256 + wr * 64 + fr; const int col0 = u.pn * 256 + wc * 32 + 8 * fq;
        const unsigned char* gp0 = G + (size_t)row0 * 4096 + s * 1024 + col0;
#pragma unroll
        for (int ai = 0; ai < 2; ++ai)
#pragma unroll
            for (int m = 0; m < 4; ++m) {
#pragma unroll
                for (int bj = 0; bj < 2; ++bj) { const unsigned char* gp = gp0 + (size_t)(ai * 128 + m * 16) * 4096 + bj * 128;
                    const u32x2 ga = *(const u32x2*)gp, gb = *(const u32x2*)(gp + 1024);
#pragma unroll
                    for (int i = 0; i < 4; ++i) {
                        const float a0 = fmaxf((float)((ga.x >> (8 * i)) & 255u), 1.f), b0 = fmaxf((float)((gb.x >> (8 * i)) & 255u), 1.f);
                        const float a1 = fmaxf((float)((ga.y >> (8 * i)) & 255u), 1.f), b1 = fmaxf((float)((gb.y >> (8 * i)) & 255u), 1.f);
                        acc[ai][bj][m][0][i] *= a0 * __builtin_amdgcn_rcpf(b0); acc[ai][bj][m][1][i] *= a1 * __builtin_amdgcn_rcpf(b1); }
                }
                asm volatile("" ::: "memory"); }
    }
    __device__ __forceinline__ void operator()(const f32x4 (&acc)[2][2][4][2], const Unit& u, int wr, int wc, int fr, int fq) const {
        const int row0 = u.pm * 256 + wr * 64 + fr; const int col0 = u.pn * 256 + wc * 32 + 8 * fq;
        const unsigned char* gp0 = G + (size_t)row0 * 4096 + 3 * 1024 + col0; bf16_t* mp0 = MG + (size_t)row0 * 1024 + col0;
#pragma unroll
        for (int ai = 0; ai < 2; ++ai)
#pragma unroll
            for (int m = 0; m < 4; ++m) {
#pragma unroll
                for (int bj = 0; bj < 2; ++bj) { const size_t ro = (size_t)(ai * 128 + m * 16);
                    const u32x2 gb = *(const u32x2*)(gp0 + ro * 4096 + bj * 128);
                    f32x4 v0 = acc[ai][bj][m][0], v1 = acc[ai][bj][m][1];
#pragma unroll
                    for (int i = 0; i < 4; ++i) { v0[i] *= fmaxf((float)((gb.x >> (8 * i)) & 255u), 1.f) * (1.f / 255.f); v1[i] *= fmaxf((float)((gb.y >> (8 * i)) & 255u), 1.f) * (1.f / 255.f); }
                    u32x4 w; w.x = cvt_pk_bf16(v0[0], v0[1]); w.y = cvt_pk_bf16(v0[2], v0[3]); w.z = cvt_pk_bf16(v1[0], v1[1]); w.w = cvt_pk_bf16(v1[2], v1[3]);
                    *(u32x4*)(mp0 + ro * 1024 + bj * 128) = w; }
                asm volatile("" ::: "memory"); }
    }
};

struct EpiResid {
    static constexpr bool PERM = true, AFTER_DRAIN = false, HOOK = false;
    const float* base; float* out; bf16_t* XB; float* SS; int stat;
    __device__ __forceinline__ void operator()(const f32x4 (&acc)[2][2][4][2], const Unit& u, int wr, int wc, int fr, int fq) const {
        const int row0 = u.pm * 256 + wr * 64 + fr; const int col0 = u.pn * 256 + wc * 32 + 8 * fq;
#pragma unroll
        for (int ai = 0; ai < 2; ++ai)
#pragma unroll
            for (int m = 0; m < 4; ++m) { const int row = row0 + ai * 128 + m * 16; const size_t off = (size_t)row * 1024 + col0; float ssum = 0.f;
#pragma unroll
                for (int bj = 0; bj < 2; ++bj) { const f32x4 b0 = *(const f32x4*)(base + off + bj * 128), b1 = *(const f32x4*)(base + off + bj * 128 + 4);
                    const f32x4 o0 = b0 + acc[ai][bj][m][0], o1 = b1 + acc[ai][bj][m][1];
                    *(f32x4*)(out + off + bj * 128) = o0; *(f32x4*)(out + off + bj * 128 + 4) = o1;
                    if (stat) { u32x4 w; w.x = cvt_pk_bf16(o0[0], o0[1]); w.y = cvt_pk_bf16(o0[2], o0[3]); w.z = cvt_pk_bf16(o1[0], o1[1]); w.w = cvt_pk_bf16(o1[2], o1[3]);
                        *(u32x4*)(XB + off + bj * 128) = w;
                        ssum += ((o0[0] * o0[0] + o0[1] * o0[1]) + (o0[2] * o0[2] + o0[3] * o0[3])) + ((o1[0] * o1[0] + o1[1] * o1[1]) + (o1[2] * o1[2] + o1[3] * o1[3])); } }
                if (stat) { ssum += __shfl_xor(ssum, 16); ssum += __shfl_xor(ssum, 32); if (fq == 0) atomicAdd(SS + row, ssum); }
                asm volatile("" ::: "memory"); }
    }
};

struct EpiSwiGLU {
    static constexpr bool PERM = true, AFTER_DRAIN = false, HOOK = false;
    bf16_t* ACT; const float* SS;
    __device__ __forceinline__ void operator()(const f32x4 (&acc)[2][2][4][2], const Unit& u, int wr, int wc, int fr, int fq) const {
        const int row0 = u.pm * 256 + wr * 64 + fr; const int f0 = u.pn * 128 + wc * 32 + 8 * fq;
#pragma unroll
        for (int ai = 0; ai < 2; ++ai)
#pragma unroll
            for (int m = 0; m < 4; ++m) { f32x4 r[2]; const float rs = __builtin_amdgcn_rsqf(SS[row0 + ai * 128 + m * 16] * (1.f / 1024.f) + EPSN);
#pragma unroll
                for (int n = 0; n < 2; ++n) { const f32x4 g = acc[ai][0][m][n] * rs, up = acc[ai][1][m][n] * rs;
#pragma unroll
                    for (int i = 0; i < 4; ++i) r[n][i] = g[i] * sigmoidf_(g[i]) * up[i]; }
                u32x4 w; w.x = cvt_pk_bf16(r[0][0], r[0][1]); w.y = cvt_pk_bf16(r[0][2], r[0][3]); w.z = cvt_pk_bf16(r[1][0], r[1][1]); w.w = cvt_pk_bf16(r[1][2], r[1][3]);
                *(u32x4*)(ACT + (size_t)(row0 + ai * 128 + m * 16) * DFF + f0) = w; }
    }
};

__device__ __forceinline__ void cvt_item(const float* src, int ld, int col0, int nvalid, int K, bf16_t* WT, int dst_row0, int kb, LAS float* scr, int lane, const float* rs = nullptr) {
    const int k0 = 64 * kb, c = lane & 31;
#pragma unroll 8
    for (int i = 0; i < 32; ++i) { const int kk = 2 * i + (lane >> 5); float v = 0.f; if (c < nvalid) v = src[(size_t)(k0 + kk) * ld + col0 + c]; if (rs) v *= rs[k0 + kk]; scr[kk * 33 + c] = v; }
    LDS_WAIT();
    const int c8 = lane & 7;
#pragma unroll
    for (int j = 0; j < 4; ++j) { const int n = (lane >> 3) + 8 * j; const LAS float* s = scr + (8 * c8) * 33 + n;
        u32x4 o; o.x = cvt_pk_bf16(s[0 * 33], s[1 * 33]); o.y = cvt_pk_bf16(s[2 * 33], s[3 * 33]); o.z = cvt_pk_bf16(s[4 * 33], s[5 * 33]); o.w = cvt_pk_bf16(s[6 * 33], s[7 * 33]);
        *(u32x4*)(WT + (size_t)(dst_row0 + n) * K + k0 + 8 * c8) = o; }
    LDS_WAIT();
}
__device__ __forceinline__ float wave_sum(float v) {
#pragma unroll
    for (int o = 1; o < 64; o <<= 1) v += __shfl_xor(v, o);
    return v;
}
__device__ __forceinline__ float wave_max(float v) {
#pragma unroll
    for (int o = 1; o < 64; o <<= 1) v = fmaxf(v, __shfl_xor(v, o));
    return v;
}
__device__ __forceinline__ void rmsnorm_rows(const float* xs, const float* gamma, bf16_t* XN, int gw, int ngw, int lane) {
    f32x4 gm[4];
#pragma unroll
    for (int j = 0; j < 4; ++j) gm[j] = *(const f32x4*)(gamma + 4 * lane + 256 * j);
    for (int m = gw; m < M_; m += ngw) {
        const f32x4* xr = (const f32x4*)(xs + (size_t)m * DM) + lane; f32x4 v[4]; float s = 0.f;
#pragma unroll
        for (int j = 0; j < 4; ++j) { v[j] = xr[64 * j]; s += (v[j].x * v[j].x + v[j].y * v[j].y) + (v[j].z * v[j].z + v[j].w * v[j].w); }
        const float r = __builtin_amdgcn_rsqf(wave_sum(s) * (1.f / DM) + EPSN);
        u32x2* o8 = (u32x2*)(XN + (size_t)m * DM) + lane;
#pragma unroll
        for (int j = 0; j < 4; ++j) { const f32x4 y = v[j] * r * gm[j]; o8[64 * j] = (u32x2){cvt_pk_bf16(y.x, y.y), cvt_pk_bf16(y.z, y.w)}; }
    }
}

__device__ __forceinline__ void x_to_bf16_ss(const float* xs, bf16_t* XN, float* SS, int gw, int ngw, int lane) {
    for (int m = gw; m < M_; m += ngw) {
        const f32x4* xr = (const f32x4*)(xs + (size_t)m * DM) + lane; f32x4 v[4]; float s = 0.f;
#pragma unroll
        for (int j = 0; j < 4; ++j) { v[j] = xr[64 * j]; s += (v[j].x * v[j].x + v[j].y * v[j].y) + (v[j].z * v[j].z + v[j].w * v[j].w); }
        s = wave_sum(s);
        u32x2* o8 = (u32x2*)(XN + (size_t)m * DM) + lane;
#pragma unroll
        for (int j = 0; j < 4; ++j) o8[64 * j] = (u32x2){cvt_pk_bf16(v[j].x, v[j].y), cvt_pk_bf16(v[j].z, v[j].w)};
        if (lane == 0) SS[m] = s;
    }
}
struct Ptrs {
    const float *mix_g, *ffn_g, *w_in, *qn, *kn, *pool_w, *pool_scale, *gm_norm, *gm_ws, *gm_b, *w_branch, *w_out, *w_gate, *w_up, *w_down;
};

__device__ __forceinline__ void convert_weights(const Ptrs& P, unsigned char* ws, LAS float* scr, int gw, int ngw, int lane, int gtid, int ngt) {
    bf16_t* WinT = (bf16_t*)(ws + WS_WIN); bf16_t* WbT = (bf16_t*)(ws + WS_WB); bf16_t* WoutT = (bf16_t*)(ws + WS_WOUT); bf16_t* WguT = (bf16_t*)(ws + WS_WGU);
    bf16_t* WdT = (bf16_t*)(ws + WS_WD); bf16_t* WpT = (bf16_t*)(ws + WS_WP); bf16_t* Wtril = (bf16_t*)(ws + WS_WS);
    constexpr int I_A = 216 * 16, I_B = 512, I_C = 512, I_D = 176 * 16, I_E = 32 * 44, I_F = 8, NIT = I_A + I_B + I_C + I_D + I_E + I_F;
    for (int it = gw; it < NIT; it += ngw) {
        int r = it;
        if (r < I_A) { const int rb = r >> 4, kb = r & 15, tile = rb >> 3, sub = rb & 7; int col0, nv = 32;
            if (tile <= 1) col0 = tile * 256 + (sub & 3) * 64 + (sub >> 2) * 32;
            else if (tile == 2) col0 = 512 + sub * 32;
            else if (tile == 3) col0 = 768 + sub * 32;
            else if (tile <= 9) col0 = 1064 + (tile - 4) * 256 + sub * 32;
            else if (tile == 10) { col0 = sub == 0 ? 1024 : 1056; nv = sub == 0 ? 32 : (sub == 1 ? 8 : 0); }
            else col0 = 2600 + (tile - 11) * 256 + sub * 32;
            cvt_item(P.w_in, DIN, col0, nv, 1024, WinT, rb * 32, kb, scr, lane, P.mix_g); continue; }
        r -= I_A;
        if (r < I_B) { const int rb = r >> 4, kb = r & 15; cvt_item(P.w_branch, 1024, rb * 32, 32, 1024, WbT, rb * 32, kb, scr, lane); continue; }
        r -= I_B;
        if (r < I_C) { const int rb = r >> 4, kb = r & 15; cvt_item(P.w_out, 1024, rb * 32, 32, 1024, WoutT, rb * 32, kb, scr, lane); continue; }
        r -= I_C;
        if (r < I_D) { const int rb = r >> 4, kb = r & 15, tile = rb >> 3, sub = rb & 7;
            cvt_item((sub >> 2) ? P.w_up : P.w_gate, DFF, tile * 128 + (sub & 3) * 32, 32, 1024, WguT, rb * 32, kb, scr, lane, P.ffn_g); continue; }
        r -= I_D;
        if (r < I_E) { const int rb = r / 44, kb = r % 44; cvt_item(P.w_down, 1024, rb * 32, 32, DFF, WdT, rb * 32, kb, scr, lane); continue; }
        r -= I_E;
        { const int gp = r >> 1, rb = r & 1; cvt_item(P.pool_w + gp * 4096, 64, rb * 32, 32, 64, WpT + gp * 4096, rb * 32, 0, scr, lane); }
    }
    for (int e = gtid; e < 4 * 128 * 128; e += ngt) { const int s = e & 127, t = (e >> 7) & 127; Wtril[e] = (s <= t) ? f2bf(P.gm_ws[e]) : (unsigned short)0; }
}

__device__ __forceinline__ unsigned mono_key(float s) { const unsigned b = __float_as_uint(s); return b ^ ((unsigned)((int)b >> 31) | 0x80000000u); }

#define wr_lane(dst, sval, ln) asm volatile("s_nop 4\n\tv_writelane_b32 %0, %1, %2\n\ts_nop 1" : "+v"(dst) : "s"(sval), "n"(ln))
template <int NBLK> __device__ __forceinline__ unsigned a1_bisect(const unsigned (&v)[64], int& cpre) {
    unsigned prefix = 0u; cpre = 0;
#pragma unroll 1
    for (int bit = 31; bit >= 0; --bit) {
        const unsigned cand = prefix | (1u << bit);
        int cnt = 0;
#pragma unroll
        for (int blk = 0; blk < NBLK; ++blk) {
            unsigned long long bl[8];
#pragma unroll
            for (int k = 0; k < 8; ++k) bl[k] = __ballot(v[blk * 8 + k] >= cand);
            __builtin_amdgcn_sched_barrier(0);
#pragma unroll
            for (int k = 0; k < 8; ++k) cnt += __builtin_popcountll(bl[k]);
            __builtin_amdgcn_sched_barrier(0);
        }
        if (cnt >= 256) { prefix = cand; cpre = cnt; if (cnt == 256) break; }
    }
    return prefix;
}
constexpr int A1_ROWF = 4100;
__device__ __forceinline__ void phase_a1(unsigned char* lds, const bf16_t* IQ, const bf16_t* IK, const float* IW, unsigned short* MASK, int tid, int bid, int G) {
    const int lane = tid & 63, w = __builtin_amdgcn_readfirstlane(tid >> 6), q = lane & 15, g = lane >> 4;
    unsigned* keys = (unsigned*)lds;
#ifndef REP_A1X
#define REP_A1X 1
#endif
    for (int L2 = bid; L2 < 1024 * REP_A1X; L2 += G) {
        const int L = L2 & 1023;
        const int b = L >> 8, c = L & 255, qg = (b & 1) ? 255 - c : c;
        const int row0 = b * SEQ + qg * 16;
        const int nreg = (qg >> 2) + 1;
        if (qg <= 15) {
#pragma unroll
            for (int half = 0; half < 2; ++half) { const int qq = half * 8 + w; const int t = qg * 16 + qq; unsigned mlo = 0u, mhi = 0u;
#pragma unroll
                for (int r = 0; r < 4; ++r) { const unsigned long long bal = __ballot(64 * r + lane <= t);
                    wr_lane(mlo, (unsigned)bal, r); wr_lane(mhi, (unsigned)(bal >> 32), r); }
                if (lane < nreg) *(u32x2*)(MASK + (size_t)(row0 + qq) * 256 + 4 * lane) = (u32x2){mlo, mhi}; }
            continue;
        }
        unsigned u[128];
        {
            bf16x8 iqf[8]; float wv[8];
#pragma unroll
            for (int h = 0; h < 8; ++h) iqf[h] = *(const bf16x8*)(IQ + (size_t)(row0 + q) * 256 + h * 32 + 8 * g);
            { const f32x4 a = *(const f32x4*)(IW + (size_t)(row0 + q) * 8), bq = *(const f32x4*)(IW + (size_t)(row0 + q) * 8 + 4);
              wv[0] = a[0]; wv[1] = a[1]; wv[2] = a[2]; wv[3] = a[3]; wv[4] = bq[0]; wv[5] = bq[1]; wv[6] = bq[2]; wv[7] = bq[3]; }
#pragma unroll
            for (int blk = 0; blk < 4; ++blk) {
                if (64 * blk + w <= qg) {
                    bf16x8 kf[8];
#pragma unroll
                    for (int ii = 0; ii < 8; ++ii) { const int kt = 8 * (8 * blk + ii) + w; kf[ii] = *(const bf16x8*)(IK + (size_t)(b * SEQ + kt * 16 + q) * 32 + 8 * g); }
#pragma unroll
                    for (int ii = 0; ii < 8; ++ii) { const int i = 8 * blk + ii; const int kt = 8 * i + w;
                        f32x4 s = {0.f, 0.f, 0.f, 0.f};
#pragma unroll
                        for (int h = 0; h < 8; ++h) { const f32x4 a = mfma16(kf[ii], iqf[h], (f32x4){0.f, 0.f, 0.f, 0.f});
#pragma unroll
                            for (int j = 0; j < 4; ++j) s[j] = __builtin_fmaf(wv[h], fmaxf(a[j], 0.f), s[j]); }
#pragma unroll
                        for (int j = 0; j < 4; ++j) { unsigned uu = mono_key(s[j]); if (kt > qg || (kt == qg && (4 * g + j) > q)) uu = 0u; u[4 * i + j] = uu; }
                    }
                } else {
#pragma unroll
                    for (int r = 0; r < 32; ++r) u[32 * blk + r] = 0u;
                }
            }
        }
#pragma unroll 1
        for (int half = 0; half < 2; ++half) {
            if ((q >> 3) == half) {
                unsigned* krow = keys + (q & 7) * A1_ROWF + 4 * g;
#pragma unroll
                for (int i = 0; i < 32; ++i) { const int kt = 8 * i + w; *(u32x4*)(krow + kt * 16) = (u32x4){u[4 * i], u[4 * i + 1], u[4 * i + 2], u[4 * i + 3]}; }
            }
            __syncthreads();
            {
                const int qq = half * 8 + w; const unsigned* krow = keys + w * A1_ROWF + lane;
                unsigned v[64];
#pragma unroll
                for (int blk = 0; blk < 8; ++blk) {
                    if (nreg > blk * 8) {
#pragma unroll
                        for (int r = blk * 8; r < blk * 8 + 8; ++r) v[r] = krow[64 * r];
                    } else {
#pragma unroll
                        for (int r = blk * 8; r < blk * 8 + 8; ++r) v[r] = 0u;
                    }
                }
#ifndef REP_BIS
#define REP_BIS 1
#endif
                unsigned prefix; int cpre = 0;
#pragma unroll 1
                for (int rb_ = 0; rb_ < REP_BIS; ++rb_)
                switch ((nreg + 7) >> 3) {
                    case 1: prefix = a1_bisect<1>(v, cpre); break; case 2: prefix = a1_bisect<2>(v, cpre); break; case 3: prefix = a1_bisect<3>(v, cpre); break; case 4: prefix = a1_bisect<4>(v, cpre); break;
                    case 5: prefix = a1_bisect<5>(v, cpre); break; case 6: prefix = a1_bisect<6>(v, cpre); break; case 7: prefix = a1_bisect<7>(v, cpre); break; default: prefix = a1_bisect<8>(v, cpre); break;
                }
                const unsigned thr = prefix > 1u ? prefix : 1u;
                unsigned mlo = 0u, mhi = 0u;
                if (cpre == 256) {
#pragma unroll
                    for (int r = 0; r < 64; ++r) { const unsigned long long bal = __ballot(v[r] >= thr); wr_lane(mlo, (unsigned)bal, r); wr_lane(mhi, (unsigned)(bal >> 32), r); }
                } else {
                    int rem = 256;
#pragma unroll
                    for (int r = 0; r < 64; ++r) rem -= __builtin_popcountll(__ballot(v[r] > thr));
#pragma unroll
                    for (int r = 0; r < 64; ++r) { unsigned long long bal = __ballot(v[r] > thr); unsigned long long eq = __ballot(v[r] == thr);
                        const int ne = __builtin_popcountll(eq);
                        if (ne <= rem) { bal |= eq; rem -= ne; }
                        else { while (rem > 0) { const unsigned long long low = eq & (0ull - eq); bal |= low; eq ^= low; --rem; } }
                        wr_lane(mlo, (unsigned)bal, r); wr_lane(mhi, (unsigned)(bal >> 32), r); }
                }
                if (lane < nreg) *(u32x2*)(MASK + (size_t)(row0 + qq) * 256 + 4 * lane) = (u32x2){mlo, mhi};
            }
            __syncthreads();
        }
    }
}

__device__ __forceinline__ void phase_a2(unsigned char* lds, const bf16_t* QA, bf16_t* OA, const bf16_t* KA, const bf16_t* VTA, const unsigned short* MASK,
                                         const float* qn, const float* kn, int tid, int bid, int G) {
    const int lane = tid & 63, w = __builtin_amdgcn_readfirstlane(tid >> 6), q = lane & 15, g = lane >> 4;
    bf16_t* Kt = (bf16_t*)lds;
    bf16_t* Vt = (bf16_t*)(lds + 2 * 64 * 72 * 2);
    const float msh = LOG2E * 8.f * wave_max(fabsf(qn[lane])) * wave_max(fabsf(kn[lane])) * 1.02f + 0.25f;
    const int srow = tid >> 3, sch = tid & 7;
    for (int L = bid; L < 512; L += G) {
        const int jj = L >> 8, c = L & 255, bh = c >> 4, qb = jj ? 31 - (c & 15) : (c & 15);
        const int b = bh >> 2, h = bh & 3;
        const int qgw = qb * 8 + w;
        const int row0 = b * SEQ + qb * 128 + 16 * w;
        bf16x8 qf[2];
#pragma unroll
        for (int hf = 0; hf < 2; ++hf) qf[hf] = *(const bf16x8*)(QA + (size_t)(row0 + q) * 256 + h * 64 + hf * 32 + 8 * g);
        const unsigned short* mrow = MASK + (size_t)(row0 + q) * 256;
        const int nsteps = 2 * qb + 2;
        const bf16_t* ksrc = KA + (size_t)(b * SEQ + srow) * 256 + h * 64 + sch * 8;
        const bf16_t* vsrc = VTA + (size_t)(b * 256 + h * 64 + srow) * SEQ + sch * 8;
        u32x4 kA = *(const u32x4*)ksrc, vA = *(const u32x4*)vsrc, kB = kA, vB = vA;
        u32x2 mE = *(const u32x2*)mrow, mO = mE;
        *(u32x4*)(Kt + srow * 72 + sch * 8) = kA; *(u32x4*)(Vt + srow * 72 + sch * 8) = vA;
        if (nsteps > 1) { kB = *(const u32x4*)(ksrc + (size_t)64 * 256); vB = *(const u32x4*)(vsrc + 64); mO = *(const u32x2*)(mrow + 4); }
        f32x4 o[4]; float lsum = 0.f; const f32x4 negm = {-msh, -msh, -msh, -msh};
#pragma unroll
        for (int d = 0; d < 4; ++d) o[d] = (f32x4){0.f, 0.f, 0.f, 0.f};
        __syncthreads();
#define A2_COMPUTE(st, buf, mcur) do { \
            const bf16_t* kb_ = Kt + (buf) * 64 * 72; const bf16_t* vb_ = Vt + (buf) * 64 * 72; \
            _Pragma("unroll") for (int p = 0; p < 2; ++p) { \
                const int kt0 = (st) * 4 + 2 * p; \
                if (kt0 <= qgw) { \
                    const unsigned mw = p ? (mcur).y : (mcur).x; \
                    const unsigned nib0 = (mw >> (4 * g)) & 15u, nib1 = (kt0 + 1 <= qgw) ? ((mw >> (16 + 4 * g)) & 15u) : 0u; \
                    const bf16_t* kr0 = kb_ + (p * 32 + q) * 72 + 8 * g; const bf16_t* kr1 = kr0 + 16 * 72; \
                    f32x4 a0 = mfma16(*(const bf16x8*)kr0, qf[0], negm); a0 = mfma16(*(const bf16x8*)(kr0 + 32), qf[1], a0); \
                    f32x4 a1 = mfma16(*(const bf16x8*)kr1, qf[0], negm); a1 = mfma16(*(const bf16x8*)(kr1 + 32), qf[1], a1); \
                    float p0[4], p1[4]; \
                    _Pragma("unroll") for (int j = 0; j < 4; ++j) { p0[j] = ((nib0 >> j) & 1u) ? __builtin_amdgcn_exp2f(a0[j]) : 0.f; p1[j] = ((nib1 >> j) & 1u) ? __builtin_amdgcn_exp2f(a1[j]) : 0.f; } \
                    lsum += ((p0[0] + p0[1]) + (p0[2] + p0[3])) + ((p1[0] + p1[1]) + (p1[2] + p1[3])); \
                    const bf16x8 pf = mk8(cvt_pk_bf16(p0[0], p0[1]), cvt_pk_bf16(p0[2], p0[3]), cvt_pk_bf16(p1[0], p1[1]), cvt_pk_bf16(p1[2], p1[3])); \
                    _Pragma("unroll") for (int d = 0; d < 4; ++d) { const bf16_t* vr = vb_ + (d * 16 + q) * 72 + p * 32 + 4 * g; \
                        const u32x2 lo = *(const u32x2*)vr, hi = *(const u32x2*)(vr + 16); \
                        o[d] = mfma16(mk8(lo.x, lo.y, hi.x, hi.y), pf, o[d]); } \
                } } } while (0)
        for (int st = 0; st < nsteps; st += 2) {
            {
                const bool more2 = st + 2 < nsteps; u32x2 mEn = mE;
                if (more2) { kA = *(const u32x4*)(ksrc + (size_t)(st + 2) * 64 * 256); vA = *(const u32x4*)(vsrc + (st + 2) * 64); mEn = *(const u32x2*)(mrow + (st + 2) * 4); }
                A2_COMPUTE(st, 0, mE);
                *(u32x4*)(Kt + 64 * 72 + srow * 72 + sch * 8) = kB; *(u32x4*)(Vt + 64 * 72 + srow * 72 + sch * 8) = vB;
                __syncthreads();
                mE = mEn;
            }
            {
                const int s1 = st + 1; const bool more2 = s1 + 2 < nsteps; u32x2 mOn = mO;
                if (more2) { kB = *(const u32x4*)(ksrc + (size_t)(s1 + 2) * 64 * 256); vB = *(const u32x4*)(vsrc + (s1 + 2) * 64); mOn = *(const u32x2*)(mrow + (s1 + 2) * 4); }
                A2_COMPUTE(s1, 1, mO);
                if (s1 + 1 < nsteps) { *(u32x4*)(Kt + srow * 72 + sch * 8) = kA; *(u32x4*)(Vt + srow * 72 + sch * 8) = vA; }
                __syncthreads();
                mO = mOn;
            }
        }
#undef A2_COMPUTE
        lsum += __shfl_xor(lsum, 16); lsum += __shfl_xor(lsum, 32);
        const float inv = 1.f / lsum;
#pragma unroll
        for (int d = 0; d < 4; ++d) { const f32x4 v = o[d] * inv;
            *(u32x2*)(OA + (size_t)(row0 + q) * 1024 + h * 64 + d * 16 + 4 * g) = (u32x2){cvt_pk_bf16(v[0], v[1]), cvt_pk_bf16(v[2], v[3])}; }
    }
}

__device__ __forceinline__ void phase_b(const bf16_t* PIN, const bf16_t* WpT, const float* pscale, bf16_t* OB, int gw, int ngw, int lane) {
    const int q = lane & 15, g4 = lane >> 4;
    for (int L = gw; L < 4096; L += ngw) {
        const int gp = L >> 10, tg = L & 1023; const int row = tg * 16 + q; const int t = row & (SEQ - 1);
        const int win = 2 << gp; const int cnt = (t + 1 < win) ? t + 1 : win; const float inv = 1.f / (float)cnt;
        f32x4 acc[4];
#pragma unroll
        for (int d = 0; d < 4; ++d) acc[d] = (f32x4){0.f, 0.f, 0.f, 0.f};
#pragma unroll
        for (int ch = 0; ch < 2; ++ch) {
            const bf16_t* p = PIN + (size_t)row * 256 + gp * 64 + ch * 32 + 8 * g4;
            u32x4 wv[16];
#pragma unroll
            for (int i = 0; i < 16; ++i) { wv[i] = (u32x4){0u, 0u, 0u, 0u}; if (i < win && i <= t) wv[i] = *(const u32x4*)(p - (size_t)i * 256); }
            float own[8], sum[8];
            own[0] = bflo(wv[0].x); own[1] = bfhi(wv[0].x); own[2] = bflo(wv[0].y); own[3] = bfhi(wv[0].y); own[4] = bflo(wv[0].z); own[5] = bfhi(wv[0].z); own[6] = bflo(wv[0].w); own[7] = bfhi(wv[0].w);
#pragma unroll
            for (int k = 0; k < 8; ++k) sum[k] = own[k];
#pragma unroll
            for (int i = 1; i < 16; ++i) { const u32x4 v = wv[i];
                sum[0] += bflo(v.x); sum[1] += bfhi(v.x); sum[2] += bflo(v.y); sum[3] += bfhi(v.y); sum[4] += bflo(v.z); sum[5] += bfhi(v.z); sum[6] += bflo(v.w); sum[7] += bfhi(v.w); }
            float pl[8];
#pragma unroll
            for (int k = 0; k < 8; ++k) pl[k] = sum[k] * inv - own[k];
            const bf16x8 bfr = mk8(cvt_pk_bf16(pl[0], pl[1]), cvt_pk_bf16(pl[2], pl[3]), cvt_pk_bf16(pl[4], pl[5]), cvt_pk_bf16(pl[6], pl[7]));
#pragma unroll
            for (int d = 0; d < 4; ++d) { const bf16x8 afr = *(const bf16x8*)(WpT + gp * 4096 + (d * 16 + q) * 64 + ch * 32 + 8 * g4); acc[d] = mfma16(afr, bfr, acc[d]); }
        }
#pragma unroll
        for (int d = 0; d < 4; ++d) { const int d0 = d * 16 + 4 * g4; const f32x4 sc = *(const f32x4*)(pscale + gp * 64 + d0); const f32x4 v = acc[d] * sc;
            *(u32x2*)(OB + (size_t)row * 1024 + gp * 64 + d0) = (u32x2){cvt_pk_bf16(v[0], v[1]), cvt_pk_bf16(v[2], v[3])}; }
    }
}

__device__ __forceinline__ void phase_c(unsigned char* lds, const bf16_t* GV, const bf16_t* GU, bf16_t* OC, const float* gamma, const bf16_t* Wtril, const float* gbias, int tid, int bid, int G) {
    bf16_t* LT = (bf16_t*)lds;
    const int lane = tid & 63, w = __builtin_amdgcn_readfirstlane(tid >> 6), q = lane & 15, g4 = lane >> 4;
    for (int L = bid; L < 512; L += G) {
        const int gp = L & 3, chk = L >> 2; const int R0 = chk * 128;
        {
            const int row = tid >> 2, part = tid & 3;
            const bf16_t* src = GV + (size_t)(R0 + row) * 256 + part * 64;
            float x[64];
#pragma unroll
            for (int k8 = 0; k8 < 8; ++k8) { const u32x4 v = *(const u32x4*)(src + 8 * k8);
                x[8 * k8 + 0] = bflo(v.x); x[8 * k8 + 1] = bfhi(v.x); x[8 * k8 + 2] = bflo(v.y); x[8 * k8 + 3] = bfhi(v.y); x[8 * k8 + 4] = bflo(v.z); x[8 * k8 + 5] = bfhi(v.z); x[8 * k8 + 6] = bflo(v.w); x[8 * k8 + 7] = bfhi(v.w); }
            float s = 0.f;
#pragma unroll
            for (int k = 0; k < 64; ++k) s += x[k];
            s += __shfl_xor(s, 1); s += __shfl_xor(s, 2);
            const float mean = s * (1.f / 256.f); float ss = 0.f;
#pragma unroll
            for (int k = 0; k < 64; ++k) { const float dd = x[k] - mean; ss += dd * dd; }
            ss += __shfl_xor(ss, 1); ss += __shfl_xor(ss, 2);
            const float rstd = __builtin_amdgcn_rsqf(ss * (1.f / 256.f) + EPSN);
            if (part == gp) {
#pragma unroll
                for (int k4 = 0; k4 < 16; ++k4) { const f32x4 gm = *(const f32x4*)(gamma + gp * 64 + 4 * k4);
#pragma unroll
                    for (int i = 0; i < 4; ++i) LT[(4 * k4 + i) * 136 + row] = f2bf((x[4 * k4 + i] - mean) * rstd * gm[i]); }
            }
        }
        __syncthreads();
        {
            f32x4 acc[4];
#pragma unroll
            for (int d = 0; d < 4; ++d) acc[d] = (f32x4){0.f, 0.f, 0.f, 0.f};
            const int t = 16 * w + q; const int nsb = ((16 * w + 15) >> 5) + 1;
            for (int sb = 0; sb < nsb; ++sb) {
                const bf16x8 bfr = *(const bf16x8*)(Wtril + ((size_t)gp * 128 + t) * 128 + sb * 32 + 8 * g4);
#pragma unroll
                for (int d = 0; d < 4; ++d) { const bf16x8 afr = *(const bf16x8*)(LT + (d * 16 + q) * 136 + sb * 32 + 8 * g4); acc[d] = mfma16(afr, bfr, acc[d]); }
            }
            const float bias = gbias[gp * 128 + t];
#pragma unroll
            for (int d = 0; d < 4; ++d) { const size_t eo = (size_t)(R0 + t) * 256 + gp * 64 + d * 16 + 4 * g4; const u32x2 uu = *(const u32x2*)(GU + eo);
                const float r0 = bflo(uu.x) * (acc[d][0] + bias), r1 = bfhi(uu.x) * (acc[d][1] + bias), r2 = bflo(uu.y) * (acc[d][2] + bias), r3 = bfhi(uu.y) * (acc[d][3] + bias);
                *(u32x2*)(OC + (size_t)(R0 + t) * 1024 + gp * 64 + d * 16 + 4 * g4) = (u32x2){cvt_pk_bf16(r0, r1), cvt_pk_bf16(r2, r3)}; }
        }
        __syncthreads();
    }
}

__device__ __forceinline__ void sb_tile(const f32x4 z, int kbase, int tq, int g, float& carry, float (&a)[4]) {
    float lm[4]; bool msk[4];
#pragma unroll
    for (int j = 0; j < 4; ++j) { msk[j] = (kbase + 4 * g + j) >= tq;
        const float e = __builtin_amdgcn_exp2f(-fabsf(z[j]) * LOG2E); const float sp = fmaxf(z[j], 0.f) + __builtin_amdgcn_logf(1.f + e) * LN2;
        lm[j] = msk[j] ? 0.f : -sp; }
    const float suf2 = lm[3], suf1 = lm[3] + lm[2], suf0 = suf1 + lm[1]; const float T = suf0 + lm[0];
    const float x16 = __shfl_xor(T, 16); const float Pp = T + x16; const float Qq = __shfl_xor(Pp, 32);
    const float Sg = ((g & 1) ? 0.f : x16) + ((g & 2) ? 0.f : Qq);
    const float base = carry + Sg;
    const float tl[4] = {base + suf0, base + suf1, base + suf2, base};
#pragma unroll
    for (int j = 0; j < 4; ++j) a[j] = msk[j] ? 0.f : __builtin_amdgcn_exp2f((z[j] + lm[j] + tl[j]) * LOG2E);
    carry += Pp + Qq;
}
__device__ __forceinline__ void phase_d(const bf16_t* SQ, bf16_t* OD, const bf16_t* SK, const bf16_t* VTS, int gw, int ngw, int lane) {
    const int q = lane & 15, g = lane >> 4;
    for (int L = gw; L < 2048; L += ngw) {
        const int qg = L & 255, bh = L >> 8, b0 = bh >> 2, h = bh & 3;
        const int tq = qg * 16 + q;
        bf16x8 qf[2][2]; f32x4 o[2][4]; float carry[2] = {0.f, 0.f};
#pragma unroll
        for (int u = 0; u < 2; ++u) { const int row0 = (b0 + 2 * u) * SEQ + qg * 16;
#pragma unroll
            for (int hf = 0; hf < 2; ++hf) qf[u][hf] = *(const bf16x8*)(SQ + (size_t)(row0 + q) * 256 + h * 64 + hf * 32 + 8 * g);
#pragma unroll
            for (int d = 0; d < 4; ++d) o[u][d] = (f32x4){0.f, 0.f, 0.f, 0.f}; }
        for (int pp = qg >> 1; pp >= 0; --pp) {
            const int kt0 = 2 * pp, kt1 = kt0 + 1;
            bf16x8 kc[2][4]; u32x2 vc[2][8];
#pragma unroll
            for (int u = 0; u < 2; ++u) { const int b = b0 + 2 * u;
                const bf16_t* kb = SK + (size_t)(b * SEQ + kt0 * 16 + q) * 256 + h * 64 + 8 * g;
#pragma unroll
                for (int i = 0; i < 4; ++i) kc[u][i] = *(const bf16x8*)(kb + (size_t)(i >> 1) * 16 * 256 + (i & 1) * 32);
                const bf16_t* vb = VTS + (size_t)(b * 256 + h * 64 + q) * SEQ + kt0 * 16 + 4 * g;
#pragma unroll
                for (int d = 0; d < 4; ++d) { vc[u][2 * d] = *(const u32x2*)(vb + (size_t)d * 16 * SEQ); vc[u][2 * d + 1] = *(const u32x2*)(vb + (size_t)d * 16 * SEQ + 16); } }
            float a0[2][4], a1[2][4];
#pragma unroll
            for (int u = 0; u < 2; ++u) {
                if (kt1 <= qg) {
                    f32x4 z = mfma16(kc[u][2], qf[u][0], (f32x4){0.f, 0.f, 0.f, 0.f}); z = mfma16(kc[u][3], qf[u][1], z);
                    sb_tile(z, kt1 * 16, tq, g, carry[u], a1[u]);
                } else {
#pragma unroll
                    for (int j = 0; j < 4; ++j) a1[u][j] = 0.f;
                }
            }
#pragma unroll
            for (int u = 0; u < 2; ++u) {
                f32x4 z = mfma16(kc[u][0], qf[u][0], (f32x4){0.f, 0.f, 0.f, 0.f}); z = mfma16(kc[u][1], qf[u][1], z);
                sb_tile(z, kt0 * 16, tq, g, carry[u], a0[u]);
            }
#pragma unroll
            for (int u = 0; u < 2; ++u) {
                const bf16x8 pf = mk8(cvt_pk_bf16(a0[u][0], a0[u][1]), cvt_pk_bf16(a0[u][2], a0[u][3]), cvt_pk_bf16(a1[u][0], a1[u][1]), cvt_pk_bf16(a1[u][2], a1[u][3]));
#pragma unroll
                for (int d = 0; d < 4; ++d) o[u][d] = mfma16(mk8(vc[u][2 * d].x, vc[u][2 * d].y, vc[u][2 * d + 1].x, vc[u][2 * d + 1].y), pf, o[u][d]);
            }
            if (__all(carry[0] < -104.f && carry[1] < -104.f)) break;
        }
#pragma unroll
        for (int u = 0; u < 2; ++u) { const int row0 = (b0 + 2 * u) * SEQ + qg * 16;
#pragma unroll
            for (int d = 0; d < 4; ++d) *(u32x2*)(OD + (size_t)(row0 + q) * 1024 + h * 64 + d * 16 + 4 * g) = (u32x2){cvt_pk_bf16(o[u][d][0], o[u][d][1]), cvt_pk_bf16(o[u][d][2], o[u][d][3])}; }
    }
}

#define XB_TMO      128
#define XB_XCNT(j)  (256  + 64 * (j))
#define XB_XSUB(j)  (1280 + 64 * (j))
#define XB_XGEN(j)  (2304 + 64 * (j))
#define XB_TOP      3328
#define XB_TOPGEN   3392
#define XCD_BAR_WORDS 3456
#define XB_SPIN_CAP (1u << 18)

__device__ __forceinline__ unsigned xb_ld(unsigned* p)              { return __hip_atomic_load(p, __ATOMIC_RELAXED, __HIP_MEMORY_SCOPE_AGENT); }
__device__ __forceinline__ unsigned xb_add(unsigned* p, unsigned v) { return __hip_atomic_fetch_add(p, v, __ATOMIC_RELAXED, __HIP_MEMORY_SCOPE_AGENT); }
__device__ __forceinline__ unsigned xb_xcc_id() { return (unsigned)__builtin_amdgcn_s_getreg((3 << 11) | 20) & 0xFu; }
#define XB_SPIN(cond, bar) do { unsigned _sp = 0; while (cond) { __builtin_amdgcn_s_sleep(1); \
    if ((++_sp & 255u) == 0u) { if (xb_ld(&(bar)[XB_TMO])) break; if (_sp > XB_SPIN_CAP) { atomicAdd(&(bar)[XB_TMO], 1u); break; } } } } while (0)

struct XcdBarrier {
    unsigned* bar; unsigned x;
    volatile LAS unsigned* st;
};

__device__ __forceinline__ XcdBarrier xcd_barrier_post(unsigned* bar, volatile LAS unsigned* st) {
    XcdBarrier b; b.bar = bar; b.x = xb_xcc_id(); b.st = st;
    if (threadIdx.x == 0) (void)xb_add(&bar[XB_XCNT(b.x)], 1u);
    return b;
}
__device__ __forceinline__ void xcd_barrier_complete(unsigned* bar, unsigned x, unsigned& nloc, unsigned& nx) {
    const unsigned G = gridDim.x * gridDim.y * gridDim.z;
    unsigned sum, cnt, mine, sp = 0u;
    for (;;) {
        sum = 0u; cnt = 0u; mine = 0u;
#pragma unroll
        for (unsigned j = 0; j < 16; ++j) { const unsigned c = xb_ld(&bar[XB_XCNT(j)]); sum += c; cnt += (c > 0u) ? 1u : 0u; mine = (j == x) ? c : mine; }
        if (sum == G) break;
        __builtin_amdgcn_s_sleep(1);
        if ((++sp & 255u) == 0u) { if (xb_ld(&bar[XB_TMO])) break; if (sp > XB_SPIN_CAP) { atomicAdd(&bar[XB_TMO], 1u); break; } }
    }
    nloc = mine > 0u ? mine : 1u; nx = cnt > 0u ? cnt : 1u;
}

__device__ __forceinline__ void xcd_barrier(const XcdBarrier& b) {
    asm volatile("s_waitcnt vmcnt(0)" ::: "memory");
    __syncthreads();
    if (threadIdx.x == 0) {
        unsigned* bar = b.bar;
        __builtin_amdgcn_s_waitcnt(0);
        unsigned nloc = b.st[0], nx = b.st[1];
        if (nloc == 0u) { xcd_barrier_complete(bar, b.x, nloc, nx); b.st[0] = nloc; b.st[1] = nx; }
        const unsigned old = xb_add(&bar[XB_XSUB(b.x)], 1u);
        const unsigned gen = old / nloc;
        if (old + 1u == (gen + 1u) * nloc) {
            __builtin_amdgcn_fence(__ATOMIC_RELEASE, "agent");
            asm volatile("s_waitcnt vmcnt(0)" ::: "memory");
            const unsigned og = xb_add(&bar[XB_TOP], 1u);
            const unsigned tg = og / nx;
            if (og + 1u == (tg + 1u) * nx) xb_add(&bar[XB_TOPGEN], 1u);
            else XB_SPIN(xb_ld(&bar[XB_TOPGEN]) == tg, bar);
            __builtin_amdgcn_fence(__ATOMIC_ACQUIRE, "agent");
            xb_add(&bar[XB_XGEN(b.x)], 1u);
            asm volatile("s_waitcnt vmcnt(0)" ::: "memory");
        } else {
            XB_SPIN(xb_ld(&bar[XB_XGEN(b.x)]) == gen, bar);
            __builtin_amdgcn_fence(__ATOMIC_ACQUIRE, "agent");
            asm volatile("s_waitcnt vmcnt(0)" ::: "memory");
        }
    }
    __syncthreads();
}

#ifndef REP_P0
#define REP_P0 1
#endif
#ifndef REP_P1
#define REP_P1 1
#endif
#ifndef REP_A1
#define REP_A1 1
#endif
#ifndef REP_BCD
#define REP_BCD 1
#endif
#ifndef REP_A2
#define REP_A2 1
#endif
#ifndef REP_MG
#define REP_MG 1
#endif
#ifndef REP_UP
#define REP_UP 1
#endif
#ifndef REP_WO
#define REP_WO 1
#endif
#ifndef REP_N2
#define REP_N2 1
#endif
#ifndef REP_DN
#define REP_DN 1
#endif
#ifndef REP_B
#define REP_B 1
#endif
#ifndef REP_C
#define REP_C 1
#endif
#ifndef REP_D
#define REP_D 1
#endif
#ifndef REP_SYNC
#define REP_SYNC 1
#endif
#define GSYNC() do { _Pragma("unroll 1") for (int r_ = 0; r_ < REP_SYNC; ++r_) xcd_barrier(bar); } while (0)
#define REPEAT(n) _Pragma("unroll 1") for (int rep_ = 0; rep_ < (n); ++rep_)
struct Args { const float* in[16]; float* out; unsigned char* ws; };
constexpr int LDS_BYTES = 147456;
__device__ __forceinline__ unsigned char* opq(unsigned char* p) { asm volatile("" : "+s"(p)); return p; }
__device__ __forceinline__ int opq_tid() { int t = threadIdx.x; asm volatile("" : "+v"(t)); return t; }
#define WSB(T, off) ((T*)(ws + (off)))
constexpr int PTAB_OFF = 147456 - 512, BST_OFF = 147456 - 64;
__device__ __forceinline__ void* ldp(PG8_LAS unsigned char* ldsl, int i) {
    unsigned off = PTAB_OFF + 8 * i; asm volatile("" : "+v"(off));
    const unsigned long long v = *(volatile LAS unsigned long long*)(ldsl + off);
    const unsigned lo = __builtin_amdgcn_readfirstlane((unsigned)v), hi = __builtin_amdgcn_readfirstlane((unsigned)(v >> 32));
    return (void*)(__attribute__((address_space(1))) void*)(((unsigned long long)hi << 32) | lo);
}

__global__ void __launch_bounds__(512, 2) fwd_kernel(Args a) {
    extern __shared__ __attribute__((aligned(16))) unsigned char lds[];
    cg::grid_group grid = cg::this_grid();
    PG8_LAS unsigned char* ldsl = (PG8_LAS unsigned char*)lds;
    if (a.ws == nullptr) grid.sync();
    if (threadIdx.x == 0) { ((volatile LAS unsigned*)(ldsl + BST_OFF))[0] = 0u; ((volatile LAS unsigned*)(ldsl + BST_OFF))[1] = 0u; }
    if (threadIdx.x == 0) { LAS unsigned long long* tb = (LAS unsigned long long*)(ldsl + PTAB_OFF);
#pragma unroll
        for (int i = 0; i < 16; ++i) tb[i] = (unsigned long long)a.in[i];
        tb[16] = (unsigned long long)a.out; tb[17] = (unsigned long long)a.ws; }
    __syncthreads();
    XcdBarrier bar = xcd_barrier_post((unsigned*)a.ws + 1024, (volatile LAS unsigned*)(ldsl + BST_OFF));
#define INP(i) ((const float*)ldp(ldsl, (i)))
#define OUTP ((float*)ldp(ldsl, 16))
#define WSP ((unsigned char*)ldp(ldsl, 17))

#define PHASE_VARS unsigned char* ws = WSP; int bid = blockIdx.x; asm volatile("" : "+s"(bid)); int G = gridDim.x; asm volatile("" : "+s"(G)); \
    const int tid = opq_tid(), lane = tid & 63, wave = __builtin_amdgcn_readfirstlane(tid >> 6); const int gw = bid * 8 + wave, ngw = G * 8; (void)ws; (void)lane; (void)gw; (void)ngw;
#ifndef REP_ALL
#define REP_ALL 1
#endif
#pragma unroll 1
    for (int ll = 0; ll < 2 * REP_ALL; ++ll) {
        const int l = ll & 1;
        REPEAT(REP_P0) {
            PHASE_VARS
#ifndef NO_CVT
            Ptrs P; P.mix_g = INP(1) + l * DM; P.ffn_g = INP(12) + l * DM;
            P.w_in = INP(2) + (size_t)l * DM * DIN; P.qn = INP(3) + l * 64; P.kn = INP(4) + l * 64; P.pool_w = INP(5) + l * 4 * 64 * 64; P.pool_scale = INP(6) + l * 256;
            P.gm_norm = INP(7) + l * 256; P.gm_ws = INP(8) + l * 4 * 128 * 128; P.gm_b = INP(9) + l * 4 * 128; P.w_branch = INP(10) + (size_t)l * 4 * 256 * 1024;
            P.w_out = INP(11) + (size_t)l * 1024 * 1024; P.w_gate = INP(13) + (size_t)l * DM * DFF; P.w_up = INP(14) + (size_t)l * DM * DFF; P.w_down = INP(15) + (size_t)l * DFF * DM;
            convert_weights(P, ws, (LAS float*)(ldsl + wave * 8448), gw, ngw, lane, bid * 512 + tid, G * 512);
#endif
            if (l == 0) x_to_bf16_ss(INP(0), WSB(bf16_t, WS_XN), WSB(float, WS_SS0), gw, ngw, lane);
        }
        GSYNC();
        REPEAT(REP_P1) {
            PHASE_VARS
            pg8::Gemm g{WSB(bf16_t, WS_XN), WSB(bf16_t, WS_WIN), M_, NINP, DM}; pg8::StaticOrder S; S.init(M_, NINP, G, bid);
            EpiIn E{ws, INP(3) + l * 64, INP(4) + l * 64, WSB(float, WS_SS0)};
#ifndef NO_G1
            pg8::gemm_phase<EpiIn, pg8::StaticOrder, true, true>(ldsl, g, S, E);
#endif
        }
        GSYNC();
        REPEAT(REP_A1) {
            PHASE_VARS
            for (int i = bid * 512 + tid; i < M_; i += G * 512) { WSB(float, WS_SS0)[i] = 0.f; WSB(float, WS_SS1)[i] = 0.f; }
#ifndef NO_A1
            phase_a1(lds, WSB(bf16_t, WS_IQ), WSB(bf16_t, WS_IK), WSB(float, WS_IW), WSB(unsigned short, WS_MASK), tid, bid, G);
#endif
            __syncthreads();
        }
        REPEAT(REP_BCD) {
        REPEAT(REP_C) {
            PHASE_VARS
#ifndef NO_C
            phase_c(lds, WSB(bf16_t, WS_GV), WSB(bf16_t, WS_GU), WSB(bf16_t, WS_OCAT) + 512, INP(7) + l * 256, WSB(bf16_t, WS_WS), INP(9) + l * 4 * 128, tid, bid, G);
#endif
        }
        REPEAT(REP_B) {
            PHASE_VARS
#ifndef NO_B
            phase_b(WSB(bf16_t, WS_PIN), WSB(bf16_t, WS_WP), INP(6) + l * 256, WSB(bf16_t, WS_OCAT) + 256, gw, ngw, lane);
#endif
        }
        REPEAT(REP_D) {
            PHASE_VARS
#ifndef NO_D
            phase_d(WSB(bf16_t, WS_SQ), WSB(bf16_t, WS_OCAT) + 768, WSB(bf16_t, WS_SK), WSB(bf16_t, WS_VTS), gw, ngw, lane);
#endif
        }
        }
        GSYNC();
        REPEAT(REP_A2) {
            PHASE_VARS
#ifndef NO_A2
            phase_a2(lds, WSB(bf16_t, WS_QA), WSB(bf16_t, WS_OCAT), WSB(bf16_t, WS_KA), WSB(bf16_t, WS_VTA), WSB(unsigned short, WS_MASK), INP(3) + l * 64, INP(4) + l * 64, tid, bid, G);
#endif
        }
        GSYNC();
        REPEAT(REP_MG) {
            PHASE_VARS
            pg8::Gemm g{WSB(bf16_t, WS_OCAT), WSB(bf16_t, WS_WB), M_, DM, DM}; pg8::StaticOrder S; S.init(M_, DM, G, bid);
            EpiMerge E{ws + WS_G, WSB(bf16_t, WS_XN)};
#ifndef NO_G2
            pg8::gemm_phase<EpiMerge, pg8::StaticOrder, true, true>(ldsl, g, S, E);
#endif
        }
        GSYNC();
        REPEAT(REP_WO) {
            PHASE_VARS
            pg8::Gemm g{WSB(bf16_t, WS_XN), WSB(bf16_t, WS_WOUT), M_, DM, DM}; pg8::StaticOrder S; S.init(M_, DM, G, bid);
            EpiResid E{l == 0 ? INP(0) : OUTP, OUTP, WSB(bf16_t, WS_S), WSB(float, WS_SS1), 1};
#ifndef NO_G3
            pg8::gemm_phase<EpiResid, pg8::StaticOrder, true, true>(ldsl, g, S, E);
#endif
        }
        GSYNC();
        REPEAT(REP_UP) {
            PHASE_VARS
            pg8::Gemm g{WSB(bf16_t, WS_S), WSB(bf16_t, WS_WGU), M_, 2 * DFF, DM}; pg8::StaticOrder S; S.init(M_, 2 * DFF, G, bid);
            EpiSwiGLU E{WSB(bf16_t, WS_R1), WSB(float, WS_SS1)};
#ifndef NO_G4
            pg8::gemm_phase<EpiSwiGLU, pg8::StaticOrder, true, true>(ldsl, g, S, E);
#endif
        }
        GSYNC();
        REPEAT(REP_DN) {
            PHASE_VARS
            pg8::Gemm g{WSB(bf16_t, WS_R1), WSB(bf16_t, WS_WD), M_, DM, DFF}; pg8::StaticOrder S; S.init(M_, DM, G, bid);
            float* o = OUTP; EpiResid E{o, o, WSB(bf16_t, WS_XN), WSB(float, WS_SS0), l == 0 ? 1 : 0};
#ifndef NO_G3
            pg8::gemm_phase<EpiResid, pg8::StaticOrder, true, true>(ldsl, g, S, E);
#endif
        }
        if (ll + 1 < 2 * REP_ALL) GSYNC();
    }
}

extern "C" void kernel_launch(void* const* d_in, const int* in_sizes, int n_in, void* d_out, int out_size, void* d_ws, size_t ws_size, hipStream_t stream) {
    static int grid_blocks = 0;
    if (grid_blocks == 0) {
        if (n_in != 16 || out_size != M_ * DM || ws_size < WS_END) { fprintf(stderr, "kernel_launch: unexpected shapes (n_in %d out %d ws %zu)\n", n_in, out_size, ws_size); grid_blocks = -1; return; }
        int dev = 0, cus = 0, per_cu = 0;
        hipGetDevice(&dev);
        hipDeviceGetAttribute(&cus, hipDeviceAttributeMultiprocessorCount, dev);
        hipFuncSetAttribute((const void*)fwd_kernel, hipFuncAttributeMaxDynamicSharedMemorySize, LDS_BYTES);
        if (hipOccupancyMaxActiveBlocksPerMultiprocessor(&per_cu, (const void*)fwd_kernel, 512, LDS_BYTES) != hipSuccess || per_cu < 1) per_cu = 1;
        (void)hipGetLastError();
        grid_blocks = cus;
    }
    if (grid_blocks < 0) return;
    Args a{};
    for (int i = 0; i < 16; ++i) a.in[i] = (const float*)d_in[i];
    a.out = (float*)d_out; a.ws = (unsigned char*)d_ws;
    if (hipMemsetAsync(d_ws, 0, 65536, stream) != hipSuccess) { fprintf(stderr, "kernel_launch: memset failed\n"); return; }
    void* args[] = {&a};
    hipError_t e = hipLaunchCooperativeKernel((const void*)fwd_kernel, dim3(grid_blocks), dim3(512), args, LDS_BYTES, stream);
    if (e != hipSuccess) fprintf(stderr, "cooperative launch failed: %s (grid %d)\n", hipGetErrorString(e), grid_blocks);
}
```

```cpp
#include <hip/hip_runtime.h>
#include <hip/hip_cooperative_groups.h>
#include <cstdio>
#include <cstdint>
namespace pg8 {
#define PG8_LAS __attribute__((address_space(3)))
typedef unsigned short bf16_t;
typedef short bf16x8 __attribute__((ext_vector_type(8)));
typedef float f32x4 __attribute__((ext_vector_type(4)));
typedef unsigned u32x4 __attribute__((ext_vector_type(4)));
constexpr int BM = 256, BK = 64, HALF = 128, HTB = HALF * BK * 2  , STAGE_BYTES = 8 * HTB, NXCD = 8, WGM = 8;

__host__ __device__ __forceinline__ int lds_byte(int r, int c) { const int st = (r >> 4) * 2 + (c >> 5), rr = r & 15, cc = c & 31, ob = rr * 64 + cc * 2; return st * 1024 + (ob ^ (((ob >> 9) & 1) << 5)); }
__host__ __device__ __forceinline__ void stage_rc(int b, int& R, int& C) { const int st = b / 1024, sb = b % 1024, swz = sb ^ (((sb >> 9) & 1) << 5); R = (st >> 1) * 16 + swz / 64; C = (st & 1) * 32 + (swz % 64) / 2; }
__host__ __device__ __forceinline__ int perm32(int rho) { const int n = rho >> 4, i = rho & 15; return 8 * (i >> 2) + 4 * n + (i & 3); }

struct Unit { int pm, pn; };
struct Gemm { const bf16_t* A; const bf16_t* Bt; int M, N, K; };

struct StaticOrder {
    int nM, nN, nwg, G, c;
    __host__ __device__ void init(int M, int N, int G_, int c_) { nM = M / BM; nN = N / BM; nwg = nM * nN; G = G_; c = c_; }
    __host__ __device__ bool next(int i, Unit& u) const {
        const long L = (long)i * G + c; if (L >= nwg) return false;
        int wgid = (int)L; { const int q = nwg / NXCD, r = nwg % NXCD, xcd = wgid % NXCD, off = wgid / NXCD; wgid = (xcd < r ? xcd * (q + 1) : r * (q + 1) + (xcd - r) * q) + off; }
        const int nig = WGM * nN, gid = wgid / nig, fm = gid * WGM, gsz = (nM - fm) < WGM ? (nM - fm) : WGM;
        u.pm = fm + ((wgid % nig) % gsz); u.pn = (wgid % nig) / gsz; return true;
    }
    __device__ __forceinline__ void a_ready(const Unit&) const {}
    __device__ __forceinline__ void done(const Unit&) const {}
};

__device__ __forceinline__ unsigned cvt_pk_bf16(float lo, float hi) { unsigned r; asm volatile("v_cvt_pk_bf16_f32 %0, %1, %2" : "=v"(r) : "v"(lo), "v"(hi)); return r; }
template <class Epi, class Sched, bool ALIGN_EPI = false, bool SP2 = false>
__device__ __forceinline__ void gemm_phase(PG8_LAS unsigned char* lds, const Gemm g, const Sched& S, const Epi& E) {
    int tid_ = threadIdx.x; asm volatile("" : "+v"(tid_)); const int tid = tid_, wid = __builtin_amdgcn_readfirstlane(tid >> 6), lane = tid & 63, wr = wid >> 2, wc = wid & 3, fr = lane & 15, fq = lane >> 4;
    const int K = g.K, nt = K / BK;
    unsigned voffA[2], voffB[2];
#pragma unroll
    for (int i = 0; i < 2; ++i) { int R, C; stage_rc(tid * 16 + i * 8192, R, C); const int Rb = Epi::PERM ? ((R & ~31) + perm32(R & 31)) : R;
        voffA[i] = (unsigned)(R * K + C) * 2u; voffB[i] = (unsigned)(Rb * K + C) * 2u; }
    const size_t kstep = (size_t)(BK * 2);
    const size_t hstep = (size_t)HALF * K * 2;
    const size_t tstep = 2 * hstep;
    const unsigned ldsw = (unsigned)wid * 1024u;
    const int aoff = lds_byte(wr * 64 + fr, fq * 8), boff = lds_byte(wc * 32 + fr, fq * 8);
#define PG8_SA(b, h) (((b) * 2 + (h)) * HTB)
#define PG8_SB(b, h) ((4 + (b) * 2 + (h)) * HTB)
#define PG8_STAGE(bufoff, gbase, voff) do { _Pragma("unroll") for (int _i = 0; _i < 2; ++_i) \
        __builtin_amdgcn_global_load_lds((const unsigned*)((const char*)(gbase) + (voff)[_i]), (PG8_LAS unsigned*)(lds + (bufoff) + ldsw + _i * 8192), 16, 0, 0); } while (0)
#define PG8_LDA(dst, b, h) do { _Pragma("unroll") for (int m = 0; m < 4; ++m) _Pragma("unroll") for (int k = 0; k < 2; ++k) dst[m][k] = *(const PG8_LAS bf16x8*)(lds + PG8_SA(b, h) + aoff + m * 2048 + k * 1024); } while (0)
#define PG8_LDB(dst, b, h) do { _Pragma("unroll") for (int n = 0; n < 2; ++n) _Pragma("unroll") for (int k = 0; k < 2; ++k) dst[n][k] = *(const PG8_LAS bf16x8*)(lds + PG8_SB(b, h) + boff + n * 2048 + k * 1024); } while (0)
#define PG8_MMA(ai, bj, At, Bt) do { __builtin_amdgcn_s_setprio(1); _Pragma("unroll") for (int m = 0; m < 4; ++m) _Pragma("unroll") for (int n = 0; n < 2; ++n) _Pragma("unroll") for (int k = 0; k < 2; ++k) \
        acc[ai][bj][m][n] = __builtin_amdgcn_mfma_f32_16x16x32_bf16(Bt[n][k], At[m][k], acc[ai][bj][m][n], 0, 0, 0); __builtin_amdgcn_s_setprio(0); } while (0)
#define PG8_WAIT_V(n) asm volatile("s_waitcnt vmcnt(" #n ")" ::: "memory")
#define PG8_WAIT_L(n) asm volatile("s_waitcnt lgkmcnt(" #n ")" ::: "memory")
#define PG8_BAR __builtin_amdgcn_s_barrier()
#define PG8_SCHED __builtin_amdgcn_sched_barrier(0)
    Unit cur, nxt; int ui = 0;
    if (!S.next(0, cur)) return;
    f32x4 acc[2][2][4][2];
#pragma unroll
    for (int a = 0; a < 2; ++a)
#pragma unroll
        for (int b = 0; b < 2; ++b)
#pragma unroll
            for (int m = 0; m < 4; ++m)
#pragma unroll
                for (int n = 0; n < 2; ++n) acc[a][b][m][n] = (f32x4){0.f, 0.f, 0.f, 0.f};
    bf16x8 At[4][2], B0[2][2], B1[2][2];
    const char* cA = (const char*)g.A + (size_t)cur.pm * tstep; const char* cB = (const char*)g.Bt + (size_t)cur.pn * tstep;
    S.a_ready(cur);
    if constexpr (SP2) {
        PG8_STAGE(PG8_SB(0, 0), cB, voffB); PG8_STAGE(PG8_SB(0, 1), cB + hstep, voffB); PG8_STAGE(PG8_SA(0, 0), cA, voffA); PG8_STAGE(PG8_SA(0, 1), cA + hstep, voffA);
        if (wr == 1) PG8_BAR;
        PG8_WAIT_V(2); PG8_BAR;
        PG8_STAGE(PG8_SB(1, 0), cB + kstep, voffB); PG8_STAGE(PG8_SA(1, 0), cA + kstep, voffA); PG8_STAGE(PG8_SB(1, 1), cB + hstep + kstep, voffB);
        PG8_WAIT_V(6); PG8_BAR;
    } else {
        PG8_STAGE(PG8_SB(0, 0), cB, voffB); PG8_STAGE(PG8_SA(0, 0), cA, voffA); PG8_STAGE(PG8_SB(0, 1), cB + hstep, voffB); PG8_STAGE(PG8_SA(0, 1), cA + hstep, voffA);
        if (wr == 1) PG8_BAR;
        PG8_WAIT_V(4); PG8_BAR;
        PG8_STAGE(PG8_SB(1, 0), cB + kstep, voffB); PG8_STAGE(PG8_SA(1, 0), cA + kstep, voffA); PG8_STAGE(PG8_SB(1, 1), cB + hstep + kstep, voffB);
        PG8_WAIT_V(6); PG8_BAR;
    }
    for (;;) {
        const bool has_next = S.next(ui + 1, nxt);
        const char* nA = has_next ? (const char*)g.A + (size_t)nxt.pm * tstep : cA; const char* nB = has_next ? (const char*)g.Bt + (size_t)nxt.pn * tstep : cB;
        for (int t = 0; t < nt; t += 2) {
            if constexpr (Epi::HOOK) { if (t != 0 && (t & 3) == 0) E.hook(acc, cur, (t >> 2) - 1, wr, wc, fr, fq); }
            const bool last = (t == nt - 2);
            const char* a1 = cA + (size_t)(t + 1) * kstep;
            const char* a2 = last ? nA : cA + (size_t)(t + 2) * kstep; const char* b2 = last ? nB : cB + (size_t)(t + 2) * kstep;
            const char* a3 = a2 + kstep; const char* b3 = b2 + kstep;
            if (last && has_next) S.a_ready(nxt);
            if constexpr (SP2) {
            PG8_LDB(B0, 0, 0); PG8_LDB(B1, 0, 1); PG8_SCHED; PG8_LDA(At, 0, 0); PG8_STAGE(PG8_SA(1, 1), a1 + hstep, voffA);
            PG8_WAIT_V(8); PG8_WAIT_L(0); PG8_BAR; PG8_MMA(0, 0, At, B0); PG8_MMA(0, 1, At, B1); PG8_BAR; PG8_SCHED;
            PG8_LDA(At, 0, 1); PG8_STAGE(PG8_SB(0, 0), b2, voffB); PG8_STAGE(PG8_SB(0, 1), b2 + hstep, voffB); PG8_STAGE(PG8_SA(0, 0), a2, voffA);
            PG8_WAIT_V(8); PG8_WAIT_L(0); PG8_BAR; PG8_MMA(1, 0, At, B0); PG8_MMA(1, 1, At, B1); PG8_BAR; PG8_SCHED;
            PG8_LDB(B0, 1, 0); PG8_LDB(B1, 1, 1); PG8_SCHED; PG8_LDA(At, 1, 0); PG8_STAGE(PG8_SA(0, 1), a2 + hstep, voffA);
            PG8_WAIT_V(8); PG8_WAIT_L(0); PG8_BAR; PG8_MMA(0, 0, At, B0); PG8_MMA(0, 1, At, B1); PG8_BAR; PG8_SCHED;
            PG8_LDA(At, 1, 1); PG8_STAGE(PG8_SB(1, 0), b3, voffB); PG8_STAGE(PG8_SB(1, 1), b3 + hstep, voffB); PG8_STAGE(PG8_SA(1, 0), a3, voffA);
            PG8_WAIT_V(8); PG8_WAIT_L(0); PG8_BAR; PG8_MMA(1, 0, At, B0); PG8_MMA(1, 1, At, B1); PG8_BAR; PG8_SCHED;
            } else {
            PG8_LDB(B0, 0, 0); PG8_SCHED; PG8_LDA(At, 0, 0); PG8_STAGE(PG8_SA(1, 1), a1 + hstep, voffA);
            PG8_WAIT_L(8); PG8_BAR; PG8_WAIT_L(0); PG8_MMA(0, 0, At, B0); PG8_BAR; PG8_SCHED;
            PG8_LDB(B1, 0, 1); PG8_STAGE(PG8_SB(0, 0), b2, voffB);
            PG8_BAR; PG8_WAIT_L(0); PG8_MMA(0, 1, At, B1); PG8_BAR;
            PG8_LDA(At, 0, 1); PG8_STAGE(PG8_SA(0, 0), a2, voffA);
            PG8_BAR; PG8_WAIT_L(0); PG8_MMA(1, 0, At, B0); PG8_BAR; PG8_SCHED;
            PG8_STAGE(PG8_SB(0, 1), b2 + hstep, voffB);
            PG8_WAIT_V(6); PG8_BAR; PG8_MMA(1, 1, At, B1); PG8_BAR;
            PG8_LDB(B0, 1, 0); PG8_SCHED; PG8_LDA(At, 1, 0); PG8_STAGE(PG8_SA(0, 1), a2 + hstep, voffA);
            PG8_WAIT_L(8); PG8_BAR; PG8_WAIT_L(0); PG8_MMA(0, 0, At, B0); PG8_BAR; PG8_SCHED;
            PG8_LDB(B1, 1, 1); PG8_STAGE(PG8_SB(1, 0), b3, voffB);
            PG8_BAR; PG8_WAIT_L(0); PG8_MMA(0, 1, At, B1); PG8_BAR;
            PG8_LDA(At, 1, 1); PG8_STAGE(PG8_SA(1, 0), a3, voffA);
            PG8_BAR; PG8_WAIT_L(0); PG8_MMA(1, 0, At, B0); PG8_BAR; PG8_SCHED;
            PG8_STAGE(PG8_SB(1, 1), b3 + hstep, voffB);
            PG8_WAIT_V(6); PG8_BAR; PG8_MMA(1, 1, At, B1); PG8_BAR;
            }
        }
        if constexpr (ALIGN_EPI) { if (wr == 0) PG8_BAR; }
        if constexpr (!Epi::AFTER_DRAIN) { E(acc, cur, wr, wc, fr, fq); S.done(cur); }
        if (!has_next) break;
#pragma unroll
        for (int a = 0; a < 2; ++a)
#pragma unroll
            for (int b = 0; b < 2; ++b)
#pragma unroll
                for (int m = 0; m < 4; ++m)
#pragma unroll
                    for (int n = 0; n < 2; ++n) acc[a][b][m][n] = (f32x4){0.f, 0.f, 0.f, 0.f};
        cur = nxt; cA = nA; cB = nB; ++ui;
        if constexpr (ALIGN_EPI) { if (wr == 1) PG8_BAR; }
    }
    PG8_WAIT_V(0);
    if constexpr (!ALIGN_EPI) { if (wr == 0) PG8_BAR; }
    PG8_BAR;
    if constexpr (Epi::AFTER_DRAIN) { E.fused(acc, cur, wr, wc, fr, fq, lds, wid, lane); S.done(cur); }
#undef PG8_SA
#undef PG8_SB
#undef PG8_STAGE
#undef PG8_LDA
#undef PG8_LDB
#undef PG8_MMA
#undef PG8_WAIT_V
#undef PG8_WAIT_L
#undef PG8_BAR
#undef PG8_SCHED
}
}
namespace cg = cooperative_groups;
using pg8::bf16_t; using pg8::bf16x8; using pg8::f32x4; using pg8::u32x4; using pg8::Unit; using pg8::cvt_pk_bf16;
typedef unsigned u32x2 __attribute__((ext_vector_type(2)));
#define LAS __attribute__((address_space(3)))
#define LDS_WAIT() asm volatile("s_waitcnt lgkmcnt(0)" ::: "memory")

constexpr int M_ = 16384, DM = 1024, SEQ = 4096, DFF = 2816, DIN = 6696, NINP = 6912;
constexpr float EPSN = 1e-6f;
constexpr float LOG2E = 1.4426950408889634f, LN2 = 0.6931471805599453f;
constexpr float C2 = 0.125f * LOG2E;

constexpr size_t MiB = (size_t)1 << 20;
constexpr size_t WS_SS0 = 128 * 1024, WS_SS1 = 256 * 1024;
constexpr size_t WS_WIN = 1 * MiB;
constexpr size_t WS_WB = WS_WIN + (size_t)NINP * 1024 * 2;
constexpr size_t WS_WOUT = WS_WB + 2 * MiB;
constexpr size_t WS_WGU = WS_WOUT + 2 * MiB;
constexpr size_t WS_WD = WS_WGU + 11 * MiB;
constexpr size_t WS_WP = WS_WD + (size_t)1024 * 2816 * 2;
constexpr size_t WS_WS = WS_WP + 32768;
static_assert(WS_WS + 131072 <= 36 * MiB, "weights region");
constexpr size_t WS_XN = 36 * MiB;
constexpr size_t WS_R1 = 68 * MiB;
constexpr size_t WS_G = WS_R1, WS_KA = WS_R1 + 64 * MiB, WS_VTA = WS_KA + 8 * MiB, WS_IQ = WS_VTA + 8 * MiB;
constexpr size_t WS_S = 156 * MiB;
constexpr size_t WS_PIN = WS_S, WS_GU = WS_S + 8 * MiB, WS_GV = WS_S + 16 * MiB, WS_SQ = WS_S + 24 * MiB, WS_SK = WS_S + 32 * MiB,
                 WS_VTS = WS_S + 40 * MiB, WS_QA = WS_S + 48 * MiB, WS_MASK = WS_S + 56 * MiB, WS_IK = 220 * MiB, WS_IW = 221 * MiB, WS_OCAT = 222 * MiB  , WS_END = 254 * MiB;

__device__ __forceinline__ float bf2f(unsigned short v) { return __uint_as_float((unsigned)v << 16); }
__device__ __forceinline__ float bflo(unsigned v) { return __uint_as_float(v << 16); }
__device__ __forceinline__ float bfhi(unsigned v) { return __uint_as_float(v & 0xffff0000u); }
__device__ __forceinline__ unsigned short f2bf(float f) { return (unsigned short)(cvt_pk_bf16(f, 0.f) & 0xffffu); }
__device__ __forceinline__ float sigmoidf_(float x) { return __builtin_amdgcn_rcpf(1.f + __builtin_amdgcn_exp2f(-x * LOG2E)); }
__device__ __forceinline__ float gelu_tanh(float x) { const float u = 0.7978845608028654f * (x + 0.044715f * x * x * x); return x * __builtin_amdgcn_rcpf(1.f + __builtin_amdgcn_exp2f(-2.f * LOG2E * u)); }
__device__ __forceinline__ f32x4 mfma16(bf16x8 a, bf16x8 b, f32x4 c) { return __builtin_amdgcn_mfma_f32_16x16x32_bf16(a, b, c, 0, 0, 0); }
__device__ __forceinline__ bf16x8 mk8(unsigned a, unsigned b, unsigned c, unsigned d) { u32x4 v = {a, b, c, d}; return __builtin_bit_cast(bf16x8, v); }

struct EpiIn {
    static constexpr bool PERM = true, AFTER_DRAIN = false, HOOK = false;
    unsigned char* ws; const float *qn, *kn; const float* SS;
    __device__ __forceinline__ void operator()(const f32x4 (&acc)[2][2][4][2], const Unit& u, int wr, int wc, int fr, int fq) const {
        bf16_t* const QA = (bf16_t*)(ws + WS_QA); bf16_t* const KA = (bf16_t*)(ws + WS_KA); bf16_t* const VTA = (bf16_t*)(ws + WS_VTA); bf16_t* const IQ = (bf16_t*)(ws + WS_IQ);
        bf16_t* const PIN = (bf16_t*)(ws + WS_PIN); bf16_t* const GU = (bf16_t*)(ws + WS_GU); bf16_t* const GV = (bf16_t*)(ws + WS_GV); bf16_t* const SQ = (bf16_t*)(ws + WS_SQ);
        bf16_t* const SK = (bf16_t*)(ws + WS_SK); bf16_t* const VTS = (bf16_t*)(ws + WS_VTS); bf16_t* const IK = (bf16_t*)(ws + WS_IK); float* const IW = (float*)(ws + WS_IW); unsigned char* const G = ws + WS_G;
        const int pn = u.pn; const int row0 = u.pm * 256 + wr * 64 + fr; const int cl = wc * 32 + 8 * fq;
        float rr[2][4];
#pragma unroll
        for (int ai = 0; ai < 2; ++ai)
#pragma unroll
            for (int m = 0; m < 4; ++m) rr[ai][m] = __builtin_amdgcn_rsqf(SS[row0 + ai * 128 + m * 16] * (1.f / 1024.f) + EPSN);
        if (pn >= 11) {
            unsigned char* gp = G + (size_t)row0 * 4096 + (pn - 11) * 256 + cl;
#pragma unroll
            for (int ai = 0; ai < 2; ++ai)
#pragma unroll
                for (int m = 0; m < 4; ++m)
#pragma unroll
                    for (int bj = 0; bj < 2; ++bj) {
                        unsigned w2[2];
#pragma unroll
                        for (int n = 0; n < 2; ++n) { const f32x4 v = (acc[ai][bj][m][n] * rr[ai][m]); unsigned pk = 0;
#pragma unroll
                            for (int i = 0; i < 4; ++i) { const unsigned qv = (unsigned)(sigmoidf_(v[i]) * 255.f + 0.5f); pk |= qv << (8 * i); }
                            w2[n] = pk; }
                        *(u32x2*)(gp + (size_t)(ai * 128 + m * 16) * 4096 + bj * 128) = (u32x2){w2[0], w2[1]};
                    }
            return;
        }
        if (pn <= 1) {
            const float* gw = pn == 0 ? qn : kn; const float sc = pn == 0 ? C2 : 1.f; bf16_t* T = pn == 0 ? QA : KA;
            f32x4 gv[2][2];
#pragma unroll
            for (int bj = 0; bj < 2; ++bj)
#pragma unroll
                for (int n = 0; n < 2; ++n) gv[bj][n] = *(const f32x4*)(gw + bj * 32 + 8 * fq + 4 * n);
#pragma unroll
            for (int ai = 0; ai < 2; ++ai)
#pragma unroll
                for (int m = 0; m < 4; ++m) {
                    float ss = 0.f;
#pragma unroll
                    for (int bj = 0; bj < 2; ++bj)
#pragma unroll
                        for (int n = 0; n < 2; ++n) { const f32x4 v = (acc[ai][bj][m][n] * rr[ai][m]); ss += (v[0] * v[0] + v[1] * v[1]) + (v[2] * v[2] + v[3] * v[3]); }
                    ss += __shfl_xor(ss, 16); ss += __shfl_xor(ss, 32);
                    const float rinv = __builtin_amdgcn_rsqf(ss * (1.f / 64.f) + EPSN) * sc;
                    bf16_t* rp = T + (size_t)(row0 + ai * 128 + m * 16) * 256 + wc * 64 + 8 * fq;
#pragma unroll
                    for (int bj = 0; bj < 2; ++bj) { const f32x4 v0 = (acc[ai][bj][m][0] * rr[ai][m]) * gv[bj][0] * rinv, v1 = (acc[ai][bj][m][1] * rr[ai][m]) * gv[bj][1] * rinv;
                        u32x4 w; w.x = cvt_pk_bf16(v0[0], v0[1]); w.y = cvt_pk_bf16(v0[2], v0[3]); w.z = cvt_pk_bf16(v1[0], v1[1]); w.w = cvt_pk_bf16(v1[2], v1[3]);
                        *(u32x4*)(rp + bj * 32) = w; }
                }
            return;
        }
        if (pn == 2 || pn == 9) {
            bf16_t* T = pn == 2 ? VTA : VTS;
#pragma unroll
            for (int ai = 0; ai < 2; ++ai)
#pragma unroll
                for (int m = 0; m < 4; ++m) { const int row = row0 + ai * 128 + m * 16; const int b = row >> 12, t = row & 4095;
#pragma unroll
                    for (int bj = 0; bj < 2; ++bj)
#pragma unroll
                        for (int n = 0; n < 2; ++n) { const f32x4 v = (acc[ai][bj][m][n] * rr[ai][m]);
#pragma unroll
                            for (int i = 0; i < 4; ++i) T[((size_t)b * 256 + bj * 128 + cl + 4 * n + i) * 4096 + t] = f2bf(v[i]); }
                }
            return;
        }
        if (pn == 10) {
            if (wc == 0) {
#pragma unroll
                for (int ai = 0; ai < 2; ++ai)
#pragma unroll
                    for (int m = 0; m < 4; ++m) { const f32x4 v0 = (acc[ai][0][m][0] * rr[ai][m]), v1 = (acc[ai][0][m][1] * rr[ai][m]);
                        u32x4 w; w.x = cvt_pk_bf16(v0[0], v0[1]); w.y = cvt_pk_bf16(v0[2], v0[3]); w.z = cvt_pk_bf16(v1[0], v1[1]); w.w = cvt_pk_bf16(v1[2], v1[3]);
                        *(u32x4*)(IK + (size_t)(row0 + ai * 128 + m * 16) * 32 + 8 * fq) = w; }
            } else if (wc == 1 && fq == 0) {
#pragma unroll
                for (int ai = 0; ai < 2; ++ai)
#pragma unroll
                    for (int m = 0; m < 4; ++m) { float* p = IW + (size_t)(row0 + ai * 128 + m * 16) * 8; *(f32x4*)p = (acc[ai][0][m][0] * rr[ai][m]); *(f32x4*)(p + 4) = (acc[ai][0][m][1] * rr[ai][m]); }
            }
            return;
        }
        {
            bf16_t* T = pn == 3 ? IQ : pn == 4 ? PIN : pn == 5 ? GU : pn == 6 ? GV : pn == 7 ? SQ : SK;
            const bool act = (pn == 5 || pn == 6); const float sc = pn == 7 ? 0.125f : 1.f;
#pragma unroll
            for (int ai = 0; ai < 2; ++ai)
#pragma unroll
                for (int m = 0; m < 4; ++m) { bf16_t* rp = T + (size_t)(row0 + ai * 128 + m * 16) * 256 + cl;
#pragma unroll
                    for (int bj = 0; bj < 2; ++bj) { f32x4 v0 = (acc[ai][bj][m][0] * rr[ai][m]) * sc, v1 = (acc[ai][bj][m][1] * rr[ai][m]) * sc;
                        if (act) {
#pragma unroll
                            for (int i = 0; i < 4; ++i) { v0[i] = gelu_tanh(v0[i]); v1[i] = gelu_tanh(v1[i]); } }
                        u32x4 w; w.x = cvt_pk_bf16(v0[0], v0[1]); w.y = cvt_pk_bf16(v0[2], v0[3]); w.z = cvt_pk_bf16(v1[0], v1[1]); w.w = cvt_pk_bf16(v1[2], v1[3]);
                        *(u32x4*)(rp + bj * 128) = w; }
                }
        }
    }
};

struct EpiMerge {
    static constexpr bool PERM = true, AFTER_DRAIN = false, HOOK = true;
    const unsigned char* G; bf16_t* MG;
    __device__ __forceinline__ void hook(f32x4 (&acc)[2][2][4][2], const Unit& u, int s, int wr, int wc, int fr, int fq) const {
        const int row0 = u.pm * 256 + wr * 64 + fr; const int col0 = u.pn * 256 + wc * 32 + 8 * fq;
        const unsigned char* gp0 = G + (size_t)row0 * 4096 + s * 1024 + col0;
#pragma unroll
        for (int ai = 0; ai < 2; ++ai) {
            u32x2 ga[4][2], gb[4][2];
#pragma unroll
            for (int m = 0; m < 4; ++m)
#pragma unroll
                for (int bj = 0; bj < 2; ++bj) { const unsigned char* gp = gp0 + (size_t)(ai * 128 + m * 16) * 4096 + bj * 128; ga[m][bj] = *(const u32x2*)gp; gb[m][bj] = *(const u32x2*)(gp + 1024); }
#pragma unroll
            for (int m = 0; m < 4; ++m)
#pragma unroll
                for (int bj = 0; bj < 2; ++bj)
#pragma unroll
                    for (int i = 0; i < 4; ++i) {
                        const float a0 = fmaxf((float)((ga[m][bj].x >> (8 * i)) & 255u), 1.f), b0 = fmaxf((float)((gb[m][bj].x >> (8 * i)) & 255u), 1.f);
                        const float a1 = fmaxf((float)((ga[m][bj].y >> (8 * i)) & 255u), 1.f), b1 = fmaxf((float)((gb[m][bj].y >> (8 * i)) & 255u), 1.f);
                        acc[ai][bj][m][0][i] *= a0 * __builtin_amdgcn_rcpf(b0); acc[ai][bj][m][1][i] *= a1 * __builtin_amdgcn_rcpf(b1); }
            asm volatile("" ::: "memory");
        }
    }
    __device__ __forceinline__ void operator()(const f32x4 (&acc)[2][2][4][2], const Unit& u, int wr, int wc, int fr, int fq) const {
        const int row0 = u.pm * 256 + wr * 64 + fr; const int col0 = u.pn * 256 + wc * 32 + 8 * fq;
        const unsigned char* gp0 = G + (size_t)row0 * 4096 + 3 * 1024 + col0; bf16_t* mp0 = MG + (size_t)row0 * 1024 + col0;
        u32x2 gb[2][4][2];
#pragma unroll
        for (int ai = 0; ai < 2; ++ai)
#pragma unroll
            for (int m = 0; m < 4; ++m)
#pragma unroll
                for (int bj = 0; bj < 2; ++bj) gb[ai][m][bj] = *(const u32x2*)(gp0 + (size_t)(ai * 128 + m * 16) * 4096 + bj * 128);
#pragma unroll
        for (int ai = 0; ai < 2; ++ai)
#pragma unroll
            for (int m = 0; m < 4; ++m)
#pragma unroll
                for (int bj = 0; bj < 2; ++bj) { const size_t ro = (size_t)(ai * 128 + m * 16); const u32x2 g2 = gb[ai][m][bj];
                    f32x4 v0 = acc[ai][bj][m][0], v1 = acc[ai][bj][m][1];
#pragma unroll
                    for (int i = 0; i < 4; ++i) { v0[i] *= fmaxf((float)((g2.x >> (8 * i)) & 255u), 1.f) * (1.f / 255.f); v1[i] *= fmaxf((float)((g2.y >> (8 * i)) & 255u), 1.f) * (1.f / 255.f); }
                    u32x4 w; w.x = cvt_pk_bf16(v0[0], v0[1]); w.y = cvt_pk_bf16(v0[2], v0[3]); w.z = cvt_pk_bf16(v1[0], v1[1]); w.w = cvt_pk_bf16(v1[2], v1[3]);
                    *(u32x4*)(mp0 + ro * 1024 + bj * 128) = w; }
    }
};

struct EpiResid {
    static constexpr bool PERM = true, AFTER_DRAIN = false, HOOK = false;
    const float* base; float* out; bf16_t* XB; float* SS; int stat;
    __device__ __forceinline__ void operator()(const f32x4 (&acc)[2][2][4][2], const Unit& u, int wr, int wc, int fr, int fq) const {
        const int row0 = u.pm * 256 + wr * 64 + fr; const int col0 = u.pn * 256 + wc * 32 + 8 * fq;
#pragma unroll
        for (int ai = 0; ai < 2; ++ai) {
            f32x4 pre[4][2][2];
#pragma unroll
            for (int m = 0; m < 4; ++m) { const size_t off = (size_t)(row0 + ai * 128 + m * 16) * 1024 + col0;
#pragma unroll
                for (int bj = 0; bj < 2; ++bj) { pre[m][bj][0] = *(const f32x4*)(base + off + bj * 128); pre[m][bj][1] = *(const f32x4*)(base + off + bj * 128 + 4); } }
#pragma unroll
            for (int m = 0; m < 4; ++m) { const int row = row0 + ai * 128 + m * 16; const size_t off = (size_t)row * 1024 + col0; float ssum = 0.f;
#pragma unroll
                for (int bj = 0; bj < 2; ++bj) {
                    const f32x4 o0 = pre[m][bj][0] + acc[ai][bj][m][0], o1 = pre[m][bj][1] + acc[ai][bj][m][1];
                    *(f32x4*)(out + off + bj * 128) = o0; *(f32x4*)(out + off + bj * 128 + 4) = o1;
                    if (stat) { u32x4 w; w.x = cvt_pk_bf16(o0[0], o0[1]); w.y = cvt_pk_bf16(o0[2], o0[3]); w.z = cvt_pk_bf16(o1[0], o1[1]); w.w = cvt_pk_bf16(o1[2], o1[3]);
                        *(u32x4*)(XB + off + bj * 128) = w;
                        ssum += ((o0[0] * o0[0] + o0[1] * o0[1]) + (o0[2] * o0[2] + o0[3] * o0[3])) + ((o1[0] * o1[0] + o1[1] * o1[1]) + (o1[2] * o1[2] + o1[3] * o1[3])); } }
                if (stat) { ssum += __shfl_xor(ssum, 16); ssum += __shfl_xor(ssum, 32); if (fq == 0) atomicAdd(SS + row, ssum); } }
            asm volatile("" ::: "memory");
        }
    }
};

struct EpiSwiGLU {
    static constexpr bool PERM = true, AFTER_DRAIN = false, HOOK = false;
    bf16_t* ACT; const float* SS;
    __device__ __forceinline__ void operator()(const f32x4 (&acc)[2][2][4][2], const Unit& u, int wr, int wc, int fr, int fq) const {
        const int row0 = u.pm * 256 + wr * 64 + fr; const int f0 = u.pn * 128 + wc * 32 + 8 * fq;
#pragma unroll
        for (int ai = 0; ai < 2; ++ai)
#pragma unroll
            for (int m = 0; m < 4; ++m) { f32x4 r[2]; const float rs = __builtin_amdgcn_rsqf(SS[row0 + ai * 128 + m * 16] * (1.f / 1024.f) + EPSN);
#pragma unroll
                for (int n = 0; n < 2; ++n) { const f32x4 g = acc[ai][0][m][n] * rs, up = acc[ai][1][m][n] * rs;
#pragma unroll
                    for (int i = 0; i < 4; ++i) r[n][i] = g[i] * sigmoidf_(g[i]) * up[i]; }
                u32x4 w; w.x = cvt_pk_bf16(r[0][0], r[0][1]); w.y = cvt_pk_bf16(r[0][2], r[0][3]); w.z = cvt_pk_bf16(r[1][0], r[1][1]); w.w = cvt_pk_bf16(r[1][2], r[1][3]);
                *(u32x4*)(ACT + (size_t)(row0 + ai * 128 + m * 16) * DFF + f0) = w; }
    }
};

__device__ __forceinline__ void cvt_item(const float* src, int ld, int col0, int nvalid, int K, bf16_t* WT, int dst_row0, int kb, LAS float* scr, int lane, const float* rs = nullptr) {
    const int k0 = 64 * kb, c = lane & 31;
    float vv[32];
#pragma unroll
    for (int i = 0; i < 32; ++i) { const int kk = 2 * i + (lane >> 5); vv[i] = (c < nvalid) ? src[(size_t)(k0 + kk) * ld + col0 + c] : 0.f; }
    if (rs) {
#pragma unroll
        for (int i = 0; i < 32; ++i) vv[i] *= rs[k0 + 2 * i + (lane >> 5)];
    }
#pragma unroll
    for (int i = 0; i < 32; ++i) scr[(2 * i + (lane >> 5)) * 33 + c] = vv[i];
    LDS_WAIT();
    const int c8 = lane & 7;
#pragma unroll
    for (int j = 0; j < 4; ++j) { const int n = (lane >> 3) + 8 * j; const LAS float* s = scr + (8 * c8) * 33 + n;
        u32x4 o; o.x = cvt_pk_bf16(s[0 * 33], s[1 * 33]); o.y = cvt_pk_bf16(s[2 * 33], s[3 * 33]); o.z = cvt_pk_bf16(s[4 * 33], s[5 * 33]); o.w = cvt_pk_bf16(s[6 * 33], s[7 * 33]);
        *(u32x4*)(WT + (size_t)(dst_row0 + n) * K + k0 + 8 * c8) = o; }
    LDS_WAIT();
}
__device__ __forceinline__ float wave_sum(float v) {
#pragma unroll
    for (int o = 1; o < 64; o <<= 1) v += __shfl_xor(v, o);
    return v;
}
__device__ __forceinline__ float wave_max(float v) {
#pragma unroll
    for (int o = 1; o < 64; o <<= 1) v = fmaxf(v, __shfl_xor(v, o));
    return v;
}
__device__ __forceinline__ void rmsnorm_rows(const float* xs, const float* gamma, bf16_t* XN, int gw, int ngw, int lane) {
    f32x4 gm[4];
#pragma unroll
    for (int j = 0; j < 4; ++j) gm[j] = *(const f32x4*)(gamma + 4 * lane + 256 * j);
    for (int m = gw; m < M_; m += ngw) {
        const f32x4* xr = (const f32x4*)(xs + (size_t)m * DM) + lane; f32x4 v[4]; float s = 0.f;
#pragma unroll
        for (int j = 0; j < 4; ++j) { v[j] = xr[64 * j]; s += (v[j].x * v[j].x + v[j].y * v[j].y) + (v[j].z * v[j].z + v[j].w * v[j].w); }
        const float r = __builtin_amdgcn_rsqf(wave_sum(s) * (1.f / DM) + EPSN);
        u32x2* o8 = (u32x2*)(XN + (size_t)m * DM) + lane;
#pragma unroll
        for (int j = 0; j < 4; ++j) { const f32x4 y = v[j] * r * gm[j]; o8[64 * j] = (u32x2){cvt_pk_bf16(y.x, y.y), cvt_pk_bf16(y.z, y.w)}; }
    }
}

__device__ __forceinline__ void x_to_bf16_ss(const float* xs, bf16_t* XN, float* SS, int gw, int ngw, int lane) {
    for (int m0 = gw * 4; m0 < M_; m0 += ngw * 4) {
        f32x4 v[4][4];
#pragma unroll
        for (int r = 0; r < 4; ++r) { const f32x4* xr = (const f32x4*)(xs + (size_t)(m0 + r) * DM) + lane;
#pragma unroll
            for (int j = 0; j < 4; ++j) v[r][j] = xr[64 * j]; }
#pragma unroll
        for (int r = 0; r < 4; ++r) { float s = 0.f;
#pragma unroll
            for (int j = 0; j < 4; ++j) s += (v[r][j].x * v[r][j].x + v[r][j].y * v[r][j].y) + (v[r][j].z * v[r][j].z + v[r][j].w * v[r][j].w);
            s = wave_sum(s);
            u32x2* o8 = (u32x2*)(XN + (size_t)(m0 + r) * DM) + lane;
#pragma unroll
            for (int j = 0; j < 4; ++j) o8[64 * j] = (u32x2){cvt_pk_bf16(v[r][j].x, v[r][j].y), cvt_pk_bf16(v[r][j].z, v[r][j].w)};
            if (lane == 0) SS[m0 + r] = s; }
    }
}
struct Ptrs {
    const float *mix_g, *ffn_g, *w_in, *qn, *kn, *pool_w, *pool_scale, *gm_norm, *gm_ws, *gm_b, *w_branch, *w_out, *w_gate, *w_up, *w_down;
};

__device__ __forceinline__ void convert_weights(const Ptrs& P, unsigned char* ws, LAS float* scr, int gw, int ngw, int lane, int gtid, int ngt) {
    bf16_t* WinT = (bf16_t*)(ws + WS_WIN); bf16_t* WbT = (bf16_t*)(ws + WS_WB); bf16_t* WoutT = (bf16_t*)(ws + WS_WOUT); bf16_t* WguT = (bf16_t*)(ws + WS_WGU);
    bf16_t* WdT = (bf16_t*)(ws + WS_WD); bf16_t* WpT = (bf16_t*)(ws + WS_WP); bf16_t* Wtril = (bf16_t*)(ws + WS_WS);
    constexpr int I_A = 216 * 16, I_B = 512, I_C = 512, I_D = 176 * 16, I_E = 32 * 44, I_F = 8, NIT = I_A + I_B + I_C + I_D + I_E + I_F;
    for (int it = gw; it < NIT; it += ngw) {
        int r = it;
        if (r < I_A) { const int rb = r >> 4, kb = r & 15, tile = rb >> 3, sub = rb & 7; int col0, nv = 32;
            if (tile <= 1) col0 = tile * 256 + (sub & 3) * 64 + (sub >> 2) * 32;
            else if (tile == 2) col0 = 512 + sub * 32;
            else if (tile == 3) col0 = 768 + sub * 32;
            else if (tile <= 9) col0 = 1064 + (tile - 4) * 256 + sub * 32;
            else if (tile == 10) { col0 = sub == 0 ? 1024 : 1056; nv = sub == 0 ? 32 : (sub == 1 ? 8 : 0); }
            else col0 = 2600 + (tile - 11) * 256 + sub * 32;
            cvt_item(P.w_in, DIN, col0, nv, 1024, WinT, rb * 32, kb, scr, lane, P.mix_g); continue; }
        r -= I_A;
        if (r < I_B) { const int rb = r >> 4, kb = r & 15; cvt_item(P.w_branch, 1024, rb * 32, 32, 1024, WbT, rb * 32, kb, scr, lane); continue; }
        r -= I_B;
        if (r < I_C) { const int rb = r >> 4, kb = r & 15; cvt_item(P.w_out, 1024, rb * 32, 32, 1024, WoutT, rb * 32, kb, scr, lane); continue; }
        r -= I_C;
        if (r < I_D) { const int rb = r >> 4, kb = r & 15, tile = rb >> 3, sub = rb & 7;
            cvt_item((sub >> 2) ? P.w_up : P.w_gate, DFF, tile * 128 + (sub & 3) * 32, 32, 1024, WguT, rb * 32, kb, scr, lane, P.ffn_g); continue; }
        r -= I_D;
        if (r < I_E) { const int rb = r / 44, kb = r % 44; cvt_item(P.w_down, 1024, rb * 32, 32, DFF, WdT, rb * 32, kb, scr, lane); continue; }
        r -= I_E;
        { const int gp = r >> 1, rb = r & 1; cvt_item(P.pool_w + gp * 4096, 64, rb * 32, 32, 64, WpT + gp * 4096, rb * 32, 0, scr, lane); }
    }
    for (int e = gtid; e < 4 * 128 * 128; e += ngt) { const int s = e & 127, t = (e >> 7) & 127; Wtril[e] = (s <= t) ? f2bf(P.gm_ws[e]) : (unsigned short)0; }
}

__device__ __forceinline__ unsigned mono_key(float s) { const unsigned b = __float_as_uint(s); return b ^ ((unsigned)((int)b >> 31) | 0x80000000u); }

#define wr_lane(dst, sval, ln) asm volatile("s_nop 4\n\tv_writelane_b32 %0, %1, %2\n\ts_nop 1" : "+v"(dst) : "s"(sval), "n"(ln))
template <int NBLK> __device__ __forceinline__ unsigned a1_bisect(const unsigned (&v)[64], int& cpre) {
    unsigned prefix = 0u; cpre = 0;
#pragma unroll 1
    for (int bit = 31; bit >= 0; --bit) {
        const unsigned cand = prefix | (1u << bit);
        int cnt = 0;
#pragma unroll
        for (int blk = 0; blk < NBLK; ++blk) {
            unsigned long long bl[8];
#pragma unroll
            for (int k = 0; k < 8; ++k) bl[k] = __ballot(v[blk * 8 + k] >= cand);
            __builtin_amdgcn_sched_barrier(0);
#pragma unroll
            for (int k = 0; k < 8; ++k) cnt += __builtin_popcountll(bl[k]);
            __builtin_amdgcn_sched_barrier(0);
        }
        if (cnt >= 256) { prefix = cand; cpre = cnt; if (cnt == 256) break; }
    }
    return prefix;
}
constexpr int A1_ROWF = 4100;
__device__ __forceinline__ void phase_a1(unsigned char* lds, const bf16_t* IQ, const bf16_t* IK, const float* IW, unsigned short* MASK, int tid, int bid, int G) {
    const int lane = tid & 63, w = __builtin_amdgcn_readfirstlane(tid >> 6), q = lane & 15, g = lane >> 4;
    unsigned* keys = (unsigned*)lds;
#ifndef REP_A1X
#define REP_A1X 1
#endif
    for (int L2 = bid; L2 < 1024 * REP_A1X; L2 += G) {
        const int L = L2 & 1023;
        const int b = L >> 8, c = L & 255, qg = (b & 1) ? 255 - c : c;
        const int row0 = b * SEQ + qg * 16;
        const int nreg = (qg >> 2) + 1;
        if (qg <= 15) {
#pragma unroll
            for (int half = 0; half < 2; ++half) { const int qq = half * 8 + w; const int t = qg * 16 + qq; unsigned mlo = 0u, mhi = 0u;
#pragma unroll
                for (int r = 0; r < 4; ++r) { const unsigned long long bal = __ballot(64 * r + lane <= t);
                    wr_lane(mlo, (unsigned)bal, r); wr_lane(mhi, (unsigned)(bal >> 32), r); }
                if (lane < nreg) *(u32x2*)(MASK + (size_t)(row0 + qq) * 256 + 4 * lane) = (u32x2){mlo, mhi}; }
            continue;
        }
        unsigned u[128];
        {
            bf16x8 iqf[8]; float wv[8];
#pragma unroll
            for (int h = 0; h < 8; ++h) iqf[h] = *(const bf16x8*)(IQ + (size_t)(row0 + q) * 256 + h * 32 + 8 * g);
            { const f32x4 a = *(const f32x4*)(IW + (size_t)(row0 + q) * 8), bq = *(const f32x4*)(IW + (size_t)(row0 + q) * 8 + 4);
              wv[0] = a[0]; wv[1] = a[1]; wv[2] = a[2]; wv[3] = a[3]; wv[4] = bq[0]; wv[5] = bq[1]; wv[6] = bq[2]; wv[7] = bq[3]; }
            bf16x8 kfn[4];
#pragma unroll
            for (int ii = 0; ii < 4; ++ii) kfn[ii] = *(const bf16x8*)(IK + (size_t)(b * SEQ + (8 * ii + w) * 16 + q) * 32 + 8 * g);
#pragma unroll
            for (int blk = 0; blk < 8; ++blk) {
                if (32 * blk + w <= qg) {
                    bf16x8 kf[4];
#pragma unroll
                    for (int ii = 0; ii < 4; ++ii) kf[ii] = kfn[ii];
                    if (blk < 7) {
#pragma unroll
                        for (int ii = 0; ii < 4; ++ii) { const int kt = 8 * (4 * (blk + 1) + ii) + w; kfn[ii] = *(const bf16x8*)(IK + (size_t)(b * SEQ + kt * 16 + q) * 32 + 8 * g); }
                    }
#pragma unroll
                    for (int ii = 0; ii < 4; ++ii) { const int i = 4 * blk + ii; const int kt = 8 * i + w;
                        f32x4 s = {0.f, 0.f, 0.f, 0.f};
#pragma unroll
                        for (int h = 0; h < 8; ++h) { const f32x4 a = mfma16(kf[ii], iqf[h], (f32x4){0.f, 0.f, 0.f, 0.f});
#pragma unroll
                            for (int j = 0; j < 4; ++j) s[j] = __builtin_fmaf(wv[h], fmaxf(a[j], 0.f), s[j]); }
#pragma unroll
                        for (int j = 0; j < 4; ++j) { unsigned uu = mono_key(s[j]); if (kt > qg || (kt == qg && (4 * g + j) > q)) uu = 0u; u[4 * i + j] = uu; }
                    }
                } else {
#pragma unroll
                    for (int r = 0; r < 16; ++r) u[16 * blk + r] = 0u;
                }
            }
        }
#pragma unroll 1
        for (int half = 0; half < 2; ++half) {
            if ((q >> 3) == half) {
                unsigned* krow = keys + (q & 7) * A1_ROWF + 4 * g;
#pragma unroll
                for (int i = 0; i < 32; ++i) { const int kt = 8 * i + w; *(u32x4*)(krow + kt * 16) = (u32x4){u[4 * i], u[4 * i + 1], u[4 * i + 2], u[4 * i + 3]}; }
            }
            __syncthreads();
            {
                const int qq = half * 8 + w; const unsigned* krow = keys + w * A1_ROWF + lane;
                unsigned v[64];
#pragma unroll
                for (int blk = 0; blk < 8; ++blk) {
                    if (nreg > blk * 8) {
#pragma unroll
                        for (int r = blk * 8; r < blk * 8 + 8; ++r) v[r] = krow[64 * r];
                    } else {
#pragma unroll
                        for (int r = blk * 8; r < blk * 8 + 8; ++r) v[r] = 0u;
                    }
                }
#ifndef REP_BIS
#define REP_BIS 1
#endif
                unsigned prefix; int cpre = 0;
#pragma unroll 1
                for (int rb_ = 0; rb_ < REP_BIS; ++rb_)
                switch ((nreg + 7) >> 3) {
                    case 1: prefix = a1_bisect<1>(v, cpre); break; case 2: prefix = a1_bisect<2>(v, cpre); break; case 3: prefix = a1_bisect<3>(v, cpre); break; case 4: prefix = a1_bisect<4>(v, cpre); break;
                    case 5: prefix = a1_bisect<5>(v, cpre); break; case 6: prefix = a1_bisect<6>(v, cpre); break; case 7: prefix = a1_bisect<7>(v, cpre); break; default: prefix = a1_bisect<8>(v, cpre); break;
                }
                const unsigned thr = prefix > 1u ? prefix : 1u;
                unsigned mlo = 0u, mhi = 0u;
                if (cpre == 256) {
#pragma unroll
                    for (int r = 0; r < 64; ++r) { const unsigned long long bal = __ballot(v[r] >= thr); wr_lane(mlo, (unsigned)bal, r); wr_lane(mhi, (unsigned)(bal >> 32), r); }
                } else {
                    int rem = 256;
#pragma unroll
                    for (int r = 0; r < 64; ++r) rem -= __builtin_popcountll(__ballot(v[r] > thr));
#pragma unroll
                    for (int r = 0; r < 64; ++r) { unsigned long long bal = __ballot(v[r] > thr); unsigned long long eq = __ballot(v[r] == thr);
                        const int ne = __builtin_popcountll(eq);
                        if (ne <= rem) { bal |= eq; rem -= ne; }
                        else { while (rem > 0) { const unsigned long long low = eq & (0ull - eq); bal |= low; eq ^= low; --rem; } }
                        wr_lane(mlo, (unsigned)bal, r); wr_lane(mhi, (unsigned)(bal >> 32), r); }
                }
                if (lane < nreg) *(u32x2*)(MASK + (size_t)(row0 + qq) * 256 + 4 * lane) = (u32x2){mlo, mhi};
            }
            __syncthreads();
        }
    }
}

__device__ __forceinline__ void phase_a2(unsigned char* lds, const bf16_t* QA, bf16_t* OA, const bf16_t* KA, const bf16_t* VTA, const unsigned short* MASK,
                                         const float* qn, const float* kn, int tid, int bid, int G) {
    const int lane = tid & 63, w = __builtin_amdgcn_readfirstlane(tid >> 6), q = lane & 15, g = lane >> 4;
    bf16_t* Kt = (bf16_t*)lds;
    bf16_t* Vt = (bf16_t*)(lds + 2 * 64 * 72 * 2);
    const float msh = LOG2E * 8.f * wave_max(fabsf(qn[lane])) * wave_max(fabsf(kn[lane])) * 1.02f + 0.25f;
    const int srow = tid >> 3, sch = tid & 7;
    for (int L = bid; L < 512; L += G) {
        const int jj = L >> 8, c = L & 255, bh = c >> 4, qb = jj ? 31 - (c & 15) : (c & 15);
        const int b = bh >> 2, h = bh & 3;
        const int qgw = qb * 8 + w;
        const int row0 = b * SEQ + qb * 128 + 16 * w;
        bf16x8 qf[2];
#pragma unroll
        for (int hf = 0; hf < 2; ++hf) qf[hf] = *(const bf16x8*)(QA + (size_t)(row0 + q) * 256 + h * 64 + hf * 32 + 8 * g);
        const unsigned short* mrow = MASK + (size_t)(row0 + q) * 256;
        const int nsteps = 2 * qb + 2;
        const bf16_t* ksrc = KA + (size_t)(b * SEQ + srow) * 256 + h * 64 + sch * 8;
        const bf16_t* vsrc = VTA + (size_t)(b * 256 + h * 64 + srow) * SEQ + sch * 8;
        u32x4 kA = *(const u32x4*)ksrc, vA = *(const u32x4*)vsrc, kB = kA, vB = vA;
        u32x2 mE = *(const u32x2*)mrow, mO = mE;
        *(u32x4*)(Kt + srow * 72 + sch * 8) = kA; *(u32x4*)(Vt + srow * 72 + sch * 8) = vA;
        if (nsteps > 1) { kB = *(const u32x4*)(ksrc + (size_t)64 * 256); vB = *(const u32x4*)(vsrc + 64); mO = *(const u32x2*)(mrow + 4); }
        f32x4 o[4]; float lsum = 0.f; const f32x4 negm = {-msh, -msh, -msh, -msh};
#pragma unroll
        for (int d = 0; d < 4; ++d) o[d] = (f32x4){0.f, 0.f, 0.f, 0.f};
        __syncthreads();
#define A2_COMPUTE(st, buf, mcur) do { \
            const bf16_t* kb_ = Kt + (buf) * 64 * 72; const bf16_t* vb_ = Vt + (buf) * 64 * 72; \
            _Pragma("unroll") for (int p = 0; p < 2; ++p) { \
                const int kt0 = (st) * 4 + 2 * p; \
                if (kt0 <= qgw) { \
                    const unsigned mw = p ? (mcur).y : (mcur).x; \
                    const unsigned nib0 = (mw >> (4 * g)) & 15u, nib1 = (kt0 + 1 <= qgw) ? ((mw >> (16 + 4 * g)) & 15u) : 0u; \
                    const bf16_t* kr0 = kb_ + (p * 32 + q) * 72 + 8 * g; const bf16_t* kr1 = kr0 + 16 * 72; \
                    f32x4 a0 = mfma16(*(const bf16x8*)kr0, qf[0], negm); a0 = mfma16(*(const bf16x8*)(kr0 + 32), qf[1], a0); \
                    f32x4 a1 = mfma16(*(const bf16x8*)kr1, qf[0], negm); a1 = mfma16(*(const bf16x8*)(kr1 + 32), qf[1], a1); \
                    float p0[4], p1[4]; \
                    _Pragma("unroll") for (int j = 0; j < 4; ++j) { p0[j] = ((nib0 >> j) & 1u) ? __builtin_amdgcn_exp2f(a0[j]) : 0.f; p1[j] = ((nib1 >> j) & 1u) ? __builtin_amdgcn_exp2f(a1[j]) : 0.f; } \
                    lsum += ((p0[0] + p0[1]) + (p0[2] + p0[3])) + ((p1[0] + p1[1]) + (p1[2] + p1[3])); \
                    const bf16x8 pf = mk8(cvt_pk_bf16(p0[0], p0[1]), cvt_pk_bf16(p0[2], p0[3]), cvt_pk_bf16(p1[0], p1[1]), cvt_pk_bf16(p1[2], p1[3])); \
                    _Pragma("unroll") for (int d = 0; d < 4; ++d) { const bf16_t* vr = vb_ + (d * 16 + q) * 72 + p * 32 + 4 * g; \
                        const u32x2 lo = *(const u32x2*)vr, hi = *(const u32x2*)(vr + 16); \
                        o[d] = mfma16(mk8(lo.x, lo.y, hi.x, hi.y), pf, o[d]); } \
                } } } while (0)
        for (int st = 0; st < nsteps; st += 2) {
            {
                const bool more2 = st + 2 < nsteps; u32x2 mEn = mE;
                if (more2) { kA = *(const u32x4*)(ksrc + (size_t)(st + 2) * 64 * 256); vA = *(const u32x4*)(vsrc + (st + 2) * 64); mEn = *(const u32x2*)(mrow + (st + 2) * 4); }
                A2_COMPUTE(st, 0, mE);
                *(u32x4*)(Kt + 64 * 72 + srow * 72 + sch * 8) = kB; *(u32x4*)(Vt + 64 * 72 + srow * 72 + sch * 8) = vB;
                __syncthreads();
                mE = mEn;
            }
            {
                const int s1 = st + 1; const bool more2 = s1 + 2 < nsteps; u32x2 mOn = mO;
                if (more2) { kB = *(const u32x4*)(ksrc + (size_t)(s1 + 2) * 64 * 256); vB = *(const u32x4*)(vsrc + (s1 + 2) * 64); mOn = *(const u32x2*)(mrow + (s1 + 2) * 4); }
                A2_COMPUTE(s1, 1, mO);
                if (s1 + 1 < nsteps) { *(u32x4*)(Kt + srow * 72 + sch * 8) = kA; *(u32x4*)(Vt + srow * 72 + sch * 8) = vA; }
                __syncthreads();
                mO = mOn;
            }
        }
#undef A2_COMPUTE
        lsum += __shfl_xor(lsum, 16); lsum += __shfl_xor(lsum, 32);
        const float inv = 1.f / lsum;
#pragma unroll
        for (int d = 0; d < 4; ++d) { const f32x4 v = o[d] * inv;
            *(u32x2*)(OA + (size_t)(row0 + q) * 1024 + h * 64 + d * 16 + 4 * g) = (u32x2){cvt_pk_bf16(v[0], v[1]), cvt_pk_bf16(v[2], v[3])}; }
    }
}

__device__ __forceinline__ void phase_b(const bf16_t* PIN, const bf16_t* WpT, const float* pscale, bf16_t* OB, int gw, int ngw, int lane) {
    const int q = lane & 15, g4 = lane >> 4;
    for (int L = gw; L < 4096; L += ngw) {
        const int gp = L >> 10, tg = L & 1023; const int row = tg * 16 + q; const int t = row & (SEQ - 1);
        const int win = 2 << gp; const int cnt = (t + 1 < win) ? t + 1 : win; const float inv = 1.f / (float)cnt;
        f32x4 acc[4];
#pragma unroll
        for (int d = 0; d < 4; ++d) acc[d] = (f32x4){0.f, 0.f, 0.f, 0.f};
#pragma unroll
        for (int ch = 0; ch < 2; ++ch) {
            const bf16_t* p = PIN + (size_t)row * 256 + gp * 64 + ch * 32 + 8 * g4;
            u32x4 wv[16];
#pragma unroll
            for (int i = 0; i < 16; ++i) { wv[i] = (u32x4){0u, 0u, 0u, 0u}; if (i < win && i <= t) wv[i] = *(const u32x4*)(p - (size_t)i * 256); }
            float own[8], sum[8];
            own[0] = bflo(wv[0].x); own[1] = bfhi(wv[0].x); own[2] = bflo(wv[0].y); own[3] = bfhi(wv[0].y); own[4] = bflo(wv[0].z); own[5] = bfhi(wv[0].z); own[6] = bflo(wv[0].w); own[7] = bfhi(wv[0].w);
#pragma unroll
            for (int k = 0; k < 8; ++k) sum[k] = own[k];
#pragma unroll
            for (int i = 1; i < 16; ++i) { const u32x4 v = wv[i];
                sum[0] += bflo(v.x); sum[1] += bfhi(v.x); sum[2] += bflo(v.y); sum[3] += bfhi(v.y); sum[4] += bflo(v.z); sum[5] += bfhi(v.z); sum[6] += bflo(v.w); sum[7] += bfhi(v.w); }
            float pl[8];
#pragma unroll
            for (int k = 0; k < 8; ++k) pl[k] = sum[k] * inv - own[k];
            const bf16x8 bfr = mk8(cvt_pk_bf16(pl[0], pl[1]), cvt_pk_bf16(pl[2], pl[3]), cvt_pk_bf16(pl[4], pl[5]), cvt_pk_bf16(pl[6], pl[7]));
#pragma unroll
            for (int d = 0; d < 4; ++d) { const bf16x8 afr = *(const bf16x8*)(WpT + gp * 4096 + (d * 16 + q) * 64 + ch * 32 + 8 * g4); acc[d] = mfma16(afr, bfr, acc[d]); }
        }
#pragma unroll
        for (int d = 0; d < 4; ++d) { const int d0 = d * 16 + 4 * g4; const f32x4 sc = *(const f32x4*)(pscale + gp * 64 + d0); const f32x4 v = acc[d] * sc;
            *(u32x2*)(OB + (size_t)row * 1024 + gp * 64 + d0) = (u32x2){cvt_pk_bf16(v[0], v[1]), cvt_pk_bf16(v[2], v[3])}; }
    }
}

__device__ __forceinline__ void phase_c(unsigned char* lds, const bf16_t* GV, const bf16_t* GU, bf16_t* OC, const float* gamma, const bf16_t* Wtril, const float* gbias, int tid, int bid, int G) {
    bf16_t* LT = (bf16_t*)lds;
    const int lane = tid & 63, w = __builtin_amdgcn_readfirstlane(tid >> 6), q = lane & 15, g4 = lane >> 4;
    for (int L = bid; L < 512; L += G) {
        const int gp = L & 3, chk = L >> 2; const int R0 = chk * 128;
        {
            const int row = tid >> 2, part = tid & 3;
            const bf16_t* src = GV + (size_t)(R0 + row) * 256 + part * 64;
            float x[64];
#pragma unroll
            for (int k8 = 0; k8 < 8; ++k8) { const u32x4 v = *(const u32x4*)(src + 8 * k8);
                x[8 * k8 + 0] = bflo(v.x); x[8 * k8 + 1] = bfhi(v.x); x[8 * k8 + 2] = bflo(v.y); x[8 * k8 + 3] = bfhi(v.y); x[8 * k8 + 4] = bflo(v.z); x[8 * k8 + 5] = bfhi(v.z); x[8 * k8 + 6] = bflo(v.w); x[8 * k8 + 7] = bfhi(v.w); }
            float s = 0.f;
#pragma unroll
            for (int k = 0; k < 64; ++k) s += x[k];
            s += __shfl_xor(s, 1); s += __shfl_xor(s, 2);
            const float mean = s * (1.f / 256.f); float ss = 0.f;
#pragma unroll
            for (int k = 0; k < 64; ++k) { const float dd = x[k] - mean; ss += dd * dd; }
            ss += __shfl_xor(ss, 1); ss += __shfl_xor(ss, 2);
            const float rstd = __builtin_amdgcn_rsqf(ss * (1.f / 256.f) + EPSN);
            if (part == gp) {
#pragma unroll
                for (int k4 = 0; k4 < 16; ++k4) { const f32x4 gm = *(const f32x4*)(gamma + gp * 64 + 4 * k4);
#pragma unroll
                    for (int i = 0; i < 4; ++i) LT[(4 * k4 + i) * 136 + row] = f2bf((x[4 * k4 + i] - mean) * rstd * gm[i]); }
            }
        }
        __syncthreads();
        {
            f32x4 acc[4];
#pragma unroll
            for (int d = 0; d < 4; ++d) acc[d] = (f32x4){0.f, 0.f, 0.f, 0.f};
            const int t = 16 * w + q; const int nsb = ((16 * w + 15) >> 5) + 1;
            for (int sb = 0; sb < nsb; ++sb) {
                const bf16x8 bfr = *(const bf16x8*)(Wtril + ((size_t)gp * 128 + t) * 128 + sb * 32 + 8 * g4);
#pragma unroll
                for (int d = 0; d < 4; ++d) { const bf16x8 afr = *(const bf16x8*)(LT + (d * 16 + q) * 136 + sb * 32 + 8 * g4); acc[d] = mfma16(afr, bfr, acc[d]); }
            }
            const float bias = gbias[gp * 128 + t];
#pragma unroll
            for (int d = 0; d < 4; ++d) { const size_t eo = (size_t)(R0 + t) * 256 + gp * 64 + d * 16 + 4 * g4; const u32x2 uu = *(const u32x2*)(GU + eo);
                const float r0 = bflo(uu.x) * (acc[d][0] + bias), r1 = bfhi(uu.x) * (acc[d][1] + bias), r2 = bflo(uu.y) * (acc[d][2] + bias), r3 = bfhi(uu.y) * (acc[d][3] + bias);
                *(u32x2*)(OC + (size_t)(R0 + t) * 1024 + gp * 64 + d * 16 + 4 * g4) = (u32x2){cvt_pk_bf16(r0, r1), cvt_pk_bf16(r2, r3)}; }
        }
        __syncthreads();
    }
}

__device__ __forceinline__ void sb_tile(const f32x4 z, int kbase, int tq, int g, float& carry, float (&a)[4]) {
    float lm[4]; bool msk[4];
#pragma unroll
    for (int j = 0; j < 4; ++j) { msk[j] = (kbase + 4 * g + j) >= tq;
        const float e = __builtin_amdgcn_exp2f(-fabsf(z[j]) * LOG2E); const float sp = fmaxf(z[j], 0.f) + __builtin_amdgcn_logf(1.f + e) * LN2;
        lm[j] = msk[j] ? 0.f : -sp; }
    const float suf2 = lm[3], suf1 = lm[3] + lm[2], suf0 = suf1 + lm[1]; const float T = suf0 + lm[0];
    const float x16 = __shfl_xor(T, 16); const float Pp = T + x16; const float Qq = __shfl_xor(Pp, 32);
    const float Sg = ((g & 1) ? 0.f : x16) + ((g & 2) ? 0.f : Qq);
    const float base = carry + Sg;
    const float tl[4] = {base + suf0, base + suf1, base + suf2, base};
#pragma unroll
    for (int j = 0; j < 4; ++j) a[j] = msk[j] ? 0.f : __builtin_amdgcn_exp2f((z[j] + lm[j] + tl[j]) * LOG2E);
    carry += Pp + Qq;
}
__device__ __forceinline__ void phase_d(const bf16_t* SQ, bf16_t* OD, const bf16_t* SK, const bf16_t* VTS, int gw, int ngw, int lane) {
    const int q = lane & 15, g = lane >> 4;
    for (int L = gw; L < 2048; L += ngw) {
        const int qg = L & 255, bh = L >> 8, b0 = bh >> 2, h = bh & 3;
        const int tq = qg * 16 + q;
        bf16x8 qf[2][2]; f32x4 o[2][4]; float carry[2] = {0.f, 0.f};
#pragma unroll
        for (int u = 0; u < 2; ++u) { const int row0 = (b0 + 2 * u) * SEQ + qg * 16;
#pragma unroll
            for (int hf = 0; hf < 2; ++hf) qf[u][hf] = *(const bf16x8*)(SQ + (size_t)(row0 + q) * 256 + h * 64 + hf * 32 + 8 * g);
#pragma unroll
            for (int d = 0; d < 4; ++d) o[u][d] = (f32x4){0.f, 0.f, 0.f, 0.f}; }
        bf16x8 kn[2][4]; u32x2 vn[2][8];
#define D_LOAD(ppx) do { const int k0_ = (ppx) * 32; _Pragma("unroll") for (int u = 0; u < 2; ++u) { const int b = b0 + 2 * u; \
                const bf16_t* kb = SK + (size_t)(b * SEQ + k0_ + q) * 256 + h * 64 + 8 * g; \
                _Pragma("unroll") for (int i = 0; i < 4; ++i) kn[u][i] = *(const bf16x8*)(kb + (size_t)(i >> 1) * 16 * 256 + (i & 1) * 32); \
                const bf16_t* vb = VTS + (size_t)(b * 256 + h * 64 + q) * SEQ + k0_ + 4 * g; \
                _Pragma("unroll") for (int d = 0; d < 4; ++d) { vn[u][2 * d] = *(const u32x2*)(vb + (size_t)d * 16 * SEQ); vn[u][2 * d + 1] = *(const u32x2*)(vb + (size_t)d * 16 * SEQ + 16); } } } while (0)
        D_LOAD(qg >> 1);
        for (int pp = qg >> 1; pp >= 0; --pp) {
            const int kt0 = 2 * pp, kt1 = kt0 + 1;
            bf16x8 kc[2][4]; u32x2 vc[2][8];
#pragma unroll
            for (int u = 0; u < 2; ++u) {
#pragma unroll
                for (int i = 0; i < 4; ++i) kc[u][i] = kn[u][i];
#pragma unroll
                for (int i = 0; i < 8; ++i) vc[u][i] = vn[u][i]; }
            D_LOAD(pp > 0 ? pp - 1 : 0);
            float a0[2][4], a1[2][4];
#pragma unroll
            for (int u = 0; u < 2; ++u) {
                if (kt1 <= qg) {
                    f32x4 z = mfma16(kc[u][2], qf[u][0], (f32x4){0.f, 0.f, 0.f, 0.f}); z = mfma16(kc[u][3], qf[u][1], z);
                    sb_tile(z, kt1 * 16, tq, g, carry[u], a1[u]);
                } else {
#pragma unroll
                    for (int j = 0; j < 4; ++j) a1[u][j] = 0.f;
                }
            }
#pragma unroll
            for (int u = 0; u < 2; ++u) {
                f32x4 z = mfma16(kc[u][0], qf[u][0], (f32x4){0.f, 0.f, 0.f, 0.f}); z = mfma16(kc[u][1], qf[u][1], z);
                sb_tile(z, kt0 * 16, tq, g, carry[u], a0[u]);
            }
#pragma unroll
            for (int u = 0; u < 2; ++u) {
                const bf16x8 pf = mk8(cvt_pk_bf16(a0[u][0], a0[u][1]), cvt_pk_bf16(a0[u][2], a0[u][3]), cvt_pk_bf16(a1[u][0], a1[u][1]), cvt_pk_bf16(a1[u][2], a1[u][3]));
#pragma unroll
                for (int d = 0; d < 4; ++d) o[u][d] = mfma16(mk8(vc[u][2 * d].x, vc[u][2 * d].y, vc[u][2 * d + 1].x, vc[u][2 * d + 1].y), pf, o[u][d]);
            }
            if (__all(carry[0] < -104.f && carry[1] < -104.f)) break;
        }
#undef D_LOAD
#pragma unroll
        for (int u = 0; u < 2; ++u) { const int row0 = (b0 + 2 * u) * SEQ + qg * 16;
#pragma unroll
            for (int d = 0; d < 4; ++d) *(u32x2*)(OD + (size_t)(row0 + q) * 1024 + h * 64 + d * 16 + 4 * g) = (u32x2){cvt_pk_bf16(o[u][d][0], o[u][d][1]), cvt_pk_bf16(o[u][d][2], o[u][d][3])}; }
    }
}

#define XB_TMO      128
#define XB_XCNT(j)  (256  + 64 * (j))
#define XB_XSUB(j)  (1280 + 64 * (j))
#define XB_XGEN(j)  (2304 + 64 * (j))
#define XB_TOP      3328
#define XB_TOPGEN   3392
#define XCD_BAR_WORDS 3456
#define XB_SPIN_CAP (1u << 18)

__device__ __forceinline__ unsigned xb_ld(unsigned* p)              { return __hip_atomic_load(p, __ATOMIC_RELAXED, __HIP_MEMORY_SCOPE_AGENT); }
__device__ __forceinline__ unsigned xb_add(unsigned* p, unsigned v) { return __hip_atomic_fetch_add(p, v, __ATOMIC_RELAXED, __HIP_MEMORY_SCOPE_AGENT); }
__device__ __forceinline__ unsigned xb_xcc_id() { return (unsigned)__builtin_amdgcn_s_getreg((3 << 11) | 20) & 0xFu; }
#define XB_SPIN(cond, bar) do { unsigned _sp = 0; while (cond) { __builtin_amdgcn_s_sleep(1); \
    if ((++_sp & 255u) == 0u) { if (xb_ld(&(bar)[XB_TMO])) break; if (_sp > XB_SPIN_CAP) { atomicAdd(&(bar)[XB_TMO], 1u); break; } } } } while (0)

struct XcdBarrier {
    unsigned* bar; unsigned x;
    volatile LAS unsigned* st;
};

__device__ __forceinline__ XcdBarrier xcd_barrier_post(unsigned* bar, volatile LAS unsigned* st) {
    XcdBarrier b; b.bar = bar; b.x = xb_xcc_id(); b.st = st;
    if (threadIdx.x == 0) (void)xb_add(&bar[XB_XCNT(b.x)], 1u);
    return b;
}
__device__ __forceinline__ void xcd_barrier_complete(unsigned* bar, unsigned x, unsigned& nloc, unsigned& nx) {
    const unsigned G = gridDim.x * gridDim.y * gridDim.z;
    unsigned sum, cnt, mine, sp = 0u;
    for (;;) {
        sum = 0u; cnt = 0u; mine = 0u;
#pragma unroll
        for (unsigned j = 0; j < 16; ++j) { const unsigned c = xb_ld(&bar[XB_XCNT(j)]); sum += c; cnt += (c > 0u) ? 1u : 0u; mine = (j == x) ? c : mine; }
        if (sum == G) break;
        __builtin_amdgcn_s_sleep(1);
        if ((++sp & 255u) == 0u) { if (xb_ld(&bar[XB_TMO])) break; if (sp > XB_SPIN_CAP) { atomicAdd(&bar[XB_TMO], 1u); break; } }
    }
    nloc = mine > 0u ? mine : 1u; nx = cnt > 0u ? cnt : 1u;
}

__device__ __forceinline__ void xcd_barrier(const XcdBarrier& b) {
    asm volatile("s_waitcnt vmcnt(0)" ::: "memory");
    __syncthreads();
    if (threadIdx.x == 0) {
        unsigned* bar = b.bar;
        __builtin_amdgcn_s_waitcnt(0);
        unsigned nloc = b.st[0], nx = b.st[1];
        if (nloc == 0u) { xcd_barrier_complete(bar, b.x, nloc, nx); b.st[0] = nloc; b.st[1] = nx; }
        const unsigned old = xb_add(&bar[XB_XSUB(b.x)], 1u);
        const unsigned gen = old / nloc;
        if (old + 1u == (gen + 1u) * nloc) {
            __builtin_amdgcn_fence(__ATOMIC_RELEASE, "agent");
            asm volatile("s_waitcnt vmcnt(0)" ::: "memory");
            const unsigned og = xb_add(&bar[XB_TOP], 1u);
            const unsigned tg = og / nx;
            if (og + 1u == (tg + 1u) * nx) xb_add(&bar[XB_TOPGEN], 1u);
            else XB_SPIN(xb_ld(&bar[XB_TOPGEN]) == tg, bar);
            __builtin_amdgcn_fence(__ATOMIC_ACQUIRE, "agent");
            xb_add(&bar[XB_XGEN(b.x)], 1u);
            asm volatile("s_waitcnt vmcnt(0)" ::: "memory");
        } else {
            XB_SPIN(xb_ld(&bar[XB_XGEN(b.x)]) == gen, bar);
            __builtin_amdgcn_fence(__ATOMIC_ACQUIRE, "agent");
            asm volatile("s_waitcnt vmcnt(0)" ::: "memory");
        }
    }
    __syncthreads();
}

#ifndef REP_P0
#define REP_P0 1
#endif
#ifndef REP_P1
#define REP_P1 1
#endif
#ifndef REP_A1
#define REP_A1 1
#endif
#ifndef REP_BCD
#define REP_BCD 1
#endif
#ifndef REP_A2
#define REP_A2 1
#endif
#ifndef REP_MG
#define REP_MG 1
#endif
#ifndef REP_UP
#define REP_UP 1
#endif
#ifndef REP_WO
#define REP_WO 1
#endif
#ifndef REP_N2
#define REP_N2 1
#endif
#ifndef REP_DN
#define REP_DN 1
#endif
#ifndef REP_B
#define REP_B 1
#endif
#ifndef REP_C
#define REP_C 1
#endif
#ifndef REP_D
#define REP_D 1
#endif
#ifndef REP_SYNC
#define REP_SYNC 1
#endif
#define GSYNC() do { _Pragma("unroll 1") for (int r_ = 0; r_ < REP_SYNC; ++r_) xcd_barrier(bar); } while (0)
#define REPEAT(n) _Pragma("unroll 1") for (int rep_ = 0; rep_ < (n); ++rep_)
struct Args { const float* in[16]; float* out; unsigned char* ws; };
constexpr int LDS_BYTES = 147456;
__device__ __forceinline__ unsigned char* opq(unsigned char* p) { asm volatile("" : "+s"(p)); return p; }
__device__ __forceinline__ int opq_tid() { int t = threadIdx.x; asm volatile("" : "+v"(t)); return t; }
#define WSB(T, off) ((T*)(ws + (off)))
constexpr int PTAB_OFF = 147456 - 512, BST_OFF = 147456 - 64;
__device__ __forceinline__ void* ldp(PG8_LAS unsigned char* ldsl, int i) {
    unsigned off = PTAB_OFF + 8 * i; asm volatile("" : "+v"(off));
    const unsigned long long v = *(volatile LAS unsigned long long*)(ldsl + off);
    const unsigned lo = __builtin_amdgcn_readfirstlane((unsigned)v), hi = __builtin_amdgcn_readfirstlane((unsigned)(v >> 32));
    return (void*)(__attribute__((address_space(1))) void*)(((unsigned long long)hi << 32) | lo);
}

__global__ void __launch_bounds__(512, 2) fwd_kernel(Args a) {
    extern __shared__ __attribute__((aligned(16))) unsigned char lds[];
    cg::grid_group grid = cg::this_grid();
    PG8_LAS unsigned char* ldsl = (PG8_LAS unsigned char*)lds;
    if (a.ws == nullptr) grid.sync();
    if (threadIdx.x == 0) { ((volatile LAS unsigned*)(ldsl + BST_OFF))[0] = 0u; ((volatile LAS unsigned*)(ldsl + BST_OFF))[1] = 0u; }
    if (threadIdx.x == 0) { LAS unsigned long long* tb = (LAS unsigned long long*)(ldsl + PTAB_OFF);
#pragma unroll
        for (int i = 0; i < 16; ++i) tb[i] = (unsigned long long)a.in[i];
        tb[16] = (unsigned long long)a.out; tb[17] = (unsigned long long)a.ws; }
    __syncthreads();
    XcdBarrier bar = xcd_barrier_post((unsigned*)a.ws + 1024, (volatile LAS unsigned*)(ldsl + BST_OFF));
#define INP(i) ((const float*)ldp(ldsl, (i)))
#define OUTP ((float*)ldp(ldsl, 16))
#define WSP ((unsigned char*)ldp(ldsl, 17))

#define PHASE_VARS unsigned char* ws = WSP; int bid = blockIdx.x; asm volatile("" : "+s"(bid)); int G = gridDim.x; asm volatile("" : "+s"(G)); \
    const int tid = opq_tid(), lane = tid & 63, wave = __builtin_amdgcn_readfirstlane(tid >> 6); const int gw = bid * 8 + wave, ngw = G * 8; (void)ws; (void)lane; (void)gw; (void)ngw;
#ifndef REP_ALL
#define REP_ALL 1
#endif
#pragma unroll 1
    for (int ll = 0; ll < 2 * REP_ALL; ++ll) {
        const int l = ll & 1;
        REPEAT(REP_P0) {
            PHASE_VARS
#ifndef NO_CVT
            Ptrs P; P.mix_g = INP(1) + l * DM; P.ffn_g = INP(12) + l * DM;
            P.w_in = INP(2) + (size_t)l * DM * DIN; P.qn = INP(3) + l * 64; P.kn = INP(4) + l * 64; P.pool_w = INP(5) + l * 4 * 64 * 64; P.pool_scale = INP(6) + l * 256;
            P.gm_norm = INP(7) + l * 256; P.gm_ws = INP(8) + l * 4 * 128 * 128; P.gm_b = INP(9) + l * 4 * 128; P.w_branch = INP(10) + (size_t)l * 4 * 256 * 1024;
            P.w_out = INP(11) + (size_t)l * 1024 * 1024; P.w_gate = INP(13) + (size_t)l * DM * DFF; P.w_up = INP(14) + (size_t)l * DM * DFF; P.w_down = INP(15) + (size_t)l * DFF * DM;
            convert_weights(P, ws, (LAS float*)(ldsl + wave * 8448), gw, ngw, lane, bid * 512 + tid, G * 512);
#endif
            if (l == 0) x_to_bf16_ss(INP(0), WSB(bf16_t, WS_XN), WSB(float, WS_SS0), gw, ngw, lane);
        }
        GSYNC();
        REPEAT(REP_P1) {
            PHASE_VARS
            pg8::Gemm g{WSB(bf16_t, WS_XN), WSB(bf16_t, WS_WIN), M_, NINP, DM}; pg8::StaticOrder S; S.init(M_, NINP, G, bid);
            EpiIn E{ws, INP(3) + l * 64, INP(4) + l * 64, WSB(float, WS_SS0)};
#ifndef NO_G1
            pg8::gemm_phase<EpiIn, pg8::StaticOrder, true, true>(ldsl, g, S, E);
#endif
        }
        GSYNC();
        REPEAT(REP_A1) {
            PHASE_VARS
            for (int i = bid * 512 + tid; i < M_; i += G * 512) { WSB(float, WS_SS0)[i] = 0.f; WSB(float, WS_SS1)[i] = 0.f; }
#ifndef NO_A1
            phase_a1(lds, WSB(bf16_t, WS_IQ), WSB(bf16_t, WS_IK), WSB(float, WS_IW), WSB(unsigned short, WS_MASK), tid, bid, G);
#endif
            __syncthreads();
        }
        REPEAT(REP_BCD) {
        REPEAT(REP_C) {
            PHASE_VARS
#ifndef NO_C
            phase_c(lds, WSB(bf16_t, WS_GV), WSB(bf16_t, WS_GU), WSB(bf16_t, WS_OCAT) + 512, INP(7) + l * 256, WSB(bf16_t, WS_WS), INP(9) + l * 4 * 128, tid, bid, G);
#endif
        }
        REPEAT(REP_B) {
            PHASE_VARS
#ifndef NO_B
            phase_b(WSB(bf16_t, WS_PIN), WSB(bf16_t, WS_WP), INP(6) + l * 256, WSB(bf16_t, WS_OCAT) + 256, gw, ngw, lane);
#endif
        }
        REPEAT(REP_D) {
            PHASE_VARS
#ifndef NO_D
            phase_d(WSB(bf16_t, WS_SQ), WSB(bf16_t, WS_OCAT) + 768, WSB(bf16_t, WS_SK), WSB(bf16_t, WS_VTS), gw, ngw, lane);
#endif
        }
        }
        GSYNC();
        REPEAT(REP_A2) {
            PHASE_VARS
#ifndef NO_A2
            phase_a2(lds, WSB(bf16_t, WS_QA), WSB(bf16_t, WS_OCAT), WSB(bf16_t, WS_KA), WSB(bf16_t, WS_VTA), WSB(unsigned short, WS_MASK), INP(3) + l * 64, INP(4) + l * 64, tid, bid, G);
#endif
        }
        GSYNC();
        REPEAT(REP_MG) {
            PHASE_VARS
            pg8::Gemm g{WSB(bf16_t, WS_OCAT), WSB(bf16_t, WS_WB), M_, DM, DM}; pg8::StaticOrder S; S.init(M_, DM, G, bid);
            EpiMerge E{ws + WS_G, WSB(bf16_t, WS_XN)};
#ifndef NO_G2
            pg8::gemm_phase<EpiMerge, pg8::StaticOrder, true, true>(ldsl, g, S, E);
#endif
        }
        GSYNC();
        REPEAT(REP_WO) {
            PHASE_VARS
            pg8::Gemm g{WSB(bf16_t, WS_XN), WSB(bf16_t, WS_WOUT), M_, DM, DM}; pg8::StaticOrder S; S.init(M_, DM, G, bid);
            EpiResid E{l == 0 ? INP(0) : OUTP, OUTP, WSB(bf16_t, WS_S), WSB(float, WS_SS1), 1};
#ifndef NO_G3
            pg8::gemm_phase<EpiResid, pg8::StaticOrder, true, true>(ldsl, g, S, E);
#endif
        }
        GSYNC();
        REPEAT(REP_UP) {
            PHASE_VARS
            pg8::Gemm g{WSB(bf16_t, WS_S), WSB(bf16_t, WS_WGU), M_, 2 * DFF, DM}; pg8::StaticOrder S; S.init(M_, 2 * DFF, G, bid);
            EpiSwiGLU E{WSB(bf16_t, WS_R1), WSB(float, WS_SS1)};
#ifndef NO_G4
            pg8::gemm_phase<EpiSwiGLU, pg8::StaticOrder, true, true>(ldsl, g, S, E);
#endif
        }
        GSYNC();
        REPEAT(REP_DN) {
            PHASE_VARS
            pg8::Gemm g{WSB(bf16_t, WS_R1), WSB(bf16_t, WS_WD), M_, DM, DFF}; pg8::StaticOrder S; S.init(M_, DM, G, bid);
            float* o = OUTP; EpiResid E{o, o, WSB(bf16_t, WS_XN), WSB(float, WS_SS0), l == 0 ? 1 : 0};
#ifndef NO_G3
            pg8::gemm_phase<EpiResid, pg8::StaticOrder, true, true>(ldsl, g, S, E);
#endif
        }
        if (ll + 1 < 2 * REP_ALL) GSYNC();
    }
}

extern "C" void kernel_launch(void* const* d_in, const int* in_sizes, int n_in, void* d_out, int out_size, void* d_ws, size_t ws_size, hipStream_t stream) {
    static int grid_blocks = 0;
    if (grid_blocks == 0) {
        if (n_in != 16 || out_size != M_ * DM || ws_size < WS_END) { fprintf(stderr, "kernel_launch: unexpected shapes (n_in %d out %d ws %zu)\n", n_in, out_size, ws_size); grid_blocks = -1; return; }
        int dev = 0, cus = 0, per_cu = 0;
        hipGetDevice(&dev);
        hipDeviceGetAttribute(&cus, hipDeviceAttributeMultiprocessorCount, dev);
        hipFuncSetAttribute((const void*)fwd_kernel, hipFuncAttributeMaxDynamicSharedMemorySize, LDS_BYTES);
        if (hipOccupancyMaxActiveBlocksPerMultiprocessor(&per_cu, (const void*)fwd_kernel, 512, LDS_BYTES) != hipSuccess || per_cu < 1) per_cu = 1;
        (void)hipGetLastError();
        grid_blocks = cus;
    }
    if (grid_blocks < 0) return;
    Args a{};
    for (int i = 0; i < 16; ++i) a.in[i] = (const float*)d_in[i];
    a.out = (float*)d_out; a.ws = (unsigned char*)d_ws;
    if (hipMemsetAsync(d_ws, 0, 65536, stream) != hipSuccess) { fprintf(stderr, "kernel_launch: memset failed\n"); return; }
    void* args[] = {&a};
    hipError_t e = hipLaunchCooperativeKernel((const void*)fwd_kernel, dim3(grid_blocks), dim3(512), args, LDS_BYTES, stream);
    if (e != hipSuccess) fprintf(stderr, "cooperative launch failed: %s (grid %d)\n", hipGetErrorString(e), grid_blocks);
}
```

```cpp
#include <hip/hip_runtime.h>
#include <hip/hip_cooperative_groups.h>
#include <cstdio>
#include <cstdint>
namespace pg8 {
#define PG8_LAS __attribute__((address_space(3)))
typedef unsigned short bf16_t;
typedef short bf16x8 __attribute__((ext_vector_type(8)));
typedef float f32x4 __attribute__((ext_vector_type(4)));
typedef unsigned u32x4 __attribute__((ext_vector_type(4)));
constexpr int BM = 256, BK = 64, HALF = 128, HTB = HALF * BK * 2  , STAGE_BYTES = 8 * HTB, NXCD = 8, WGM = 8;

__host__ __device__ __forceinline__ int lds_byte(int r, int c) { const int st = (r >> 4) * 2 + (c >> 5), rr = r & 15, cc = c & 31, ob = rr * 64 + cc * 2; return st * 1024 + (ob ^ (((ob >> 9) & 1) << 5)); }
__host__ __device__ __forceinline__ void stage_rc(int b, int& R, int& C) { const int st = b / 1024, sb = b % 1024, swz = sb ^ (((sb >> 9) & 1) << 5); R = (st >> 1) * 16 + swz / 64; C = (st & 1) * 32 + (swz % 64) / 2; }
__host__ __device__ __forceinline__ int perm32(int rho) { const int n = rho >> 4, i = rho & 15; return 8 * (i >> 2) + 4 * n + (i & 3); }

struct Unit { int pm, pn; };
struct Gemm { const bf16_t* A; const bf16_t* Bt; int M, N, K; };

struct StaticOrder {
    int nM, nN, nwg, G, c;
    __host__ __device__ void init(int M, int N, int G_, int c_) { nM = M / BM; nN = N / BM; nwg = nM * nN; G = G_; c = c_; }
    __host__ __device__ bool next(int i, Unit& u) const {
        const long L = (long)i * G + c; if (L >= nwg) return false;
        int wgid = (int)L; { const int q = nwg / NXCD, r = nwg % NXCD, xcd = wgid % NXCD, off = wgid / NXCD; wgid = (xcd < r ? xcd * (q + 1) : r * (q + 1) + (xcd - r) * q) + off; }
        const int nig = WGM * nN, gid = wgid / nig, fm = gid * WGM, gsz = (nM - fm) < WGM ? (nM - fm) : WGM;
        u.pm = fm + ((wgid % nig) % gsz); u.pn = (wgid % nig) / gsz; return true;
    }
    __device__ __forceinline__ void a_ready(const Unit&) const {}
    __device__ __forceinline__ void done(const Unit&) const {}
};

__device__ __forceinline__ unsigned cvt_pk_bf16(float lo, float hi) { unsigned r; asm volatile("v_cvt_pk_bf16_f32 %0, %1, %2" : "=v"(r) : "v"(lo), "v"(hi)); return r; }
template <class Epi, class Sched, bool ALIGN_EPI = false, bool SP2 = false>
__device__ __forceinline__ void gemm_phase(PG8_LAS unsigned char* lds, const Gemm g, const Sched& S, const Epi& E) {
    int tid_ = threadIdx.x; asm volatile("" : "+v"(tid_)); const int tid = tid_, wid = __builtin_amdgcn_readfirstlane(tid >> 6), lane = tid & 63, wr = wid >> 2, wc = wid & 3, fr = lane & 15, fq = lane >> 4;
    const int K = g.K, nt = K / BK;
    unsigned voffA[2], voffB[2];
#pragma unroll
    for (int i = 0; i < 2; ++i) { int R, C; stage_rc(tid * 16 + i * 8192, R, C); const int Rb = Epi::PERM ? ((R & ~31) + perm32(R & 31)) : R;
        voffA[i] = (unsigned)(R * K + C) * 2u; voffB[i] = (unsigned)(Rb * K + C) * 2u; }
    const size_t kstep = (size_t)(BK * 2);
    const size_t hstep = (size_t)HALF * K * 2;
    const size_t tstep = 2 * hstep;
    const unsigned ldsw = (unsigned)wid * 1024u;
    const int aoff = lds_byte(wr * 64 + fr, fq * 8), boff = lds_byte(wc * 32 + fr, fq * 8);
#define PG8_SA(b, h) (((b) * 2 + (h)) * HTB)
#define PG8_SB(b, h) ((4 + (b) * 2 + (h)) * HTB)
#define PG8_STAGE(bufoff, gbase, voff) do { _Pragma("unroll") for (int _i = 0; _i < 2; ++_i) \
        __builtin_amdgcn_global_load_lds((const unsigned*)((const char*)(gbase) + (voff)[_i]), (PG8_LAS unsigned*)(lds + (bufoff) + ldsw + _i * 8192), 16, 0, 0); } while (0)
#define PG8_LDA(dst, b, h) do { _Pragma("unroll") for (int m = 0; m < 4; ++m) _Pragma("unroll") for (int k = 0; k < 2; ++k) dst[m][k] = *(const PG8_LAS bf16x8*)(lds + PG8_SA(b, h) + aoff + m * 2048 + k * 1024); } while (0)
#define PG8_LDB(dst, b, h) do { _Pragma("unroll") for (int n = 0; n < 2; ++n) _Pragma("unroll") for (int k = 0; k < 2; ++k) dst[n][k] = *(const PG8_LAS bf16x8*)(lds + PG8_SB(b, h) + boff + n * 2048 + k * 1024); } while (0)
#define PG8_MMA(ai, bj, At, Bt) do { __builtin_amdgcn_s_setprio(1); _Pragma("unroll") for (int m = 0; m < 4; ++m) _Pragma("unroll") for (int n = 0; n < 2; ++n) _Pragma("unroll") for (int k = 0; k < 2; ++k) \
        acc[ai][bj][m][n] = __builtin_amdgcn_mfma_f32_16x16x32_bf16(Bt[n][k], At[m][k], acc[ai][bj][m][n], 0, 0, 0); __builtin_amdgcn_s_setprio(0); } while (0)
#define PG8_WAIT_V(n) asm volatile("s_waitcnt vmcnt(" #n ")" ::: "memory")
#define PG8_WAIT_L(n) asm volatile("s_waitcnt lgkmcnt(" #n ")" ::: "memory")
#define PG8_BAR __builtin_amdgcn_s_barrier()
#define PG8_SCHED __builtin_amdgcn_sched_barrier(0)
    Unit cur, nxt; int ui = 0;
    if (!S.next(0, cur)) return;
    f32x4 acc[2][2][4][2];
#pragma unroll
    for (int a = 0; a < 2; ++a)
#pragma unroll
        for (int b = 0; b < 2; ++b)
#pragma unroll
            for (int m = 0; m < 4; ++m)
#pragma unroll
                for (int n = 0; n < 2; ++n) acc[a][b][m][n] = (f32x4){0.f, 0.f, 0.f, 0.f};
    bf16x8 At[4][2], B0[2][2], B1[2][2];
    const char* cA = (const char*)g.A + (size_t)cur.pm * tstep; const char* cB = (const char*)g.Bt + (size_t)cur.pn * tstep;
    S.a_ready(cur);
    if constexpr (SP2) {
        PG8_STAGE(PG8_SB(0, 0), cB, voffB); PG8_STAGE(PG8_SB(0, 1), cB + hstep, voffB); PG8_STAGE(PG8_SA(0, 0), cA, voffA); PG8_STAGE(PG8_SA(0, 1), cA + hstep, voffA);
        if (wr == 1) PG8_BAR;
        PG8_WAIT_V(2); PG8_BAR;
        PG8_STAGE(PG8_SB(1, 0), cB + kstep, voffB); PG8_STAGE(PG8_SA(1, 0), cA + kstep, voffA); PG8_STAGE(PG8_SB(1, 1), cB + hstep + kstep, voffB);
        PG8_WAIT_V(6); PG8_BAR;
    } else {
        PG8_STAGE(PG8_SB(0, 0), cB, voffB); PG8_STAGE(PG8_SA(0, 0), cA, voffA); PG8_STAGE(PG8_SB(0, 1), cB + hstep, voffB); PG8_STAGE(PG8_SA(0, 1), cA + hstep, voffA);
        if (wr == 1) PG8_BAR;
        PG8_WAIT_V(4); PG8_BAR;
        PG8_STAGE(PG8_SB(1, 0), cB + kstep, voffB); PG8_STAGE(PG8_SA(1, 0), cA + kstep, voffA); PG8_STAGE(PG8_SB(1, 1), cB + hstep + kstep, voffB);
        PG8_WAIT_V(6); PG8_BAR;
    }
    for (;;) {
        const bool has_next = S.next(ui + 1, nxt);
        const char* nA = has_next ? (const char*)g.A + (size_t)nxt.pm * tstep : cA; const char* nB = has_next ? (const char*)g.Bt + (size_t)nxt.pn * tstep : cB;
        for (int t = 0; t < nt; t += 2) {
            if constexpr (Epi::HOOK) { if (t != 0 && (t & 3) == 0) E.hook(acc, cur, (t >> 2) - 1, wr, wc, fr, fq); }
            const bool last = (t == nt - 2);
            const char* a1 = cA + (size_t)(t + 1) * kstep;
            const char* a2 = last ? nA : cA + (size_t)(t + 2) * kstep; const char* b2 = last ? nB : cB + (size_t)(t + 2) * kstep;
            const char* a3 = a2 + kstep; const char* b3 = b2 + kstep;
            if (last && has_next) S.a_ready(nxt);
            if constexpr (SP2) {
            PG8_LDB(B0, 0, 0); PG8_LDB(B1, 0, 1); PG8_SCHED; PG8_LDA(At, 0, 0); PG8_STAGE(PG8_SA(1, 1), a1 + hstep, voffA);
            PG8_WAIT_V(8); PG8_WAIT_L(0); PG8_BAR; PG8_MMA(0, 0, At, B0); PG8_MMA(0, 1, At, B1); PG8_BAR; PG8_SCHED;
            PG8_LDA(At, 0, 1); PG8_STAGE(PG8_SB(0, 0), b2, voffB); PG8_STAGE(PG8_SB(0, 1), b2 + hstep, voffB); PG8_STAGE(PG8_SA(0, 0), a2, voffA);
            PG8_WAIT_V(8); PG8_WAIT_L(0); PG8_BAR; PG8_MMA(1, 0, At, B0); PG8_MMA(1, 1, At, B1); PG8_BAR; PG8_SCHED;
            PG8_LDB(B0, 1, 0); PG8_LDB(B1, 1, 1); PG8_SCHED; PG8_LDA(At, 1, 0); PG8_STAGE(PG8_SA(0, 1), a2 + hstep, voffA);
            PG8_WAIT_V(8); PG8_WAIT_L(0); PG8_BAR; PG8_MMA(0, 0, At, B0); PG8_MMA(0, 1, At, B1); PG8_BAR; PG8_SCHED;
            PG8_LDA(At, 1, 1); PG8_STAGE(PG8_SB(1, 0), b3, voffB); PG8_STAGE(PG8_SB(1, 1), b3 + hstep, voffB); PG8_STAGE(PG8_SA(1, 0), a3, voffA);
            PG8_WAIT_V(8); PG8_WAIT_L(0); PG8_BAR; PG8_MMA(1, 0, At, B0); PG8_MMA(1, 1, At, B1); PG8_BAR; PG8_SCHED;
            } else {
            PG8_LDB(B0, 0, 0); PG8_SCHED; PG8_LDA(At, 0, 0); PG8_STAGE(PG8_SA(1, 1), a1 + hstep, voffA);
            PG8_WAIT_L(8); PG8_BAR; PG8_WAIT_L(0); PG8_MMA(0, 0, At, B0); PG8_BAR; PG8_SCHED;
            PG8_LDB(B1, 0, 1); PG8_STAGE(PG8_SB(0, 0), b2, voffB);
            PG8_BAR; PG8_WAIT_L(0); PG8_MMA(0, 1, At, B1); PG8_BAR;
            PG8_LDA(At, 0, 1); PG8_STAGE(PG8_SA(0, 0), a2, voffA);
            PG8_BAR; PG8_WAIT_L(0); PG8_MMA(1, 0, At, B0); PG8_BAR; PG8_SCHED;
            PG8_STAGE(PG8_SB(0, 1), b2 + hstep, voffB);
            PG8_WAIT_V(6); PG8_BAR; PG8_MMA(1, 1, At, B1); PG8_BAR;
            PG8_LDB(B0, 1, 0); PG8_SCHED; PG8_LDA(At, 1, 0); PG8_STAGE(PG8_SA(0, 1), a2 + hstep, voffA);
            PG8_WAIT_L(8); PG8_BAR; PG8_WAIT_L(0); PG8_MMA(0, 0, At, B0); PG8_BAR; PG8_SCHED;
            PG8_LDB(B1, 1, 1); PG8_STAGE(PG8_SB(1, 0), b3, voffB);
            PG8_BAR; PG8_WAIT_L(0); PG8_MMA(0, 1, At, B1); PG8_BAR;
            PG8_LDA(At, 1, 1); PG8_STAGE(PG8_SA(1, 0), a3, voffA);
            PG8_BAR; PG8_WAIT_L(0); PG8_MMA(1, 0, At, B0); PG8_BAR; PG8_SCHED;
            PG8_STAGE(PG8_SB(1, 1), b3 + hstep, voffB);
            PG8_WAIT_V(6); PG8_BAR; PG8_MMA(1, 1, At, B1); PG8_BAR;
            }
        }
        if constexpr (ALIGN_EPI) { if (wr == 0) PG8_BAR; }
        if constexpr (!Epi::AFTER_DRAIN) { E(acc, cur, wr, wc, fr, fq); if constexpr (Epi::EPI_TWICE) { E(acc, cur, wr, wc, fr, fq); } S.done(cur); }
        if (!has_next) break;
#pragma unroll
        for (int a = 0; a < 2; ++a)
#pragma unroll
            for (int b = 0; b < 2; ++b)
#pragma unroll
                for (int m = 0; m < 4; ++m)
#pragma unroll
                    for (int n = 0; n < 2; ++n) acc[a][b][m][n] = (f32x4){0.f, 0.f, 0.f, 0.f};
        cur = nxt; cA = nA; cB = nB; ++ui;
        if constexpr (ALIGN_EPI) { if (wr == 1) PG8_BAR; }
    }
    PG8_WAIT_V(0);
    if constexpr (!ALIGN_EPI) { if (wr == 0) PG8_BAR; }
    PG8_BAR;
    if constexpr (Epi::AFTER_DRAIN) { E.fused(acc, cur, wr, wc, fr, fq, lds, wid, lane); S.done(cur); }
#undef PG8_SA
#undef PG8_SB
#undef PG8_STAGE
#undef PG8_LDA
#undef PG8_LDB
#undef PG8_MMA
#undef PG8_WAIT_V
#undef PG8_WAIT_L
#undef PG8_BAR
#undef PG8_SCHED
}
}
namespace cg = cooperative_groups;
using pg8::bf16_t; using pg8::bf16x8; using pg8::f32x4; using pg8::u32x4; using pg8::Unit; using pg8::cvt_pk_bf16;
typedef unsigned u32x2 __attribute__((ext_vector_type(2)));
#define LAS __attribute__((address_space(3)))
#define LDS_WAIT() asm volatile("s_waitcnt lgkmcnt(0)" ::: "memory")

constexpr int M_ = 16384, DM = 1024, SEQ = 4096, DFF = 2816, DIN = 6696, NINP = 6912;
constexpr float EPSN = 1e-6f;
constexpr float LOG2E = 1.4426950408889634f, LN2 = 0.6931471805599453f;
constexpr float C2 = 0.125f * LOG2E;

constexpr size_t MiB = (size_t)1 << 20;
constexpr size_t WS_SS0 = 128 * 1024, WS_SS1 = 256 * 1024;
constexpr size_t WS_WIN = 1 * MiB;
constexpr size_t WS_WB = WS_WIN + (size_t)NINP * 1024 * 2;
constexpr size_t WS_WOUT = WS_WB + 2 * MiB;
constexpr size_t WS_WGU = WS_WOUT + 2 * MiB;
constexpr size_t WS_WD = WS_WGU + 11 * MiB;
constexpr size_t WS_WP = WS_WD + (size_t)1024 * 2816 * 2;
constexpr size_t WS_WS = WS_WP + 32768;
static_assert(WS_WS + 131072 <= 36 * MiB, "weights region");
constexpr size_t WS_XN = 36 * MiB;
constexpr size_t WS_R1 = 68 * MiB;
constexpr size_t WS_G = WS_R1, WS_KA = WS_R1 + 64 * MiB, WS_VTA = WS_KA + 8 * MiB, WS_IQ = WS_VTA + 8 * MiB;
constexpr size_t WS_S = 156 * MiB;
constexpr size_t WS_PIN = WS_S, WS_GU = WS_S + 8 * MiB, WS_GV = WS_S + 16 * MiB, WS_SQ = WS_S + 24 * MiB, WS_SK = WS_S + 32 * MiB,
                 WS_VTS = WS_S + 40 * MiB, WS_QA = WS_S + 48 * MiB, WS_MASK = WS_S + 56 * MiB, WS_IK = 220 * MiB, WS_IW = 221 * MiB, WS_OCAT = 222 * MiB  , WS_END = 254 * MiB;

__device__ __forceinline__ float bf2f(unsigned short v) { return __uint_as_float((unsigned)v << 16); }
__device__ __forceinline__ float bflo(unsigned v) { return __uint_as_float(v << 16); }
__device__ __forceinline__ float bfhi(unsigned v) { return __uint_as_float(v & 0xffff0000u); }
__device__ __forceinline__ unsigned short f2bf(float f) { return (unsigned short)(cvt_pk_bf16(f, 0.f) & 0xffffu); }
__device__ __forceinline__ float relu1(float x) { const int b = __float_as_int(x); return __int_as_float(b > 0 ? b : 0); }
__device__ __forceinline__ float sigmoidf_(float x) { return __builtin_amdgcn_rcpf(1.f + __builtin_amdgcn_exp2f(-x * LOG2E)); }
__device__ __forceinline__ float gelu_tanh(float x) { const float u = 0.7978845608028654f * (x + 0.044715f * x * x * x); return x * __builtin_amdgcn_rcpf(1.f + __builtin_amdgcn_exp2f(-2.f * LOG2E * u)); }
__device__ __forceinline__ f32x4 mfma16(bf16x8 a, bf16x8 b, f32x4 c) { return __builtin_amdgcn_mfma_f32_16x16x32_bf16(a, b, c, 0, 0, 0); }
__device__ __forceinline__ bf16x8 mk8(unsigned a, unsigned b, unsigned c, unsigned d) { u32x4 v = {a, b, c, d}; return __builtin_bit_cast(bf16x8, v); }

struct EpiIn {
    static constexpr bool PERM = true, AFTER_DRAIN = false, HOOK = false;
#ifdef PROBE_EPI_IN
    static constexpr bool EPI_TWICE = true;
#else
    static constexpr bool EPI_TWICE = false;
#endif
    unsigned char* ws; const float *qn, *kn; const float* SS;
    __device__ __forceinline__ void operator()(const f32x4 (&acc)[2][2][4][2], const Unit& u, int wr, int wc, int fr, int fq) const {
        bf16_t* const QA = (bf16_t*)(ws + WS_QA); bf16_t* const KA = (bf16_t*)(ws + WS_KA); bf16_t* const VTA = (bf16_t*)(ws + WS_VTA); bf16_t* const IQ = (bf16_t*)(ws + WS_IQ);
        bf16_t* const PIN = (bf16_t*)(ws + WS_PIN); bf16_t* const GU = (bf16_t*)(ws + WS_GU); bf16_t* const GV = (bf16_t*)(ws + WS_GV); bf16_t* const SQ = (bf16_t*)(ws + WS_SQ);
        bf16_t* const SK = (bf16_t*)(ws + WS_SK); bf16_t* const VTS = (bf16_t*)(ws + WS_VTS); bf16_t* const IK = (bf16_t*)(ws + WS_IK); float* const IW = (float*)(ws + WS_IW); unsigned char* const G = ws + WS_G;
        const int pn = u.pn; const int row0 = u.pm * 256 + wr * 64 + fr; const int cl = wc * 32 + 8 * fq;
        float rr[2][4];
#pragma unroll
        for (int ai = 0; ai < 2; ++ai)
#pragma unroll
            for (int m = 0; m < 4; ++m) rr[ai][m] = __builtin_amdgcn_rsqf(SS[row0 + ai * 128 + m * 16] * (1.f / 1024.f) + EPSN);
        if (pn >= 11) {
            unsigned char* gp = G + (size_t)row0 * 4096 + (pn - 11) * 256 + cl;
#pragma unroll
            for (int ai = 0; ai < 2; ++ai)
#pragma unroll
                for (int m = 0; m < 4; ++m)
#pragma unroll
                    for (int bj = 0; bj < 2; ++bj) {
                        unsigned w2[2];
#pragma unroll
                        for (int n = 0; n < 2; ++n) { const f32x4 v = (acc[ai][bj][m][n] * rr[ai][m]); unsigned pk = 0;
#pragma unroll
                            for (int i = 0; i < 4; ++i) { const unsigned qv = (unsigned)(sigmoidf_(v[i]) * 255.f + 0.5f); pk |= qv << (8 * i); }
                            w2[n] = pk; }
                        *(u32x2*)(gp + (size_t)(ai * 128 + m * 16) * 4096 + bj * 128) = (u32x2){w2[0], w2[1]};
                    }
            return;
        }
        if (pn <= 1) {
            const float* gw = pn == 0 ? qn : kn; const float sc = pn == 0 ? C2 : 1.f; bf16_t* T = pn == 0 ? QA : KA;
            f32x4 gv[2][2];
#pragma unroll
            for (int bj = 0; bj < 2; ++bj)
#pragma unroll
                for (int n = 0; n < 2; ++n) gv[bj][n] = *(const f32x4*)(gw + bj * 32 + 8 * fq + 4 * n);
#pragma unroll
            for (int ai = 0; ai < 2; ++ai)
#pragma unroll
                for (int m = 0; m < 4; ++m) {
                    float ss = 0.f;
#pragma unroll
                    for (int bj = 0; bj < 2; ++bj)
#pragma unroll
                        for (int n = 0; n < 2; ++n) { const f32x4 v = (acc[ai][bj][m][n] * rr[ai][m]); ss += (v[0] * v[0] + v[1] * v[1]) + (v[2] * v[2] + v[3] * v[3]); }
                    ss += __shfl_xor(ss, 16); ss += __shfl_xor(ss, 32);
                    const float rinv = __builtin_amdgcn_rsqf(ss * (1.f / 64.f) + EPSN) * sc;
                    bf16_t* rp = T + (size_t)(row0 + ai * 128 + m * 16) * 256 + wc * 64 + 8 * fq;
#pragma unroll
                    for (int bj = 0; bj < 2; ++bj) { const f32x4 v0 = (acc[ai][bj][m][0] * rr[ai][m]) * gv[bj][0] * rinv, v1 = (acc[ai][bj][m][1] * rr[ai][m]) * gv[bj][1] * rinv;
                        u32x4 w; w.x = cvt_pk_bf16(v0[0], v0[1]); w.y = cvt_pk_bf16(v0[2], v0[3]); w.z = cvt_pk_bf16(v1[0], v1[1]); w.w = cvt_pk_bf16(v1[2], v1[3]);
                        *(u32x4*)(rp + bj * 32) = w; }
                }
            return;
        }
        if (pn == 2 || pn == 9) {
            bf16_t* T = pn == 2 ? VTA : VTS;
#pragma unroll
            for (int ai = 0; ai < 2; ++ai)
#pragma unroll
                for (int m = 0; m < 4; ++m) { const int row = row0 + ai * 128 + m * 16; const int b = row >> 12, t = row & 4095;
#pragma unroll
                    for (int bj = 0; bj < 2; ++bj)
#pragma unroll
                        for (int n = 0; n < 2; ++n) { const f32x4 v = (acc[ai][bj][m][n] * rr[ai][m]);
#pragma unroll
                            for (int i = 0; i < 4; ++i) T[((size_t)b * 256 + bj * 128 + cl + 4 * n + i) * 4096 + t] = f2bf(v[i]); }
                }
            return;
        }
        if (pn == 10) {
            if (wc == 0) {
#pragma unroll
                for (int ai = 0; ai < 2; ++ai)
#pragma unroll
                    for (int m = 0; m < 4; ++m) { const f32x4 v0 = (acc[ai][0][m][0] * rr[ai][m]), v1 = (acc[ai][0][m][1] * rr[ai][m]);
                        u32x4 w; w.x = cvt_pk_bf16(v0[0], v0[1]); w.y = cvt_pk_bf16(v0[2], v0[3]); w.z = cvt_pk_bf16(v1[0], v1[1]); w.w = cvt_pk_bf16(v1[2], v1[3]);
                        *(u32x4*)(IK + (size_t)(row0 + ai * 128 + m * 16) * 32 + 8 * fq) = w; }
            } else if (wc == 1 && fq == 0) {
#pragma unroll
                for (int ai = 0; ai < 2; ++ai)
#pragma unroll
                    for (int m = 0; m < 4; ++m) { float* p = IW + (size_t)(row0 + ai * 128 + m * 16) * 8; *(f32x4*)p = (acc[ai][0][m][0] * rr[ai][m]); *(f32x4*)(p + 4) = (acc[ai][0][m][1] * rr[ai][m]); }
            }
            return;
        }
        {
            bf16_t* T = pn == 3 ? IQ : pn == 4 ? PIN : pn == 5 ? GU : pn == 6 ? GV : pn == 7 ? SQ : SK;
            const bool act = (pn == 5 || pn == 6); const float sc = pn == 7 ? 0.125f : 1.f;
#pragma unroll
            for (int ai = 0; ai < 2; ++ai)
#pragma unroll
                for (int m = 0; m < 4; ++m) { bf16_t* rp = T + (size_t)(row0 + ai * 128 + m * 16) * 256 + cl;
#pragma unroll
                    for (int bj = 0; bj < 2; ++bj) { f32x4 v0 = (acc[ai][bj][m][0] * rr[ai][m]) * sc, v1 = (acc[ai][bj][m][1] * rr[ai][m]) * sc;
                        if (act) {
#pragma unroll
                            for (int i = 0; i < 4; ++i) { v0[i] = gelu_tanh(v0[i]); v1[i] = gelu_tanh(v1[i]); } }
                        u32x4 w; w.x = cvt_pk_bf16(v0[0], v0[1]); w.y = cvt_pk_bf16(v0[2], v0[3]); w.z = cvt_pk_bf16(v1[0], v1[1]); w.w = cvt_pk_bf16(v1[2], v1[3]);
                        *(u32x4*)(rp + bj * 128) = w; }
                }
        }
    }
};

struct EpiMerge {
    static constexpr bool PERM = true, AFTER_DRAIN = false, HOOK = true, EPI_TWICE = false;
    const unsigned char* G; bf16_t* MG;
    __device__ __forceinline__ void hook(f32x4 (&acc)[2][2][4][2], const Unit& u, int s, int wr, int wc, int fr, int fq) const {
        const int row0 = u.pm * 256 + wr * 64 + fr; const int col0 = u.pn * 256 + wc * 32 + 8 * fq;
        const unsigned char* gp0 = G + (size_t)row0 * 4096 + s * 1024 + col0;
#pragma unroll
        for (int ai = 0; ai < 2; ++ai) {
            u32x2 ga[4][2], gb[4][2];
#pragma unroll
            for (int m = 0; m < 4; ++m)
#pragma unroll
                for (int bj = 0; bj < 2; ++bj) { const unsigned char* gp = gp0 + (size_t)(ai * 128 + m * 16) * 4096 + bj * 128; ga[m][bj] = *(const u32x2*)gp; gb[m][bj] = *(const u32x2*)(gp + 1024); }
#pragma unroll
            for (int m = 0; m < 4; ++m)
#pragma unroll
                for (int bj = 0; bj < 2; ++bj)
#pragma unroll
                    for (int i = 0; i < 4; ++i) {
                        const float a0 = fmaxf((float)((ga[m][bj].x >> (8 * i)) & 255u), 1.f), b0 = fmaxf((float)((gb[m][bj].x >> (8 * i)) & 255u), 1.f);
                        const float a1 = fmaxf((float)((ga[m][bj].y >> (8 * i)) & 255u), 1.f), b1 = fmaxf((float)((gb[m][bj].y >> (8 * i)) & 255u), 1.f);
                        acc[ai][bj][m][0][i] *= a0 * __builtin_amdgcn_rcpf(b0); acc[ai][bj][m][1][i] *= a1 * __builtin_amdgcn_rcpf(b1); }
            asm volatile("" ::: "memory");
        }
    }
    __device__ __forceinline__ void operator()(const f32x4 (&acc)[2][2][4][2], const Unit& u, int wr, int wc, int fr, int fq) const {
        const int row0 = u.pm * 256 + wr * 64 + fr; const int col0 = u.pn * 256 + wc * 32 + 8 * fq;
        const unsigned char* gp0 = G + (size_t)row0 * 4096 + 3 * 1024 + col0; bf16_t* mp0 = MG + (size_t)row0 * 1024 + col0;
        u32x2 gb[2][4][2];
#pragma unroll
        for (int ai = 0; ai < 2; ++ai)
#pragma unroll
            for (int m = 0; m < 4; ++m)
#pragma unroll
                for (int bj = 0; bj < 2; ++bj) gb[ai][m][bj] = *(const u32x2*)(gp0 + (size_t)(ai * 128 + m * 16) * 4096 + bj * 128);
#pragma unroll
        for (int ai = 0; ai < 2; ++ai)
#pragma unroll
            for (int m = 0; m < 4; ++m)
#pragma unroll
                for (int bj = 0; bj < 2; ++bj) { const size_t ro = (size_t)(ai * 128 + m * 16); const u32x2 g2 = gb[ai][m][bj];
                    f32x4 v0 = acc[ai][bj][m][0], v1 = acc[ai][bj][m][1];
#pragma unroll
                    for (int i = 0; i < 4; ++i) { v0[i] *= fmaxf((float)((g2.x >> (8 * i)) & 255u), 1.f) * (1.f / 255.f); v1[i] *= fmaxf((float)((g2.y >> (8 * i)) & 255u), 1.f) * (1.f / 255.f); }
                    u32x4 w; w.x = cvt_pk_bf16(v0[0], v0[1]); w.y = cvt_pk_bf16(v0[2], v0[3]); w.z = cvt_pk_bf16(v1[0], v1[1]); w.w = cvt_pk_bf16(v1[2], v1[3]);
                    *(u32x4*)(mp0 + ro * 1024 + bj * 128) = w; }
    }
};

struct EpiResid {
    static constexpr bool PERM = true, AFTER_DRAIN = false, HOOK = false, EPI_TWICE = false;
    const float* base; float* out; bf16_t* XB; float* SS; int stat;
    __device__ __forceinline__ void operator()(const f32x4 (&acc)[2][2][4][2], const Unit& u, int wr, int wc, int fr, int fq) const {
        const int row0 = u.pm * 256 + wr * 64 + fr; const int col0 = u.pn * 256 + wc * 32 + 8 * fq;
#pragma unroll
        for (int ai = 0; ai < 2; ++ai) {
            f32x4 pre[4][2][2];
#pragma unroll
            for (int m = 0; m < 4; ++m) { const size_t off = (size_t)(row0 + ai * 128 + m * 16) * 1024 + col0;
#pragma unroll
                for (int bj = 0; bj < 2; ++bj) { pre[m][bj][0] = *(const f32x4*)(base + off + bj * 128); pre[m][bj][1] = *(const f32x4*)(base + off + bj * 128 + 4); } }
#pragma unroll
            for (int m = 0; m < 4; ++m) { const int row = row0 + ai * 128 + m * 16; const size_t off = (size_t)row * 1024 + col0; float ssum = 0.f;
#pragma unroll
                for (int bj = 0; bj < 2; ++bj) {
                    const f32x4 o0 = pre[m][bj][0] + acc[ai][bj][m][0], o1 = pre[m][bj][1] + acc[ai][bj][m][1];
                    *(f32x4*)(out + off + bj * 128) = o0; *(f32x4*)(out + off + bj * 128 + 4) = o1;
                    if (stat) { u32x4 w; w.x = cvt_pk_bf16(o0[0], o0[1]); w.y = cvt_pk_bf16(o0[2], o0[3]); w.z = cvt_pk_bf16(o1[0], o1[1]); w.w = cvt_pk_bf16(o1[2], o1[3]);
                        *(u32x4*)(XB + off + bj * 128) = w;
                        ssum += ((o0[0] * o0[0] + o0[1] * o0[1]) + (o0[2] * o0[2] + o0[3] * o0[3])) + ((o1[0] * o1[0] + o1[1] * o1[1]) + (o1[2] * o1[2] + o1[3] * o1[3])); } }
                if (stat) { ssum += __shfl_xor(ssum, 16); ssum += __shfl_xor(ssum, 32); if (fq == 0) atomicAdd(SS + row, ssum); } }
            asm volatile("" ::: "memory");
        }
    }
};

struct EpiSwiGLU {
    static constexpr bool PERM = true, AFTER_DRAIN = false, HOOK = false, EPI_TWICE = false;
    bf16_t* ACT; const float* SS;
    __device__ __forceinline__ void operator()(const f32x4 (&acc)[2][2][4][2], const Unit& u, int wr, int wc, int fr, int fq) const {
        const int row0 = u.pm * 256 + wr * 64 + fr; const int f0 = u.pn * 128 + wc * 32 + 8 * fq;
#pragma unroll
        for (int ai = 0; ai < 2; ++ai)
#pragma unroll
            for (int m = 0; m < 4; ++m) { f32x4 r[2]; const float rs = __builtin_amdgcn_rsqf(SS[row0 + ai * 128 + m * 16] * (1.f / 1024.f) + EPSN);
#pragma unroll
                for (int n = 0; n < 2; ++n) { const f32x4 g = acc[ai][0][m][n] * rs, up = acc[ai][1][m][n] * rs;
#pragma unroll
                    for (int i = 0; i < 4; ++i) r[n][i] = g[i] * sigmoidf_(g[i]) * up[i]; }
                u32x4 w; w.x = cvt_pk_bf16(r[0][0], r[0][1]); w.y = cvt_pk_bf16(r[0][2], r[0][3]); w.z = cvt_pk_bf16(r[1][0], r[1][1]); w.w = cvt_pk_bf16(r[1][2], r[1][3]);
                *(u32x4*)(ACT + (size_t)(row0 + ai * 128 + m * 16) * DFF + f0) = w; }
    }
};

__device__ __forceinline__ void cvt_item(const float* src, int ld, int col0, int nvalid, int K, bf16_t* WT, int dst_row0, int kb, LAS float* scr, int lane, const float* rs = nullptr) {
    const int k0 = 64 * kb, c = lane & 31;
    float vv[32];
#pragma unroll
    for (int i = 0; i < 32; ++i) { const int kk = 2 * i + (lane >> 5); vv[i] = (c < nvalid) ? src[(size_t)(k0 + kk) * ld + col0 + c] : 0.f; }
    if (rs) {
#pragma unroll
        for (int i = 0; i < 32; ++i) vv[i] *= rs[k0 + 2 * i + (lane >> 5)];
    }
#pragma unroll
    for (int i = 0; i < 32; ++i) scr[(2 * i + (lane >> 5)) * 33 + c] = vv[i];
    LDS_WAIT();
    const int c8 = lane & 7;
#pragma unroll
    for (int j = 0; j < 4; ++j) { const int n = (lane >> 3) + 8 * j; const LAS float* s = scr + (8 * c8) * 33 + n;
        u32x4 o; o.x = cvt_pk_bf16(s[0 * 33], s[1 * 33]); o.y = cvt_pk_bf16(s[2 * 33], s[3 * 33]); o.z = cvt_pk_bf16(s[4 * 33], s[5 * 33]); o.w = cvt_pk_bf16(s[6 * 33], s[7 * 33]);
        *(u32x4*)(WT + (size_t)(dst_row0 + n) * K + k0 + 8 * c8) = o; }
    LDS_WAIT();
}
__device__ __forceinline__ float wave_sum(float v) {
#pragma unroll
    for (int o = 1; o < 64; o <<= 1) v += __shfl_xor(v, o);
    return v;
}
__device__ __forceinline__ float wave_max(float v) {
#pragma unroll
    for (int o = 1; o < 64; o <<= 1) v = fmaxf(v, __shfl_xor(v, o));
    return v;
}
__device__ __forceinline__ void rmsnorm_rows(const float* xs, const float* gamma, bf16_t* XN, int gw, int ngw, int lane) {
    f32x4 gm[4];
#pragma unroll
    for (int j = 0; j < 4; ++j) gm[j] = *(const f32x4*)(gamma + 4 * lane + 256 * j);
    for (int m = gw; m < M_; m += ngw) {
        const f32x4* xr = (const f32x4*)(xs + (size_t)m * DM) + lane; f32x4 v[4]; float s = 0.f;
#pragma unroll
        for (int j = 0; j < 4; ++j) { v[j] = xr[64 * j]; s += (v[j].x * v[j].x + v[j].y * v[j].y) + (v[j].z * v[j].z + v[j].w * v[j].w); }
        const float r = __builtin_amdgcn_rsqf(wave_sum(s) * (1.f / DM) + EPSN);
        u32x2* o8 = (u32x2*)(XN + (size_t)m * DM) + lane;
#pragma unroll
        for (int j = 0; j < 4; ++j) { const f32x4 y = v[j] * r * gm[j]; o8[64 * j] = (u32x2){cvt_pk_bf16(y.x, y.y), cvt_pk_bf16(y.z, y.w)}; }
    }
}

__device__ __forceinline__ void x_to_bf16_ss(const float* xs, bf16_t* XN, float* SS, int gw, int ngw, int lane) {
    for (int m0 = gw * 4; m0 < M_; m0 += ngw * 4) {
        f32x4 v[4][4];
#pragma unroll
        for (int r = 0; r < 4; ++r) { const f32x4* xr = (const f32x4*)(xs + (size_t)(m0 + r) * DM) + lane;
#pragma unroll
            for (int j = 0; j < 4; ++j) v[r][j] = xr[64 * j]; }
#pragma unroll
        for (int r = 0; r < 4; ++r) { float s = 0.f;
#pragma unroll
            for (int j = 0; j < 4; ++j) s += (v[r][j].x * v[r][j].x + v[r][j].y * v[r][j].y) + (v[r][j].z * v[r][j].z + v[r][j].w * v[r][j].w);
            s = wave_sum(s);
            u32x2* o8 = (u32x2*)(XN + (size_t)(m0 + r) * DM) + lane;
#pragma unroll
            for (int j = 0; j < 4; ++j) o8[64 * j] = (u32x2){cvt_pk_bf16(v[r][j].x, v[r][j].y), cvt_pk_bf16(v[r][j].z, v[r][j].w)};
            if (lane == 0) SS[m0 + r] = s; }
    }
}
struct Ptrs {
    const float *mix_g, *ffn_g, *w_in, *qn, *kn, *pool_w, *pool_scale, *gm_norm, *gm_ws, *gm_b, *w_branch, *w_out, *w_gate, *w_up, *w_down;
};

__device__ __forceinline__ void convert_weights(const Ptrs& P, unsigned char* ws, LAS float* scr, int gw, int ngw, int lane, int gtid, int ngt) {
    bf16_t* WinT = (bf16_t*)(ws + WS_WIN); bf16_t* WbT = (bf16_t*)(ws + WS_WB); bf16_t* WoutT = (bf16_t*)(ws + WS_WOUT); bf16_t* WguT = (bf16_t*)(ws + WS_WGU);
    bf16_t* WdT = (bf16_t*)(ws + WS_WD); bf16_t* WpT = (bf16_t*)(ws + WS_WP); bf16_t* Wtril = (bf16_t*)(ws + WS_WS);
    constexpr int I_A = 216 * 16, I_B = 512, I_C = 512, I_D = 176 * 16, I_E = 32 * 44, I_F = 8, NIT = I_A + I_B + I_C + I_D + I_E + I_F;
    for (int it = gw; it < NIT; it += ngw) {
        int r = it;
        if (r < I_A) { const int rb = r >> 4, kb = r & 15, tile = rb >> 3, sub = rb & 7; int col0, nv = 32;
            if (tile <= 1) col0 = tile * 256 + (sub & 3) * 64 + (sub >> 2) * 32;
            else if (tile == 2) col0 = 512 + sub * 32;
            else if (tile == 3) col0 = 768 + sub * 32;
            else if (tile <= 9) col0 = 1064 + (tile - 4) * 256 + sub * 32;
            else if (tile == 10) { col0 = sub == 0 ? 1024 : 1056; nv = sub == 0 ? 32 : (sub == 1 ? 8 : 0); }
            else col0 = 2600 + (tile - 11) * 256 + sub * 32;
            cvt_item(P.w_in, DIN, col0, nv, 1024, WinT, rb * 32, kb, scr, lane, P.mix_g); continue; }
        r -= I_A;
        if (r < I_B) { const int rb = r >> 4, kb = r & 15; cvt_item(P.w_branch, 1024, rb * 32, 32, 1024, WbT, rb * 32, kb, scr, lane); continue; }
        r -= I_B;
        if (r < I_C) { const int rb = r >> 4, kb = r & 15; cvt_item(P.w_out, 1024, rb * 32, 32, 1024, WoutT, rb * 32, kb, scr, lane); continue; }
        r -= I_C;
        if (r < I_D) { const int rb = r >> 4, kb = r & 15, tile = rb >> 3, sub = rb & 7;
            cvt_item((sub >> 2) ? P.w_up : P.w_gate, DFF, tile * 128 + (sub & 3) * 32, 32, 1024, WguT, rb * 32, kb, scr, lane, P.ffn_g); continue; }
        r -= I_D;
        if (r < I_E) { const int rb = r / 44, kb = r % 44; cvt_item(P.w_down, 1024, rb * 32, 32, DFF, WdT, rb * 32, kb, scr, lane); continue; }
        r -= I_E;
        { const int gp = r >> 1, rb = r & 1; cvt_item(P.pool_w + gp * 4096, 64, rb * 32, 32, 64, WpT + gp * 4096, rb * 32, 0, scr, lane); }
    }
    for (int e = gtid; e < 4 * 128 * 128; e += ngt) { const int s = e & 127, t = (e >> 7) & 127; Wtril[e] = (s <= t) ? f2bf(P.gm_ws[e]) : (unsigned short)0; }
}

__device__ __forceinline__ unsigned mono_key(float s) { const unsigned b = __float_as_uint(s); return b ^ ((unsigned)((int)b >> 31) | 0x80000000u); }

#define wr_lane(dst, sval, ln) asm volatile("s_nop 4\n\tv_writelane_b32 %0, %1, %2\n\ts_nop 1" : "+v"(dst) : "s"(sval), "n"(ln))
template <int NBLK> __device__ __forceinline__ unsigned a1_bisect(const unsigned (&v)[64], int& cpre) {
    unsigned prefix = 0u; cpre = 0;
#pragma unroll 1
    for (int bit = 31; bit >= 0; --bit) {
        const unsigned cand = prefix | (1u << bit);
        int cnt = 0;
#pragma unroll
        for (int blk = 0; blk < NBLK; ++blk) {
            unsigned long long bl[8];
#pragma unroll
            for (int k = 0; k < 8; ++k) bl[k] = __ballot(v[blk * 8 + k] >= cand);
            __builtin_amdgcn_sched_barrier(0);
#pragma unroll
            for (int k = 0; k < 8; ++k) cnt += __builtin_popcountll(bl[k]);
            __builtin_amdgcn_sched_barrier(0);
        }
        if (cnt >= 256) { prefix = cand; cpre = cnt; if (cnt == 256) break; }
    }
    return prefix;
}
constexpr int A1_ROWF = 4100;
__device__ __forceinline__ void phase_a1(unsigned char* lds, const bf16_t* IQ, const bf16_t* IK, const float* IW, unsigned short* MASK, int tid, int bid, int G) {
    const int lane = tid & 63, w = __builtin_amdgcn_readfirstlane(tid >> 6), q = lane & 15, g = lane >> 4;
    unsigned* keys = (unsigned*)lds;
#ifndef REP_A1X
#define REP_A1X 1
#endif
    for (int L2 = bid; L2 < 1024 * REP_A1X; L2 += G) {
        const int L = L2 & 1023;
        const int b = L >> 8, c = L & 255, qg = (b & 1) ? 255 - c : c;
        const int row0 = b * SEQ + qg * 16;
        const int nreg = (qg >> 2) + 1;
        if (qg <= 15) {
#pragma unroll
            for (int half = 0; half < 2; ++half) { const int qq = half * 8 + w; const int t = qg * 16 + qq; unsigned mlo = 0u, mhi = 0u;
#pragma unroll
                for (int r = 0; r < 4; ++r) { const unsigned long long bal = __ballot(64 * r + lane <= t);
                    wr_lane(mlo, (unsigned)bal, r); wr_lane(mhi, (unsigned)(bal >> 32), r); }
                if (lane < nreg) *(u32x2*)(MASK + (size_t)(row0 + qq) * 256 + 4 * lane) = (u32x2){mlo, mhi}; }
            continue;
        }
        unsigned u[128];
        {
            bf16x8 iqf[8]; float wv[8];
#pragma unroll
            for (int h = 0; h < 8; ++h) iqf[h] = *(const bf16x8*)(IQ + (size_t)(row0 + q) * 256 + h * 32 + 8 * g);
            { const f32x4 a = *(const f32x4*)(IW + (size_t)(row0 + q) * 8), bq = *(const f32x4*)(IW + (size_t)(row0 + q) * 8 + 4);
              wv[0] = a[0]; wv[1] = a[1]; wv[2] = a[2]; wv[3] = a[3]; wv[4] = bq[0]; wv[5] = bq[1]; wv[6] = bq[2]; wv[7] = bq[3]; }
            bf16x8 kfn[4];
#pragma unroll
            for (int ii = 0; ii < 4; ++ii) kfn[ii] = *(const bf16x8*)(IK + (size_t)(b * SEQ + (8 * ii + w) * 16 + q) * 32 + 8 * g);
#pragma unroll
            for (int blk = 0; blk < 8; ++blk) {
                if (32 * blk + w <= qg) {
                    bf16x8 kf[4];
#pragma unroll
                    for (int ii = 0; ii < 4; ++ii) kf[ii] = kfn[ii];
                    if (blk < 7) {
#pragma unroll
                        for (int ii = 0; ii < 4; ++ii) { const int kt = 8 * (4 * (blk + 1) + ii) + w; kfn[ii] = *(const bf16x8*)(IK + (size_t)(b * SEQ + kt * 16 + q) * 32 + 8 * g); }
                    }
#pragma unroll
                    for (int ii = 0; ii < 4; ++ii) { const int i = 4 * blk + ii; const int kt = 8 * i + w;
                        f32x4 s = {0.f, 0.f, 0.f, 0.f};
#pragma unroll
                        for (int h = 0; h < 8; ++h) { const f32x4 a = mfma16(kf[ii], iqf[h], (f32x4){0.f, 0.f, 0.f, 0.f});
#pragma unroll
                            for (int j = 0; j < 4; ++j) s[j] = __builtin_fmaf(wv[h], relu1(a[j]), s[j]); }
#pragma unroll
                        for (int j = 0; j < 4; ++j) { unsigned uu = mono_key(s[j]); if (kt > qg || (kt == qg && (4 * g + j) > q)) uu = 0u; u[4 * i + j] = uu; }
                    }
                } else {
#pragma unroll
                    for (int r = 0; r < 16; ++r) u[16 * blk + r] = 0u;
                }
            }
        }
#pragma unroll 1
        for (int half = 0; half < 2; ++half) {
            if ((q >> 3) == half) {
                unsigned* krow = keys + (q & 7) * A1_ROWF + 4 * g;
#pragma unroll
                for (int i = 0; i < 32; ++i) { const int kt = 8 * i + w; *(u32x4*)(krow + kt * 16) = (u32x4){u[4 * i], u[4 * i + 1], u[4 * i + 2], u[4 * i + 3]}; }
            }
            __syncthreads();
            {
                const int qq = half * 8 + w; const unsigned* krow = keys + w * A1_ROWF + lane;
                unsigned v[64];
#pragma unroll
                for (int blk = 0; blk < 8; ++blk) {
                    if (nreg > blk * 8) {
#pragma unroll
                        for (int r = blk * 8; r < blk * 8 + 8; ++r) v[r] = krow[64 * r];
                    } else {
#pragma unroll
                        for (int r = blk * 8; r < blk * 8 + 8; ++r) v[r] = 0u;
                    }
                }
#ifndef REP_BIS
#define REP_BIS 1
#endif
                unsigned prefix; int cpre = 0;
#pragma unroll 1
                for (int rb_ = 0; rb_ < REP_BIS; ++rb_)
                switch ((nreg + 7) >> 3) {
                    case 1: prefix = a1_bisect<1>(v, cpre); break; case 2: prefix = a1_bisect<2>(v, cpre); break; case 3: prefix = a1_bisect<3>(v, cpre); break; case 4: prefix = a1_bisect<4>(v, cpre); break;
                    case 5: prefix = a1_bisect<5>(v, cpre); break; case 6: prefix = a1_bisect<6>(v, cpre); break; case 7: prefix = a1_bisect<7>(v, cpre); break; default: prefix = a1_bisect<8>(v, cpre); break;
                }
                const unsigned thr = prefix > 1u ? prefix : 1u;
                unsigned mlo = 0u, mhi = 0u;
                if (cpre == 256) {
#pragma unroll
                    for (int r = 0; r < 64; ++r) { const unsigned long long bal = __ballot(v[r] >= thr); wr_lane(mlo, (unsigned)bal, r); wr_lane(mhi, (unsigned)(bal >> 32), r); }
                } else {
                    int rem = 256;
#pragma unroll
                    for (int r = 0; r < 64; ++r) rem -= __builtin_popcountll(__ballot(v[r] > thr));
#pragma unroll
                    for (int r = 0; r < 64; ++r) { unsigned long long bal = __ballot(v[r] > thr); unsigned long long eq = __ballot(v[r] == thr);
                        const int ne = __builtin_popcountll(eq);
                        if (ne <= rem) { bal |= eq; rem -= ne; }
                        else { while (rem > 0) { const unsigned long long low = eq & (0ull - eq); bal |= low; eq ^= low; --rem; } }
                        wr_lane(mlo, (unsigned)bal, r); wr_lane(mhi, (unsigned)(bal >> 32), r); }
                }
                if (lane < nreg) *(u32x2*)(MASK + (size_t)(row0 + qq) * 256 + 4 * lane) = (u32x2){mlo, mhi};
            }
            __syncthreads();
        }
    }
}

__device__ __forceinline__ void phase_a2(unsigned char* lds, const bf16_t* QA, bf16_t* OA, const bf16_t* KA, const bf16_t* VTA, const unsigned short* MASK,
                                         const float* qn, const float* kn, int tid, int bid, int G) {
    const int lane = tid & 63, w = __builtin_amdgcn_readfirstlane(tid >> 6), q = lane & 15, g = lane >> 4;
    bf16_t* Kt = (bf16_t*)lds;
    bf16_t* Vt = (bf16_t*)(lds + 2 * 64 * 72 * 2);
    const float msh = LOG2E * 8.f * wave_max(fabsf(qn[lane])) * wave_max(fabsf(kn[lane])) * 1.02f + 0.25f;
    const int srow = tid >> 3, sch = tid & 7;
    for (int L = bid; L < 512; L += G) {
        const int jj = L >> 8, c0 = L & 255, c = (c0 & 7) * 32 + (c0 >> 3), bh = c >> 4, qb = jj ? 31 - (c & 15) : (c & 15);
        const int b = bh >> 2, h = bh & 3;
        const int qgw = qb * 8 + w;
        const int row0 = b * SEQ + qb * 128 + 16 * w;
        bf16x8 qf[2];
#pragma unroll
        for (int hf = 0; hf < 2; ++hf) qf[hf] = *(const bf16x8*)(QA + (size_t)(row0 + q) * 256 + h * 64 + hf * 32 + 8 * g);
        const unsigned short* mrow = MASK + (size_t)(row0 + q) * 256;
        const int nsteps = 2 * qb + 2;
        const bf16_t* ksrc = KA + (size_t)(b * SEQ + srow) * 256 + h * 64 + sch * 8;
        const bf16_t* vsrc = VTA + (size_t)(b * 256 + h * 64 + srow) * SEQ + sch * 8;
        u32x4 kA = *(const u32x4*)ksrc, vA = *(const u32x4*)vsrc, kB = kA, vB = vA;
        u32x2 mE = *(const u32x2*)mrow, mO = mE;
        *(u32x4*)(Kt + srow * 72 + sch * 8) = kA; *(u32x4*)(Vt + srow * 72 + sch * 8) = vA;
        if (nsteps > 1) { kB = *(const u32x4*)(ksrc + (size_t)64 * 256); vB = *(const u32x4*)(vsrc + 64); mO = *(const u32x2*)(mrow + 4); }
        f32x4 o[4]; float lsum = 0.f; const f32x4 negm = {-msh, -msh, -msh, -msh};
#pragma unroll
        for (int d = 0; d < 4; ++d) o[d] = (f32x4){0.f, 0.f, 0.f, 0.f};
        __syncthreads();
#define A2_COMPUTE(st, buf, mcur) do { \
            const bf16_t* kb_ = Kt + (buf) * 64 * 72; const bf16_t* vb_ = Vt + (buf) * 64 * 72; \
            _Pragma("unroll") for (int p = 0; p < 2; ++p) { \
                const int kt0 = (st) * 4 + 2 * p; \
                if (kt0 <= qgw) { \
                    const unsigned mw = p ? (mcur).y : (mcur).x; \
                    const unsigned nib0 = (mw >> (4 * g)) & 15u, nib1 = (kt0 + 1 <= qgw) ? ((mw >> (16 + 4 * g)) & 15u) : 0u; \
                    const bf16_t* kr0 = kb_ + (p * 32 + q) * 72 + 8 * g; const bf16_t* kr1 = kr0 + 16 * 72; \
                    f32x4 a0 = mfma16(*(const bf16x8*)kr0, qf[0], negm); a0 = mfma16(*(const bf16x8*)(kr0 + 32), qf[1], a0); \
                    f32x4 a1 = mfma16(*(const bf16x8*)kr1, qf[0], negm); a1 = mfma16(*(const bf16x8*)(kr1 + 32), qf[1], a1); \
                    float p0[4], p1[4]; \
                    _Pragma("unroll") for (int j = 0; j < 4; ++j) { p0[j] = __uint_as_float(__float_as_uint(__builtin_amdgcn_exp2f(a0[j])) & (0u - ((nib0 >> j) & 1u))); p1[j] = __uint_as_float(__float_as_uint(__builtin_amdgcn_exp2f(a1[j])) & (0u - ((nib1 >> j) & 1u))); } \
                    lsum += ((p0[0] + p0[1]) + (p0[2] + p0[3])) + ((p1[0] + p1[1]) + (p1[2] + p1[3])); \
                    const bf16x8 pf = mk8(cvt_pk_bf16(p0[0], p0[1]), cvt_pk_bf16(p0[2], p0[3]), cvt_pk_bf16(p1[0], p1[1]), cvt_pk_bf16(p1[2], p1[3])); \
                    _Pragma("unroll") for (int d = 0; d < 4; ++d) { const bf16_t* vr = vb_ + (d * 16 + q) * 72 + p * 32 + 4 * g; \
                        const u32x2 lo = *(const u32x2*)vr, hi = *(const u32x2*)(vr + 16); \
                        o[d] = mfma16(mk8(lo.x, lo.y, hi.x, hi.y), pf, o[d]); } \
                } } } while (0)
        for (int st = 0; st < nsteps; st += 2) {
            {
                const bool more2 = st + 2 < nsteps; u32x2 mEn = mE;
                if (more2) { kA = *(const u32x4*)(ksrc + (size_t)(st + 2) * 64 * 256); vA = *(const u32x4*)(vsrc + (st + 2) * 64); mEn = *(const u32x2*)(mrow + (st + 2) * 4); }
                A2_COMPUTE(st, 0, mE);
                *(u32x4*)(Kt + 64 * 72 + srow * 72 + sch * 8) = kB; *(u32x4*)(Vt + 64 * 72 + srow * 72 + sch * 8) = vB;
                __syncthreads();
                mE = mEn;
            }
            {
                const int s1 = st + 1; const bool more2 = s1 + 2 < nsteps; u32x2 mOn = mO;
                if (more2) { kB = *(const u32x4*)(ksrc + (size_t)(s1 + 2) * 64 * 256); vB = *(const u32x4*)(vsrc + (s1 + 2) * 64); mOn = *(const u32x2*)(mrow + (s1 + 2) * 4); }
                A2_COMPUTE(s1, 1, mO);
                if (s1 + 1 < nsteps) { *(u32x4*)(Kt + srow * 72 + sch * 8) = kA; *(u32x4*)(Vt + srow * 72 + sch * 8) = vA; }
                __syncthreads();
                mO = mOn;
            }
        }
#undef A2_COMPUTE
        lsum += __shfl_xor(lsum, 16); lsum += __shfl_xor(lsum, 32);
        const float inv = 1.f / lsum;
#pragma unroll
        for (int d = 0; d < 4; ++d) { const f32x4 v = o[d] * inv;
            *(u32x2*)(OA + (size_t)(row0 + q) * 1024 + h * 64 + d * 16 + 4 * g) = (u32x2){cvt_pk_bf16(v[0], v[1]), cvt_pk_bf16(v[2], v[3])}; }
    }
}

__device__ __forceinline__ void phase_b(const bf16_t* PIN, const bf16_t* WpT, const float* pscale, bf16_t* OB, int gw, int ngw, int lane) {
    const int q = lane & 15, g4 = lane >> 4;
    for (int L = gw; L < 4096; L += ngw) {
        const int gp = L >> 10, tg = L & 1023; const int row = tg * 16 + q; const int t = row & (SEQ - 1);
        const int win = 2 << gp; const int cnt = (t + 1 < win) ? t + 1 : win; const float inv = 1.f / (float)cnt;
        f32x4 acc[4];
#pragma unroll
        for (int d = 0; d < 4; ++d) acc[d] = (f32x4){0.f, 0.f, 0.f, 0.f};
#pragma unroll
        for (int ch = 0; ch < 2; ++ch) {
            const bf16_t* p = PIN + (size_t)row * 256 + gp * 64 + ch * 32 + 8 * g4;
            u32x4 wv[16];
#pragma unroll
            for (int i = 0; i < 16; ++i) { wv[i] = (u32x4){0u, 0u, 0u, 0u}; if (i < win && i <= t) wv[i] = *(const u32x4*)(p - (size_t)i * 256); }
            float own[8], sum[8];
            own[0] = bflo(wv[0].x); own[1] = bfhi(wv[0].x); own[2] = bflo(wv[0].y); own[3] = bfhi(wv[0].y); own[4] = bflo(wv[0].z); own[5] = bfhi(wv[0].z); own[6] = bflo(wv[0].w); own[7] = bfhi(wv[0].w);
#pragma unroll
            for (int k = 0; k < 8; ++k) sum[k] = own[k];
#pragma unroll
            for (int i = 1; i < 16; ++i) { const u32x4 v = wv[i];
                sum[0] += bflo(v.x); sum[1] += bfhi(v.x); sum[2] += bflo(v.y); sum[3] += bfhi(v.y); sum[4] += bflo(v.z); sum[5] += bfhi(v.z); sum[6] += bflo(v.w); sum[7] += bfhi(v.w); }
            float pl[8];
#pragma unroll
            for (int k = 0; k < 8; ++k) pl[k] = sum[k] * inv - own[k];
            const bf16x8 bfr = mk8(cvt_pk_bf16(pl[0], pl[1]), cvt_pk_bf16(pl[2], pl[3]), cvt_pk_bf16(pl[4], pl[5]), cvt_pk_bf16(pl[6], pl[7]));
#pragma unroll
            for (int d = 0; d < 4; ++d) { const bf16x8 afr = *(const bf16x8*)(WpT + gp * 4096 + (d * 16 + q) * 64 + ch * 32 + 8 * g4); acc[d] = mfma16(afr, bfr, acc[d]); }
        }
#pragma unroll
        for (int d = 0; d < 4; ++d) { const int d0 = d * 16 + 4 * g4; const f32x4 sc = *(const f32x4*)(pscale + gp * 64 + d0); const f32x4 v = acc[d] * sc;
            *(u32x2*)(OB + (size_t)row * 1024 + gp * 64 + d0) = (u32x2){cvt_pk_bf16(v[0], v[1]), cvt_pk_bf16(v[2], v[3])}; }
    }
}

__device__ __forceinline__ void phase_c(unsigned char* lds, const bf16_t* GV, const bf16_t* GU, bf16_t* OC, const float* gamma, const bf16_t* Wtril, const float* gbias, int tid, int bid, int G) {
    bf16_t* LT = (bf16_t*)lds;
    const int lane = tid & 63, w = __builtin_amdgcn_readfirstlane(tid >> 6), q = lane & 15, g4 = lane >> 4;
    for (int L = bid; L < 512; L += G) {
        const int gp = L & 3, chk = L >> 2; const int R0 = chk * 128;
        {
            const int row = tid >> 2, part = tid & 3;
            const bf16_t* src = GV + (size_t)(R0 + row) * 256 + part * 64;
            float x[64];
#pragma unroll
            for (int k8 = 0; k8 < 8; ++k8) { const u32x4 v = *(const u32x4*)(src + 8 * k8);
                x[8 * k8 + 0] = bflo(v.x); x[8 * k8 + 1] = bfhi(v.x); x[8 * k8 + 2] = bflo(v.y); x[8 * k8 + 3] = bfhi(v.y); x[8 * k8 + 4] = bflo(v.z); x[8 * k8 + 5] = bfhi(v.z); x[8 * k8 + 6] = bflo(v.w); x[8 * k8 + 7] = bfhi(v.w); }
            float s = 0.f;
#pragma unroll
            for (int k = 0; k < 64; ++k) s += x[k];
            s += __shfl_xor(s, 1); s += __shfl_xor(s, 2);
            const float mean = s * (1.f / 256.f); float ss = 0.f;
#pragma unroll
            for (int k = 0; k < 64; ++k) { const float dd = x[k] - mean; ss += dd * dd; }
            ss += __shfl_xor(ss, 1); ss += __shfl_xor(ss, 2);
            const float rstd = __builtin_amdgcn_rsqf(ss * (1.f / 256.f) + EPSN);
            if (part == gp) {
#pragma unroll
                for (int k4 = 0; k4 < 16; ++k4) { const f32x4 gm = *(const f32x4*)(gamma + gp * 64 + 4 * k4);
#pragma unroll
                    for (int i = 0; i < 4; ++i) LT[(4 * k4 + i) * 136 + row] = f2bf((x[4 * k4 + i] - mean) * rstd * gm[i]); }
            }
        }
        __syncthreads();
        {
            f32x4 acc[4];
#pragma unroll
            for (int d = 0; d < 4; ++d) acc[d] = (f32x4){0.f, 0.f, 0.f, 0.f};
            const int t = 16 * w + q; const int nsb = ((16 * w + 15) >> 5) + 1;
            for (int sb = 0; sb < nsb; ++sb) {
                const bf16x8 bfr = *(const bf16x8*)(Wtril + ((size_t)gp * 128 + t) * 128 + sb * 32 + 8 * g4);
#pragma unroll
                for (int d = 0; d < 4; ++d) { const bf16x8 afr = *(const bf16x8*)(LT + (d * 16 + q) * 136 + sb * 32 + 8 * g4); acc[d] = mfma16(afr, bfr, acc[d]); }
            }
            const float bias = gbias[gp * 128 + t];
#pragma unroll
            for (int d = 0; d < 4; ++d) { const size_t eo = (size_t)(R0 + t) * 256 + gp * 64 + d * 16 + 4 * g4; const u32x2 uu = *(const u32x2*)(GU + eo);
                const float r0 = bflo(uu.x) * (acc[d][0] + bias), r1 = bfhi(uu.x) * (acc[d][1] + bias), r2 = bflo(uu.y) * (acc[d][2] + bias), r3 = bfhi(uu.y) * (acc[d][3] + bias);
                *(u32x2*)(OC + (size_t)(R0 + t) * 1024 + gp * 64 + d * 16 + 4 * g4) = (u32x2){cvt_pk_bf16(r0, r1), cvt_pk_bf16(r2, r3)}; }
        }
        __syncthreads();
    }
}

__device__ __forceinline__ void sb_tile(const f32x4 z, int kbase, int tq, int g, float& carry, float (&a)[4]) {
    float lm[4]; bool msk[4];
#pragma unroll
    for (int j = 0; j < 4; ++j) { msk[j] = (kbase + 4 * g + j) >= tq;
        const float e = __builtin_amdgcn_exp2f(-fabsf(z[j]) * LOG2E); const float sp = relu1(z[j]) + __builtin_amdgcn_logf(1.f + e) * LN2;
        lm[j] = msk[j] ? 0.f : -sp; }
    const float suf2 = lm[3], suf1 = lm[3] + lm[2], suf0 = suf1 + lm[1]; const float T = suf0 + lm[0];
    const float x16 = __shfl_xor(T, 16); const float Pp = T + x16; const float Qq = __shfl_xor(Pp, 32);
    const float Sg = ((g & 1) ? 0.f : x16) + ((g & 2) ? 0.f : Qq);
    const float base = carry + Sg;
    const float tl[4] = {base + suf0, base + suf1, base + suf2, base};
#pragma unroll
    for (int j = 0; j < 4; ++j) a[j] = msk[j] ? 0.f : __builtin_amdgcn_exp2f((z[j] + lm[j] + tl[j]) * LOG2E);
    carry += Pp + Qq;
}
__device__ __forceinline__ void phase_d(const bf16_t* SQ, bf16_t* OD, const bf16_t* SK, const bf16_t* VTS, int gw, int ngw, int lane) {
    const int q = lane & 15, g = lane >> 4;
    for (int L0 = gw; L0 < 2048; L0 += ngw) {
        const int blk_ = L0 >> 3, L = ((((blk_ & 7) * 32 + ((blk_ >> 3) & 31)) << 3) | (L0 & 7)) & 2047;
        const int qg = L & 255, bh = L >> 8, b0 = bh >> 2, h = bh & 3;
        const int tq = qg * 16 + q;
        bf16x8 qf[2][2]; f32x4 o[2][4]; float carry[2] = {0.f, 0.f};
#pragma unroll
        for (int u = 0; u < 2; ++u) { const int row0 = (b0 + 2 * u) * SEQ + qg * 16;
#pragma unroll
            for (int hf = 0; hf < 2; ++hf) qf[u][hf] = *(const bf16x8*)(SQ + (size_t)(row0 + q) * 256 + h * 64 + hf * 32 + 8 * g);
#pragma unroll
            for (int d = 0; d < 4; ++d) o[u][d] = (f32x4){0.f, 0.f, 0.f, 0.f}; }
        bf16x8 kn[2][4]; u32x2 vn[2][8];
#define D_LOAD(ppx) do { const int k0_ = (ppx) * 32; _Pragma("unroll") for (int u = 0; u < 2; ++u) { const int b = b0 + 2 * u; \
                const bf16_t* kb = SK + (size_t)(b * SEQ + k0_ + q) * 256 + h * 64 + 8 * g; \
                _Pragma("unroll") for (int i = 0; i < 4; ++i) kn[u][i] = *(const bf16x8*)(kb + (size_t)(i >> 1) * 16 * 256 + (i & 1) * 32); \
                const bf16_t* vb = VTS + (size_t)(b * 256 + h * 64 + q) * SEQ + k0_ + 4 * g; \
                _Pragma("unroll") for (int d = 0; d < 4; ++d) { vn[u][2 * d] = *(const u32x2*)(vb + (size_t)d * 16 * SEQ); vn[u][2 * d + 1] = *(const u32x2*)(vb + (size_t)d * 16 * SEQ + 16); } } } while (0)
        D_LOAD(qg >> 1);
        for (int pp = qg >> 1; pp >= 0; --pp) {
            const int kt0 = 2 * pp, kt1 = kt0 + 1;
            bf16x8 kc[2][4]; u32x2 vc[2][8];
#pragma unroll
            for (int u = 0; u < 2; ++u) {
#pragma unroll
                for (int i = 0; i < 4; ++i) kc[u][i] = kn[u][i];
#pragma unroll
                for (int i = 0; i < 8; ++i) vc[u][i] = vn[u][i]; }
            D_LOAD(pp > 0 ? pp - 1 : 0);
            float a0[2][4], a1[2][4];
#pragma unroll
            for (int u = 0; u < 2; ++u) {
                if (kt1 <= qg) {
                    f32x4 z = mfma16(kc[u][2], qf[u][0], (f32x4){0.f, 0.f, 0.f, 0.f}); z = mfma16(kc[u][3], qf[u][1], z);
                    sb_tile(z, kt1 * 16, tq, g, carry[u], a1[u]);
                } else {
#pragma unroll
                    for (int j = 0; j < 4; ++j) a1[u][j] = 0.f;
                }
            }
#pragma unroll
            for (int u = 0; u < 2; ++u) {
                f32x4 z = mfma16(kc[u][0], qf[u][0], (f32x4){0.f, 0.f, 0.f, 0.f}); z = mfma16(kc[u][1], qf[u][1], z);
                sb_tile(z, kt0 * 16, tq, g, carry[u], a0[u]);
            }
#pragma unroll
            for (int u = 0; u < 2; ++u) {
                const bf16x8 pf = mk8(cvt_pk_bf16(a0[u][0], a0[u][1]), cvt_pk_bf16(a0[u][2], a0[u][3]), cvt_pk_bf16(a1[u][0], a1[u][1]), cvt_pk_bf16(a1[u][2], a1[u][3]));
#pragma unroll
                for (int d = 0; d < 4; ++d) o[u][d] = mfma16(mk8(vc[u][2 * d].x, vc[u][2 * d].y, vc[u][2 * d + 1].x, vc[u][2 * d + 1].y), pf, o[u][d]);
            }
            if (__all(carry[0] < -104.f && carry[1] < -104.f)) break;
        }
#undef D_LOAD
#pragma unroll
        for (int u = 0; u < 2; ++u) { const int row0 = (b0 + 2 * u) * SEQ + qg * 16;
#pragma unroll
            for (int d = 0; d < 4; ++d) *(u32x2*)(OD + (size_t)(row0 + q) * 1024 + h * 64 + d * 16 + 4 * g) = (u32x2){cvt_pk_bf16(o[u][d][0], o[u][d][1]), cvt_pk_bf16(o[u][d][2], o[u][d][3])}; }
    }
}

#define XB_TMO      128
#define XB_XCNT(j)  (256  + 64 * (j))
#define XB_XSUB(j)  (1280 + 64 * (j))
#define XB_XGEN(j)  (2304 + 64 * (j))
#define XB_TOP      3328
#define XB_TOPGEN   3392
#define XCD_BAR_WORDS 3456
#define XB_SPIN_CAP (1u << 18)

__device__ __forceinline__ unsigned xb_ld(unsigned* p)              { return __hip_atomic_load(p, __ATOMIC_RELAXED, __HIP_MEMORY_SCOPE_AGENT); }
__device__ __forceinline__ unsigned xb_add(unsigned* p, unsigned v) { return __hip_atomic_fetch_add(p, v, __ATOMIC_RELAXED, __HIP_MEMORY_SCOPE_AGENT); }
__device__ __forceinline__ unsigned xb_xcc_id() { return (unsigned)__builtin_amdgcn_s_getreg((3 << 11) | 20) & 0xFu; }
#define XB_SPIN(cond, bar) do { unsigned _sp = 0; while (cond) { __builtin_amdgcn_s_sleep(1); \
    if ((++_sp & 255u) == 0u) { if (xb_ld(&(bar)[XB_TMO])) break; if (_sp > XB_SPIN_CAP) { atomicAdd(&(bar)[XB_TMO], 1u); break; } } } } while (0)

struct XcdBarrier {
    unsigned* bar; unsigned x;
    volatile LAS unsigned* st;
};

__device__ __forceinline__ XcdBarrier xcd_barrier_post(unsigned* bar, volatile LAS unsigned* st) {
    XcdBarrier b; b.bar = bar; b.x = xb_xcc_id(); b.st = st;
    if (threadIdx.x == 0) (void)xb_add(&bar[XB_XCNT(b.x)], 1u);
    return b;
}
__device__ __forceinline__ void xcd_barrier_complete(unsigned* bar, unsigned x, unsigned& nloc, unsigned& nx) {
    const unsigned G = gridDim.x * gridDim.y * gridDim.z;
    unsigned sum, cnt, mine, sp = 0u;
    for (;;) {
        sum = 0u; cnt = 0u; mine = 0u;
#pragma unroll
        for (unsigned j = 0; j < 16; ++j) { const unsigned c = xb_ld(&bar[XB_XCNT(j)]); sum += c; cnt += (c > 0u) ? 1u : 0u; mine = (j == x) ? c : mine; }
        if (sum == G) break;
        __builtin_amdgcn_s_sleep(1);
        if ((++sp & 255u) == 0u) { if (xb_ld(&bar[XB_TMO])) break; if (sp > XB_SPIN_CAP) { atomicAdd(&bar[XB_TMO], 1u); break; } }
    }
    nloc = mine > 0u ? mine : 1u; nx = cnt > 0u ? cnt : 1u;
}

__device__ __forceinline__ void xcd_barrier(const XcdBarrier& b) {
    asm volatile("s_waitcnt vmcnt(0)" ::: "memory");
    __syncthreads();
    if (threadIdx.x == 0) {
        unsigned* bar = b.bar;
        __builtin_amdgcn_s_waitcnt(0);
        unsigned nloc = b.st[0], nx = b.st[1];
        if (nloc == 0u) { xcd_barrier_complete(bar, b.x, nloc, nx); b.st[0] = nloc; b.st[1] = nx; }
        const unsigned old = xb_add(&bar[XB_XSUB(b.x)], 1u);
        const unsigned gen = old / nloc;
        if (old + 1u == (gen + 1u) * nloc) {
            __builtin_amdgcn_fence(__ATOMIC_RELEASE, "agent");
            asm volatile("s_waitcnt vmcnt(0)" ::: "memory");
            const unsigned og = xb_add(&bar[XB_TOP], 1u);
            const unsigned tg = og / nx;
            if (og + 1u == (tg + 1u) * nx) xb_add(&bar[XB_TOPGEN], 1u);
            else XB_SPIN(xb_ld(&bar[XB_TOPGEN]) == tg, bar);
            __builtin_amdgcn_fence(__ATOMIC_ACQUIRE, "agent");
            xb_add(&bar[XB_XGEN(b.x)], 1u);
            asm volatile("s_waitcnt vmcnt(0)" ::: "memory");
        } else {
            XB_SPIN(xb_ld(&bar[XB_XGEN(b.x)]) == gen, bar);
            __builtin_amdgcn_fence(__ATOMIC_ACQUIRE, "agent");
            asm volatile("s_waitcnt vmcnt(0)" ::: "memory");
        }
    }
    __syncthreads();
}

#ifndef REP_P0
#define REP_P0 1
#endif
#ifndef REP_P1
#define REP_P1 1
#endif
#ifndef REP_A1
#define REP_A1 1
#endif
#ifndef REP_BCD
#define REP_BCD 1
#endif
#ifndef REP_A2
#define REP_A2 1
#endif
#ifndef REP_MG
#define REP_MG 1
#endif
#ifndef REP_UP
#define REP_UP 1
#endif
#ifndef REP_WO
#define REP_WO 1
#endif
#ifndef REP_N2
#define REP_N2 1
#endif
#ifndef REP_DN
#define REP_DN 1
#endif
#ifndef REP_B
#define REP_B 1
#endif
#ifndef REP_C
#define REP_C 1
#endif
#ifndef REP_D
#define REP_D 1
#endif
#ifndef REP_SYNC
#define REP_SYNC 1
#endif
#define GSYNC() do { _Pragma("unroll 1") for (int r_ = 0; r_ < REP_SYNC; ++r_) xcd_barrier(bar); } while (0)
#define REPEAT(n) _Pragma("unroll 1") for (int rep_ = 0; rep_ < (n); ++rep_)
struct Args { const float* in[16]; float* out; unsigned char* ws; };
constexpr int LDS_BYTES = 147456;
__device__ __forceinline__ unsigned char* opq(unsigned char* p) { asm volatile("" : "+s"(p)); return p; }
__device__ __forceinline__ int opq_tid() { int t = threadIdx.x; asm volatile("" : "+v"(t)); return t; }
#define WSB(T, off) ((T*)(ws + (off)))
constexpr int PTAB_OFF = 147456 - 512, BST_OFF = 147456 - 64;
__device__ __forceinline__ void* ldp(PG8_LAS unsigned char* ldsl, int i) {
    unsigned off = PTAB_OFF + 8 * i; asm volatile("" : "+v"(off));
    const unsigned long long v = *(volatile LAS unsigned long long*)(ldsl + off);
    const unsigned lo = __builtin_amdgcn_readfirstlane((unsigned)v), hi = __builtin_amdgcn_readfirstlane((unsigned)(v >> 32));
    return (void*)(__attribute__((address_space(1))) void*)(((unsigned long long)hi << 32) | lo);
}

__global__ void __launch_bounds__(512, 2) fwd_kernel(Args a) {
    extern __shared__ __attribute__((aligned(16))) unsigned char lds[];
    cg::grid_group grid = cg::this_grid();
    PG8_LAS unsigned char* ldsl = (PG8_LAS unsigned char*)lds;
    if (a.ws == nullptr) grid.sync();
    if (threadIdx.x == 0) { ((volatile LAS unsigned*)(ldsl + BST_OFF))[0] = 0u; ((volatile LAS unsigned*)(ldsl + BST_OFF))[1] = 0u; }
    if (threadIdx.x == 0) { LAS unsigned long long* tb = (LAS unsigned long long*)(ldsl + PTAB_OFF);
#pragma unroll
        for (int i = 0; i < 16; ++i) tb[i] = (unsigned long long)a.in[i];
        tb[16] = (unsigned long long)a.out; tb[17] = (unsigned long long)a.ws; }
    __syncthreads();
    XcdBarrier bar = xcd_barrier_post((unsigned*)a.ws + 1024, (volatile LAS unsigned*)(ldsl + BST_OFF));
#define INP(i) ((const float*)ldp(ldsl, (i)))
#define OUTP ((float*)ldp(ldsl, 16))
#define WSP ((unsigned char*)ldp(ldsl, 17))

#define PHASE_VARS unsigned char* ws = WSP; int bid = blockIdx.x; asm volatile("" : "+s"(bid)); int G = gridDim.x; asm volatile("" : "+s"(G)); \
    const int tid = opq_tid(), lane = tid & 63, wave = __builtin_amdgcn_readfirstlane(tid >> 6); const int gw = bid * 8 + wave, ngw = G * 8; (void)ws; (void)lane; (void)gw; (void)ngw;
#ifndef REP_ALL
#define REP_ALL 1
#endif
#pragma unroll 1
    for (int ll = 0; ll < 2 * REP_ALL; ++ll) {
        const int l = ll & 1;
        REPEAT(REP_P0) {
            PHASE_VARS
#ifndef NO_CVT
            Ptrs P; P.mix_g = INP(1) + l * DM; P.ffn_g = INP(12) + l * DM;
            P.w_in = INP(2) + (size_t)l * DM * DIN; P.qn = INP(3) + l * 64; P.kn = INP(4) + l * 64; P.pool_w = INP(5) + l * 4 * 64 * 64; P.pool_scale = INP(6) + l * 256;
            P.gm_norm = INP(7) + l * 256; P.gm_ws = INP(8) + l * 4 * 128 * 128; P.gm_b = INP(9) + l * 4 * 128; P.w_branch = INP(10) + (size_t)l * 4 * 256 * 1024;
            P.w_out = INP(11) + (size_t)l * 1024 * 1024; P.w_gate = INP(13) + (size_t)l * DM * DFF; P.w_up = INP(14) + (size_t)l * DM * DFF; P.w_down = INP(15) + (size_t)l * DFF * DM;
            convert_weights(P, ws, (LAS float*)(ldsl + wave * 8448), gw, ngw, lane, bid * 512 + tid, G * 512);
#endif
            if (l == 0) x_to_bf16_ss(INP(0), WSB(bf16_t, WS_XN), WSB(float, WS_SS0), gw, ngw, lane);
        }
        GSYNC();
        REPEAT(REP_P1) {
            PHASE_VARS
            pg8::Gemm g{WSB(bf16_t, WS_XN), WSB(bf16_t, WS_WIN), M_, NINP, DM}; pg8::StaticOrder S; S.init(M_, NINP, G, bid);
            EpiIn E{ws, INP(3) + l * 64, INP(4) + l * 64, WSB(float, WS_SS0)};
#ifndef NO_G1
            pg8::gemm_phase<EpiIn, pg8::StaticOrder, true, true>(ldsl, g, S, E);
#endif
        }
        GSYNC();
        REPEAT(REP_A1) {
            PHASE_VARS
            for (int i = bid * 512 + tid; i < M_; i += G * 512) { WSB(float, WS_SS0)[i] = 0.f; WSB(float, WS_SS1)[i] = 0.f; }
#ifndef NO_A1
            phase_a1(lds, WSB(bf16_t, WS_IQ), WSB(bf16_t, WS_IK), WSB(float, WS_IW), WSB(unsigned short, WS_MASK), tid, bid, G);
#endif
            __syncthreads();
        }
        REPEAT(REP_BCD) {
        REPEAT(REP_C) {
            PHASE_VARS
#ifndef NO_C
            phase_c(lds, WSB(bf16_t, WS_GV), WSB(bf16_t, WS_GU), WSB(bf16_t, WS_OCAT) + 512, INP(7) + l * 256, WSB(bf16_t, WS_WS), INP(9) + l * 4 * 128, tid, bid, G);
#endif
        }
        REPEAT(REP_B) {
            PHASE_VARS
#ifndef NO_B
            phase_b(WSB(bf16_t, WS_PIN), WSB(bf16_t, WS_WP), INP(6) + l * 256, WSB(bf16_t, WS_OCAT) + 256, gw, ngw, lane);
#endif
        }
        REPEAT(REP_D) {
            PHASE_VARS
#ifndef NO_D
            phase_d(WSB(bf16_t, WS_SQ), WSB(bf16_t, WS_OCAT) + 768, WSB(bf16_t, WS_SK), WSB(bf16_t, WS_VTS), gw, ngw, lane);
#endif
        }
        }
        GSYNC();
        REPEAT(REP_A2) {
            PHASE_VARS
#ifndef NO_A2
            phase_a2(lds, WSB(bf16_t, WS_QA), WSB(bf16_t, WS_OCAT), WSB(bf16_t, WS_KA), WSB(bf16_t, WS_VTA), WSB(unsigned short, WS_MASK), INP(3) + l * 64, INP(4) + l * 64, tid, bid, G);
#endif
        }
        GSYNC();
        REPEAT(REP_MG) {
            PHASE_VARS
            pg8::Gemm g{WSB(bf16_t, WS_OCAT), WSB(bf16_t, WS_WB), M_, DM, DM}; pg8::StaticOrder S; S.init(M_, DM, G, bid);
            EpiMerge E{ws + WS_G, WSB(bf16_t, WS_XN)};
#ifndef NO_G2
            pg8::gemm_phase<EpiMerge, pg8::StaticOrder, true, true>(ldsl, g, S, E);
#endif
        }
        GSYNC();
        REPEAT(REP_WO) {
            PHASE_VARS
            pg8::Gemm g{WSB(bf16_t, WS_XN), WSB(bf16_t, WS_WOUT), M_, DM, DM}; pg8::StaticOrder S; S.init(M_, DM, G, bid);
            EpiResid E{l == 0 ? INP(0) : OUTP, OUTP, WSB(bf16_t, WS_S), WSB(float, WS_SS1), 1};
#ifndef NO_G3
            pg8::gemm_phase<EpiResid, pg8::StaticOrder, true, true>(ldsl, g, S, E);
#endif
        }
        GSYNC();
        REPEAT(REP_UP) {
            PHASE_VARS
            pg8::Gemm g{WSB(bf16_t, WS_S), WSB(bf16_t, WS_WGU), M_, 2 * DFF, DM}; pg8::StaticOrder S; S.init(M_, 2 * DFF, G, bid);
            EpiSwiGLU E{WSB(bf16_t, WS_R1), WSB(float, WS_SS1)};
#ifndef NO_G4
            pg8::gemm_phase<EpiSwiGLU, pg8::StaticOrder, true, true>(ldsl, g, S, E);
#endif
        }
        GSYNC();
        REPEAT(REP_DN) {
            PHASE_VARS
            pg8::Gemm g{WSB(bf16_t, WS_R1), WSB(bf16_t, WS_WD), M_, DM, DFF}; pg8::StaticOrder S; S.init(M_, DM, G, bid);
            float* o = OUTP; EpiResid E{o, o, WSB(bf16_t, WS_XN), WSB(float, WS_SS0), l == 0 ? 1 : 0};
#ifndef NO_G3
            pg8::gemm_phase<EpiResid, pg8::StaticOrder, true, true>(ldsl, g, S, E);
#endif
        }
        if (ll + 1 < 2 * REP_ALL) GSYNC();
    }
}

extern "C" void kernel_launch(void* const* d_in, const int* in_sizes, int n_in, void* d_out, int out_size, void* d_ws, size_t ws_size, hipStream_t stream) {
    static int grid_blocks = 0;
    if (grid_blocks == 0) {
        if (n_in != 16 || out_size != M_ * DM || ws_size < WS_END) { fprintf(stderr, "kernel_launch: unexpected shapes (n_in %d out %d ws %zu)\n", n_in, out_size, ws_size); grid_blocks = -1; return; }
        int dev = 0, cus = 0, per_cu = 0;
        hipGetDevice(&dev);
        hipDeviceGetAttribute(&cus, hipDeviceAttributeMultiprocessorCount, dev);
        hipFuncSetAttribute((const void*)fwd_kernel, hipFuncAttributeMaxDynamicSharedMemorySize, LDS_BYTES);
        if (hipOccupancyMaxActiveBlocksPerMultiprocessor(&per_cu, (const void*)fwd_kernel, 512, LDS_BYTES) != hipSuccess || per_cu < 1) per_cu = 1;
        (void)hipGetLastError();
        grid_blocks = cus;
    }
    if (grid_blocks < 0) return;
    Args a{};
    for (int i = 0; i < 16; ++i) a.in[i] = (const float*)d_in[i];
    a.out = (float*)d_out; a.ws = (unsigned char*)d_ws;
    if (hipMemsetAsync(d_ws, 0, 65536, stream) != hipSuccess) { fprintf(stderr, "kernel_launch: memset failed\n"); return; }
    void* args[] = {&a};
    hipError_t e = hipLaunchCooperativeKernel((const void*)fwd_kernel, dim3(grid_blocks), dim3(512), args, LDS_BYTES, stream);
    if (e != hipSuccess) fprintf(stderr, "cooperative launch failed: %s (grid %d)\n", hipGetErrorString(e), grid_blocks);
}
```

```cpp
#include <hip/hip_runtime.h>
#include <hip/hip_cooperative_groups.h>
#include <cstdio>
#include <cstdint>
namespace pg8 {
#define PG8_LAS __attribute__((address_space(3)))
typedef unsigned short bf16_t;
typedef short bf16x8 __attribute__((ext_vector_type(8)));
typedef float f32x4 __attribute__((ext_vector_type(4)));
typedef unsigned u32x4 __attribute__((ext_vector_type(4)));
constexpr int BM = 256, BK = 64, HALF = 128, HTB = HALF * BK * 2  , STAGE_BYTES = 8 * HTB, NXCD = 8, WGM = 8;

__host__ __device__ __forceinline__ int lds_byte(int r, int c) { const int st = (r >> 4) * 2 + (c >> 5), rr = r & 15, cc = c & 31, ob = rr * 64 + cc * 2; return st * 1024 + (ob ^ (((ob >> 9) & 1) << 5)); }
__host__ __device__ __forceinline__ void stage_rc(int b, int& R, int& C) { const int st = b / 1024, sb = b % 1024, swz = sb ^ (((sb >> 9) & 1) << 5); R = (st >> 1) * 16 + swz / 64; C = (st & 1) * 32 + (swz % 64) / 2; }
__host__ __device__ __forceinline__ int perm32(int rho) { const int n = rho >> 4, i = rho & 15; return 8 * (i >> 2) + 4 * n + (i & 3); }

struct Unit { int pm, pn; };
struct Gemm { const bf16_t* A; const bf16_t* Bt; int M, N, K; };

struct StaticOrder {
    int nM, nN, nwg, G, c;
    __host__ __device__ void init(int M, int N, int G_, int c_) { nM = M / BM; nN = N / BM; nwg = nM * nN; G = G_; c = c_; }
    __host__ __device__ bool next(int i, Unit& u) const {
        const long L = (long)i * G + c; if (L >= nwg) return false;
        int wgid = (int)L; { const int q = nwg / NXCD, r = nwg % NXCD, xcd = wgid % NXCD, off = wgid / NXCD; wgid = (xcd < r ? xcd * (q + 1) : r * (q + 1) + (xcd - r) * q) + off; }
        const int nig = WGM * nN, gid = wgid / nig, fm = gid * WGM, gsz = (nM - fm) < WGM ? (nM - fm) : WGM;
        u.pm = fm + ((wgid % nig) % gsz); u.pn = (wgid % nig) / gsz; return true;
    }
    __device__ __forceinline__ void a_ready(const Unit&) const {}
    __device__ __forceinline__ void done(const Unit&) const {}
};

__device__ __forceinline__ unsigned cvt_pk_bf16(float lo, float hi) { unsigned r; asm volatile("v_cvt_pk_bf16_f32 %0, %1, %2" : "=v"(r) : "v"(lo), "v"(hi)); return r; }
template <class Epi, class Sched, bool ALIGN_EPI = false, bool SP2 = false>
__device__ __forceinline__ void gemm_phase(PG8_LAS unsigned char* lds, const Gemm g, const Sched& S, const Epi& E) {
    int tid_ = threadIdx.x; asm volatile("" : "+v"(tid_)); const int tid = tid_, wid = __builtin_amdgcn_readfirstlane(tid >> 6), lane = tid & 63, wr = wid >> 2, wc = wid & 3, fr = lane & 15, fq = lane >> 4;
    const int K = g.K, nt = K / BK;
    unsigned voffA[2], voffB[2];
#pragma unroll
    for (int i = 0; i < 2; ++i) { int R, C; stage_rc(tid * 16 + i * 8192, R, C); const int Rb = Epi::PERM ? ((R & ~31) + perm32(R & 31)) : R;
        voffA[i] = (unsigned)(R * K + C) * 2u; voffB[i] = (unsigned)(Rb * K + C) * 2u; }
    const size_t kstep = (size_t)(BK * 2);
    const size_t hstep = (size_t)HALF * K * 2;
    const size_t tstep = 2 * hstep;
    const unsigned ldsw = (unsigned)wid * 1024u;
    const int aoff = lds_byte(wr * 64 + fr, fq * 8), boff = lds_byte(wc * 32 + fr, fq * 8);
#define PG8_SA(b, h) (((b) * 2 + (h)) * HTB)
#define PG8_SB(b, h) ((4 + (b) * 2 + (h)) * HTB)
#define PG8_STAGE(bufoff, gbase, voff) do { _Pragma("unroll") for (int _i = 0; _i < 2; ++_i) \
        __builtin_amdgcn_global_load_lds((const unsigned*)((const char*)(gbase) + (voff)[_i]), (PG8_LAS unsigned*)(lds + (bufoff) + ldsw + _i * 8192), 16, 0, 0); } while (0)
#define PG8_LDA(dst, b, h) do { _Pragma("unroll") for (int m = 0; m < 4; ++m) _Pragma("unroll") for (int k = 0; k < 2; ++k) dst[m][k] = *(const PG8_LAS bf16x8*)(lds + PG8_SA(b, h) + aoff + m * 2048 + k * 1024); } while (0)
#define PG8_LDB(dst, b, h) do { _Pragma("unroll") for (int n = 0; n < 2; ++n) _Pragma("unroll") for (int k = 0; k < 2; ++k) dst[n][k] = *(const PG8_LAS bf16x8*)(lds + PG8_SB(b, h) + boff + n * 2048 + k * 1024); } while (0)
#define PG8_MMA(ai, bj, At, Bt) do { __builtin_amdgcn_s_setprio(1); _Pragma("unroll") for (int m = 0; m < 4; ++m) _Pragma("unroll") for (int n = 0; n < 2; ++n) _Pragma("unroll") for (int k = 0; k < 2; ++k) \
        acc[ai][bj][m][n] = __builtin_amdgcn_mfma_f32_16x16x32_bf16(Bt[n][k], At[m][k], acc[ai][bj][m][n], 0, 0, 0); __builtin_amdgcn_s_setprio(0); } while (0)
#define PG8_WAIT_V(n) asm volatile("s_waitcnt vmcnt(" #n ")" ::: "memory")
#define PG8_WAIT_L(n) asm volatile("s_waitcnt lgkmcnt(" #n ")" ::: "memory")
#define PG8_BAR __builtin_amdgcn_s_barrier()
#define PG8_SCHED __builtin_amdgcn_sched_barrier(0)
    Unit cur, nxt; int ui = 0;
    if (!S.next(0, cur)) return;
    f32x4 acc[2][2][4][2];
#pragma unroll
    for (int a = 0; a < 2; ++a)
#pragma unroll
        for (int b = 0; b < 2; ++b)
#pragma unroll
            for (int m = 0; m < 4; ++m)
#pragma unroll
                for (int n = 0; n < 2; ++n) acc[a][b][m][n] = (f32x4){0.f, 0.f, 0.f, 0.f};
    bf16x8 At[4][2], B0[2][2], B1[2][2];
    const char* cA = (const char*)g.A + (size_t)cur.pm * tstep; const char* cB = (const char*)g.Bt + (size_t)cur.pn * tstep;
    S.a_ready(cur);
    if constexpr (SP2) {
        PG8_STAGE(PG8_SB(0, 0), cB, voffB); PG8_STAGE(PG8_SB(0, 1), cB + hstep, voffB); PG8_STAGE(PG8_SA(0, 0), cA, voffA); PG8_STAGE(PG8_SA(0, 1), cA + hstep, voffA);
        if (wr == 1) PG8_BAR;
        PG8_WAIT_V(2); PG8_BAR;
        PG8_STAGE(PG8_SB(1, 0), cB + kstep, voffB); PG8_STAGE(PG8_SA(1, 0), cA + kstep, voffA); PG8_STAGE(PG8_SB(1, 1), cB + hstep + kstep, voffB);
        PG8_WAIT_V(6); PG8_BAR;
    } else {
        PG8_STAGE(PG8_SB(0, 0), cB, voffB); PG8_STAGE(PG8_SA(0, 0), cA, voffA); PG8_STAGE(PG8_SB(0, 1), cB + hstep, voffB); PG8_STAGE(PG8_SA(0, 1), cA + hstep, voffA);
        if (wr == 1) PG8_BAR;
        PG8_WAIT_V(4); PG8_BAR;
        PG8_STAGE(PG8_SB(1, 0), cB + kstep, voffB); PG8_STAGE(PG8_SA(1, 0), cA + kstep, voffA); PG8_STAGE(PG8_SB(1, 1), cB + hstep + kstep, voffB);
        PG8_WAIT_V(6); PG8_BAR;
    }
    for (;;) {
        const bool has_next = S.next(ui + 1, nxt);
        const char* nA = has_next ? (const char*)g.A + (size_t)nxt.pm * tstep : cA; const char* nB = has_next ? (const char*)g.Bt + (size_t)nxt.pn * tstep : cB;
        for (int t = 0; t < nt; t += 2) {
            if constexpr (Epi::HOOK) { if (t != 0 && (t & 3) == 0) E.hook(acc, cur, (t >> 2) - 1, wr, wc, fr, fq); }
            const bool last = (t == nt - 2);
            const char* a1 = cA + (size_t)(t + 1) * kstep;
            const char* a2 = last ? nA : cA + (size_t)(t + 2) * kstep; const char* b2 = last ? nB : cB + (size_t)(t + 2) * kstep;
            const char* a3 = a2 + kstep; const char* b3 = b2 + kstep;
            if (last && has_next) S.a_ready(nxt);
            if constexpr (SP2) {
            PG8_LDB(B0, 0, 0); PG8_LDB(B1, 0, 1); PG8_SCHED; PG8_LDA(At, 0, 0); PG8_STAGE(PG8_SA(1, 1), a1 + hstep, voffA);
            PG8_WAIT_V(8); PG8_WAIT_L(0); PG8_BAR; PG8_MMA(0, 0, At, B0); PG8_MMA(0, 1, At, B1); PG8_BAR; PG8_SCHED;
            PG8_LDA(At, 0, 1); PG8_STAGE(PG8_SB(0, 0), b2, voffB); PG8_STAGE(PG8_SB(0, 1), b2 + hstep, voffB); PG8_STAGE(PG8_SA(0, 0), a2, voffA);
            PG8_WAIT_V(8); PG8_WAIT_L(0); PG8_BAR; PG8_MMA(1, 0, At, B0); PG8_MMA(1, 1, At, B1); PG8_BAR; PG8_SCHED;
            PG8_LDB(B0, 1, 0); PG8_LDB(B1, 1, 1); PG8_SCHED; PG8_LDA(At, 1, 0); PG8_STAGE(PG8_SA(0, 1), a2 + hstep, voffA);
            PG8_WAIT_V(8); PG8_WAIT_L(0); PG8_BAR; PG8_MMA(0, 0, At, B0); PG8_MMA(0, 1, At, B1); PG8_BAR; PG8_SCHED;
            PG8_LDA(At, 1, 1); PG8_STAGE(PG8_SB(1, 0), b3, voffB); PG8_STAGE(PG8_SB(1, 1), b3 + hstep, voffB); PG8_STAGE(PG8_SA(1, 0), a3, voffA);
            PG8_WAIT_V(8); PG8_WAIT_L(0); PG8_BAR; PG8_MMA(1, 0, At, B0); PG8_MMA(1, 1, At, B1); PG8_BAR; PG8_SCHED;
            } else {
            PG8_LDB(B0, 0, 0); PG8_SCHED; PG8_LDA(At, 0, 0); PG8_STAGE(PG8_SA(1, 1), a1 + hstep, voffA);
            PG8_WAIT_L(8); PG8_BAR; PG8_WAIT_L(0); PG8_MMA(0, 0, At, B0); PG8_BAR; PG8_SCHED;
            PG8_LDB(B1, 0, 1); PG8_STAGE(PG8_SB(0, 0), b2, voffB);
            PG8_BAR; PG8_WAIT_L(0); PG8_MMA(0, 1, At, B1); PG8_BAR;
            PG8_LDA(At, 0, 1); PG8_STAGE(PG8_SA(0, 0), a2, voffA);
            PG8_BAR; PG8_WAIT_L(0); PG8_MMA(1, 0, At, B0); PG8_BAR; PG8_SCHED;
            PG8_STAGE(PG8_SB(0, 1), b2 + hstep, voffB);
            PG8_WAIT_V(6); PG8_BAR; PG8_MMA(1, 1, At, B1); PG8_BAR;
            PG8_LDB(B0, 1, 0); PG8_SCHED; PG8_LDA(At, 1, 0); PG8_STAGE(PG8_SA(0, 1), a2 + hstep, voffA);
            PG8_WAIT_L(8); PG8_BAR; PG8_WAIT_L(0); PG8_MMA(0, 0, At, B0); PG8_BAR; PG8_SCHED;
            PG8_LDB(B1, 1, 1); PG8_STAGE(PG8_SB(1, 0), b3, voffB);
            PG8_BAR; PG8_WAIT_L(0); PG8_MMA(0, 1, At, B1); PG8_BAR;
            PG8_LDA(At, 1, 1); PG8_STAGE(PG8_SA(1, 0), a3, voffA);
            PG8_BAR; PG8_WAIT_L(0); PG8_MMA(1, 0, At, B0); PG8_BAR; PG8_SCHED;
            PG8_STAGE(PG8_SB(1, 1), b3 + hstep, voffB);
            PG8_WAIT_V(6); PG8_BAR; PG8_MMA(1, 1, At, B1); PG8_BAR;
            }
        }
        if constexpr (ALIGN_EPI) { if (wr == 0) PG8_BAR; }
        if constexpr (!Epi::AFTER_DRAIN) { E(acc, cur, wr, wc, fr, fq); if constexpr (Epi::EPI_TWICE) { E(acc, cur, wr, wc, fr, fq); } S.done(cur); }
        if (!has_next) break;
#pragma unroll
        for (int a = 0; a < 2; ++a)
#pragma unroll
            for (int b = 0; b < 2; ++b)
#pragma unroll
                for (int m = 0; m < 4; ++m)
#pragma unroll
                    for (int n = 0; n < 2; ++n) acc[a][b][m][n] = (f32x4){0.f, 0.f, 0.f, 0.f};
        cur = nxt; cA = nA; cB = nB; ++ui;
        if constexpr (ALIGN_EPI) { if (wr == 1) PG8_BAR; }
    }
    PG8_WAIT_V(0);
    if constexpr (!ALIGN_EPI) { if (wr == 0) PG8_BAR; }
    PG8_BAR;
    if constexpr (Epi::AFTER_DRAIN) { E.fused(acc, cur, wr, wc, fr, fq, lds, wid, lane); S.done(cur); }
#undef PG8_SA
#undef PG8_SB
#undef PG8_STAGE
#undef PG8_LDA
#undef PG8_LDB
#undef PG8_MMA
#undef PG8_WAIT_V
#undef PG8_WAIT_L
#undef PG8_BAR
#undef PG8_SCHED
}
}
namespace cg = cooperative_groups;
using pg8::bf16_t; using pg8::bf16x8; using pg8::f32x4; using pg8::u32x4; using pg8::Unit; using pg8::cvt_pk_bf16;
typedef unsigned u32x2 __attribute__((ext_vector_type(2)));
#define LAS __attribute__((address_space(3)))
#define LDS_WAIT() asm volatile("s_waitcnt lgkmcnt(0)" ::: "memory")

constexpr int M_ = 16384, DM = 1024, SEQ = 4096, DFF = 2816, DIN = 6696, NINP = 6912;
constexpr float EPSN = 1e-6f;
constexpr float LOG2E = 1.4426950408889634f, LN2 = 0.6931471805599453f;
constexpr float C2 = 0.125f * LOG2E;

constexpr size_t MiB = (size_t)1 << 20;
constexpr size_t WS_SS0 = 128 * 1024, WS_SS1 = 256 * 1024;
constexpr size_t WS_WIN = 1 * MiB;
constexpr size_t WS_WB = WS_WIN + (size_t)NINP * 1024 * 2;
constexpr size_t WS_WOUT = WS_WB + 2 * MiB;
constexpr size_t WS_WGU = WS_WOUT + 2 * MiB;
constexpr size_t WS_WD = WS_WGU + 11 * MiB;
constexpr size_t WS_WP = WS_WD + (size_t)1024 * 2816 * 2;
constexpr size_t WS_WS = WS_WP + 32768;
static_assert(WS_WS + 131072 <= 36 * MiB, "weights region");
constexpr size_t WS_XN = 36 * MiB;
constexpr size_t WS_R1 = 68 * MiB;
constexpr size_t WS_G = WS_R1, WS_KA = WS_R1 + 64 * MiB, WS_VTA = WS_KA + 8 * MiB, WS_IQ = WS_VTA + 8 * MiB;
constexpr size_t WS_S = 156 * MiB;
constexpr size_t WS_PIN = WS_S, WS_GU = WS_S + 8 * MiB, WS_GV = WS_S + 16 * MiB, WS_SQ = WS_S + 24 * MiB, WS_SK = WS_S + 32 * MiB,
                 WS_VTS = WS_S + 40 * MiB, WS_QA = WS_S + 48 * MiB, WS_MASK = WS_S + 56 * MiB, WS_IK = 220 * MiB, WS_IW = 221 * MiB, WS_OCAT = 222 * MiB  , WS_END = 254 * MiB;

__device__ __forceinline__ float bf2f(unsigned short v) { return __uint_as_float((unsigned)v << 16); }
__device__ __forceinline__ float bflo(unsigned v) { return __uint_as_float(v << 16); }
__device__ __forceinline__ float bfhi(unsigned v) { return __uint_as_float(v & 0xffff0000u); }
__device__ __forceinline__ unsigned short f2bf(float f) { return (unsigned short)(cvt_pk_bf16(f, 0.f) & 0xffffu); }
__device__ __forceinline__ float relu1(float x) { const int b = __float_as_int(x); return __int_as_float(b > 0 ? b : 0); }
__device__ __forceinline__ float sigmoidf_(float x) { return __builtin_amdgcn_rcpf(1.f + __builtin_amdgcn_exp2f(-x * LOG2E)); }
__device__ __forceinline__ float gelu_tanh(float x) { const float u = 0.7978845608028654f * (x + 0.044715f * x * x * x); return x * __builtin_amdgcn_rcpf(1.f + __builtin_amdgcn_exp2f(-2.f * LOG2E * u)); }
__device__ __forceinline__ f32x4 mfma16(bf16x8 a, bf16x8 b, f32x4 c) { return __builtin_amdgcn_mfma_f32_16x16x32_bf16(a, b, c, 0, 0, 0); }
__device__ __forceinline__ bf16x8 mk8(unsigned a, unsigned b, unsigned c, unsigned d) { u32x4 v = {a, b, c, d}; return __builtin_bit_cast(bf16x8, v); }

struct EpiIn {
    static constexpr bool PERM = true, AFTER_DRAIN = false, HOOK = false;
#ifdef PROBE_EPI_IN
    static constexpr bool EPI_TWICE = true;
#else
    static constexpr bool EPI_TWICE = false;
#endif
    unsigned char* ws; const float *qn, *kn; const float* SS;
    __device__ __forceinline__ void operator()(const f32x4 (&acc)[2][2][4][2], const Unit& u, int wr, int wc, int fr, int fq) const {
        bf16_t* const QA = (bf16_t*)(ws + WS_QA); bf16_t* const KA = (bf16_t*)(ws + WS_KA); bf16_t* const VTA = (bf16_t*)(ws + WS_VTA); bf16_t* const IQ = (bf16_t*)(ws + WS_IQ);
        bf16_t* const PIN = (bf16_t*)(ws + WS_PIN); bf16_t* const GU = (bf16_t*)(ws + WS_GU); bf16_t* const GV = (bf16_t*)(ws + WS_GV); bf16_t* const SQ = (bf16_t*)(ws + WS_SQ);
        bf16_t* const SK = (bf16_t*)(ws + WS_SK); bf16_t* const VTS = (bf16_t*)(ws + WS_VTS); bf16_t* const IK = (bf16_t*)(ws + WS_IK); float* const IW = (float*)(ws + WS_IW); unsigned char* const G = ws + WS_G;
        const int pn = u.pn; const int row0 = u.pm * 256 + wr * 64 + fr; const int cl = wc * 32 + 8 * fq;
        float rr[2][4];
#pragma unroll
        for (int ai = 0; ai < 2; ++ai)
#pragma unroll
            for (int m = 0; m < 4; ++m) rr[ai][m] = __builtin_amdgcn_rsqf(SS[row0 + ai * 128 + m * 16] * (1.f / 1024.f) + EPSN);
        if (pn >= 11) {
            unsigned char* gp = G + (size_t)row0 * 4096 + (pn - 11) * 256 + cl;
#pragma unroll
            for (int ai = 0; ai < 2; ++ai)
#pragma unroll
                for (int m = 0; m < 4; ++m)
#pragma unroll
                    for (int bj = 0; bj < 2; ++bj) {
                        unsigned w2[2];
#pragma unroll
                        for (int n = 0; n < 2; ++n) { const f32x4 v = (acc[ai][bj][m][n] * rr[ai][m]); unsigned pk = 0;
#pragma unroll
                            for (int i = 0; i < 4; ++i) { const unsigned qv = (unsigned)(sigmoidf_(v[i]) * 255.f + 0.5f); pk |= qv << (8 * i); }
                            w2[n] = pk; }
                        *(u32x2*)(gp + (size_t)(ai * 128 + m * 16) * 4096 + bj * 128) = (u32x2){w2[0], w2[1]};
                    }
            return;
        }
        if (pn <= 1) {
            const float* gw = pn == 0 ? qn : kn; const float sc = pn == 0 ? C2 : 1.f; bf16_t* T = pn == 0 ? QA : KA;
            f32x4 gv[2][2];
#pragma unroll
            for (int bj = 0; bj < 2; ++bj)
#pragma unroll
                for (int n = 0; n < 2; ++n) gv[bj][n] = *(const f32x4*)(gw + bj * 32 + 8 * fq + 4 * n);
#pragma unroll
            for (int ai = 0; ai < 2; ++ai)
#pragma unroll
                for (int m = 0; m < 4; ++m) {
                    float ss = 0.f;
#pragma unroll
                    for (int bj = 0; bj < 2; ++bj)
#pragma unroll
                        for (int n = 0; n < 2; ++n) { const f32x4 v = (acc[ai][bj][m][n] * rr[ai][m]); ss += (v[0] * v[0] + v[1] * v[1]) + (v[2] * v[2] + v[3] * v[3]); }
                    ss += __shfl_xor(ss, 16); ss += __shfl_xor(ss, 32);
                    const float rinv = __builtin_amdgcn_rsqf(ss * (1.f / 64.f) + EPSN) * sc;
                    bf16_t* rp = T + (size_t)(row0 + ai * 128 + m * 16) * 256 + wc * 64 + 8 * fq;
#pragma unroll
                    for (int bj = 0; bj < 2; ++bj) { const f32x4 v0 = (acc[ai][bj][m][0] * rr[ai][m]) * gv[bj][0] * rinv, v1 = (acc[ai][bj][m][1] * rr[ai][m]) * gv[bj][1] * rinv;
                        u32x4 w; w.x = cvt_pk_bf16(v0[0], v0[1]); w.y = cvt_pk_bf16(v0[2], v0[3]); w.z = cvt_pk_bf16(v1[0], v1[1]); w.w = cvt_pk_bf16(v1[2], v1[3]);
                        *(u32x4*)(rp + bj * 32) = w; }
                }
            return;
        }
        if (pn == 2 || pn == 9) {
            bf16_t* T = pn == 2 ? VTA : VTS;
#pragma unroll
            for (int ai = 0; ai < 2; ++ai)
#pragma unroll
                for (int m = 0; m < 4; ++m) { const int row = row0 + ai * 128 + m * 16; const int b = row >> 12, t = row & 4095;
#pragma unroll
                    for (int bj = 0; bj < 2; ++bj)
#pragma unroll
                        for (int n = 0; n < 2; ++n) { const f32x4 v = (acc[ai][bj][m][n] * rr[ai][m]);
#pragma unroll
                            for (int i = 0; i < 4; ++i) T[((size_t)b * 256 + bj * 128 + cl + 4 * n + i) * 4096 + t] = f2bf(v[i]); }
                }
            return;
        }
        if (pn == 10) {
            if (wc == 0) {
#pragma unroll
                for (int ai = 0; ai < 2; ++ai)
#pragma unroll
                    for (int m = 0; m < 4; ++m) { const f32x4 v0 = (acc[ai][0][m][0] * rr[ai][m]), v1 = (acc[ai][0][m][1] * rr[ai][m]);
                        u32x4 w; w.x = cvt_pk_bf16(v0[0], v0[1]); w.y = cvt_pk_bf16(v0[2], v0[3]); w.z = cvt_pk_bf16(v1[0], v1[1]); w.w = cvt_pk_bf16(v1[2], v1[3]);
                        *(u32x4*)(IK + (size_t)(row0 + ai * 128 + m * 16) * 32 + 8 * fq) = w; }
            } else if (wc == 1 && fq == 0) {
#pragma unroll
                for (int ai = 0; ai < 2; ++ai)
#pragma unroll
                    for (int m = 0; m < 4; ++m) { float* p = IW + (size_t)(row0 + ai * 128 + m * 16) * 8; *(f32x4*)p = (acc[ai][0][m][0] * rr[ai][m]); *(f32x4*)(p + 4) = (acc[ai][0][m][1] * rr[ai][m]); }
            }
            return;
        }
        {
            bf16_t* T = pn == 3 ? IQ : pn == 4 ? PIN : pn == 5 ? GU : pn == 6 ? GV : pn == 7 ? SQ : SK;
            const bool act = (pn == 5 || pn == 6); const float sc = pn == 7 ? 0.125f : 1.f;
#pragma unroll
            for (int ai = 0; ai < 2; ++ai)
#pragma unroll
                for (int m = 0; m < 4; ++m) { bf16_t* rp = T + (size_t)(row0 + ai * 128 + m * 16) * 256 + cl;
#pragma unroll
                    for (int bj = 0; bj < 2; ++bj) { f32x4 v0 = (acc[ai][bj][m][0] * rr[ai][m]) * sc, v1 = (acc[ai][bj][m][1] * rr[ai][m]) * sc;
                        if (act) {
#pragma unroll
                            for (int i = 0; i < 4; ++i) { v0[i] = gelu_tanh(v0[i]); v1[i] = gelu_tanh(v1[i]); } }
                        u32x4 w; w.x = cvt_pk_bf16(v0[0], v0[1]); w.y = cvt_pk_bf16(v0[2], v0[3]); w.z = cvt_pk_bf16(v1[0], v1[1]); w.w = cvt_pk_bf16(v1[2], v1[3]);
                        *(u32x4*)(rp + bj * 128) = w; }
                }
        }
    }
};

struct EpiMerge {
    static constexpr bool PERM = true, AFTER_DRAIN = false, HOOK = true, EPI_TWICE = false;
    const unsigned char* G; bf16_t* MG;
    __device__ __forceinline__ void hook(f32x4 (&acc)[2][2][4][2], const Unit& u, int s, int wr, int wc, int fr, int fq) const {
        const int row0 = u.pm * 256 + wr * 64 + fr; const int col0 = u.pn * 256 + wc * 32 + 8 * fq;
        const unsigned char* gp0 = G + (size_t)row0 * 4096 + s * 1024 + col0;
#pragma unroll
        for (int ai = 0; ai < 2; ++ai) {
            u32x2 ga[4][2], gb[4][2];
#pragma unroll
            for (int m = 0; m < 4; ++m)
#pragma unroll
                for (int bj = 0; bj < 2; ++bj) { const unsigned char* gp = gp0 + (size_t)(ai * 128 + m * 16) * 4096 + bj * 128; ga[m][bj] = *(const u32x2*)gp; gb[m][bj] = *(const u32x2*)(gp + 1024); }
#pragma unroll
            for (int m = 0; m < 4; ++m)
#pragma unroll
                for (int bj = 0; bj < 2; ++bj)
#pragma unroll
                    for (int i = 0; i < 4; ++i) {
                        const float a0 = fmaxf((float)((ga[m][bj].x >> (8 * i)) & 255u), 1.f), b0 = fmaxf((float)((gb[m][bj].x >> (8 * i)) & 255u), 1.f);
                        const float a1 = fmaxf((float)((ga[m][bj].y >> (8 * i)) & 255u), 1.f), b1 = fmaxf((float)((gb[m][bj].y >> (8 * i)) & 255u), 1.f);
                        acc[ai][bj][m][0][i] *= a0 * __builtin_amdgcn_rcpf(b0); acc[ai][bj][m][1][i] *= a1 * __builtin_amdgcn_rcpf(b1); }
            asm volatile("" ::: "memory");
        }
    }
    __device__ __forceinline__ void operator()(const f32x4 (&acc)[2][2][4][2], const Unit& u, int wr, int wc, int fr, int fq) const {
        const int row0 = u.pm * 256 + wr * 64 + fr; const int col0 = u.pn * 256 + wc * 32 + 8 * fq;
        const unsigned char* gp0 = G + (size_t)row0 * 4096 + 3 * 1024 + col0; bf16_t* mp0 = MG + (size_t)row0 * 1024 + col0;
        u32x2 gb[2][4][2];
#pragma unroll
        for (int ai = 0; ai < 2; ++ai)
#pragma unroll
            for (int m = 0; m < 4; ++m)
#pragma unroll
                for (int bj = 0; bj < 2; ++bj) gb[ai][m][bj] = *(const u32x2*)(gp0 + (size_t)(ai * 128 + m * 16) * 4096 + bj * 128);
#pragma unroll
        for (int ai = 0; ai < 2; ++ai)
#pragma unroll
            for (int m = 0; m < 4; ++m)
#pragma unroll
                for (int bj = 0; bj < 2; ++bj) { const size_t ro = (size_t)(ai * 128 + m * 16); const u32x2 g2 = gb[ai][m][bj];
                    f32x4 v0 = acc[ai][bj][m][0], v1 = acc[ai][bj][m][1];
#pragma unroll
                    for (int i = 0; i < 4; ++i) { v0[i] *= fmaxf((float)((g2.x >> (8 * i)) & 255u), 1.f) * (1.f / 255.f); v1[i] *= fmaxf((float)((g2.y >> (8 * i)) & 255u), 1.f) * (1.f / 255.f); }
                    u32x4 w; w.x = cvt_pk_bf16(v0[0], v0[1]); w.y = cvt_pk_bf16(v0[2], v0[3]); w.z = cvt_pk_bf16(v1[0], v1[1]); w.w = cvt_pk_bf16(v1[2], v1[3]);
                    *(u32x4*)(mp0 + ro * 1024 + bj * 128) = w; }
    }
};

struct EpiResid {
    static constexpr bool PERM = true, AFTER_DRAIN = false, HOOK = false, EPI_TWICE = false;
    const float* base; float* out; bf16_t* XB; float* SS; int stat;
    __device__ __forceinline__ void operator()(const f32x4 (&acc)[2][2][4][2], const Unit& u, int wr, int wc, int fr, int fq) const {
        const int row0 = u.pm * 256 + wr * 64 + fr; const int col0 = u.pn * 256 + wc * 32 + 8 * fq;
#pragma unroll
        for (int ai = 0; ai < 2; ++ai) {
            f32x4 pre[4][2][2];
#pragma unroll
            for (int m = 0; m < 4; ++m) { const size_t off = (size_t)(row0 + ai * 128 + m * 16) * 1024 + col0;
#pragma unroll
                for (int bj = 0; bj < 2; ++bj) { pre[m][bj][0] = *(const f32x4*)(base + off + bj * 128); pre[m][bj][1] = *(const f32x4*)(base + off + bj * 128 + 4); } }
#pragma unroll
            for (int m = 0; m < 4; ++m) { const int row = row0 + ai * 128 + m * 16; const size_t off = (size_t)row * 1024 + col0; float ssum = 0.f;
#pragma unroll
                for (int bj = 0; bj < 2; ++bj) {
                    const f32x4 o0 = pre[m][bj][0] + acc[ai][bj][m][0], o1 = pre[m][bj][1] + acc[ai][bj][m][1];
                    *(f32x4*)(out + off + bj * 128) = o0; *(f32x4*)(out + off + bj * 128 + 4) = o1;
                    if (stat) { u32x4 w; w.x = cvt_pk_bf16(o0[0], o0[1]); w.y = cvt_pk_bf16(o0[2], o0[3]); w.z = cvt_pk_bf16(o1[0], o1[1]); w.w = cvt_pk_bf16(o1[2], o1[3]);
                        *(u32x4*)(XB + off + bj * 128) = w;
                        ssum += ((o0[0] * o0[0] + o0[1] * o0[1]) + (o0[2] * o0[2] + o0[3] * o0[3])) + ((o1[0] * o1[0] + o1[1] * o1[1]) + (o1[2] * o1[2] + o1[3] * o1[3])); } }
                if (stat) { ssum += __shfl_xor(ssum, 16); ssum += __shfl_xor(ssum, 32); if (fq == 0) atomicAdd(SS + row, ssum); } }
            asm volatile("" ::: "memory");
        }
    }
};

struct EpiSwiGLU {
    static constexpr bool PERM = true, AFTER_DRAIN = false, HOOK = false, EPI_TWICE = false;
    bf16_t* ACT; const float* SS;
    __device__ __forceinline__ void operator()(const f32x4 (&acc)[2][2][4][2], const Unit& u, int wr, int wc, int fr, int fq) const {
        const int row0 = u.pm * 256 + wr * 64 + fr; const int f0 = u.pn * 128 + wc * 32 + 8 * fq;
#pragma unroll
        for (int ai = 0; ai < 2; ++ai)
#pragma unroll
            for (int m = 0; m < 4; ++m) { f32x4 r[2]; const float rs = __builtin_amdgcn_rsqf(SS[row0 + ai * 128 + m * 16] * (1.f / 1024.f) + EPSN);
#pragma unroll
                for (int n = 0; n < 2; ++n) { const f32x4 g = acc[ai][0][m][n] * rs, up = acc[ai][1][m][n] * rs;
#pragma unroll
                    for (int i = 0; i < 4; ++i) r[n][i] = g[i] * sigmoidf_(g[i]) * up[i]; }
                u32x4 w; w.x = cvt_pk_bf16(r[0][0], r[0][1]); w.y = cvt_pk_bf16(r[0][2], r[0][3]); w.z = cvt_pk_bf16(r[1][0], r[1][1]); w.w = cvt_pk_bf16(r[1][2], r[1][3]);
                *(u32x4*)(ACT + (size_t)(row0 + ai * 128 + m * 16) * DFF + f0) = w; }
    }
};

__device__ __forceinline__ void cvt_item(const float* src, int ld, int col0, int nvalid, int K, bf16_t* WT, int dst_row0, int kb, LAS float* scr, int lane, const float* rs = nullptr) {
    const int k0 = 64 * kb, c = lane & 31;
    float vv[32];
#pragma unroll
    for (int i = 0; i < 32; ++i) { const int kk = 2 * i + (lane >> 5); vv[i] = (c < nvalid) ? src[(size_t)(k0 + kk) * ld + col0 + c] : 0.f; }
    if (rs) {
#pragma unroll
        for (int i = 0; i < 32; ++i) vv[i] *= rs[k0 + 2 * i + (lane >> 5)];
    }
#pragma unroll
    for (int i = 0; i < 32; ++i) scr[(2 * i + (lane >> 5)) * 33 + c] = vv[i];
    LDS_WAIT();
    const int c8 = lane & 7;
#pragma unroll
    for (int j = 0; j < 4; ++j) { const int n = (lane >> 3) + 8 * j; const LAS float* s = scr + (8 * c8) * 33 + n;
        u32x4 o; o.x = cvt_pk_bf16(s[0 * 33], s[1 * 33]); o.y = cvt_pk_bf16(s[2 * 33], s[3 * 33]); o.z = cvt_pk_bf16(s[4 * 33], s[5 * 33]); o.w = cvt_pk_bf16(s[6 * 33], s[7 * 33]);
        *(u32x4*)(WT + (size_t)(dst_row0 + n) * K + k0 + 8 * c8) = o; }
    LDS_WAIT();
}
__device__ __forceinline__ float wave_sum(float v) {
#pragma unroll
    for (int o = 1; o < 64; o <<= 1) v += __shfl_xor(v, o);
    return v;
}
__device__ __forceinline__ float wave_max(float v) {
#pragma unroll
    for (int o = 1; o < 64; o <<= 1) v = fmaxf(v, __shfl_xor(v, o));
    return v;
}
__device__ __forceinline__ void rmsnorm_rows(const float* xs, const float* gamma, bf16_t* XN, int gw, int ngw, int lane) {
    f32x4 gm[4];
#pragma unroll
    for (int j = 0; j < 4; ++j) gm[j] = *(const f32x4*)(gamma + 4 * lane + 256 * j);
    for (int m = gw; m < M_; m += ngw) {
        const f32x4* xr = (const f32x4*)(xs + (size_t)m * DM) + lane; f32x4 v[4]; float s = 0.f;
#pragma unroll
        for (int j = 0; j < 4; ++j) { v[j] = xr[64 * j]; s += (v[j].x * v[j].x + v[j].y * v[j].y) + (v[j].z * v[j].z + v[j].w * v[j].w); }
        const float r = __builtin_amdgcn_rsqf(wave_sum(s) * (1.f / DM) + EPSN);
        u32x2* o8 = (u32x2*)(XN + (size_t)m * DM) + lane;
#pragma unroll
        for (int j = 0; j < 4; ++j) { const f32x4 y = v[j] * r * gm[j]; o8[64 * j] = (u32x2){cvt_pk_bf16(y.x, y.y), cvt_pk_bf16(y.z, y.w)}; }
    }
}

__device__ __forceinline__ void x_to_bf16_ss(const float* xs, bf16_t* XN, float* SS, int gw, int ngw, int lane) {
    for (int m0 = gw * 4; m0 < M_; m0 += ngw * 4) {
        f32x4 v[4][4];
#pragma unroll
        for (int r = 0; r < 4; ++r) { const f32x4* xr = (const f32x4*)(xs + (size_t)(m0 + r) * DM) + lane;
#pragma unroll
            for (int j = 0; j < 4; ++j) v[r][j] = xr[64 * j]; }
#pragma unroll
        for (int r = 0; r < 4; ++r) { float s = 0.f;
#pragma unroll
            for (int j = 0; j < 4; ++j) s += (v[r][j].x * v[r][j].x + v[r][j].y * v[r][j].y) + (v[r][j].z * v[r][j].z + v[r][j].w * v[r][j].w);
            s = wave_sum(s);
            u32x2* o8 = (u32x2*)(XN + (size_t)(m0 + r) * DM) + lane;
#pragma unroll
            for (int j = 0; j < 4; ++j) o8[64 * j] = (u32x2){cvt_pk_bf16(v[r][j].x, v[r][j].y), cvt_pk_bf16(v[r][j].z, v[r][j].w)};
            if (lane == 0) SS[m0 + r] = s; }
    }
}
struct Ptrs {
    const float *mix_g, *ffn_g, *w_in, *qn, *kn, *pool_w, *pool_scale, *gm_norm, *gm_ws, *gm_b, *w_branch, *w_out, *w_gate, *w_up, *w_down;
};

__device__ __forceinline__ void convert_weights(const Ptrs& P, unsigned char* ws, LAS float* scr, int gw, int ngw, int lane, int gtid, int ngt) {
    bf16_t* WinT = (bf16_t*)(ws + WS_WIN); bf16_t* WbT = (bf16_t*)(ws + WS_WB); bf16_t* WoutT = (bf16_t*)(ws + WS_WOUT); bf16_t* WguT = (bf16_t*)(ws + WS_WGU);
    bf16_t* WdT = (bf16_t*)(ws + WS_WD); bf16_t* WpT = (bf16_t*)(ws + WS_WP); bf16_t* Wtril = (bf16_t*)(ws + WS_WS);
    constexpr int I_A = 216 * 16, I_B = 512, I_C = 512, I_D = 176 * 16, I_E = 32 * 44, I_F = 8, NIT = I_A + I_B + I_C + I_D + I_E + I_F;
    for (int it = gw; it < NIT; it += ngw) {
        int r = it;
        if (r < I_A) { const int rb = r >> 4, kb = r & 15, tile = rb >> 3, sub = rb & 7; int col0, nv = 32;
            if (tile <= 1) col0 = tile * 256 + (sub & 3) * 64 + (sub >> 2) * 32;
            else if (tile == 2) col0 = 512 + sub * 32;
            else if (tile == 3) col0 = 768 + sub * 32;
            else if (tile <= 9) col0 = 1064 + (tile - 4) * 256 + sub * 32;
            else if (tile == 10) { col0 = sub == 0 ? 1024 : 1056; nv = sub == 0 ? 32 : (sub == 1 ? 8 : 0); }
            else col0 = 2600 + (tile - 11) * 256 + sub * 32;
            cvt_item(P.w_in, DIN, col0, nv, 1024, WinT, rb * 32, kb, scr, lane, P.mix_g); continue; }
        r -= I_A;
        if (r < I_B) { const int rb = r >> 4, kb = r & 15; cvt_item(P.w_branch, 1024, rb * 32, 32, 1024, WbT, rb * 32, kb, scr, lane); continue; }
        r -= I_B;
        if (r < I_C) { const int rb = r >> 4, kb = r & 15; cvt_item(P.w_out, 1024, rb * 32, 32, 1024, WoutT, rb * 32, kb, scr, lane); continue; }
        r -= I_C;
        if (r < I_D) { const int rb = r >> 4, kb = r & 15, tile = rb >> 3, sub = rb & 7;
            cvt_item((sub >> 2) ? P.w_up : P.w_gate, DFF, tile * 128 + (sub & 3) * 32, 32, 1024, WguT, rb * 32, kb, scr, lane, P.ffn_g); continue; }
        r -= I_D;
        if (r < I_E) { const int rb = r / 44, kb = r % 44; cvt_item(P.w_down, 1024, rb * 32, 32, DFF, WdT, rb * 32, kb, scr, lane); continue; }
        r -= I_E;
        { const int gp = r >> 1, rb = r & 1; cvt_item(P.pool_w + gp * 4096, 64, rb * 32, 32, 64, WpT + gp * 4096, rb * 32, 0, scr, lane); }
    }
    for (int e = gtid; e < 4 * 128 * 128; e += ngt) { const int s = e & 127, t = (e >> 7) & 127; Wtril[e] = (s <= t) ? f2bf(P.gm_ws[e]) : (unsigned short)0; }
}

__device__ __forceinline__ unsigned mono_key(float s) { const unsigned b = __float_as_uint(s); return b ^ ((unsigned)((int)b >> 31) | 0x80000000u); }

#define wr_lane(dst, sval, ln) asm volatile("s_nop 4\n\tv_writelane_b32 %0, %1, %2\n\ts_nop 1" : "+v"(dst) : "s"(sval), "n"(ln))
template <int NBLK> __device__ __forceinline__ unsigned a1_bisect(const unsigned (&v)[64], int& cpre) {
    unsigned prefix = 0u; cpre = 0;
#pragma unroll 1
    for (int bit = 31; bit >= 0; --bit) {
        const unsigned cand = prefix | (1u << bit);
        int cnt = 0;
#pragma unroll
        for (int blk = 0; blk < NBLK; ++blk) {
            unsigned long long bl[8];
#pragma unroll
            for (int k = 0; k < 8; ++k) bl[k] = __ballot(v[blk * 8 + k] >= cand);
            __builtin_amdgcn_sched_barrier(0);
#pragma unroll
            for (int k = 0; k < 8; ++k) cnt += __builtin_popcountll(bl[k]);
            __builtin_amdgcn_sched_barrier(0);
        }
        if (cnt >= 256) { prefix = cand; cpre = cnt; if (cnt == 256) break; }
    }
    return prefix;
}
constexpr int A1_ROWF = 4100;
__device__ __forceinline__ void phase_a1(unsigned char* lds, const bf16_t* IQ, const bf16_t* IK, const float* IW, unsigned short* MASK, int tid, int bid, int G) {
    const int lane = tid & 63, w = __builtin_amdgcn_readfirstlane(tid >> 6), q = lane & 15, g = lane >> 4;
    unsigned* keys = (unsigned*)lds;
#ifndef REP_A1X
#define REP_A1X 1
#endif
    for (int L2 = bid; L2 < 1024 * REP_A1X; L2 += G) {
        const int L = L2 & 1023;
        const int b = L >> 8, c = L & 255, qg = (b & 1) ? 255 - c : c;
        const int row0 = b * SEQ + qg * 16;
        const int nreg = (qg >> 2) + 1;
        if (qg <= 15) {
#pragma unroll
            for (int half = 0; half < 2; ++half) { const int qq = half * 8 + w; const int t = qg * 16 + qq; unsigned mlo = 0u, mhi = 0u;
#pragma unroll
                for (int r = 0; r < 4; ++r) { const unsigned long long bal = __ballot(64 * r + lane <= t);
                    wr_lane(mlo, (unsigned)bal, r); wr_lane(mhi, (unsigned)(bal >> 32), r); }
                if (lane < nreg) *(u32x2*)(MASK + (size_t)(row0 + qq) * 256 + 4 * lane) = (u32x2){mlo, mhi}; }
            continue;
        }
        unsigned u[128];
        {
            bf16x8 iqf[8]; float wv[8];
#pragma unroll
            for (int h = 0; h < 8; ++h) iqf[h] = *(const bf16x8*)(IQ + (size_t)(row0 + q) * 256 + h * 32 + 8 * g);
            { const f32x4 a = *(const f32x4*)(IW + (size_t)(row0 + q) * 8), bq = *(const f32x4*)(IW + (size_t)(row0 + q) * 8 + 4);
              wv[0] = a[0]; wv[1] = a[1]; wv[2] = a[2]; wv[3] = a[3]; wv[4] = bq[0]; wv[5] = bq[1]; wv[6] = bq[2]; wv[7] = bq[3]; }
            bf16x8 kfn[4];
#pragma unroll
            for (int ii = 0; ii < 4; ++ii) kfn[ii] = *(const bf16x8*)(IK + (size_t)(b * SEQ + (8 * ii + w) * 16 + q) * 32 + 8 * g);
#pragma unroll
            for (int blk = 0; blk < 8; ++blk) {
                if (32 * blk + w <= qg) {
                    bf16x8 kf[4];
#pragma unroll
                    for (int ii = 0; ii < 4; ++ii) kf[ii] = kfn[ii];
                    if (blk < 7) {
#pragma unroll
                        for (int ii = 0; ii < 4; ++ii) { const int kt = 8 * (4 * (blk + 1) + ii) + w; kfn[ii] = *(const bf16x8*)(IK + (size_t)(b * SEQ + kt * 16 + q) * 32 + 8 * g); }
                    }
#pragma unroll
                    for (int ii = 0; ii < 4; ++ii) { const int i = 4 * blk + ii; const int kt = 8 * i + w;
                        f32x4 s = {0.f, 0.f, 0.f, 0.f};
#pragma unroll
                        for (int h = 0; h < 8; ++h) { const f32x4 a = mfma16(kf[ii], iqf[h], (f32x4){0.f, 0.f, 0.f, 0.f});
#pragma unroll
                            for (int j = 0; j < 4; ++j) s[j] = __builtin_fmaf(wv[h], relu1(a[j]), s[j]); }
#pragma unroll
                        for (int j = 0; j < 4; ++j) { unsigned uu = mono_key(s[j]); if (kt > qg || (kt == qg && (4 * g + j) > q)) uu = 0u; u[4 * i + j] = uu; }
                    }
                } else {
#pragma unroll
                    for (int r = 0; r < 16; ++r) u[16 * blk + r] = 0u;
                }
            }
        }
#pragma unroll 1
        for (int half = 0; half < 2; ++half) {
            if ((q >> 3) == half) {
                unsigned* krow = keys + (q & 7) * A1_ROWF + 4 * g;
#pragma unroll
                for (int i = 0; i < 32; ++i) { const int kt = 8 * i + w; *(u32x4*)(krow + kt * 16) = (u32x4){u[4 * i], u[4 * i + 1], u[4 * i + 2], u[4 * i + 3]}; }
            }
            __syncthreads();
            {
                const int qq = half * 8 + w; const unsigned* krow = keys + w * A1_ROWF + lane;
                unsigned v[64];
#pragma unroll
                for (int blk = 0; blk < 8; ++blk) {
                    if (nreg > blk * 8) {
#pragma unroll
                        for (int r = blk * 8; r < blk * 8 + 8; ++r) v[r] = krow[64 * r];
                    } else {
#pragma unroll
                        for (int r = blk * 8; r < blk * 8 + 8; ++r) v[r] = 0u;
                    }
                }
#ifndef REP_BIS
#define REP_BIS 1
#endif
                __syncthreads();
                unsigned prefix; int cpre = 0;
#pragma unroll 1
                for (int rb_ = 0; rb_ < REP_BIS; ++rb_)
                switch ((nreg + 7) >> 3) {
                    case 1: prefix = a1_bisect<1>(v, cpre); break; case 2: prefix = a1_bisect<2>(v, cpre); break; case 3: prefix = a1_bisect<3>(v, cpre); break; case 4: prefix = a1_bisect<4>(v, cpre); break;
                    case 5: prefix = a1_bisect<5>(v, cpre); break; case 6: prefix = a1_bisect<6>(v, cpre); break; case 7: prefix = a1_bisect<7>(v, cpre); break; default: prefix = a1_bisect<8>(v, cpre); break;
                }
                const unsigned thr = prefix > 1u ? prefix : 1u;
                unsigned mlo = 0u, mhi = 0u;
                if (cpre == 256) {
#pragma unroll
                    for (int r = 0; r < 64; ++r) { const unsigned long long bal = __ballot(v[r] >= thr); wr_lane(mlo, (unsigned)bal, r); wr_lane(mhi, (unsigned)(bal >> 32), r); }
                } else {
                    int rem = 256;
#pragma unroll
                    for (int r = 0; r < 64; ++r) rem -= __builtin_popcountll(__ballot(v[r] > thr));
#pragma unroll
                    for (int r = 0; r < 64; ++r) { unsigned long long bal = __ballot(v[r] > thr); unsigned long long eq = __ballot(v[r] == thr);
                        const int ne = __builtin_popcountll(eq);
                        if (ne <= rem) { bal |= eq; rem -= ne; }
                        else { while (rem > 0) { const unsigned long long low = eq & (0ull - eq); bal |= low; eq ^= low; --rem; } }
                        wr_lane(mlo, (unsigned)bal, r); wr_lane(mhi, (unsigned)(bal >> 32), r); }
                }
                if (lane < nreg) *(u32x2*)(MASK + (size_t)(row0 + qq) * 256 + 4 * lane) = (u32x2){mlo, mhi};
            }
        }
    }
}

__device__ __forceinline__ void phase_a2(unsigned char* lds, const bf16_t* QA, bf16_t* OA, const bf16_t* KA, const bf16_t* VTA, const unsigned short* MASK,
                                         const float* qn, const float* kn, int tid, int bid, int G) {
    const int lane = tid & 63, w = __builtin_amdgcn_readfirstlane(tid >> 6), q = lane & 15, g = lane >> 4;
    bf16_t* Kt = (bf16_t*)lds;
    bf16_t* Vt = (bf16_t*)(lds + 2 * 64 * 72 * 2);
    const float msh = LOG2E * 8.f * wave_max(fabsf(qn[lane])) * wave_max(fabsf(kn[lane])) * 1.02f + 0.25f;
    const int srow = tid >> 3, sch = tid & 7;
    for (int L = bid; L < 512; L += G) {
        const int jj = L >> 8, c0 = L & 255, c = (c0 & 7) * 32 + (c0 >> 3), bh = c >> 4, qb = jj ? 31 - (c & 15) : (c & 15);
        const int b = bh >> 2, h = bh & 3;
        const int qgw = qb * 8 + w;
        const int row0 = b * SEQ + qb * 128 + 16 * w;
        bf16x8 qf[2];
#pragma unroll
        for (int hf = 0; hf < 2; ++hf) qf[hf] = *(const bf16x8*)(QA + (size_t)(row0 + q) * 256 + h * 64 + hf * 32 + 8 * g);
        const unsigned short* mrow = MASK + (size_t)(row0 + q) * 256;
        const int nsteps = 2 * qb + 2;
        const bf16_t* ksrc = KA + (size_t)(b * SEQ + srow) * 256 + h * 64 + sch * 8;
        const bf16_t* vsrc = VTA + (size_t)(b * 256 + h * 64 + srow) * SEQ + sch * 8;
        u32x4 kA = *(const u32x4*)ksrc, vA = *(const u32x4*)vsrc, kB = kA, vB = vA;
        u32x2 mE = *(const u32x2*)mrow, mO = mE;
        *(u32x4*)(Kt + srow * 72 + sch * 8) = kA; *(u32x4*)(Vt + srow * 72 + sch * 8) = vA;
        if (nsteps > 1) { kB = *(const u32x4*)(ksrc + (size_t)64 * 256); vB = *(const u32x4*)(vsrc + 64); mO = *(const u32x2*)(mrow + 4); }
        f32x4 o[4]; float lsum = 0.f; const f32x4 negm = {-msh, -msh, -msh, -msh};
#pragma unroll
        for (int d = 0; d < 4; ++d) o[d] = (f32x4){0.f, 0.f, 0.f, 0.f};
        __syncthreads();
#define A2_COMPUTE(st, buf, mcur) do { \
            const bf16_t* kb_ = Kt + (buf) * 64 * 72; const bf16_t* vb_ = Vt + (buf) * 64 * 72; \
            _Pragma("unroll") for (int p = 0; p < 2; ++p) { \
                const int kt0 = (st) * 4 + 2 * p; \
                if (kt0 <= qgw) { \
                    const unsigned mw = p ? (mcur).y : (mcur).x; \
                    const unsigned nib0 = (mw >> (4 * g)) & 15u, nib1 = (kt0 + 1 <= qgw) ? ((mw >> (16 + 4 * g)) & 15u) : 0u; \
                    const bf16_t* kr0 = kb_ + (p * 32 + q) * 72 + 8 * g; const bf16_t* kr1 = kr0 + 16 * 72; \
                    f32x4 a0 = mfma16(*(const bf16x8*)kr0, qf[0], negm); a0 = mfma16(*(const bf16x8*)(kr0 + 32), qf[1], a0); \
                    f32x4 a1 = mfma16(*(const bf16x8*)kr1, qf[0], negm); a1 = mfma16(*(const bf16x8*)(kr1 + 32), qf[1], a1); \
                    float p0[4], p1[4]; \
                    _Pragma("unroll") for (int j = 0; j < 4; ++j) { p0[j] = __uint_as_float(__float_as_uint(__builtin_amdgcn_exp2f(a0[j])) & (0u - ((nib0 >> j) & 1u))); p1[j] = __uint_as_float(__float_as_uint(__builtin_amdgcn_exp2f(a1[j])) & (0u - ((nib1 >> j) & 1u))); } \
                    lsum += ((p0[0] + p0[1]) + (p0[2] + p0[3])) + ((p1[0] + p1[1]) + (p1[2] + p1[3])); \
                    const bf16x8 pf = mk8(cvt_pk_bf16(p0[0], p0[1]), cvt_pk_bf16(p0[2], p0[3]), cvt_pk_bf16(p1[0], p1[1]), cvt_pk_bf16(p1[2], p1[3])); \
                    _Pragma("unroll") for (int d = 0; d < 4; ++d) { const bf16_t* vr = vb_ + (d * 16 + q) * 72 + p * 32 + 4 * g; \
                        const u32x2 lo = *(const u32x2*)vr, hi = *(const u32x2*)(vr + 16); \
                        o[d] = mfma16(mk8(lo.x, lo.y, hi.x, hi.y), pf, o[d]); } \
                } } } while (0)
        for (int st = 0; st < nsteps; st += 2) {
            {
                const bool more2 = st + 2 < nsteps; u32x2 mEn = mE;
                if (more2) { kA = *(const u32x4*)(ksrc + (size_t)(st + 2) * 64 * 256); vA = *(const u32x4*)(vsrc + (st + 2) * 64); mEn = *(const u32x2*)(mrow + (st + 2) * 4); }
                A2_COMPUTE(st, 0, mE);
                *(u32x4*)(Kt + 64 * 72 + srow * 72 + sch * 8) = kB; *(u32x4*)(Vt + 64 * 72 + srow * 72 + sch * 8) = vB;
                __syncthreads();
                mE = mEn;
            }
            {
                const int s1 = st + 1; const bool more2 = s1 + 2 < nsteps; u32x2 mOn = mO;
                if (more2) { kB = *(const u32x4*)(ksrc + (size_t)(s1 + 2) * 64 * 256); vB = *(const u32x4*)(vsrc + (s1 + 2) * 64); mOn = *(const u32x2*)(mrow + (s1 + 2) * 4); }
                A2_COMPUTE(s1, 1, mO);
                if (s1 + 1 < nsteps) { *(u32x4*)(Kt + srow * 72 + sch * 8) = kA; *(u32x4*)(Vt + srow * 72 + sch * 8) = vA; }
                __syncthreads();
                mO = mOn;
            }
        }
#undef A2_COMPUTE
        lsum += __shfl_xor(lsum, 16); lsum += __shfl_xor(lsum, 32);
        const float inv = 1.f / lsum;
#pragma unroll
        for (int d = 0; d < 4; ++d) { const f32x4 v = o[d] * inv;
            *(u32x2*)(OA + (size_t)(row0 + q) * 1024 + h * 64 + d * 16 + 4 * g) = (u32x2){cvt_pk_bf16(v[0], v[1]), cvt_pk_bf16(v[2], v[3])}; }
    }
}

__device__ __forceinline__ void phase_b(const bf16_t* PIN, const bf16_t* WpT, const float* pscale, bf16_t* OB, int gw, int ngw, int lane) {
    const int q = lane & 15, g4 = lane >> 4;
    for (int L = gw; L < 4096; L += ngw) {
        const int gp = L >> 10, tg = L & 1023; const int row = tg * 16 + q; const int t = row & (SEQ - 1);
        const int win = 2 << gp; const int cnt = (t + 1 < win) ? t + 1 : win; const float inv = 1.f / (float)cnt;
        f32x4 acc[4];
#pragma unroll
        for (int d = 0; d < 4; ++d) acc[d] = (f32x4){0.f, 0.f, 0.f, 0.f};
#pragma unroll
        for (int ch = 0; ch < 2; ++ch) {
            const bf16_t* p = PIN + (size_t)row * 256 + gp * 64 + ch * 32 + 8 * g4;
            u32x4 wv[16];
#pragma unroll
            for (int i = 0; i < 16; ++i) { wv[i] = (u32x4){0u, 0u, 0u, 0u}; if (i < win && i <= t) wv[i] = *(const u32x4*)(p - (size_t)i * 256); }
            float own[8], sum[8];
            own[0] = bflo(wv[0].x); own[1] = bfhi(wv[0].x); own[2] = bflo(wv[0].y); own[3] = bfhi(wv[0].y); own[4] = bflo(wv[0].z); own[5] = bfhi(wv[0].z); own[6] = bflo(wv[0].w); own[7] = bfhi(wv[0].w);
#pragma unroll
            for (int k = 0; k < 8; ++k) sum[k] = own[k];
#pragma unroll
            for (int i = 1; i < 16; ++i) { const u32x4 v = wv[i];
                sum[0] += bflo(v.x); sum[1] += bfhi(v.x); sum[2] += bflo(v.y); sum[3] += bfhi(v.y); sum[4] += bflo(v.z); sum[5] += bfhi(v.z); sum[6] += bflo(v.w); sum[7] += bfhi(v.w); }
            float pl[8];
#pragma unroll
            for (int k = 0; k < 8; ++k) pl[k] = sum[k] * inv - own[k];
            const bf16x8 bfr = mk8(cvt_pk_bf16(pl[0], pl[1]), cvt_pk_bf16(pl[2], pl[3]), cvt_pk_bf16(pl[4], pl[5]), cvt_pk_bf16(pl[6], pl[7]));
#pragma unroll
            for (int d = 0; d < 4; ++d) { const bf16x8 afr = *(const bf16x8*)(WpT + gp * 4096 + (d * 16 + q) * 64 + ch * 32 + 8 * g4); acc[d] = mfma16(afr, bfr, acc[d]); }
        }
#pragma unroll
        for (int d = 0; d < 4; ++d) { const int d0 = d * 16 + 4 * g4; const f32x4 sc = *(const f32x4*)(pscale + gp * 64 + d0); const f32x4 v = acc[d] * sc;
            *(u32x2*)(OB + (size_t)row * 1024 + gp * 64 + d0) = (u32x2){cvt_pk_bf16(v[0], v[1]), cvt_pk_bf16(v[2], v[3])}; }
    }
}

__device__ __forceinline__ void phase_c(unsigned char* lds, const bf16_t* GV, const bf16_t* GU, bf16_t* OC, const float* gamma, const bf16_t* Wtril, const float* gbias, int tid, int bid, int G) {
    bf16_t* LT = (bf16_t*)lds;
    const int lane = tid & 63, w = __builtin_amdgcn_readfirstlane(tid >> 6), q = lane & 15, g4 = lane >> 4;
    for (int L = bid; L < 512; L += G) {
        const int gp = L & 3, chk = L >> 2; const int R0 = chk * 128;
        {
            const int row = tid >> 2, part = tid & 3;
            const bf16_t* src = GV + (size_t)(R0 + row) * 256 + part * 64;
            float x[64];
#pragma unroll
            for (int k8 = 0; k8 < 8; ++k8) { const u32x4 v = *(const u32x4*)(src + 8 * k8);
                x[8 * k8 + 0] = bflo(v.x); x[8 * k8 + 1] = bfhi(v.x); x[8 * k8 + 2] = bflo(v.y); x[8 * k8 + 3] = bfhi(v.y); x[8 * k8 + 4] = bflo(v.z); x[8 * k8 + 5] = bfhi(v.z); x[8 * k8 + 6] = bflo(v.w); x[8 * k8 + 7] = bfhi(v.w); }
            float s = 0.f;
#pragma unroll
            for (int k = 0; k < 64; ++k) s += x[k];
            s += __shfl_xor(s, 1); s += __shfl_xor(s, 2);
            const float mean = s * (1.f / 256.f); float ss = 0.f;
#pragma unroll
            for (int k = 0; k < 64; ++k) { const float dd = x[k] - mean; ss += dd * dd; }
            ss += __shfl_xor(ss, 1); ss += __shfl_xor(ss, 2);
            const float rstd = __builtin_amdgcn_rsqf(ss * (1.f / 256.f) + EPSN);
            if (part == gp) {
#pragma unroll
                for (int k4 = 0; k4 < 16; ++k4) { const f32x4 gm = *(const f32x4*)(gamma + gp * 64 + 4 * k4);
#pragma unroll
                    for (int i = 0; i < 4; ++i) LT[(4 * k4 + i) * 136 + row] = f2bf((x[4 * k4 + i] - mean) * rstd * gm[i]); }
            }
        }
        __syncthreads();
        {
            f32x4 acc[4];
#pragma unroll
            for (int d = 0; d < 4; ++d) acc[d] = (f32x4){0.f, 0.f, 0.f, 0.f};
            const int t = 16 * w + q; const int nsb = ((16 * w + 15) >> 5) + 1;
            for (int sb = 0; sb < nsb; ++sb) {
                const bf16x8 bfr = *(const bf16x8*)(Wtril + ((size_t)gp * 128 + t) * 128 + sb * 32 + 8 * g4);
#pragma unroll
                for (int d = 0; d < 4; ++d) { const bf16x8 afr = *(const bf16x8*)(LT + (d * 16 + q) * 136 + sb * 32 + 8 * g4); acc[d] = mfma16(afr, bfr, acc[d]); }
            }
            const float bias = gbias[gp * 128 + t];
#pragma unroll
            for (int d = 0; d < 4; ++d) { const size_t eo = (size_t)(R0 + t) * 256 + gp * 64 + d * 16 + 4 * g4; const u32x2 uu = *(const u32x2*)(GU + eo);
                const float r0 = bflo(uu.x) * (acc[d][0] + bias), r1 = bfhi(uu.x) * (acc[d][1] + bias), r2 = bflo(uu.y) * (acc[d][2] + bias), r3 = bfhi(uu.y) * (acc[d][3] + bias);
                *(u32x2*)(OC + (size_t)(R0 + t) * 1024 + gp * 64 + d * 16 + 4 * g4) = (u32x2){cvt_pk_bf16(r0, r1), cvt_pk_bf16(r2, r3)}; }
        }
        __syncthreads();
    }
}

__device__ __forceinline__ void sb_tile(const f32x4 z, int kbase, int tq, int g, float& carry, float (&a)[4]) {
    float lm[4]; bool msk[4];
#pragma unroll
    for (int j = 0; j < 4; ++j) { msk[j] = (kbase + 4 * g + j) >= tq;
        const float e = __builtin_amdgcn_exp2f(-fabsf(z[j]) * LOG2E); const float sp = relu1(z[j]) + __builtin_amdgcn_logf(1.f + e) * LN2;
        lm[j] = msk[j] ? 0.f : -sp; }
    const float suf2 = lm[3], suf1 = lm[3] + lm[2], suf0 = suf1 + lm[1]; const float T = suf0 + lm[0];
    const float x16 = __shfl_xor(T, 16); const float Pp = T + x16; const float Qq = __shfl_xor(Pp, 32);
    const float Sg = ((g & 1) ? 0.f : x16) + ((g & 2) ? 0.f : Qq);
    const float base = carry + Sg;
    const float tl[4] = {base + suf0, base + suf1, base + suf2, base};
#pragma unroll
    for (int j = 0; j < 4; ++j) a[j] = msk[j] ? 0.f : __builtin_amdgcn_exp2f((z[j] + lm[j] + tl[j]) * LOG2E);
    carry += Pp + Qq;
}
__device__ __forceinline__ void phase_d(const bf16_t* SQ, bf16_t* OD, const bf16_t* SK, const bf16_t* VTS, int gw, int ngw, int lane) {
    const int q = lane & 15, g = lane >> 4;
    for (int L0 = gw; L0 < 2048; L0 += ngw) {
        const int blk_ = L0 >> 3, L = ((((blk_ & 7) * 32 + ((blk_ >> 3) & 31)) << 3) | (L0 & 7)) & 2047;
        const int qg = L & 255, bh = L >> 8, b0 = bh >> 2, h = bh & 3;
        const int tq = qg * 16 + q;
        bf16x8 qf[2][2]; f32x4 o[2][4]; float carry[2] = {0.f, 0.f};
#pragma unroll
        for (int u = 0; u < 2; ++u) { const int row0 = (b0 + 2 * u) * SEQ + qg * 16;
#pragma unroll
            for (int hf = 0; hf < 2; ++hf) qf[u][hf] = *(const bf16x8*)(SQ + (size_t)(row0 + q) * 256 + h * 64 + hf * 32 + 8 * g);
#pragma unroll
            for (int d = 0; d < 4; ++d) o[u][d] = (f32x4){0.f, 0.f, 0.f, 0.f}; }
        bf16x8 kn[2][4]; u32x2 vn[2][8];
#define D_LOAD(ppx) do { const int k0_ = (ppx) * 32; _Pragma("unroll") for (int u = 0; u < 2; ++u) { const int b = b0 + 2 * u; \
                const bf16_t* kb = SK + (size_t)(b * SEQ + k0_ + q) * 256 + h * 64 + 8 * g; \
                _Pragma("unroll") for (int i = 0; i < 4; ++i) kn[u][i] = *(const bf16x8*)(kb + (size_t)(i >> 1) * 16 * 256 + (i & 1) * 32); \
                const bf16_t* vb = VTS + (size_t)(b * 256 + h * 64 + q) * SEQ + k0_ + 4 * g; \
                _Pragma("unroll") for (int d = 0; d < 4; ++d) { vn[u][2 * d] = *(const u32x2*)(vb + (size_t)d * 16 * SEQ); vn[u][2 * d + 1] = *(const u32x2*)(vb + (size_t)d * 16 * SEQ + 16); } } } while (0)
        D_LOAD(qg >> 1);
        for (int pp = qg >> 1; pp >= 0; --pp) {
            const int kt0 = 2 * pp, kt1 = kt0 + 1;
            bf16x8 kc[2][4]; u32x2 vc[2][8];
#pragma unroll
            for (int u = 0; u < 2; ++u) {
#pragma unroll
                for (int i = 0; i < 4; ++i) kc[u][i] = kn[u][i];
#pragma unroll
                for (int i = 0; i < 8; ++i) vc[u][i] = vn[u][i]; }
            D_LOAD(pp > 0 ? pp - 1 : 0);
            float a0[2][4], a1[2][4];
#pragma unroll
            for (int u = 0; u < 2; ++u) {
                if (kt1 <= qg) {
                    f32x4 z = mfma16(kc[u][2], qf[u][0], (f32x4){0.f, 0.f, 0.f, 0.f}); z = mfma16(kc[u][3], qf[u][1], z);
                    sb_tile(z, kt1 * 16, tq, g, carry[u], a1[u]);
                } else {
#pragma unroll
                    for (int j = 0; j < 4; ++j) a1[u][j] = 0.f;
                }
            }
#pragma unroll
            for (int u = 0; u < 2; ++u) {
                f32x4 z = mfma16(kc[u][0], qf[u][0], (f32x4){0.f, 0.f, 0.f, 0.f}); z = mfma16(kc[u][1], qf[u][1], z);
                sb_tile(z, kt0 * 16, tq, g, carry[u], a0[u]);
            }
#pragma unroll
            for (int u = 0; u < 2; ++u) {
                const bf16x8 pf = mk8(cvt_pk_bf16(a0[u][0], a0[u][1]), cvt_pk_bf16(a0[u][2], a0[u][3]), cvt_pk_bf16(a1[u][0], a1[u][1]), cvt_pk_bf16(a1[u][2], a1[u][3]));
#pragma unroll
                for (int d = 0; d < 4; ++d) o[u][d] = mfma16(mk8(vc[u][2 * d].x, vc[u][2 * d].y, vc[u][2 * d + 1].x, vc[u][2 * d + 1].y), pf, o[u][d]);
            }
            if (__all(carry[0] < -104.f && carry[1] < -104.f)) break;
        }
#undef D_LOAD
#pragma unroll
        for (int u = 0; u < 2; ++u) { const int row0 = (b0 + 2 * u) * SEQ + qg * 16;
#pragma unroll
            for (int d = 0; d < 4; ++d) *(u32x2*)(OD + (size_t)(row0 + q) * 1024 + h * 64 + d * 16 + 4 * g) = (u32x2){cvt_pk_bf16(o[u][d][0], o[u][d][1]), cvt_pk_bf16(o[u][d][2], o[u][d][3])}; }
    }
}

#define XB_TMO      128
#define XB_XCNT(j)  (256  + 64 * (j))
#define XB_XSUB(j)  (1280 + 64 * (j))
#define XB_XGEN(j)  (2304 + 64 * (j))
#define XB_TOP      3328
#define XB_TOPGEN   3392
#define XCD_BAR_WORDS 3456
#define XB_SPIN_CAP (1u << 18)

__device__ __forceinline__ unsigned xb_ld(unsigned* p)              { return __hip_atomic_load(p, __ATOMIC_RELAXED, __HIP_MEMORY_SCOPE_AGENT); }
__device__ __forceinline__ unsigned xb_add(unsigned* p, unsigned v) { return __hip_atomic_fetch_add(p, v, __ATOMIC_RELAXED, __HIP_MEMORY_SCOPE_AGENT); }
__device__ __forceinline__ unsigned xb_xcc_id() { return (unsigned)__builtin_amdgcn_s_getreg((3 << 11) | 20) & 0xFu; }
#define XB_SPIN(cond, bar) do { unsigned _sp = 0; while (cond) { __builtin_amdgcn_s_sleep(1); \
    if ((++_sp & 255u) == 0u) { if (xb_ld(&(bar)[XB_TMO])) break; if (_sp > XB_SPIN_CAP) { atomicAdd(&(bar)[XB_TMO], 1u); break; } } } } while (0)

struct XcdBarrier {
    unsigned* bar; unsigned x;
    volatile LAS unsigned* st;
};

__device__ __forceinline__ XcdBarrier xcd_barrier_post(unsigned* bar, volatile LAS unsigned* st) {
    XcdBarrier b; b.bar = bar; b.x = xb_xcc_id(); b.st = st;
    if (threadIdx.x == 0) (void)xb_add(&bar[XB_XCNT(b.x)], 1u);
    return b;
}
__device__ __forceinline__ void xcd_barrier_complete(unsigned* bar, unsigned x, unsigned& nloc, unsigned& nx) {
    const unsigned G = gridDim.x * gridDim.y * gridDim.z;
    unsigned sum, cnt, mine, sp = 0u;
    for (;;) {
        sum = 0u; cnt = 0u; mine = 0u;
#pragma unroll
        for (unsigned j = 0; j < 16; ++j) { const unsigned c = xb_ld(&bar[XB_XCNT(j)]); sum += c; cnt += (c > 0u) ? 1u : 0u; mine = (j == x) ? c : mine; }
        if (sum == G) break;
        __builtin_amdgcn_s_sleep(1);
        if ((++sp & 255u) == 0u) { if (xb_ld(&bar[XB_TMO])) break; if (sp > XB_SPIN_CAP) { atomicAdd(&bar[XB_TMO], 1u); break; } }
    }
    nloc = mine > 0u ? mine : 1u; nx = cnt > 0u ? cnt : 1u;
}

__device__ __forceinline__ void xcd_barrier(const XcdBarrier& b) {
    asm volatile("s_waitcnt vmcnt(0)" ::: "memory");
    __syncthreads();
    if (threadIdx.x == 0) {
        unsigned* bar = b.bar;
        __builtin_amdgcn_s_waitcnt(0);
        unsigned nloc = b.st[0], nx = b.st[1];
        if (nloc == 0u) { xcd_barrier_complete(bar, b.x, nloc, nx); b.st[0] = nloc; b.st[1] = nx; }
        const unsigned old = xb_add(&bar[XB_XSUB(b.x)], 1u);
        const unsigned gen = old / nloc;
        if (old + 1u == (gen + 1u) * nloc) {
            __builtin_amdgcn_fence(__ATOMIC_RELEASE, "agent");
            asm volatile("s_waitcnt vmcnt(0)" ::: "memory");
            const unsigned og = xb_add(&bar[XB_TOP], 1u);
            const unsigned tg = og / nx;
            if (og + 1u == (tg + 1u) * nx) xb_add(&bar[XB_TOPGEN], 1u);
            else XB_SPIN(xb_ld(&bar[XB_TOPGEN]) == tg, bar);
            __builtin_amdgcn_fence(__ATOMIC_ACQUIRE, "agent");
            xb_add(&bar[XB_XGEN(b.x)], 1u);
            asm volatile("s_waitcnt vmcnt(0)" ::: "memory");
        } else {
            XB_SPIN(xb_ld(&bar[XB_XGEN(b.x)]) == gen, bar);
            __builtin_amdgcn_fence(__ATOMIC_ACQUIRE, "agent");
            asm volatile("s_waitcnt vmcnt(0)" ::: "memory");
        }
    }
    __syncthreads();
}

#ifndef REP_P0
#define REP_P0 1
#endif
#ifndef REP_P1
#define REP_P1 1
#endif
#ifndef REP_A1
#define REP_A1 1
#endif
#ifndef REP_BCD
#define REP_BCD 1
#endif
#ifndef REP_A2
#define REP_A2 1
#endif
#ifndef REP_MG
#define REP_MG 1
#endif
#ifndef REP_UP
#define REP_UP 1
#endif
#ifndef REP_WO
#define REP_WO 1
#endif
#ifndef REP_N2
#define REP_N2 1
#endif
#ifndef REP_DN
#define REP_DN 1
#endif
#ifndef REP_B
#define REP_B 1
#endif
#ifndef REP_C
#define REP_C 1
#endif
#ifndef REP_D
#define REP_D 1
#endif
#ifndef REP_SYNC
#define REP_SYNC 1
#endif
#define GSYNC() do { _Pragma("unroll 1") for (int r_ = 0; r_ < REP_SYNC; ++r_) xcd_barrier(bar); } while (0)
#define REPEAT(n) _Pragma("unroll 1") for (int rep_ = 0; rep_ < (n); ++rep_)
struct Args { const float* in[16]; float* out; unsigned char* ws; };
constexpr int LDS_BYTES = 147456;
__device__ __forceinline__ unsigned char* opq(unsigned char* p) { asm volatile("" : "+s"(p)); return p; }
__device__ __forceinline__ int opq_tid() { int t = threadIdx.x; asm volatile("" : "+v"(t)); return t; }
#define WSB(T, off) ((T*)(ws + (off)))
constexpr int PTAB_OFF = 147456 - 512, BST_OFF = 147456 - 64;
__device__ __forceinline__ void* ldp(PG8_LAS unsigned char* ldsl, int i) {
    unsigned off = PTAB_OFF + 8 * i; asm volatile("" : "+v"(off));
    const unsigned long long v = *(volatile LAS unsigned long long*)(ldsl + off);
    const unsigned lo = __builtin_amdgcn_readfirstlane((unsigned)v), hi = __builtin_amdgcn_readfirstlane((unsigned)(v >> 32));
    return (void*)(__attribute__((address_space(1))) void*)(((unsigned long long)hi << 32) | lo);
}

__global__ void __launch_bounds__(512, 2) fwd_kernel(Args a) {
    extern __shared__ __attribute__((aligned(16))) unsigned char lds[];
    cg::grid_group grid = cg::this_grid();
    PG8_LAS unsigned char* ldsl = (PG8_LAS unsigned char*)lds;
    if (a.ws == nullptr) grid.sync();
    if (threadIdx.x == 0) { ((volatile LAS unsigned*)(ldsl + BST_OFF))[0] = 0u; ((volatile LAS unsigned*)(ldsl + BST_OFF))[1] = 0u; }
    if (threadIdx.x == 0) { LAS unsigned long long* tb = (LAS unsigned long long*)(ldsl + PTAB_OFF);
#pragma unroll
        for (int i = 0; i < 16; ++i) tb[i] = (unsigned long long)a.in[i];
        tb[16] = (unsigned long long)a.out; tb[17] = (unsigned long long)a.ws; }
    __syncthreads();
    XcdBarrier bar = xcd_barrier_post((unsigned*)a.ws + 1024, (volatile LAS unsigned*)(ldsl + BST_OFF));
#define INP(i) ((const float*)ldp(ldsl, (i)))
#define OUTP ((float*)ldp(ldsl, 16))
#define WSP ((unsigned char*)ldp(ldsl, 17))

#define PHASE_VARS unsigned char* ws = WSP; int bid = blockIdx.x; asm volatile("" : "+s"(bid)); int G = gridDim.x; asm volatile("" : "+s"(G)); \
    const int tid = opq_tid(), lane = tid & 63, wave = __builtin_amdgcn_readfirstlane(tid >> 6); const int gw = bid * 8 + wave, ngw = G * 8; (void)ws; (void)lane; (void)gw; (void)ngw;
#ifndef REP_ALL
#define REP_ALL 1
#endif
#pragma unroll 1
    for (int ll = 0; ll < 2 * REP_ALL; ++ll) {
        const int l = ll & 1;
        REPEAT(REP_P0) {
            PHASE_VARS
#ifndef NO_CVT
            Ptrs P; P.mix_g = INP(1) + l * DM; P.ffn_g = INP(12) + l * DM;
            P.w_in = INP(2) + (size_t)l * DM * DIN; P.qn = INP(3) + l * 64; P.kn = INP(4) + l * 64; P.pool_w = INP(5) + l * 4 * 64 * 64; P.pool_scale = INP(6) + l * 256;
            P.gm_norm = INP(7) + l * 256; P.gm_ws = INP(8) + l * 4 * 128 * 128; P.gm_b = INP(9) + l * 4 * 128; P.w_branch = INP(10) + (size_t)l * 4 * 256 * 1024;
            P.w_out = INP(11) + (size_t)l * 1024 * 1024; P.w_gate = INP(13) + (size_t)l * DM * DFF; P.w_up = INP(14) + (size_t)l * DM * DFF; P.w_down = INP(15) + (size_t)l * DFF * DM;
            convert_weights(P, ws, (LAS float*)(ldsl + wave * 8448), gw, ngw, lane, bid * 512 + tid, G * 512);
#endif
            if (l == 0) x_to_bf16_ss(INP(0), WSB(bf16_t, WS_XN), WSB(float, WS_SS0), gw, ngw, lane);
        }
        GSYNC();
        REPEAT(REP_P1) {
            PHASE_VARS
            pg8::Gemm g{WSB(bf16_t, WS_XN), WSB(bf16_t, WS_WIN), M_, NINP, DM}; pg8::StaticOrder S; S.init(M_, NINP, G, bid);
            EpiIn E{ws, INP(3) + l * 64, INP(4) + l * 64, WSB(float, WS_SS0)};
#ifndef NO_G1
            pg8::gemm_phase<EpiIn, pg8::StaticOrder, true, true>(ldsl, g, S, E);
#endif
        }
        GSYNC();
        REPEAT(REP_A1) {
            PHASE_VARS
            for (int i = bid * 512 + tid; i < M_; i += G * 512) { WSB(float, WS_SS0)[i] = 0.f; WSB(float, WS_SS1)[i] = 0.f; }
#ifndef NO_A1
            phase_a1(lds, WSB(bf16_t, WS_IQ), WSB(bf16_t, WS_IK), WSB(float, WS_IW), WSB(unsigned short, WS_MASK), tid, bid, G);
#endif
            __syncthreads();
        }
        REPEAT(REP_BCD) {
        REPEAT(REP_C) {
            PHASE_VARS
#ifndef NO_C
            phase_c(lds, WSB(bf16_t, WS_GV), WSB(bf16_t, WS_GU), WSB(bf16_t, WS_OCAT) + 512, INP(7) + l * 256, WSB(bf16_t, WS_WS), INP(9) + l * 4 * 128, tid, bid, G);
#endif
        }
        REPEAT(REP_B) {
            PHASE_VARS
#ifndef NO_B
            phase_b(WSB(bf16_t, WS_PIN), WSB(bf16_t, WS_WP), INP(6) + l * 256, WSB(bf16_t, WS_OCAT) + 256, gw, ngw, lane);
#endif
        }
        REPEAT(REP_D) {
            PHASE_VARS
#ifndef NO_D
            phase_d(WSB(bf16_t, WS_SQ), WSB(bf16_t, WS_OCAT) + 768, WSB(bf16_t, WS_SK), WSB(bf16_t, WS_VTS), gw, ngw, lane);
#endif
        }
        }
        GSYNC();
        REPEAT(REP_A2) {
            PHASE_VARS
#ifndef NO_A2
            phase_a2(lds, WSB(bf16_t, WS_QA), WSB(bf16_t, WS_OCAT), WSB(bf16_t, WS_KA), WSB(bf16_t, WS_VTA), WSB(unsigned short, WS_MASK), INP(3) + l * 64, INP(4) + l * 64, tid, bid, G);
#endif
        }
        GSYNC();
        REPEAT(REP_MG) {
            PHASE_VARS
            pg8::Gemm g{WSB(bf16_t, WS_OCAT), WSB(bf16_t, WS_WB), M_, DM, DM}; pg8::StaticOrder S; S.init(M_, DM, G, bid);
            EpiMerge E{ws + WS_G, WSB(bf16_t, WS_XN)};
#ifndef NO_G2
            pg8::gemm_phase<EpiMerge, pg8::StaticOrder, true, true>(ldsl, g, S, E);
#endif
        }
        GSYNC();
        REPEAT(REP_WO) {
            PHASE_VARS
            pg8::Gemm g{WSB(bf16_t, WS_XN), WSB(bf16_t, WS_WOUT), M_, DM, DM}; pg8::StaticOrder S; S.init(M_, DM, G, bid);
            EpiResid E{l == 0 ? INP(0) : OUTP, OUTP, WSB(bf16_t, WS_S), WSB(float, WS_SS1), 1};
#ifndef NO_G3
            pg8::gemm_phase<EpiResid, pg8::StaticOrder, true, true>(ldsl, g, S, E);
#endif
        }
        GSYNC();
        REPEAT(REP_UP) {
            PHASE_VARS
            pg8::Gemm g{WSB(bf16_t, WS_S), WSB(bf16_t, WS_WGU), M_, 2 * DFF, DM}; pg8::StaticOrder S; S.init(M_, 2 * DFF, G, bid);
            EpiSwiGLU E{WSB(bf16_t, WS_R1), WSB(float, WS_SS1)};
#ifndef NO_G4
            pg8::gemm_phase<EpiSwiGLU, pg8::StaticOrder, true, true>(ldsl, g, S, E);
#endif
        }
        GSYNC();
        REPEAT(REP_DN) {
            PHASE_VARS
            pg8::Gemm g{WSB(bf16_t, WS_R1), WSB(bf16_t, WS_WD), M_, DM, DFF}; pg8::StaticOrder S; S.init(M_, DM, G, bid);
            float* o = OUTP; EpiResid E{o, o, WSB(bf16_t, WS_XN), WSB(float, WS_SS0), l == 0 ? 1 : 0};
#ifndef NO_G3
            pg8::gemm_phase<EpiResid, pg8::StaticOrder, true, true>(ldsl, g, S, E);
#endif
        }
        if (ll + 1 < 2 * REP_ALL) GSYNC();
    }
}

extern "C" void kernel_launch(void* const* d_in, const int* in_sizes, int n_in, void* d_out, int out_size, void* d_ws, size_t ws_size, hipStream_t stream) {
    static int grid_blocks = 0;
    if (grid_blocks == 0) {
        if (n_in != 16 || out_size != M_ * DM || ws_size < WS_END) { fprintf(stderr, "kernel_launch: unexpected shapes (n_in %d out %d ws %zu)\n", n_in, out_size, ws_size); grid_blocks = -1; return; }
        int dev = 0, cus = 0, per_cu = 0;
        hipGetDevice(&dev);
        hipDeviceGetAttribute(&cus, hipDeviceAttributeMultiprocessorCount, dev);
        hipFuncSetAttribute((const void*)fwd_kernel, hipFuncAttributeMaxDynamicSharedMemorySize, LDS_BYTES);
        if (hipOccupancyMaxActiveBlocksPerMultiprocessor(&per_cu, (const void*)fwd_kernel, 512, LDS_BYTES) != hipSuccess || per_cu < 1) per_cu = 1;
        (void)hipGetLastError();
        grid_blocks = cus;
    }
    if (grid_blocks < 0) return;
    Args a{};
    for (int i = 0; i < 16; ++i) a.in[i] = (const float*)d_in[i];
    a.out = (float*)d_out; a.ws = (unsigned char*)d_ws;
    if (hipMemsetAsync(d_ws, 0, 65536, stream) != hipSuccess) { fprintf(stderr, "kernel_launch: memset failed\n"); return; }
    void* args[] = {&a};
    hipError_t e = hipLaunchCooperativeKernel((const void*)fwd_kernel, dim3(grid_blocks), dim3(512), args, LDS_BYTES, stream);
    if (e != hipSuccess) fprintf(stderr, "cooperative launch failed: %s (grid %d)\n", hipGetErrorString(e), grid_blocks);
}
```

```cpp
#include <hip/hip_runtime.h>
#include <hip/hip_cooperative_groups.h>
#include <cstdio>
#include <cstdint>
namespace pg8 {
#define PG8_LAS __attribute__((address_space(3)))
typedef unsigned short bf16_t;
typedef short bf16x8 __attribute__((ext_vector_type(8)));
typedef float f32x4 __attribute__((ext_vector_type(4)));
typedef unsigned u32x4 __attribute__((ext_vector_type(4)));
constexpr int BM = 256, BK = 64, HALF = 128, HTB = HALF * BK * 2  , STAGE_BYTES = 8 * HTB, NXCD = 8, WGM = 8;

__host__ __device__ __forceinline__ int lds_byte(int r, int c) { const int st = (r >> 4) * 2 + (c >> 5), rr = r & 15, cc = c & 31, ob = rr * 64 + cc * 2; return st * 1024 + (ob ^ (((ob >> 9) & 1) << 5)); }
__host__ __device__ __forceinline__ void stage_rc(int b, int& R, int& C) { const int st = b / 1024, sb = b % 1024, swz = sb ^ (((sb >> 9) & 1) << 5); R = (st >> 1) * 16 + swz / 64; C = (st & 1) * 32 + (swz % 64) / 2; }
__host__ __device__ __forceinline__ int perm32(int rho) { const int n = rho >> 4, i = rho & 15; return 8 * (i >> 2) + 4 * n + (i & 3); }

struct Unit { int pm, pn; };
struct Gemm { const bf16_t* A; const bf16_t* Bt; int M, N, K; };

struct StaticOrder {
    int nM, nN, nwg, G, c;
    __host__ __device__ void init(int M, int N, int G_, int c_) { nM = M / BM; nN = N / BM; nwg = nM * nN; G = G_; c = c_; }
    __host__ __device__ bool next(int i, Unit& u) const {
        const long L = (long)i * G + c; if (L >= nwg) return false;
        int wgid = (int)L; { const int q = nwg / NXCD, r = nwg % NXCD, xcd = wgid % NXCD, off = wgid / NXCD; wgid = (xcd < r ? xcd * (q + 1) : r * (q + 1) + (xcd - r) * q) + off; }
        const int nig = WGM * nN, gid = wgid / nig, fm = gid * WGM, gsz = (nM - fm) < WGM ? (nM - fm) : WGM;
        u.pm = fm + ((wgid % nig) % gsz); u.pn = (wgid % nig) / gsz; return true;
    }
    __device__ __forceinline__ void a_ready(const Unit&) const {}
    __device__ __forceinline__ void done(const Unit&) const {}
};

__device__ __forceinline__ unsigned cvt_pk_bf16(float lo, float hi) { unsigned r; asm volatile("v_cvt_pk_bf16_f32 %0, %1, %2" : "=v"(r) : "v"(lo), "v"(hi)); return r; }
template <class Epi, class Sched, bool ALIGN_EPI = false, bool SP2 = false>
__device__ __forceinline__ void gemm_phase(PG8_LAS unsigned char* lds, const Gemm g, const Sched& S, const Epi& E) {
    int tid_ = threadIdx.x; asm volatile("" : "+v"(tid_)); const int tid = tid_, wid = __builtin_amdgcn_readfirstlane(tid >> 6), lane = tid & 63, wr = wid >> 2, wc = wid & 3, fr = lane & 15, fq = lane >> 4;
    const int K = g.K, nt = K / BK;
    unsigned voffA[2], voffB[2];
#pragma unroll
    for (int i = 0; i < 2; ++i) { int R, C; stage_rc(tid * 16 + i * 8192, R, C); const int Rb = Epi::PERM ? ((R & ~31) + perm32(R & 31)) : R;
        voffA[i] = (unsigned)(R * K + C) * 2u; voffB[i] = (unsigned)(Rb * K + C) * 2u; }
    const size_t kstep = (size_t)(BK * 2);
    const size_t hstep = (size_t)HALF * K * 2;
    const size_t tstep = 2 * hstep;
    const unsigned ldsw = (unsigned)wid * 1024u;
    const int aoff = lds_byte(wr * 64 + fr, fq * 8), boff = lds_byte(wc * 32 + fr, fq * 8);
#define PG8_SA(b, h) (((b) * 2 + (h)) * HTB)
#define PG8_SB(b, h) ((4 + (b) * 2 + (h)) * HTB)
#define PG8_STAGE(bufoff, gbase, voff) do { _Pragma("unroll") for (int _i = 0; _i < 2; ++_i) \
        __builtin_amdgcn_global_load_lds((const unsigned*)((const char*)(gbase) + (voff)[_i]), (PG8_LAS unsigned*)(lds + (bufoff) + ldsw + _i * 8192), 16, 0, 0); } while (0)
#define PG8_LDA(dst, b, h) do { _Pragma("unroll") for (int m = 0; m < 4; ++m) _Pragma("unroll") for (int k = 0; k < 2; ++k) dst[m][k] = *(const PG8_LAS bf16x8*)(lds + PG8_SA(b, h) + aoff + m * 2048 + k * 1024); } while (0)
#define PG8_LDB(dst, b, h) do { _Pragma("unroll") for (int n = 0; n < 2; ++n) _Pragma("unroll") for (int k = 0; k < 2; ++k) dst[n][k] = *(const PG8_LAS bf16x8*)(lds + PG8_SB(b, h) + boff + n * 2048 + k * 1024); } while (0)
#define PG8_MMA(ai, bj, At, Bt) do { __builtin_amdgcn_s_setprio(1); _Pragma("unroll") for (int m = 0; m < 4; ++m) _Pragma("unroll") for (int n = 0; n < 2; ++n) _Pragma("unroll") for (int k = 0; k < 2; ++k) \
        acc[ai][bj][m][n] = __builtin_amdgcn_mfma_f32_16x16x32_bf16(Bt[n][k], At[m][k], acc[ai][bj][m][n], 0, 0, 0); __builtin_amdgcn_s_setprio(0); } while (0)
#define PG8_WAIT_V(n) asm volatile("s_waitcnt vmcnt(" #n ")" ::: "memory")
#define PG8_WAIT_L(n) asm volatile("s_waitcnt lgkmcnt(" #n ")" ::: "memory")
#define PG8_BAR __builtin_amdgcn_s_barrier()
#define PG8_SCHED __builtin_amdgcn_sched_barrier(0)
    Unit cur, nxt; int ui = 0;
    if (!S.next(0, cur)) return;
    f32x4 acc[2][2][4][2];
#pragma unroll
    for (int a = 0; a < 2; ++a)
#pragma unroll
        for (int b = 0; b < 2; ++b)
#pragma unroll
            for (int m = 0; m < 4; ++m)
#pragma unroll
                for (int n = 0; n < 2; ++n) acc[a][b][m][n] = (f32x4){0.f, 0.f, 0.f, 0.f};
    bf16x8 At[4][2], B0[2][2], B1[2][2];
    const char* cA = (const char*)g.A + (size_t)cur.pm * tstep; const char* cB = (const char*)g.Bt + (size_t)cur.pn * tstep;
    S.a_ready(cur);
    if constexpr (SP2) {
        PG8_STAGE(PG8_SB(0, 0), cB, voffB); PG8_STAGE(PG8_SB(0, 1), cB + hstep, voffB); PG8_STAGE(PG8_SA(0, 0), cA, voffA); PG8_STAGE(PG8_SA(0, 1), cA + hstep, voffA);
        if (wr == 1) PG8_BAR;
        PG8_WAIT_V(2); PG8_BAR;
        PG8_STAGE(PG8_SB(1, 0), cB + kstep, voffB); PG8_STAGE(PG8_SA(1, 0), cA + kstep, voffA); PG8_STAGE(PG8_SB(1, 1), cB + hstep + kstep, voffB);
        PG8_WAIT_V(6); PG8_BAR;
    } else {
        PG8_STAGE(PG8_SB(0, 0), cB, voffB); PG8_STAGE(PG8_SA(0, 0), cA, voffA); PG8_STAGE(PG8_SB(0, 1), cB + hstep, voffB); PG8_STAGE(PG8_SA(0, 1), cA + hstep, voffA);
        if (wr == 1) PG8_BAR;
        PG8_WAIT_V(4); PG8_BAR;
        PG8_STAGE(PG8_SB(1, 0), cB + kstep, voffB); PG8_STAGE(PG8_SA(1, 0), cA + kstep, voffA); PG8_STAGE(PG8_SB(1, 1), cB + hstep + kstep, voffB);
        PG8_WAIT_V(6); PG8_BAR;
    }
    for (;;) {
        const bool has_next = S.next(ui + 1, nxt);
        const char* nA = has_next ? (const char*)g.A + (size_t)nxt.pm * tstep : cA; const char* nB = has_next ? (const char*)g.Bt + (size_t)nxt.pn * tstep : cB;
        for (int t = 0; t < nt; t += 2) {
            if constexpr (Epi::HOOK) { if (t != 0 && (t & 3) == 0) E.hook(acc, cur, (t >> 2) - 1, wr, wc, fr, fq); }
            const bool last = (t == nt - 2);
            const char* a1 = cA + (size_t)(t + 1) * kstep;
            const char* a2 = last ? nA : cA + (size_t)(t + 2) * kstep; const char* b2 = last ? nB : cB + (size_t)(t + 2) * kstep;
            const char* a3 = a2 + kstep; const char* b3 = b2 + kstep;
            if (last && has_next) S.a_ready(nxt);
            if constexpr (SP2) {
            PG8_LDB(B0, 0, 0); PG8_LDB(B1, 0, 1); PG8_SCHED; PG8_LDA(At, 0, 0); PG8_STAGE(PG8_SA(1, 1), a1 + hstep, voffA);
            PG8_WAIT_V(8); PG8_WAIT_L(0); PG8_BAR; PG8_MMA(0, 0, At, B0); PG8_MMA(0, 1, At, B1); PG8_BAR; PG8_SCHED;
            PG8_LDA(At, 0, 1); PG8_STAGE(PG8_SB(0, 0), b2, voffB); PG8_STAGE(PG8_SB(0, 1), b2 + hstep, voffB); PG8_STAGE(PG8_SA(0, 0), a2, voffA);
            PG8_WAIT_V(8); PG8_WAIT_L(0); PG8_BAR; PG8_MMA(1, 0, At, B0); PG8_MMA(1, 1, At, B1); PG8_BAR; PG8_SCHED;
            PG8_LDB(B0, 1, 0); PG8_LDB(B1, 1, 1); PG8_SCHED; PG8_LDA(At, 1, 0); PG8_STAGE(PG8_SA(0, 1), a2 + hstep, voffA);
            PG8_WAIT_V(8); PG8_WAIT_L(0); PG8_BAR; PG8_MMA(0, 0, At, B0); PG8_MMA(0, 1, At, B1); PG8_BAR; PG8_SCHED;
            PG8_LDA(At, 1, 1); PG8_STAGE(PG8_SB(1, 0), b3, voffB); PG8_STAGE(PG8_SB(1, 1), b3 + hstep, voffB); PG8_STAGE(PG8_SA(1, 0), a3, voffA);
            PG8_WAIT_V(8); PG8_WAIT_L(0); PG8_BAR; PG8_MMA(1, 0, At, B0); PG8_MMA(1, 1, At, B1); PG8_BAR; PG8_SCHED;
            } else {
            PG8_LDB(B0, 0, 0); PG8_SCHED; PG8_LDA(At, 0, 0); PG8_STAGE(PG8_SA(1, 1), a1 + hstep, voffA);
            PG8_WAIT_L(8); PG8_BAR; PG8_WAIT_L(0); PG8_MMA(0, 0, At, B0); PG8_BAR; PG8_SCHED;
            PG8_LDB(B1, 0, 1); PG8_STAGE(PG8_SB(0, 0), b2, voffB);
            PG8_BAR; PG8_WAIT_L(0); PG8_MMA(0, 1, At, B1); PG8_BAR;
            PG8_LDA(At, 0, 1); PG8_STAGE(PG8_SA(0, 0), a2, voffA);
            PG8_BAR; PG8_WAIT_L(0); PG8_MMA(1, 0, At, B0); PG8_BAR; PG8_SCHED;
            PG8_STAGE(PG8_SB(0, 1), b2 + hstep, voffB);
            PG8_WAIT_V(6); PG8_BAR; PG8_MMA(1, 1, At, B1); PG8_BAR;
            PG8_LDB(B0, 1, 0); PG8_SCHED; PG8_LDA(At, 1, 0); PG8_STAGE(PG8_SA(0, 1), a2 + hstep, voffA);
            PG8_WAIT_L(8); PG8_BAR; PG8_WAIT_L(0); PG8_MMA(0, 0, At, B0); PG8_BAR; PG8_SCHED;
            PG8_LDB(B1, 1, 1); PG8_STAGE(PG8_SB(1, 0), b3, voffB);
            PG8_BAR; PG8_WAIT_L(0); PG8_MMA(0, 1, At, B1); PG8_BAR;
            PG8_LDA(At, 1, 1); PG8_STAGE(PG8_SA(1, 0), a3, voffA);
            PG8_BAR; PG8_WAIT_L(0); PG8_MMA(1, 0, At, B0); PG8_BAR; PG8_SCHED;
            PG8_STAGE(PG8_SB(1, 1), b3 + hstep, voffB);
            PG8_WAIT_V(6); PG8_BAR; PG8_MMA(1, 1, At, B1); PG8_BAR;
            }
        }
        if constexpr (ALIGN_EPI) { if (wr == 0) PG8_BAR; }
        if constexpr (!Epi::AFTER_DRAIN) { E(acc, cur, wr, wc, fr, fq); if constexpr (Epi::EPI_TWICE) { E(acc, cur, wr, wc, fr, fq); } S.done(cur); }
        if (!has_next) break;
#pragma unroll
        for (int a = 0; a < 2; ++a)
#pragma unroll
            for (int b = 0; b < 2; ++b)
#pragma unroll
                for (int m = 0; m < 4; ++m)
#pragma unroll
                    for (int n = 0; n < 2; ++n) acc[a][b][m][n] = (f32x4){0.f, 0.f, 0.f, 0.f};
        cur = nxt; cA = nA; cB = nB; ++ui;
        if constexpr (ALIGN_EPI) { if (wr == 1) PG8_BAR; }
    }
    PG8_WAIT_V(0);
    if constexpr (!ALIGN_EPI) { if (wr == 0) PG8_BAR; }
    PG8_BAR;
    if constexpr (Epi::AFTER_DRAIN) { E.fused(acc, cur, wr, wc, fr, fq, lds, wid, lane); S.done(cur); }
#undef PG8_SA
#undef PG8_SB
#undef PG8_STAGE
#undef PG8_LDA
#undef PG8_LDB
#undef PG8_MMA
#undef PG8_WAIT_V
#undef PG8_WAIT_L
#undef PG8_BAR
#undef PG8_SCHED
}
}
namespace cg = cooperative_groups;
using pg8::bf16_t; using pg8::bf16x8; using pg8::f32x4; using pg8::u32x4; using pg8::Unit; using pg8::cvt_pk_bf16;
typedef unsigned u32x2 __attribute__((ext_vector_type(2)));
#define LAS __attribute__((address_space(3)))
#define LDS_WAIT() asm volatile("s_waitcnt lgkmcnt(0)" ::: "memory")

constexpr int M_ = 16384, DM = 1024, SEQ = 4096, DFF = 2816, DIN = 6696, NINP = 6912;
constexpr float EPSN = 1e-6f;
constexpr float LOG2E = 1.4426950408889634f, LN2 = 0.6931471805599453f;
constexpr float C2 = 0.125f * LOG2E;

constexpr size_t MiB = (size_t)1 << 20;
constexpr size_t WS_SS0 = 128 * 1024, WS_SS1 = 256 * 1024;
constexpr size_t WS_WIN = 1 * MiB;
constexpr size_t WS_WB = WS_WIN + (size_t)NINP * 1024 * 2;
constexpr size_t WS_WOUT = WS_WB + 2 * MiB;
constexpr size_t WS_WGU = WS_WOUT + 2 * MiB;
constexpr size_t WS_WD = WS_WGU + 11 * MiB;
constexpr size_t WS_WP = WS_WD + (size_t)1024 * 2816 * 2;
constexpr size_t WS_WS = WS_WP + 32768;
static_assert(WS_WS + 131072 <= 36 * MiB, "weights region");
constexpr size_t WS_XN = 36 * MiB;
constexpr size_t WS_R1 = 68 * MiB;
constexpr size_t WS_G = WS_R1, WS_KA = WS_R1 + 64 * MiB, WS_VTA = WS_KA + 8 * MiB, WS_IQ = WS_VTA + 8 * MiB;
constexpr size_t WS_S = 156 * MiB;
constexpr size_t WS_PIN = WS_S, WS_GU = WS_S + 8 * MiB, WS_GV = WS_S + 16 * MiB, WS_SQ = WS_S + 24 * MiB, WS_SK = WS_S + 32 * MiB,
                 WS_VTS = WS_S + 40 * MiB, WS_QA = WS_S + 48 * MiB, WS_MASK = WS_S + 56 * MiB, WS_IK = 220 * MiB, WS_IW = 221 * MiB, WS_OCAT = 222 * MiB  , WS_END = 254 * MiB;

__device__ __forceinline__ float bf2f(unsigned short v) { return __uint_as_float((unsigned)v << 16); }
__device__ __forceinline__ float bflo(unsigned v) { return __uint_as_float(v << 16); }
__device__ __forceinline__ float bfhi(unsigned v) { return __uint_as_float(v & 0xffff0000u); }
__device__ __forceinline__ unsigned short f2bf(float f) { return (unsigned short)(cvt_pk_bf16(f, 0.f) & 0xffffu); }
__device__ __forceinline__ float relu1(float x) { const int b = __float_as_int(x); return __int_as_float(b > 0 ? b : 0); }
__device__ __forceinline__ float sigmoidf_(float x) { return __builtin_amdgcn_rcpf(1.f + __builtin_amdgcn_exp2f(-x * LOG2E)); }
__device__ __forceinline__ float gelu_tanh(float x) { const float u = 0.7978845608028654f * (x + 0.044715f * x * x * x); return x * __builtin_amdgcn_rcpf(1.f + __builtin_amdgcn_exp2f(-2.f * LOG2E * u)); }
__device__ __forceinline__ f32x4 mfma16(bf16x8 a, bf16x8 b, f32x4 c) { return __builtin_amdgcn_mfma_f32_16x16x32_bf16(a, b, c, 0, 0, 0); }
__device__ __forceinline__ bf16x8 mk8(unsigned a, unsigned b, unsigned c, unsigned d) { u32x4 v = {a, b, c, d}; return __builtin_bit_cast(bf16x8, v); }

struct EpiIn {
    static constexpr bool PERM = true, AFTER_DRAIN = false, HOOK = false;
#ifdef PROBE_EPI_IN
    static constexpr bool EPI_TWICE = true;
#else
    static constexpr bool EPI_TWICE = false;
#endif
    unsigned char* ws; const float *qn, *kn; const float* SS;
    __device__ __forceinline__ void operator()(const f32x4 (&acc)[2][2][4][2], const Unit& u, int wr, int wc, int fr, int fq) const {
        bf16_t* const QA = (bf16_t*)(ws + WS_QA); bf16_t* const KA = (bf16_t*)(ws + WS_KA); bf16_t* const VTA = (bf16_t*)(ws + WS_VTA); bf16_t* const IQ = (bf16_t*)(ws + WS_IQ);
        bf16_t* const PIN = (bf16_t*)(ws + WS_PIN); bf16_t* const GU = (bf16_t*)(ws + WS_GU); bf16_t* const GV = (bf16_t*)(ws + WS_GV); bf16_t* const SQ = (bf16_t*)(ws + WS_SQ);
        bf16_t* const SK = (bf16_t*)(ws + WS_SK); bf16_t* const VTS = (bf16_t*)(ws + WS_VTS); bf16_t* const IK = (bf16_t*)(ws + WS_IK); float* const IW = (float*)(ws + WS_IW); unsigned char* const G = ws + WS_G;
        const int pn = u.pn; const int row0 = u.pm * 256 + wr * 64 + fr; const int cl = wc * 32 + 8 * fq;
        float rr[2][4];
#pragma unroll
        for (int ai = 0; ai < 2; ++ai)
#pragma unroll
            for (int m = 0; m < 4; ++m) rr[ai][m] = __builtin_amdgcn_rsqf(SS[row0 + ai * 128 + m * 16] * (1.f / 1024.f) + EPSN);
        if (pn >= 11) {
            unsigned char* gp = G + (size_t)row0 * 4096 + (pn - 11) * 256 + cl;
#pragma unroll
            for (int ai = 0; ai < 2; ++ai)
#pragma unroll
                for (int m = 0; m < 4; ++m)
#pragma unroll
                    for (int bj = 0; bj < 2; ++bj) {
                        unsigned w2[2];
#pragma unroll
                        for (int n = 0; n < 2; ++n) { const f32x4 v = (acc[ai][bj][m][n] * rr[ai][m]); unsigned pk = 0;
#pragma unroll
                            for (int i = 0; i < 4; ++i) { const unsigned qv = (unsigned)(sigmoidf_(v[i]) * 255.f + 0.5f); pk |= qv << (8 * i); }
                            w2[n] = pk; }
                        *(u32x2*)(gp + (size_t)(ai * 128 + m * 16) * 4096 + bj * 128) = (u32x2){w2[0], w2[1]};
                    }
            return;
        }
        if (pn <= 1) {
            const float* gw = pn == 0 ? qn : kn; const float sc = pn == 0 ? C2 : 1.f; bf16_t* T = pn == 0 ? QA : KA;
            f32x4 gv[2][2];
#pragma unroll
            for (int bj = 0; bj < 2; ++bj)
#pragma unroll
                for (int n = 0; n < 2; ++n) gv[bj][n] = *(const f32x4*)(gw + bj * 32 + 8 * fq + 4 * n);
#pragma unroll
            for (int ai = 0; ai < 2; ++ai)
#pragma unroll
                for (int m = 0; m < 4; ++m) {
                    float ss = 0.f;
#pragma unroll
                    for (int bj = 0; bj < 2; ++bj)
#pragma unroll
                        for (int n = 0; n < 2; ++n) { const f32x4 v = (acc[ai][bj][m][n] * rr[ai][m]); ss += (v[0] * v[0] + v[1] * v[1]) + (v[2] * v[2] + v[3] * v[3]); }
                    ss += __shfl_xor(ss, 16); ss += __shfl_xor(ss, 32);
                    const float rinv = __builtin_amdgcn_rsqf(ss * (1.f / 64.f) + EPSN) * sc;
                    bf16_t* rp = T + (size_t)(row0 + ai * 128 + m * 16) * 256 + wc * 64 + 8 * fq;
#pragma unroll
                    for (int bj = 0; bj < 2; ++bj) { const f32x4 v0 = (acc[ai][bj][m][0] * rr[ai][m]) * gv[bj][0] * rinv, v1 = (acc[ai][bj][m][1] * rr[ai][m]) * gv[bj][1] * rinv;
                        u32x4 w; w.x = cvt_pk_bf16(v0[0], v0[1]); w.y = cvt_pk_bf16(v0[2], v0[3]); w.z = cvt_pk_bf16(v1[0], v1[1]); w.w = cvt_pk_bf16(v1[2], v1[3]);
                        *(u32x4*)(rp + bj * 32) = w; }
                }
            return;
        }
        if (pn == 2 || pn == 9) {
            bf16_t* T = pn == 2 ? VTA : VTS;
#pragma unroll
            for (int ai = 0; ai < 2; ++ai)
#pragma unroll
                for (int m = 0; m < 4; ++m) { const int row = row0 + ai * 128 + m * 16; const int b = row >> 12, t = row & 4095;
#pragma unroll
                    for (int bj = 0; bj < 2; ++bj)
#pragma unroll
                        for (int n = 0; n < 2; ++n) { const f32x4 v = (acc[ai][bj][m][n] * rr[ai][m]);
#pragma unroll
                            for (int i = 0; i < 4; ++i) T[((size_t)b * 256 + bj * 128 + cl + 4 * n + i) * 4096 + t] = f2bf(v[i]); }
                }
            return;
        }
        if (pn == 10) {
            if (wc == 0) {
#pragma unroll
                for (int ai = 0; ai < 2; ++ai)
#pragma unroll
                    for (int m = 0; m < 4; ++m) { const f32x4 v0 = (acc[ai][0][m][0] * rr[ai][m]), v1 = (acc[ai][0][m][1] * rr[ai][m]);
                        u32x4 w; w.x = cvt_pk_bf16(v0[0], v0[1]); w.y = cvt_pk_bf16(v0[2], v0[3]); w.z = cvt_pk_bf16(v1[0], v1[1]); w.w = cvt_pk_bf16(v1[2], v1[3]);
                        *(u32x4*)(IK + (size_t)(row0 + ai * 128 + m * 16) * 32 + 8 * fq) = w; }
            } else if (wc == 1 && fq == 0) {
#pragma unroll
                for (int ai = 0; ai < 2; ++ai)
#pragma unroll
                    for (int m = 0; m < 4; ++m) { float* p = IW + (size_t)(row0 + ai * 128 + m * 16) * 8; *(f32x4*)p = (acc[ai][0][m][0] * rr[ai][m]); *(f32x4*)(p + 4) = (acc[ai][0][m][1] * rr[ai][m]); }
            }
            return;
        }
        {
            bf16_t* T = pn == 3 ? IQ : pn == 4 ? PIN : pn == 5 ? GU : pn == 6 ? GV : pn == 7 ? SQ : SK;
            const bool act = (pn == 5 || pn == 6); const float sc = pn == 7 ? 0.125f : 1.f;
#pragma unroll
            for (int ai = 0; ai < 2; ++ai)
#pragma unroll
                for (int m = 0; m < 4; ++m) { bf16_t* rp = T + (size_t)(row0 + ai * 128 + m * 16) * 256 + cl;
#pragma unroll
                    for (int bj = 0; bj < 2; ++bj) { f32x4 v0 = (acc[ai][bj][m][0] * rr[ai][m]) * sc, v1 = (acc[ai][bj][m][1] * rr[ai][m]) * sc;
                        if (act) {
#pragma unroll
                            for (int i = 0; i < 4; ++i) { v0[i] = gelu_tanh(v0[i]); v1[i] = gelu_tanh(v1[i]); } }
                        u32x4 w; w.x = cvt_pk_bf16(v0[0], v0[1]); w.y = cvt_pk_bf16(v0[2], v0[3]); w.z = cvt_pk_bf16(v1[0], v1[1]); w.w = cvt_pk_bf16(v1[2], v1[3]);
                        *(u32x4*)(rp + bj * 128) = w; }
                }
        }
    }
};

struct EpiMerge {
    static constexpr bool PERM = true, AFTER_DRAIN = false, HOOK = true, EPI_TWICE = false;
    const unsigned char* G; bf16_t* MG;
    __device__ __forceinline__ void hook(f32x4 (&acc)[2][2][4][2], const Unit& u, int s, int wr, int wc, int fr, int fq) const {
        const int row0 = u.pm * 256 + wr * 64 + fr; const int col0 = u.pn * 256 + wc * 32 + 8 * fq;
        const unsigned char* gp0 = G + (size_t)row0 * 4096 + s * 1024 + col0;
        u32x2 ga[2][4][2], gb[2][4][2];
#pragma unroll
        for (int ai = 0; ai < 2; ++ai)
#pragma unroll
            for (int m = 0; m < 4; ++m)
#pragma unroll
                for (int bj = 0; bj < 2; ++bj) { const unsigned char* gp = gp0 + (size_t)(ai * 128 + m * 16) * 4096 + bj * 128; ga[ai][m][bj] = *(const u32x2*)gp; gb[ai][m][bj] = *(const u32x2*)(gp + 1024); }
#pragma unroll
        for (int ai = 0; ai < 2; ++ai)
#pragma unroll
            for (int m = 0; m < 4; ++m)
#pragma unroll
                for (int bj = 0; bj < 2; ++bj)
#pragma unroll
                    for (int i = 0; i < 4; ++i) {
                        const float a0 = fmaxf((float)((ga[ai][m][bj].x >> (8 * i)) & 255u), 1.f), b0 = fmaxf((float)((gb[ai][m][bj].x >> (8 * i)) & 255u), 1.f);
                        const float a1 = fmaxf((float)((ga[ai][m][bj].y >> (8 * i)) & 255u), 1.f), b1 = fmaxf((float)((gb[ai][m][bj].y >> (8 * i)) & 255u), 1.f);
                        acc[ai][bj][m][0][i] *= a0 * __builtin_amdgcn_rcpf(b0); acc[ai][bj][m][1][i] *= a1 * __builtin_amdgcn_rcpf(b1); }
    }
    __device__ __forceinline__ void operator()(const f32x4 (&acc)[2][2][4][2], const Unit& u, int wr, int wc, int fr, int fq) const {
        const int row0 = u.pm * 256 + wr * 64 + fr; const int col0 = u.pn * 256 + wc * 32 + 8 * fq;
        const unsigned char* gp0 = G + (size_t)row0 * 4096 + 3 * 1024 + col0; bf16_t* mp0 = MG + (size_t)row0 * 1024 + col0;
        u32x2 gb[2][4][2];
#pragma unroll
        for (int ai = 0; ai < 2; ++ai)
#pragma unroll
            for (int m = 0; m < 4; ++m)
#pragma unroll
                for (int bj = 0; bj < 2; ++bj) gb[ai][m][bj] = *(const u32x2*)(gp0 + (size_t)(ai * 128 + m * 16) * 4096 + bj * 128);
#pragma unroll
        for (int ai = 0; ai < 2; ++ai)
#pragma unroll
            for (int m = 0; m < 4; ++m)
#pragma unroll
                for (int bj = 0; bj < 2; ++bj) { const size_t ro = (size_t)(ai * 128 + m * 16); const u32x2 g2 = gb[ai][m][bj];
                    f32x4 v0 = acc[ai][bj][m][0], v1 = acc[ai][bj][m][1];
#pragma unroll
                    for (int i = 0; i < 4; ++i) { v0[i] *= fmaxf((float)((g2.x >> (8 * i)) & 255u), 1.f) * (1.f / 255.f); v1[i] *= fmaxf((float)((g2.y >> (8 * i)) & 255u), 1.f) * (1.f / 255.f); }
                    u32x4 w; w.x = cvt_pk_bf16(v0[0], v0[1]); w.y = cvt_pk_bf16(v0[2], v0[3]); w.z = cvt_pk_bf16(v1[0], v1[1]); w.w = cvt_pk_bf16(v1[2], v1[3]);
                    *(u32x4*)(mp0 + ro * 1024 + bj * 128) = w; }
    }
};

struct EpiResid {
    static constexpr bool PERM = true, AFTER_DRAIN = false, HOOK = false, EPI_TWICE = false;
    const float* base; float* out; bf16_t* XB; float* SS; int stat;
    __device__ __forceinline__ void operator()(const f32x4 (&acc)[2][2][4][2], const Unit& u, int wr, int wc, int fr, int fq) const {
        const int row0 = u.pm * 256 + wr * 64 + fr; const int col0 = u.pn * 256 + wc * 32 + 8 * fq;
#pragma unroll
        for (int ai = 0; ai < 2; ++ai) {
            f32x4 pre[4][2][2];
#pragma unroll
            for (int m = 0; m < 4; ++m) { const size_t off = (size_t)(row0 + ai * 128 + m * 16) * 1024 + col0;
#pragma unroll
                for (int bj = 0; bj < 2; ++bj) { pre[m][bj][0] = *(const f32x4*)(base + off + bj * 128); pre[m][bj][1] = *(const f32x4*)(base + off + bj * 128 + 4); } }
#pragma unroll
            for (int m = 0; m < 4; ++m) { const int row = row0 + ai * 128 + m * 16; const size_t off = (size_t)row * 1024 + col0; float ssum = 0.f;
#pragma unroll
                for (int bj = 0; bj < 2; ++bj) {
                    const f32x4 o0 = pre[m][bj][0] + acc[ai][bj][m][0], o1 = pre[m][bj][1] + acc[ai][bj][m][1];
                    *(f32x4*)(out + off + bj * 128) = o0; *(f32x4*)(out + off + bj * 128 + 4) = o1;
                    if (stat) { u32x4 w; w.x = cvt_pk_bf16(o0[0], o0[1]); w.y = cvt_pk_bf16(o0[2], o0[3]); w.z = cvt_pk_bf16(o1[0], o1[1]); w.w = cvt_pk_bf16(o1[2], o1[3]);
                        *(u32x4*)(XB + off + bj * 128) = w;
                        ssum += ((o0[0] * o0[0] + o0[1] * o0[1]) + (o0[2] * o0[2] + o0[3] * o0[3])) + ((o1[0] * o1[0] + o1[1] * o1[1]) + (o1[2] * o1[2] + o1[3] * o1[3])); } }
                if (stat) { ssum += __shfl_xor(ssum, 16); ssum += __shfl_xor(ssum, 32); if (fq == 0) atomicAdd(SS + row, ssum); } }
            asm volatile("" ::: "memory");
        }
    }
};

struct EpiSwiGLU {
    static constexpr bool PERM = true, AFTER_DRAIN = false, HOOK = false, EPI_TWICE = false;
    bf16_t* ACT; const float* SS;
    __device__ __forceinline__ void operator()(const f32x4 (&acc)[2][2][4][2], const Unit& u, int wr, int wc, int fr, int fq) const {
        const int row0 = u.pm * 256 + wr * 64 + fr; const int f0 = u.pn * 128 + wc * 32 + 8 * fq;
#pragma unroll
        for (int ai = 0; ai < 2; ++ai)
#pragma unroll
            for (int m = 0; m < 4; ++m) { f32x4 r[2]; const float rs = __builtin_amdgcn_rsqf(SS[row0 + ai * 128 + m * 16] * (1.f / 1024.f) + EPSN);
#pragma unroll
                for (int n = 0; n < 2; ++n) { const f32x4 g = acc[ai][0][m][n] * rs, up = acc[ai][1][m][n] * rs;
#pragma unroll
                    for (int i = 0; i < 4; ++i) r[n][i] = g[i] * sigmoidf_(g[i]) * up[i]; }
                u32x4 w; w.x = cvt_pk_bf16(r[0][0], r[0][1]); w.y = cvt_pk_bf16(r[0][2], r[0][3]); w.z = cvt_pk_bf16(r[1][0], r[1][1]); w.w = cvt_pk_bf16(r[1][2], r[1][3]);
                *(u32x4*)(ACT + (size_t)(row0 + ai * 128 + m * 16) * DFF + f0) = w; }
    }
};

__device__ __forceinline__ void cvt_item(const float* src, int ld, int col0, int nvalid, int K, bf16_t* WT, int dst_row0, int kb, LAS float* scr, int lane, const float* rs = nullptr) {
    const int k0 = 64 * kb, c = lane & 31;
    float vv[32];
#pragma unroll
    for (int i = 0; i < 32; ++i) { const int kk = 2 * i + (lane >> 5); vv[i] = (c < nvalid) ? src[(size_t)(k0 + kk) * ld + col0 + c] : 0.f; }
    if (rs) {
#pragma unroll
        for (int i = 0; i < 32; ++i) vv[i] *= rs[k0 + 2 * i + (lane >> 5)];
    }
#pragma unroll
    for (int i = 0; i < 32; ++i) scr[(2 * i + (lane >> 5)) * 33 + c] = vv[i];
    LDS_WAIT();
    const int c8 = lane & 7;
#pragma unroll
    for (int j = 0; j < 4; ++j) { const int n = (lane >> 3) + 8 * j; const LAS float* s = scr + (8 * c8) * 33 + n;
        u32x4 o; o.x = cvt_pk_bf16(s[0 * 33], s[1 * 33]); o.y = cvt_pk_bf16(s[2 * 33], s[3 * 33]); o.z = cvt_pk_bf16(s[4 * 33], s[5 * 33]); o.w = cvt_pk_bf16(s[6 * 33], s[7 * 33]);
        *(u32x4*)(WT + (size_t)(dst_row0 + n) * K + k0 + 8 * c8) = o; }
    LDS_WAIT();
}
__device__ __forceinline__ float wave_sum(float v) {
#pragma unroll
    for (int o = 1; o < 64; o <<= 1) v += __shfl_xor(v, o);
    return v;
}
__device__ __forceinline__ float wave_max(float v) {
#pragma unroll
    for (int o = 1; o < 64; o <<= 1) v = fmaxf(v, __shfl_xor(v, o));
    return v;
}
__device__ __forceinline__ void rmsnorm_rows(const float* xs, const float* gamma, bf16_t* XN, int gw, int ngw, int lane) {
    f32x4 gm[4];
#pragma unroll
    for (int j = 0; j < 4; ++j) gm[j] = *(const f32x4*)(gamma + 4 * lane + 256 * j);
    for (int m = gw; m < M_; m += ngw) {
        const f32x4* xr = (const f32x4*)(xs + (size_t)m * DM) + lane; f32x4 v[4]; float s = 0.f;
#pragma unroll
        for (int j = 0; j < 4; ++j) { v[j] = xr[64 * j]; s += (v[j].x * v[j].x + v[j].y * v[j].y) + (v[j].z * v[j].z + v[j].w * v[j].w); }
        const float r = __builtin_amdgcn_rsqf(wave_sum(s) * (1.f / DM) + EPSN);
        u32x2* o8 = (u32x2*)(XN + (size_t)m * DM) + lane;
#pragma unroll
        for (int j = 0; j < 4; ++j) { const f32x4 y = v[j] * r * gm[j]; o8[64 * j] = (u32x2){cvt_pk_bf16(y.x, y.y), cvt_pk_bf16(y.z, y.w)}; }
    }
}

__device__ __forceinline__ void x_to_bf16_ss(const float* xs, bf16_t* XN, float* SS, int gw, int ngw, int lane) {
    for (int m0 = gw * 4; m0 < M_; m0 += ngw * 4) {
        f32x4 v[4][4];
#pragma unroll
        for (int r = 0; r < 4; ++r) { const f32x4* xr = (const f32x4*)(xs + (size_t)(m0 + r) * DM) + lane;
#pragma unroll
            for (int j = 0; j < 4; ++j) v[r][j] = xr[64 * j]; }
#pragma unroll
        for (int r = 0; r < 4; ++r) { float s = 0.f;
#pragma unroll
            for (int j = 0; j < 4; ++j) s += (v[r][j].x * v[r][j].x + v[r][j].y * v[r][j].y) + (v[r][j].z * v[r][j].z + v[r][j].w * v[r][j].w);
            s = wave_sum(s);
            u32x2* o8 = (u32x2*)(XN + (size_t)(m0 + r) * DM) + lane;
#pragma unroll
            for (int j = 0; j < 4; ++j) o8[64 * j] = (u32x2){cvt_pk_bf16(v[r][j].x, v[r][j].y), cvt_pk_bf16(v[r][j].z, v[r][j].w)};
            if (lane == 0) SS[m0 + r] = s; }
    }
}
struct Ptrs {
    const float *mix_g, *ffn_g, *w_in, *qn, *kn, *pool_w, *pool_scale, *gm_norm, *gm_ws, *gm_b, *w_branch, *w_out, *w_gate, *w_up, *w_down;
};

__device__ __forceinline__ void convert_weights(const Ptrs& P, unsigned char* ws, LAS float* scr, int gw, int ngw, int lane, int gtid, int ngt) {
    bf16_t* WinT = (bf16_t*)(ws + WS_WIN); bf16_t* WbT = (bf16_t*)(ws + WS_WB); bf16_t* WoutT = (bf16_t*)(ws + WS_WOUT); bf16_t* WguT = (bf16_t*)(ws + WS_WGU);
    bf16_t* WdT = (bf16_t*)(ws + WS_WD); bf16_t* WpT = (bf16_t*)(ws + WS_WP); bf16_t* Wtril = (bf16_t*)(ws + WS_WS);
    constexpr int I_A = 216 * 16, I_B = 512, I_C = 512, I_D = 176 * 16, I_E = 32 * 44, I_F = 8, NIT = I_A + I_B + I_C + I_D + I_E + I_F;
    for (int it = gw; it < NIT; it += ngw) {
        int r = it;
        if (r < I_A) { const int rb = r >> 4, kb = r & 15, tile = rb >> 3, sub = rb & 7; int col0, nv = 32;
            if (tile <= 1) col0 = tile * 256 + (sub & 3) * 64 + (sub >> 2) * 32;
            else if (tile == 2) col0 = 512 + sub * 32;
            else if (tile == 3) col0 = 768 + sub * 32;
            else if (tile <= 9) col0 = 1064 + (tile - 4) * 256 + sub * 32;
            else if (tile == 10) { col0 = sub == 0 ? 1024 : 1056; nv = sub == 0 ? 32 : (sub == 1 ? 8 : 0); }
            else col0 = 2600 + (tile - 11) * 256 + sub * 32;
            cvt_item(P.w_in, DIN, col0, nv, 1024, WinT, rb * 32, kb, scr, lane, P.mix_g); continue; }
        r -= I_A;
        if (r < I_B) { const int rb = r >> 4, kb = r & 15; cvt_item(P.w_branch, 1024, rb * 32, 32, 1024, WbT, rb * 32, kb, scr, lane); continue; }
        r -= I_B;
        if (r < I_C) { const int rb = r >> 4, kb = r & 15; cvt_item(P.w_out, 1024, rb * 32, 32, 1024, WoutT, rb * 32, kb, scr, lane); continue; }
        r -= I_C;
        if (r < I_D) { const int rb = r >> 4, kb = r & 15, tile = rb >> 3, sub = rb & 7;
            cvt_item((sub >> 2) ? P.w_up : P.w_gate, DFF, tile * 128 + (sub & 3) * 32, 32, 1024, WguT, rb * 32, kb, scr, lane, P.ffn_g); continue; }
        r -= I_D;
        if (r < I_E) { const int rb = r / 44, kb = r % 44; cvt_item(P.w_down, 1024, rb * 32, 32, DFF, WdT, rb * 32, kb, scr, lane); continue; }
        r -= I_E;
        { const int gp = r >> 1, rb = r & 1; cvt_item(P.pool_w + gp * 4096, 64, rb * 32, 32, 64, WpT + gp * 4096, rb * 32, 0, scr, lane); }
    }
    for (int e = gtid; e < 4 * 128 * 128; e += ngt) { const int s = e & 127, t = (e >> 7) & 127; Wtril[e] = (s <= t) ? f2bf(P.gm_ws[e]) : (unsigned short)0; }
}

__device__ __forceinline__ unsigned mono_key(float s) { const unsigned b = __float_as_uint(s); return b ^ ((unsigned)((int)b >> 31) | 0x80000000u); }

#define wr_lane(dst, sval, ln) asm volatile("s_nop 4\n\tv_writelane_b32 %0, %1, %2\n\ts_nop 1" : "+v"(dst) : "s"(sval), "n"(ln))
template <int NBLK> __device__ __forceinline__ unsigned a1_bisect(const unsigned (&v)[64], int& cpre) {
    unsigned prefix = 0u; cpre = 0;
#pragma unroll 1
    for (int bit = 31; bit >= 0; --bit) {
        const unsigned cand = prefix | (1u << bit);
        int cnt = 0;
#pragma unroll
        for (int blk = 0; blk < NBLK; ++blk) {
            unsigned long long bl[8];
#pragma unroll
            for (int k = 0; k < 8; ++k) bl[k] = __ballot(v[blk * 8 + k] >= cand);
            __builtin_amdgcn_sched_barrier(0);
#pragma unroll
            for (int k = 0; k < 8; ++k) cnt += __builtin_popcountll(bl[k]);
            __builtin_amdgcn_sched_barrier(0);
        }
        if (cnt >= 256) { prefix = cand; cpre = cnt; if (cnt == 256) break; }
    }
    return prefix;
}
constexpr int A1_ROWF = 4100;
__device__ __forceinline__ void phase_a1(unsigned char* lds, const bf16_t* IQ, const bf16_t* IK, const float* IW, unsigned short* MASK, int tid, int bid, int G) {
    const int lane = tid & 63, w = __builtin_amdgcn_readfirstlane(tid >> 6), q = lane & 15, g = lane >> 4;
    unsigned* keys = (unsigned*)lds;
#ifndef REP_A1X
#define REP_A1X 1
#endif
    for (int L2 = bid; L2 < 1024 * REP_A1X; L2 += G) {
        const int L = L2 & 1023;
        const int b = L >> 8, c = L & 255, qg = (b & 1) ? 255 - c : c;
        const int row0 = b * SEQ + qg * 16;
        const int nreg = (qg >> 2) + 1;
        if (qg <= 15) {
#pragma unroll
            for (int half = 0; half < 2; ++half) { const int qq = half * 8 + w; const int t = qg * 16 + qq; unsigned mlo = 0u, mhi = 0u;
#pragma unroll
                for (int r = 0; r < 4; ++r) { const unsigned long long bal = __ballot(64 * r + lane <= t);
                    wr_lane(mlo, (unsigned)bal, r); wr_lane(mhi, (unsigned)(bal >> 32), r); }
                if (lane < nreg) *(u32x2*)(MASK + (size_t)(row0 + qq) * 256 + 4 * lane) = (u32x2){mlo, mhi}; }
            continue;
        }
        unsigned u[128];
        {
            bf16x8 iqf[8]; float wv[8];
#pragma unroll
            for (int h = 0; h < 8; ++h) iqf[h] = *(const bf16x8*)(IQ + (size_t)(row0 + q) * 256 + h * 32 + 8 * g);
            { const f32x4 a = *(const f32x4*)(IW + (size_t)(row0 + q) * 8), bq = *(const f32x4*)(IW + (size_t)(row0 + q) * 8 + 4);
              wv[0] = a[0]; wv[1] = a[1]; wv[2] = a[2]; wv[3] = a[3]; wv[4] = bq[0]; wv[5] = bq[1]; wv[6] = bq[2]; wv[7] = bq[3]; }
            bf16x8 kfn[4];
#pragma unroll
            for (int ii = 0; ii < 4; ++ii) kfn[ii] = *(const bf16x8*)(IK + (size_t)(b * SEQ + (8 * ii + w) * 16 + q) * 32 + 8 * g);
#pragma unroll
            for (int blk = 0; blk < 8; ++blk) {
                if (32 * blk + w <= qg) {
                    bf16x8 kf[4];
#pragma unroll
                    for (int ii = 0; ii < 4; ++ii) kf[ii] = kfn[ii];
                    if (blk < 7) {
#pragma unroll
                        for (int ii = 0; ii < 4; ++ii) { const int kt = 8 * (4 * (blk + 1) + ii) + w; kfn[ii] = *(const bf16x8*)(IK + (size_t)(b * SEQ + kt * 16 + q) * 32 + 8 * g); }
                    }
#pragma unroll
                    for (int ii = 0; ii < 4; ++ii) { const int i = 4 * blk + ii; const int kt = 8 * i + w;
                        f32x4 s = {0.f, 0.f, 0.f, 0.f};
#pragma unroll
                        for (int h = 0; h < 8; ++h) { const f32x4 a = mfma16(kf[ii], iqf[h], (f32x4){0.f, 0.f, 0.f, 0.f});
#pragma unroll
                            for (int j = 0; j < 4; ++j) s[j] = __builtin_fmaf(wv[h], relu1(a[j]), s[j]); }
#pragma unroll
                        for (int j = 0; j < 4; ++j) { unsigned uu = mono_key(s[j]); if (kt > qg || (kt == qg && (4 * g + j) > q)) uu = 0u; u[4 * i + j] = uu; }
                    }
                } else {
#pragma unroll
                    for (int r = 0; r < 16; ++r) u[16 * blk + r] = 0u;
                }
            }
        }
#pragma unroll 1
        for (int half = 0; half < 2; ++half) {
            if ((q >> 3) == half) {
                unsigned* krow = keys + (q & 7) * A1_ROWF + 4 * g;
#pragma unroll
                for (int i = 0; i < 32; ++i) { const int kt = 8 * i + w; *(u32x4*)(krow + kt * 16) = (u32x4){u[4 * i], u[4 * i + 1], u[4 * i + 2], u[4 * i + 3]}; }
            }
            __syncthreads();
            {
                const int qq = half * 8 + w; const unsigned* krow = keys + w * A1_ROWF + lane;
                unsigned v[64];
#pragma unroll
                for (int blk = 0; blk < 8; ++blk) {
                    if (nreg > blk * 8) {
#pragma unroll
                        for (int r = blk * 8; r < blk * 8 + 8; ++r) v[r] = krow[64 * r];
                    } else {
#pragma unroll
                        for (int r = blk * 8; r < blk * 8 + 8; ++r) v[r] = 0u;
                    }
                }
#ifndef REP_BIS
#define REP_BIS 1
#endif
                __syncthreads();
                unsigned prefix; int cpre = 0;
#pragma unroll 1
                for (int rb_ = 0; rb_ < REP_BIS; ++rb_)
                switch ((nreg + 7) >> 3) {
                    case 1: prefix = a1_bisect<1>(v, cpre); break; case 2: prefix = a1_bisect<2>(v, cpre); break; case 3: prefix = a1_bisect<3>(v, cpre); break; case 4: prefix = a1_bisect<4>(v, cpre); break;
                    case 5: prefix = a1_bisect<5>(v, cpre); break; case 6: prefix = a1_bisect<6>(v, cpre); break; case 7: prefix = a1_bisect<7>(v, cpre); break; default: prefix = a1_bisect<8>(v, cpre); break;
                }
                const unsigned thr = prefix > 1u ? prefix : 1u;
                unsigned mlo = 0u, mhi = 0u;
                if (cpre == 256) {
#pragma unroll
                    for (int r = 0; r < 64; ++r) { const unsigned long long bal = __ballot(v[r] >= thr); wr_lane(mlo, (unsigned)bal, r); wr_lane(mhi, (unsigned)(bal >> 32), r); }
                } else {
                    int rem = 256;
#pragma unroll
                    for (int r = 0; r < 64; ++r) rem -= __builtin_popcountll(__ballot(v[r] > thr));
#pragma unroll
                    for (int r = 0; r < 64; ++r) { unsigned long long bal = __ballot(v[r] > thr); unsigned long long eq = __ballot(v[r] == thr);
                        const int ne = __builtin_popcountll(eq);
                        if (ne <= rem) { bal |= eq; rem -= ne; }
                        else { while (rem > 0) { const unsigned long long low = eq & (0ull - eq); bal |= low; eq ^= low; --rem; } }
                        wr_lane(mlo, (unsigned)bal, r); wr_lane(mhi, (unsigned)(bal >> 32), r); }
                }
                if (lane < nreg) *(u32x2*)(MASK + (size_t)(row0 + qq) * 256 + 4 * lane) = (u32x2){mlo, mhi};
            }
        }
    }
}

__device__ __forceinline__ void phase_a2(unsigned char* lds, const bf16_t* QA, bf16_t* OA, const bf16_t* KA, const bf16_t* VTA, const unsigned short* MASK,
                                         const float* qn, const float* kn, int tid, int bid, int G) {
    const int lane = tid & 63, w = __builtin_amdgcn_readfirstlane(tid >> 6), q = lane & 15, g = lane >> 4;
    bf16_t* Kt = (bf16_t*)lds;
    bf16_t* Vt = (bf16_t*)(lds + 2 * 64 * 72 * 2);
    const float msh = LOG2E * 8.f * wave_max(fabsf(qn[lane])) * wave_max(fabsf(kn[lane])) * 1.02f + 0.25f;
    const int srow = tid >> 3, sch = tid & 7;
    for (int L = bid; L < 512; L += G) {
        const int jj = L >> 8, c0 = L & 255, c = (c0 & 7) * 32 + (c0 >> 3), bh = c >> 4, qb = jj ? 31 - (c & 15) : (c & 15);
        const int b = bh >> 2, h = bh & 3;
        const int qgw = qb * 8 + w;
        const int row0 = b * SEQ + qb * 128 + 16 * w;
        bf16x8 qf[2];
#pragma unroll
        for (int hf = 0; hf < 2; ++hf) qf[hf] = *(const bf16x8*)(QA + (size_t)(row0 + q) * 256 + h * 64 + hf * 32 + 8 * g);
        const unsigned short* mrow = MASK + (size_t)(row0 + q) * 256;
        const int nsteps = 2 * qb + 2;
        const bf16_t* ksrc = KA + (size_t)(b * SEQ + srow) * 256 + h * 64 + sch * 8;
        const bf16_t* vsrc = VTA + (size_t)(b * 256 + h * 64 + srow) * SEQ + sch * 8;
        u32x4 kA = *(const u32x4*)ksrc, vA = *(const u32x4*)vsrc, kB = kA, vB = vA;
        u32x2 mE = *(const u32x2*)mrow, mO = mE;
        *(u32x4*)(Kt + srow * 72 + sch * 8) = kA; *(u32x4*)(Vt + srow * 72 + sch * 8) = vA;
        if (nsteps > 1) { kB = *(const u32x4*)(ksrc + (size_t)64 * 256); vB = *(const u32x4*)(vsrc + 64); mO = *(const u32x2*)(mrow + 4); }
        f32x4 o[4]; float lsum = 0.f; const f32x4 negm = {-msh, -msh, -msh, -msh};
#pragma unroll
        for (int d = 0; d < 4; ++d) o[d] = (f32x4){0.f, 0.f, 0.f, 0.f};
        __syncthreads();
#define A2_COMPUTE(st, buf, mcur) do { \
            const bf16_t* kb_ = Kt + (buf) * 64 * 72; const bf16_t* vb_ = Vt + (buf) * 64 * 72; \
            _Pragma("unroll") for (int p = 0; p < 2; ++p) { \
                const int kt0 = (st) * 4 + 2 * p; \
                if (kt0 <= qgw) { \
                    const unsigned mw = p ? (mcur).y : (mcur).x; \
                    const unsigned nib0 = (mw >> (4 * g)) & 15u, nib1 = (kt0 + 1 <= qgw) ? ((mw >> (16 + 4 * g)) & 15u) : 0u; \
                    const bf16_t* kr0 = kb_ + (p * 32 + q) * 72 + 8 * g; const bf16_t* kr1 = kr0 + 16 * 72; \
                    f32x4 a0 = mfma16(*(const bf16x8*)kr0, qf[0], negm); a0 = mfma16(*(const bf16x8*)(kr0 + 32), qf[1], a0); \
                    f32x4 a1 = mfma16(*(const bf16x8*)kr1, qf[0], negm); a1 = mfma16(*(const bf16x8*)(kr1 + 32), qf[1], a1); \
                    float p0[4], p1[4]; \
                    _Pragma("unroll") for (int j = 0; j < 4; ++j) { p0[j] = __uint_as_float(__float_as_uint(__builtin_amdgcn_exp2f(a0[j])) & (0u - ((nib0 >> j) & 1u))); p1[j] = __uint_as_float(__float_as_uint(__builtin_amdgcn_exp2f(a1[j])) & (0u - ((nib1 >> j) & 1u))); } \
                    lsum += ((p0[0] + p0[1]) + (p0[2] + p0[3])) + ((p1[0] + p1[1]) + (p1[2] + p1[3])); \
                    const bf16x8 pf = mk8(cvt_pk_bf16(p0[0], p0[1]), cvt_pk_bf16(p0[2], p0[3]), cvt_pk_bf16(p1[0], p1[1]), cvt_pk_bf16(p1[2], p1[3])); \
                    _Pragma("unroll") for (int d = 0; d < 4; ++d) { const bf16_t* vr = vb_ + (d * 16 + q) * 72 + p * 32 + 4 * g; \
                        const u32x2 lo = *(const u32x2*)vr, hi = *(const u32x2*)(vr + 16); \
                        o[d] = mfma16(mk8(lo.x, lo.y, hi.x, hi.y), pf, o[d]); } \
                } } } while (0)
        for (int st = 0; st < nsteps; st += 2) {
            {
                const bool more2 = st + 2 < nsteps; u32x2 mEn = mE;
                if (more2) { kA = *(const u32x4*)(ksrc + (size_t)(st + 2) * 64 * 256); vA = *(const u32x4*)(vsrc + (st + 2) * 64); mEn = *(const u32x2*)(mrow + (st + 2) * 4); }
                A2_COMPUTE(st, 0, mE);
                *(u32x4*)(Kt + 64 * 72 + srow * 72 + sch * 8) = kB; *(u32x4*)(Vt + 64 * 72 + srow * 72 + sch * 8) = vB;
                __syncthreads();
                mE = mEn;
            }
            {
                const int s1 = st + 1; const bool more2 = s1 + 2 < nsteps; u32x2 mOn = mO;
                if (more2) { kB = *(const u32x4*)(ksrc + (size_t)(s1 + 2) * 64 * 256); vB = *(const u32x4*)(vsrc + (s1 + 2) * 64); mOn = *(const u32x2*)(mrow + (s1 + 2) * 4); }
                A2_COMPUTE(s1, 1, mO);
                if (s1 + 1 < nsteps) { *(u32x4*)(Kt + srow * 72 + sch * 8) = kA; *(u32x4*)(Vt + srow * 72 + sch * 8) = vA; }
                __syncthreads();
                mO = mOn;
            }
        }
#undef A2_COMPUTE
        lsum += __shfl_xor(lsum, 16); lsum += __shfl_xor(lsum, 32);
        const float inv = 1.f / lsum;
#pragma unroll
        for (int d = 0; d < 4; ++d) { const f32x4 v = o[d] * inv;
            *(u32x2*)(OA + (size_t)(row0 + q) * 1024 + h * 64 + d * 16 + 4 * g) = (u32x2){cvt_pk_bf16(v[0], v[1]), cvt_pk_bf16(v[2], v[3])}; }
    }
}

__device__ __forceinline__ void phase_b(const bf16_t* PIN, const bf16_t* WpT, const float* pscale, bf16_t* OB, int gw, int ngw, int lane) {
    const int q = lane & 15, g4 = lane >> 4;
    for (int L = gw; L < 4096; L += ngw) {
        const int gp = L >> 10, tg = L & 1023; const int row = tg * 16 + q; const int t = row & (SEQ - 1);
        const int win = 2 << gp; const int cnt = (t + 1 < win) ? t + 1 : win; const float inv = 1.f / (float)cnt;
        f32x4 acc[4];
#pragma unroll
        for (int d = 0; d < 4; ++d) acc[d] = (f32x4){0.f, 0.f, 0.f, 0.f};
#pragma unroll
        for (int ch = 0; ch < 2; ++ch) {
            const bf16_t* p = PIN + (size_t)row * 256 + gp * 64 + ch * 32 + 8 * g4;
            u32x4 wv[16];
#pragma unroll
            for (int i = 0; i < 16; ++i) { wv[i] = (u32x4){0u, 0u, 0u, 0u}; if (i < win && i <= t) wv[i] = *(const u32x4*)(p - (size_t)i * 256); }
            float own[8], sum[8];
            own[0] = bflo(wv[0].x); own[1] = bfhi(wv[0].x); own[2] = bflo(wv[0].y); own[3] = bfhi(wv[0].y); own[4] = bflo(wv[0].z); own[5] = bfhi(wv[0].z); own[6] = bflo(wv[0].w); own[7] = bfhi(wv[0].w);
#pragma unroll
            for (int k = 0; k < 8; ++k) sum[k] = own[k];
#pragma unroll
            for (int i = 1; i < 16; ++i) { const u32x4 v = wv[i];
                sum[0] += bflo(v.x); sum[1] += bfhi(v.x); sum[2] += bflo(v.y); sum[3] += bfhi(v.y); sum[4] += bflo(v.z); sum[5] += bfhi(v.z); sum[6] += bflo(v.w); sum[7] += bfhi(v.w); }
            float pl[8];
#pragma unroll
            for (int k = 0; k < 8; ++k) pl[k] = sum[k] * inv - own[k];
            const bf16x8 bfr = mk8(cvt_pk_bf16(pl[0], pl[1]), cvt_pk_bf16(pl[2], pl[3]), cvt_pk_bf16(pl[4], pl[5]), cvt_pk_bf16(pl[6], pl[7]));
#pragma unroll
            for (int d = 0; d < 4; ++d) { const bf16x8 afr = *(const bf16x8*)(WpT + gp * 4096 + (d * 16 + q) * 64 + ch * 32 + 8 * g4); acc[d] = mfma16(afr, bfr, acc[d]); }
        }
#pragma unroll
        for (int d = 0; d < 4; ++d) { const int d0 = d * 16 + 4 * g4; const f32x4 sc = *(const f32x4*)(pscale + gp * 64 + d0); const f32x4 v = acc[d] * sc;
            *(u32x2*)(OB + (size_t)row * 1024 + gp * 64 + d0) = (u32x2){cvt_pk_bf16(v[0], v[1]), cvt_pk_bf16(v[2], v[3])}; }
    }
}

__device__ __forceinline__ void phase_c(unsigned char* lds, const bf16_t* GV, const bf16_t* GU, bf16_t* OC, const float* gamma, const bf16_t* Wtril, const float* gbias, int tid, int bid, int G) {
    bf16_t* LT = (bf16_t*)lds;
    const int lane = tid & 63, w = __builtin_amdgcn_readfirstlane(tid >> 6), q = lane & 15, g4 = lane >> 4;
    for (int L = bid; L < 512; L += G) {
        const int gp = L & 3, chk = L >> 2; const int R0 = chk * 128;
        {
            const int row = tid >> 2, part = tid & 3;
            const bf16_t* src = GV + (size_t)(R0 + row) * 256 + part * 64;
            float x[64];
#pragma unroll
            for (int k8 = 0; k8 < 8; ++k8) { const u32x4 v = *(const u32x4*)(src + 8 * k8);
                x[8 * k8 + 0] = bflo(v.x); x[8 * k8 + 1] = bfhi(v.x); x[8 * k8 + 2] = bflo(v.y); x[8 * k8 + 3] = bfhi(v.y); x[8 * k8 + 4] = bflo(v.z); x[8 * k8 + 5] = bfhi(v.z); x[8 * k8 + 6] = bflo(v.w); x[8 * k8 + 7] = bfhi(v.w); }
            float s = 0.f;
#pragma unroll
            for (int k = 0; k < 64; ++k) s += x[k];
            s += __shfl_xor(s, 1); s += __shfl_xor(s, 2);
            const float mean = s * (1.f / 256.f); float ss = 0.f;
#pragma unroll
            for (int k = 0; k < 64; ++k) { const float dd = x[k] - mean; ss += dd * dd; }
            ss += __shfl_xor(ss, 1); ss += __shfl_xor(ss, 2);
            const float rstd = __builtin_amdgcn_rsqf(ss * (1.f / 256.f) + EPSN);
            if (part == gp) {
#pragma unroll
                for (int k4 = 0; k4 < 16; ++k4) { const f32x4 gm = *(const f32x4*)(gamma + gp * 64 + 4 * k4);
#pragma unroll
                    for (int i = 0; i < 4; ++i) LT[(4 * k4 + i) * 136 + row] = f2bf((x[4 * k4 + i] - mean) * rstd * gm[i]); }
            }
        }
        __syncthreads();
        {
            f32x4 acc[4];
#pragma unroll
            for (int d = 0; d < 4; ++d) acc[d] = (f32x4){0.f, 0.f, 0.f, 0.f};
            const int t = 16 * w + q; const int nsb = ((16 * w + 15) >> 5) + 1;
            for (int sb = 0; sb < nsb; ++sb) {
                const bf16x8 bfr = *(const bf16x8*)(Wtril + ((size_t)gp * 128 + t) * 128 + sb * 32 + 8 * g4);
#pragma unroll
                for (int d = 0; d < 4; ++d) { const bf16x8 afr = *(const bf16x8*)(LT + (d * 16 + q) * 136 + sb * 32 + 8 * g4); acc[d] = mfma16(afr, bfr, acc[d]); }
            }
            const float bias = gbias[gp * 128 + t];
#pragma unroll
            for (int d = 0; d < 4; ++d) { const size_t eo = (size_t)(R0 + t) * 256 + gp * 64 + d * 16 + 4 * g4; const u32x2 uu = *(const u32x2*)(GU + eo);
                const float r0 = bflo(uu.x) * (acc[d][0] + bias), r1 = bfhi(uu.x) * (acc[d][1] + bias), r2 = bflo(uu.y) * (acc[d][2] + bias), r3 = bfhi(uu.y) * (acc[d][3] + bias);
                *(u32x2*)(OC + (size_t)(R0 + t) * 1024 + gp * 64 + d * 16 + 4 * g4) = (u32x2){cvt_pk_bf16(r0, r1), cvt_pk_bf16(r2, r3)}; }
        }
        __syncthreads();
    }
}

__device__ __forceinline__ void sb_tile(const f32x4 z, int kbase, int tq, int g, float& carry, float (&a)[4]) {
    float lm[4]; bool msk[4];
#pragma unroll
    for (int j = 0; j < 4; ++j) { msk[j] = (kbase + 4 * g + j) >= tq;
        const float e = __builtin_amdgcn_exp2f(-fabsf(z[j]) * LOG2E); const float sp = relu1(z[j]) + __builtin_amdgcn_logf(1.f + e) * LN2;
        lm[j] = msk[j] ? 0.f : -sp; }
    const float suf2 = lm[3], suf1 = lm[3] + lm[2], suf0 = suf1 + lm[1]; const float T = suf0 + lm[0];
    const float x16 = __shfl_xor(T, 16); const float Pp = T + x16; const float Qq = __shfl_xor(Pp, 32);
    const float Sg = ((g & 1) ? 0.f : x16) + ((g & 2) ? 0.f : Qq);
    const float base = carry + Sg;
    const float tl[4] = {base + suf0, base + suf1, base + suf2, base};
#pragma unroll
    for (int j = 0; j < 4; ++j) a[j] = msk[j] ? 0.f : __builtin_amdgcn_exp2f((z[j] + lm[j] + tl[j]) * LOG2E);
    carry += Pp + Qq;
}
__device__ __forceinline__ void phase_d(const bf16_t* SQ, bf16_t* OD, const bf16_t* SK, const bf16_t* VTS, int gw, int ngw, int lane) {
    const int q = lane & 15, g = lane >> 4;
    for (int L0 = gw; L0 < 2048; L0 += ngw) {
        const int blk_ = L0 >> 3, L = ((((blk_ & 7) * 32 + ((blk_ >> 3) & 31)) << 3) | (L0 & 7)) & 2047;
        const int qg = L & 255, bh = L >> 8, b0 = bh >> 2, h = bh & 3;
        const int tq = qg * 16 + q;
        bf16x8 qf[2][2]; f32x4 o[2][4]; float carry[2] = {0.f, 0.f};
#pragma unroll
        for (int u = 0; u < 2; ++u) { const int row0 = (b0 + 2 * u) * SEQ + qg * 16;
#pragma unroll
            for (int hf = 0; hf < 2; ++hf) qf[u][hf] = *(const bf16x8*)(SQ + (size_t)(row0 + q) * 256 + h * 64 + hf * 32 + 8 * g);
#pragma unroll
            for (int d = 0; d < 4; ++d) o[u][d] = (f32x4){0.f, 0.f, 0.f, 0.f}; }
        bf16x8 kn[2][4]; u32x2 vn[2][8];
#define D_LOAD(ppx) do { const int k0_ = (ppx) * 32; _Pragma("unroll") for (int u = 0; u < 2; ++u) { const int b = b0 + 2 * u; \
                const bf16_t* kb = SK + (size_t)(b * SEQ + k0_ + q) * 256 + h * 64 + 8 * g; \
                _Pragma("unroll") for (int i = 0; i < 4; ++i) kn[u][i] = *(const bf16x8*)(kb + (size_t)(i >> 1) * 16 * 256 + (i & 1) * 32); \
                const bf16_t* vb = VTS + (size_t)(b * 256 + h * 64 + q) * SEQ + k0_ + 4 * g; \
                _Pragma("unroll") for (int d = 0; d < 4; ++d) { vn[u][2 * d] = *(const u32x2*)(vb + (size_t)d * 16 * SEQ); vn[u][2 * d + 1] = *(const u32x2*)(vb + (size_t)d * 16 * SEQ + 16); } } } while (0)
        D_LOAD(qg >> 1);
        for (int pp = qg >> 1; pp >= 0; --pp) {
            const int kt0 = 2 * pp, kt1 = kt0 + 1;
            bf16x8 kc[2][4]; u32x2 vc[2][8];
#pragma unroll
            for (int u = 0; u < 2; ++u) {
#pragma unroll
                for (int i = 0; i < 4; ++i) kc[u][i] = kn[u][i];
#pragma unroll
                for (int i = 0; i < 8; ++i) vc[u][i] = vn[u][i]; }
            D_LOAD(pp > 0 ? pp - 1 : 0);
            float a0[2][4], a1[2][4];
#pragma unroll
            for (int u = 0; u < 2; ++u) {
                if (kt1 <= qg) {
                    f32x4 z = mfma16(kc[u][2], qf[u][0], (f32x4){0.f, 0.f, 0.f, 0.f}); z = mfma16(kc[u][3], qf[u][1], z);
                    sb_tile(z, kt1 * 16, tq, g, carry[u], a1[u]);
                } else {
#pragma unroll
                    for (int j = 0; j < 4; ++j) a1[u][j] = 0.f;
                }
            }
#pragma unroll
            for (int u = 0; u < 2; ++u) {
                f32x4 z = mfma16(kc[u][0], qf[u][0], (f32x4){0.f, 0.f, 0.f, 0.f}); z = mfma16(kc[u][1], qf[u][1], z);
                sb_tile(z, kt0 * 16, tq, g, carry[u], a0[u]);
            }
#pragma unroll
            for (int u = 0; u < 2; ++u) {
                const bf16x8 pf = mk8(cvt_pk_bf16(a0[u][0], a0[u][1]), cvt_pk_bf16(a0[u][2], a0[u][3]), cvt_pk_bf16(a1[u][0], a1[u][1]), cvt_pk_bf16(a1[u][2], a1[u][3]));
#pragma unroll
                for (int d = 0; d < 4; ++d) o[u][d] = mfma16(mk8(vc[u][2 * d].x, vc[u][2 * d].y, vc[u][2 * d + 1].x, vc[u][2 * d + 1].y), pf, o[u][d]);
            }
            if (__all(carry[0] < -104.f && carry[1] < -104.f)) break;
        }
#undef D_LOAD
#pragma unroll
        for (int u = 0; u < 2; ++u) { const int row0 = (b0 + 2 * u) * SEQ + qg * 16;
#pragma unroll
            for (int d = 0; d < 4; ++d) *(u32x2*)(OD + (size_t)(row0 + q) * 1024 + h * 64 + d * 16 + 4 * g) = (u32x2){cvt_pk_bf16(o[u][d][0], o[u][d][1]), cvt_pk_bf16(o[u][d][2], o[u][d][3])}; }
    }
}

#define XB_TMO      128
#define XB_XCNT(j)  (256  + 64 * (j))
#define XB_XSUB(j)  (1280 + 64 * (j))
#define XB_XGEN(j)  (2304 + 64 * (j))
#define XB_TOP      3328
#define XB_TOPGEN   3392
#define XCD_BAR_WORDS 3456
#define XB_SPIN_CAP (1u << 18)

__device__ __forceinline__ unsigned xb_ld(unsigned* p)              { return __hip_atomic_load(p, __ATOMIC_RELAXED, __HIP_MEMORY_SCOPE_AGENT); }
__device__ __forceinline__ unsigned xb_add(unsigned* p, unsigned v) { return __hip_atomic_fetch_add(p, v, __ATOMIC_RELAXED, __HIP_MEMORY_SCOPE_AGENT); }
__device__ __forceinline__ unsigned xb_xcc_id() { return (unsigned)__builtin_amdgcn_s_getreg((3 << 11) | 20) & 0xFu; }
#define XB_SPIN(cond, bar) do { unsigned _sp = 0; while (cond) { __builtin_amdgcn_s_sleep(1); \
    if ((++_sp & 255u) == 0u) { if (xb_ld(&(bar)[XB_TMO])) break; if (_sp > XB_SPIN_CAP) { atomicAdd(&(bar)[XB_TMO], 1u); break; } } } } while (0)

struct XcdBarrier {
    unsigned* bar; unsigned x;
    volatile LAS unsigned* st;
};

__device__ __forceinline__ XcdBarrier xcd_barrier_post(unsigned* bar, volatile LAS unsigned* st) {
    XcdBarrier b; b.bar = bar; b.x = xb_xcc_id(); b.st = st;
    if (threadIdx.x == 0) (void)xb_add(&bar[XB_XCNT(b.x)], 1u);
    return b;
}
__device__ __forceinline__ void xcd_barrier_complete(unsigned* bar, unsigned x, unsigned& nloc, unsigned& nx) {
    const unsigned G = gridDim.x * gridDim.y * gridDim.z;
    unsigned sum, cnt, mine, sp = 0u;
    for (;;) {
        sum = 0u; cnt = 0u; mine = 0u;
#pragma unroll
        for (unsigned j = 0; j < 16; ++j) { const unsigned c = xb_ld(&bar[XB_XCNT(j)]); sum += c; cnt += (c > 0u) ? 1u : 0u; mine = (j == x) ? c : mine; }
        if (sum == G) break;
        __builtin_amdgcn_s_sleep(1);
        if ((++sp & 255u) == 0u) { if (xb_ld(&bar[XB_TMO])) break; if (sp > XB_SPIN_CAP) { atomicAdd(&bar[XB_TMO], 1u); break; } }
    }
    nloc = mine > 0u ? mine : 1u; nx = cnt > 0u ? cnt : 1u;
}

__device__ __forceinline__ void xcd_barrier(const XcdBarrier& b) {
    asm volatile("s_waitcnt vmcnt(0)" ::: "memory");
    __syncthreads();
    if (threadIdx.x == 0) {
        unsigned* bar = b.bar;
        __builtin_amdgcn_s_waitcnt(0);
        unsigned nloc = b.st[0], nx = b.st[1];
        if (nloc == 0u) { xcd_barrier_complete(bar, b.x, nloc, nx); b.st[0] = nloc; b.st[1] = nx; }
        const unsigned old = xb_add(&bar[XB_XSUB(b.x)], 1u);
        const unsigned gen = old / nloc;
        if (old + 1u == (gen + 1u) * nloc) {
            __builtin_amdgcn_fence(__ATOMIC_RELEASE, "agent");
            asm volatile("s_waitcnt vmcnt(0)" ::: "memory");
            const unsigned og = xb_add(&bar[XB_TOP], 1u);
            const unsigned tg = og / nx;
            if (og + 1u == (tg + 1u) * nx) xb_add(&bar[XB_TOPGEN], 1u);
            else XB_SPIN(xb_ld(&bar[XB_TOPGEN]) == tg, bar);
            __builtin_amdgcn_fence(__ATOMIC_ACQUIRE, "agent");
            xb_add(&bar[XB_XGEN(b.x)], 1u);
            asm volatile("s_waitcnt vmcnt(0)" ::: "memory");
        } else {
            XB_SPIN(xb_ld(&bar[XB_XGEN(b.x)]) == gen, bar);
            __builtin_amdgcn_fence(__ATOMIC_ACQUIRE, "agent");
            asm volatile("s_waitcnt vmcnt(0)" ::: "memory");
        }
    }
    __syncthreads();
}

#ifndef REP_P0
#define REP_P0 1
#endif
#ifndef REP_P1
#define REP_P1 1
#endif
#ifndef REP_A1
#define REP_A1 1
#endif
#ifndef REP_BCD
#define REP_BCD 1
#endif
#ifndef REP_A2
#define REP_A2 1
#endif
#ifndef REP_MG
#define REP_MG 1
#endif
#ifndef REP_UP
#define REP_UP 1
#endif
#ifndef REP_WO
#define REP_WO 1
#endif
#ifndef REP_N2
#define REP_N2 1
#endif
#ifndef REP_DN
#define REP_DN 1
#endif
#ifndef REP_B
#define REP_B 1
#endif
#ifndef REP_C
#define REP_C 1
#endif
#ifndef REP_D
#define REP_D 1
#endif
#ifndef REP_SYNC
#define REP_SYNC 1
#endif
#define GSYNC() do { _Pragma("unroll 1") for (int r_ = 0; r_ < REP_SYNC; ++r_) xcd_barrier(bar); } while (0)
#define REPEAT(n) _Pragma("unroll 1") for (int rep_ = 0; rep_ < (n); ++rep_)
struct Args { const float* in[16]; float* out; unsigned char* ws; };
constexpr int LDS_BYTES = 147456;
__device__ __forceinline__ unsigned char* opq(unsigned char* p) { asm volatile("" : "+s"(p)); return p; }
__device__ __forceinline__ int opq_tid() { int t = threadIdx.x; asm volatile("" : "+v"(t)); return t; }
#define WSB(T, off) ((T*)(ws + (off)))
constexpr int PTAB_OFF = 147456 - 512, BST_OFF = 147456 - 64;
__device__ __forceinline__ void* ldp(PG8_LAS unsigned char* ldsl, int i) {
    unsigned off = PTAB_OFF + 8 * i; asm volatile("" : "+v"(off));
    const unsigned long long v = *(volatile LAS unsigned long long*)(ldsl + off);
    const unsigned lo = __builtin_amdgcn_readfirstlane((unsigned)v), hi = __builtin_amdgcn_readfirstlane((unsigned)(v >> 32));
    return (void*)(__attribute__((address_space(1))) void*)(((unsigned long long)hi << 32) | lo);
}

__global__ void __launch_bounds__(512, 2) fwd_kernel(Args a) {
    extern __shared__ __attribute__((aligned(16))) unsigned char lds[];
    cg::grid_group grid = cg::this_grid();
    PG8_LAS unsigned char* ldsl = (PG8_LAS unsigned char*)lds;
    if (a.ws == nullptr) grid.sync();
    if (threadIdx.x == 0) { ((volatile LAS unsigned*)(ldsl + BST_OFF))[0] = 0u; ((volatile LAS unsigned*)(ldsl + BST_OFF))[1] = 0u; }
    if (threadIdx.x == 0) { LAS unsigned long long* tb = (LAS unsigned long long*)(ldsl + PTAB_OFF);
#pragma unroll
        for (int i = 0; i < 16; ++i) tb[i] = (unsigned long long)a.in[i];
        tb[16] = (unsigned long long)a.out; tb[17] = (unsigned long long)a.ws; }
    __syncthreads();
    XcdBarrier bar = xcd_barrier_post((unsigned*)a.ws + 1024, (volatile LAS unsigned*)(ldsl + BST_OFF));
#define INP(i) ((const float*)ldp(ldsl, (i)))
#define OUTP ((float*)ldp(ldsl, 16))
#define WSP ((unsigned char*)ldp(ldsl, 17))

#define PHASE_VARS unsigned char* ws = WSP; int bid = blockIdx.x; asm volatile("" : "+s"(bid)); int G = gridDim.x; asm volatile("" : "+s"(G)); \
    const int tid = opq_tid(), lane = tid & 63, wave = __builtin_amdgcn_readfirstlane(tid >> 6); const int gw = bid * 8 + wave, ngw = G * 8; (void)ws; (void)lane; (void)gw; (void)ngw;
#ifndef REP_ALL
#define REP_ALL 1
#endif
#pragma unroll 1
    for (int ll = 0; ll < 2 * REP_ALL; ++ll) {
        const int l = ll & 1;
        REPEAT(REP_P0) {
            PHASE_VARS
#ifndef NO_CVT
            Ptrs P; P.mix_g = INP(1) + l * DM; P.ffn_g = INP(12) + l * DM;
            P.w_in = INP(2) + (size_t)l * DM * DIN; P.qn = INP(3) + l * 64; P.kn = INP(4) + l * 64; P.pool_w = INP(5) + l * 4 * 64 * 64; P.pool_scale = INP(6) + l * 256;
            P.gm_norm = INP(7) + l * 256; P.gm_ws = INP(8) + l * 4 * 128 * 128; P.gm_b = INP(9) + l * 4 * 128; P.w_branch = INP(10) + (size_t)l * 4 * 256 * 1024;
            P.w_out = INP(11) + (size_t)l * 1024 * 1024; P.w_gate = INP(13) + (size_t)l * DM * DFF; P.w_up = INP(14) + (size_t)l * DM * DFF; P.w_down = INP(15) + (size_t)l * DFF * DM;
            convert_weights(P, ws, (LAS float*)(ldsl + wave * 8448), gw, ngw, lane, bid * 512 + tid, G * 512);
#endif
            if (l == 0) x_to_bf16_ss(INP(0), WSB(bf16_t, WS_XN), WSB(float, WS_SS0), gw, ngw, lane);
        }
        GSYNC();
        REPEAT(REP_P1) {
            PHASE_VARS
            pg8::Gemm g{WSB(bf16_t, WS_XN), WSB(bf16_t, WS_WIN), M_, NINP, DM}; pg8::StaticOrder S; S.init(M_, NINP, G, bid);
            EpiIn E{ws, INP(3) + l * 64, INP(4) + l * 64, WSB(float, WS_SS0)};
#ifndef NO_G1
            pg8::gemm_phase<EpiIn, pg8::StaticOrder, true, true>(ldsl, g, S, E);
#endif
        }
        GSYNC();
        REPEAT(REP_A1) {
            PHASE_VARS
            for (int i = bid * 512 + tid; i < M_; i += G * 512) { WSB(float, WS_SS0)[i] = 0.f; WSB(float, WS_SS1)[i] = 0.f; }
#ifndef NO_A1
            phase_a1(lds, WSB(bf16_t, WS_IQ), WSB(bf16_t, WS_IK), WSB(float, WS_IW), WSB(unsigned short, WS_MASK), tid, bid, G);
#endif
            __syncthreads();
        }
        REPEAT(REP_BCD) {
        REPEAT(REP_C) {
            PHASE_VARS
#ifndef NO_C
            phase_c(lds, WSB(bf16_t, WS_GV), WSB(bf16_t, WS_GU), WSB(bf16_t, WS_OCAT) + 512, INP(7) + l * 256, WSB(bf16_t, WS_WS), INP(9) + l * 4 * 128, tid, bid, G);
#endif
        }
        REPEAT(REP_B) {
            PHASE_VARS
#ifndef NO_B
            phase_b(WSB(bf16_t, WS_PIN), WSB(bf16_t, WS_WP), INP(6) + l * 256, WSB(bf16_t, WS_OCAT) + 256, gw, ngw, lane);
#endif
        }
        REPEAT(REP_D) {
            PHASE_VARS
#ifndef NO_D
            phase_d(WSB(bf16_t, WS_SQ), WSB(bf16_t, WS_OCAT) + 768, WSB(bf16_t, WS_SK), WSB(bf16_t, WS_VTS), gw, ngw, lane);
#endif
        }
        }
        GSYNC();
        REPEAT(REP_A2) {
            PHASE_VARS
#ifndef NO_A2
            phase_a2(lds, WSB(bf16_t, WS_QA), WSB(bf16_t, WS_OCAT), WSB(bf16_t, WS_KA), WSB(bf16_t, WS_VTA), WSB(unsigned short, WS_MASK), INP(3) + l * 64, INP(4) + l * 64, tid, bid, G);
#endif
        }
        GSYNC();
        REPEAT(REP_MG) {
            PHASE_VARS
            pg8::Gemm g{WSB(bf16_t, WS_OCAT), WSB(bf16_t, WS_WB), M_, DM, DM}; pg8::StaticOrder S; S.init(M_, DM, G, bid);
            EpiMerge E{ws + WS_G, WSB(bf16_t, WS_XN)};
#ifndef NO_G2
            pg8::gemm_phase<EpiMerge, pg8::StaticOrder, true, true>(ldsl, g, S, E);
#endif
        }
        GSYNC();
        REPEAT(REP_WO) {
            PHASE_VARS
            pg8::Gemm g{WSB(bf16_t, WS_XN), WSB(bf16_t, WS_WOUT), M_, DM, DM}; pg8::StaticOrder S; S.init(M_, DM, G, bid);
            EpiResid E{l == 0 ? INP(0) : OUTP, OUTP, WSB(bf16_t, WS_S), WSB(float, WS_SS1), 1};
#ifndef NO_G3
            pg8::gemm_phase<EpiResid, pg8::StaticOrder, true, true>(ldsl, g, S, E);
#endif
        }
        GSYNC();
        REPEAT(REP_UP) {
            PHASE_VARS
            pg8::Gemm g{WSB(bf16_t, WS_S), WSB(bf16_t, WS_WGU), M_, 2 * DFF, DM}; pg8::StaticOrder S; S.init(M_, 2 * DFF, G, bid);
            EpiSwiGLU E{WSB(bf16_t, WS_R1), WSB(float, WS_SS1)};
#ifndef NO_G4
            pg8::gemm_phase<EpiSwiGLU, pg8::StaticOrder, true, true>(ldsl, g, S, E);
#endif
        }
        GSYNC();
        REPEAT(REP_DN) {
            PHASE_VARS
            pg8::Gemm g{WSB(bf16_t, WS_R1), WSB(bf16_t, WS_WD), M_, DM, DFF}; pg8::StaticOrder S; S.init(M_, DM, G, bid);
            float* o = OUTP; EpiResid E{o, o, WSB(bf16_t, WS_XN), WSB(float, WS_SS0), l == 0 ? 1 : 0};
#ifndef NO_G3
            pg8::gemm_phase<EpiResid, pg8::StaticOrder, true, true>(ldsl, g, S, E);
#endif
        }
        if (ll + 1 < 2 * REP_ALL) GSYNC();
    }
}

extern "C" void kernel_launch(void* const* d_in, const int* in_sizes, int n_in, void* d_out, int out_size, void* d_ws, size_t ws_size, hipStream_t stream) {
    static int grid_blocks = 0;
    if (grid_blocks == 0) {
        if (n_in != 16 || out_size != M_ * DM || ws_size < WS_END) { fprintf(stderr, "kernel_launch: unexpected shapes (n_in %d out %d ws %zu)\n", n_in, out_size, ws_size); grid_blocks = -1; return; }
        int dev = 0, cus = 0, per_cu = 0;
        hipGetDevice(&dev);
        hipDeviceGetAttribute(&cus, hipDeviceAttributeMultiprocessorCount, dev);
        hipFuncSetAttribute((const void*)fwd_kernel, hipFuncAttributeMaxDynamicSharedMemorySize, LDS_BYTES);
        if (hipOccupancyMaxActiveBlocksPerMultiprocessor(&per_cu, (const void*)fwd_kernel, 512, LDS_BYTES) != hipSuccess || per_cu < 1) per_cu = 1;
        (void)hipGetLastError();
        grid_blocks = cus;
    }
    if (grid_blocks < 0) return;
    Args a{};
    for (int i = 0; i < 16; ++i) a.in[i] = (const float*)d_in[i];
    a.out = (float*)d_out; a.ws = (unsigned char*)d_ws;
    if (hipMemsetAsync(d_ws, 0, 65536, stream) != hipSuccess) { fprintf(stderr, "kernel_launch: memset failed\n"); return; }
    void* args[] = {&a};
    hipError_t e = hipLaunchCooperativeKernel((const void*)fwd_kernel, dim3(grid_blocks), dim3(512), args, LDS_BYTES, stream);
    if (e != hipSuccess) fprintf(stderr, "cooperative launch failed: %s (grid %d)\n", hipGetErrorString(e), grid_blocks);
}
```

```cpp
#include <hip/hip_runtime.h>
#include <hip/hip_cooperative_groups.h>
#include <cstdio>
#include <cstdint>
namespace pg8 {
#define PG8_LAS __attribute__((address_space(3)))
typedef unsigned short bf16_t;
typedef short bf16x8 __attribute__((ext_vector_type(8)));
typedef float f32x4 __attribute__((ext_vector_type(4)));
typedef unsigned u32x4 __attribute__((ext_vector_type(4)));
constexpr int BM = 256, BK = 64, HALF = 128, HTB = HALF * BK * 2  , STAGE_BYTES = 8 * HTB, NXCD = 8, WGM = 8;

__host__ __device__ __forceinline__ int lds_byte(int r, int c) { const int st = (r >> 4) * 2 + (c >> 5), rr = r & 15, cc = c & 31, ob = rr * 64 + cc * 2; return st * 1024 + (ob ^ (((ob >> 9) & 1) << 5)); }
__host__ __device__ __forceinline__ void stage_rc(int b, int& R, int& C) { const int st = b / 1024, sb = b % 1024, swz = sb ^ (((sb >> 9) & 1) << 5); R = (st >> 1) * 16 + swz / 64; C = (st & 1) * 32 + (swz % 64) / 2; }
__host__ __device__ __forceinline__ int perm32(int rho) { const int n = rho >> 4, i = rho & 15; return 8 * (i >> 2) + 4 * n + (i & 3); }

struct Unit { int pm, pn; };
struct Gemm { const bf16_t* A; const bf16_t* Bt; int M, N, K; };

struct StaticOrder {
    int nM, nN, nwg, G, c;
    __host__ __device__ void init(int M, int N, int G_, int c_) { nM = M / BM; nN = N / BM; nwg = nM * nN; G = G_; c = c_; }
    __host__ __device__ bool next(int i, Unit& u) const {
        const long L = (long)i * G + c; if (L >= nwg) return false;
        int wgid = (int)L; { const int q = nwg / NXCD, r = nwg % NXCD, xcd = wgid % NXCD, off = wgid / NXCD; wgid = (xcd < r ? xcd * (q + 1) : r * (q + 1) + (xcd - r) * q) + off; }
        const int nig = WGM * nN, gid = wgid / nig, fm = gid * WGM, gsz = (nM - fm) < WGM ? (nM - fm) : WGM;
        u.pm = fm + ((wgid % nig) % gsz); u.pn = (wgid % nig) / gsz; return true;
    }
    __device__ __forceinline__ void a_ready(const Unit&) const {}
    __device__ __forceinline__ void done(const Unit&) const {}
};

__device__ __forceinline__ unsigned cvt_pk_bf16(float lo, float hi) { unsigned r; asm volatile("v_cvt_pk_bf16_f32 %0, %1, %2" : "=v"(r) : "v"(lo), "v"(hi)); return r; }
template <class Epi, class Sched, bool ALIGN_EPI = false, bool SP2 = false>
__device__ __forceinline__ void gemm_phase(PG8_LAS unsigned char* lds, const Gemm g, const Sched& S, const Epi& E) {
    int tid_ = threadIdx.x; asm volatile("" : "+v"(tid_)); const int tid = tid_, wid = __builtin_amdgcn_readfirstlane(tid >> 6), lane = tid & 63, wr = wid >> 2, wc = wid & 3, fr = lane & 15, fq = lane >> 4;
    const int K = g.K, nt = K / BK;
    unsigned voffA[2], voffB[2];
#pragma unroll
    for (int i = 0; i < 2; ++i) { int R, C; stage_rc(tid * 16 + i * 8192, R, C); const int Rb = Epi::PERM ? ((R & ~31) + perm32(R & 31)) : R;
        voffA[i] = (unsigned)(R * K + C) * 2u; voffB[i] = (unsigned)(Rb * K + C) * 2u; }
    const size_t kstep = (size_t)(BK * 2);
    const size_t hstep = (size_t)HALF * K * 2;
    const size_t tstep = 2 * hstep;
    const unsigned ldsw = (unsigned)wid * 1024u;
    const int aoff = lds_byte(wr * 64 + fr, fq * 8), boff = lds_byte(wc * 32 + fr, fq * 8);
#define PG8_SA(b, h) (((b) * 2 + (h)) * HTB)
#define PG8_SB(b, h) ((4 + (b) * 2 + (h)) * HTB)
#define PG8_STAGE(bufoff, gbase, voff) do { _Pragma("unroll") for (int _i = 0; _i < 2; ++_i) \
        __builtin_amdgcn_global_load_lds((const unsigned*)((const char*)(gbase) + (voff)[_i]), (PG8_LAS unsigned*)(lds + (bufoff) + ldsw + _i * 8192), 16, 0, 0); } while (0)
#define PG8_LDA(dst, b, h) do { _Pragma("unroll") for (int m = 0; m < 4; ++m) _Pragma("unroll") for (int k = 0; k < 2; ++k) dst[m][k] = *(const PG8_LAS bf16x8*)(lds + PG8_SA(b, h) + aoff + m * 2048 + k * 1024); } while (0)
#define PG8_LDB(dst, b, h) do { _Pragma("unroll") for (int n = 0; n < 2; ++n) _Pragma("unroll") for (int k = 0; k < 2; ++k) dst[n][k] = *(const PG8_LAS bf16x8*)(lds + PG8_SB(b, h) + boff + n * 2048 + k * 1024); } while (0)
#define PG8_MMA(ai, bj, At, Bt) do { __builtin_amdgcn_s_setprio(1); _Pragma("unroll") for (int m = 0; m < 4; ++m) _Pragma("unroll") for (int n = 0; n < 2; ++n) _Pragma("unroll") for (int k = 0; k < 2; ++k) \
        acc[ai][bj][m][n] = __builtin_amdgcn_mfma_f32_16x16x32_bf16(Bt[n][k], At[m][k], acc[ai][bj][m][n], 0, 0, 0); __builtin_amdgcn_s_setprio(0); } while (0)
#define PG8_WAIT_V(n) asm volatile("s_waitcnt vmcnt(" #n ")" ::: "memory")
#define PG8_WAIT_L(n) asm volatile("s_waitcnt lgkmcnt(" #n ")" ::: "memory")
#define PG8_BAR __builtin_amdgcn_s_barrier()
#define PG8_SCHED __builtin_amdgcn_sched_barrier(0)
    Unit cur, nxt; int ui = 0;
    if (!S.next(0, cur)) return;
    f32x4 acc[2][2][4][2];
#pragma unroll
    for (int a = 0; a < 2; ++a)
#pragma unroll
        for (int b = 0; b < 2; ++b)
#pragma unroll
            for (int m = 0; m < 4; ++m)
#pragma unroll
                for (int n = 0; n < 2; ++n) acc[a][b][m][n] = (f32x4){0.f, 0.f, 0.f, 0.f};
    bf16x8 At[4][2], B0[2][2], B1[2][2];
    const char* cA = (const char*)g.A + (size_t)cur.pm * tstep; const char* cB = (const char*)g.Bt + (size_t)cur.pn * tstep;
    S.a_ready(cur);
    if constexpr (SP2) {
        PG8_STAGE(PG8_SB(0, 0), cB, voffB); PG8_STAGE(PG8_SB(0, 1), cB + hstep, voffB); PG8_STAGE(PG8_SA(0, 0), cA, voffA); PG8_STAGE(PG8_SA(0, 1), cA + hstep, voffA);
        if (wr == 1) PG8_BAR;
        PG8_WAIT_V(2); PG8_BAR;
        PG8_STAGE(PG8_SB(1, 0), cB + kstep, voffB); PG8_STAGE(PG8_SA(1, 0), cA + kstep, voffA); PG8_STAGE(PG8_SB(1, 1), cB + hstep + kstep, voffB);
        PG8_WAIT_V(6); PG8_BAR;
    } else {
        PG8_STAGE(PG8_SB(0, 0), cB, voffB); PG8_STAGE(PG8_SA(0, 0), cA, voffA); PG8_STAGE(PG8_SB(0, 1), cB + hstep, voffB); PG8_STAGE(PG8_SA(0, 1), cA + hstep, voffA);
        if (wr == 1) PG8_BAR;
        PG8_WAIT_V(4); PG8_BAR;
        PG8_STAGE(PG8_SB(1, 0), cB + kstep, voffB); PG8_STAGE(PG8_SA(1, 0), cA + kstep, voffA); PG8_STAGE(PG8_SB(1, 1), cB + hstep + kstep, voffB);
        PG8_WAIT_V(6); PG8_BAR;
    }
    for (;;) {
        const bool has_next = S.next(ui + 1, nxt);
        const char* nA = has_next ? (const char*)g.A + (size_t)nxt.pm * tstep : cA; const char* nB = has_next ? (const char*)g.Bt + (size_t)nxt.pn * tstep : cB;
        for (int t = 0; t < nt; t += 2) {
            if constexpr (Epi::HOOK) { if (t != 0 && (t & 3) == 0) E.hook(acc, cur, (t >> 2) - 1, wr, wc, fr, fq); }
            const bool last = (t == nt - 2);
            const char* a1 = cA + (size_t)(t + 1) * kstep;
            const char* a2 = last ? nA : cA + (size_t)(t + 2) * kstep; const char* b2 = last ? nB : cB + (size_t)(t + 2) * kstep;
            const char* a3 = a2 + kstep; const char* b3 = b2 + kstep;
            if (last && has_next) S.a_ready(nxt);
            if constexpr (SP2) {
            PG8_LDB(B0, 0, 0); PG8_LDB(B1, 0, 1); PG8_SCHED; PG8_LDA(At, 0, 0); PG8_STAGE(PG8_SA(1, 1), a1 + hstep, voffA);
            PG8_WAIT_V(8); PG8_WAIT_L(0); PG8_BAR; PG8_MMA(0, 0, At, B0); PG8_MMA(0, 1, At, B1); PG8_BAR; PG8_SCHED;
            PG8_LDA(At, 0, 1); PG8_STAGE(PG8_SB(0, 0), b2, voffB); PG8_STAGE(PG8_SB(0, 1), b2 + hstep, voffB); PG8_STAGE(PG8_SA(0, 0), a2, voffA);
            PG8_WAIT_V(8); PG8_WAIT_L(0); PG8_BAR; PG8_MMA(1, 0, At, B0); PG8_MMA(1, 1, At, B1); PG8_BAR; PG8_SCHED;
            PG8_LDB(B0, 1, 0); PG8_LDB(B1, 1, 1); PG8_SCHED; PG8_LDA(At, 1, 0); PG8_STAGE(PG8_SA(0, 1), a2 + hstep, voffA);
            PG8_WAIT_V(8); PG8_WAIT_L(0); PG8_BAR; PG8_MMA(0, 0, At, B0); PG8_MMA(0, 1, At, B1); PG8_BAR; PG8_SCHED;
            PG8_LDA(At, 1, 1); PG8_STAGE(PG8_SB(1, 0), b3, voffB); PG8_STAGE(PG8_SB(1, 1), b3 + hstep, voffB); PG8_STAGE(PG8_SA(1, 0), a3, voffA);
            PG8_WAIT_V(8); PG8_WAIT_L(0); PG8_BAR; PG8_MMA(1, 0, At, B0); PG8_MMA(1, 1, At, B1); PG8_BAR; PG8_SCHED;
            } else {
            PG8_LDB(B0, 0, 0); PG8_SCHED; PG8_LDA(At, 0, 0); PG8_STAGE(PG8_SA(1, 1), a1 + hstep, voffA);
            PG8_WAIT_L(8); PG8_BAR; PG8_WAIT_L(0); PG8_MMA(0, 0, At, B0); PG8_BAR; PG8_SCHED;
            PG8_LDB(B1, 0, 1); PG8_STAGE(PG8_SB(0, 0), b2, voffB);
            PG8_BAR; PG8_WAIT_L(0); PG8_MMA(0, 1, At, B1); PG8_BAR;
            PG8_LDA(At, 0, 1); PG8_STAGE(PG8_SA(0, 0), a2, voffA);
            PG8_BAR; PG8_WAIT_L(0); PG8_MMA(1, 0, At, B0); PG8_BAR; PG8_SCHED;
            PG8_STAGE(PG8_SB(0, 1), b2 + hstep, voffB);
            PG8_WAIT_V(6); PG8_BAR; PG8_MMA(1, 1, At, B1); PG8_BAR;
            PG8_LDB(B0, 1, 0); PG8_SCHED; PG8_LDA(At, 1, 0); PG8_STAGE(PG8_SA(0, 1), a2 + hstep, voffA);
            PG8_WAIT_L(8); PG8_BAR; PG8_WAIT_L(0); PG8_MMA(0, 0, At, B0); PG8_BAR; PG8_SCHED;
            PG8_LDB(B1, 1, 1); PG8_STAGE(PG8_SB(1, 0), b3, voffB);
            PG8_BAR; PG8_WAIT_L(0); PG8_MMA(0, 1, At, B1); PG8_BAR;
            PG8_LDA(At, 1, 1); PG8_STAGE(PG8_SA(1, 0), a3, voffA);
            PG8_BAR; PG8_WAIT_L(0); PG8_MMA(1, 0, At, B0); PG8_BAR; PG8_SCHED;
            PG8_STAGE(PG8_SB(1, 1), b3 + hstep, voffB);
            PG8_WAIT_V(6); PG8_BAR; PG8_MMA(1, 1, At, B1); PG8_BAR;
            }
        }
        if constexpr (ALIGN_EPI) { if (wr == 0) PG8_BAR; }
        if constexpr (!Epi::AFTER_DRAIN) { E(acc, cur, wr, wc, fr, fq); if constexpr (Epi::EPI_TWICE) { E(acc, cur, wr, wc, fr, fq); } S.done(cur); }
        if (!has_next) break;
#pragma unroll
        for (int a = 0; a < 2; ++a)
#pragma unroll
            for (int b = 0; b < 2; ++b)
#pragma unroll
                for (int m = 0; m < 4; ++m)
#pragma unroll
                    for (int n = 0; n < 2; ++n) acc[a][b][m][n] = (f32x4){0.f, 0.f, 0.f, 0.f};
        cur = nxt; cA = nA; cB = nB; ++ui;
        if constexpr (ALIGN_EPI) { if (wr == 1) PG8_BAR; }
    }
    PG8_WAIT_V(0);
    if constexpr (!ALIGN_EPI) { if (wr == 0) PG8_BAR; }
    PG8_BAR;
    if constexpr (Epi::AFTER_DRAIN) { E.fused(acc, cur, wr, wc, fr, fq, lds, wid, lane); S.done(cur); }
#undef PG8_SA
#undef PG8_SB
#undef PG8_STAGE
#undef PG8_LDA
#undef PG8_LDB
#undef PG8_MMA
#undef PG8_WAIT_V
#undef PG8_WAIT_L
#undef PG8_BAR
#undef PG8_SCHED
}
}
namespace cg = cooperative_groups;
using pg8::bf16_t; using pg8::bf16x8; using pg8::f32x4; using pg8::u32x4; using pg8::Unit; using pg8::cvt_pk_bf16;
typedef unsigned u32x2 __attribute__((ext_vector_type(2)));
#define LAS __attribute__((address_space(3)))
#define LDS_WAIT() asm volatile("s_waitcnt lgkmcnt(0)" ::: "memory")

constexpr int M_ = 16384, DM = 1024, SEQ = 4096, DFF = 2816, DIN = 6696, NINP = 6912;
constexpr float EPSN = 1e-6f;
constexpr float LOG2E = 1.4426950408889634f, LN2 = 0.6931471805599453f;
constexpr float C2 = 0.125f * LOG2E;

constexpr size_t MiB = (size_t)1 << 20;
constexpr size_t WS_SS0 = 128 * 1024, WS_SS1 = 256 * 1024;
constexpr size_t WS_WIN = 1 * MiB;
constexpr size_t WS_WB = WS_WIN + (size_t)NINP * 1024 * 2;
constexpr size_t WS_WOUT = WS_WB + 2 * MiB;
constexpr size_t WS_WGU = WS_WOUT + 2 * MiB;
constexpr size_t WS_WD = WS_WGU + 11 * MiB;
constexpr size_t WS_WP = WS_WD + (size_t)1024 * 2816 * 2;
constexpr size_t WS_WS = WS_WP + 32768;
static_assert(WS_WS + 131072 <= 36 * MiB, "weights region");
constexpr size_t WS_XN = 36 * MiB;
constexpr size_t WS_R1 = 68 * MiB;
constexpr size_t WS_G = WS_R1, WS_KA = WS_R1 + 64 * MiB, WS_VTA = WS_KA + 8 * MiB, WS_IQ = WS_VTA + 8 * MiB;
constexpr size_t WS_S = 156 * MiB;
constexpr size_t WS_PIN = WS_S, WS_GU = WS_S + 8 * MiB, WS_GV = WS_S + 16 * MiB, WS_SQ = WS_S + 24 * MiB, WS_SK = WS_S + 32 * MiB,
                 WS_VTS = WS_S + 40 * MiB, WS_QA = WS_S + 48 * MiB, WS_MASK = WS_S + 56 * MiB, WS_IK = 220 * MiB, WS_IW = 221 * MiB, WS_OCAT = 222 * MiB  , WS_END = 254 * MiB;

__device__ __forceinline__ float bf2f(unsigned short v) { return __uint_as_float((unsigned)v << 16); }
__device__ __forceinline__ float bflo(unsigned v) { return __uint_as_float(v << 16); }
__device__ __forceinline__ float bfhi(unsigned v) { return __uint_as_float(v & 0xffff0000u); }
__device__ __forceinline__ unsigned short f2bf(float f) { return (unsigned short)(cvt_pk_bf16(f, 0.f) & 0xffffu); }
__device__ __forceinline__ float relu1(float x) { const int b = __float_as_int(x); return __int_as_float(b > 0 ? b : 0); }
__device__ __forceinline__ float sigmoidf_(float x) { return __builtin_amdgcn_rcpf(1.f + __builtin_amdgcn_exp2f(-x * LOG2E)); }
__device__ __forceinline__ float gelu_tanh(float x) { const float u = 0.7978845608028654f * (x + 0.044715f * x * x * x); return x * __builtin_amdgcn_rcpf(1.f + __builtin_amdgcn_exp2f(-2.f * LOG2E * u)); }
__device__ __forceinline__ f32x4 mfma16(bf16x8 a, bf16x8 b, f32x4 c) { return __builtin_amdgcn_mfma_f32_16x16x32_bf16(a, b, c, 0, 0, 0); }
__device__ __forceinline__ bf16x8 mk8(unsigned a, unsigned b, unsigned c, unsigned d) { u32x4 v = {a, b, c, d}; return __builtin_bit_cast(bf16x8, v); }

struct EpiIn {
    static constexpr bool PERM = true, AFTER_DRAIN = false, HOOK = false;
#ifdef PROBE_EPI_IN
    static constexpr bool EPI_TWICE = true;
#else
    static constexpr bool EPI_TWICE = false;
#endif
    unsigned char* ws; const float *qn, *kn; const float* SS;
    __device__ __forceinline__ void operator()(const f32x4 (&acc)[2][2][4][2], const Unit& u, int wr, int wc, int fr, int fq) const {
        bf16_t* const QA = (bf16_t*)(ws + WS_QA); bf16_t* const KA = (bf16_t*)(ws + WS_KA); bf16_t* const VTA = (bf16_t*)(ws + WS_VTA); bf16_t* const IQ = (bf16_t*)(ws + WS_IQ);
        bf16_t* const PIN = (bf16_t*)(ws + WS_PIN); bf16_t* const GU = (bf16_t*)(ws + WS_GU); bf16_t* const GV = (bf16_t*)(ws + WS_GV); bf16_t* const SQ = (bf16_t*)(ws + WS_SQ);
        bf16_t* const SK = (bf16_t*)(ws + WS_SK); bf16_t* const VTS = (bf16_t*)(ws + WS_VTS); bf16_t* const IK = (bf16_t*)(ws + WS_IK); float* const IW = (float*)(ws + WS_IW); unsigned char* const G = ws + WS_G;
        const int pn = u.pn; const int row0 = u.pm * 256 + wr * 64 + fr; const int cl = wc * 32 + 8 * fq;
        float rr[2][4];
#pragma unroll
        for (int ai = 0; ai < 2; ++ai)
#pragma unroll
            for (int m = 0; m < 4; ++m) rr[ai][m] = __builtin_amdgcn_rsqf(SS[row0 + ai * 128 + m * 16] * (1.f / 1024.f) + EPSN);
        if (pn >= 11) {
            unsigned char* gp = G + (size_t)row0 * 4096 + (pn - 11) * 256 + cl;
#pragma unroll
            for (int ai = 0; ai < 2; ++ai)
#pragma unroll
                for (int m = 0; m < 4; ++m)
#pragma unroll
                    for (int bj = 0; bj < 2; ++bj) {
                        unsigned w2[2];
#pragma unroll
                        for (int n = 0; n < 2; ++n) { const f32x4 v = (acc[ai][bj][m][n] * rr[ai][m]); unsigned pk = 0;
#pragma unroll
                            for (int i = 0; i < 4; ++i) { const unsigned qv = (unsigned)(sigmoidf_(v[i]) * 255.f + 0.5f); pk |= qv << (8 * i); }
                            w2[n] = pk; }
                        *(u32x2*)(gp + (size_t)(ai * 128 + m * 16) * 4096 + bj * 128) = (u32x2){w2[0], w2[1]};
                    }
            return;
        }
        if (pn <= 1) {
            const float* gw = pn == 0 ? qn : kn; const float sc = pn == 0 ? C2 : 1.f; bf16_t* T = pn == 0 ? QA : KA;
            f32x4 gv[2][2];
#pragma unroll
            for (int bj = 0; bj < 2; ++bj)
#pragma unroll
                for (int n = 0; n < 2; ++n) gv[bj][n] = *(const f32x4*)(gw + bj * 32 + 8 * fq + 4 * n);
#pragma unroll
            for (int ai = 0; ai < 2; ++ai)
#pragma unroll
                for (int m = 0; m < 4; ++m) {
                    float ss = 0.f;
#pragma unroll
                    for (int bj = 0; bj < 2; ++bj)
#pragma unroll
                        for (int n = 0; n < 2; ++n) { const f32x4 v = (acc[ai][bj][m][n] * rr[ai][m]); ss += (v[0] * v[0] + v[1] * v[1]) + (v[2] * v[2] + v[3] * v[3]); }
                    ss += __shfl_xor(ss, 16); ss += __shfl_xor(ss, 32);
                    const float rinv = __builtin_amdgcn_rsqf(ss * (1.f / 64.f) + EPSN) * sc;
                    bf16_t* rp = T + (size_t)(row0 + ai * 128 + m * 16) * 256 + wc * 64 + 8 * fq;
#pragma unroll
                    for (int bj = 0; bj < 2; ++bj) { const f32x4 v0 = (acc[ai][bj][m][0] * rr[ai][m]) * gv[bj][0] * rinv, v1 = (acc[ai][bj][m][1] * rr[ai][m]) * gv[bj][1] * rinv;
                        u32x4 w; w.x = cvt_pk_bf16(v0[0], v0[1]); w.y = cvt_pk_bf16(v0[2], v0[3]); w.z = cvt_pk_bf16(v1[0], v1[1]); w.w = cvt_pk_bf16(v1[2], v1[3]);
                        *(u32x4*)(rp + bj * 32) = w; }
                }
            return;
        }
        if (pn == 2 || pn == 9) {
            bf16_t* T = pn == 2 ? VTA : VTS;
#pragma unroll
            for (int ai = 0; ai < 2; ++ai)
#pragma unroll
                for (int m = 0; m < 4; ++m) { const int row = row0 + ai * 128 + m * 16; const int b = row >> 12, t = row & 4095;
#pragma unroll
                    for (int bj = 0; bj < 2; ++bj)
#pragma unroll
                        for (int n = 0; n < 2; ++n) { const f32x4 v = (acc[ai][bj][m][n] * rr[ai][m]);
#pragma unroll
                            for (int i = 0; i < 4; ++i) T[((size_t)b * 256 + bj * 128 + cl + 4 * n + i) * 4096 + t] = f2bf(v[i]); }
                }
            return;
        }
        if (pn == 10) {
            if (wc == 0) {
#pragma unroll
                for (int ai = 0; ai < 2; ++ai)
#pragma unroll
                    for (int m = 0; m < 4; ++m) { const f32x4 v0 = (acc[ai][0][m][0] * rr[ai][m]), v1 = (acc[ai][0][m][1] * rr[ai][m]);
                        u32x4 w; w.x = cvt_pk_bf16(v0[0], v0[1]); w.y = cvt_pk_bf16(v0[2], v0[3]); w.z = cvt_pk_bf16(v1[0], v1[1]); w.w = cvt_pk_bf16(v1[2], v1[3]);
                        *(u32x4*)(IK + (size_t)(row0 + ai * 128 + m * 16) * 32 + 8 * fq) = w; }
            } else if (wc == 1 && fq == 0) {
#pragma unroll
                for (int ai = 0; ai < 2; ++ai)
#pragma unroll
                    for (int m = 0; m < 4; ++m) { float* p = IW + (size_t)(row0 + ai * 128 + m * 16) * 8; *(f32x4*)p = (acc[ai][0][m][0] * rr[ai][m]); *(f32x4*)(p + 4) = (acc[ai][0][m][1] * rr[ai][m]); }
            }
            return;
        }
        {
            bf16_t* T = pn == 3 ? IQ : pn == 4 ? PIN : pn == 5 ? GU : pn == 6 ? GV : pn == 7 ? SQ : SK;
            const bool act = (pn == 5 || pn == 6); const float sc = pn == 7 ? 0.125f : 1.f;
#pragma unroll
            for (int ai = 0; ai < 2; ++ai)
#pragma unroll
                for (int m = 0; m < 4; ++m) { bf16_t* rp = T + (size_t)(row0 + ai * 128 + m * 16) * 256 + cl;
#pragma unroll
                    for (int bj = 0; bj < 2; ++bj) { f32x4 v0 = (acc[ai][bj][m][0] * rr[ai][m]) * sc, v1 = (acc[ai][bj][m][1] * rr[ai][m]) * sc;
                        if (act) {
#pragma unroll
                            for (int i = 0; i < 4; ++i) { v0[i] = gelu_tanh(v0[i]); v1[i] = gelu_tanh(v1[i]); } }
                        u32x4 w; w.x = cvt_pk_bf16(v0[0], v0[1]); w.y = cvt_pk_bf16(v0[2], v0[3]); w.z = cvt_pk_bf16(v1[0], v1[1]); w.w = cvt_pk_bf16(v1[2], v1[3]);
                        *(u32x4*)(rp + bj * 128) = w; }
                }
        }
    }
};

struct EpiMerge {
    static constexpr bool PERM = true, AFTER_DRAIN = false, HOOK = true, EPI_TWICE = false;
    const unsigned char* G; bf16_t* MG;
    __device__ __forceinline__ void hook(f32x4 (&acc)[2][2][4][2], const Unit& u, int s, int wr, int wc, int fr, int fq) const {
        const int row0 = u.pm * 256 + wr * 64 + fr; const int col0 = u.pn * 256 + wc * 32 + 8 * fq;
        const unsigned char* gp0 = G + (size_t)row0 * 4096 + s * 1024 + col0;
        u32x2 ga[2][4][2], gb[2][4][2];
#pragma unroll
        for (int ai = 0; ai < 2; ++ai)
#pragma unroll
            for (int m = 0; m < 4; ++m)
#pragma unroll
                for (int bj = 0; bj < 2; ++bj) { const unsigned char* gp = gp0 + (size_t)(ai * 128 + m * 16) * 4096 + bj * 128; ga[ai][m][bj] = *(const u32x2*)gp; gb[ai][m][bj] = *(const u32x2*)(gp + 1024); }
#pragma unroll
        for (int ai = 0; ai < 2; ++ai)
#pragma unroll
            for (int m = 0; m < 4; ++m)
#pragma unroll
                for (int bj = 0; bj < 2; ++bj)
#pragma unroll
                    for (int i = 0; i < 4; ++i) {
                        const float a0 = fmaxf((float)((ga[ai][m][bj].x >> (8 * i)) & 255u), 1.f), b0 = fmaxf((float)((gb[ai][m][bj].x >> (8 * i)) & 255u), 1.f);
                        const float a1 = fmaxf((float)((ga[ai][m][bj].y >> (8 * i)) & 255u), 1.f), b1 = fmaxf((float)((gb[ai][m][bj].y >> (8 * i)) & 255u), 1.f);
                        acc[ai][bj][m][0][i] *= a0 * __builtin_amdgcn_rcpf(b0); acc[ai][bj][m][1][i] *= a1 * __builtin_amdgcn_rcpf(b1); }
    }
    __device__ __forceinline__ void operator()(const f32x4 (&acc)[2][2][4][2], const Unit& u, int wr, int wc, int fr, int fq) const {
        const int row0 = u.pm * 256 + wr * 64 + fr; const int col0 = u.pn * 256 + wc * 32 + 8 * fq;
        const unsigned char* gp0 = G + (size_t)row0 * 4096 + 3 * 1024 + col0; bf16_t* mp0 = MG + (size_t)row0 * 1024 + col0;
        u32x2 gb[2][4][2];
#pragma unroll
        for (int ai = 0; ai < 2; ++ai)
#pragma unroll
            for (int m = 0; m < 4; ++m)
#pragma unroll
                for (int bj = 0; bj < 2; ++bj) gb[ai][m][bj] = *(const u32x2*)(gp0 + (size_t)(ai * 128 + m * 16) * 4096 + bj * 128);
#pragma unroll
        for (int ai = 0; ai < 2; ++ai)
#pragma unroll
            for (int m = 0; m < 4; ++m)
#pragma unroll
                for (int bj = 0; bj < 2; ++bj) { const size_t ro = (size_t)(ai * 128 + m * 16); const u32x2 g2 = gb[ai][m][bj];
                    f32x4 v0 = acc[ai][bj][m][0], v1 = acc[ai][bj][m][1];
#pragma unroll
                    for (int i = 0; i < 4; ++i) { v0[i] *= fmaxf((float)((g2.x >> (8 * i)) & 255u), 1.f) * (1.f / 255.f); v1[i] *= fmaxf((float)((g2.y >> (8 * i)) & 255u), 1.f) * (1.f / 255.f); }
                    u32x4 w; w.x = cvt_pk_bf16(v0[0], v0[1]); w.y = cvt_pk_bf16(v0[2], v0[3]); w.z = cvt_pk_bf16(v1[0], v1[1]); w.w = cvt_pk_bf16(v1[2], v1[3]);
                    *(u32x4*)(mp0 + ro * 1024 + bj * 128) = w; }
    }
};

struct EpiResid {
    static constexpr bool PERM = true, AFTER_DRAIN = false, HOOK = false, EPI_TWICE = false;
    const float* base; float* out; bf16_t* XB; float* SS; int stat;
    __device__ __forceinline__ void operator()(const f32x4 (&acc)[2][2][4][2], const Unit& u, int wr, int wc, int fr, int fq) const {
        const int row0 = u.pm * 256 + wr * 64 + fr; const int col0 = u.pn * 256 + wc * 32 + 8 * fq;
#pragma unroll
        for (int ai = 0; ai < 2; ++ai) {
            f32x4 pre[4][2][2];
#pragma unroll
            for (int m = 0; m < 4; ++m) { const size_t off = (size_t)(row0 + ai * 128 + m * 16) * 1024 + col0;
#pragma unroll
                for (int bj = 0; bj < 2; ++bj) { pre[m][bj][0] = *(const f32x4*)(base + off + bj * 128); pre[m][bj][1] = *(const f32x4*)(base + off + bj * 128 + 4); } }
#pragma unroll
            for (int m = 0; m < 4; ++m) { const int row = row0 + ai * 128 + m * 16; const size_t off = (size_t)row * 1024 + col0; float ssum = 0.f;
#pragma unroll
                for (int bj = 0; bj < 2; ++bj) {
                    const f32x4 o0 = pre[m][bj][0] + acc[ai][bj][m][0], o1 = pre[m][bj][1] + acc[ai][bj][m][1];
                    *(f32x4*)(out + off + bj * 128) = o0; *(f32x4*)(out + off + bj * 128 + 4) = o1;
                    if (stat) { u32x4 w; w.x = cvt_pk_bf16(o0[0], o0[1]); w.y = cvt_pk_bf16(o0[2], o0[3]); w.z = cvt_pk_bf16(o1[0], o1[1]); w.w = cvt_pk_bf16(o1[2], o1[3]);
                        *(u32x4*)(XB + off + bj * 128) = w;
                        ssum += ((o0[0] * o0[0] + o0[1] * o0[1]) + (o0[2] * o0[2] + o0[3] * o0[3])) + ((o1[0] * o1[0] + o1[1] * o1[1]) + (o1[2] * o1[2] + o1[3] * o1[3])); } }
                if (stat) { ssum += __shfl_xor(ssum, 16); ssum += __shfl_xor(ssum, 32); if (fq == 0) atomicAdd(SS + row, ssum); } }
            asm volatile("" ::: "memory");
        }
    }
};

struct EpiSwiGLU {
    static constexpr bool PERM = true, AFTER_DRAIN = false, HOOK = false, EPI_TWICE = false;
    bf16_t* ACT; const float* SS;
    __device__ __forceinline__ void operator()(const f32x4 (&acc)[2][2][4][2], const Unit& u, int wr, int wc, int fr, int fq) const {
        const int row0 = u.pm * 256 + wr * 64 + fr; const int f0 = u.pn * 128 + wc * 32 + 8 * fq;
        float rr[2][4];
#pragma unroll
        for (int ai = 0; ai < 2; ++ai)
#pragma unroll
            for (int m = 0; m < 4; ++m) rr[ai][m] = SS[row0 + ai * 128 + m * 16];
#pragma unroll
        for (int ai = 0; ai < 2; ++ai)
#pragma unroll
            for (int m = 0; m < 4; ++m) { f32x4 r[2]; const float rs = __builtin_amdgcn_rsqf(rr[ai][m] * (1.f / 1024.f) + EPSN);
#pragma unroll
                for (int n = 0; n < 2; ++n) { const f32x4 g = acc[ai][0][m][n] * rs, up = acc[ai][1][m][n] * rs;
#pragma unroll
                    for (int i = 0; i < 4; ++i) r[n][i] = g[i] * sigmoidf_(g[i]) * up[i]; }
                u32x4 w; w.x = cvt_pk_bf16(r[0][0], r[0][1]); w.y = cvt_pk_bf16(r[0][2], r[0][3]); w.z = cvt_pk_bf16(r[1][0], r[1][1]); w.w = cvt_pk_bf16(r[1][2], r[1][3]);
                *(u32x4*)(ACT + (size_t)(row0 + ai * 128 + m * 16) * DFF + f0) = w; }
    }
};

__device__ __forceinline__ void cvt_item(const float* src, int ld, int col0, int nvalid, int K, bf16_t* WT, int dst_row0, int kb, LAS float* scr, int lane, const float* rs = nullptr) {
    const int k0 = 64 * kb, c = lane & 31;
    float vv[32];
#pragma unroll
    for (int i = 0; i < 32; ++i) { const int kk = 2 * i + (lane >> 5); vv[i] = (c < nvalid) ? src[(size_t)(k0 + kk) * ld + col0 + c] : 0.f; }
    if (rs) {
#pragma unroll
        for (int i = 0; i < 32; ++i) vv[i] *= rs[k0 + 2 * i + (lane >> 5)];
    }
#pragma unroll
    for (int i = 0; i < 32; ++i) scr[(2 * i + (lane >> 5)) * 33 + c] = vv[i];
    LDS_WAIT();
    const int c8 = lane & 7;
#pragma unroll
    for (int j = 0; j < 4; ++j) { const int n = (lane >> 3) + 8 * j; const LAS float* s = scr + (8 * c8) * 33 + n;
        u32x4 o; o.x = cvt_pk_bf16(s[0 * 33], s[1 * 33]); o.y = cvt_pk_bf16(s[2 * 33], s[3 * 33]); o.z = cvt_pk_bf16(s[4 * 33], s[5 * 33]); o.w = cvt_pk_bf16(s[6 * 33], s[7 * 33]);
        *(u32x4*)(WT + (size_t)(dst_row0 + n) * K + k0 + 8 * c8) = o; }
    LDS_WAIT();
}
__device__ __forceinline__ float wave_sum(float v) {
#pragma unroll
    for (int o = 1; o < 64; o <<= 1) v += __shfl_xor(v, o);
    return v;
}
__device__ __forceinline__ float wave_max(float v) {
#pragma unroll
    for (int o = 1; o < 64; o <<= 1) v = fmaxf(v, __shfl_xor(v, o));
    return v;
}
__device__ __forceinline__ void rmsnorm_rows(const float* xs, const float* gamma, bf16_t* XN, int gw, int ngw, int lane) {
    f32x4 gm[4];
#pragma unroll
    for (int j = 0; j < 4; ++j) gm[j] = *(const f32x4*)(gamma + 4 * lane + 256 * j);
    for (int m = gw; m < M_; m += ngw) {
        const f32x4* xr = (const f32x4*)(xs + (size_t)m * DM) + lane; f32x4 v[4]; float s = 0.f;
#pragma unroll
        for (int j = 0; j < 4; ++j) { v[j] = xr[64 * j]; s += (v[j].x * v[j].x + v[j].y * v[j].y) + (v[j].z * v[j].z + v[j].w * v[j].w); }
        const float r = __builtin_amdgcn_rsqf(wave_sum(s) * (1.f / DM) + EPSN);
        u32x2* o8 = (u32x2*)(XN + (size_t)m * DM) + lane;
#pragma unroll
        for (int j = 0; j < 4; ++j) { const f32x4 y = v[j] * r * gm[j]; o8[64 * j] = (u32x2){cvt_pk_bf16(y.x, y.y), cvt_pk_bf16(y.z, y.w)}; }
    }
}

__device__ __forceinline__ void x_to_bf16_ss(const float* xs, bf16_t* XN, float* SS, int gw, int ngw, int lane) {
    for (int m0 = gw * 4; m0 < M_; m0 += ngw * 4) {
        f32x4 v[4][4];
#pragma unroll
        for (int r = 0; r < 4; ++r) { const f32x4* xr = (const f32x4*)(xs + (size_t)(m0 + r) * DM) + lane;
#pragma unroll
            for (int j = 0; j < 4; ++j) v[r][j] = xr[64 * j]; }
#pragma unroll
        for (int r = 0; r < 4; ++r) { float s = 0.f;
#pragma unroll
            for (int j = 0; j < 4; ++j) s += (v[r][j].x * v[r][j].x + v[r][j].y * v[r][j].y) + (v[r][j].z * v[r][j].z + v[r][j].w * v[r][j].w);
            s = wave_sum(s);
            u32x2* o8 = (u32x2*)(XN + (size_t)(m0 + r) * DM) + lane;
#pragma unroll
            for (int j = 0; j < 4; ++j) o8[64 * j] = (u32x2){cvt_pk_bf16(v[r][j].x, v[r][j].y), cvt_pk_bf16(v[r][j].z, v[r][j].w)};
            if (lane == 0) SS[m0 + r] = s; }
    }
}
struct Ptrs {
    const float *mix_g, *ffn_g, *w_in, *qn, *kn, *pool_w, *pool_scale, *gm_norm, *gm_ws, *gm_b, *w_branch, *w_out, *w_gate, *w_up, *w_down;
};

__device__ __forceinline__ void convert_weights(const Ptrs& P, unsigned char* ws, LAS float* scr, int gw, int ngw, int lane, int gtid, int ngt) {
    bf16_t* WinT = (bf16_t*)(ws + WS_WIN); bf16_t* WbT = (bf16_t*)(ws + WS_WB); bf16_t* WoutT = (bf16_t*)(ws + WS_WOUT); bf16_t* WguT = (bf16_t*)(ws + WS_WGU);
    bf16_t* WdT = (bf16_t*)(ws + WS_WD); bf16_t* WpT = (bf16_t*)(ws + WS_WP); bf16_t* Wtril = (bf16_t*)(ws + WS_WS);
    constexpr int I_A = 216 * 16, I_B = 512, I_C = 512, I_D = 176 * 16, I_E = 32 * 44, I_F = 8, NIT = I_A + I_B + I_C + I_D + I_E + I_F;
    for (int it = gw; it < NIT; it += ngw) {
        int r = it;
        if (r < I_A) { const int rb = r >> 4, kb = r & 15, tile = rb >> 3, sub = rb & 7; int col0, nv = 32;
            if (tile <= 1) col0 = tile * 256 + (sub & 3) * 64 + (sub >> 2) * 32;
            else if (tile == 2) col0 = 512 + sub * 32;
            else if (tile == 3) col0 = 768 + sub * 32;
            else if (tile <= 9) col0 = 1064 + (tile - 4) * 256 + sub * 32;
            else if (tile == 10) { col0 = sub == 0 ? 1024 : 1056; nv = sub == 0 ? 32 : (sub == 1 ? 8 : 0); }
            else col0 = 2600 + (tile - 11) * 256 + sub * 32;
            cvt_item(P.w_in, DIN, col0, nv, 1024, WinT, rb * 32, kb, scr, lane, P.mix_g); continue; }
        r -= I_A;
        if (r < I_B) { const int rb = r >> 4, kb = r & 15; cvt_item(P.w_branch, 1024, rb * 32, 32, 1024, WbT, rb * 32, kb, scr, lane); continue; }
        r -= I_B;
        if (r < I_C) { const int rb = r >> 4, kb = r & 15; cvt_item(P.w_out, 1024, rb * 32, 32, 1024, WoutT, rb * 32, kb, scr, lane); continue; }
        r -= I_C;
        if (r < I_D) { const int rb = r >> 4, kb = r & 15, tile = rb >> 3, sub = rb & 7;
            cvt_item((sub >> 2) ? P.w_up : P.w_gate, DFF, tile * 128 + (sub & 3) * 32, 32, 1024, WguT, rb * 32, kb, scr, lane, P.ffn_g); continue; }
        r -= I_D;
        if (r < I_E) { const int rb = r / 44, kb = r % 44; cvt_item(P.w_down, 1024, rb * 32, 32, DFF, WdT, rb * 32, kb, scr, lane); continue; }
        r -= I_E;
        { const int gp = r >> 1, rb = r & 1; cvt_item(P.pool_w + gp * 4096, 64, rb * 32, 32, 64, WpT + gp * 4096, rb * 32, 0, scr, lane); }
    }
    for (int e = gtid; e < 4 * 128 * 128; e += ngt) { const int s = e & 127, t = (e >> 7) & 127; Wtril[e] = (s <= t) ? f2bf(P.gm_ws[e]) : (unsigned short)0; }
}

__device__ __forceinline__ unsigned mono_key(float s) { const unsigned b = __float_as_uint(s); return b ^ ((unsigned)((int)b >> 31) | 0x80000000u); }

#define wr_lane(dst, sval, ln) asm volatile("s_nop 4\n\tv_writelane_b32 %0, %1, %2\n\ts_nop 1" : "+v"(dst) : "s"(sval), "n"(ln))
template <int NBLK> __device__ __forceinline__ unsigned a1_bisect(const unsigned (&v)[64], int& cpre) {
    unsigned prefix = 0u; cpre = 0;
#pragma unroll 1
    for (int bit = 31; bit >= 0; --bit) {
        const unsigned cand = prefix | (1u << bit);
        int cnt = 0;
#pragma unroll
        for (int blk = 0; blk < NBLK; ++blk) {
            unsigned long long bl[8];
#pragma unroll
            for (int k = 0; k < 8; ++k) bl[k] = __ballot(v[blk * 8 + k] >= cand);
            __builtin_amdgcn_sched_barrier(0);
#pragma unroll
            for (int k = 0; k < 8; ++k) cnt += __builtin_popcountll(bl[k]);
            __builtin_amdgcn_sched_barrier(0);
        }
        if (cnt >= 256) { prefix = cand; cpre = cnt; if (cnt == 256) break; }
    }
    return prefix;
}
constexpr int A1_ROWF = 4100;
__device__ __forceinline__ void phase_a1(unsigned char* lds, const bf16_t* IQ, const bf16_t* IK, const float* IW, unsigned short* MASK, int tid, int bid, int G) {
    const int lane = tid & 63, w = __builtin_amdgcn_readfirstlane(tid >> 6), q = lane & 15, g = lane >> 4;
    unsigned* keys = (unsigned*)lds;
#ifndef REP_A1X
#define REP_A1X 1
#endif
    for (int L2 = bid; L2 < 1024 * REP_A1X; L2 += G) {
        const int L = L2 & 1023;
        const int b = L >> 8, c = L & 255, qg = (b & 1) ? 255 - c : c;
        const int row0 = b * SEQ + qg * 16;
        const int nreg = (qg >> 2) + 1;
        if (qg <= 15) {
#pragma unroll
            for (int half = 0; half < 2; ++half) { const int qq = half * 8 + w; const int t = qg * 16 + qq; unsigned mlo = 0u, mhi = 0u;
#pragma unroll
                for (int r = 0; r < 4; ++r) { const unsigned long long bal = __ballot(64 * r + lane <= t);
                    wr_lane(mlo, (unsigned)bal, r); wr_lane(mhi, (unsigned)(bal >> 32), r); }
                if (lane < nreg) *(u32x2*)(MASK + (size_t)(row0 + qq) * 256 + 4 * lane) = (u32x2){mlo, mhi}; }
            continue;
        }
        unsigned u[128];
        {
            bf16x8 iqf[8]; float wv[8];
#pragma unroll
            for (int h = 0; h < 8; ++h) iqf[h] = *(const bf16x8*)(IQ + (size_t)(row0 + q) * 256 + h * 32 + 8 * g);
            { const f32x4 a = *(const f32x4*)(IW + (size_t)(row0 + q) * 8), bq = *(const f32x4*)(IW + (size_t)(row0 + q) * 8 + 4);
              wv[0] = a[0]; wv[1] = a[1]; wv[2] = a[2]; wv[3] = a[3]; wv[4] = bq[0]; wv[5] = bq[1]; wv[6] = bq[2]; wv[7] = bq[3]; }
            bf16x8 kfn[4];
#pragma unroll
            for (int ii = 0; ii < 4; ++ii) kfn[ii] = *(const bf16x8*)(IK + (size_t)(b * SEQ + (8 * ii + w) * 16 + q) * 32 + 8 * g);
#pragma unroll
            for (int blk = 0; blk < 8; ++blk) {
                if (32 * blk + w <= qg) {
                    bf16x8 kf[4];
#pragma unroll
                    for (int ii = 0; ii < 4; ++ii) kf[ii] = kfn[ii];
                    if (blk < 7) {
#pragma unroll
                        for (int ii = 0; ii < 4; ++ii) { const int kt = 8 * (4 * (blk + 1) + ii) + w; kfn[ii] = *(const bf16x8*)(IK + (size_t)(b * SEQ + kt * 16 + q) * 32 + 8 * g); }
                    }
#pragma unroll
                    for (int ii = 0; ii < 4; ++ii) { const int i = 4 * blk + ii; const int kt = 8 * i + w;
                        f32x4 s = {0.f, 0.f, 0.f, 0.f};
#pragma unroll
                        for (int h = 0; h < 8; ++h) { const f32x4 a = mfma16(kf[ii], iqf[h], (f32x4){0.f, 0.f, 0.f, 0.f});
#pragma unroll
                            for (int j = 0; j < 4; ++j) s[j] = __builtin_fmaf(wv[h], relu1(a[j]), s[j]); }
#pragma unroll
                        for (int j = 0; j < 4; ++j) { unsigned uu = mono_key(s[j]); if (kt > qg || (kt == qg && (4 * g + j) > q)) uu = 0u; u[4 * i + j] = uu; }
                    }
                } else {
#pragma unroll
                    for (int r = 0; r < 16; ++r) u[16 * blk + r] = 0u;
                }
            }
        }
#pragma unroll 1
        for (int half = 0; half < 2; ++half) {
            if ((q >> 3) == half) {
                unsigned* krow = keys + (q & 7) * A1_ROWF + 4 * g;
#pragma unroll
                for (int i = 0; i < 32; ++i) { const int kt = 8 * i + w; *(u32x4*)(krow + kt * 16) = (u32x4){u[4 * i], u[4 * i + 1], u[4 * i + 2], u[4 * i + 3]}; }
            }
            __syncthreads();
            {
                const int qq = half * 8 + w; const unsigned* krow = keys + w * A1_ROWF + lane;
                unsigned v[64];
#pragma unroll
                for (int blk = 0; blk < 8; ++blk) {
                    if (nreg > blk * 8) {
#pragma unroll
                        for (int r = blk * 8; r < blk * 8 + 8; ++r) v[r] = krow[64 * r];
                    } else {
#pragma unroll
                        for (int r = blk * 8; r < blk * 8 + 8; ++r) v[r] = 0u;
                    }
                }
#ifndef REP_BIS
#define REP_BIS 1
#endif
                __syncthreads();
                unsigned prefix; int cpre = 0;
#pragma unroll 1
                for (int rb_ = 0; rb_ < REP_BIS; ++rb_)
                switch ((nreg + 7) >> 3) {
                    case 1: prefix = a1_bisect<1>(v, cpre); break; case 2: prefix = a1_bisect<2>(v, cpre); break; case 3: prefix = a1_bisect<3>(v, cpre); break; case 4: prefix = a1_bisect<4>(v, cpre); break;
                    case 5: prefix = a1_bisect<5>(v, cpre); break; case 6: prefix = a1_bisect<6>(v, cpre); break; case 7: prefix = a1_bisect<7>(v, cpre); break; default: prefix = a1_bisect<8>(v, cpre); break;
                }
                const unsigned thr = prefix > 1u ? prefix : 1u;
                unsigned mlo = 0u, mhi = 0u;
                if (cpre == 256) {
#pragma unroll
                    for (int r = 0; r < 64; ++r) { const unsigned long long bal = __ballot(v[r] >= thr); wr_lane(mlo, (unsigned)bal, r); wr_lane(mhi, (unsigned)(bal >> 32), r); }
                } else {
                    int rem = 256;
#pragma unroll
                    for (int r = 0; r < 64; ++r) rem -= __builtin_popcountll(__ballot(v[r] > thr));
#pragma unroll
                    for (int r = 0; r < 64; ++r) { unsigned long long bal = __ballot(v[r] > thr); unsigned long long eq = __ballot(v[r] == thr);
                        const int ne = __builtin_popcountll(eq);
                        if (ne <= rem) { bal |= eq; rem -= ne; }
                        else { while (rem > 0) { const unsigned long long low = eq & (0ull - eq); bal |= low; eq ^= low; --rem; } }
                        wr_lane(mlo, (unsigned)bal, r); wr_lane(mhi, (unsigned)(bal >> 32), r); }
                }
                if (lane < nreg) *(u32x2*)(MASK + (size_t)(row0 + qq) * 256 + 4 * lane) = (u32x2){mlo, mhi};
            }
        }
    }
}

__device__ __forceinline__ void phase_a2(unsigned char* lds, const bf16_t* QA, bf16_t* OA, const bf16_t* KA, const bf16_t* VTA, const unsigned short* MASK,
                                         const float* qn, const float* kn, int tid, int bid, int G) {
    const int lane = tid & 63, w = __builtin_amdgcn_readfirstlane(tid >> 6), q = lane & 15, g = lane >> 4;
    bf16_t* Kt = (bf16_t*)lds;
    bf16_t* Vt = (bf16_t*)(lds + 2 * 64 * 72 * 2);
    const float msh = LOG2E * 8.f * wave_max(fabsf(qn[lane])) * wave_max(fabsf(kn[lane])) * 1.02f + 0.25f;
    const int srow = tid >> 3, sch = tid & 7;
    for (int L = bid; L < 512; L += G) {
        const int jj = L >> 8, c0 = L & 255, c = (c0 & 7) * 32 + (c0 >> 3), bh = c >> 4, qb = jj ? 31 - (c & 15) : (c & 15);
        const int b = bh >> 2, h = bh & 3;
        const int qgw = qb * 8 + w;
        const int row0 = b * SEQ + qb * 128 + 16 * w;
        bf16x8 qf[2];
#pragma unroll
        for (int hf = 0; hf < 2; ++hf) qf[hf] = *(const bf16x8*)(QA + (size_t)(row0 + q) * 256 + h * 64 + hf * 32 + 8 * g);
        const unsigned short* mrow = MASK + (size_t)(row0 + q) * 256;
        const int nsteps = 2 * qb + 2;
        const bf16_t* ksrc = KA + (size_t)(b * SEQ + srow) * 256 + h * 64 + sch * 8;
        const bf16_t* vsrc = VTA + (size_t)(b * 256 + h * 64 + srow) * SEQ + sch * 8;
        u32x4 kA = *(const u32x4*)ksrc, vA = *(const u32x4*)vsrc, kB = kA, vB = vA;
        u32x2 mE = *(const u32x2*)mrow, mO = mE;
        *(u32x4*)(Kt + srow * 72 + sch * 8) = kA; *(u32x4*)(Vt + srow * 72 + sch * 8) = vA;
        if (nsteps > 1) { kB = *(const u32x4*)(ksrc + (size_t)64 * 256); vB = *(const u32x4*)(vsrc + 64); mO = *(const u32x2*)(mrow + 4); }
        f32x4 o[4]; float lsum = 0.f; const f32x4 negm = {-msh, -msh, -msh, -msh};
#pragma unroll
        for (int d = 0; d < 4; ++d) o[d] = (f32x4){0.f, 0.f, 0.f, 0.f};
        __syncthreads();
#define A2_COMPUTE(st, buf, mcur) do { \
            const bf16_t* kb_ = Kt + (buf) * 64 * 72; const bf16_t* vb_ = Vt + (buf) * 64 * 72; \
            _Pragma("unroll") for (int p = 0; p < 2; ++p) { \
                const int kt0 = (st) * 4 + 2 * p; \
                if (kt0 <= qgw) { \
                    const unsigned mw = p ? (mcur).y : (mcur).x; \
                    const unsigned nib0 = (mw >> (4 * g)) & 15u, nib1 = (kt0 + 1 <= qgw) ? ((mw >> (16 + 4 * g)) & 15u) : 0u; \
                    const bf16_t* kr0 = kb_ + (p * 32 + q) * 72 + 8 * g; const bf16_t* kr1 = kr0 + 16 * 72; \
                    f32x4 a0 = mfma16(*(const bf16x8*)kr0, qf[0], negm); a0 = mfma16(*(const bf16x8*)(kr0 + 32), qf[1], a0); \
                    f32x4 a1 = mfma16(*(const bf16x8*)kr1, qf[0], negm); a1 = mfma16(*(const bf16x8*)(kr1 + 32), qf[1], a1); \
                    float p0[4], p1[4]; \
                    _Pragma("unroll") for (int j = 0; j < 4; ++j) { p0[j] = __uint_as_float(__float_as_uint(__builtin_amdgcn_exp2f(a0[j])) & (0u - ((nib0 >> j) & 1u))); p1[j] = __uint_as_float(__float_as_uint(__builtin_amdgcn_exp2f(a1[j])) & (0u - ((nib1 >> j) & 1u))); } \
                    lsum += ((p0[0] + p0[1]) + (p0[2] + p0[3])) + ((p1[0] + p1[1]) + (p1[2] + p1[3])); \
                    const bf16x8 pf = mk8(cvt_pk_bf16(p0[0], p0[1]), cvt_pk_bf16(p0[2], p0[3]), cvt_pk_bf16(p1[0], p1[1]), cvt_pk_bf16(p1[2], p1[3])); \
                    _Pragma("unroll") for (int d = 0; d < 4; ++d) { const bf16_t* vr = vb_ + (d * 16 + q) * 72 + p * 32 + 4 * g; \
                        const u32x2 lo = *(const u32x2*)vr, hi = *(const u32x2*)(vr + 16); \
                        o[d] = mfma16(mk8(lo.x, lo.y, hi.x, hi.y), pf, o[d]); } \
                } } } while (0)
        for (int st = 0; st < nsteps; st += 2) {
            {
                const bool more2 = st + 2 < nsteps; u32x2 mEn = mE;
                if (more2) { kA = *(const u32x4*)(ksrc + (size_t)(st + 2) * 64 * 256); vA = *(const u32x4*)(vsrc + (st + 2) * 64); mEn = *(const u32x2*)(mrow + (st + 2) * 4); }
                A2_COMPUTE(st, 0, mE);
                *(u32x4*)(Kt + 64 * 72 + srow * 72 + sch * 8) = kB; *(u32x4*)(Vt + 64 * 72 + srow * 72 + sch * 8) = vB;
                __syncthreads();
                mE = mEn;
            }
            {
                const int s1 = st + 1; const bool more2 = s1 + 2 < nsteps; u32x2 mOn = mO;
                if (more2) { kB = *(const u32x4*)(ksrc + (size_t)(s1 + 2) * 64 * 256); vB = *(const u32x4*)(vsrc + (s1 + 2) * 64); mOn = *(const u32x2*)(mrow + (s1 + 2) * 4); }
                A2_COMPUTE(s1, 1, mO);
                if (s1 + 1 < nsteps) { *(u32x4*)(Kt + srow * 72 + sch * 8) = kA; *(u32x4*)(Vt + srow * 72 + sch * 8) = vA; }
                __syncthreads();
                mO = mOn;
            }
        }
#undef A2_COMPUTE
        lsum += __shfl_xor(lsum, 16); lsum += __shfl_xor(lsum, 32);
        const float inv = 1.f / lsum;
#pragma unroll
        for (int d = 0; d < 4; ++d) { const f32x4 v = o[d] * inv;
            *(u32x2*)(OA + (size_t)(row0 + q) * 1024 + h * 64 + d * 16 + 4 * g) = (u32x2){cvt_pk_bf16(v[0], v[1]), cvt_pk_bf16(v[2], v[3])}; }
    }
}

__device__ __forceinline__ void phase_b(const bf16_t* PIN, const bf16_t* WpT, const float* pscale, bf16_t* OB, int gw, int ngw, int lane) {
    const int q = lane & 15, g4 = lane >> 4;
    for (int L = gw; L < 4096; L += ngw) {
        const int gp = L >> 10, tg = L & 1023; const int row = tg * 16 + q; const int t = row & (SEQ - 1);
        const int win = 2 << gp; const int cnt = (t + 1 < win) ? t + 1 : win; const float inv = 1.f / (float)cnt;
        f32x4 acc[4];
#pragma unroll
        for (int d = 0; d < 4; ++d) acc[d] = (f32x4){0.f, 0.f, 0.f, 0.f};
#pragma unroll
        for (int ch = 0; ch < 2; ++ch) {
            const bf16_t* p = PIN + (size_t)row * 256 + gp * 64 + ch * 32 + 8 * g4;
            u32x4 wv[16];
#pragma unroll
            for (int i = 0; i < 16; ++i) { wv[i] = (u32x4){0u, 0u, 0u, 0u}; if (i < win && i <= t) wv[i] = *(const u32x4*)(p - (size_t)i * 256); }
            float own[8], sum[8];
            own[0] = bflo(wv[0].x); own[1] = bfhi(wv[0].x); own[2] = bflo(wv[0].y); own[3] = bfhi(wv[0].y); own[4] = bflo(wv[0].z); own[5] = bfhi(wv[0].z); own[6] = bflo(wv[0].w); own[7] = bfhi(wv[0].w);
#pragma unroll
            for (int k = 0; k < 8; ++k) sum[k] = own[k];
#pragma unroll
            for (int i = 1; i < 16; ++i) { const u32x4 v = wv[i];
                sum[0] += bflo(v.x); sum[1] += bfhi(v.x); sum[2] += bflo(v.y); sum[3] += bfhi(v.y); sum[4] += bflo(v.z); sum[5] += bfhi(v.z); sum[6] += bflo(v.w); sum[7] += bfhi(v.w); }
            float pl[8];
#pragma unroll
            for (int k = 0; k < 8; ++k) pl[k] = sum[k] * inv - own[k];
            const bf16x8 bfr = mk8(cvt_pk_bf16(pl[0], pl[1]), cvt_pk_bf16(pl[2], pl[3]), cvt_pk_bf16(pl[4], pl[5]), cvt_pk_bf16(pl[6], pl[7]));
#pragma unroll
            for (int d = 0; d < 4; ++d) { const bf16x8 afr = *(const bf16x8*)(WpT + gp * 4096 + (d * 16 + q) * 64 + ch * 32 + 8 * g4); acc[d] = mfma16(afr, bfr, acc[d]); }
        }
#pragma unroll
        for (int d = 0; d < 4; ++d) { const int d0 = d * 16 + 4 * g4; const f32x4 sc = *(const f32x4*)(pscale + gp * 64 + d0); const f32x4 v = acc[d] * sc;
            *(u32x2*)(OB + (size_t)row * 1024 + gp * 64 + d0) = (u32x2){cvt_pk_bf16(v[0], v[1]), cvt_pk_bf16(v[2], v[3])}; }
    }
}

__device__ __forceinline__ void phase_c(unsigned char* lds, const bf16_t* GV, const bf16_t* GU, bf16_t* OC, const float* gamma, const bf16_t* Wtril, const float* gbias, int tid, int bid, int G) {
    bf16_t* LT = (bf16_t*)lds;
    const int lane = tid & 63, w = __builtin_amdgcn_readfirstlane(tid >> 6), q = lane & 15, g4 = lane >> 4;
    for (int L = bid; L < 512; L += G) {
        const int gp = L & 3, chk = L >> 2; const int R0 = chk * 128;
        {
            const int row = tid >> 2, part = tid & 3;
            const bf16_t* src = GV + (size_t)(R0 + row) * 256 + part * 64;
            float x[64];
#pragma unroll
            for (int k8 = 0; k8 < 8; ++k8) { const u32x4 v = *(const u32x4*)(src + 8 * k8);
                x[8 * k8 + 0] = bflo(v.x); x[8 * k8 + 1] = bfhi(v.x); x[8 * k8 + 2] = bflo(v.y); x[8 * k8 + 3] = bfhi(v.y); x[8 * k8 + 4] = bflo(v.z); x[8 * k8 + 5] = bfhi(v.z); x[8 * k8 + 6] = bflo(v.w); x[8 * k8 + 7] = bfhi(v.w); }
            float s = 0.f;
#pragma unroll
            for (int k = 0; k < 64; ++k) s += x[k];
            s += __shfl_xor(s, 1); s += __shfl_xor(s, 2);
            const float mean = s * (1.f / 256.f); float ss = 0.f;
#pragma unroll
            for (int k = 0; k < 64; ++k) { const float dd = x[k] - mean; ss += dd * dd; }
            ss += __shfl_xor(ss, 1); ss += __shfl_xor(ss, 2);
            const float rstd = __builtin_amdgcn_rsqf(ss * (1.f / 256.f) + EPSN);
            if (part == gp) {
#pragma unroll
                for (int k4 = 0; k4 < 16; ++k4) { const f32x4 gm = *(const f32x4*)(gamma + gp * 64 + 4 * k4);
#pragma unroll
                    for (int i = 0; i < 4; ++i) LT[(4 * k4 + i) * 136 + row] = f2bf((x[4 * k4 + i] - mean) * rstd * gm[i]); }
            }
        }
        __syncthreads();
        {
            f32x4 acc[4];
#pragma unroll
            for (int d = 0; d < 4; ++d) acc[d] = (f32x4){0.f, 0.f, 0.f, 0.f};
            const int t = 16 * w + q; const int nsb = ((16 * w + 15) >> 5) + 1;
            for (int sb = 0; sb < nsb; ++sb) {
                const bf16x8 bfr = *(const bf16x8*)(Wtril + ((size_t)gp * 128 + t) * 128 + sb * 32 + 8 * g4);
#pragma unroll
                for (int d = 0; d < 4; ++d) { const bf16x8 afr = *(const bf16x8*)(LT + (d * 16 + q) * 136 + sb * 32 + 8 * g4); acc[d] = mfma16(afr, bfr, acc[d]); }
            }
            const float bias = gbias[gp * 128 + t];
#pragma unroll
            for (int d = 0; d < 4; ++d) { const size_t eo = (size_t)(R0 + t) * 256 + gp * 64 + d * 16 + 4 * g4; const u32x2 uu = *(const u32x2*)(GU + eo);
                const float r0 = bflo(uu.x) * (acc[d][0] + bias), r1 = bfhi(uu.x) * (acc[d][1] + bias), r2 = bflo(uu.y) * (acc[d][2] + bias), r3 = bfhi(uu.y) * (acc[d][3] + bias);
                *(u32x2*)(OC + (size_t)(R0 + t) * 1024 + gp * 64 + d * 16 + 4 * g4) = (u32x2){cvt_pk_bf16(r0, r1), cvt_pk_bf16(r2, r3)}; }
        }
        __syncthreads();
    }
}

__device__ __forceinline__ void sb_tile(const f32x4 z, int kbase, int tq, int g, float& carry, float (&a)[4]) {
    float lm[4]; bool msk[4];
#pragma unroll
    for (int j = 0; j < 4; ++j) { msk[j] = (kbase + 4 * g + j) >= tq;
        const float e = __builtin_amdgcn_exp2f(-fabsf(z[j]) * LOG2E); const float sp = relu1(z[j]) + __builtin_amdgcn_logf(1.f + e) * LN2;
        lm[j] = msk[j] ? 0.f : -sp; }
    const float suf2 = lm[3], suf1 = lm[3] + lm[2], suf0 = suf1 + lm[1]; const float T = suf0 + lm[0];
    const float x16 = __shfl_xor(T, 16); const float Pp = T + x16; const float Qq = __shfl_xor(Pp, 32);
    const float Sg = ((g & 1) ? 0.f : x16) + ((g & 2) ? 0.f : Qq);
    const float base = carry + Sg;
    const float tl[4] = {base + suf0, base + suf1, base + suf2, base};
#pragma unroll
    for (int j = 0; j < 4; ++j) a[j] = msk[j] ? 0.f : __builtin_amdgcn_exp2f((z[j] + lm[j] + tl[j]) * LOG2E);
    carry += Pp + Qq;
}
__device__ __forceinline__ void phase_d(const bf16_t* SQ, bf16_t* OD, const bf16_t* SK, const bf16_t* VTS, int gw, int ngw, int lane) {
    const int q = lane & 15, g = lane >> 4;
    for (int L0 = gw; L0 < 2048; L0 += ngw) {
        const int blk_ = L0 >> 3, L = ((((blk_ & 7) * 32 + ((blk_ >> 3) & 31)) << 3) | (L0 & 7)) & 2047;
        const int qg = L & 255, bh = L >> 8, b0 = bh >> 2, h = bh & 3;
        const int tq = qg * 16 + q;
        bf16x8 qf[2][2]; f32x4 o[2][4]; float carry[2] = {0.f, 0.f};
#pragma unroll
        for (int u = 0; u < 2; ++u) { const int row0 = (b0 + 2 * u) * SEQ + qg * 16;
#pragma unroll
            for (int hf = 0; hf < 2; ++hf) qf[u][hf] = *(const bf16x8*)(SQ + (size_t)(row0 + q) * 256 + h * 64 + hf * 32 + 8 * g);
#pragma unroll
            for (int d = 0; d < 4; ++d) o[u][d] = (f32x4){0.f, 0.f, 0.f, 0.f}; }
        bf16x8 kn[2][4]; u32x2 vn[2][8];
#define D_LOAD(ppx) do { const int k0_ = (ppx) * 32; _Pragma("unroll") for (int u = 0; u < 2; ++u) { const int b = b0 + 2 * u; \
                const bf16_t* kb = SK + (size_t)(b * SEQ + k0_ + q) * 256 + h * 64 + 8 * g; \
                _Pragma("unroll") for (int i = 0; i < 4; ++i) kn[u][i] = *(const bf16x8*)(kb + (size_t)(i >> 1) * 16 * 256 + (i & 1) * 32); \
                const bf16_t* vb = VTS + (size_t)(b * 256 + h * 64 + q) * SEQ + k0_ + 4 * g; \
                _Pragma("unroll") for (int d = 0; d < 4; ++d) { vn[u][2 * d] = *(const u32x2*)(vb + (size_t)d * 16 * SEQ); vn[u][2 * d + 1] = *(const u32x2*)(vb + (size_t)d * 16 * SEQ + 16); } } } while (0)
        D_LOAD(qg >> 1);
        for (int pp = qg >> 1; pp >= 0; --pp) {
            const int kt0 = 2 * pp, kt1 = kt0 + 1;
            bf16x8 kc[2][4]; u32x2 vc[2][8];
#pragma unroll
            for (int u = 0; u < 2; ++u) {
#pragma unroll
                for (int i = 0; i < 4; ++i) kc[u][i] = kn[u][i];
#pragma unroll
                for (int i = 0; i < 8; ++i) vc[u][i] = vn[u][i]; }
            D_LOAD(pp > 0 ? pp - 1 : 0);
            float a0[2][4], a1[2][4];
#pragma unroll
            for (int u = 0; u < 2; ++u) {
                if (kt1 <= qg) {
                    f32x4 z = mfma16(kc[u][2], qf[u][0], (f32x4){0.f, 0.f, 0.f, 0.f}); z = mfma16(kc[u][3], qf[u][1], z);
                    sb_tile(z, kt1 * 16, tq, g, carry[u], a1[u]);
                } else {
#pragma unroll
                    for (int j = 0; j < 4; ++j) a1[u][j] = 0.f;
                }
            }
#pragma unroll
            for (int u = 0; u < 2; ++u) {
                f32x4 z = mfma16(kc[u][0], qf[u][0], (f32x4){0.f, 0.f, 0.f, 0.f}); z = mfma16(kc[u][1], qf[u][1], z);
                sb_tile(z, kt0 * 16, tq, g, carry[u], a0[u]);
            }
#pragma unroll
            for (int u = 0; u < 2; ++u) {
                const bf16x8 pf = mk8(cvt_pk_bf16(a0[u][0], a0[u][1]), cvt_pk_bf16(a0[u][2], a0[u][3]), cvt_pk_bf16(a1[u][0], a1[u][1]), cvt_pk_bf16(a1[u][2], a1[u][3]));
#pragma unroll
                for (int d = 0; d < 4; ++d) o[u][d] = mfma16(mk8(vc[u][2 * d].x, vc[u][2 * d].y, vc[u][2 * d + 1].x, vc[u][2 * d + 1].y), pf, o[u][d]);
            }
            if (__all(carry[0] < -104.f && carry[1] < -104.f)) break;
        }
#undef D_LOAD
#pragma unroll
        for (int u = 0; u < 2; ++u) { const int row0 = (b0 + 2 * u) * SEQ + qg * 16;
#pragma unroll
            for (int d = 0; d < 4; ++d) *(u32x2*)(OD + (size_t)(row0 + q) * 1024 + h * 64 + d * 16 + 4 * g) = (u32x2){cvt_pk_bf16(o[u][d][0], o[u][d][1]), cvt_pk_bf16(o[u][d][2], o[u][d][3])}; }
    }
}

#define XB_TMO      128
#define XB_XCNT(j)  (256  + 64 * (j))
#define XB_XSUB(j)  (1280 + 64 * (j))
#define XB_XGEN(j)  (2304 + 64 * (j))
#define XB_TOP      3328
#define XB_TOPGEN   3392
#define XCD_BAR_WORDS 3456
#define XB_SPIN_CAP (1u << 18)

__device__ __forceinline__ unsigned xb_ld(unsigned* p)              { return __hip_atomic_load(p, __ATOMIC_RELAXED, __HIP_MEMORY_SCOPE_AGENT); }
__device__ __forceinline__ unsigned xb_add(unsigned* p, unsigned v) { return __hip_atomic_fetch_add(p, v, __ATOMIC_RELAXED, __HIP_MEMORY_SCOPE_AGENT); }
__device__ __forceinline__ unsigned xb_xcc_id() { return (unsigned)__builtin_amdgcn_s_getreg((3 << 11) | 20) & 0xFu; }
#define XB_SPIN(cond, bar) do { unsigned _sp = 0; while (cond) { __builtin_amdgcn_s_sleep(1); \
    if ((++_sp & 255u) == 0u) { if (xb_ld(&(bar)[XB_TMO])) break; if (_sp > XB_SPIN_CAP) { atomicAdd(&(bar)[XB_TMO], 1u); break; } } } } while (0)

struct XcdBarrier {
    unsigned* bar; unsigned x;
    volatile LAS unsigned* st;
};

__device__ __forceinline__ XcdBarrier xcd_barrier_post(unsigned* bar, volatile LAS unsigned* st) {
    XcdBarrier b; b.bar = bar; b.x = xb_xcc_id(); b.st = st;
    if (threadIdx.x == 0) (void)xb_add(&bar[XB_XCNT(b.x)], 1u);
    return b;
}
__device__ __forceinline__ void xcd_barrier_complete(unsigned* bar, unsigned x, unsigned& nloc, unsigned& nx) {
    const unsigned G = gridDim.x * gridDim.y * gridDim.z;
    unsigned sum, cnt, mine, sp = 0u;
    for (;;) {
        sum = 0u; cnt = 0u; mine = 0u;
#pragma unroll
        for (unsigned j = 0; j < 16; ++j) { const unsigned c = xb_ld(&bar[XB_XCNT(j)]); sum += c; cnt += (c > 0u) ? 1u : 0u; mine = (j == x) ? c : mine; }
        if (sum == G) break;
        __builtin_amdgcn_s_sleep(1);
        if ((++sp & 255u) == 0u) { if (xb_ld(&bar[XB_TMO])) break; if (sp > XB_SPIN_CAP) { atomicAdd(&bar[XB_TMO], 1u); break; } }
    }
    nloc = mine > 0u ? mine : 1u; nx = cnt > 0u ? cnt : 1u;
}

__device__ __forceinline__ void xcd_barrier(const XcdBarrier& b) {
    asm volatile("s_waitcnt vmcnt(0)" ::: "memory");
    __syncthreads();
    if (threadIdx.x == 0) {
        unsigned* bar = b.bar;
        __builtin_amdgcn_s_waitcnt(0);
        unsigned nloc = b.st[0], nx = b.st[1];
        if (nloc == 0u) { xcd_barrier_complete(bar, b.x, nloc, nx); b.st[0] = nloc; b.st[1] = nx; }
        const unsigned old = xb_add(&bar[XB_XSUB(b.x)], 1u);
        const unsigned gen = old / nloc;
        if (old + 1u == (gen + 1u) * nloc) {
            __builtin_amdgcn_fence(__ATOMIC_RELEASE, "agent");
            asm volatile("s_waitcnt vmcnt(0)" ::: "memory");
            const unsigned og = xb_add(&bar[XB_TOP], 1u);
            const unsigned tg = og / nx;
            if (og + 1u == (tg + 1u) * nx) xb_add(&bar[XB_TOPGEN], 1u);
            else XB_SPIN(xb_ld(&bar[XB_TOPGEN]) == tg, bar);
            __builtin_amdgcn_fence(__ATOMIC_ACQUIRE, "agent");
            xb_add(&bar[XB_XGEN(b.x)], 1u);
            asm volatile("s_waitcnt vmcnt(0)" ::: "memory");
        } else {
            XB_SPIN(xb_ld(&bar[XB_XGEN(b.x)]) == gen, bar);
            __builtin_amdgcn_fence(__ATOMIC_ACQUIRE, "agent");
            asm volatile("s_waitcnt vmcnt(0)" ::: "memory");
        }
    }
    __syncthreads();
}

#ifndef REP_P0
#define REP_P0 1
#endif
#ifndef REP_P1
#define REP_P1 1
#endif
#ifndef REP_A1
#define REP_A1 1
#endif
#ifndef REP_BCD
#define REP_BCD 1
#endif
#ifndef REP_A2
#define REP_A2 1
#endif
#ifndef REP_MG
#define REP_MG 1
#endif
#ifndef REP_UP
#define REP_UP 1
#endif
#ifndef REP_WO
#define REP_WO 1
#endif
#ifndef REP_N2
#define REP_N2 1
#endif
#ifndef REP_DN
#define REP_DN 1
#endif
#ifndef REP_B
#define REP_B 1
#endif
#ifndef REP_C
#define REP_C 1
#endif
#ifndef REP_D
#define REP_D 1
#endif
#ifndef REP_SYNC
#define REP_SYNC 1
#endif
#define GSYNC() do { _Pragma("unroll 1") for (int r_ = 0; r_ < REP_SYNC; ++r_) xcd_barrier(bar); } while (0)
#define REPEAT(n) _Pragma("unroll 1") for (int rep_ = 0; rep_ < (n); ++rep_)
struct Args { const float* in[16]; float* out; unsigned char* ws; };
constexpr int LDS_BYTES = 147456;
__device__ __forceinline__ unsigned char* opq(unsigned char* p) { asm volatile("" : "+s"(p)); return p; }
__device__ __forceinline__ int opq_tid() { int t = threadIdx.x; asm volatile("" : "+v"(t)); return t; }
#define WSB(T, off) ((T*)(ws + (off)))
constexpr int PTAB_OFF = 147456 - 512, BST_OFF = 147456 - 64;
__device__ __forceinline__ void* ldp(PG8_LAS unsigned char* ldsl, int i) {
    unsigned off = PTAB_OFF + 8 * i; asm volatile("" : "+v"(off));
    const unsigned long long v = *(volatile LAS unsigned long long*)(ldsl + off);
    const unsigned lo = __builtin_amdgcn_readfirstlane((unsigned)v), hi = __builtin_amdgcn_readfirstlane((unsigned)(v >> 32));
    return (void*)(__attribute__((address_space(1))) void*)(((unsigned long long)hi << 32) | lo);
}

__global__ void __launch_bounds__(512, 2) fwd_kernel(Args a) {
    extern __shared__ __attribute__((aligned(16))) unsigned char lds[];
    cg::grid_group grid = cg::this_grid();
    PG8_LAS unsigned char* ldsl = (PG8_LAS unsigned char*)lds;
    if (a.ws == nullptr) grid.sync();
    if (threadIdx.x == 0) { ((volatile LAS unsigned*)(ldsl + BST_OFF))[0] = 0u; ((volatile LAS unsigned*)(ldsl + BST_OFF))[1] = 0u; }
    if (threadIdx.x == 0) { LAS unsigned long long* tb = (LAS unsigned long long*)(ldsl + PTAB_OFF);
#pragma unroll
        for (int i = 0; i < 16; ++i) tb[i] = (unsigned long long)a.in[i];
        tb[16] = (unsigned long long)a.out; tb[17] = (unsigned long long)a.ws; }
    __syncthreads();
    XcdBarrier bar = xcd_barrier_post((unsigned*)a.ws + 1024, (volatile LAS unsigned*)(ldsl + BST_OFF));
#define INP(i) ((const float*)ldp(ldsl, (i)))
#define OUTP ((float*)ldp(ldsl, 16))
#define WSP ((unsigned char*)ldp(ldsl, 17))

#define PHASE_VARS unsigned char* ws = WSP; int bid = blockIdx.x; asm volatile("" : "+s"(bid)); int G = gridDim.x; asm volatile("" : "+s"(G)); \
    const int tid = opq_tid(), lane = tid & 63, wave = __builtin_amdgcn_readfirstlane(tid >> 6); const int gw = bid * 8 + wave, ngw = G * 8; (void)ws; (void)lane; (void)gw; (void)ngw;
#ifndef REP_ALL
#define REP_ALL 1
#endif
#pragma unroll 1
    for (int ll = 0; ll < 2 * REP_ALL; ++ll) {
        const int l = ll & 1;
        REPEAT(REP_P0) {
            PHASE_VARS
#ifndef NO_CVT
            Ptrs P; P.mix_g = INP(1) + l * DM; P.ffn_g = INP(12) + l * DM;
            P.w_in = INP(2) + (size_t)l * DM * DIN; P.qn = INP(3) + l * 64; P.kn = INP(4) + l * 64; P.pool_w = INP(5) + l * 4 * 64 * 64; P.pool_scale = INP(6) + l * 256;
            P.gm_norm = INP(7) + l * 256; P.gm_ws = INP(8) + l * 4 * 128 * 128; P.gm_b = INP(9) + l * 4 * 128; P.w_branch = INP(10) + (size_t)l * 4 * 256 * 1024;
            P.w_out = INP(11) + (size_t)l * 1024 * 1024; P.w_gate = INP(13) + (size_t)l * DM * DFF; P.w_up = INP(14) + (size_t)l * DM * DFF; P.w_down = INP(15) + (size_t)l * DFF * DM;
            convert_weights(P, ws, (LAS float*)(ldsl + wave * 8448), gw, ngw, lane, bid * 512 + tid, G * 512);
#endif
            if (l == 0) x_to_bf16_ss(INP(0), WSB(bf16_t, WS_XN), WSB(float, WS_SS0), gw, ngw, lane);
        }
        GSYNC();
        REPEAT(REP_P1) {
            PHASE_VARS
            pg8::Gemm g{WSB(bf16_t, WS_XN), WSB(bf16_t, WS_WIN), M_, NINP, DM}; pg8::StaticOrder S; S.init(M_, NINP, G, bid);
            EpiIn E{ws, INP(3) + l * 64, INP(4) + l * 64, WSB(float, WS_SS0)};
#ifndef NO_G1
            pg8::gemm_phase<EpiIn, pg8::StaticOrder, true, true>(ldsl, g, S, E);
#endif
        }
        GSYNC();
        REPEAT(REP_A1) {
            PHASE_VARS
            for (int i = bid * 512 + tid; i < M_; i += G * 512) { WSB(float, WS_SS0)[i] = 0.f; WSB(float, WS_SS1)[i] = 0.f; }
#ifndef NO_A1
            phase_a1(lds, WSB(bf16_t, WS_IQ), WSB(bf16_t, WS_IK), WSB(float, WS_IW), WSB(unsigned short, WS_MASK), tid, bid, G);
#endif
            __syncthreads();
        }
        REPEAT(REP_BCD) {
        REPEAT(REP_C) {
            PHASE_VARS
#ifndef NO_C
            phase_c(lds, WSB(bf16_t, WS_GV), WSB(bf16_t, WS_GU), WSB(bf16_t, WS_OCAT) + 512, INP(7) + l * 256, WSB(bf16_t, WS_WS), INP(9) + l * 4 * 128, tid, bid, G);
#endif
        }
        REPEAT(REP_B) {
            PHASE_VARS
#ifndef NO_B
            phase_b(WSB(bf16_t, WS_PIN), WSB(bf16_t, WS_WP), INP(6) + l * 256, WSB(bf16_t, WS_OCAT) + 256, gw, ngw, lane);
#endif
        }
        REPEAT(REP_D) {
            PHASE_VARS
#ifndef NO_D
            phase_d(WSB(bf16_t, WS_SQ), WSB(bf16_t, WS_OCAT) + 768, WSB(bf16_t, WS_SK), WSB(bf16_t, WS_VTS), gw, ngw, lane);
#endif
        }
        }
        GSYNC();
        REPEAT(REP_A2) {
            PHASE_VARS
#ifndef NO_A2
            phase_a2(lds, WSB(bf16_t, WS_QA), WSB(bf16_t, WS_OCAT), WSB(bf16_t, WS_KA), WSB(bf16_t, WS_VTA), WSB(unsigned short, WS_MASK), INP(3) + l * 64, INP(4) + l * 64, tid, bid, G);
#endif
        }
        GSYNC();
        REPEAT(REP_MG) {
            PHASE_VARS
            pg8::Gemm g{WSB(bf16_t, WS_OCAT), WSB(bf16_t, WS_WB), M_, DM, DM}; pg8::StaticOrder S; S.init(M_, DM, G, bid);
            EpiMerge E{ws + WS_G, WSB(bf16_t, WS_XN)};
#ifndef NO_G2
            pg8::gemm_phase<EpiMerge, pg8::StaticOrder, true, true>(ldsl, g, S, E);
#endif
        }
        GSYNC();
        REPEAT(REP_WO) {
            PHASE_VARS
            pg8::Gemm g{WSB(bf16_t, WS_XN), WSB(bf16_t, WS_WOUT), M_, DM, DM}; pg8::StaticOrder S; S.init(M_, DM, G, bid);
            EpiResid E{l == 0 ? INP(0) : OUTP, OUTP, WSB(bf16_t, WS_S), WSB(float, WS_SS1), 1};
#ifndef NO_G3
            pg8::gemm_phase<EpiResid, pg8::StaticOrder, true, true>(ldsl, g, S, E);
#endif
        }
        GSYNC();
        REPEAT(REP_UP) {
            PHASE_VARS
            pg8::Gemm g{WSB(bf16_t, WS_S), WSB(bf16_t, WS_WGU), M_, 2 * DFF, DM}; pg8::StaticOrder S; S.init(M_, 2 * DFF, G, bid);
            EpiSwiGLU E{WSB(bf16_t, WS_R1), WSB(float, WS_SS1)};
#ifndef NO_G4
            pg8::gemm_phase<EpiSwiGLU, pg8::StaticOrder, true, true>(ldsl, g, S, E);
#endif
        }
        GSYNC();
        REPEAT(REP_DN) {
            PHASE_VARS
            pg8::Gemm g{WSB(bf16_t, WS_R1), WSB(bf16_t, WS_WD), M_, DM, DFF}; pg8::StaticOrder S; S.init(M_, DM, G, bid);
            float* o = OUTP; EpiResid E{o, o, WSB(bf16_t, WS_XN), WSB(float, WS_SS0), l == 0 ? 1 : 0};
#ifndef NO_G3
            pg8::gemm_phase<EpiResid, pg8::StaticOrder, true, true>(ldsl, g, S, E);
#endif
        }
        if (ll + 1 < 2 * REP_ALL) GSYNC();
    }
}

extern "C" void kernel_launch(void* const* d_in, const int* in_sizes, int n_in, void* d_out, int out_size, void* d_ws, size_t ws_size, hipStream_t stream) {
    static int grid_blocks = 0;
    if (grid_blocks == 0) {
        if (n_in != 16 || out_size != M_ * DM || ws_size < WS_END) { fprintf(stderr, "kernel_launch: unexpected shapes (n_in %d out %d ws %zu)\n", n_in, out_size, ws_size); grid_blocks = -1; return; }
        int dev = 0, cus = 0, per_cu = 0;
        hipGetDevice(&dev);
        hipDeviceGetAttribute(&cus, hipDeviceAttributeMultiprocessorCount, dev);
        hipFuncSetAttribute((const void*)fwd_kernel, hipFuncAttributeMaxDynamicSharedMemorySize, LDS_BYTES);
        if (hipOccupancyMaxActiveBlocksPerMultiprocessor(&per_cu, (const void*)fwd_kernel, 512, LDS_BYTES) != hipSuccess || per_cu < 1) per_cu = 1;
        (void)hipGetLastError();
        grid_blocks = cus;
    }
    if (grid_blocks < 0) return;
    Args a{};
    for (int i = 0; i < 16; ++i) a.in[i] = (const float*)d_in[i];
    a.out = (float*)d_out; a.ws = (unsigned char*)d_ws;
    if (hipMemsetAsync(d_ws, 0, 65536, stream) != hipSuccess) { fprintf(stderr, "kernel_launch: memset failed\n"); return; }
    void* args[] = {&a};
    hipError_t e = hipLaunchCooperativeKernel((const void*)fwd_kernel, dim3(grid_blocks), dim3(512), args, LDS_BYTES, stream);
    if (e != hipSuccess) fprintf(stderr, "cooperative launch failed: %s (grid %d)\n", hipGetErrorString(e), grid_blocks);
}
```

```cpp
#include <hip/hip_runtime.h>
#include <hip/hip_cooperative_groups.h>
#include <cstdio>
#include <cstdint>
namespace pg8 {
#define PG8_LAS __attribute__((address_space(3)))
typedef unsigned short bf16_t;
typedef short bf16x8 __attribute__((ext_vector_type(8)));
typedef float f32x4 __attribute__((ext_vector_type(4)));
typedef unsigned u32x4 __attribute__((ext_vector_type(4)));
constexpr int BM = 256, BK = 64, HALF = 128, HTB = HALF * BK * 2  , STAGE_BYTES = 8 * HTB, NXCD = 8, WGM = 8;

__host__ __device__ __forceinline__ int lds_byte(int r, int c) { const int st = (r >> 4) * 2 + (c >> 5), rr = r & 15, cc = c & 31, ob = rr * 64 + cc * 2; return st * 1024 + (ob ^ (((ob >> 9) & 1) << 5)); }
__host__ __device__ __forceinline__ void stage_rc(int b, int& R, int& C) { const int st = b / 1024, sb = b % 1024, swz = sb ^ (((sb >> 9) & 1) << 5); R = (st >> 1) * 16 + swz / 64; C = (st & 1) * 32 + (swz % 64) / 2; }
__host__ __device__ __forceinline__ int perm32(int rho) { const int n = rho >> 4, i = rho & 15; return 8 * (i >> 2) + 4 * n + (i & 3); }

struct Unit { int pm, pn; };
struct Gemm { const bf16_t* A; const bf16_t* Bt; int M, N, K; };

struct StaticOrder {
    int nM, nN, nwg, G, c;
    __host__ __device__ void init(int M, int N, int G_, int c_) { nM = M / BM; nN = N / BM; nwg = nM * nN; G = G_; c = c_; }
    __host__ __device__ bool next(int i, Unit& u) const {
        const long L = (long)i * G + c; if (L >= nwg) return false;
        int wgid = (int)L; { const int q = nwg / NXCD, r = nwg % NXCD, xcd = wgid % NXCD, off = wgid / NXCD; wgid = (xcd < r ? xcd * (q + 1) : r * (q + 1) + (xcd - r) * q) + off; }
        const int nig = WGM * nN, gid = wgid / nig, fm = gid * WGM, gsz = (nM - fm) < WGM ? (nM - fm) : WGM;
        u.pm = fm + ((wgid % nig) % gsz); u.pn = (wgid % nig) / gsz; return true;
    }
    __device__ __forceinline__ void a_ready(const Unit&) const {}
    __device__ __forceinline__ void done(const Unit&) const {}
};

__device__ __forceinline__ unsigned cvt_pk_bf16(float lo, float hi) { unsigned r; asm volatile("v_cvt_pk_bf16_f32 %0, %1, %2" : "=v"(r) : "v"(lo), "v"(hi)); return r; }
template <class Epi, class Sched, bool ALIGN_EPI = false, bool SP2 = false>
__device__ __forceinline__ void gemm_phase(PG8_LAS unsigned char* lds, const Gemm g, const Sched& S, const Epi& E) {
    int tid_ = threadIdx.x; asm volatile("" : "+v"(tid_)); const int tid = tid_, wid = __builtin_amdgcn_readfirstlane(tid >> 6), lane = tid & 63, wr = wid >> 2, wc = wid & 3, fr = lane & 15, fq = lane >> 4;
    const int K = g.K, nt = K / BK;
    unsigned voffA[2], voffB[2];
#pragma unroll
    for (int i = 0; i < 2; ++i) { int R, C; stage_rc(tid * 16 + i * 8192, R, C); const int Rb = Epi::PERM ? ((R & ~31) + perm32(R & 31)) : R;
        voffA[i] = (unsigned)(R * K + C) * 2u; voffB[i] = (unsigned)(Rb * K + C) * 2u; }
    const size_t kstep = (size_t)(BK * 2);
    const size_t hstep = (size_t)HALF * K * 2;
    const size_t tstep = 2 * hstep;
    const unsigned ldsw = (unsigned)wid * 1024u;
    const int aoff = lds_byte(wr * 64 + fr, fq * 8), boff = lds_byte(wc * 32 + fr, fq * 8);
#define PG8_SA(b, h) (((b) * 2 + (h)) * HTB)
#define PG8_SB(b, h) ((4 + (b) * 2 + (h)) * HTB)
#define PG8_STAGE(bufoff, gbase, voff) do { _Pragma("unroll") for (int _i = 0; _i < 2; ++_i) \
        __builtin_amdgcn_global_load_lds((const unsigned*)((const char*)(gbase) + (voff)[_i]), (PG8_LAS unsigned*)(lds + (bufoff) + ldsw + _i * 8192), 16, 0, 0); } while (0)
#define PG8_LDA(dst, b, h) do { _Pragma("unroll") for (int m = 0; m < 4; ++m) _Pragma("unroll") for (int k = 0; k < 2; ++k) dst[m][k] = *(const PG8_LAS bf16x8*)(lds + PG8_SA(b, h) + aoff + m * 2048 + k * 1024); } while (0)
#define PG8_LDB(dst, b, h) do { _Pragma("unroll") for (int n = 0; n < 2; ++n) _Pragma("unroll") for (int k = 0; k < 2; ++k) dst[n][k] = *(const PG8_LAS bf16x8*)(lds + PG8_SB(b, h) + boff + n * 2048 + k * 1024); } while (0)
#define PG8_MMA(ai, bj, At, Bt) do { __builtin_amdgcn_s_setprio(1); _Pragma("unroll") for (int m = 0; m < 4; ++m) _Pragma("unroll") for (int n = 0; n < 2; ++n) _Pragma("unroll") for (int k = 0; k < 2; ++k) \
        acc[ai][bj][m][n] = __builtin_amdgcn_mfma_f32_16x16x32_bf16(Bt[n][k], At[m][k], acc[ai][bj][m][n], 0, 0, 0); __builtin_amdgcn_s_setprio(0); } while (0)
#define PG8_WAIT_V(n) asm volatile("s_waitcnt vmcnt(" #n ")" ::: "memory")
#define PG8_WAIT_L(n) asm volatile("s_waitcnt lgkmcnt(" #n ")" ::: "memory")
#define PG8_BAR __builtin_amdgcn_s_barrier()
#define PG8_SCHED __builtin_amdgcn_sched_barrier(0)
    Unit cur, nxt; int ui = 0;
    if (!S.next(0, cur)) return;
    f32x4 acc[2][2][4][2];
#pragma unroll
    for (int a = 0; a < 2; ++a)
#pragma unroll
        for (int b = 0; b < 2; ++b)
#pragma unroll
            for (int m = 0; m < 4; ++m)
#pragma unroll
                for (int n = 0; n < 2; ++n) acc[a][b][m][n] = (f32x4){0.f, 0.f, 0.f, 0.f};
    bf16x8 At[4][2], B0[2][2], B1[2][2];
    const char* cA = (const char*)g.A + (size_t)cur.pm * tstep; const char* cB = (const char*)g.Bt + (size_t)cur.pn * tstep;
    S.a_ready(cur);
    if constexpr (SP2) {
        PG8_STAGE(PG8_SB(0, 0), cB, voffB); PG8_STAGE(PG8_SB(0, 1), cB + hstep, voffB); PG8_STAGE(PG8_SA(0, 0), cA, voffA); PG8_STAGE(PG8_SA(0, 1), cA + hstep, voffA);
        if (wr == 1) PG8_BAR;
        PG8_WAIT_V(2); PG8_BAR;
        PG8_STAGE(PG8_SB(1, 0), cB + kstep, voffB); PG8_STAGE(PG8_SA(1, 0), cA + kstep, voffA); PG8_STAGE(PG8_SB(1, 1), cB + hstep + kstep, voffB);
        PG8_WAIT_V(6); PG8_BAR;
    } else {
        PG8_STAGE(PG8_SB(0, 0), cB, voffB); PG8_STAGE(PG8_SA(0, 0), cA, voffA); PG8_STAGE(PG8_SB(0, 1), cB + hstep, voffB); PG8_STAGE(PG8_SA(0, 1), cA + hstep, voffA);
        if (wr == 1) PG8_BAR;
        PG8_WAIT_V(4); PG8_BAR;
        PG8_STAGE(PG8_SB(1, 0), cB + kstep, voffB); PG8_STAGE(PG8_SA(1, 0), cA + kstep, voffA); PG8_STAGE(PG8_SB(1, 1), cB + hstep + kstep, voffB);
        PG8_WAIT_V(6); PG8_BAR;
    }
    for (;;) {
        const bool has_next = S.next(ui + 1, nxt);
        const char* nA = has_next ? (const char*)g.A + (size_t)nxt.pm * tstep : cA; const char* nB = has_next ? (const char*)g.Bt + (size_t)nxt.pn * tstep : cB;
        for (int t = 0; t < nt; t += 2) {
            if constexpr (Epi::HOOK) { if (t != 0 && (t & 3) == 0) E.hook(acc, cur, (t >> 2) - 1, wr, wc, fr, fq); }
            const bool last = (t == nt - 2);
            const char* a1 = cA + (size_t)(t + 1) * kstep;
            const char* a2 = last ? nA : cA + (size_t)(t + 2) * kstep; const char* b2 = last ? nB : cB + (size_t)(t + 2) * kstep;
            const char* a3 = a2 + kstep; const char* b3 = b2 + kstep;
            if (last && has_next) S.a_ready(nxt);
            if constexpr (SP2) {
            PG8_LDB(B0, 0, 0); PG8_LDB(B1, 0, 1); PG8_SCHED; PG8_LDA(At, 0, 0); PG8_STAGE(PG8_SA(1, 1), a1 + hstep, voffA);
            PG8_WAIT_V(8); PG8_WAIT_L(0); PG8_BAR; PG8_MMA(0, 0, At, B0); PG8_MMA(0, 1, At, B1); PG8_BAR; PG8_SCHED;
            PG8_LDA(At, 0, 1); PG8_STAGE(PG8_SB(0, 0), b2, voffB); PG8_STAGE(PG8_SB(0, 1), b2 + hstep, voffB); PG8_STAGE(PG8_SA(0, 0), a2, voffA);
            PG8_WAIT_V(8); PG8_WAIT_L(0); PG8_BAR; PG8_MMA(1, 0, At, B0); PG8_MMA(1, 1, At, B1); PG8_BAR; PG8_SCHED;
            PG8_LDB(B0, 1, 0); PG8_LDB(B1, 1, 1); PG8_SCHED; PG8_LDA(At, 1, 0); PG8_STAGE(PG8_SA(0, 1), a2 + hstep, voffA);
            PG8_WAIT_V(8); PG8_WAIT_L(0); PG8_BAR; PG8_MMA(0, 0, At, B0); PG8_MMA(0, 1, At, B1); PG8_BAR; PG8_SCHED;
            PG8_LDA(At, 1, 1); PG8_STAGE(PG8_SB(1, 0), b3, voffB); PG8_STAGE(PG8_SB(1, 1), b3 + hstep, voffB); PG8_STAGE(PG8_SA(1, 0), a3, voffA);
            PG8_WAIT_V(8); PG8_WAIT_L(0); PG8_BAR; PG8_MMA(1, 0, At, B0); PG8_MMA(1, 1, At, B1); PG8_BAR; PG8_SCHED;
            } else {
            PG8_LDB(B0, 0, 0); PG8_SCHED; PG8_LDA(At, 0, 0); PG8_STAGE(PG8_SA(1, 1), a1 + hstep, voffA);
            PG8_WAIT_L(8); PG8_BAR; PG8_WAIT_L(0); PG8_MMA(0, 0, At, B0); PG8_BAR; PG8_SCHED;
            PG8_LDB(B1, 0, 1); PG8_STAGE(PG8_SB(0, 0), b2, voffB);
            PG8_BAR; PG8_WAIT_L(0); PG8_MMA(0, 1, At, B1); PG8_BAR;
            PG8_LDA(At, 0, 1); PG8_STAGE(PG8_SA(0, 0), a2, voffA);
            PG8_BAR; PG8_WAIT_L(0); PG8_MMA(1, 0, At, B0); PG8_BAR; PG8_SCHED;
            PG8_STAGE(PG8_SB(0, 1), b2 + hstep, voffB);
            PG8_WAIT_V(6); PG8_BAR; PG8_MMA(1, 1, At, B1); PG8_BAR;
            PG8_LDB(B0, 1, 0); PG8_SCHED; PG8_LDA(At, 1, 0); PG8_STAGE(PG8_SA(0, 1), a2 + hstep, voffA);
            PG8_WAIT_L(8); PG8_BAR; PG8_WAIT_L(0); PG8_MMA(0, 0, At, B0); PG8_BAR; PG8_SCHED;
            PG8_LDB(B1, 1, 1); PG8_STAGE(PG8_SB(1, 0), b3, voffB);
            PG8_BAR; PG8_WAIT_L(0); PG8_MMA(0, 1, At, B1); PG8_BAR;
            PG8_LDA(At, 1, 1); PG8_STAGE(PG8_SA(1, 0), a3, voffA);
            PG8_BAR; PG8_WAIT_L(0); PG8_MMA(1, 0, At, B0); PG8_BAR; PG8_SCHED;
            PG8_STAGE(PG8_SB(1, 1), b3 + hstep, voffB);
            PG8_WAIT_V(6); PG8_BAR; PG8_MMA(1, 1, At, B1); PG8_BAR;
            }
        }
        if constexpr (ALIGN_EPI) { if (wr == 0) PG8_BAR; }
        if constexpr (!Epi::AFTER_DRAIN) { E(acc, cur, wr, wc, fr, fq); if constexpr (Epi::EPI_TWICE) { E(acc, cur, wr, wc, fr, fq); } S.done(cur); }
        if (!has_next) break;
#pragma unroll
        for (int a = 0; a < 2; ++a)
#pragma unroll
            for (int b = 0; b < 2; ++b)
#pragma unroll
                for (int m = 0; m < 4; ++m)
#pragma unroll
                    for (int n = 0; n < 2; ++n) acc[a][b][m][n] = (f32x4){0.f, 0.f, 0.f, 0.f};
        cur = nxt; cA = nA; cB = nB; ++ui;
        if constexpr (ALIGN_EPI) { if (wr == 1) PG8_BAR; }
    }
    PG8_WAIT_V(0);
    if constexpr (!ALIGN_EPI) { if (wr == 0) PG8_BAR; }
    PG8_BAR;
    if constexpr (Epi::AFTER_DRAIN) { E.fused(acc, cur, wr, wc, fr, fq, lds, wid, lane); S.done(cur); }
#undef PG8_SA
#undef PG8_SB
#undef PG8_STAGE
#undef PG8_LDA
#undef PG8_LDB
#undef PG8_MMA
#undef PG8_WAIT_V
#undef PG8_WAIT_L
#undef PG8_BAR
#undef PG8_SCHED
}
}
namespace cg = cooperative_groups;
using pg8::bf16_t; using pg8::bf16x8; using pg8::f32x4; using pg8::u32x4; using pg8::Unit; using pg8::cvt_pk_bf16;
typedef unsigned u32x2 __attribute__((ext_vector_type(2)));
#define LAS __attribute__((address_space(3)))
#define LDS_WAIT() asm volatile("s_waitcnt lgkmcnt(0)" ::: "memory")

constexpr int M_ = 16384, DM = 1024, SEQ = 4096, DFF = 2816, DIN = 6696, NINP = 6912;
constexpr float EPSN = 1e-6f;
constexpr float LOG2E = 1.4426950408889634f, LN2 = 0.6931471805599453f;
constexpr float C2 = 0.125f * LOG2E;

constexpr size_t MiB = (size_t)1 << 20;
constexpr size_t WS_SS0 = 128 * 1024, WS_SS1 = 256 * 1024;
constexpr size_t WS_WIN = 1 * MiB;
constexpr size_t WS_WB = WS_WIN + (size_t)NINP * 1024 * 2;
constexpr size_t WS_WOUT = WS_WB + 2 * MiB;
constexpr size_t WS_WGU = WS_WOUT + 2 * MiB;
constexpr size_t WS_WD = WS_WGU + 11 * MiB;
constexpr size_t WS_WP = WS_WD + (size_t)1024 * 2816 * 2;
constexpr size_t WS_WS = WS_WP + 32768;
static_assert(WS_WS + 131072 <= 36 * MiB, "weights region");
constexpr size_t WS_XN = 36 * MiB;
constexpr size_t WS_R1 = 68 * MiB;
constexpr size_t WS_G = WS_R1, WS_KA = WS_R1 + 64 * MiB, WS_VTA = WS_KA + 8 * MiB, WS_IQ = WS_VTA + 8 * MiB;
constexpr size_t WS_S = 156 * MiB;
constexpr size_t WS_PIN = WS_S, WS_GU = WS_S + 8 * MiB, WS_GV = WS_S + 16 * MiB, WS_SQ = WS_S + 24 * MiB, WS_SK = WS_S + 32 * MiB,
                 WS_VTS = WS_S + 40 * MiB, WS_QA = WS_S + 48 * MiB, WS_MASK = WS_S + 56 * MiB, WS_IK = 220 * MiB, WS_IW = 221 * MiB, WS_OCAT = 222 * MiB  , WS_END = 254 * MiB;

__device__ __forceinline__ float bf2f(unsigned short v) { return __uint_as_float((unsigned)v << 16); }
__device__ __forceinline__ float bflo(unsigned v) { return __uint_as_float(v << 16); }
__device__ __forceinline__ float bfhi(unsigned v) { return __uint_as_float(v & 0xffff0000u); }
__device__ __forceinline__ unsigned short f2bf(float f) { return (unsigned short)(cvt_pk_bf16(f, 0.f) & 0xffffu); }
__device__ __forceinline__ float relu1(float x) { const int b = __float_as_int(x); return __int_as_float(b > 0 ? b : 0); }
__device__ __forceinline__ float sigmoidf_(float x) { return __builtin_amdgcn_rcpf(1.f + __builtin_amdgcn_exp2f(-x * LOG2E)); }
__device__ __forceinline__ float gelu_tanh(float x) { const float u = 0.7978845608028654f * (x + 0.044715f * x * x * x); return x * __builtin_amdgcn_rcpf(1.f + __builtin_amdgcn_exp2f(-2.f * LOG2E * u)); }
__device__ __forceinline__ f32x4 mfma16(bf16x8 a, bf16x8 b, f32x4 c) { return __builtin_amdgcn_mfma_f32_16x16x32_bf16(a, b, c, 0, 0, 0); }
__device__ __forceinline__ bf16x8 mk8(unsigned a, unsigned b, unsigned c, unsigned d) { u32x4 v = {a, b, c, d}; return __builtin_bit_cast(bf16x8, v); }

struct EpiIn {
    static constexpr bool PERM = true, AFTER_DRAIN = false, HOOK = false;
#ifdef PROBE_EPI_IN
    static constexpr bool EPI_TWICE = true;
#else
    static constexpr bool EPI_TWICE = false;
#endif
    unsigned char* ws; const float *qn, *kn; const float* SS;
    __device__ __forceinline__ void operator()(const f32x4 (&acc)[2][2][4][2], const Unit& u, int wr, int wc, int fr, int fq) const {
        bf16_t* const QA = (bf16_t*)(ws + WS_QA); bf16_t* const KA = (bf16_t*)(ws + WS_KA); bf16_t* const VTA = (bf16_t*)(ws + WS_VTA); bf16_t* const IQ = (bf16_t*)(ws + WS_IQ);
        bf16_t* const PIN = (bf16_t*)(ws + WS_PIN); bf16_t* const GU = (bf16_t*)(ws + WS_GU); bf16_t* const GV = (bf16_t*)(ws + WS_GV); bf16_t* const SQ = (bf16_t*)(ws + WS_SQ);
        bf16_t* const SK = (bf16_t*)(ws + WS_SK); bf16_t* const VTS = (bf16_t*)(ws + WS_VTS); bf16_t* const IK = (bf16_t*)(ws + WS_IK); float* const IW = (float*)(ws + WS_IW); unsigned char* const G = ws + WS_G;
        const int pn = u.pn; const int row0 = u.pm * 256 + wr * 64 + fr; const int cl = wc * 32 + 8 * fq;
        float rr[2][4];
#pragma unroll
        for (int ai = 0; ai < 2; ++ai)
#pragma unroll
            for (int m = 0; m < 4; ++m) rr[ai][m] = __builtin_amdgcn_rsqf(SS[row0 + ai * 128 + m * 16] * (1.f / 1024.f) + EPSN);
        if (pn >= 11) {
            unsigned char* gp = G + (size_t)row0 * 4096 + (pn - 11) * 256 + cl;
#pragma unroll
            for (int ai = 0; ai < 2; ++ai)
#pragma unroll
                for (int m = 0; m < 4; ++m)
#pragma unroll
                    for (int bj = 0; bj < 2; ++bj) {
                        unsigned w2[2];
#pragma unroll
                        for (int n = 0; n < 2; ++n) { const f32x4 v = (acc[ai][bj][m][n] * rr[ai][m]); unsigned pk = 0;
#pragma unroll
                            for (int i = 0; i < 4; ++i) { const unsigned qv = (unsigned)(sigmoidf_(v[i]) * 255.f + 0.5f); pk |= qv << (8 * i); }
                            w2[n] = pk; }
                        *(u32x2*)(gp + (size_t)(ai * 128 + m * 16) * 4096 + bj * 128) = (u32x2){w2[0], w2[1]};
                    }
            return;
        }
        if (pn <= 1) {
            const float* gw = pn == 0 ? qn : kn; const float sc = pn == 0 ? C2 : 1.f; bf16_t* T = pn == 0 ? QA : KA;
            f32x4 gv[2][2];
#pragma unroll
            for (int bj = 0; bj < 2; ++bj)
#pragma unroll
                for (int n = 0; n < 2; ++n) gv[bj][n] = *(const f32x4*)(gw + bj * 32 + 8 * fq + 4 * n);
#pragma unroll
            for (int ai = 0; ai < 2; ++ai)
#pragma unroll
                for (int m = 0; m < 4; ++m) {
                    float ss = 0.f;
#pragma unroll
                    for (int bj = 0; bj < 2; ++bj)
#pragma unroll
                        for (int n = 0; n < 2; ++n) { const f32x4 v = (acc[ai][bj][m][n] * rr[ai][m]); ss += (v[0] * v[0] + v[1] * v[1]) + (v[2] * v[2] + v[3] * v[3]); }
                    ss += __shfl_xor(ss, 16); ss += __shfl_xor(ss, 32);
                    const float rinv = __builtin_amdgcn_rsqf(ss * (1.f / 64.f) + EPSN) * sc;
                    bf16_t* rp = T + (size_t)(row0 + ai * 128 + m * 16) * 256 + wc * 64 + 8 * fq;
#pragma unroll
                    for (int bj = 0; bj < 2; ++bj) { const f32x4 v0 = (acc[ai][bj][m][0] * rr[ai][m]) * gv[bj][0] * rinv, v1 = (acc[ai][bj][m][1] * rr[ai][m]) * gv[bj][1] * rinv;
                        u32x4 w; w.x = cvt_pk_bf16(v0[0], v0[1]); w.y = cvt_pk_bf16(v0[2], v0[3]); w.z = cvt_pk_bf16(v1[0], v1[1]); w.w = cvt_pk_bf16(v1[2], v1[3]);
                        *(u32x4*)(rp + bj * 32) = w; }
                }
            return;
        }
        if (pn == 2 || pn == 9) {
            bf16_t* T = pn == 2 ? VTA : VTS;
#pragma unroll
            for (int ai = 0; ai < 2; ++ai)
#pragma unroll
                for (int m = 0; m < 4; ++m) { const int row = row0 + ai * 128 + m * 16; const int b = row >> 12, t = row & 4095;
#pragma unroll
                    for (int bj = 0; bj < 2; ++bj)
#pragma unroll
                        for (int n = 0; n < 2; ++n) { const f32x4 v = (acc[ai][bj][m][n] * rr[ai][m]);
#pragma unroll
                            for (int i = 0; i < 4; ++i) T[((size_t)b * 256 + bj * 128 + cl + 4 * n + i) * 4096 + t] = f2bf(v[i]); }
                }
            return;
        }
        if (pn == 10) {
            if (wc == 0) {
#pragma unroll
                for (int ai = 0; ai < 2; ++ai)
#pragma unroll
                    for (int m = 0; m < 4; ++m) { const f32x4 v0 = (acc[ai][0][m][0] * rr[ai][m]), v1 = (acc[ai][0][m][1] * rr[ai][m]);
                        u32x4 w; w.x = cvt_pk_bf16(v0[0], v0[1]); w.y = cvt_pk_bf16(v0[2], v0[3]); w.z = cvt_pk_bf16(v1[0], v1[1]); w.w = cvt_pk_bf16(v1[2], v1[3]);
                        *(u32x4*)(IK + (size_t)(row0 + ai * 128 + m * 16) * 32 + 8 * fq) = w; }
            } else if (wc == 1 && fq == 0) {
#pragma unroll
                for (int ai = 0; ai < 2; ++ai)
#pragma unroll
                    for (int m = 0; m < 4; ++m) { float* p = IW + (size_t)(row0 + ai * 128 + m * 16) * 8; *(f32x4*)p = (acc[ai][0][m][0] * rr[ai][m]); *(f32x4*)(p + 4) = (acc[ai][0][m][1] * rr[ai][m]); }
            }
            return;
        }
        {
            bf16_t* T = pn == 3 ? IQ : pn == 4 ? PIN : pn == 5 ? GU : pn == 6 ? GV : pn == 7 ? SQ : SK;
            const bool act = (pn == 5 || pn == 6); const float sc = pn == 7 ? 0.125f : 1.f;
#pragma unroll
            for (int ai = 0; ai < 2; ++ai)
#pragma unroll
                for (int m = 0; m < 4; ++m) { bf16_t* rp = T + (size_t)(row0 + ai * 128 + m * 16) * 256 + cl;
#pragma unroll
                    for (int bj = 0; bj < 2; ++bj) { f32x4 v0 = (acc[ai][bj][m][0] * rr[ai][m]) * sc, v1 = (acc[ai][bj][m][1] * rr[ai][m]) * sc;
                        if (act) {
#pragma unroll
                            for (int i = 0; i < 4; ++i) { v0[i] = gelu_tanh(v0[i]); v1[i] = gelu_tanh(v1[i]); } }
                        u32x4 w; w.x = cvt_pk_bf16(v0[0], v0[1]); w.y = cvt_pk_bf16(v0[2], v0[3]); w.z = cvt_pk_bf16(v1[0], v1[1]); w.w = cvt_pk_bf16(v1[2], v1[3]);
                        *(u32x4*)(rp + bj * 128) = w; }
                }
        }
    }
};

struct EpiMerge {
    static constexpr bool PERM = true, AFTER_DRAIN = false, HOOK = true, EPI_TWICE = false;
    const unsigned char* G; bf16_t* MG;
    __device__ __forceinline__ void hook(f32x4 (&acc)[2][2][4][2], const Unit& u, int s, int wr, int wc, int fr, int fq) const {
        const int row0 = u.pm * 256 + wr * 64 + fr; const int col0 = u.pn * 256 + wc * 32 + 8 * fq;
        const unsigned char* gp0 = G + (size_t)row0 * 4096 + s * 1024 + col0;
        u32x2 ga[2][4][2], gb[2][4][2];
#pragma unroll
        for (int ai = 0; ai < 2; ++ai)
#pragma unroll
            for (int m = 0; m < 4; ++m)
#pragma unroll
                for (int bj = 0; bj < 2; ++bj) { const unsigned char* gp = gp0 + (size_t)(ai * 128 + m * 16) * 4096 + bj * 128; ga[ai][m][bj] = *(const u32x2*)gp; gb[ai][m][bj] = *(const u32x2*)(gp + 1024); }
#pragma unroll
        for (int ai = 0; ai < 2; ++ai)
#pragma unroll
            for (int m = 0; m < 4; ++m)
#pragma unroll
                for (int bj = 0; bj < 2; ++bj)
#pragma unroll
                    for (int i = 0; i < 4; ++i) {
                        const float a0 = fmaxf((float)((ga[ai][m][bj].x >> (8 * i)) & 255u), 1.f), b0 = fmaxf((float)((gb[ai][m][bj].x >> (8 * i)) & 255u), 1.f);
                        const float a1 = fmaxf((float)((ga[ai][m][bj].y >> (8 * i)) & 255u), 1.f), b1 = fmaxf((float)((gb[ai][m][bj].y >> (8 * i)) & 255u), 1.f);
                        acc[ai][bj][m][0][i] *= a0 * __builtin_amdgcn_rcpf(b0); acc[ai][bj][m][1][i] *= a1 * __builtin_amdgcn_rcpf(b1); }
    }
    __device__ __forceinline__ void operator()(const f32x4 (&acc)[2][2][4][2], const Unit& u, int wr, int wc, int fr, int fq) const {
        const int row0 = u.pm * 256 + wr * 64 + fr; const int col0 = u.pn * 256 + wc * 32 + 8 * fq;
        const unsigned char* gp0 = G + (size_t)row0 * 4096 + 3 * 1024 + col0; bf16_t* mp0 = MG + (size_t)row0 * 1024 + col0;
        u32x2 gb[2][4][2];
#pragma unroll
        for (int ai = 0; ai < 2; ++ai)
#pragma unroll
            for (int m = 0; m < 4; ++m)
#pragma unroll
                for (int bj = 0; bj < 2; ++bj) gb[ai][m][bj] = *(const u32x2*)(gp0 + (size_t)(ai * 128 + m * 16) * 4096 + bj * 128);
#pragma unroll
        for (int ai = 0; ai < 2; ++ai)
#pragma unroll
            for (int m = 0; m < 4; ++m)
#pragma unroll
                for (int bj = 0; bj < 2; ++bj) { const size_t ro = (size_t)(ai * 128 + m * 16); const u32x2 g2 = gb[ai][m][bj];
                    f32x4 v0 = acc[ai][bj][m][0], v1 = acc[ai][bj][m][1];
#pragma unroll
                    for (int i = 0; i < 4; ++i) { v0[i] *= fmaxf((float)((g2.x >> (8 * i)) & 255u), 1.f) * (1.f / 255.f); v1[i] *= fmaxf((float)((g2.y >> (8 * i)) & 255u), 1.f) * (1.f / 255.f); }
                    u32x4 w; w.x = cvt_pk_bf16(v0[0], v0[1]); w.y = cvt_pk_bf16(v0[2], v0[3]); w.z = cvt_pk_bf16(v1[0], v1[1]); w.w = cvt_pk_bf16(v1[2], v1[3]);
                    *(u32x4*)(mp0 + ro * 1024 + bj * 128) = w; }
    }
};

struct EpiResid {
    static constexpr bool PERM = true, AFTER_DRAIN = false, HOOK = false, EPI_TWICE = false;
    const float* base; float* out; bf16_t* XB; float* SS; int stat;
    __device__ __forceinline__ void operator()(const f32x4 (&acc)[2][2][4][2], const Unit& u, int wr, int wc, int fr, int fq) const {
        const int row0 = u.pm * 256 + wr * 64 + fr; const int col0 = u.pn * 256 + wc * 32 + 8 * fq;
#pragma unroll
        for (int ai = 0; ai < 2; ++ai) {
            f32x4 pre[4][2][2];
#pragma unroll
            for (int m = 0; m < 4; ++m) { const size_t off = (size_t)(row0 + ai * 128 + m * 16) * 1024 + col0;
#pragma unroll
                for (int bj = 0; bj < 2; ++bj) { pre[m][bj][0] = *(const f32x4*)(base + off + bj * 128); pre[m][bj][1] = *(const f32x4*)(base + off + bj * 128 + 4); } }
#pragma unroll
            for (int m = 0; m < 4; ++m) { const int row = row0 + ai * 128 + m * 16; const size_t off = (size_t)row * 1024 + col0; float ssum = 0.f;
#pragma unroll
                for (int bj = 0; bj < 2; ++bj) {
                    const f32x4 o0 = pre[m][bj][0] + acc[ai][bj][m][0], o1 = pre[m][bj][1] + acc[ai][bj][m][1];
                    *(f32x4*)(out + off + bj * 128) = o0; *(f32x4*)(out + off + bj * 128 + 4) = o1;
                    if (stat) { u32x4 w; w.x = cvt_pk_bf16(o0[0], o0[1]); w.y = cvt_pk_bf16(o0[2], o0[3]); w.z = cvt_pk_bf16(o1[0], o1[1]); w.w = cvt_pk_bf16(o1[2], o1[3]);
                        *(u32x4*)(XB + off + bj * 128) = w;
                        ssum += ((o0[0] * o0[0] + o0[1] * o0[1]) + (o0[2] * o0[2] + o0[3] * o0[3])) + ((o1[0] * o1[0] + o1[1] * o1[1]) + (o1[2] * o1[2] + o1[3] * o1[3])); } }
                if (stat) { ssum += __shfl_xor(ssum, 16); ssum += __shfl_xor(ssum, 32); if (fq == 0) atomicAdd(SS + row, ssum); } }
            asm volatile("" ::: "memory");
        }
    }
};

struct EpiSwiGLU {
    static constexpr bool PERM = true, AFTER_DRAIN = false, HOOK = false, EPI_TWICE = false;
    bf16_t* ACT; const float* SS;
    __device__ __forceinline__ void operator()(const f32x4 (&acc)[2][2][4][2], const Unit& u, int wr, int wc, int fr, int fq) const {
        const int row0 = u.pm * 256 + wr * 64 + fr; const int f0 = u.pn * 128 + wc * 32 + 8 * fq;
        float rr[2][4];
#pragma unroll
        for (int ai = 0; ai < 2; ++ai)
#pragma unroll
            for (int m = 0; m < 4; ++m) rr[ai][m] = SS[row0 + ai * 128 + m * 16];
#pragma unroll
        for (int ai = 0; ai < 2; ++ai)
#pragma unroll
            for (int m = 0; m < 4; ++m) { f32x4 r[2]; const float rs = __builtin_amdgcn_rsqf(rr[ai][m] * (1.f / 1024.f) + EPSN);
#pragma unroll
                for (int n = 0; n < 2; ++n) { const f32x4 g = acc[ai][0][m][n] * rs, up = acc[ai][1][m][n] * rs;
#pragma unroll
                    for (int i = 0; i < 4; ++i) r[n][i] = g[i] * sigmoidf_(g[i]) * up[i]; }
                u32x4 w; w.x = cvt_pk_bf16(r[0][0], r[0][1]); w.y = cvt_pk_bf16(r[0][2], r[0][3]); w.z = cvt_pk_bf16(r[1][0], r[1][1]); w.w = cvt_pk_bf16(r[1][2], r[1][3]);
                *(u32x4*)(ACT + (size_t)(row0 + ai * 128 + m * 16) * DFF + f0) = w; }
    }
};

__device__ __forceinline__ void cvt_item(const float* src, int ld, int col0, int nvalid, int K, bf16_t* WT, int dst_row0, int kb, LAS float* scr, int lane, const float* rs = nullptr) {
    const int k0 = 64 * kb, c = lane & 31;
    float vv[32];
#pragma unroll
    for (int i = 0; i < 32; ++i) { const int kk = 2 * i + (lane >> 5); vv[i] = (c < nvalid) ? src[(size_t)(k0 + kk) * ld + col0 + c] : 0.f; }
    if (rs) {
#pragma unroll
        for (int i = 0; i < 32; ++i) vv[i] *= rs[k0 + 2 * i + (lane >> 5)];
    }
#pragma unroll
    for (int i = 0; i < 32; ++i) scr[(2 * i + (lane >> 5)) * 33 + c] = vv[i];
    LDS_WAIT();
    const int c8 = lane & 7;
#pragma unroll
    for (int j = 0; j < 4; ++j) { const int n = (lane >> 3) + 8 * j; const LAS float* s = scr + (8 * c8) * 33 + n;
        u32x4 o; o.x = cvt_pk_bf16(s[0 * 33], s[1 * 33]); o.y = cvt_pk_bf16(s[2 * 33], s[3 * 33]); o.z = cvt_pk_bf16(s[4 * 33], s[5 * 33]); o.w = cvt_pk_bf16(s[6 * 33], s[7 * 33]);
        *(u32x4*)(WT + (size_t)(dst_row0 + n) * K + k0 + 8 * c8) = o; }
    LDS_WAIT();
}
__device__ __forceinline__ float wave_sum(float v) {
#pragma unroll
    for (int o = 1; o < 64; o <<= 1) v += __shfl_xor(v, o);
    return v;
}
__device__ __forceinline__ float wave_max(float v) {
#pragma unroll
    for (int o = 1; o < 64; o <<= 1) v = fmaxf(v, __shfl_xor(v, o));
    return v;
}
__device__ __forceinline__ void rmsnorm_rows(const float* xs, const float* gamma, bf16_t* XN, int gw, int ngw, int lane) {
    f32x4 gm[4];
#pragma unroll
    for (int j = 0; j < 4; ++j) gm[j] = *(const f32x4*)(gamma + 4 * lane + 256 * j);
    for (int m = gw; m < M_; m += ngw) {
        const f32x4* xr = (const f32x4*)(xs + (size_t)m * DM) + lane; f32x4 v[4]; float s = 0.f;
#pragma unroll
        for (int j = 0; j < 4; ++j) { v[j] = xr[64 * j]; s += (v[j].x * v[j].x + v[j].y * v[j].y) + (v[j].z * v[j].z + v[j].w * v[j].w); }
        const float r = __builtin_amdgcn_rsqf(wave_sum(s) * (1.f / DM) + EPSN);
        u32x2* o8 = (u32x2*)(XN + (size_t)m * DM) + lane;
#pragma unroll
        for (int j = 0; j < 4; ++j) { const f32x4 y = v[j] * r * gm[j]; o8[64 * j] = (u32x2){cvt_pk_bf16(y.x, y.y), cvt_pk_bf16(y.z, y.w)}; }
    }
}

__device__ __forceinline__ void x_to_bf16_ss(const float* xs, bf16_t* XN, float* SS, int gw, int ngw, int lane) {
    for (int m0 = gw * 4; m0 < M_; m0 += ngw * 4) {
        f32x4 v[4][4];
#pragma unroll
        for (int r = 0; r < 4; ++r) { const f32x4* xr = (const f32x4*)(xs + (size_t)(m0 + r) * DM) + lane;
#pragma unroll
            for (int j = 0; j < 4; ++j) v[r][j] = xr[64 * j]; }
#pragma unroll
        for (int r = 0; r < 4; ++r) { float s = 0.f;
#pragma unroll
            for (int j = 0; j < 4; ++j) s += (v[r][j].x * v[r][j].x + v[r][j].y * v[r][j].y) + (v[r][j].z * v[r][j].z + v[r][j].w * v[r][j].w);
            s = wave_sum(s);
            u32x2* o8 = (u32x2*)(XN + (size_t)(m0 + r) * DM) + lane;
#pragma unroll
            for (int j = 0; j < 4; ++j) o8[64 * j] = (u32x2){cvt_pk_bf16(v[r][j].x, v[r][j].y), cvt_pk_bf16(v[r][j].z, v[r][j].w)};
            if (lane == 0) SS[m0 + r] = s; }
    }
}
struct Ptrs {
    const float *mix_g, *ffn_g, *w_in, *qn, *kn, *pool_w, *pool_scale, *gm_norm, *gm_ws, *gm_b, *w_branch, *w_out, *w_gate, *w_up, *w_down;
};

__device__ __forceinline__ void convert_weights(const Ptrs& P, unsigned char* ws, LAS float* scr, int gw, int ngw, int lane, int gtid, int ngt) {
    bf16_t* WinT = (bf16_t*)(ws + WS_WIN); bf16_t* WbT = (bf16_t*)(ws + WS_WB); bf16_t* WoutT = (bf16_t*)(ws + WS_WOUT); bf16_t* WguT = (bf16_t*)(ws + WS_WGU);
    bf16_t* WdT = (bf16_t*)(ws + WS_WD); bf16_t* WpT = (bf16_t*)(ws + WS_WP); bf16_t* Wtril = (bf16_t*)(ws + WS_WS);
    constexpr int I_A = 216 * 16, I_B = 512, I_C = 512, I_D = 176 * 16, I_E = 32 * 44, I_F = 8, NIT = I_A + I_B + I_C + I_D + I_E + I_F;
    for (int it = gw; it < NIT; it += ngw) {
        int r = it;
        if (r < I_A) { const int rb = r >> 4, kb = r & 15, tile = rb >> 3, sub = rb & 7; int col0, nv = 32;
            if (tile <= 1) col0 = tile * 256 + (sub & 3) * 64 + (sub >> 2) * 32;
            else if (tile == 2) col0 = 512 + sub * 32;
            else if (tile == 3) col0 = 768 + sub * 32;
            else if (tile <= 9) col0 = 1064 + (tile - 4) * 256 + sub * 32;
            else if (tile == 10) { col0 = sub == 0 ? 1024 : 1056; nv = sub == 0 ? 32 : (sub == 1 ? 8 : 0); }
            else col0 = 2600 + (tile - 11) * 256 + sub * 32;
            cvt_item(P.w_in, DIN, col0, nv, 1024, WinT, rb * 32, kb, scr, lane, P.mix_g); continue; }
        r -= I_A;
        if (r < I_B) { const int rb = r >> 4, kb = r & 15; cvt_item(P.w_branch, 1024, rb * 32, 32, 1024, WbT, rb * 32, kb, scr, lane); continue; }
        r -= I_B;
        if (r < I_C) { const int rb = r >> 4, kb = r & 15; cvt_item(P.w_out, 1024, rb * 32, 32, 1024, WoutT, rb * 32, kb, scr, lane); continue; }
        r -= I_C;
        if (r < I_D) { const int rb = r >> 4, kb = r & 15, tile = rb >> 3, sub = rb & 7;
            cvt_item((sub >> 2) ? P.w_up : P.w_gate, DFF, tile * 128 + (sub & 3) * 32, 32, 1024, WguT, rb * 32, kb, scr, lane, P.ffn_g); continue; }
        r -= I_D;
        if (r < I_E) { const int rb = r / 44, kb = r % 44; cvt_item(P.w_down, 1024, rb * 32, 32, DFF, WdT, rb * 32, kb, scr, lane); continue; }
        r -= I_E;
        { const int gp = r >> 1, rb = r & 1; cvt_item(P.pool_w + gp * 4096, 64, rb * 32, 32, 64, WpT + gp * 4096, rb * 32, 0, scr, lane); }
    }
    for (int e = gtid; e < 4 * 128 * 128; e += ngt) { const int s = e & 127, t = (e >> 7) & 127; Wtril[e] = (s <= t) ? f2bf(P.gm_ws[e]) : (unsigned short)0; }
}

__device__ __forceinline__ unsigned mono_key(float s) { const unsigned b = __float_as_uint(s); return b ^ ((unsigned)((int)b >> 31) | 0x80000000u); }

#define wr_lane(dst, sval, ln) asm volatile("s_nop 4\n\tv_writelane_b32 %0, %1, %2\n\ts_nop 1" : "+v"(dst) : "s"(sval), "n"(ln))
template <int NBLK> __device__ __forceinline__ unsigned a1_bisect(const unsigned (&v)[64], int& cpre) {
    unsigned prefix = 0u; cpre = 0;
#pragma unroll 1
    for (int bit = 31; bit >= 0; --bit) {
        const unsigned cand = prefix | (1u << bit);
        int cnt = 0;
#pragma unroll
        for (int blk = 0; blk < NBLK; ++blk) {
            unsigned long long bl[8];
#pragma unroll
            for (int k = 0; k < 8; ++k) bl[k] = __ballot(v[blk * 8 + k] >= cand);
            __builtin_amdgcn_sched_barrier(0);
#pragma unroll
            for (int k = 0; k < 8; ++k) cnt += __builtin_popcountll(bl[k]);
            __builtin_amdgcn_sched_barrier(0);
        }
        if (cnt >= 256) { prefix = cand; cpre = cnt; if (cnt == 256) break; }
    }
    return prefix;
}
constexpr int A1_ROWF = 4100;
__device__ __forceinline__ void phase_a1(unsigned char* lds, const bf16_t* IQ, const bf16_t* IK, const float* IW, unsigned short* MASK, int tid, int bid, int G) {
    const int lane = tid & 63, w = __builtin_amdgcn_readfirstlane(tid >> 6), q = lane & 15, g = lane >> 4;
    unsigned* keys = (unsigned*)lds;
#ifndef REP_A1X
#define REP_A1X 1
#endif
    for (int L2 = bid; L2 < 1024 * REP_A1X; L2 += G) {
        const int L = L2 & 1023;
        const int b = L >> 8, c = L & 255, qg = (b & 1) ? 255 - c : c;
        const int row0 = b * SEQ + qg * 16;
        const int nreg = (qg >> 2) + 1;
        if (qg <= 15) {
#pragma unroll
            for (int half = 0; half < 2; ++half) { const int qq = half * 8 + w; const int t = qg * 16 + qq; unsigned mlo = 0u, mhi = 0u;
#pragma unroll
                for (int r = 0; r < 4; ++r) { const unsigned long long bal = __ballot(64 * r + lane <= t);
                    wr_lane(mlo, (unsigned)bal, r); wr_lane(mhi, (unsigned)(bal >> 32), r); }
                if (lane < nreg) *(u32x2*)(MASK + (size_t)(row0 + qq) * 256 + 4 * lane) = (u32x2){mlo, mhi}; }
            continue;
        }
        unsigned u[128];
        {
            bf16x8 iqf[8]; float wv[8];
#pragma unroll
            for (int h = 0; h < 8; ++h) iqf[h] = *(const bf16x8*)(IQ + (size_t)(row0 + q) * 256 + h * 32 + 8 * g);
            { const f32x4 a = *(const f32x4*)(IW + (size_t)(row0 + q) * 8), bq = *(const f32x4*)(IW + (size_t)(row0 + q) * 8 + 4);
              wv[0] = a[0]; wv[1] = a[1]; wv[2] = a[2]; wv[3] = a[3]; wv[4] = bq[0]; wv[5] = bq[1]; wv[6] = bq[2]; wv[7] = bq[3]; }
            bf16x8 kfn[4];
#pragma unroll
            for (int ii = 0; ii < 4; ++ii) kfn[ii] = *(const bf16x8*)(IK + (size_t)(b * SEQ + (8 * ii + w) * 16 + q) * 32 + 8 * g);
#pragma unroll
            for (int blk = 0; blk < 8; ++blk) {
                if (32 * blk + w <= qg) {
                    bf16x8 kf[4];
#pragma unroll
                    for (int ii = 0; ii < 4; ++ii) kf[ii] = kfn[ii];
                    if (blk < 7) {
#pragma unroll
                        for (int ii = 0; ii < 4; ++ii) { const int kt = 8 * (4 * (blk + 1) + ii) + w; kfn[ii] = *(const bf16x8*)(IK + (size_t)(b * SEQ + kt * 16 + q) * 32 + 8 * g); }
                    }
#pragma unroll
                    for (int ii = 0; ii < 4; ++ii) { const int i = 4 * blk + ii; const int kt = 8 * i + w;
                        f32x4 s = {0.f, 0.f, 0.f, 0.f};
#pragma unroll
                        for (int h = 0; h < 8; ++h) { const f32x4 a = mfma16(kf[ii], iqf[h], (f32x4){0.f, 0.f, 0.f, 0.f});
#pragma unroll
                            for (int j = 0; j < 4; ++j) s[j] = __builtin_fmaf(wv[h], relu1(a[j]), s[j]); }
#pragma unroll
                        for (int j = 0; j < 4; ++j) { unsigned uu = mono_key(s[j]); if (kt > qg || (kt == qg && (4 * g + j) > q)) uu = 0u; u[4 * i + j] = uu; }
                    }
                } else {
#pragma unroll
                    for (int r = 0; r < 16; ++r) u[16 * blk + r] = 0u;
                }
            }
        }
#pragma unroll 1
        for (int half = 0; half < 2; ++half) {
            if ((q >> 3) == half) {
                unsigned* krow = keys + (q & 7) * A1_ROWF + 4 * g;
#pragma unroll
                for (int i = 0; i < 32; ++i) { const int kt = 8 * i + w; *(u32x4*)(krow + kt * 16) = (u32x4){u[4 * i], u[4 * i + 1], u[4 * i + 2], u[4 * i + 3]}; }
            }
            __syncthreads();
            {
                const int qq = half * 8 + w; const unsigned* krow = keys + w * A1_ROWF + lane;
                unsigned v[64];
#pragma unroll
                for (int blk = 0; blk < 8; ++blk) {
                    if (nreg > blk * 8) {
#pragma unroll
                        for (int r = blk * 8; r < blk * 8 + 8; ++r) v[r] = krow[64 * r];
                    } else {
#pragma unroll
                        for (int r = blk * 8; r < blk * 8 + 8; ++r) v[r] = 0u;
                    }
                }
#ifndef REP_BIS
#define REP_BIS 1
#endif
                __syncthreads();
                unsigned prefix; int cpre = 0;
#pragma unroll 1
                for (int rb_ = 0; rb_ < REP_BIS; ++rb_)
                switch ((nreg + 7) >> 3) {
                    case 1: prefix = a1_bisect<1>(v, cpre); break; case 2: prefix = a1_bisect<2>(v, cpre); break; case 3: prefix = a1_bisect<3>(v, cpre); break; case 4: prefix = a1_bisect<4>(v, cpre); break;
                    case 5: prefix = a1_bisect<5>(v, cpre); break; case 6: prefix = a1_bisect<6>(v, cpre); break; case 7: prefix = a1_bisect<7>(v, cpre); break; default: prefix = a1_bisect<8>(v, cpre); break;
                }
                const unsigned thr = prefix > 1u ? prefix : 1u;
                unsigned mlo = 0u, mhi = 0u;
                if (cpre == 256) {
#pragma unroll
                    for (int r = 0; r < 64; ++r) { const unsigned long long bal = __ballot(v[r] >= thr); wr_lane(mlo, (unsigned)bal, r); wr_lane(mhi, (unsigned)(bal >> 32), r); }
                } else {
                    int rem = 256;
#pragma unroll
                    for (int r = 0; r < 64; ++r) rem -= __builtin_popcountll(__ballot(v[r] > thr));
#pragma unroll
                    for (int r = 0; r < 64; ++r) { unsigned long long bal = __ballot(v[r] > thr); unsigned long long eq = __ballot(v[r] == thr);
                        const int ne = __builtin_popcountll(eq);
                        if (ne <= rem) { bal |= eq; rem -= ne; }
                        else { while (rem > 0) { const unsigned long long low = eq & (0ull - eq); bal |= low; eq ^= low; --rem; } }
                        wr_lane(mlo, (unsigned)bal, r); wr_lane(mhi, (unsigned)(bal >> 32), r); }
                }
                if (lane < nreg) *(u32x2*)(MASK + (size_t)(row0 + qq) * 256 + 4 * lane) = (u32x2){mlo, mhi};
            }
        }
    }
}

__device__ __forceinline__ void phase_a2(unsigned char* lds, const bf16_t* QA, bf16_t* OA, const bf16_t* KA, const bf16_t* VTA, const unsigned short* MASK,
                                         const float* qn, const float* kn, int tid, int bid, int G) {
    const int lane = tid & 63, w = __builtin_amdgcn_readfirstlane(tid >> 6), q = lane & 15, g = lane >> 4;
    bf16_t* Kt = (bf16_t*)lds;
    bf16_t* Vt = (bf16_t*)(lds + 2 * 64 * 72 * 2);
    const float msh = LOG2E * 8.f * wave_max(fabsf(qn[lane])) * wave_max(fabsf(kn[lane])) * 1.02f + 0.25f;
    const int srow = tid >> 3, sch = tid & 7;
    for (int L = bid; L < 512; L += G) {
        const int jj = L >> 8, c0 = L & 255, c = (c0 & 7) * 32 + (c0 >> 3), bh = c >> 4, qb = jj ? 31 - (c & 15) : (c & 15);
        const int b = bh >> 2, h = bh & 3;
        const int qgw = qb * 8 + w;
        const int row0 = b * SEQ + qb * 128 + 16 * w;
        bf16x8 qf[2];
#pragma unroll
        for (int hf = 0; hf < 2; ++hf) qf[hf] = *(const bf16x8*)(QA + (size_t)(row0 + q) * 256 + h * 64 + hf * 32 + 8 * g);
        const unsigned short* mrow = MASK + (size_t)(row0 + q) * 256;
        const int nsteps = 2 * qb + 2;
        const bf16_t* ksrc = KA + (size_t)(b * SEQ + srow) * 256 + h * 64 + sch * 8;
        const bf16_t* vsrc = VTA + (size_t)(b * 256 + h * 64 + srow) * SEQ + sch * 8;
        u32x4 kA = *(const u32x4*)ksrc, vA = *(const u32x4*)vsrc, kB = kA, vB = vA;
        u32x2 mE = *(const u32x2*)mrow, mO = mE;
        *(u32x4*)(Kt + srow * 72 + sch * 8) = kA; *(u32x4*)(Vt + srow * 72 + sch * 8) = vA;
        if (nsteps > 1) { kB = *(const u32x4*)(ksrc + (size_t)64 * 256); vB = *(const u32x4*)(vsrc + 64); mO = *(const u32x2*)(mrow + 4); }
        f32x4 o[4]; float lsum = 0.f; const f32x4 negm = {-msh, -msh, -msh, -msh};
#pragma unroll
        for (int d = 0; d < 4; ++d) o[d] = (f32x4){0.f, 0.f, 0.f, 0.f};
        __syncthreads();
#define A2_COMPUTE(st, buf, mcur) do { \
            const bf16_t* kb_ = Kt + (buf) * 64 * 72; const bf16_t* vb_ = Vt + (buf) * 64 * 72; \
            _Pragma("unroll") for (int p = 0; p < 2; ++p) { \
                const int kt0 = (st) * 4 + 2 * p; \
                if (kt0 <= qgw) { \
                    const unsigned mw = p ? (mcur).y : (mcur).x; \
                    const unsigned nib0 = (mw >> (4 * g)) & 15u, nib1 = (kt0 + 1 <= qgw) ? ((mw >> (16 + 4 * g)) & 15u) : 0u; \
                    const bf16_t* kr0 = kb_ + (p * 32 + q) * 72 + 8 * g; const bf16_t* kr1 = kr0 + 16 * 72; \
                    f32x4 a0 = mfma16(*(const bf16x8*)kr0, qf[0], negm); a0 = mfma16(*(const bf16x8*)(kr0 + 32), qf[1], a0); \
                    f32x4 a1 = mfma16(*(const bf16x8*)kr1, qf[0], negm); a1 = mfma16(*(const bf16x8*)(kr1 + 32), qf[1], a1); \
                    float p0[4], p1[4]; \
                    _Pragma("unroll") for (int j = 0; j < 4; ++j) { p0[j] = __uint_as_float(__float_as_uint(__builtin_amdgcn_exp2f(a0[j])) & (0u - ((nib0 >> j) & 1u))); p1[j] = __uint_as_float(__float_as_uint(__builtin_amdgcn_exp2f(a1[j])) & (0u - ((nib1 >> j) & 1u))); } \
                    lsum += ((p0[0] + p0[1]) + (p0[2] + p0[3])) + ((p1[0] + p1[1]) + (p1[2] + p1[3])); \
                    const bf16x8 pf = mk8(cvt_pk_bf16(p0[0], p0[1]), cvt_pk_bf16(p0[2], p0[3]), cvt_pk_bf16(p1[0], p1[1]), cvt_pk_bf16(p1[2], p1[3])); \
                    _Pragma("unroll") for (int d = 0; d < 4; ++d) { const bf16_t* vr = vb_ + (d * 16 + q) * 72 + p * 32 + 4 * g; \
                        const u32x2 lo = *(const u32x2*)vr, hi = *(const u32x2*)(vr + 16); \
                        o[d] = mfma16(mk8(lo.x, lo.y, hi.x, hi.y), pf, o[d]); } \
                } } } while (0)
        for (int st = 0; st < nsteps; st += 2) {
            {
                const bool more2 = st + 2 < nsteps; u32x2 mEn = mE;
                if (more2) { kA = *(const u32x4*)(ksrc + (size_t)(st + 2) * 64 * 256); vA = *(const u32x4*)(vsrc + (st + 2) * 64); mEn = *(const u32x2*)(mrow + (st + 2) * 4); }
                A2_COMPUTE(st, 0, mE);
                *(u32x4*)(Kt + 64 * 72 + srow * 72 + sch * 8) = kB; *(u32x4*)(Vt + 64 * 72 + srow * 72 + sch * 8) = vB;
                __syncthreads();
                mE = mEn;
            }
            {
                const int s1 = st + 1; const bool more2 = s1 + 2 < nsteps; u32x2 mOn = mO;
                if (more2) { kB = *(const u32x4*)(ksrc + (size_t)(s1 + 2) * 64 * 256); vB = *(const u32x4*)(vsrc + (s1 + 2) * 64); mOn = *(const u32x2*)(mrow + (s1 + 2) * 4); }
                A2_COMPUTE(s1, 1, mO);
                if (s1 + 1 < nsteps) { *(u32x4*)(Kt + srow * 72 + sch * 8) = kA; *(u32x4*)(Vt + srow * 72 + sch * 8) = vA; }
                __syncthreads();
                mO = mOn;
            }
        }
#undef A2_COMPUTE
        lsum += __shfl_xor(lsum, 16); lsum += __shfl_xor(lsum, 32);
        const float inv = 1.f / lsum;
#pragma unroll
        for (int d = 0; d < 4; ++d) { const f32x4 v = o[d] * inv;
            *(u32x2*)(OA + (size_t)(row0 + q) * 1024 + h * 64 + d * 16 + 4 * g) = (u32x2){cvt_pk_bf16(v[0], v[1]), cvt_pk_bf16(v[2], v[3])}; }
    }
}

__device__ __forceinline__ void phase_b(const bf16_t* PIN, const bf16_t* WpT, const float* pscale, bf16_t* OB, int gw, int ngw, int lane) {
    const int q = lane & 15, g4 = lane >> 4;
    for (int L = gw; L < 4096; L += ngw) {
        const int gp = L >> 10, tg = L & 1023; const int row = tg * 16 + q; const int t = row & (SEQ - 1);
        const int win = 2 << gp; const int cnt = (t + 1 < win) ? t + 1 : win; const float inv = 1.f / (float)cnt;
        f32x4 acc[4];
#pragma unroll
        for (int d = 0; d < 4; ++d) acc[d] = (f32x4){0.f, 0.f, 0.f, 0.f};
#pragma unroll
        for (int ch = 0; ch < 2; ++ch) {
            const bf16_t* p = PIN + (size_t)row * 256 + gp * 64 + ch * 32 + 8 * g4;
            u32x4 wv[16];
#pragma unroll
            for (int i = 0; i < 16; ++i) { wv[i] = (u32x4){0u, 0u, 0u, 0u}; if (i < win && i <= t) wv[i] = *(const u32x4*)(p - (size_t)i * 256); }
            float own[8], sum[8];
            own[0] = bflo(wv[0].x); own[1] = bfhi(wv[0].x); own[2] = bflo(wv[0].y); own[3] = bfhi(wv[0].y); own[4] = bflo(wv[0].z); own[5] = bfhi(wv[0].z); own[6] = bflo(wv[0].w); own[7] = bfhi(wv[0].w);
#pragma unroll
            for (int k = 0; k < 8; ++k) sum[k] = own[k];
#pragma unroll
            for (int i = 1; i < 16; ++i) { const u32x4 v = wv[i];
                sum[0] += bflo(v.x); sum[1] += bfhi(v.x); sum[2] += bflo(v.y); sum[3] += bfhi(v.y); sum[4] += bflo(v.z); sum[5] += bfhi(v.z); sum[6] += bflo(v.w); sum[7] += bfhi(v.w); }
            float pl[8];
#pragma unroll
            for (int k = 0; k < 8; ++k) pl[k] = sum[k] * inv - own[k];
            const bf16x8 bfr = mk8(cvt_pk_bf16(pl[0], pl[1]), cvt_pk_bf16(pl[2], pl[3]), cvt_pk_bf16(pl[4], pl[5]), cvt_pk_bf16(pl[6], pl[7]));
#pragma unroll
            for (int d = 0; d < 4; ++d) { const bf16x8 afr = *(const bf16x8*)(WpT + gp * 4096 + (d * 16 + q) * 64 + ch * 32 + 8 * g4); acc[d] = mfma16(afr, bfr, acc[d]); }
        }
#pragma unroll
        for (int d = 0; d < 4; ++d) { const int d0 = d * 16 + 4 * g4; const f32x4 sc = *(const f32x4*)(pscale + gp * 64 + d0); const f32x4 v = acc[d] * sc;
            *(u32x2*)(OB + (size_t)row * 1024 + gp * 64 + d0) = (u32x2){cvt_pk_bf16(v[0], v[1]), cvt_pk_bf16(v[2], v[3])}; }
    }
}

__device__ __forceinline__ void phase_c(unsigned char* lds, const bf16_t* GV, const bf16_t* GU, bf16_t* OC, const float* gamma, const bf16_t* Wtril, const float* gbias, int tid, int bid, int G) {
    bf16_t* LT = (bf16_t*)lds;
    const int lane = tid & 63, w = __builtin_amdgcn_readfirstlane(tid >> 6), q = lane & 15, g4 = lane >> 4;
    for (int L = bid; L < 512; L += G) {
        const int gp = L & 3, chk = L >> 2; const int R0 = chk * 128;
        {
            const int row = tid >> 2, part = tid & 3;
            const bf16_t* src = GV + (size_t)(R0 + row) * 256 + part * 64;
            float x[64];
#pragma unroll
            for (int k8 = 0; k8 < 8; ++k8) { const u32x4 v = *(const u32x4*)(src + 8 * k8);
                x[8 * k8 + 0] = bflo(v.x); x[8 * k8 + 1] = bfhi(v.x); x[8 * k8 + 2] = bflo(v.y); x[8 * k8 + 3] = bfhi(v.y); x[8 * k8 + 4] = bflo(v.z); x[8 * k8 + 5] = bfhi(v.z); x[8 * k8 + 6] = bflo(v.w); x[8 * k8 + 7] = bfhi(v.w); }
            float s = 0.f;
#pragma unroll
            for (int k = 0; k < 64; ++k) s += x[k];
            s += __shfl_xor(s, 1); s += __shfl_xor(s, 2);
            const float mean = s * (1.f / 256.f); float ss = 0.f;
#pragma unroll
            for (int k = 0; k < 64; ++k) { const float dd = x[k] - mean; ss += dd * dd; }
            ss += __shfl_xor(ss, 1); ss += __shfl_xor(ss, 2);
            const float rstd = __builtin_amdgcn_rsqf(ss * (1.f / 256.f) + EPSN);
            if (part == gp) {
#pragma unroll
                for (int k4 = 0; k4 < 16; ++k4) { const f32x4 gm = *(const f32x4*)(gamma + gp * 64 + 4 * k4);
#pragma unroll
                    for (int i = 0; i < 4; ++i) LT[(4 * k4 + i) * 136 + row] = f2bf((x[4 * k4 + i] - mean) * rstd * gm[i]); }
            }
        }
        __syncthreads();
        {
            f32x4 acc[4];
#pragma unroll
            for (int d = 0; d < 4; ++d) acc[d] = (f32x4){0.f, 0.f, 0.f, 0.f};
            const int t = 16 * w + q; const int nsb = ((16 * w + 15) >> 5) + 1;
            for (int sb = 0; sb < nsb; ++sb) {
                const bf16x8 bfr = *(const bf16x8*)(Wtril + ((size_t)gp * 128 + t) * 128 + sb * 32 + 8 * g4);
#pragma unroll
                for (int d = 0; d < 4; ++d) { const bf16x8 afr = *(const bf16x8*)(LT + (d * 16 + q) * 136 + sb * 32 + 8 * g4); acc[d] = mfma16(afr, bfr, acc[d]); }
            }
            const float bias = gbias[gp * 128 + t];
#pragma unroll
            for (int d = 0; d < 4; ++d) { const size_t eo = (size_t)(R0 + t) * 256 + gp * 64 + d * 16 + 4 * g4; const u32x2 uu = *(const u32x2*)(GU + eo);
                const float r0 = bflo(uu.x) * (acc[d][0] + bias), r1 = bfhi(uu.x) * (acc[d][1] + bias), r2 = bflo(uu.y) * (acc[d][2] + bias), r3 = bfhi(uu.y) * (acc[d][3] + bias);
                *(u32x2*)(OC + (size_t)(R0 + t) * 1024 + gp * 64 + d * 16 + 4 * g4) = (u32x2){cvt_pk_bf16(r0, r1), cvt_pk_bf16(r2, r3)}; }
        }
        __syncthreads();
    }
}

__device__ __forceinline__ void sb_tile(const f32x4 z, int kbase, int tq, int g, float& carry, float (&a)[4]) {
    float lm[4]; bool msk[4];
#pragma unroll
    for (int j = 0; j < 4; ++j) { msk[j] = (kbase + 4 * g + j) >= tq;
        const float e = __builtin_amdgcn_exp2f(-fabsf(z[j]) * LOG2E); const float sp = relu1(z[j]) + __builtin_amdgcn_logf(1.f + e) * LN2;
        lm[j] = msk[j] ? 0.f : -sp; }
    const float suf2 = lm[3], suf1 = lm[3] + lm[2], suf0 = suf1 + lm[1]; const float T = suf0 + lm[0];
    const float x16 = __shfl_xor(T, 16); const float Pp = T + x16; const float Qq = __shfl_xor(Pp, 32);
    const float Sg = ((g & 1) ? 0.f : x16) + ((g & 2) ? 0.f : Qq);
    const float base = carry + Sg;
    const float tl[4] = {base + suf0, base + suf1, base + suf2, base};
#pragma unroll
    for (int j = 0; j < 4; ++j) a[j] = msk[j] ? 0.f : __builtin_amdgcn_exp2f((z[j] + lm[j] + tl[j]) * LOG2E);
    carry += Pp + Qq;
}
__device__ __forceinline__ void phase_d(const bf16_t* SQ, bf16_t* OD, const bf16_t* SK, const bf16_t* VTS, int gw, int ngw, int lane) {
    const int q = lane & 15, g = lane >> 4;
    for (int L0 = gw; L0 < 2048; L0 += ngw) {
        const int blk_ = L0 >> 3, L = ((((blk_ & 7) * 32 + ((blk_ >> 3) & 31)) << 3) | (L0 & 7)) & 2047;
        const int qg = L & 255, bh = L >> 8, b0 = bh >> 2, h = bh & 3;
        const int tq = qg * 16 + q;
        bf16x8 qf[2][2]; f32x4 o[2][4]; float carry[2] = {0.f, 0.f};
#pragma unroll
        for (int u = 0; u < 2; ++u) { const int row0 = (b0 + 2 * u) * SEQ + qg * 16;
#pragma unroll
            for (int hf = 0; hf < 2; ++hf) qf[u][hf] = *(const bf16x8*)(SQ + (size_t)(row0 + q) * 256 + h * 64 + hf * 32 + 8 * g);
#pragma unroll
            for (int d = 0; d < 4; ++d) o[u][d] = (f32x4){0.f, 0.f, 0.f, 0.f}; }
        bf16x8 kn[2][4]; u32x2 vn[2][8];
#define D_LOAD(ppx) do { const int k0_ = (ppx) * 32; _Pragma("unroll") for (int u = 0; u < 2; ++u) { const int b = b0 + 2 * u; \
                const bf16_t* kb = SK + (size_t)(b * SEQ + k0_ + q) * 256 + h * 64 + 8 * g; \
                _Pragma("unroll") for (int i = 0; i < 4; ++i) kn[u][i] = *(const bf16x8*)(kb + (size_t)(i >> 1) * 16 * 256 + (i & 1) * 32); \
                const bf16_t* vb = VTS + (size_t)(b * 256 + h * 64 + q) * SEQ + k0_ + 4 * g; \
                _Pragma("unroll") for (int d = 0; d < 4; ++d) { vn[u][2 * d] = *(const u32x2*)(vb + (size_t)d * 16 * SEQ); vn[u][2 * d + 1] = *(const u32x2*)(vb + (size_t)d * 16 * SEQ + 16); } } } while (0)
        D_LOAD(qg >> 1);
        for (int pp = qg >> 1; pp >= 0; --pp) {
            const int kt0 = 2 * pp, kt1 = kt0 + 1;
            bf16x8 kc[2][4]; u32x2 vc[2][8];
#pragma unroll
            for (int u = 0; u < 2; ++u) {
#pragma unroll
                for (int i = 0; i < 4; ++i) kc[u][i] = kn[u][i];
#pragma unroll
                for (int i = 0; i < 8; ++i) vc[u][i] = vn[u][i]; }
            D_LOAD(pp > 0 ? pp - 1 : 0);
            float a0[2][4], a1[2][4];
#pragma unroll
            for (int u = 0; u < 2; ++u) {
                if (kt1 <= qg) {
                    f32x4 z = mfma16(kc[u][2], qf[u][0], (f32x4){0.f, 0.f, 0.f, 0.f}); z = mfma16(kc[u][3], qf[u][1], z);
                    sb_tile(z, kt1 * 16, tq, g, carry[u], a1[u]);
                } else {
#pragma unroll
                    for (int j = 0; j < 4; ++j) a1[u][j] = 0.f;
                }
            }
#pragma unroll
            for (int u = 0; u < 2; ++u) {
                f32x4 z = mfma16(kc[u][0], qf[u][0], (f32x4){0.f, 0.f, 0.f, 0.f}); z = mfma16(kc[u][1], qf[u][1], z);
                sb_tile(z, kt0 * 16, tq, g, carry[u], a0[u]);
            }
#pragma unroll
            for (int u = 0; u < 2; ++u) {
                const bf16x8 pf = mk8(cvt_pk_bf16(a0[u][0], a0[u][1]), cvt_pk_bf16(a0[u][2], a0[u][3]), cvt_pk_bf16(a1[u][0], a1[u][1]), cvt_pk_bf16(a1[u][2], a1[u][3]));
#pragma unroll
                for (int d = 0; d < 4; ++d) o[u][d] = mfma16(mk8(vc[u][2 * d].x, vc[u][2 * d].y, vc[u][2 * d + 1].x, vc[u][2 * d + 1].y), pf, o[u][d]);
            }
            if (__all(carry[0] < -104.f && carry[1] < -104.f)) break;
        }
#undef D_LOAD
#pragma unroll
        for (int u = 0; u < 2; ++u) { const int row0 = (b0 + 2 * u) * SEQ + qg * 16;
#pragma unroll
            for (int d = 0; d < 4; ++d) *(u32x2*)(OD + (size_t)(row0 + q) * 1024 + h * 64 + d * 16 + 4 * g) = (u32x2){cvt_pk_bf16(o[u][d][0], o[u][d][1]), cvt_pk_bf16(o[u][d][2], o[u][d][3])}; }
    }
}

#define XB_TMO      128
#define XB_XCNT(j)  (256  + 64 * (j))
#define XB_XSUB(j)  (1280 + 64 * (j))
#define XB_XGEN(j)  (2304 + 64 * (j))
#define XB_TOP      3328
#define XB_TOPGEN   3392
#define XCD_BAR_WORDS 3456
#define XB_SPIN_CAP (1u << 18)

__device__ __forceinline__ unsigned xb_ld(unsigned* p)              { return __hip_atomic_load(p, __ATOMIC_RELAXED, __HIP_MEMORY_SCOPE_AGENT); }
__device__ __forceinline__ unsigned xb_add(unsigned* p, unsigned v) { return __hip_atomic_fetch_add(p, v, __ATOMIC_RELAXED, __HIP_MEMORY_SCOPE_AGENT); }
__device__ __forceinline__ unsigned xb_xcc_id() { return (unsigned)__builtin_amdgcn_s_getreg((3 << 11) | 20) & 0xFu; }
#define XB_SPIN(cond, bar) do { unsigned _sp = 0; while (cond) { __builtin_amdgcn_s_sleep(1); \
    if ((++_sp & 255u) == 0u) { if (xb_ld(&(bar)[XB_TMO])) break; if (_sp > XB_SPIN_CAP) { atomicAdd(&(bar)[XB_TMO], 1u); break; } } } } while (0)

struct XcdBarrier {
    unsigned* bar; unsigned x;
    volatile LAS unsigned* st;
};

__device__ __forceinline__ XcdBarrier xcd_barrier_post(unsigned* bar, volatile LAS unsigned* st) {
    XcdBarrier b; b.bar = bar; b.x = xb_xcc_id(); b.st = st;
    if (threadIdx.x == 0) (void)xb_add(&bar[XB_XCNT(b.x)], 1u);
    return b;
}
__device__ __forceinline__ void xcd_barrier_complete(unsigned* bar, unsigned x, unsigned& nloc, unsigned& nx) {
    const unsigned G = gridDim.x * gridDim.y * gridDim.z;
    unsigned sum, cnt, mine, sp = 0u;
    for (;;) {
        sum = 0u; cnt = 0u; mine = 0u;
#pragma unroll
        for (unsigned j = 0; j < 16; ++j) { const unsigned c = xb_ld(&bar[XB_XCNT(j)]); sum += c; cnt += (c > 0u) ? 1u : 0u; mine = (j == x) ? c : mine; }
        if (sum == G) break;
        __builtin_amdgcn_s_sleep(1);
        if ((++sp & 255u) == 0u) { if (xb_ld(&bar[XB_TMO])) break; if (sp > XB_SPIN_CAP) { atomicAdd(&bar[XB_TMO], 1u); break; } }
    }
    nloc = mine > 0u ? mine : 1u; nx = cnt > 0u ? cnt : 1u;
}

__device__ __forceinline__ void xcd_barrier(const XcdBarrier& b) {
    asm volatile("s_waitcnt vmcnt(0)" ::: "memory");
    __syncthreads();
    if (threadIdx.x == 0) {
        unsigned* bar = b.bar;
        __builtin_amdgcn_s_waitcnt(0);
        unsigned nloc = b.st[0], nx = b.st[1];
        if (nloc == 0u) { xcd_barrier_complete(bar, b.x, nloc, nx); b.st[0] = nloc; b.st[1] = nx; }
        const unsigned old = xb_add(&bar[XB_XSUB(b.x)], 1u);
        const unsigned gen = old / nloc;
        if (old + 1u == (gen + 1u) * nloc) {
            __builtin_amdgcn_fence(__ATOMIC_RELEASE, "agent");
            asm volatile("s_waitcnt vmcnt(0)" ::: "memory");
            const unsigned og = xb_add(&bar[XB_TOP], 1u);
            const unsigned tg = og / nx;
            if (og + 1u == (tg + 1u) * nx) xb_add(&bar[XB_TOPGEN], 1u);
            else XB_SPIN(xb_ld(&bar[XB_TOPGEN]) == tg, bar);
            __builtin_amdgcn_fence(__ATOMIC_ACQUIRE, "agent");
            xb_add(&bar[XB_XGEN(b.x)], 1u);
            asm volatile("s_waitcnt vmcnt(0)" ::: "memory");
        } else {
            XB_SPIN(xb_ld(&bar[XB_XGEN(b.x)]) == gen, bar);
            __builtin_amdgcn_fence(__ATOMIC_ACQUIRE, "agent");
            asm volatile("s_waitcnt vmcnt(0)" ::: "memory");
        }
    }
    __syncthreads();
}

#ifndef REP_P0
#define REP_P0 1
#endif
#ifndef REP_P1
#define REP_P1 1
#endif
#ifndef REP_A1
#define REP_A1 1
#endif
#ifndef REP_BCD
#define REP_BCD 1
#endif
#ifndef REP_A2
#define REP_A2 1
#endif
#ifndef REP_MG
#define REP_MG 1
#endif
#ifndef REP_UP
#define REP_UP 1
#endif
#ifndef REP_WO
#define REP_WO 1
#endif
#ifndef REP_N2
#define REP_N2 1
#endif
#ifndef REP_DN
#define REP_DN 1
#endif
#ifndef REP_B
#define REP_B 1
#endif
#ifndef REP_C
#define REP_C 1
#endif
#ifndef REP_D
#define REP_D 1
#endif
#ifndef REP_SYNC
#define REP_SYNC 1
#endif
#define GSYNC() do { _Pragma("unroll 1") for (int r_ = 0; r_ < REP_SYNC; ++r_) xcd_barrier(bar); } while (0)
#define REPEAT(n) _Pragma("unroll 1") for (int rep_ = 0; rep_ < (n); ++rep_)
struct Args { const float* in[16]; float* out; unsigned char* ws; };
constexpr int LDS_BYTES = 147456;
__device__ __forceinline__ unsigned char* opq(unsigned char* p) { asm volatile("" : "+s"(p)); return p; }
__device__ __forceinline__ int opq_tid() { int t = threadIdx.x; asm volatile("" : "+v"(t)); return t; }
#define WSB(T, off) ((T*)(ws + (off)))
constexpr int PTAB_OFF = 147456 - 512, BST_OFF = 147456 - 64;
__device__ __forceinline__ void* ldp(PG8_LAS unsigned char* ldsl, int i) {
    unsigned off = PTAB_OFF + 8 * i; asm volatile("" : "+v"(off));
    const unsigned long long v = *(volatile LAS unsigned long long*)(ldsl + off);
    const unsigned lo = __builtin_amdgcn_readfirstlane((unsigned)v), hi = __builtin_amdgcn_readfirstlane((unsigned)(v >> 32));
    return (void*)(__attribute__((address_space(1))) void*)(((unsigned long long)hi << 32) | lo);
}

__global__ void __launch_bounds__(512, 2) fwd_kernel(Args a) {
    extern __shared__ __attribute__((aligned(16))) unsigned char lds[];
    cg::grid_group grid = cg::this_grid();
    PG8_LAS unsigned char* ldsl = (PG8_LAS unsigned char*)lds;
    if (a.ws == nullptr) grid.sync();
    if (threadIdx.x == 0) { ((volatile LAS unsigned*)(ldsl + BST_OFF))[0] = 0u; ((volatile LAS unsigned*)(ldsl + BST_OFF))[1] = 0u; }
    if (threadIdx.x == 0) { LAS unsigned long long* tb = (LAS unsigned long long*)(ldsl + PTAB_OFF);
#pragma unroll
        for (int i = 0; i < 16; ++i) tb[i] = (unsigned long long)a.in[i];
        tb[16] = (unsigned long long)a.out; tb[17] = (unsigned long long)a.ws; }
    __syncthreads();
    XcdBarrier bar = xcd_barrier_post((unsigned*)a.ws + 1024, (volatile LAS unsigned*)(ldsl + BST_OFF));
#define INP(i) ((const float*)ldp(ldsl, (i)))
#define OUTP ((float*)ldp(ldsl, 16))
#define WSP ((unsigned char*)ldp(ldsl, 17))

#define PHASE_VARS unsigned char* ws = WSP; int bid = blockIdx.x; asm volatile("" : "+s"(bid)); int G = gridDim.x; asm volatile("" : "+s"(G)); \
    const int tid = opq_tid(), lane = tid & 63, wave = __builtin_amdgcn_readfirstlane(tid >> 6); const int gw = bid * 8 + wave, ngw = G * 8; (void)ws; (void)lane; (void)gw; (void)ngw;
#ifndef REP_ALL
#define REP_ALL 1
#endif
#pragma unroll 1
    for (int ll = 0; ll < 2 * REP_ALL; ++ll) {
        const int l = ll & 1;
        REPEAT(REP_P0) {
            PHASE_VARS
#ifndef NO_CVT
            Ptrs P; P.mix_g = INP(1) + l * DM; P.ffn_g = INP(12) + l * DM;
            P.w_in = INP(2) + (size_t)l * DM * DIN; P.qn = INP(3) + l * 64; P.kn = INP(4) + l * 64; P.pool_w = INP(5) + l * 4 * 64 * 64; P.pool_scale = INP(6) + l * 256;
            P.gm_norm = INP(7) + l * 256; P.gm_ws = INP(8) + l * 4 * 128 * 128; P.gm_b = INP(9) + l * 4 * 128; P.w_branch = INP(10) + (size_t)l * 4 * 256 * 1024;
            P.w_out = INP(11) + (size_t)l * 1024 * 1024; P.w_gate = INP(13) + (size_t)l * DM * DFF; P.w_up = INP(14) + (size_t)l * DM * DFF; P.w_down = INP(15) + (size_t)l * DFF * DM;
            convert_weights(P, ws, (LAS float*)(ldsl + wave * 8448), gw, ngw, lane, bid * 512 + tid, G * 512);
#endif
            if (l == 0) x_to_bf16_ss(INP(0), WSB(bf16_t, WS_XN), WSB(float, WS_SS0), gw, ngw, lane);
        }
        GSYNC();
        REPEAT(REP_P1) {
            PHASE_VARS
            pg8::Gemm g{WSB(bf16_t, WS_XN), WSB(bf16_t, WS_WIN), M_, NINP, DM}; pg8::StaticOrder S; S.init(M_, NINP, G, bid);
            EpiIn E{ws, INP(3) + l * 64, INP(4) + l * 64, WSB(float, WS_SS0)};
#ifndef NO_G1
            pg8::gemm_phase<EpiIn, pg8::StaticOrder, true, true>(ldsl, g, S, E);
#endif
        }
        GSYNC();
        REPEAT(REP_A1) {
            PHASE_VARS
            for (int i = bid * 512 + tid; i < M_; i += G * 512) { WSB(float, WS_SS0)[i] = 0.f; WSB(float, WS_SS1)[i] = 0.f; }
#ifndef NO_A1
            phase_a1(lds, WSB(bf16_t, WS_IQ), WSB(bf16_t, WS_IK), WSB(float, WS_IW), WSB(unsigned short, WS_MASK), tid, bid, G);
#endif
            __syncthreads();
        }
        REPEAT(REP_BCD) {
        REPEAT(REP_C) {
            PHASE_VARS
#ifndef NO_C
            phase_c(lds, WSB(bf16_t, WS_GV), WSB(bf16_t, WS_GU), WSB(bf16_t, WS_OCAT) + 512, INP(7) + l * 256, WSB(bf16_t, WS_WS), INP(9) + l * 4 * 128, tid, bid, G);
#endif
        }
        REPEAT(REP_B) {
            PHASE_VARS
#ifndef NO_B
            phase_b(WSB(bf16_t, WS_PIN), WSB(bf16_t, WS_WP), INP(6) + l * 256, WSB(bf16_t, WS_OCAT) + 256, gw, ngw, lane);
#endif
        }
        REPEAT(REP_D) {
            PHASE_VARS
#ifndef NO_D
            phase_d(WSB(bf16_t, WS_SQ), WSB(bf16_t, WS_OCAT) + 768, WSB(bf16_t, WS_SK), WSB(bf16_t, WS_VTS), gw, ngw, lane);
#endif
        }
        }
        GSYNC();
        REPEAT(REP_A2) {
            PHASE_VARS
#ifndef NO_A2
            phase_a2(lds, WSB(bf16_t, WS_QA), WSB(bf16_t, WS_OCAT), WSB(bf16_t, WS_KA), WSB(bf16_t, WS_VTA), WSB(unsigned short, WS_MASK), INP(3) + l * 64, INP(4) + l * 64, tid, bid, G);
#endif
        }
        GSYNC();
        REPEAT(REP_MG) {
            PHASE_VARS
            pg8::Gemm g{WSB(bf16_t, WS_OCAT), WSB(bf16_t, WS_WB), M_, DM, DM}; pg8::StaticOrder S; S.init(M_, DM, G, bid);
            EpiMerge E{ws + WS_G, WSB(bf16_t, WS_XN)};
#ifndef NO_G2
            pg8::gemm_phase<EpiMerge, pg8::StaticOrder, true, true>(ldsl, g, S, E);
#endif
        }
        GSYNC();
        REPEAT(REP_WO) {
            PHASE_VARS
            pg8::Gemm g{WSB(bf16_t, WS_XN), WSB(bf16_t, WS_WOUT), M_, DM, DM}; pg8::StaticOrder S; S.init(M_, DM, G, bid);
            EpiResid E{l == 0 ? INP(0) : OUTP, OUTP, WSB(bf16_t, WS_S), WSB(float, WS_SS1), 1};
#ifndef NO_G3
            pg8::gemm_phase<EpiResid, pg8::StaticOrder, true, true>(ldsl, g, S, E);
#endif
        }
        GSYNC();
        REPEAT(REP_UP) {
            PHASE_VARS
            pg8::Gemm g{WSB(bf16_t, WS_S), WSB(bf16_t, WS_WGU), M_, 2 * DFF, DM}; pg8::StaticOrder S; S.init(M_, 2 * DFF, G, bid);
            EpiSwiGLU E{WSB(bf16_t, WS_R1), WSB(float, WS_SS1)};
#ifndef NO_G4
            pg8::gemm_phase<EpiSwiGLU, pg8::StaticOrder, true, true>(ldsl, g, S, E);
#endif
        }
        GSYNC();
        REPEAT(REP_DN) {
            PHASE_VARS
            pg8::Gemm g{WSB(bf16_t, WS_R1), WSB(bf16_t, WS_WD), M_, DM, DFF}; pg8::StaticOrder S; S.init(M_, DM, G, bid);
            float* o = OUTP; EpiResid E{o, o, WSB(bf16_t, WS_XN), WSB(float, WS_SS0), l == 0 ? 1 : 0};
#ifndef NO_G3
            pg8::gemm_phase<EpiResid, pg8::StaticOrder, true, true>(ldsl, g, S, E);
#endif
        }
        if (ll + 1 < 2 * REP_ALL) GSYNC();
    }
}

extern "C" void kernel_launch(void* const* d_in, const int* in_sizes, int n_in, void* d_out, int out_size, void* d_ws, size_t ws_size, hipStream_t stream) {
    static int grid_blocks = 0;
    if (grid_blocks == 0) {
        if (n_in != 16 || out_size != M_ * DM || ws_size < WS_END) { fprintf(stderr, "kernel_launch: unexpected shapes (n_in %d out %d ws %zu)\n", n_in, out_size, ws_size); grid_blocks = -1; return; }
        int dev = 0, cus = 0, per_cu = 0;
        hipGetDevice(&dev);
        hipDeviceGetAttribute(&cus, hipDeviceAttributeMultiprocessorCount, dev);
        hipFuncSetAttribute((const void*)fwd_kernel, hipFuncAttributeMaxDynamicSharedMemorySize, LDS_BYTES);
        if (hipOccupancyMaxActiveBlocksPerMultiprocessor(&per_cu, (const void*)fwd_kernel, 512, LDS_BYTES) != hipSuccess || per_cu < 1) per_cu = 1;
        (void)hipGetLastError();
        grid_blocks = cus;
    }
    if (grid_blocks < 0) return;
    Args a{};
    for (int i = 0; i < 16; ++i) a.in[i] = (const float*)d_in[i];
    a.out = (float*)d_out; a.ws = (unsigned char*)d_ws;
    if (hipMemsetAsync(d_ws, 0, 20480, stream) != hipSuccess) { fprintf(stderr, "kernel_launch: memset failed\n"); return; }
    void* args[] = {&a};
    hipError_t e = hipLaunchCooperativeKernel((const void*)fwd_kernel, dim3(grid_blocks), dim3(512), args, LDS_BYTES, stream);
    if (e != hipSuccess) fprintf(stderr, "cooperative launch failed: %s (grid %d)\n", hipGetErrorString(e), grid_blocks);
}
```

```cpp
#include <hip/hip_runtime.h>
#include <hip/hip_cooperative_groups.h>
#include <cstdio>
#include <cstdint>
namespace pg8 {
#define PG8_LAS __attribute__((address_space(3)))
typedef unsigned short bf16_t;
typedef short bf16x8 __attribute__((ext_vector_type(8)));
typedef float f32x4 __attribute__((ext_vector_type(4)));
typedef unsigned u32x4 __attribute__((ext_vector_type(4)));
constexpr int BM = 256, BK = 64, HALF = 128, HTB = HALF * BK * 2  , STAGE_BYTES = 8 * HTB, NXCD = 8, WGM = 8;

__host__ __device__ __forceinline__ int lds_byte(int r, int c) { const int st = (r >> 4) * 2 + (c >> 5), rr = r & 15, cc = c & 31, ob = rr * 64 + cc * 2; return st * 1024 + (ob ^ (((ob >> 9) & 1) << 5)); }
__host__ __device__ __forceinline__ void stage_rc(int b, int& R, int& C) { const int st = b / 1024, sb = b % 1024, swz = sb ^ (((sb >> 9) & 1) << 5); R = (st >> 1) * 16 + swz / 64; C = (st & 1) * 32 + (swz % 64) / 2; }
__host__ __device__ __forceinline__ int perm32(int rho) { const int n = rho >> 4, i = rho & 15; return 8 * (i >> 2) + 4 * n + (i & 3); }

struct Unit { int pm, pn; };
struct Gemm { const bf16_t* A; const bf16_t* Bt; int M, N, K; };

struct StaticOrder {
    int nM, nN, nwg, G, c;
    __host__ __device__ void init(int M, int N, int G_, int c_) { nM = M / BM; nN = N / BM; nwg = nM * nN; G = G_; c = c_; }
    __host__ __device__ bool next(int i, Unit& u) const {
        const long L = (long)i * G + c; if (L >= nwg) return false;
        int wgid = (int)L; { const int q = nwg / NXCD, r = nwg % NXCD, xcd = wgid % NXCD, off = wgid / NXCD; wgid = (xcd < r ? xcd * (q + 1) : r * (q + 1) + (xcd - r) * q) + off; }
        const int nig = WGM * nN, gid = wgid / nig, fm = gid * WGM, gsz = (nM - fm) < WGM ? (nM - fm) : WGM;
        u.pm = fm + ((wgid % nig) % gsz); u.pn = (wgid % nig) / gsz; return true;
    }
    __device__ __forceinline__ void a_ready(const Unit&) const {}
    __device__ __forceinline__ void done(const Unit&) const {}
};

__device__ __forceinline__ unsigned cvt_pk_bf16(float lo, float hi) { unsigned r; asm volatile("v_cvt_pk_bf16_f32 %0, %1, %2" : "=v"(r) : "v"(lo), "v"(hi)); return r; }
template <class Epi, class Sched, bool ALIGN_EPI = false, bool SP2 = false>
__device__ __forceinline__ void gemm_phase(PG8_LAS unsigned char* lds, const Gemm g, const Sched& S, const Epi& E) {
    int tid_ = threadIdx.x; asm volatile("" : "+v"(tid_)); const int tid = tid_, wid = __builtin_amdgcn_readfirstlane(tid >> 6), lane = tid & 63, wr = wid >> 2, wc = wid & 3, fr = lane & 15, fq = lane >> 4;
    const int K = g.K, nt = K / BK;
    unsigned voffA[2], voffB[2];
#pragma unroll
    for (int i = 0; i < 2; ++i) { int R, C; stage_rc(tid * 16 + i * 8192, R, C); const int Rb = Epi::PERM ? ((R & ~31) + perm32(R & 31)) : R;
        voffA[i] = (unsigned)(R * K + C) * 2u; voffB[i] = (unsigned)(Rb * K + C) * 2u; }
    const size_t kstep = (size_t)(BK * 2);
    const size_t hstep = (size_t)HALF * K * 2;
    const size_t tstep = 2 * hstep;
    const unsigned ldsw = (unsigned)wid * 1024u;
    const int aoff = lds_byte(wr * 64 + fr, fq * 8), boff = lds_byte(wc * 32 + fr, fq * 8);
#define PG8_SA(b, h) (((b) * 2 + (h)) * HTB)
#define PG8_SB(b, h) ((4 + (b) * 2 + (h)) * HTB)
#define PG8_STAGE(bufoff, gbase, voff) do { _Pragma("unroll") for (int _i = 0; _i < 2; ++_i) \
        __builtin_amdgcn_global_load_lds((const unsigned*)((const char*)(gbase) + (voff)[_i]), (PG8_LAS unsigned*)(lds + (bufoff) + ldsw + _i * 8192), 16, 0, 0); } while (0)
#define PG8_LDA(dst, b, h) do { _Pragma("unroll") for (int m = 0; m < 4; ++m) _Pragma("unroll") for (int k = 0; k < 2; ++k) dst[m][k] = *(const PG8_LAS bf16x8*)(lds + PG8_SA(b, h) + aoff + m * 2048 + k * 1024); } while (0)
#define PG8_LDB(dst, b, h) do { _Pragma("unroll") for (int n = 0; n < 2; ++n) _Pragma("unroll") for (int k = 0; k < 2; ++k) dst[n][k] = *(const PG8_LAS bf16x8*)(lds + PG8_SB(b, h) + boff + n * 2048 + k * 1024); } while (0)
#define PG8_MMA(ai, bj, At, Bt) do { __builtin_amdgcn_s_setprio(1); _Pragma("unroll") for (int m = 0; m < 4; ++m) _Pragma("unroll") for (int n = 0; n < 2; ++n) _Pragma("unroll") for (int k = 0; k < 2; ++k) \
        acc[ai][bj][m][n] = __builtin_amdgcn_mfma_f32_16x16x32_bf16(Bt[n][k], At[m][k], acc[ai][bj][m][n], 0, 0, 0); __builtin_amdgcn_s_setprio(0); } while (0)
#define PG8_WAIT_V(n) asm volatile("s_waitcnt vmcnt(" #n ")" ::: "memory")
#define PG8_WAIT_L(n) asm volatile("s_waitcnt lgkmcnt(" #n ")" ::: "memory")
#define PG8_BAR __builtin_amdgcn_s_barrier()
#define PG8_SCHED __builtin_amdgcn_sched_barrier(0)
    Unit cur, nxt; int ui = 0;
    if (!S.next(0, cur)) return;
    f32x4 acc[2][2][4][2];
#pragma unroll
    for (int a = 0; a < 2; ++a)
#pragma unroll
        for (int b = 0; b < 2; ++b)
#pragma unroll
            for (int m = 0; m < 4; ++m)
#pragma unroll
                for (int n = 0; n < 2; ++n) acc[a][b][m][n] = (f32x4){0.f, 0.f, 0.f, 0.f};
    bf16x8 At[4][2], B0[2][2], B1[2][2];
    const char* cA = (const char*)g.A + (size_t)cur.pm * tstep; const char* cB = (const char*)g.Bt + (size_t)cur.pn * tstep;
    S.a_ready(cur);
    if constexpr (SP2) {
        PG8_STAGE(PG8_SB(0, 0), cB, voffB); PG8_STAGE(PG8_SB(0, 1), cB + hstep, voffB); PG8_STAGE(PG8_SA(0, 0), cA, voffA); PG8_STAGE(PG8_SA(0, 1), cA + hstep, voffA);
        if (wr == 1) PG8_BAR;
        PG8_WAIT_V(2); PG8_BAR;
        PG8_STAGE(PG8_SB(1, 0), cB + kstep, voffB); PG8_STAGE(PG8_SA(1, 0), cA + kstep, voffA); PG8_STAGE(PG8_SB(1, 1), cB + hstep + kstep, voffB);
        PG8_WAIT_V(6); PG8_BAR;
    } else {
        PG8_STAGE(PG8_SB(0, 0), cB, voffB); PG8_STAGE(PG8_SA(0, 0), cA, voffA); PG8_STAGE(PG8_SB(0, 1), cB + hstep, voffB); PG8_STAGE(PG8_SA(0, 1), cA + hstep, voffA);
        if (wr == 1) PG8_BAR;
        PG8_WAIT_V(4); PG8_BAR;
        PG8_STAGE(PG8_SB(1, 0), cB + kstep, voffB); PG8_STAGE(PG8_SA(1, 0), cA + kstep, voffA); PG8_STAGE(PG8_SB(1, 1), cB + hstep + kstep, voffB);
        PG8_WAIT_V(6); PG8_BAR;
    }
    for (;;) {
        const bool has_next = S.next(ui + 1, nxt);
        const char* nA = has_next ? (const char*)g.A + (size_t)nxt.pm * tstep : cA; const char* nB = has_next ? (const char*)g.Bt + (size_t)nxt.pn * tstep : cB;
        for (int t = 0; t < nt; t += 2) {
            if constexpr (Epi::HOOK) { if (t != 0 && (t & 3) == 0) E.hook(acc, cur, (t >> 2) - 1, wr, wc, fr, fq); }
            const bool last = (t == nt - 2);
            const char* a1 = cA + (size_t)(t + 1) * kstep;
            const char* a2 = last ? nA : cA + (size_t)(t + 2) * kstep; const char* b2 = last ? nB : cB + (size_t)(t + 2) * kstep;
            const char* a3 = a2 + kstep; const char* b3 = b2 + kstep;
            if (last && has_next) S.a_ready(nxt);
            if constexpr (SP2) {
            PG8_LDB(B0, 0, 0); PG8_LDB(B1, 0, 1); PG8_SCHED; PG8_LDA(At, 0, 0); PG8_STAGE(PG8_SA(1, 1), a1 + hstep, voffA);
            PG8_WAIT_V(8); PG8_WAIT_L(0); PG8_BAR; PG8_MMA(0, 0, At, B0); PG8_MMA(0, 1, At, B1); PG8_BAR; PG8_SCHED;
            PG8_LDA(At, 0, 1); PG8_STAGE(PG8_SB(0, 0), b2, voffB); PG8_STAGE(PG8_SB(0, 1), b2 + hstep, voffB); PG8_STAGE(PG8_SA(0, 0), a2, voffA);
            PG8_WAIT_V(8); PG8_WAIT_L(0); PG8_BAR; PG8_MMA(1, 0, At, B0); PG8_MMA(1, 1, At, B1); PG8_BAR; PG8_SCHED;
            PG8_LDB(B0, 1, 0); PG8_LDB(B1, 1, 1); PG8_SCHED; PG8_LDA(At, 1, 0); PG8_STAGE(PG8_SA(0, 1), a2 + hstep, voffA);
            PG8_WAIT_V(8); PG8_WAIT_L(0); PG8_BAR; PG8_MMA(0, 0, At, B0); PG8_MMA(0, 1, At, B1); PG8_BAR; PG8_SCHED;
            PG8_LDA(At, 1, 1); PG8_STAGE(PG8_SB(1, 0), b3, voffB); PG8_STAGE(PG8_SB(1, 1), b3 + hstep, voffB); PG8_STAGE(PG8_SA(1, 0), a3, voffA);
            PG8_WAIT_V(8); PG8_WAIT_L(0); PG8_BAR; PG8_MMA(1, 0, At, B0); PG8_MMA(1, 1, At, B1); PG8_BAR; PG8_SCHED;
            } else {
            PG8_LDB(B0, 0, 0); PG8_SCHED; PG8_LDA(At, 0, 0); PG8_STAGE(PG8_SA(1, 1), a1 + hstep, voffA);
            PG8_WAIT_L(8); PG8_BAR; PG8_WAIT_L(0); PG8_MMA(0, 0, At, B0); PG8_BAR; PG8_SCHED;
            PG8_LDB(B1, 0, 1); PG8_STAGE(PG8_SB(0, 0), b2, voffB);
            PG8_BAR; PG8_WAIT_L(0); PG8_MMA(0, 1, At, B1); PG8_BAR;
            PG8_LDA(At, 0, 1); PG8_STAGE(PG8_SA(0, 0), a2, voffA);
            PG8_BAR; PG8_WAIT_L(0); PG8_MMA(1, 0, At, B0); PG8_BAR; PG8_SCHED;
            PG8_STAGE(PG8_SB(0, 1), b2 + hstep, voffB);
            PG8_WAIT_V(6); PG8_BAR; PG8_MMA(1, 1, At, B1); PG8_BAR;
            PG8_LDB(B0, 1, 0); PG8_SCHED; PG8_LDA(At, 1, 0); PG8_STAGE(PG8_SA(0, 1), a2 + hstep, voffA);
            PG8_WAIT_L(8); PG8_BAR; PG8_WAIT_L(0); PG8_MMA(0, 0, At, B0); PG8_BAR; PG8_SCHED;
            PG8_LDB(B1, 1, 1); PG8_STAGE(PG8_SB(1, 0), b3, voffB);
            PG8_BAR; PG8_WAIT_L(0); PG8_MMA(0, 1, At, B1); PG8_BAR;
            PG8_LDA(At, 1, 1); PG8_STAGE(PG8_SA(1, 0), a3, voffA);
            PG8_BAR; PG8_WAIT_L(0); PG8_MMA(1, 0, At, B0); PG8_BAR; PG8_SCHED;
            PG8_STAGE(PG8_SB(1, 1), b3 + hstep, voffB);
            PG8_WAIT_V(6); PG8_BAR; PG8_MMA(1, 1, At, B1); PG8_BAR;
            }
        }
        if constexpr (ALIGN_EPI) { if (wr == 0) PG8_BAR; }
        if constexpr (!Epi::AFTER_DRAIN) { E(acc, cur, wr, wc, fr, fq); if constexpr (Epi::EPI_TWICE) { E(acc, cur, wr, wc, fr, fq); } S.done(cur); }
        if (!has_next) break;
#pragma unroll
        for (int a = 0; a < 2; ++a)
#pragma unroll
            for (int b = 0; b < 2; ++b)
#pragma unroll
                for (int m = 0; m < 4; ++m)
#pragma unroll
                    for (int n = 0; n < 2; ++n) acc[a][b][m][n] = (f32x4){0.f, 0.f, 0.f, 0.f};
        cur = nxt; cA = nA; cB = nB; ++ui;
        if constexpr (ALIGN_EPI) { if (wr == 1) PG8_BAR; }
    }
    PG8_WAIT_V(0);
    if constexpr (!ALIGN_EPI) { if (wr == 0) PG8_BAR; }
    PG8_BAR;
    if constexpr (Epi::AFTER_DRAIN) { E.fused(acc, cur, wr, wc, fr, fq, lds, wid, lane); S.done(cur); }
#undef PG8_SA
#undef PG8_SB
#undef PG8_STAGE
#undef PG8_LDA
#undef PG8_LDB
#undef PG8_MMA
#undef PG8_WAIT_V
#undef PG8_WAIT_L
#undef PG8_BAR
#undef PG8_SCHED
}
}
namespace cg = cooperative_groups;
using pg8::bf16_t; using pg8::bf16x8; using pg8::f32x4; using pg8::u32x4; using pg8::Unit; using pg8::cvt_pk_bf16;
typedef unsigned u32x2 __attribute__((ext_vector_type(2)));
#define LAS __attribute__((address_space(3)))
#define LDS_WAIT() asm volatile("s_waitcnt lgkmcnt(0)" ::: "memory")

constexpr int M_ = 16384, DM = 1024, SEQ = 4096, DFF = 2816, DIN = 6696, NINP = 6912;
constexpr float EPSN = 1e-6f;
constexpr float LOG2E = 1.4426950408889634f, LN2 = 0.6931471805599453f;
constexpr float C2 = 0.125f * LOG2E;

constexpr size_t MiB = (size_t)1 << 20;
constexpr size_t WS_SS0 = 128 * 1024, WS_SS1 = 256 * 1024;
constexpr size_t WS_WIN = 1 * MiB;
constexpr size_t WS_WB = WS_WIN + (size_t)NINP * 1024 * 2;
constexpr size_t WS_WOUT = WS_WB + 2 * MiB;
constexpr size_t WS_WGU = WS_WOUT + 2 * MiB;
constexpr size_t WS_WD = WS_WGU + 11 * MiB;
constexpr size_t WS_WP = WS_WD + (size_t)1024 * 2816 * 2;
constexpr size_t WS_WS = WS_WP + 32768;
static_assert(WS_WS + 131072 <= 36 * MiB, "weights region");
constexpr size_t WS_XN = 36 * MiB;
constexpr size_t WS_R1 = 68 * MiB;
constexpr size_t WS_G = WS_R1, WS_KA = WS_R1 + 64 * MiB, WS_VTA = WS_KA + 8 * MiB, WS_IQ = WS_VTA + 8 * MiB;
constexpr size_t WS_S = 156 * MiB;
constexpr size_t WS_PIN = WS_S, WS_GU = WS_S + 8 * MiB, WS_GV = WS_S + 16 * MiB, WS_SQ = WS_S + 24 * MiB, WS_SK = WS_S + 32 * MiB,
                 WS_VTS = WS_S + 40 * MiB, WS_QA = WS_S + 48 * MiB, WS_MASK = WS_S + 56 * MiB, WS_IK = 220 * MiB, WS_IW = 221 * MiB, WS_OCAT = 222 * MiB  , WS_END = 254 * MiB;

__device__ __forceinline__ float bf2f(unsigned short v) { return __uint_as_float((unsigned)v << 16); }
__device__ __forceinline__ float bflo(unsigned v) { return __uint_as_float(v << 16); }
__device__ __forceinline__ float bfhi(unsigned v) { return __uint_as_float(v & 0xffff0000u); }
__device__ __forceinline__ unsigned short f2bf(float f) { return (unsigned short)(cvt_pk_bf16(f, 0.f) & 0xffffu); }
__device__ __forceinline__ float relu1(float x) { const int b = __float_as_int(x); return __int_as_float(b > 0 ? b : 0); }
__device__ __forceinline__ float sigmoidf_(float x) { return __builtin_amdgcn_rcpf(1.f + __builtin_amdgcn_exp2f(-x * LOG2E)); }
__device__ __forceinline__ float gelu_tanh(float x) { const float u = 0.7978845608028654f * (x + 0.044715f * x * x * x); return x * __builtin_amdgcn_rcpf(1.f + __builtin_amdgcn_exp2f(-2.f * LOG2E * u)); }
__device__ __forceinline__ f32x4 mfma16(bf16x8 a, bf16x8 b, f32x4 c) { return __builtin_amdgcn_mfma_f32_16x16x32_bf16(a, b, c, 0, 0, 0); }
__device__ __forceinline__ bf16x8 mk8(unsigned a, unsigned b, unsigned c, unsigned d) { u32x4 v = {a, b, c, d}; return __builtin_bit_cast(bf16x8, v); }

struct EpiIn {
    static constexpr bool PERM = true, AFTER_DRAIN = false, HOOK = false;
#ifdef PROBE_EPI_IN
    static constexpr bool EPI_TWICE = true;
#else
    static constexpr bool EPI_TWICE = false;
#endif
    unsigned char* ws; const float *qn, *kn; const float* SS;
    __device__ __forceinline__ void operator()(const f32x4 (&acc)[2][2][4][2], const Unit& u, int wr, int wc, int fr, int fq) const {
        bf16_t* const QA = (bf16_t*)(ws + WS_QA); bf16_t* const KA = (bf16_t*)(ws + WS_KA); bf16_t* const VTA = (bf16_t*)(ws + WS_VTA); bf16_t* const IQ = (bf16_t*)(ws + WS_IQ);
        bf16_t* const PIN = (bf16_t*)(ws + WS_PIN); bf16_t* const GU = (bf16_t*)(ws + WS_GU); bf16_t* const GV = (bf16_t*)(ws + WS_GV); bf16_t* const SQ = (bf16_t*)(ws + WS_SQ);
        bf16_t* const SK = (bf16_t*)(ws + WS_SK); bf16_t* const VTS = (bf16_t*)(ws + WS_VTS); bf16_t* const IK = (bf16_t*)(ws + WS_IK); float* const IW = (float*)(ws + WS_IW); unsigned char* const G = ws + WS_G;
        const int pn = u.pn; const int row0 = u.pm * 256 + wr * 64 + fr; const int cl = wc * 32 + 8 * fq;
        float rr[2][4];
#pragma unroll
        for (int ai = 0; ai < 2; ++ai)
#pragma unroll
            for (int m = 0; m < 4; ++m) rr[ai][m] = __builtin_amdgcn_rsqf(SS[row0 + ai * 128 + m * 16] * (1.f / 1024.f) + EPSN);
        if (pn >= 11) {
            unsigned char* gp = G + (size_t)row0 * 4096 + (pn - 11) * 256 + cl;
#pragma unroll
            for (int ai = 0; ai < 2; ++ai)
#pragma unroll
                for (int m = 0; m < 4; ++m)
#pragma unroll
                    for (int bj = 0; bj < 2; ++bj) {
                        unsigned w2[2];
#pragma unroll
                        for (int n = 0; n < 2; ++n) { const f32x4 v = (acc[ai][bj][m][n] * rr[ai][m]); unsigned pk = 0;
#pragma unroll
                            for (int i = 0; i < 4; ++i) { const unsigned qv = (unsigned)(sigmoidf_(v[i]) * 255.f + 0.5f); pk |= qv << (8 * i); }
                            w2[n] = pk; }
                        *(u32x2*)(gp + (size_t)(ai * 128 + m * 16) * 4096 + bj * 128) = (u32x2){w2[0], w2[1]};
                    }
            return;
        }
        if (pn <= 1) {
            const float* gw = pn == 0 ? qn : kn; const float sc = pn == 0 ? C2 : 1.f; bf16_t* T = pn == 0 ? QA : KA;
            f32x4 gv[2][2];
#pragma unroll
            for (int bj = 0; bj < 2; ++bj)
#pragma unroll
                for (int n = 0; n < 2; ++n) gv[bj][n] = *(const f32x4*)(gw + bj * 32 + 8 * fq + 4 * n);
#pragma unroll
            for (int ai = 0; ai < 2; ++ai)
#pragma unroll
                for (int m = 0; m < 4; ++m) {
                    float ss = 0.f;
#pragma unroll
                    for (int bj = 0; bj < 2; ++bj)
#pragma unroll
                        for (int n = 0; n < 2; ++n) { const f32x4 v = (acc[ai][bj][m][n] * rr[ai][m]); ss += (v[0] * v[0] + v[1] * v[1]) + (v[2] * v[2] + v[3] * v[3]); }
                    ss += __shfl_xor(ss, 16); ss += __shfl_xor(ss, 32);
                    const float rinv = __builtin_amdgcn_rsqf(ss * (1.f / 64.f) + EPSN) * sc;
                    bf16_t* rp = T + (size_t)(row0 + ai * 128 + m * 16) * 256 + wc * 64 + 8 * fq;
#pragma unroll
                    for (int bj = 0; bj < 2; ++bj) { const f32x4 v0 = (acc[ai][bj][m][0] * rr[ai][m]) * gv[bj][0] * rinv, v1 = (acc[ai][bj][m][1] * rr[ai][m]) * gv[bj][1] * rinv;
                        u32x4 w; w.x = cvt_pk_bf16(v0[0], v0[1]); w.y = cvt_pk_bf16(v0[2], v0[3]); w.z = cvt_pk_bf16(v1[0], v1[1]); w.w = cvt_pk_bf16(v1[2], v1[3]);
                        *(u32x4*)(rp + bj * 32) = w; }
                }
            return;
        }
        if (pn == 2 || pn == 9) {
            bf16_t* T = pn == 2 ? VTA : VTS;
#pragma unroll
            for (int ai = 0; ai < 2; ++ai)
#pragma unroll
                for (int m = 0; m < 4; ++m) { const int row = row0 + ai * 128 + m * 16; const int b = row >> 12, t = row & 4095;
#pragma unroll
                    for (int bj = 0; bj < 2; ++bj)
#pragma unroll
                        for (int n = 0; n < 2; ++n) { const f32x4 v = (acc[ai][bj][m][n] * rr[ai][m]);
#pragma unroll
                            for (int i = 0; i < 4; ++i) T[((size_t)b * 256 + bj * 128 + cl + 4 * n + i) * 4096 + t] = f2bf(v[i]); }
                }
            return;
        }
        if (pn == 10) {
            if (wc == 0) {
#pragma unroll
                for (int ai = 0; ai < 2; ++ai)
#pragma unroll
                    for (int m = 0; m < 4; ++m) { const f32x4 v0 = (acc[ai][0][m][0] * rr[ai][m]), v1 = (acc[ai][0][m][1] * rr[ai][m]);
                        u32x4 w; w.x = cvt_pk_bf16(v0[0], v0[1]); w.y = cvt_pk_bf16(v0[2], v0[3]); w.z = cvt_pk_bf16(v1[0], v1[1]); w.w = cvt_pk_bf16(v1[2], v1[3]);
                        *(u32x4*)(IK + (size_t)(row0 + ai * 128 + m * 16) * 32 + 8 * fq) = w; }
            } else if (wc == 1 && fq == 0) {
#pragma unroll
                for (int ai = 0; ai < 2; ++ai)
#pragma unroll
                    for (int m = 0; m < 4; ++m) { float* p = IW + (size_t)(row0 + ai * 128 + m * 16) * 8; *(f32x4*)p = (acc[ai][0][m][0] * rr[ai][m]); *(f32x4*)(p + 4) = (acc[ai][0][m][1] * rr[ai][m]); }
            }
            return;
        }
        {
            bf16_t* T = pn == 3 ? IQ : pn == 4 ? PIN : pn == 5 ? GU : pn == 6 ? GV : pn == 7 ? SQ : SK;
            const bool act = (pn == 5 || pn == 6); const float sc = pn == 7 ? 0.125f : 1.f;
#pragma unroll
            for (int ai = 0; ai < 2; ++ai)
#pragma unroll
                for (int m = 0; m < 4; ++m) { bf16_t* rp = T + (size_t)(row0 + ai * 128 + m * 16) * 256 + cl;
#pragma unroll
                    for (int bj = 0; bj < 2; ++bj) { f32x4 v0 = (acc[ai][bj][m][0] * rr[ai][m]) * sc, v1 = (acc[ai][bj][m][1] * rr[ai][m]) * sc;
                        if (act) {
#pragma unroll
                            for (int i = 0; i < 4; ++i) { v0[i] = gelu_tanh(v0[i]); v1[i] = gelu_tanh(v1[i]); } }
                        u32x4 w; w.x = cvt_pk_bf16(v0[0], v0[1]); w.y = cvt_pk_bf16(v0[2], v0[3]); w.z = cvt_pk_bf16(v1[0], v1[1]); w.w = cvt_pk_bf16(v1[2], v1[3]);
                        *(u32x4*)(rp + bj * 128) = w; }
                }
        }
    }
};

struct EpiMerge {
    static constexpr bool PERM = true, AFTER_DRAIN = false, HOOK = true, EPI_TWICE = false;
    const unsigned char* G; bf16_t* MG;
    __device__ __forceinline__ void hook(f32x4 (&acc)[2][2][4][2], const Unit& u, int s, int wr, int wc, int fr, int fq) const {
        const int row0 = u.pm * 256 + wr * 64 + fr; const int col0 = u.pn * 256 + wc * 32 + 8 * fq;
        const unsigned char* gp0 = G + (size_t)row0 * 4096 + s * 1024 + col0;
        u32x2 ga[2][4][2], gb[2][4][2];
#pragma unroll
        for (int ai = 0; ai < 2; ++ai)
#pragma unroll
            for (int m = 0; m < 4; ++m)
#pragma unroll
                for (int bj = 0; bj < 2; ++bj) { const unsigned char* gp = gp0 + (size_t)(ai * 128 + m * 16) * 4096 + bj * 128; ga[ai][m][bj] = *(const u32x2*)gp; gb[ai][m][bj] = *(const u32x2*)(gp + 1024); }
#pragma unroll
        for (int ai = 0; ai < 2; ++ai)
#pragma unroll
            for (int m = 0; m < 4; ++m)
#pragma unroll
                for (int bj = 0; bj < 2; ++bj)
#pragma unroll
                    for (int i = 0; i < 4; ++i) {
                        const float a0 = fmaxf((float)((ga[ai][m][bj].x >> (8 * i)) & 255u), 1.f), b0 = fmaxf((float)((gb[ai][m][bj].x >> (8 * i)) & 255u), 1.f);
                        const float a1 = fmaxf((float)((ga[ai][m][bj].y >> (8 * i)) & 255u), 1.f), b1 = fmaxf((float)((gb[ai][m][bj].y >> (8 * i)) & 255u), 1.f);
                        acc[ai][bj][m][0][i] *= a0 * __builtin_amdgcn_rcpf(b0); acc[ai][bj][m][1][i] *= a1 * __builtin_amdgcn_rcpf(b1); }
    }
    __device__ __forceinline__ void operator()(const f32x4 (&acc)[2][2][4][2], const Unit& u, int wr, int wc, int fr, int fq) const {
        const int row0 = u.pm * 256 + wr * 64 + fr; const int col0 = u.pn * 256 + wc * 32 + 8 * fq;
        const unsigned char* gp0 = G + (size_t)row0 * 4096 + 3 * 1024 + col0; bf16_t* mp0 = MG + (size_t)row0 * 1024 + col0;
        u32x2 gb[2][4][2];
#pragma unroll
        for (int ai = 0; ai < 2; ++ai)
#pragma unroll
            for (int m = 0; m < 4; ++m)
#pragma unroll
                for (int bj = 0; bj < 2; ++bj) gb[ai][m][bj] = *(const u32x2*)(gp0 + (size_t)(ai * 128 + m * 16) * 4096 + bj * 128);
#pragma unroll
        for (int ai = 0; ai < 2; ++ai)
#pragma unroll
            for (int m = 0; m < 4; ++m)
#pragma unroll
                for (int bj = 0; bj < 2; ++bj) { const size_t ro = (size_t)(ai * 128 + m * 16); const u32x2 g2 = gb[ai][m][bj];
                    f32x4 v0 = acc[ai][bj][m][0], v1 = acc[ai][bj][m][1];
#pragma unroll
                    for (int i = 0; i < 4; ++i) { v0[i] *= fmaxf((float)((g2.x >> (8 * i)) & 255u), 1.f) * (1.f / 255.f); v1[i] *= fmaxf((float)((g2.y >> (8 * i)) & 255u), 1.f) * (1.f / 255.f); }
                    u32x4 w; w.x = cvt_pk_bf16(v0[0], v0[1]); w.y = cvt_pk_bf16(v0[2], v0[3]); w.z = cvt_pk_bf16(v1[0], v1[1]); w.w = cvt_pk_bf16(v1[2], v1[3]);
                    *(u32x4*)(mp0 + ro * 1024 + bj * 128) = w; }
    }
};

struct EpiResid {
    static constexpr bool PERM = true, AFTER_DRAIN = false, HOOK = false, EPI_TWICE = false;
    const float* base; float* out; bf16_t* XB; float* SS; int stat;
    __device__ __forceinline__ void operator()(const f32x4 (&acc)[2][2][4][2], const Unit& u, int wr, int wc, int fr, int fq) const {
        const int row0 = u.pm * 256 + wr * 64 + fr; const int col0 = u.pn * 256 + wc * 32 + 8 * fq;
#pragma unroll
        for (int ai = 0; ai < 2; ++ai) {
            f32x4 pre[4][2][2];
#pragma unroll
            for (int m = 0; m < 4; ++m) { const size_t off = (size_t)(row0 + ai * 128 + m * 16) * 1024 + col0;
#pragma unroll
                for (int bj = 0; bj < 2; ++bj) { pre[m][bj][0] = *(const f32x4*)(base + off + bj * 128); pre[m][bj][1] = *(const f32x4*)(base + off + bj * 128 + 4); } }
#pragma unroll
            for (int m = 0; m < 4; ++m) { const int row = row0 + ai * 128 + m * 16; const size_t off = (size_t)row * 1024 + col0; float ssum = 0.f;
#pragma unroll
                for (int bj = 0; bj < 2; ++bj) {
                    const f32x4 o0 = pre[m][bj][0] + acc[ai][bj][m][0], o1 = pre[m][bj][1] + acc[ai][bj][m][1];
                    *(f32x4*)(out + off + bj * 128) = o0; *(f32x4*)(out + off + bj * 128 + 4) = o1;
                    if (stat) { u32x4 w; w.x = cvt_pk_bf16(o0[0], o0[1]); w.y = cvt_pk_bf16(o0[2], o0[3]); w.z = cvt_pk_bf16(o1[0], o1[1]); w.w = cvt_pk_bf16(o1[2], o1[3]);
                        *(u32x4*)(XB + off + bj * 128) = w;
                        ssum += ((o0[0] * o0[0] + o0[1] * o0[1]) + (o0[2] * o0[2] + o0[3] * o0[3])) + ((o1[0] * o1[0] + o1[1] * o1[1]) + (o1[2] * o1[2] + o1[3] * o1[3])); } }
                if (stat) { ssum += __shfl_xor(ssum, 16); ssum += __shfl_xor(ssum, 32); if (fq == 0) atomicAdd(SS + row, ssum); } }
            asm volatile("" ::: "memory");
        }
    }
};

struct EpiSwiGLU {
    static constexpr bool PERM = true, AFTER_DRAIN = false, HOOK = false, EPI_TWICE = false;
    bf16_t* ACT; const float* SS;
    __device__ __forceinline__ void operator()(const f32x4 (&acc)[2][2][4][2], const Unit& u, int wr, int wc, int fr, int fq) const {
        const int row0 = u.pm * 256 + wr * 64 + fr; const int f0 = u.pn * 128 + wc * 32 + 8 * fq;
        float rr[2][4];
#pragma unroll
        for (int ai = 0; ai < 2; ++ai)
#pragma unroll
            for (int m = 0; m < 4; ++m) rr[ai][m] = SS[row0 + ai * 128 + m * 16];
#pragma unroll
        for (int ai = 0; ai < 2; ++ai)
#pragma unroll
            for (int m = 0; m < 4; ++m) { f32x4 r[2]; const float rs = __builtin_amdgcn_rsqf(rr[ai][m] * (1.f / 1024.f) + EPSN);
#pragma unroll
                for (int n = 0; n < 2; ++n) { const f32x4 g = acc[ai][0][m][n] * rs, up = acc[ai][1][m][n] * rs;
#pragma unroll
                    for (int i = 0; i < 4; ++i) r[n][i] = g[i] * sigmoidf_(g[i]) * up[i]; }
                u32x4 w; w.x = cvt_pk_bf16(r[0][0], r[0][1]); w.y = cvt_pk_bf16(r[0][2], r[0][3]); w.z = cvt_pk_bf16(r[1][0], r[1][1]); w.w = cvt_pk_bf16(r[1][2], r[1][3]);
                *(u32x4*)(ACT + (size_t)(row0 + ai * 128 + m * 16) * DFF + f0) = w; }
    }
};

__device__ __forceinline__ void cvt_item(const float* src, int ld, int col0, int nvalid, int K, bf16_t* WT, int dst_row0, int kb, LAS float* scr, int lane, const float* rs = nullptr) {
    const int k0 = 64 * kb, c = lane & 31;
    float vv[32];
#pragma unroll
    for (int i = 0; i < 32; ++i) { const int kk = 2 * i + (lane >> 5); vv[i] = (c < nvalid) ? src[(size_t)(k0 + kk) * ld + col0 + c] : 0.f; }
    if (rs) {
#pragma unroll
        for (int i = 0; i < 32; ++i) vv[i] *= rs[k0 + 2 * i + (lane >> 5)];
    }
#pragma unroll
    for (int i = 0; i < 32; ++i) scr[(2 * i + (lane >> 5)) * 33 + c] = vv[i];
    LDS_WAIT();
    const int c8 = lane & 7;
#pragma unroll
    for (int j = 0; j < 4; ++j) { const int n = (lane >> 3) + 8 * j; const LAS float* s = scr + (8 * c8) * 33 + n;
        u32x4 o; o.x = cvt_pk_bf16(s[0 * 33], s[1 * 33]); o.y = cvt_pk_bf16(s[2 * 33], s[3 * 33]); o.z = cvt_pk_bf16(s[4 * 33], s[5 * 33]); o.w = cvt_pk_bf16(s[6 * 33], s[7 * 33]);
        *(u32x4*)(WT + (size_t)(dst_row0 + n) * K + k0 + 8 * c8) = o; }
    LDS_WAIT();
}
__device__ __forceinline__ float wave_sum(float v) {
#pragma unroll
    for (int o = 1; o < 64; o <<= 1) v += __shfl_xor(v, o);
    return v;
}
__device__ __forceinline__ float wave_max(float v) {
#pragma unroll
    for (int o = 1; o < 64; o <<= 1) v = fmaxf(v, __shfl_xor(v, o));
    return v;
}
__device__ __forceinline__ void rmsnorm_rows(const float* xs, const float* gamma, bf16_t* XN, int gw, int ngw, int lane) {
    f32x4 gm[4];
#pragma unroll
    for (int j = 0; j < 4; ++j) gm[j] = *(const f32x4*)(gamma + 4 * lane + 256 * j);
    for (int m = gw; m < M_; m += ngw) {
        const f32x4* xr = (const f32x4*)(xs + (size_t)m * DM) + lane; f32x4 v[4]; float s = 0.f;
#pragma unroll
        for (int j = 0; j < 4; ++j) { v[j] = xr[64 * j]; s += (v[j].x * v[j].x + v[j].y * v[j].y) + (v[j].z * v[j].z + v[j].w * v[j].w); }
        const float r = __builtin_amdgcn_rsqf(wave_sum(s) * (1.f / DM) + EPSN);
        u32x2* o8 = (u32x2*)(XN + (size_t)m * DM) + lane;
#pragma unroll
        for (int j = 0; j < 4; ++j) { const f32x4 y = v[j] * r * gm[j]; o8[64 * j] = (u32x2){cvt_pk_bf16(y.x, y.y), cvt_pk_bf16(y.z, y.w)}; }
    }
}

__device__ __forceinline__ void x_to_bf16_ss(const float* xs, bf16_t* XN, float* SS, int gw, int ngw, int lane) {
    for (int m0 = gw * 4; m0 < M_; m0 += ngw * 4) {
        f32x4 v[4][4];
#pragma unroll
        for (int r = 0; r < 4; ++r) { const f32x4* xr = (const f32x4*)(xs + (size_t)(m0 + r) * DM) + lane;
#pragma unroll
            for (int j = 0; j < 4; ++j) v[r][j] = xr[64 * j]; }
#pragma unroll
        for (int r = 0; r < 4; ++r) { float s = 0.f;
#pragma unroll
            for (int j = 0; j < 4; ++j) s += (v[r][j].x * v[r][j].x + v[r][j].y * v[r][j].y) + (v[r][j].z * v[r][j].z + v[r][j].w * v[r][j].w);
            s = wave_sum(s);
            u32x2* o8 = (u32x2*)(XN + (size_t)(m0 + r) * DM) + lane;
#pragma unroll
            for (int j = 0; j < 4; ++j) o8[64 * j] = (u32x2){cvt_pk_bf16(v[r][j].x, v[r][j].y), cvt_pk_bf16(v[r][j].z, v[r][j].w)};
            if (lane == 0) SS[m0 + r] = s; }
    }
}
struct Ptrs {
    const float *mix_g, *ffn_g, *w_in, *qn, *kn, *pool_w, *pool_scale, *gm_norm, *gm_ws, *gm_b, *w_branch, *w_out, *w_gate, *w_up, *w_down;
};

__device__ __forceinline__ void convert_weights(const Ptrs& P, unsigned char* ws, LAS float* scr, int gw, int ngw, int lane, int gtid, int ngt) {
    bf16_t* WinT = (bf16_t*)(ws + WS_WIN); bf16_t* WbT = (bf16_t*)(ws + WS_WB); bf16_t* WoutT = (bf16_t*)(ws + WS_WOUT); bf16_t* WguT = (bf16_t*)(ws + WS_WGU);
    bf16_t* WdT = (bf16_t*)(ws + WS_WD); bf16_t* WpT = (bf16_t*)(ws + WS_WP); bf16_t* Wtril = (bf16_t*)(ws + WS_WS);
    constexpr int I_A = 216 * 16, I_B = 512, I_C = 512, I_D = 176 * 16, I_E = 32 * 44, I_F = 8, NIT = I_A + I_B + I_C + I_D + I_E + I_F;
    for (int it = gw; it < NIT; it += ngw) {
        int r = it;
        if (r < I_A) { const int rb = r >> 4, kb = r & 15, tile = rb >> 3, sub = rb & 7; int col0, nv = 32;
            if (tile <= 1) col0 = tile * 256 + (sub & 3) * 64 + (sub >> 2) * 32;
            else if (tile == 2) col0 = 512 + sub * 32;
            else if (tile == 3) col0 = 768 + sub * 32;
            else if (tile <= 9) col0 = 1064 + (tile - 4) * 256 + sub * 32;
            else if (tile == 10) { col0 = sub == 0 ? 1024 : 1056; nv = sub == 0 ? 32 : (sub == 1 ? 8 : 0); }
            else col0 = 2600 + (tile - 11) * 256 + sub * 32;
            cvt_item(P.w_in, DIN, col0, nv, 1024, WinT, rb * 32, kb, scr, lane, P.mix_g); continue; }
        r -= I_A;
        if (r < I_B) { const int rb = r >> 4, kb = r & 15; cvt_item(P.w_branch, 1024, rb * 32, 32, 1024, WbT, rb * 32, kb, scr, lane); continue; }
        r -= I_B;
        if (r < I_C) { const int rb = r >> 4, kb = r & 15; cvt_item(P.w_out, 1024, rb * 32, 32, 1024, WoutT, rb * 32, kb, scr, lane); continue; }
        r -= I_C;
        if (r < I_D) { const int rb = r >> 4, kb = r & 15, tile = rb >> 3, sub = rb & 7;
            cvt_item((sub >> 2) ? P.w_up : P.w_gate, DFF, tile * 128 + (sub & 3) * 32, 32, 1024, WguT, rb * 32, kb, scr, lane, P.ffn_g); continue; }
        r -= I_D;
        if (r < I_E) { const int rb = r / 44, kb = r % 44; cvt_item(P.w_down, 1024, rb * 32, 32, DFF, WdT, rb * 32, kb, scr, lane); continue; }
        r -= I_E;
        { const int gp = r >> 1, rb = r & 1; cvt_item(P.pool_w + gp * 4096, 64, rb * 32, 32, 64, WpT + gp * 4096, rb * 32, 0, scr, lane); }
    }
    for (int e = gtid; e < 4 * 128 * 128; e += ngt) { const int s = e & 127, t = (e >> 7) & 127; Wtril[e] = (s <= t) ? f2bf(P.gm_ws[e]) : (unsigned short)0; }
}

__device__ __forceinline__ unsigned mono_key(float s) { const unsigned b = __float_as_uint(s); return b ^ ((unsigned)((int)b >> 31) | 0x80000000u); }

#define wr_lane(dst, sval, ln) asm volatile("s_nop 4\n\tv_writelane_b32 %0, %1, %2\n\ts_nop 1" : "+v"(dst) : "s"(sval), "n"(ln))
template <int NBLK> __device__ __forceinline__ unsigned a1_bisect(const unsigned (&v)[64], int& cpre) {
    unsigned prefix = 0u; cpre = 0;
#pragma unroll 1
    for (int bit = 31; bit >= 0; --bit) {
        const unsigned cand = prefix | (1u << bit);
        int cnt = 0;
#pragma unroll
        for (int blk = 0; blk < NBLK; ++blk) {
            unsigned long long bl[8];
#pragma unroll
            for (int k = 0; k < 8; ++k) bl[k] = __ballot(v[blk * 8 + k] >= cand);
            __builtin_amdgcn_sched_barrier(0);
#pragma unroll
            for (int k = 0; k < 8; ++k) cnt += __builtin_popcountll(bl[k]);
            __builtin_amdgcn_sched_barrier(0);
        }
        if (cnt >= 256) { prefix = cand; cpre = cnt; if (cnt == 256) break; }
    }
    return prefix;
}
constexpr int A1_ROWF = 4100;
__device__ __forceinline__ void phase_a1(unsigned char* lds, const bf16_t* IQ, const bf16_t* IK, const float* IW, unsigned short* MASK, int tid, int bid, int G) {
    const int lane = tid & 63, w = __builtin_amdgcn_readfirstlane(tid >> 6), q = lane & 15, g = lane >> 4;
    unsigned* keys = (unsigned*)lds;
#ifndef REP_A1X
#define REP_A1X 1
#endif
    for (int L2 = bid; L2 < 1024 * REP_A1X; L2 += G) {
        const int L = L2 & 1023;
        const int b = L >> 8, c = L & 255, qg = (b & 1) ? 255 - c : c;
        const int row0 = b * SEQ + qg * 16;
        const int nreg = (qg >> 2) + 1;
        if (qg <= 15) {
#pragma unroll
            for (int half = 0; half < 2; ++half) { const int qq = half * 8 + w; const int t = qg * 16 + qq; unsigned mlo = 0u, mhi = 0u;
#pragma unroll
                for (int r = 0; r < 4; ++r) { const unsigned long long bal = __ballot(64 * r + lane <= t);
                    wr_lane(mlo, (unsigned)bal, r); wr_lane(mhi, (unsigned)(bal >> 32), r); }
                if (lane < nreg) *(u32x2*)(MASK + (size_t)(row0 + qq) * 256 + 4 * lane) = (u32x2){mlo, mhi}; }
            continue;
        }
        unsigned u[128];
        {
            bf16x8 iqf[8]; float wv[8];
#pragma unroll
            for (int h = 0; h < 8; ++h) iqf[h] = *(const bf16x8*)(IQ + (size_t)(row0 + q) * 256 + h * 32 + 8 * g);
            { const f32x4 a = *(const f32x4*)(IW + (size_t)(row0 + q) * 8), bq = *(const f32x4*)(IW + (size_t)(row0 + q) * 8 + 4);
              wv[0] = a[0]; wv[1] = a[1]; wv[2] = a[2]; wv[3] = a[3]; wv[4] = bq[0]; wv[5] = bq[1]; wv[6] = bq[2]; wv[7] = bq[3]; }
            bf16x8 kfn[4];
#pragma unroll
            for (int ii = 0; ii < 4; ++ii) kfn[ii] = *(const bf16x8*)(IK + (size_t)(b * SEQ + (8 * ii + w) * 16 + q) * 32 + 8 * g);
#pragma unroll
            for (int blk = 0; blk < 8; ++blk) {
                if (32 * blk + w <= qg) {
                    bf16x8 kf[4];
#pragma unroll
                    for (int ii = 0; ii < 4; ++ii) kf[ii] = kfn[ii];
                    if (blk < 7) {
#pragma unroll
                        for (int ii = 0; ii < 4; ++ii) { const int kt = 8 * (4 * (blk + 1) + ii) + w; kfn[ii] = *(const bf16x8*)(IK + (size_t)(b * SEQ + kt * 16 + q) * 32 + 8 * g); }
                    }
#pragma unroll
                    for (int ii = 0; ii < 4; ++ii) { const int i = 4 * blk + ii; const int kt = 8 * i + w;
                        f32x4 s = {0.f, 0.f, 0.f, 0.f};
#pragma unroll
                        for (int h = 0; h < 8; ++h) { const f32x4 a = mfma16(kf[ii], iqf[h], (f32x4){0.f, 0.f, 0.f, 0.f});
#pragma unroll
                            for (int j = 0; j < 4; ++j) s[j] = __builtin_fmaf(wv[h], relu1(a[j]), s[j]); }
#pragma unroll
                        for (int j = 0; j < 4; ++j) { unsigned uu = mono_key(s[j]); if (kt > qg || (kt == qg && (4 * g + j) > q)) uu = 0u; u[4 * i + j] = uu; }
                    }
                } else {
#pragma unroll
                    for (int r = 0; r < 16; ++r) u[16 * blk + r] = 0u;
                }
            }
        }
#pragma unroll 1
        for (int half = 0; half < 2; ++half) {
            if ((q >> 3) == half) {
                unsigned* krow = keys + (q & 7) * A1_ROWF + 4 * g;
#pragma unroll
                for (int i = 0; i < 32; ++i) { const int kt = 8 * i + w; *(u32x4*)(krow + kt * 16) = (u32x4){u[4 * i], u[4 * i + 1], u[4 * i + 2], u[4 * i + 3]}; }
            }
            __syncthreads();
            {
                const int qq = half * 8 + w; const unsigned* krow = keys + w * A1_ROWF + lane;
                unsigned v[64];
#pragma unroll
                for (int blk = 0; blk < 8; ++blk) {
                    if (nreg > blk * 8) {
#pragma unroll
                        for (int r = blk * 8; r < blk * 8 + 8; ++r) v[r] = krow[64 * r];
                    } else {
#pragma unroll
                        for (int r = blk * 8; r < blk * 8 + 8; ++r) v[r] = 0u;
                    }
                }
#ifndef REP_BIS
#define REP_BIS 1
#endif
                __syncthreads();
                unsigned prefix; int cpre = 0;
#pragma unroll 1
                for (int rb_ = 0; rb_ < REP_BIS; ++rb_)
                switch ((nreg + 7) >> 3) {
                    case 1: prefix = a1_bisect<1>(v, cpre); break; case 2: prefix = a1_bisect<2>(v, cpre); break; case 3: prefix = a1_bisect<3>(v, cpre); break; case 4: prefix = a1_bisect<4>(v, cpre); break;
                    case 5: prefix = a1_bisect<5>(v, cpre); break; case 6: prefix = a1_bisect<6>(v, cpre); break; case 7: prefix = a1_bisect<7>(v, cpre); break; default: prefix = a1_bisect<8>(v, cpre); break;
                }
                const unsigned thr = prefix > 1u ? prefix : 1u;
                unsigned mlo = 0u, mhi = 0u;
                if (cpre == 256) {
#pragma unroll
                    for (int r = 0; r < 64; ++r) { const unsigned long long bal = __ballot(v[r] >= thr); wr_lane(mlo, (unsigned)bal, r); wr_lane(mhi, (unsigned)(bal >> 32), r); }
                } else {
                    int rem = 256;
#pragma unroll
                    for (int r = 0; r < 64; ++r) rem -= __builtin_popcountll(__ballot(v[r] > thr));
#pragma unroll
                    for (int r = 0; r < 64; ++r) { unsigned long long bal = __ballot(v[r] > thr); unsigned long long eq = __ballot(v[r] == thr);
                        const int ne = __builtin_popcountll(eq);
                        if (ne <= rem) { bal |= eq; rem -= ne; }
                        else { while (rem > 0) { const unsigned long long low = eq & (0ull - eq); bal |= low; eq ^= low; --rem; } }
                        wr_lane(mlo, (unsigned)bal, r); wr_lane(mhi, (unsigned)(bal >> 32), r); }
                }
                if (lane < nreg) *(u32x2*)(MASK + (size_t)(row0 + qq) * 256 + 4 * lane) = (u32x2){mlo, mhi};
            }
        }
    }
}

__device__ __forceinline__ void phase_a2(unsigned char* lds, const bf16_t* QA, bf16_t* OA, const bf16_t* KA, const bf16_t* VTA, const unsigned short* MASK,
                                         const float* qn, const float* kn, int tid, int bid, int G) {
    const int lane = tid & 63, w = __builtin_amdgcn_readfirstlane(tid >> 6), q = lane & 15, g = lane >> 4;
    bf16_t* Kt = (bf16_t*)lds;
    bf16_t* Vt = (bf16_t*)(lds + 2 * 64 * 72 * 2);
    const float msh = LOG2E * 8.f * wave_max(fabsf(qn[lane])) * wave_max(fabsf(kn[lane])) * 1.02f + 0.25f;
    const int srow = tid >> 3, sch = tid & 7;
    for (int L = bid; L < 512; L += G) {
        const int jj = L >> 8, c0 = L & 255, c = (c0 & 7) * 32 + (c0 >> 3), bh = c >> 4, qb = jj ? 31 - (c & 15) : (c & 15);
        const int b = bh >> 2, h = bh & 3;
        const int qgw = qb * 8 + w;
        const int row0 = b * SEQ + qb * 128 + 16 * w;
        bf16x8 qf[2];
#pragma unroll
        for (int hf = 0; hf < 2; ++hf) qf[hf] = *(const bf16x8*)(QA + (size_t)(row0 + q) * 256 + h * 64 + hf * 32 + 8 * g);
        const unsigned short* mrow = MASK + (size_t)(row0 + q) * 256;
        const int nsteps = 2 * qb + 2;
        const bf16_t* ksrc = KA + (size_t)(b * SEQ + srow) * 256 + h * 64 + sch * 8;
        const bf16_t* vsrc = VTA + (size_t)(b * 256 + h * 64 + srow) * SEQ + sch * 8;
        u32x4 kA = *(const u32x4*)ksrc, vA = *(const u32x4*)vsrc, kB = kA, vB = vA;
        u32x2 mE = *(const u32x2*)mrow, mO = mE;
        *(u32x4*)(Kt + srow * 72 + sch * 8) = kA; *(u32x4*)(Vt + srow * 72 + sch * 8) = vA;
        if (nsteps > 1) { kB = *(const u32x4*)(ksrc + (size_t)64 * 256); vB = *(const u32x4*)(vsrc + 64); mO = *(const u32x2*)(mrow + 4); }
        f32x4 o[4]; float lsum = 0.f; const f32x4 negm = {-msh, -msh, -msh, -msh};
#pragma unroll
        for (int d = 0; d < 4; ++d) o[d] = (f32x4){0.f, 0.f, 0.f, 0.f};
        __syncthreads();
#define A2_COMPUTE(st, buf, mcur) do { \
            const bf16_t* kb_ = Kt + (buf) * 64 * 72; const bf16_t* vb_ = Vt + (buf) * 64 * 72; \
            _Pragma("unroll") for (int p = 0; p < 2; ++p) { \
                const int kt0 = (st) * 4 + 2 * p; \
                if (kt0 <= qgw) { \
                    const unsigned mw = p ? (mcur).y : (mcur).x; \
                    const unsigned nib0 = (mw >> (4 * g)) & 15u, nib1 = (kt0 + 1 <= qgw) ? ((mw >> (16 + 4 * g)) & 15u) : 0u; \
                    const bf16_t* kr0 = kb_ + (p * 32 + q) * 72 + 8 * g; const bf16_t* kr1 = kr0 + 16 * 72; \
                    f32x4 a0 = mfma16(*(const bf16x8*)kr0, qf[0], negm); a0 = mfma16(*(const bf16x8*)(kr0 + 32), qf[1], a0); \
                    f32x4 a1 = mfma16(*(const bf16x8*)kr1, qf[0], negm); a1 = mfma16(*(const bf16x8*)(kr1 + 32), qf[1], a1); \
                    float p0[4], p1[4]; \
                    _Pragma("unroll") for (int j = 0; j < 4; ++j) { p0[j] = __uint_as_float(__float_as_uint(__builtin_amdgcn_exp2f(a0[j])) & (0u - ((nib0 >> j) & 1u))); p1[j] = __uint_as_float(__float_as_uint(__builtin_amdgcn_exp2f(a1[j])) & (0u - ((nib1 >> j) & 1u))); } \
                    lsum += ((p0[0] + p0[1]) + (p0[2] + p0[3])) + ((p1[0] + p1[1]) + (p1[2] + p1[3])); \
                    const bf16x8 pf = mk8(cvt_pk_bf16(p0[0], p0[1]), cvt_pk_bf16(p0[2], p0[3]), cvt_pk_bf16(p1[0], p1[1]), cvt_pk_bf16(p1[2], p1[3])); \
                    _Pragma("unroll") for (int d = 0; d < 4; ++d) { const bf16_t* vr = vb_ + (d * 16 + q) * 72 + p * 32 + 4 * g; \
                        const u32x2 lo = *(const u32x2*)vr, hi = *(const u32x2*)(vr + 16); \
                        o[d] = mfma16(mk8(lo.x, lo.y, hi.x, hi.y), pf, o[d]); } \
                } } } while (0)
        for (int st = 0; st < nsteps; st += 2) {
            {
                const bool more2 = st + 2 < nsteps; u32x2 mEn = mE;
                if (more2) { kA = *(const u32x4*)(ksrc + (size_t)(st + 2) * 64 * 256); vA = *(const u32x4*)(vsrc + (st + 2) * 64); mEn = *(const u32x2*)(mrow + (st + 2) * 4); }
                A2_COMPUTE(st, 0, mE);
                *(u32x4*)(Kt + 64 * 72 + srow * 72 + sch * 8) = kB; *(u32x4*)(Vt + 64 * 72 + srow * 72 + sch * 8) = vB;
                __syncthreads();
                mE = mEn;
            }
            {
                const int s1 = st + 1; const bool more2 = s1 + 2 < nsteps; u32x2 mOn = mO;
                if (more2) { kB = *(const u32x4*)(ksrc + (size_t)(s1 + 2) * 64 * 256); vB = *(const u32x4*)(vsrc + (s1 + 2) * 64); mOn = *(const u32x2*)(mrow + (s1 + 2) * 4); }
                A2_COMPUTE(s1, 1, mO);
                if (s1 + 1 < nsteps) { *(u32x4*)(Kt + srow * 72 + sch * 8) = kA; *(u32x4*)(Vt + srow * 72 + sch * 8) = vA; }
                __syncthreads();
                mO = mOn;
            }
        }
#undef A2_COMPUTE
        lsum += __shfl_xor(lsum, 16); lsum += __shfl_xor(lsum, 32);
        const float inv = 1.f / lsum;
#pragma unroll
        for (int d = 0; d < 4; ++d) { const f32x4 v = o[d] * inv;
            *(u32x2*)(OA + (size_t)(row0 + q) * 1024 + h * 64 + d * 16 + 4 * g) = (u32x2){cvt_pk_bf16(v[0], v[1]), cvt_pk_bf16(v[2], v[3])}; }
    }
}

__device__ __forceinline__ void phase_b(const bf16_t* PIN, const bf16_t* WpT, const float* pscale, bf16_t* OB, int gw, int ngw, int lane) {
    const int q = lane & 15, g4 = lane >> 4;
    for (int L = gw; L < 4096; L += ngw) {
        const int gp = L >> 10, tg = L & 1023; const int row = tg * 16 + q; const int t = row & (SEQ - 1);
        const int win = 2 << gp; const int cnt = (t + 1 < win) ? t + 1 : win; const float inv = 1.f / (float)cnt;
        f32x4 acc[4];
#pragma unroll
        for (int d = 0; d < 4; ++d) acc[d] = (f32x4){0.f, 0.f, 0.f, 0.f};
#pragma unroll
        for (int ch = 0; ch < 2; ++ch) {
            const bf16_t* p = PIN + (size_t)row * 256 + gp * 64 + ch * 32 + 8 * g4;
            u32x4 wv[16];
#pragma unroll
            for (int i = 0; i < 16; ++i) { wv[i] = (u32x4){0u, 0u, 0u, 0u}; if (i < win && i <= t) wv[i] = *(const u32x4*)(p - (size_t)i * 256); }
            float own[8], sum[8];
            own[0] = bflo(wv[0].x); own[1] = bfhi(wv[0].x); own[2] = bflo(wv[0].y); own[3] = bfhi(wv[0].y); own[4] = bflo(wv[0].z); own[5] = bfhi(wv[0].z); own[6] = bflo(wv[0].w); own[7] = bfhi(wv[0].w);
#pragma unroll
            for (int k = 0; k < 8; ++k) sum[k] = own[k];
#pragma unroll
            for (int i = 1; i < 16; ++i) { const u32x4 v = wv[i];
                sum[0] += bflo(v.x); sum[1] += bfhi(v.x); sum[2] += bflo(v.y); sum[3] += bfhi(v.y); sum[4] += bflo(v.z); sum[5] += bfhi(v.z); sum[6] += bflo(v.w); sum[7] += bfhi(v.w); }
            float pl[8];
#pragma unroll
            for (int k = 0; k < 8; ++k) pl[k] = sum[k] * inv - own[k];
            const bf16x8 bfr = mk8(cvt_pk_bf16(pl[0], pl[1]), cvt_pk_bf16(pl[2], pl[3]), cvt_pk_bf16(pl[4], pl[5]), cvt_pk_bf16(pl[6], pl[7]));
#pragma unroll
            for (int d = 0; d < 4; ++d) { const bf16x8 afr = *(const bf16x8*)(WpT + gp * 4096 + (d * 16 + q) * 64 + ch * 32 + 8 * g4); acc[d] = mfma16(afr, bfr, acc[d]); }
        }
#pragma unroll
        for (int d = 0; d < 4; ++d) { const int d0 = d * 16 + 4 * g4; const f32x4 sc = *(const f32x4*)(pscale + gp * 64 + d0); const f32x4 v = acc[d] * sc;
            *(u32x2*)(OB + (size_t)row * 1024 + gp * 64 + d0) = (u32x2){cvt_pk_bf16(v[0], v[1]), cvt_pk_bf16(v[2], v[3])}; }
    }
}

__device__ __forceinline__ void phase_c(unsigned char* lds, const bf16_t* GV, const bf16_t* GU, bf16_t* OC, const float* gamma, const bf16_t* Wtril, const float* gbias, int tid, int bid, int G) {
    bf16_t* LT = (bf16_t*)lds;
    const int lane = tid & 63, w = __builtin_amdgcn_readfirstlane(tid >> 6), q = lane & 15, g4 = lane >> 4;
    for (int L = bid; L < 512; L += G) {
        const int gp = L & 3, chk = L >> 2; const int R0 = chk * 128;
        {
            const int row = tid >> 2, part = tid & 3;
            const bf16_t* src = GV + (size_t)(R0 + row) * 256 + part * 64;
            float x[64];
#pragma unroll
            for (int k8 = 0; k8 < 8; ++k8) { const u32x4 v = *(const u32x4*)(src + 8 * k8);
                x[8 * k8 + 0] = bflo(v.x); x[8 * k8 + 1] = bfhi(v.x); x[8 * k8 + 2] = bflo(v.y); x[8 * k8 + 3] = bfhi(v.y); x[8 * k8 + 4] = bflo(v.z); x[8 * k8 + 5] = bfhi(v.z); x[8 * k8 + 6] = bflo(v.w); x[8 * k8 + 7] = bfhi(v.w); }
            float s = 0.f;
#pragma unroll
            for (int k = 0; k < 64; ++k) s += x[k];
            s += __shfl_xor(s, 1); s += __shfl_xor(s, 2);
            const float mean = s * (1.f / 256.f); float ss = 0.f;
#pragma unroll
            for (int k = 0; k < 64; ++k) { const float dd = x[k] - mean; ss += dd * dd; }
            ss += __shfl_xor(ss, 1); ss += __shfl_xor(ss, 2);
            const float rstd = __builtin_amdgcn_rsqf(ss * (1.f / 256.f) + EPSN);
            if (part == gp) {
#pragma unroll
                for (int k4 = 0; k4 < 16; ++k4) { const f32x4 gm = *(const f32x4*)(gamma + gp * 64 + 4 * k4);
#pragma unroll
                    for (int i = 0; i < 4; ++i) LT[(4 * k4 + i) * 136 + row] = f2bf((x[4 * k4 + i] - mean) * rstd * gm[i]); }
            }
        }
        __syncthreads();
        {
            f32x4 acc[4];
#pragma unroll
            for (int d = 0; d < 4; ++d) acc[d] = (f32x4){0.f, 0.f, 0.f, 0.f};
            const int t = 16 * w + q; const int nsb = ((16 * w + 15) >> 5) + 1;
            for (int sb = 0; sb < nsb; ++sb) {
                const bf16x8 bfr = *(const bf16x8*)(Wtril + ((size_t)gp * 128 + t) * 128 + sb * 32 + 8 * g4);
#pragma unroll
                for (int d = 0; d < 4; ++d) { const bf16x8 afr = *(const bf16x8*)(LT + (d * 16 + q) * 136 + sb * 32 + 8 * g4); acc[d] = mfma16(afr, bfr, acc[d]); }
            }
            const float bias = gbias[gp * 128 + t];
#pragma unroll
            for (int d = 0; d < 4; ++d) { const size_t eo = (size_t)(R0 + t) * 256 + gp * 64 + d * 16 + 4 * g4; const u32x2 uu = *(const u32x2*)(GU + eo);
                const float r0 = bflo(uu.x) * (acc[d][0] + bias), r1 = bfhi(uu.x) * (acc[d][1] + bias), r2 = bflo(uu.y) * (acc[d][2] + bias), r3 = bfhi(uu.y) * (acc[d][3] + bias);
                *(u32x2*)(OC + (size_t)(R0 + t) * 1024 + gp * 64 + d * 16 + 4 * g4) = (u32x2){cvt_pk_bf16(r0, r1), cvt_pk_bf16(r2, r3)}; }
        }
        __syncthreads();
    }
}

__device__ __forceinline__ void sb_tile(const f32x4 z, int kbase, int tq, int g, float& carry, float (&a)[4]) {
    float lm[4]; bool msk[4];
#pragma unroll
    for (int j = 0; j < 4; ++j) { msk[j] = (kbase + 4 * g + j) >= tq;
        const float e = __builtin_amdgcn_exp2f(-fabsf(z[j]) * LOG2E); const float sp = relu1(z[j]) + __builtin_amdgcn_logf(1.f + e) * LN2;
        lm[j] = msk[j] ? 0.f : -sp; }
    const float suf2 = lm[3], suf1 = lm[3] + lm[2], suf0 = suf1 + lm[1]; const float T = suf0 + lm[0];
    const float x16 = __shfl_xor(T, 16); const float Pp = T + x16; const float Qq = __shfl_xor(Pp, 32);
    const float Sg = ((g & 1) ? 0.f : x16) + ((g & 2) ? 0.f : Qq);
    const float base = carry + Sg;
    const float tl[4] = {base + suf0, base + suf1, base + suf2, base};
#pragma unroll
    for (int j = 0; j < 4; ++j) a[j] = msk[j] ? 0.f : __builtin_amdgcn_exp2f((z[j] + lm[j] + tl[j]) * LOG2E);
    carry += Pp + Qq;
}
__device__ __forceinline__ void phase_d(const bf16_t* SQ, bf16_t* OD, const bf16_t* SK, const bf16_t* VTS, int gw, int ngw, int lane) {
    const int q = lane & 15, g = lane >> 4;
    for (int L0 = gw; L0 < 2048; L0 += ngw) {
        const int blk_ = L0 >> 3, L = ((((blk_ & 7) * 32 + ((blk_ >> 3) & 31)) << 3) | (L0 & 7)) & 2047;
        const int qg = L & 255, bh = L >> 8, b0 = bh >> 2, h = bh & 3;
        const int tq = qg * 16 + q;
        bf16x8 qf[2][2]; f32x4 o[2][4]; float carry[2] = {0.f, 0.f};
#pragma unroll
        for (int u = 0; u < 2; ++u) { const int row0 = (b0 + 2 * u) * SEQ + qg * 16;
#pragma unroll
            for (int hf = 0; hf < 2; ++hf) qf[u][hf] = *(const bf16x8*)(SQ + (size_t)(row0 + q) * 256 + h * 64 + hf * 32 + 8 * g);
#pragma unroll
            for (int d = 0; d < 4; ++d) o[u][d] = (f32x4){0.f, 0.f, 0.f, 0.f}; }
        bf16x8 kn[2][4]; u32x2 vn[2][8];
#define D_LOAD(ppx) do { const int k0_ = (ppx) * 32; _Pragma("unroll") for (int u = 0; u < 2; ++u) { const int b = b0 + 2 * u; \
                const bf16_t* kb = SK + (size_t)(b * SEQ + k0_ + q) * 256 + h * 64 + 8 * g; \
                _Pragma("unroll") for (int i = 0; i < 4; ++i) kn[u][i] = *(const bf16x8*)(kb + (size_t)(i >> 1) * 16 * 256 + (i & 1) * 32); \
                const bf16_t* vb = VTS + (size_t)(b * 256 + h * 64 + q) * SEQ + k0_ + 4 * g; \
                _Pragma("unroll") for (int d = 0; d < 4; ++d) { vn[u][2 * d] = *(const u32x2*)(vb + (size_t)d * 16 * SEQ); vn[u][2 * d + 1] = *(const u32x2*)(vb + (size_t)d * 16 * SEQ + 16); } } } while (0)
        D_LOAD(qg >> 1);
        for (int pp = qg >> 1; pp >= 0; --pp) {
            const int kt0 = 2 * pp, kt1 = kt0 + 1;
            bf16x8 kc[2][4]; u32x2 vc[2][8];
#pragma unroll
            for (int u = 0; u < 2; ++u) {
#pragma unroll
                for (int i = 0; i < 4; ++i) kc[u][i] = kn[u][i];
#pragma unroll
                for (int i = 0; i < 8; ++i) vc[u][i] = vn[u][i]; }
            D_LOAD(pp > 0 ? pp - 1 : 0);
            float a0[2][4], a1[2][4];
#pragma unroll
            for (int u = 0; u < 2; ++u) {
                if (kt1 <= qg) {
                    f32x4 z = mfma16(kc[u][2], qf[u][0], (f32x4){0.f, 0.f, 0.f, 0.f}); z = mfma16(kc[u][3], qf[u][1], z);
                    sb_tile(z, kt1 * 16, tq, g, carry[u], a1[u]);
                } else {
#pragma unroll
                    for (int j = 0; j < 4; ++j) a1[u][j] = 0.f;
                }
            }
#pragma unroll
            for (int u = 0; u < 2; ++u) {
                f32x4 z = mfma16(kc[u][0], qf[u][0], (f32x4){0.f, 0.f, 0.f, 0.f}); z = mfma16(kc[u][1], qf[u][1], z);
                sb_tile(z, kt0 * 16, tq, g, carry[u], a0[u]);
            }
#pragma unroll
            for (int u = 0; u < 2; ++u) {
                const bf16x8 pf = mk8(cvt_pk_bf16(a0[u][0], a0[u][1]), cvt_pk_bf16(a0[u][2], a0[u][3]), cvt_pk_bf16(a1[u][0], a1[u][1]), cvt_pk_bf16(a1[u][2], a1[u][3]));
#pragma unroll
                for (int d = 0; d < 4; ++d) o[u][d] = mfma16(mk8(vc[u][2 * d].x, vc[u][2 * d].y, vc[u][2 * d + 1].x, vc[u][2 * d + 1].y), pf, o[u][d]);
            }
            if (__all(carry[0] < -104.f && carry[1] < -104.f)) break;
        }
#undef D_LOAD
#pragma unroll
        for (int u = 0; u < 2; ++u) { const int row0 = (b0 + 2 * u) * SEQ + qg * 16;
#pragma unroll
            for (int d = 0; d < 4; ++d) *(u32x2*)(OD + (size_t)(row0 + q) * 1024 + h * 64 + d * 16 + 4 * g) = (u32x2){cvt_pk_bf16(o[u][d][0], o[u][d][1]), cvt_pk_bf16(o[u][d][2], o[u][d][3])}; }
    }
}

#define XB_TMO      128
#define XB_XCNT(j)  (256  + 64 * (j))
#define XB_XSUB(j)  (1280 + 64 * (j))
#define XB_XGEN(j)  (2304 + 64 * (j))
#define XB_TOP      3328
#define XB_TOPGEN   3392
#define XCD_BAR_WORDS 3456
#define XB_SPIN_CAP (1u << 18)

__device__ __forceinline__ unsigned xb_ld(unsigned* p)              { return __hip_atomic_load(p, __ATOMIC_RELAXED, __HIP_MEMORY_SCOPE_AGENT); }
__device__ __forceinline__ unsigned xb_add(unsigned* p, unsigned v) { return __hip_atomic_fetch_add(p, v, __ATOMIC_RELAXED, __HIP_MEMORY_SCOPE_AGENT); }
__device__ __forceinline__ unsigned xb_xcc_id() { return (unsigned)__builtin_amdgcn_s_getreg((3 << 11) | 20) & 0xFu; }
#define XB_SPIN(cond, bar) do { unsigned _sp = 0; while (cond) { __builtin_amdgcn_s_sleep(1); \
    if ((++_sp & 255u) == 0u) { if (xb_ld(&(bar)[XB_TMO])) break; if (_sp > XB_SPIN_CAP) { atomicAdd(&(bar)[XB_TMO], 1u); break; } } } } while (0)

struct XcdBarrier {
    unsigned* bar; unsigned x;
    volatile LAS unsigned* st;
};

__device__ __forceinline__ XcdBarrier xcd_barrier_post(unsigned* bar, volatile LAS unsigned* st) {
    XcdBarrier b; b.bar = bar; b.x = xb_xcc_id(); b.st = st;
    if (threadIdx.x == 0) (void)xb_add(&bar[XB_XCNT(b.x)], 1u);
    return b;
}
__device__ __forceinline__ void xcd_barrier_complete(unsigned* bar, unsigned x, unsigned& nloc, unsigned& nx) {
    const unsigned G = gridDim.x * gridDim.y * gridDim.z;
    unsigned sum, cnt, mine, sp = 0u;
    for (;;) {
        sum = 0u; cnt = 0u; mine = 0u;
#pragma unroll
        for (unsigned j = 0; j < 16; ++j) { const unsigned c = xb_ld(&bar[XB_XCNT(j)]); sum += c; cnt += (c > 0u) ? 1u : 0u; mine = (j == x) ? c : mine; }
        if (sum == G) break;
        __builtin_amdgcn_s_sleep(1);
        if ((++sp & 255u) == 0u) { if (xb_ld(&bar[XB_TMO])) break; if (sp > XB_SPIN_CAP) { atomicAdd(&bar[XB_TMO], 1u); break; } }
    }
    nloc = mine > 0u ? mine : 1u; nx = cnt > 0u ? cnt : 1u;
}

__device__ __forceinline__ void xcd_barrier(const XcdBarrier& b) {
    asm volatile("s_waitcnt vmcnt(0)" ::: "memory");
    __syncthreads();
    if (threadIdx.x == 0) {
        unsigned* bar = b.bar;
        __builtin_amdgcn_s_waitcnt(0);
        unsigned nloc = b.st[0], nx = b.st[1];
        if (nloc == 0u) { xcd_barrier_complete(bar, b.x, nloc, nx); b.st[0] = nloc; b.st[1] = nx; }
        const unsigned old = xb_add(&bar[XB_XSUB(b.x)], 1u);
        const unsigned gen = old / nloc;
        if (old + 1u == (gen + 1u) * nloc) {
            __builtin_amdgcn_fence(__ATOMIC_RELEASE, "agent");
            asm volatile("s_waitcnt vmcnt(0)" ::: "memory");
            const unsigned og = xb_add(&bar[XB_TOP], 1u);
            const unsigned tg = og / nx;
            if (og + 1u == (tg + 1u) * nx) xb_add(&bar[XB_TOPGEN], 1u);
            else XB_SPIN(xb_ld(&bar[XB_TOPGEN]) == tg, bar);
            __builtin_amdgcn_fence(__ATOMIC_ACQUIRE, "agent");
            xb_add(&bar[XB_XGEN(b.x)], 1u);
            asm volatile("s_waitcnt vmcnt(0)" ::: "memory");
        } else {
            XB_SPIN(xb_ld(&bar[XB_XGEN(b.x)]) == gen, bar);
            __builtin_amdgcn_fence(__ATOMIC_ACQUIRE, "agent");
            asm volatile("s_waitcnt vmcnt(0)" ::: "memory");
        }
    }
    __syncthreads();
}

#ifndef REP_P0
#define REP_P0 1
#endif
#ifndef REP_P1
#define REP_P1 1
#endif
#ifndef REP_A1
#define REP_A1 1
#endif
#ifndef REP_BCD
#define REP_BCD 1
#endif
#ifndef REP_A2
#define REP_A2 1
#endif
#ifndef REP_MG
#define REP_MG 1
#endif
#ifndef REP_UP
#define REP_UP 1
#endif
#ifndef REP_WO
#define REP_WO 1
#endif
#ifndef REP_N2
#define REP_N2 1
#endif
#ifndef REP_DN
#define REP_DN 1
#endif
#ifndef REP_B
#define REP_B 1
#endif
#ifndef REP_C
#define REP_C 1
#endif
#ifndef REP_D
#define REP_D 1
#endif
#ifndef REP_SYNC
#define REP_SYNC 1
#endif
#define GSYNC() do { _Pragma("unroll 1") for (int r_ = 0; r_ < REP_SYNC; ++r_) xcd_barrier(bar); } while (0)
#define REPEAT(n) _Pragma("unroll 1") for (int rep_ = 0; rep_ < (n); ++rep_)
struct Args { const float* in[16]; float* out; unsigned char* ws; };
constexpr int LDS_BYTES = 147456;
__device__ __forceinline__ unsigned char* opq(unsigned char* p) { asm volatile("" : "+s"(p)); return p; }
__device__ __forceinline__ int opq_tid() { int t = threadIdx.x; asm volatile("" : "+v"(t)); return t; }
#define WSB(T, off) ((T*)(ws + (off)))
constexpr int PTAB_OFF = 147456 - 512, BST_OFF = 147456 - 64;
__device__ __forceinline__ void* ldp(PG8_LAS unsigned char* ldsl, int i) {
    unsigned off = PTAB_OFF + 8 * i; asm volatile("" : "+v"(off));
    const unsigned long long v = *(volatile LAS unsigned long long*)(ldsl + off);
    const unsigned lo = __builtin_amdgcn_readfirstlane((unsigned)v), hi = __builtin_amdgcn_readfirstlane((unsigned)(v >> 32));
    return (void*)(__attribute__((address_space(1))) void*)(((unsigned long long)hi << 32) | lo);
}

__global__ void __launch_bounds__(512, 2) fwd_kernel(Args a) {
    extern __shared__ __attribute__((aligned(16))) unsigned char lds[];
    cg::grid_group grid = cg::this_grid();
    PG8_LAS unsigned char* ldsl = (PG8_LAS unsigned char*)lds;
    if (a.ws == nullptr) grid.sync();
    if (threadIdx.x == 0) { ((volatile LAS unsigned*)(ldsl + BST_OFF))[0] = 0u; ((volatile LAS unsigned*)(ldsl + BST_OFF))[1] = 0u; }
    if (threadIdx.x == 0) { LAS unsigned long long* tb = (LAS unsigned long long*)(ldsl + PTAB_OFF);
#pragma unroll
        for (int i = 0; i < 16; ++i) tb[i] = (unsigned long long)a.in[i];
        tb[16] = (unsigned long long)a.out; tb[17] = (unsigned long long)a.ws; }
    __syncthreads();
    XcdBarrier bar = xcd_barrier_post((unsigned*)a.ws + 1024, (volatile LAS unsigned*)(ldsl + BST_OFF));
#define INP(i) ((const float*)ldp(ldsl, (i)))
#define OUTP ((float*)ldp(ldsl, 16))
#define WSP ((unsigned char*)ldp(ldsl, 17))

#define PHASE_VARS unsigned char* ws = WSP; int bid = blockIdx.x; asm volatile("" : "+s"(bid)); int G = gridDim.x; asm volatile("" : "+s"(G)); \
    const int tid = opq_tid(), lane = tid & 63, wave = __builtin_amdgcn_readfirstlane(tid >> 6); const int gw = bid * 8 + wave, ngw = G * 8; (void)ws; (void)lane; (void)gw; (void)ngw;
#ifndef REP_ALL
#define REP_ALL 1
#endif
#pragma unroll 1
    for (int ll = 0; ll < 2 * REP_ALL; ++ll) {
        const int l = ll & 1;
        REPEAT(REP_P0) {
            PHASE_VARS
#ifndef NO_CVT
            Ptrs P; P.mix_g = INP(1) + l * DM; P.ffn_g = INP(12) + l * DM;
            P.w_in = INP(2) + (size_t)l * DM * DIN; P.qn = INP(3) + l * 64; P.kn = INP(4) + l * 64; P.pool_w = INP(5) + l * 4 * 64 * 64; P.pool_scale = INP(6) + l * 256;
            P.gm_norm = INP(7) + l * 256; P.gm_ws = INP(8) + l * 4 * 128 * 128; P.gm_b = INP(9) + l * 4 * 128; P.w_branch = INP(10) + (size_t)l * 4 * 256 * 1024;
            P.w_out = INP(11) + (size_t)l * 1024 * 1024; P.w_gate = INP(13) + (size_t)l * DM * DFF; P.w_up = INP(14) + (size_t)l * DM * DFF; P.w_down = INP(15) + (size_t)l * DFF * DM;
            convert_weights(P, ws, (LAS float*)(ldsl + wave * 8448), gw, ngw, lane, bid * 512 + tid, G * 512);
#endif
            if (l == 0) x_to_bf16_ss(INP(0), WSB(bf16_t, WS_XN), WSB(float, WS_SS0), gw, ngw, lane);
        }
        GSYNC();
        REPEAT(REP_P1) {
            PHASE_VARS
            pg8::Gemm g{WSB(bf16_t, WS_XN), WSB(bf16_t, WS_WIN), M_, NINP, DM}; pg8::StaticOrder S; S.init(M_, NINP, G, bid);
            EpiIn E{ws, INP(3) + l * 64, INP(4) + l * 64, WSB(float, WS_SS0)};
#ifndef NO_G1
            pg8::gemm_phase<EpiIn, pg8::StaticOrder, true, true>(ldsl, g, S, E);
#endif
        }
        GSYNC();
        REPEAT(REP_A1) {
            PHASE_VARS
            for (int i = bid * 512 + tid; i < M_; i += G * 512) { WSB(float, WS_SS0)[i] = 0.f; WSB(float, WS_SS1)[i] = 0.f; }
#ifndef NO_A1
            phase_a1(lds, WSB(bf16_t, WS_IQ), WSB(bf16_t, WS_IK), WSB(float, WS_IW), WSB(unsigned short, WS_MASK), tid, bid, G);
#endif
        }
        REPEAT(REP_BCD) {
        REPEAT(REP_C) {
            PHASE_VARS
#ifndef NO_C
            phase_c(lds, WSB(bf16_t, WS_GV), WSB(bf16_t, WS_GU), WSB(bf16_t, WS_OCAT) + 512, INP(7) + l * 256, WSB(bf16_t, WS_WS), INP(9) + l * 4 * 128, tid, bid, G);
#endif
        }
        REPEAT(REP_B) {
            PHASE_VARS
#ifndef NO_B
            phase_b(WSB(bf16_t, WS_PIN), WSB(bf16_t, WS_WP), INP(6) + l * 256, WSB(bf16_t, WS_OCAT) + 256, gw, ngw, lane);
#endif
        }
        REPEAT(REP_D) {
            PHASE_VARS
#ifndef NO_D
            phase_d(WSB(bf16_t, WS_SQ), WSB(bf16_t, WS_OCAT) + 768, WSB(bf16_t, WS_SK), WSB(bf16_t, WS_VTS), gw, ngw, lane);
#endif
        }
        }
        GSYNC();
        REPEAT(REP_A2) {
            PHASE_VARS
#ifndef NO_A2
            phase_a2(lds, WSB(bf16_t, WS_QA), WSB(bf16_t, WS_OCAT), WSB(bf16_t, WS_KA), WSB(bf16_t, WS_VTA), WSB(unsigned short, WS_MASK), INP(3) + l * 64, INP(4) + l * 64, tid, bid, G);
#endif
        }
        GSYNC();
        REPEAT(REP_MG) {
            PHASE_VARS
            pg8::Gemm g{WSB(bf16_t, WS_OCAT), WSB(bf16_t, WS_WB), M_, DM, DM}; pg8::StaticOrder S; S.init(M_, DM, G, bid);
            EpiMerge E{ws + WS_G, WSB(bf16_t, WS_XN)};
#ifndef NO_G2
            pg8::gemm_phase<EpiMerge, pg8::StaticOrder, true, true>(ldsl, g, S, E);
#endif
        }
        GSYNC();
        REPEAT(REP_WO) {
            PHASE_VARS
            pg8::Gemm g{WSB(bf16_t, WS_XN), WSB(bf16_t, WS_WOUT), M_, DM, DM}; pg8::StaticOrder S; S.init(M_, DM, G, bid);
            EpiResid E{l == 0 ? INP(0) : OUTP, OUTP, WSB(bf16_t, WS_S), WSB(float, WS_SS1), 1};
#ifndef NO_G3
            pg8::gemm_phase<EpiResid, pg8::StaticOrder, true, true>(ldsl, g, S, E);
#endif
        }
        GSYNC();
        REPEAT(REP_UP) {
            PHASE_VARS
            pg8::Gemm g{WSB(bf16_t, WS_S), WSB(bf16_t, WS_WGU), M_, 2 * DFF, DM}; pg8::StaticOrder S; S.init(M_, 2 * DFF, G, bid);
            EpiSwiGLU E{WSB(bf16_t, WS_R1), WSB(float, WS_SS1)};
#ifndef NO_G4
            pg8::gemm_phase<EpiSwiGLU, pg8::StaticOrder, true, true>(ldsl, g, S, E);
#endif
        }
        GSYNC();
        REPEAT(REP_DN) {
            PHASE_VARS
            pg8::Gemm g{WSB(bf16_t, WS_R1), WSB(bf16_t, WS_WD), M_, DM, DFF}; pg8::StaticOrder S; S.init(M_, DM, G, bid);
            float* o = OUTP; EpiResid E{o, o, WSB(bf16_t, WS_XN), WSB(float, WS_SS0), l == 0 ? 1 : 0};
#ifndef NO_G3
            pg8::gemm_phase<EpiResid, pg8::StaticOrder, true, true>(ldsl, g, S, E);
#endif
        }
        if (ll + 1 < 2 * REP_ALL) GSYNC();
    }
}

extern "C" void kernel_launch(void* const* d_in, const int* in_sizes, int n_in, void* d_out, int out_size, void* d_ws, size_t ws_size, hipStream_t stream) {
    static int grid_blocks = 0;
    if (grid_blocks == 0) {
        if (n_in != 16 || out_size != M_ * DM || ws_size < WS_END) { fprintf(stderr, "kernel_launch: unexpected shapes (n_in %d out %d ws %zu)\n", n_in, out_size, ws_size); grid_blocks = -1; return; }
        int dev = 0, cus = 0, per_cu = 0;
        hipGetDevice(&dev);
        hipDeviceGetAttribute(&cus, hipDeviceAttributeMultiprocessorCount, dev);
        hipFuncSetAttribute((const void*)fwd_kernel, hipFuncAttributeMaxDynamicSharedMemorySize, LDS_BYTES);
        if (hipOccupancyMaxActiveBlocksPerMultiprocessor(&per_cu, (const void*)fwd_kernel, 512, LDS_BYTES) != hipSuccess || per_cu < 1) per_cu = 1;
        (void)hipGetLastError();
        grid_blocks = cus;
    }
    if (grid_blocks < 0) return;
    Args a{};
    for (int i = 0; i < 16; ++i) a.in[i] = (const float*)d_in[i];
    a.out = (float*)d_out; a.ws = (unsigned char*)d_ws;
    if (hipMemsetAsync(d_ws, 0, 20480, stream) != hipSuccess) { fprintf(stderr, "kernel_launch: memset failed\n"); return; }
    void* args[] = {&a};
    hipError_t e = hipLaunchCooperativeKernel((const void*)fwd_kernel, dim3(grid_blocks), dim3(512), args, LDS_BYTES, stream);
    if (e != hipSuccess) fprintf(stderr, "cooperative launch failed: %s (grid %d)\n", hipGetErrorString(e), grid_blocks);
}
```
